# Optimizing an MI355X kernel written in HIP

```python
import math
import jax, jax.numpy as jnp
from jax import lax
import numpy as np

D_MODEL = 2048
BATCH = 8
SEQ = 2048
DEPTH = 1

D_MIX = D_MODEL
HG_WIDTH = D_MIX // 2
HG_DK = 128
HG_HEADS = HG_WIDTH // HG_DK
HG_DV = HG_WIDTH // HG_HEADS
HG_CHUNK = 64
NSA_WIDTH = D_MIX - HG_WIDTH
NSA_HEAD_DIM = 128
NSA_HEADS = NSA_WIDTH // NSA_HEAD_DIM
NSA_KV_HEADS = 2
NSA_GROUP = NSA_HEADS // NSA_KV_HEADS
KV_WIDTH = NSA_KV_HEADS * NSA_HEAD_DIM
CMP_BLOCK = 32
CMP_STRIDE = 16
SEL_BLOCK = 64
SEL_TOP = 16
WINDOW = 512
Q_BLOCK = 128
SEL_Q_BLOCK = 32
IN_COLS = 4 * HG_WIDTH + NSA_WIDTH + 6 * KV_WIDTH + 3 * NSA_HEADS
N_EXPERTS = 32
TOP_K = 4
D_FF = D_MODEL
SWIGLU_LIMIT = 7.0
SWIGLU_ALPHA = 1.702
MOE_BLOCK = 256
EPS = 1e-6
NEG_INF = -1e30
FORCED_SCORE = 1e4

kernel_name = "hymba_hgrn2_nsa_moe_layer"


def _rmsnorm(x, g):
    xf = x.astype(jnp.float32)
    y = xf * lax.rsqrt(jnp.mean(xf * xf, axis=-1, keepdims=True) + EPS)
    return (y * g.astype(jnp.float32)).astype(x.dtype)


def _alibi_slopes():
    h = np.arange(1, NSA_HEADS + 1, dtype=np.float32)
    slopes = np.power(np.float32(2.0), -8.0 * h / NSA_HEADS).astype(np.float32)
    return jnp.asarray(slopes).reshape(NSA_KV_HEADS, NSA_GROUP)


def _hgrn2(q, f_logit, i, g, lb, norm_g):
    B, T, _ = q.shape
    dt = q.dtype
    f32 = jnp.float32
    f = lb + (1.0 - lb) * jax.nn.sigmoid(f_logit.astype(f32))
    log_f = jnp.log(f)
    k = 1.0 - f
    qf = jax.nn.silu(q.astype(f32))
    v = i.astype(f32)
    nc = T // HG_CHUNK

    def to_chunks(t, d):
        return t.reshape(B, nc, HG_CHUNK, HG_HEADS, d).transpose(1, 0, 3, 2, 4)

    xs = (to_chunks(qf, HG_DK), to_chunks(k, HG_DK), to_chunks(v, HG_DV), to_chunks(log_f, HG_DK))
    causal = jnp.tril(jnp.ones((HG_CHUNK, HG_CHUNK), f32))

    def step(S, c):
        qc, kc, vc, gc = c
        b = jnp.cumsum(gc, axis=-2)
        b_last = b[..., -1:, :]
        q_dec = qc * jnp.exp(b)
        k_dec = kc * jnp.exp(-b)
        a = jnp.einsum('bhtk,bhsk->bhts', q_dec, k_dec) * causal
        o = jnp.einsum('bhts,bhsv->bhtv', a, vc) + jnp.einsum('bhtk,bhkv->bhtv', q_dec, S)
        S = jnp.exp(b_last)[..., 0, :, None] * S + jnp.einsum('bhsk,bhsv->bhkv', kc * jnp.exp(b_last - b), vc)
        return S, o

    S0 = jnp.zeros((B, HG_HEADS, HG_DK, HG_DV), f32)
    _, o = lax.scan(step, S0, xs)
    o = o.transpose(1, 0, 3, 2, 4).reshape(B, T, HG_HEADS, HG_DV)
    o = _rmsnorm(o, norm_g) * jax.nn.silu(g.astype(f32).reshape(B, T, HG_HEADS, HG_DV))
    return o.reshape(B, T, HG_WIDTH).astype(dt)


def _nsa(q, k_cmp, v_cmp, k_sel, v_sel, k_win, v_win, gates, cmp_pos, cmp_w1, cmp_w2, norm_g):
    B, T, _ = q.shape
    dt = q.dtype
    f32 = jnp.float32
    G, R, d = NSA_KV_HEADS, NSA_GROUP, NSA_HEAD_DIM
    scale = d ** -0.5
    slopes = _alibi_slopes()
    qh = q.reshape(B, T, G, R, d).transpose(0, 2, 3, 1, 4)

    def kvh(t):
        return t.reshape(B, T, G, d).transpose(0, 2, 1, 3)

    t_pos = jnp.arange(T, dtype=jnp.int32)

    n_cmp = (T - CMP_BLOCK) // CMP_STRIDE + 1
    blk_idx = np.arange(n_cmp)[:, None] * CMP_STRIDE + np.arange(CMP_BLOCK)[None, :]

    def compress(t, j):
        blocks = kvh(t)[:, :, blk_idx] + cmp_pos[j]
        hdn = jax.nn.gelu(blocks.reshape(B, G, n_cmp, CMP_BLOCK * d) @ cmp_w1[j])
        return hdn @ cmp_w2[j]

    kc = compress(k_cmp, 0)
    vc = compress(v_cmp, 1)
    cmp_end = jnp.asarray(blk_idx[:, -1], jnp.int32)
    dist_c = t_pos[:, None] - cmp_end[None, :]
    valid_c = dist_c >= 0
    s = jnp.einsum('bgrtd,bgnd->bgrtn', qh, kc, preferred_element_type=f32) * scale \
        - slopes[:, :, None, None] * dist_c.astype(f32)
    s = jnp.where(valid_c, s, NEG_INF)
    p_cmp = jnp.where(valid_c, jax.nn.softmax(s, axis=-1), 0.0)
    o_cmp = jnp.einsum('bgrtn,bgnd->bgrtd', p_cmp.astype(dt), vc)

    n_sel = T // SEL_BLOCK
    top_n = min(SEL_TOP, n_sel)
    ratio_s = SEL_BLOCK // CMP_STRIDE
    ratio_c = CMP_BLOCK // CMP_STRIDE
    jj, mm, nn = np.meshgrid(np.arange(n_sel), np.arange(ratio_s), np.arange(ratio_c), indexing='ij')
    ii = ratio_s * jj + mm + nn - (ratio_c - 1)
    ok = (ii >= 0) & (ii < n_cmp)
    overlap = np.zeros((n_cmp, n_sel), np.float32)
    np.add.at(overlap, (ii[ok], jj[ok]), 1.0)
    imp = jnp.einsum('bgrtn,nj->bgtj', p_cmp, jnp.asarray(overlap))
    blk = jnp.arange(n_sel, dtype=jnp.int32)
    cur = t_pos // SEL_BLOCK
    sel_valid = blk[None, :] <= cur[:, None]
    forced = (blk[None, :] == 0) | (blk[None, :] == cur[:, None]) | (blk[None, :] == cur[:, None] - 1)
    score = jnp.where(forced, FORCED_SCORE, jnp.where(sel_valid, imp, -FORCED_SCORE))
    _, sel_idx = lax.top_k(score, top_n)

    k_blocks = kvh(k_sel).reshape(B, G, n_sel, SEL_BLOCK, d)
    v_blocks = kvh(v_sel).reshape(B, G, n_sel, SEL_BLOCK, d)
    gather = jax.vmap(jax.vmap(lambda blocks, ix: blocks[ix]))

    def sel_block(qb):
        s0 = qb * SEL_Q_BLOCK
        qblk = lax.dynamic_slice_in_dim(qh, s0, SEL_Q_BLOCK, axis=3)
        iblk = lax.dynamic_slice_in_dim(sel_idx, s0, SEL_Q_BLOCK, axis=2)
        kb = gather(k_blocks, iblk)
        vb = gather(v_blocks, iblk)
        tq = s0 + jnp.arange(SEL_Q_BLOCK, dtype=jnp.int32)
        kpos = iblk[..., None] * SEL_BLOCK + jnp.arange(SEL_BLOCK, dtype=jnp.int32)
        dist = (tq[:, None, None] - kpos)[:, :, None]
        sc = jnp.einsum('bgrqd,bgqkld->bgrqkl', qblk, kb, preferred_element_type=f32) * scale \
            - slopes[:, :, None, None, None] * dist.astype(f32)
        sc = jnp.where(dist >= 0, sc, NEG_INF)
        p = jax.nn.softmax(sc.reshape(B, G, R, SEL_Q_BLOCK, top_n * SEL_BLOCK), axis=-1).reshape(sc.shape)
        return jnp.einsum('bgrqkl,bgqkld->bgrqd', p.astype(dt), vb)

    o_sel = lax.map(sel_block, jnp.arange(T // SEL_Q_BLOCK, dtype=jnp.int32))
    o_sel = o_sel.transpose(1, 2, 3, 0, 4, 5).reshape(B, G, R, T, d)

    kw = jnp.pad(kvh(k_win), ((0, 0), (0, 0), (WINDOW, 0), (0, 0)))
    vw = jnp.pad(kvh(v_win), ((0, 0), (0, 0), (WINDOW, 0), (0, 0)))
    span = WINDOW + Q_BLOCK

    def win_block(qb):
        s0 = qb * Q_BLOCK
        qblk = lax.dynamic_slice_in_dim(qh, s0, Q_BLOCK, axis=3)
        kblk = lax.dynamic_slice_in_dim(kw, s0, span, axis=2)
        vblk = lax.dynamic_slice_in_dim(vw, s0, span, axis=2)
        tq = s0 + jnp.arange(Q_BLOCK, dtype=jnp.int32)
        kpos = s0 - WINDOW + jnp.arange(span, dtype=jnp.int32)
        dist = tq[:, None] - kpos[None, :]
        okw = (dist >= 0) & (dist < WINDOW) & (kpos[None, :] >= 0)
        sc = jnp.einsum('bgrqd,bgkd->bgrqk', qblk, kblk, preferred_element_type=f32) * scale \
            - slopes[:, :, None, None] * dist.astype(f32)
        sc = jnp.where(okw, sc, NEG_INF)
        p = jax.nn.softmax(sc, axis=-1)
        return jnp.einsum('bgrqk,bgkd->bgrqd', p.astype(dt), vblk)

    o_win = lax.map(win_block, jnp.arange(T // Q_BLOCK, dtype=jnp.int32))
    o_win = o_win.transpose(1, 2, 3, 0, 4, 5).reshape(B, G, R, T, d)

    gt = jax.nn.sigmoid(gates.astype(f32)).reshape(B, T, G, R, 3).transpose(0, 2, 3, 1, 4)
    o = gt[..., 0:1] * o_cmp + gt[..., 1:2] * o_sel + gt[..., 2:3] * o_win
    o = _rmsnorm(o.transpose(0, 3, 1, 2, 4), norm_g)
    return o.reshape(B, T, NSA_WIDTH).astype(dt)


def _moe(x, w_router, b_router, w_gate_up, b_gate_up, w_down, b_down):
    B, T, D = x.shape
    n_tok = B * T
    xf = x.reshape(n_tok, D)
    logits = jnp.dot(xf, w_router, preferred_element_type=jnp.float32) + b_router.astype(jnp.float32)
    top_logit, top_idx = lax.top_k(logits, TOP_K)
    top_w = jax.nn.softmax(top_logit, axis=-1)
    n_asg = n_tok * TOP_K
    flat_e = top_idx.reshape(n_asg)
    flat_tok = jnp.repeat(jnp.arange(n_tok, dtype=jnp.int32), TOP_K)
    flat_w = top_w.reshape(n_asg)
    order = jnp.argsort(flat_e)
    se, stok, sw = flat_e[order], flat_tok[order], flat_w[order]
    counts = jnp.bincount(flat_e, length=N_EXPERTS)
    start = jnp.cumsum(counts) - counts
    padded = (counts + MOE_BLOCK - 1) // MOE_BLOCK * MOE_BLOCK
    pad_end = jnp.cumsum(padded)
    pad_start = pad_end - padded
    dest = pad_start[se] + jnp.arange(n_asg, dtype=jnp.int32) - start[se]
    n_blocks = -(-n_asg // MOE_BLOCK) + N_EXPERTS
    cap = n_blocks * MOE_BLOCK
    slot_tok = jnp.full((cap,), n_tok, jnp.int32).at[dest].set(stok)
    slot_w = jnp.zeros((cap,), jnp.float32).at[dest].set(sw)
    block_e = jnp.minimum(jnp.searchsorted(pad_end, jnp.arange(n_blocks, dtype=jnp.int32) * MOE_BLOCK, side='right'),
                          N_EXPERTS - 1)
    x_pad = jnp.concatenate([xf, jnp.zeros((1, D), xf.dtype)], axis=0)

    def expert_block(args):
        e, tok, w = args
        hgu = x_pad[tok] @ w_gate_up[e] + b_gate_up[e]
        gate, up = jnp.split(hgu, 2, axis=-1)
        gate = jnp.minimum(gate, SWIGLU_LIMIT)
        up = jnp.clip(up, -SWIGLU_LIMIT, SWIGLU_LIMIT)
        act = gate * jax.nn.sigmoid(SWIGLU_ALPHA * gate) * (up + 1.0)
        y = act @ w_down[e] + b_down[e]
        return y.astype(jnp.float32) * w[:, None]

    y = lax.map(expert_block, (block_e, slot_tok.reshape(n_blocks, MOE_BLOCK), slot_w.reshape(n_blocks, MOE_BLOCK)))
    y = jax.ops.segment_sum(y.reshape(cap, D), slot_tok, num_segments=n_tok + 1)[:n_tok]
    return y.reshape(B, T, D).astype(x.dtype)


def setup_inputs(seed: int = 0) -> dict:
    key = jax.random.key(seed)
    ks = jax.random.split(key, 19)
    f32 = jnp.float32

    def nrm(k, shape, s):
        return jax.random.normal(k, shape, f32) * s

    Lc = CMP_BLOCK * NSA_HEAD_DIM
    return {
        "x": nrm(ks[0], (BATCH, SEQ, D_MODEL), 1.0),
        "norm1_g": 1.0 + nrm(ks[1], (DEPTH, D_MODEL), 0.02),
        "w_in": nrm(ks[2], (DEPTH, D_MODEL, IN_COLS), D_MODEL ** -0.5),
        "hg_lb_logits": nrm(ks[3], (DEPTH + 1, HG_WIDTH), 0.5),
        "hg_norm_g": 1.0 + nrm(ks[4], (DEPTH, HG_DV), 0.02),
        "cmp_pos": nrm(ks[5], (DEPTH, 2, CMP_BLOCK, NSA_HEAD_DIM), 0.1),
        "cmp_w1": nrm(ks[6], (DEPTH, 2, Lc, NSA_HEAD_DIM), Lc ** -0.5),
        "cmp_w2": nrm(ks[7], (DEPTH, 2, NSA_HEAD_DIM, NSA_HEAD_DIM), NSA_HEAD_DIM ** -0.5),
        "nsa_norm_g": 1.0 + nrm(ks[8], (DEPTH, NSA_HEAD_DIM), 0.02),
        "w_out": nrm(ks[9], (DEPTH, D_MIX, D_MODEL), D_MIX ** -0.5),
        "norm2_g": 1.0 + nrm(ks[10], (DEPTH, D_MODEL), 0.02),
        "w_router": nrm(ks[11], (DEPTH, D_MODEL, N_EXPERTS), D_MODEL ** -0.5),
        "b_router": nrm(ks[12], (DEPTH, N_EXPERTS), 0.01),
        "w_gate_up": nrm(ks[13], (DEPTH, N_EXPERTS, D_MODEL, 2 * D_FF), D_MODEL ** -0.5),
        "b_gate_up": nrm(ks[14], (DEPTH, N_EXPERTS, 2 * D_FF), 0.01),
        "w_down": nrm(ks[15], (DEPTH, N_EXPERTS, D_FF, D_MODEL), D_FF ** -0.5),
        "b_down": nrm(ks[16], (DEPTH, N_EXPERTS, D_MODEL), 0.01),
        "final_norm_g": 1.0 + nrm(ks[17], (D_MODEL,), 0.02),
    }


def reference(x, norm1_g, w_in, hg_lb_logits, hg_norm_g, cmp_pos, cmp_w1, cmp_w2, nsa_norm_g, w_out,
              norm2_g, w_router, b_router, w_gate_up, b_gate_up, w_down, b_down, final_norm_g):
    split_points = np.cumsum([HG_WIDTH] * 4 + [NSA_WIDTH] + [KV_WIDTH] * 6).tolist()
    lb_all = jnp.cumsum(jax.nn.softmax(hg_lb_logits.astype(jnp.float32), axis=0), axis=0)
    B, T, _ = x.shape
    h = x
    for l in range(DEPTH):
        u = _rmsnorm(h, norm1_g[l])
        proj = u @ w_in[l]
        (hq, hf, hi, hgt, nq, kcm, vcm, ksl, vsl, kwn, vwn, ngt) = jnp.split(proj, split_points, axis=-1)
        y_hg = _hgrn2(hq, hf, hi, hgt, lb_all[l], hg_norm_g[l])
        y_nsa = _nsa(nq, kcm, vcm, ksl, vsl, kwn, vwn, ngt.reshape(B, T, NSA_HEADS, 3),
                     cmp_pos[l], cmp_w1[l], cmp_w2[l], nsa_norm_g[l])
        h = h + jnp.concatenate([y_hg, y_nsa], axis=-1) @ w_out[l]
        h = h + _moe(_rmsnorm(h, norm2_g[l]), w_router[l], b_router[l], w_gate_up[l], b_gate_up[l],
                     w_down[l], b_down[l])
    return _rmsnorm(h, final_norm_g)
```

```cpp
#include <hip/hip_runtime.h>
#include <stdint.h>
#include <stdio.h>

#ifndef N_LAUNCH_PER_PHASE
#define N_LAUNCH_PER_PHASE 0
#endif

#define DEBUG_CMP 0
#ifndef REP_MASK
#define REP_MASK 0
#endif
#define LAS __attribute__((address_space(3)))
typedef unsigned short bf16_t;
typedef short bf16x8 __attribute__((ext_vector_type(8)));
typedef float f32x4 __attribute__((ext_vector_type(4)));
typedef float f32x2 __attribute__((ext_vector_type(2)));
typedef float f32x16 __attribute__((ext_vector_type(16)));
typedef unsigned u32x4 __attribute__((ext_vector_type(4)));
typedef unsigned u32x2 __attribute__((ext_vector_type(2)));
typedef int i32x8 __attribute__((ext_vector_type(8)));

constexpr int BATCH = 8, SEQ = 2048, NTOK = BATCH * SEQ, DM = 2048;
constexpr int HG_W = 1024, HG_H = 8, HG_DK = 128, HG_DV = 128;
constexpr int NSA_H = 8, NSA_G = 2, NSA_R = 4, HD = 128, KVW = 256;
constexpr int IN_COLS = 6680, PROJ_LD = 6912;
constexpr int C_HQ = 0, C_HF = 1024, C_HI = 2048, C_HGT = 3072, C_NQ = 4096, C_KCM = 5120, C_VCM = 5376, C_KSL = 5632, C_VSL = 5888, C_KWN = 6144, C_VWN = 6400, C_NGT = 6656;
constexpr int NCMP = 127, NSEL = 32, SEL_TOP = 16, WINDOW = 512;
constexpr int NEXP = 32, TOPK = 4, DFF = 2048, NASG = NTOK * TOPK;
constexpr float EPS = 1e-6f;
constexpr int NTHREADS = 512;
constexpr int CONV_P0 = 0, CONV_P2 = 1280;

constexpr size_t al256(size_t x) { return (x + 255) & ~(size_t)255; }
constexpr size_t WS_CTL = 0, CTL_BYTES = 65536;
constexpr size_t WS_WINT = WS_CTL + CTL_BYTES;
constexpr size_t WS_WOUTT = WS_WINT + (size_t)PROJ_LD * DM * 2;
constexpr size_t WS_WGUT = WS_WOUTT + (size_t)DM * DM * 2;
constexpr size_t WS_WDT = WS_WGUT + (size_t)NEXP * 2 * DFF * DM * 2;
constexpr size_t WS_W1T = WS_WDT + (size_t)NEXP * DM * DFF * 2;
constexpr size_t WS_W2T = WS_W1T + (size_t)2 * 128 * 4096 * 2;
constexpr size_t WS_BIAS1 = WS_W2T + (size_t)2 * 128 * 128 * 2;
constexpr size_t WS_WR2 = WS_BIAS1 + 1024;
constexpr size_t WS_LB = WS_WR2 + (size_t)DM * NEXP * 4;
constexpr size_t WS_U = WS_LB + 4096;
constexpr size_t WS_PROJ = WS_U + (size_t)NTOK * DM * 2;
constexpr size_t WS_KC = WS_PROJ + (size_t)(NTOK + 64) * PROJ_LD * 2;
constexpr size_t WS_VC = WS_KC + (size_t)16 * 128 * 128 * 2;
constexpr size_t WS_YMIX = WS_VC + (size_t)16 * 128 * 128 * 2;
constexpr size_t WS_H1 = WS_YMIX + (size_t)NTOK * DM * 2;
constexpr size_t WS_TOKW = WS_H1 + (size_t)NTOK * DM * 4;
constexpr size_t WS_SLOT = WS_TOKW + (size_t)NTOK * 4 * 4;
constexpr size_t WS_ACT = WS_SLOT + (size_t)NEXP * NTOK * 4;
constexpr size_t WS_Y = WS_ACT + (size_t)NASG * DFF * 2;
constexpr size_t WS_OT = WS_Y + (size_t)NASG * DM * 2;
constexpr size_t WS_OMF = WS_OT + (size_t)256 * 64 * 512 * 4;
constexpr size_t WS_B1P = WS_OMF + (size_t)NTOK * HG_W * 2;
constexpr size_t WS_END = WS_B1P + (size_t)2 * 32 * 128 * 4;
constexpr int CW_CNT = 4096, CW_QUEUE = 4160, CW_ERR = 4224, CW_AMAX = 4544;

__device__ __forceinline__ float bf2f(bf16_t b) { return __uint_as_float(((unsigned)b) << 16); }
typedef __bf16 bf16v2_t __attribute__((ext_vector_type(2)));
__device__ __forceinline__ unsigned cvt_pk_bf16(float lo, float hi) { f32x2 v = {lo, hi}; bf16v2_t r = __builtin_convertvector(v, bf16v2_t); return __builtin_bit_cast(unsigned, r); }
__device__ __forceinline__ unsigned cvt4_fp8(float a, float b, float c, float d) { unsigned w = 0u; w = __builtin_amdgcn_cvt_pk_fp8_f32(a, b, w, false); w = __builtin_amdgcn_cvt_pk_fp8_f32(c, d, w, true); return w; }
__device__ __forceinline__ unsigned cvt4_bf8(float a, float b, float c, float d) { unsigned w = 0u; w = __builtin_amdgcn_cvt_pk_bf8_f32(a, b, w, false); w = __builtin_amdgcn_cvt_pk_bf8_f32(c, d, w, true); return w; }
__device__ __forceinline__ int amax_shift(unsigned bits) { if (bits == 0u) return 0; int s_ = 5 - ((int)(bits >> 23) - 127); return s_ < -60 ? -60 : (s_ > 60 ? 60 : s_); }
__device__ __forceinline__ float shift_mult(int s_) { return __uint_as_float((unsigned)(s_ + 127) << 23); }
__device__ __forceinline__ unsigned cvt4_fp8s(float a, float b, float c, float d, float m) {
    return cvt4_fp8(__builtin_amdgcn_fmed3f(a * m, -448.f, 448.f), __builtin_amdgcn_fmed3f(b * m, -448.f, 448.f), __builtin_amdgcn_fmed3f(c * m, -448.f, 448.f), __builtin_amdgcn_fmed3f(d * m, -448.f, 448.f)); }
__device__ __forceinline__ bf16_t f2bf(float f) { return (bf16_t)(cvt_pk_bf16(f, 0.f) & 0xffffu); }
__device__ __forceinline__ float sigmoidf_(float x) { return 1.f / (1.f + __expf(-x)); }
__device__ __forceinline__ float siluf_(float x) { return x * sigmoidf_(x); }
__device__ __forceinline__ float wave_sum(float v) {
#pragma unroll
    for (int o = 32; o > 0; o >>= 1) v += __shfl_xor(v, o);
    return v;
}
__device__ __forceinline__ float wave_max(float v) {
#pragma unroll
    for (int o = 32; o > 0; o >>= 1) v = fmaxf(v, __shfl_xor(v, o));
    return v;
}
__device__ __forceinline__ void unpack8(const u32x4 w, float (&f)[8]) {
#pragma unroll
    for (int i = 0; i < 4; ++i) { f[2 * i] = __uint_as_float(w[i] << 16); f[2 * i + 1] = __uint_as_float(w[i] & 0xffff0000u); }
}

#define XB_TMO      128
#define XB_XCNT(j)  (256  + 64 * (j))
#define XB_XSUB(j)  (1280 + 64 * (j))
#define XB_XGEN(j)  (2304 + 64 * (j))
#define XB_TOP      3328
#define XB_TOPGEN   3392
#define XCD_BAR_WORDS 3456
#define XB_SPIN_CAP (1u << 18)
__device__ __forceinline__ unsigned xb_ld(unsigned* p)              { return __hip_atomic_load(p, __ATOMIC_RELAXED, __HIP_MEMORY_SCOPE_AGENT); }
__device__ __forceinline__ unsigned xb_add(unsigned* p, unsigned v) { return __hip_atomic_fetch_add(p, v, __ATOMIC_RELAXED, __HIP_MEMORY_SCOPE_AGENT); }
__device__ __forceinline__ unsigned xb_xcc_id() { return (unsigned)__builtin_amdgcn_s_getreg((3 << 11) | 20) & 0xFu; }
#define XB_SPIN(cond, bar) do { unsigned _sp = 0; while (cond) { __builtin_amdgcn_s_sleep(1); \
    if ((++_sp & 255u) == 0u) { if (xb_ld(&(bar)[XB_TMO])) break; if (_sp > XB_SPIN_CAP) { atomicAdd(&(bar)[XB_TMO], 1u); break; } } } } while (0)
struct XcdBarrier { unsigned* bar; unsigned x; volatile LAS unsigned* st; };
__device__ __forceinline__ XcdBarrier xcd_barrier_post(unsigned* bar, volatile LAS unsigned* st) {
    XcdBarrier b; b.bar = bar; b.x = xb_xcc_id(); b.st = st;
    if (threadIdx.x == 0) (void)xb_add(&bar[XB_XCNT(b.x)], 1u);
    return b;
}
__device__ __forceinline__ void xcd_barrier_complete(unsigned* bar, unsigned x, unsigned& nloc, unsigned& nx) {
    const unsigned G = gridDim.x * gridDim.y * gridDim.z;
    unsigned sum, cnt, mine, sp = 0u;
    for (;;) {
        sum = 0u; cnt = 0u; mine = 0u;
#pragma unroll
        for (unsigned j = 0; j < 16; ++j) { const unsigned c = xb_ld(&bar[XB_XCNT(j)]); sum += c; cnt += (c > 0u) ? 1u : 0u; mine = (j == x) ? c : mine; }
        if (sum == G) break;
        __builtin_amdgcn_s_sleep(1);
        if ((++sp & 255u) == 0u) { if (xb_ld(&bar[XB_TMO])) break; if (sp > XB_SPIN_CAP) { atomicAdd(&bar[XB_TMO], 1u); break; } }
    }
    nloc = mine > 0u ? mine : 1u; nx = cnt > 0u ? cnt : 1u;
}
__device__ __forceinline__ void xcd_barrier(const XcdBarrier& b) {
    asm volatile("s_waitcnt vmcnt(0)" ::: "memory");
    __syncthreads();
    if (threadIdx.x == 0) {
        unsigned* bar = b.bar;
        __builtin_amdgcn_s_waitcnt(0);
        unsigned nloc = b.st[0], nx = b.st[1];
        if (nloc == 0u) { xcd_barrier_complete(bar, b.x, nloc, nx); b.st[0] = nloc; b.st[1] = nx; }
        const unsigned old = xb_add(&bar[XB_XSUB(b.x)], 1u);
        const unsigned gen = old / nloc;
        if (old + 1u == (gen + 1u) * nloc) {
            __builtin_amdgcn_fence(__ATOMIC_RELEASE, "agent");
            asm volatile("s_waitcnt vmcnt(0)" ::: "memory");
            const unsigned og = xb_add(&bar[XB_TOP], 1u);
            const unsigned tg = og / nx;
            if (og + 1u == (tg + 1u) * nx) xb_add(&bar[XB_TOPGEN], 1u);
            else XB_SPIN(xb_ld(&bar[XB_TOPGEN]) == tg, bar);
            __builtin_amdgcn_fence(__ATOMIC_ACQUIRE, "agent");
            xb_add(&bar[XB_XGEN(b.x)], 1u);
            asm volatile("s_waitcnt vmcnt(0)" ::: "memory");
        } else {
            XB_SPIN(xb_ld(&bar[XB_XGEN(b.x)]) == gen, bar);
            __builtin_amdgcn_fence(__ATOMIC_ACQUIRE, "agent");
            asm volatile("s_waitcnt vmcnt(0)" ::: "memory");
        }
    }
    __syncthreads();
}

namespace g8 {
constexpr int BM = 256, BK = 64, HALF = 128, HTB = HALF * BK * 2, STAGE_BYTES = 8 * HTB, NXCD = 8;
__host__ __device__ __forceinline__ int lds_byte(int r, int c) { const int st = (r >> 4) * 2 + (c >> 5), rr = r & 15, cc = c & 31, ob = rr * 64 + cc * 2; return st * 1024 + (ob ^ (((ob >> 9) & 1) << 5)); }
__host__ __device__ __forceinline__ void stage_rc(int b, int& R, int& C) { const int st = b / 1024, sb = b % 1024, swz = sb ^ (((sb >> 9) & 1) << 5); R = (st >> 1) * 16 + swz / 64; C = (st & 1) * 32 + (swz % 64) / 2; }
__host__ __device__ __forceinline__ int perm32(int rho) { const int n = rho >> 4, i = rho & 15; return 8 * (i >> 2) + 4 * n + (i & 3); }

struct Unit { const char* A; const char* B0; const char* B1; const int* rows; const float* bias0; const float* bias1; int nvalid; int m0, n0, e; int wscale; };

template <class Sched>
__device__ __forceinline__ void a_offsets(const Unit& u, const int (&R)[2], const int (&C)[2], unsigned (&vo)[2][2]) {
#pragma unroll
    for (int h = 0; h < 2; ++h)
#pragma unroll
        for (int i = 0; i < 2; ++i) {
            if constexpr (Sched::GATHER) {
                const int r = h * HALF + R[i];
                const int idx = u.rows[r < u.nvalid ? r : 0] >> Sched::SHIFT;
                vo[h][i] = (unsigned)idx * (unsigned)(Sched::LDA * Sched::ESZ) + (unsigned)C[i] * 2u;
            } else {
                vo[h][i] = (unsigned)(h * HALF + R[i]) * (unsigned)(Sched::LDA * Sched::ESZ) + (unsigned)C[i] * 2u;
            }
        }
}

__device__ __forceinline__ const char* uni_ptr(const char* p) { const unsigned long long v = (unsigned long long)p;
    const unsigned lo = (unsigned)__builtin_amdgcn_readfirstlane((int)(unsigned)v), hi = (unsigned)__builtin_amdgcn_readfirstlane((int)(unsigned)(v >> 32));
    return (const char*)(((unsigned long long)hi << 32) | lo); }
template <class Sched, class Epi>
__device__ __forceinline__ void gemm_phase(LAS unsigned char* lds, const Sched& S, const Epi& E) {
    const int tid = threadIdx.x, wid = __builtin_amdgcn_readfirstlane(tid >> 6), lane = tid & 63, wr = wid >> 2, wc = wid & 3, fr = lane & 15, fq = lane >> 4;
    constexpr int K = Sched::K, nt = K * Sched::ESZ / (BK * 2);
    int Rr[2], Cc[2]; unsigned voffB[2];
#pragma unroll
    for (int i = 0; i < 2; ++i) { stage_rc(tid * 16 + i * 8192, Rr[i], Cc[i]); const int Rb = Epi::PERM ? ((Rr[i] & ~31) + perm32(Rr[i] & 31)) : Rr[i];
        voffB[i] = (unsigned)Rb * (unsigned)(K * Sched::ESZ) + (unsigned)Cc[i] * 2u; }
    const size_t kstep = (size_t)(BK * 2);
    const unsigned ldsw = (unsigned)wid * 1024u;
    const int aoff = lds_byte(wr * 64 + fr, fq * 8), boff = lds_byte(wc * 32 + fr, fq * 8);
#define G8_SA(b, h) (((b) * 2 + (h)) * HTB)
#define G8_SB(b, h) ((4 + (b) * 2 + (h)) * HTB)
#define G8_STAGE(bufoff, gbase, voff) do { _Pragma("unroll") for (int _i = 0; _i < 2; ++_i) \
        __builtin_amdgcn_global_load_lds((const unsigned*)((const char*)(gbase) + (voff)[_i]), (LAS unsigned*)(lds + (bufoff) + ldsw + _i * 8192), 16, 0, 0); } while (0)
#define G8_LDA(dst, b, h) do { _Pragma("unroll") for (int m = 0; m < 4; ++m) _Pragma("unroll") for (int k = 0; k < 2; ++k) dst[m][k] = *(const LAS bf16x8*)(lds + G8_SA(b, h) + aoff + m * 2048 + k * 1024); } while (0)
#define G8_LDB(dst, b, h) do { _Pragma("unroll") for (int n = 0; n < 2; ++n) _Pragma("unroll") for (int k = 0; k < 2; ++k) dst[n][k] = *(const LAS bf16x8*)(lds + G8_SB(b, h) + boff + n * 2048 + k * 1024); } while (0)
#define G8_MMA(ai, bj, At, Bt) do { __builtin_amdgcn_s_setprio(1); _Pragma("unroll") for (int m = 0; m < 4; ++m) _Pragma("unroll") for (int n = 0; n < 2; ++n) { \
        if constexpr (Sched::ESZ == 2) { _Pragma("unroll") for (int k = 0; k < 2; ++k) acc[ai][bj][m][n] = __builtin_amdgcn_mfma_f32_16x16x32_bf16(Bt[n][k], At[m][k], acc[ai][bj][m][n], 0, 0, 0); } \
        else { const u32x4 b0_ = __builtin_bit_cast(u32x4, Bt[n][0]), b1_ = __builtin_bit_cast(u32x4, Bt[n][1]), a0_ = __builtin_bit_cast(u32x4, At[m][0]), a1_ = __builtin_bit_cast(u32x4, At[m][1]); \
            const i32x8 bw_ = {(int)b0_[0], (int)b0_[1], (int)b0_[2], (int)b0_[3], (int)b1_[0], (int)b1_[1], (int)b1_[2], (int)b1_[3]}; \
            const i32x8 aw_ = {(int)a0_[0], (int)a0_[1], (int)a0_[2], (int)a0_[3], (int)a1_[0], (int)a1_[1], (int)a1_[2], (int)a1_[3]}; \
            acc[ai][bj][m][n] = __builtin_amdgcn_mfma_scale_f32_16x16x128_f8f6f4(bw_, aw_, acc[ai][bj][m][n], Sched::FMT_W, Sched::FMT_A, 0, wsc_cur, 0, 0x7f7f7f7f); } } \
        __builtin_amdgcn_s_setprio(0); } while (0)
#define G8_WAIT_V(n) asm volatile("s_waitcnt vmcnt(" #n ")" ::: "memory")
#define G8_WAIT_L(n) asm volatile("s_waitcnt lgkmcnt(" #n ")" ::: "memory")
#define G8_BAR __builtin_amdgcn_s_barrier()
#define G8_SCHED __builtin_amdgcn_sched_barrier(0)
    Unit cur, nxt; int ui = 0;
    if (!S.next(0, cur)) return;
    f32x4 acc[2][2][4][2];
#pragma unroll
    for (int a = 0; a < 2; ++a)
#pragma unroll
        for (int b = 0; b < 2; ++b)
#pragma unroll
            for (int m = 0; m < 4; ++m)
#pragma unroll
                for (int n = 0; n < 2; ++n) acc[a][b][m][n] = (f32x4){0.f, 0.f, 0.f, 0.f};
    bf16x8 At[4][2], B0[2][2], B1[2][2];
    unsigned voffA[2][2], nvoffA[2][2];
    LAS unsigned char* auxb = lds + STAGE_BYTES; int par_cur = 0, par_nxt = 1;
#define G8_AUX_ISSUE(U, PAR) do { if (wid < 4) { const int r_ = wid * 64 + lane; __builtin_amdgcn_global_load_lds((const unsigned*)((U).rows + (r_ < (U).nvalid ? r_ : 0)), (LAS unsigned*)(auxb + (PAR) * 2048 + wid * 256), 4, 0, 0); } \
        else { const float* b_ = (wid < 6 ? (U).bias0 + (wid - 4) * 64 : (U).bias1 + (wid - 6) * 64) + lane; __builtin_amdgcn_global_load_lds((const unsigned*)b_, (LAS unsigned*)(auxb + (PAR) * 2048 + 1024 + (wid - 4) * 256), 4, 0, 0); } } while (0)
#define G8_AUX_OFFS(PAR) do { _Pragma("unroll") for (int h = 0; h < 2; ++h) _Pragma("unroll") for (int i = 0; i < 2; ++i) { \
        const int idx_ = *(const LAS int*)(auxb + (PAR) * 2048 + (h * HALF + Rr[i]) * 4) >> Sched::SHIFT; voffA[h][i] = (unsigned)idx_ * (unsigned)(Sched::LDA * Sched::ESZ) + (unsigned)Cc[i] * 2u; } } while (0)
    if constexpr (Sched::LDSAUX) { G8_AUX_ISSUE(cur, 0); G8_WAIT_V(0); __syncthreads(); G8_AUX_OFFS(0); }
    else a_offsets<Sched>(cur, Rr, Cc, voffA);
    const char* cA = cur.A; const char* cB0 = cur.B0; const char* cB1 = cur.B1;
    int wsc_cur = cur.wscale;
    G8_STAGE(G8_SB(0, 0), cB0, voffB); G8_STAGE(G8_SA(0, 0), cA, voffA[0]); G8_STAGE(G8_SB(0, 1), cB1, voffB); G8_STAGE(G8_SA(0, 1), cA, voffA[1]);
    if (wr == 1) G8_BAR;
    G8_WAIT_V(4); G8_BAR;
    G8_STAGE(G8_SB(1, 0), cB0 + kstep, voffB); G8_STAGE(G8_SA(1, 0), cA + kstep, voffA[0]); G8_STAGE(G8_SB(1, 1), cB1 + kstep, voffB);
    G8_WAIT_V(6); G8_BAR;
    for (;;) {
        const bool has_next = S.next(ui + 1, nxt);
        const char* nA = has_next ? nxt.A : cA; const char* nB0 = has_next ? nxt.B0 : cB0; const char* nB1 = has_next ? nxt.B1 : cB1;
        if constexpr (Sched::LDSAUX) { if (has_next) G8_AUX_ISSUE(nxt, par_nxt); }
        else if constexpr (Sched::GATHER) {
            if (has_next) a_offsets<Sched>(nxt, Rr, Cc, nvoffA);
            else {
#pragma unroll
                for (int h = 0; h < 2; ++h)
#pragma unroll
                    for (int i = 0; i < 2; ++i) nvoffA[h][i] = voffA[h][i];
            }
        }
        for (int t = 0; t < nt; t += 2) {
            const bool last = (t == nt - 2);
            const char* a1 = cA + (size_t)(t + 1) * kstep;
            const char* a2 = last ? nA : cA + (size_t)(t + 2) * kstep;
            const char* b20 = last ? nB0 : cB0 + (size_t)(t + 2) * kstep; const char* b21 = last ? nB1 : cB1 + (size_t)(t + 2) * kstep;
            const char* a3 = a2 + kstep; const char* b30 = b20 + kstep; const char* b31 = b21 + kstep;
            G8_LDB(B0, 0, 0); G8_SCHED; G8_LDA(At, 0, 0); G8_STAGE(G8_SA(1, 1), a1, voffA[1]);
            G8_WAIT_L(8); G8_BAR; G8_WAIT_L(0); G8_MMA(0, 0, At, B0); G8_BAR; G8_SCHED;
            if constexpr (Sched::LDSAUX) { if (last && has_next) G8_AUX_OFFS(par_nxt); }
            else if constexpr (Sched::GATHER) { if (last) {
#pragma unroll
                for (int h = 0; h < 2; ++h)
#pragma unroll
                    for (int i = 0; i < 2; ++i) voffA[h][i] = nvoffA[h][i]; } }
            G8_LDB(B1, 0, 1); G8_STAGE(G8_SB(0, 0), b20, voffB);
            G8_BAR; G8_WAIT_L(0); G8_MMA(0, 1, At, B1); G8_BAR;
            G8_LDA(At, 0, 1); G8_STAGE(G8_SA(0, 0), a2, voffA[0]);
            G8_BAR; G8_WAIT_L(0); G8_MMA(1, 0, At, B0); G8_BAR; G8_SCHED;
            G8_STAGE(G8_SB(0, 1), b21, voffB);
            G8_WAIT_V(6); G8_BAR; G8_MMA(1, 1, At, B1); G8_BAR;
            G8_LDB(B0, 1, 0); G8_SCHED; G8_LDA(At, 1, 0); G8_STAGE(G8_SA(0, 1), a2, voffA[1]);
            G8_WAIT_L(8); G8_BAR; G8_WAIT_L(0); G8_MMA(0, 0, At, B0); G8_BAR; G8_SCHED;
            G8_LDB(B1, 1, 1); G8_STAGE(G8_SB(1, 0), b30, voffB);
            G8_BAR; G8_WAIT_L(0); G8_MMA(0, 1, At, B1); G8_BAR;
            G8_LDA(At, 1, 1); G8_STAGE(G8_SA(1, 0), a3, voffA[0]);
            G8_BAR; G8_WAIT_L(0); G8_MMA(1, 0, At, B0); G8_BAR; G8_SCHED;
            G8_STAGE(G8_SB(1, 1), b31, voffB);
            G8_WAIT_V(6); G8_BAR; G8_MMA(1, 1, At, B1); G8_BAR;
        }
        E(acc, cur, wr, wc, fr, fq, (const LAS int*)(auxb + par_cur * 2048), (const LAS float*)(auxb + par_cur * 2048 + 1024));
        if (!has_next) break;
#pragma unroll
        for (int a = 0; a < 2; ++a)
#pragma unroll
            for (int b = 0; b < 2; ++b)
#pragma unroll
                for (int m = 0; m < 4; ++m)
#pragma unroll
                    for (int n = 0; n < 2; ++n) acc[a][b][m][n] = (f32x4){0.f, 0.f, 0.f, 0.f};
        cur = nxt; cA = nA; cB0 = nB0; cB1 = nB1; ++ui; wsc_cur = cur.wscale; par_cur = par_nxt; par_nxt = par_nxt == 2 ? 0 : par_nxt + 1;
    }
    G8_WAIT_V(0);
    if (wr == 0) G8_BAR;
    G8_BAR;
#undef G8_AUX_ISSUE
#undef G8_AUX_OFFS
#undef G8_SA
#undef G8_SB
#undef G8_STAGE
#undef G8_LDA
#undef G8_LDB
#undef G8_MMA
#undef G8_WAIT_V
#undef G8_WAIT_L
#undef G8_BAR
#undef G8_SCHED
}

template <int K_, int LDA_>
struct DenseSched {
    static constexpr int K = K_, LDA = LDA_, SHIFT = 0, ESZ = 2, FMT_W = 0, FMT_A = 0; static constexpr bool GATHER = false, LDSAUX = false;
    const char* A; const char* Bt; int nM, nN, nwg, G, c;
    __device__ void init(const void* A_, const void* Bt_, int M, int N, int G_, int c_) { A = (const char*)A_; Bt = (const char*)Bt_; nM = M / BM; nN = N / BM; nwg = nM * nN; G = G_; c = c_; }
    __device__ __forceinline__ bool next(int i, Unit& u) const {
        const long L = (long)i * G + c; if (L >= nwg) return false;
        int wgid = (int)L; { const int q = nwg / NXCD, r = nwg % NXCD, xcd = wgid % NXCD, off = wgid / NXCD; wgid = (xcd < r ? xcd * (q + 1) : r * (q + 1) + (xcd - r) * q) + off; }
        constexpr int WGM = 8;
        const int nig = WGM * nN, gid = wgid / nig, fm = gid * WGM, gsz = (nM - fm) < WGM ? (nM - fm) : WGM;
        const int pm = fm + ((wgid % nig) % gsz), pn = (wgid % nig) / gsz;
        u.A = A + (size_t)pm * BM * LDA * 2; u.B0 = Bt + (size_t)pn * BM * K * 2; u.B1 = u.B0 + (size_t)HALF * K * 2;
        u.rows = nullptr; u.bias0 = nullptr; u.bias1 = nullptr; u.wscale = 0x7f7f7f7f; u.nvalid = BM; u.m0 = pm * BM; u.n0 = pn * BM; u.e = 0; return true;
    }
};

template <int NPN  , int SHIFT_, bool GU>
struct MoeSched {
    static constexpr int K = 2048, LDA = 2048, SHIFT = SHIFT_, ESZ = 1, FMT_W = 0  , FMT_A = 0  ; static constexpr bool GATHER = true, LDSAUX = true;
    const char* A; const char* Bt; const int* slot; const float* bias; const LAS int* tstart; const LAS int* cnt; int G, c;
    __device__ __forceinline__ bool next(int i, Unit& u) const {
        const int ntile = tstart[NEXP]; const int nwg = ntile * NPN;
        const long L = (long)i * G + c; if (L >= nwg) return false;
        int wgid = (int)L; { const int q = nwg / NXCD, r = nwg % NXCD, xcd = wgid % NXCD, off = wgid / NXCD; wgid = (xcd < r ? xcd * (q + 1) : r * (q + 1) + (xcd - r) * q) + off; }
        int e = 0;
        for (int s = 16; s > 0; s >>= 1) if (tstart[e + s] * NPN <= wgid) e += s;
        const int mt = tstart[e + 1] - tstart[e], w = wgid - tstart[e] * NPN, pn = w / mt, m = w % mt;
        u.A = A; u.e = e; u.m0 = m * BM; u.n0 = pn; u.wscale = cnt[40 + (GU ? 0 : 32) + e]; u.rows = slot + (size_t)e * NTOK + m * BM;
        const int left = cnt[e] - m * BM; u.nvalid = left < BM ? left : BM;
        if (GU) { u.B0 = Bt + ((size_t)e * 4096 + (size_t)pn * HALF) * K * ESZ; u.B1 = u.B0 + (size_t)2048 * K * ESZ; u.bias0 = bias + (size_t)e * 4096 + pn * HALF; u.bias1 = u.bias0 + 2048; }
        else { u.B0 = Bt + ((size_t)e * 2048 + (size_t)pn * BM) * K * ESZ; u.B1 = u.B0 + (size_t)HALF * K * ESZ; u.bias0 = bias + (size_t)e * 2048 + pn * BM; u.bias1 = u.bias0 + HALF; }
        return true;
    }
};

struct EpiBf16 {
    static constexpr bool PERM = true;
    bf16_t* O; int ldc;
    __device__ __forceinline__ void operator()(const f32x4 (&acc)[2][2][4][2], const Unit& u, int wr, int wc, int fr, int fq, const LAS int* lrows, const LAS float* lbias) const {
        const int row0 = u.m0 + wr * 64 + fr, col0 = u.n0 + wc * 32 + 8 * fq;
#pragma unroll
        for (int ai = 0; ai < 2; ++ai)
#pragma unroll
            for (int m = 0; m < 4; ++m) { bf16_t* rowp = O + (size_t)(row0 + ai * HALF + m * 16) * ldc + col0;
#pragma unroll
                for (int bj = 0; bj < 2; ++bj) { const f32x4 v0 = acc[ai][bj][m][0], v1 = acc[ai][bj][m][1];
                    u32x4 w; w[0] = cvt_pk_bf16(v0[0], v0[1]); w[1] = cvt_pk_bf16(v0[2], v0[3]); w[2] = cvt_pk_bf16(v1[0], v1[1]); w[3] = cvt_pk_bf16(v1[2], v1[3]);
                    *(u32x4*)(rowp + bj * HALF) = w; } }
    }
};
struct EpiProj {
    static constexpr bool PERM = true;
    bf16_t* O; int ldc; bf16_t* OMF; const float* lb;
    __device__ __forceinline__ void operator()(const f32x4 (&acc)[2][2][4][2], const Unit& u, int wr, int wc, int fr, int fq, const LAS int* lrows, const LAS float* lbias) const {
        const int row0 = u.m0 + wr * 64 + fr, col0 = u.n0 + wc * 32 + 8 * fq;
        const int mode = (u.n0 < 1024 || (u.n0 >= 3072 && u.n0 < 4096)) ? 1 : ((u.n0 >= 1024 && u.n0 < 2048) ? 2 : 0);
        f32x4 lbv[2][2];
        if (mode == 2) {
#pragma unroll
            for (int bj = 0; bj < 2; ++bj) { lbv[bj][0] = *(const f32x4*)(lb + col0 - 1024 + bj * HALF); lbv[bj][1] = *(const f32x4*)(lb + col0 - 1024 + bj * HALF + 4); } }
#pragma unroll
        for (int ai = 0; ai < 2; ++ai)
#pragma unroll
            for (int m = 0; m < 4; ++m) { const size_t rowi = (size_t)(row0 + ai * HALF + m * 16); bf16_t* rowp = O + rowi * ldc + col0;
#pragma unroll
                for (int bj = 0; bj < 2; ++bj) { f32x4 v0 = acc[ai][bj][m][0], v1 = acc[ai][bj][m][1];
                    f32x4 o0 = {0.f, 0.f, 0.f, 0.f}, o1 = o0;
                    if (mode != 0) {
                        f32x4 e0 = v0 * (-1.4426950408889634f), e1 = v1 * (-1.4426950408889634f);
#pragma unroll
                        for (int j = 0; j < 4; ++j) { e0[j] = __builtin_amdgcn_exp2f(e0[j]); e1[j] = __builtin_amdgcn_exp2f(e1[j]); }
                        e0 = e0 + 1.f; e1 = e1 + 1.f;
#pragma unroll
                        for (int j = 0; j < 4; ++j) { e0[j] = __builtin_amdgcn_rcpf(e0[j]); e1[j] = __builtin_amdgcn_rcpf(e1[j]); }
                        if (mode == 1) { v0 = v0 * e0; v1 = v1 * e1; }
                        else { const f32x4 f0 = lbv[bj][0] + (1.f - lbv[bj][0]) * e0, f1 = lbv[bj][1] + (1.f - lbv[bj][1]) * e1;
#pragma unroll
                            for (int j = 0; j < 4; ++j) { v0[j] = __builtin_amdgcn_logf(f0[j]); v1[j] = __builtin_amdgcn_logf(f1[j]); }
                            o0 = 1.f - f0; o1 = 1.f - f1; } }
                    if (mode == 2) {
                        u32x4 w2; w2[0] = cvt_pk_bf16(o0[0], o0[1]); w2[1] = cvt_pk_bf16(o0[2], o0[3]); w2[2] = cvt_pk_bf16(o1[0], o1[1]); w2[3] = cvt_pk_bf16(o1[2], o1[3]);
                        *(u32x4*)(OMF + rowi * HG_W + (col0 - 1024) + bj * HALF) = w2; }
                    u32x4 w; w[0] = cvt_pk_bf16(v0[0], v0[1]); w[1] = cvt_pk_bf16(v0[2], v0[3]); w[2] = cvt_pk_bf16(v1[0], v1[1]); w[3] = cvt_pk_bf16(v1[2], v1[3]);
                    *(u32x4*)(rowp + bj * HALF) = w; } }
    }
};
struct EpiResF32 {
    static constexpr bool PERM = false;
    float* C; const float* res; int ldc;
    __device__ __forceinline__ void operator()(const f32x4 (&acc)[2][2][4][2], const Unit& u, int wr, int wc, int fr, int fq, const LAS int* lrows, const LAS float* lbias) const {
        const int row0 = u.m0 + wr * 64 + fr, col0 = u.n0 + wc * 32 + 4 * fq;
#pragma unroll
        for (int ai = 0; ai < 2; ++ai)
#pragma unroll
            for (int m = 0; m < 4; ++m) { const size_t off = (size_t)(row0 + ai * HALF + m * 16) * ldc + col0;
#pragma unroll
                for (int bj = 0; bj < 2; ++bj)
#pragma unroll
                    for (int n = 0; n < 2; ++n) { const f32x4 r = *(const f32x4*)(res + off + bj * HALF + n * 16); *(f32x4*)(C + off + bj * HALF + n * 16) = acc[ai][bj][m][n] + r; } }
    }
};
struct EpiResBf16 {
    static constexpr bool PERM = true;
    bf16_t* C; const float* res; int ldc;
    __device__ __forceinline__ void operator()(const f32x4 (&acc)[2][2][4][2], const Unit& u, int wr, int wc, int fr, int fq, const LAS int*, const LAS float*) const {
        const int row0 = u.m0 + wr * 64 + fr, col0 = u.n0 + wc * 32 + 8 * fq;
#pragma unroll
        for (int ai = 0; ai < 2; ++ai)
#pragma unroll
            for (int m = 0; m < 4; ++m) { const size_t off = (size_t)(row0 + ai * HALF + m * 16) * ldc + col0;
#pragma unroll
                for (int bj = 0; bj < 2; ++bj) { const f32x4 r0 = *(const f32x4*)(res + off + bj * HALF), r1 = *(const f32x4*)(res + off + bj * HALF + 4);
                    const f32x4 v0 = acc[ai][bj][m][0] + r0, v1 = acc[ai][bj][m][1] + r1;
                    u32x4 w; w[0] = cvt_pk_bf16(v0[0], v0[1]); w[1] = cvt_pk_bf16(v0[2], v0[3]); w[2] = cvt_pk_bf16(v1[0], v1[1]); w[3] = cvt_pk_bf16(v1[2], v1[3]);
                    *(u32x4*)(C + off + bj * HALF) = w; } }
    }
};
struct EpiGateUp {
    static constexpr bool PERM = true;
    unsigned char* ACT; const float* bias;
    __device__ __forceinline__ void operator()(const f32x4 (&acc)[2][2][4][2], const Unit& u, int wr, int wc, int fr, int fq, const LAS int* lrows, const LAS float* lbias) const {
        const int colh = u.n0 * HALF + wc * 32 + 8 * fq;
        const LAS float* bp = lbias + wc * 32 + 8 * fq;
        const f32x4 bg0 = *(const LAS f32x4*)bp, bg1 = *(const LAS f32x4*)(bp + 4), bu0 = *(const LAS f32x4*)(bp + 128), bu1 = *(const LAS f32x4*)(bp + 132);
#pragma unroll
        for (int ai = 0; ai < 2; ++ai)
#pragma unroll
            for (int m = 0; m < 4; ++m) { const int r = ai * HALF + wr * 64 + m * 16 + fr;
                if (r < u.nvalid) { const int asg = lrows[r];
                    f32x4 g0 = acc[ai][0][m][0] + bg0, g1 = acc[ai][0][m][1] + bg1, u0 = acc[ai][1][m][0] + bu0, u1 = acc[ai][1][m][1] + bu1;
                    f32x4 e0, e1;
#pragma unroll
                    for (int j = 0; j < 4; ++j) { g0[j] = fminf(g0[j], 7.f); g1[j] = fminf(g1[j], 7.f); u0[j] = __builtin_amdgcn_fmed3f(u0[j], -7.f, 7.f); u1[j] = __builtin_amdgcn_fmed3f(u1[j], -7.f, 7.f); }
                    const f32x4 z0 = g0 * (-1.702f * 1.4426950408889634f), z1 = g1 * (-1.702f * 1.4426950408889634f);
#pragma unroll
                    for (int j = 0; j < 4; ++j) { e0[j] = __builtin_amdgcn_exp2f(z0[j]); e1[j] = __builtin_amdgcn_exp2f(z1[j]); }
                    e0 = e0 + 1.f; e1 = e1 + 1.f;
#pragma unroll
                    for (int j = 0; j < 4; ++j) { e0[j] = __builtin_amdgcn_rcpf(e0[j]); e1[j] = __builtin_amdgcn_rcpf(e1[j]); }
                    const f32x4 o0 = (g0 * e0) * (u0 + 1.f), o1 = (g1 * e1) * (u1 + 1.f);
                    u32x2 w; w[0] = cvt4_fp8(o0[0], o0[1], o0[2], o0[3]); w[1] = cvt4_fp8(o1[0], o1[1], o1[2], o1[3]);
                    *(u32x2*)(ACT + (size_t)asg * DFF + colh) = w; } }
    }
};
struct EpiDown {
    static constexpr bool PERM = true;
    bf16_t* Y; const float* bias;
    __device__ __forceinline__ void operator()(const f32x4 (&acc)[2][2][4][2], const Unit& u, int wr, int wc, int fr, int fq, const LAS int* lrows, const LAS float* lbias) const {
        const int col0 = u.n0 * BM + wc * 32 + 8 * fq;
        const LAS float* bp = lbias + wc * 32 + 8 * fq;
        f32x4 bv[2][2];
#pragma unroll
        for (int bj = 0; bj < 2; ++bj) { bv[bj][0] = *(const LAS f32x4*)(bp + bj * HALF); bv[bj][1] = *(const LAS f32x4*)(bp + bj * HALF + 4); }
#pragma unroll
        for (int ai = 0; ai < 2; ++ai)
#pragma unroll
            for (int m = 0; m < 4; ++m) { const int r = ai * HALF + wr * 64 + m * 16 + fr;
                if (r < u.nvalid) { const int asg = lrows[r]; bf16_t* rowp = Y + (size_t)asg * DM + col0;
#pragma unroll
                    for (int bj = 0; bj < 2; ++bj) { const f32x4 v0 = acc[ai][bj][m][0] + bv[bj][0], v1 = acc[ai][bj][m][1] + bv[bj][1];
                        u32x4 w; w[0] = cvt_pk_bf16(v0[0], v0[1]); w[1] = cvt_pk_bf16(v0[2], v0[3]); w[2] = cvt_pk_bf16(v1[0], v1[1]); w[3] = cvt_pk_bf16(v1[2], v1[3]);
                        *(u32x4*)(rowp + bj * HALF) = w; } } }
    }
};
}

struct Args { const float* in[18]; float* out; unsigned char* ws; int ph_lo, ph_hi; };
enum { I_X = 0, I_N1G, I_WIN, I_LBL, I_HGNG, I_CPOS, I_CW1, I_CW2, I_NSAG, I_WOUT, I_N2G, I_WR, I_BR, I_WGU, I_BGU, I_WD, I_BD, I_FNG };
constexpr int LDS_STAGE = 131072, LDS_BYTES = LDS_STAGE + 16384, LDS_MISC = LDS_BYTES - 4096;

struct Frame {
    LAS unsigned char* lds; unsigned char* ws; unsigned* ctl; int tid, wid, lane, G, bid;
};

__device__ __forceinline__ void conv_tile(const Frame& F, const float* src, int lds_, int k0, int n0, int N, bf16_t* dst, int ldd) {
    LAS float* tile = (LAS float*)F.lds;
#pragma unroll
    for (int p = 0; p < 2; ++p) { const int k = p * 32 + (F.tid >> 4), n = (F.tid & 15) * 4;
        f32x4 v = (f32x4){0.f, 0.f, 0.f, 0.f};
        if (n0 + n < N) v = *(const f32x4*)(src + (size_t)(k0 + k) * lds_ + n0 + n);
        tile[k * 65 + n] = v[0]; tile[k * 65 + n + 1] = v[1]; tile[k * 65 + n + 2] = v[2]; tile[k * 65 + n + 3] = v[3]; }
    __syncthreads();
    { const int n = F.tid >> 3, kc = (F.tid & 7) * 8;
      if (n0 + n < N) { float f[8];
#pragma unroll
          for (int j = 0; j < 8; ++j) f[j] = tile[(kc + j) * 65 + n];
          u32x4 w; w[0] = cvt_pk_bf16(f[0], f[1]); w[1] = cvt_pk_bf16(f[2], f[3]); w[2] = cvt_pk_bf16(f[4], f[5]); w[3] = cvt_pk_bf16(f[6], f[7]);
          *(u32x4*)(dst + (size_t)(n0 + n) * ldd + k0 + kc) = w; } }
    __syncthreads();
}
struct ConvJob { const float* src; unsigned char* dst; int N; };
__device__ __forceinline__ ConvJob conv_job(const Args& a, unsigned char* ws, int st, int& kt, int& ntile) {
    ConvJob j;
    if (st < 8192) { const int e = st >> 8, r = st & 255; kt = r >> 4; ntile = r & 15; j.src = a.in[I_WGU] + (size_t)e * DM * 4096; j.dst = ws + WS_WGUT + (size_t)e * 4096 * DM; j.N = 4096; }
    else { const int q = st - 8192, e = q >> 7, r = q & 127; kt = r >> 3; ntile = r & 7; j.src = a.in[I_WD] + (size_t)e * DFF * DM; j.dst = ws + WS_WDT + (size_t)e * DM * DFF; j.N = 2048; }
    return j;
}
__device__ __forceinline__ void conv_experts(const Frame& F, const Args& a, int first, int stride, int limit) {
    unsigned char* ws = F.ws; LAS unsigned* tile = (LAS unsigned*)F.lds;
    LAS float* mtab = (LAS float*)(F.lds + 32768);
    if (F.tid < 64) mtab[F.tid] = shift_mult(amax_shift(__hip_atomic_load(F.ctl + CW_AMAX + F.tid, __ATOMIC_RELAXED, __HIP_MEMORY_SCOPE_AGENT)));
    __syncthreads();
    const int NST = limit;
    const int lk = F.tid >> 5, lc = F.tid & 31;
    f32x4 v[16];
    int st = first, kt = 0, ntile = 0; ConvJob J{};
#define CV_LOAD() do { _Pragma("unroll") for (int T = 0; T < 2; ++T) _Pragma("unroll") for (int pp = 0; pp < 8; ++pp) \
        v[T * 8 + pp] = __builtin_nontemporal_load((const f32x4*)(J.src + (size_t)(kt * 128 + pp * 16 + lk) * J.N + ntile * 256 + T * 128 + lc * 4)); } while (0)
    if (st < NST) { J = conv_job(a, ws, st, kt, ntile); CV_LOAD(); }
    for (; st < NST; st += stride) {
        const float mlt = mtab[st < 8192 ? (st >> 8) : 32 + ((st - 8192) >> 7)];
#pragma unroll
        for (int T = 0; T < 2; ++T)
#pragma unroll
            for (int pp = 0; pp < 8; ++pp) { const int k = pp * 16 + lk; const f32x4 x = v[T * 8 + pp];
                tile[T * 4096 + k * 32 + (lc ^ (4 * (k >> 4)))] = cvt4_fp8s(x[0], x[1], x[2], x[3], mlt); }
        __syncthreads();
        const ConvJob Jc = J; const int ktc = kt, ntc = ntile;
        const int nx = st + stride;
        if (nx < NST) { J = conv_job(a, ws, nx, kt, ntile); CV_LOAD(); }
        { const int i = F.tid & 7, n4g = (F.tid >> 3) & 31, T = F.tid >> 8;
          unsigned d[16];
#pragma unroll
          for (int jj = 0; jj < 16; ++jj) d[jj] = tile[T * 4096 + (16 * i + jj) * 32 + (n4g ^ (4 * i))];
          u32x4 o[4];
#pragma unroll
          for (int q = 0; q < 4; ++q) {
              const unsigned a0 = __builtin_amdgcn_perm(d[4 * q + 1], d[4 * q], 0x05010400u), a1 = __builtin_amdgcn_perm(d[4 * q + 1], d[4 * q], 0x07030602u);
              const unsigned a2 = __builtin_amdgcn_perm(d[4 * q + 3], d[4 * q + 2], 0x05010400u), a3 = __builtin_amdgcn_perm(d[4 * q + 3], d[4 * q + 2], 0x07030602u);
              o[0][q] = __builtin_amdgcn_perm(a2, a0, 0x05040100u); o[1][q] = __builtin_amdgcn_perm(a2, a0, 0x07060302u);
              o[2][q] = __builtin_amdgcn_perm(a3, a1, 0x05040100u); o[3][q] = __builtin_amdgcn_perm(a3, a1, 0x07060302u); }
          unsigned char* dp = Jc.dst + (size_t)(ntc * 256 + T * 128 + n4g * 4) * DM + ktc * 128 + 16 * i;
#pragma unroll
          for (int r = 0; r < 4; ++r) *(u32x4*)(dp + (size_t)r * DM) = o[r]; }
        __syncthreads();
    }
#undef CV_LOAD
}
__device__ __forceinline__ void conv_matrix4(const Frame& F, const float* src, int K, int N, bf16_t* dst) {
    LAS float* tile = (LAS float*)F.lds;
    const int tn4 = (N + 255) / 256, tk = K / 64, cnt = tn4 * tk;
    for (int t = F.bid; t < cnt; t += F.G) { const int k0 = (t / tn4) * 64, n00 = (t % tn4) * 256;
        f32x4 v[8];
#pragma unroll
        for (int q = 0; q < 4; ++q)
#pragma unroll
            for (int p = 0; p < 2; ++p) { const int k = p * 32 + (F.tid >> 4), n = n00 + q * 64 + (F.tid & 15) * 4;
                v[q * 2 + p] = (n < N) ? *(const f32x4*)(src + (size_t)(k0 + k) * N + n) : (f32x4){0.f, 0.f, 0.f, 0.f}; }
#pragma unroll
        for (int q = 0; q < 4; ++q)
#pragma unroll
            for (int p = 0; p < 2; ++p) { LAS float* tp = tile + q * (64 * 65) + (p * 32 + (F.tid >> 4)) * 65 + (F.tid & 15) * 4; const f32x4 x = v[q * 2 + p]; tp[0] = x[0]; tp[1] = x[1]; tp[2] = x[2]; tp[3] = x[3]; }
        __syncthreads();
        { const int n = F.tid >> 3, kc = (F.tid & 7) * 8;
#pragma unroll
          for (int q = 0; q < 4; ++q) { const int nn = n00 + q * 64 + n;
              if (nn < N) { float f[8];
#pragma unroll
                  for (int j = 0; j < 8; ++j) f[j] = tile[q * (64 * 65) + (kc + j) * 65 + n];
                  u32x4 w; w[0] = cvt_pk_bf16(f[0], f[1]); w[1] = cvt_pk_bf16(f[2], f[3]); w[2] = cvt_pk_bf16(f[4], f[5]); w[3] = cvt_pk_bf16(f[6], f[7]);
                  *(u32x4*)(dst + (size_t)nn * K + k0 + kc) = w; } } }
        __syncthreads(); }
}
__device__ __forceinline__ void conv_matrix(const Frame& F, const float* src, int K, int N, bf16_t* dst, long& base) {
    const int tn = (N + 63) / 64, tk = K / 64; const long cnt = (long)tn * tk;
    long first = ((long)F.bid - base) % F.G; if (first < 0) first += F.G;
    for (long t = first; t < cnt; t += F.G) { const int kt = (int)(t / tn), nt_ = (int)(t % tn); conv_tile(F, src, N, kt * 64, nt_ * 64, N, dst, K); }
    base += cnt;
}
__device__ __forceinline__ void bias1_partials(const Frame& F, const Args& a, int rank, int nranks) {
    LAS float* red = (LAS float*)F.lds;
    const int c = F.tid & 127, kq = F.tid >> 7;
    for (int job = rank; job < 64; job += nranks) { const int j = job >> 5, kg = job & 31;
        const float* pos = a.in[I_CPOS] + (size_t)j * 4096 + kg * 128 + kq * 32; const float* w1 = a.in[I_CW1] + ((size_t)j * 4096 + kg * 128 + kq * 32) * 128 + c;
        float s0 = 0.f, s1 = 0.f, s2 = 0.f, s3 = 0.f;
#pragma unroll
        for (int k = 0; k < 32; k += 4) { s0 += pos[k] * w1[(size_t)k * 128]; s1 += pos[k + 1] * w1[(size_t)(k + 1) * 128]; s2 += pos[k + 2] * w1[(size_t)(k + 2) * 128]; s3 += pos[k + 3] * w1[(size_t)(k + 3) * 128]; }
        red[kq * 128 + c] = (s0 + s1) + (s2 + s3);
        __syncthreads();
        if (F.tid < 128) ((float*)(F.ws + WS_B1P))[((size_t)j * 32 + kg) * 128 + c] = ((red[c] + red[128 + c]) + red[256 + c]) + red[384 + c];
        __syncthreads(); }
}
__device__ __forceinline__ void p0_sample(const Frame& F, const Args& a) {
    const int j = F.bid & 63, q = F.bid >> 6, nq = (F.G + 63 - j) >> 6;
    const float* src; size_t stride; int nalt;
    if (j < 32) { src = a.in[I_WGU] + (size_t)j * DM * 4096; stride = (size_t)DM * 4096 / 64; nalt = 2; }
    else { src = a.in[I_WD] + (size_t)(j - 32) * DFF * DM; stride = (size_t)DFF * DM / 64; nalt = 1; }
    float mx = 0.f;
    for (int c = q; c < 64; c += nq) { const f32x4 v = *(const f32x4*)(src + (size_t)c * stride + (size_t)(c % nalt) * 2048 + F.tid * 4);
        mx = fmaxf(fmaxf(mx, fmaxf(fabsf(v[0]), fabsf(v[1]))), fmaxf(fabsf(v[2]), fabsf(v[3]))); }
    mx = wave_max(mx);
    if (F.lane == 0 && mx > 0.f) atomicMax(F.ctl + CW_AMAX + j, __float_as_uint(mx));
}
__device__ __forceinline__ void p0_prologue(const Frame& F, const Args& a) {
    unsigned char* ws = F.ws;
    long base = 0;
    p0_sample(F, a);
    static_assert(CONV_P0 == 0, "expert tiles need the sampled scales: none may be converted in the prologue");
    conv_matrix4(F, a.in[I_WIN], DM, IN_COLS, (bf16_t*)(ws + WS_WINT));
    conv_matrix(F, a.in[I_WOUT], DM, DM, (bf16_t*)(ws + WS_WOUTT), base);
    for (int j = 0; j < 2; ++j) conv_matrix(F, a.in[I_CW1] + (size_t)j * 4096 * 128, 4096, 128, (bf16_t*)(ws + WS_W1T) + (size_t)j * 128 * 4096, base);
    for (int j = 0; j < 2; ++j) conv_matrix(F, a.in[I_CW2] + (size_t)j * 128 * 128, 128, 128, (bf16_t*)(ws + WS_W2T) + (size_t)j * 128 * 128, base);
    { const float* x = a.in[I_X]; const float* g = a.in[I_N1G]; bf16_t* U = (bf16_t*)(ws + WS_U);
      f32x4 vn[8]; int row = F.bid * 8 + F.wid;
#define P0_LDROW(r_) do { const float* xr_ = x + (size_t)(r_) * DM; _Pragma("unroll") for (int i = 0; i < 4; ++i) { vn[2 * i] = *(const f32x4*)(xr_ + i * 512 + F.lane * 8); vn[2 * i + 1] = *(const f32x4*)(xr_ + i * 512 + F.lane * 8 + 4); } } while (0)
      if (row < NTOK) P0_LDROW(row);
      for (; row < NTOK; row += F.G * 8) {
          f32x4 v[8]; float ss = 0.f;
#pragma unroll
          for (int i = 0; i < 8; ++i) v[i] = vn[i];
          if (row + F.G * 8 < NTOK) P0_LDROW(row + F.G * 8);
#pragma unroll
          for (int i = 0; i < 8; ++i)
#pragma unroll
              for (int j = 0; j < 4; ++j) ss += v[i][j] * v[i][j];
          ss = wave_sum(ss); const float rs = rsqrtf(ss * (1.f / DM) + EPS);
#pragma unroll
          for (int i = 0; i < 4; ++i) { const f32x4 g0 = *(const f32x4*)(g + i * 512 + F.lane * 8), g1 = *(const f32x4*)(g + i * 512 + F.lane * 8 + 4);
              const f32x4 a0 = v[2 * i] * rs * g0, a1 = v[2 * i + 1] * rs * g1;
              u32x4 w; w[0] = cvt_pk_bf16(a0[0], a0[1]); w[1] = cvt_pk_bf16(a0[2], a0[3]); w[2] = cvt_pk_bf16(a1[0], a1[1]); w[3] = cvt_pk_bf16(a1[2], a1[3]);
              *(u32x4*)(U + (size_t)row * DM + i * 512 + F.lane * 8) = w; } }
#undef P0_LDROW
    }
    { const int gw = F.bid * 8 + F.wid;
      (void)gw;
      for (int i = F.bid * NTHREADS + F.tid; i < DM * NEXP; i += F.G * NTHREADS) ((float*)(ws + WS_WR2))[i] = a.in[I_N2G][i >> 5] * a.in[I_WR][i];
      for (int i = F.bid * NTHREADS + F.tid; i < HG_W; i += F.G * NTHREADS) { const float l0 = a.in[I_LBL][i], l1 = a.in[I_LBL][HG_W + i]; const float m = fmaxf(l0, l1);
          const float e0 = __expf(l0 - m), e1 = __expf(l1 - m); ((float*)(ws + WS_LB))[i] = e0 / (e0 + e1); } }
}

__device__ __forceinline__ float gelu_tanh(float x) { const float u = 0.7978845608028654f * (x + 0.044715f * x * x * x); return 0.5f * x * (1.f + tanhf(u)); }
__device__ __forceinline__ void p2_compress_naive(const Frame& F, const Args& a) {
    unsigned char* ws = F.ws; const bf16_t* PROJ = (const bf16_t*)(ws + WS_PROJ);
    LAS float* red = (LAS float*)F.lds;
    LAS float* hdn = red + 512;
    const int c = F.tid & 127, kq = F.tid >> 7;
    for (int u = F.bid; u < 2 * 16 * 128; u += F.G) {
        const int j = u >> 11, bg = (u >> 7) & 15, n = u & 127, b = bg >> 1, g = bg & 1;
        bf16_t* dst = (bf16_t*)(ws + (j ? WS_VC : WS_KC)) + ((size_t)bg * 128 + n) * 128;
        if (n == 127) { if (F.tid < 128) dst[F.tid] = 0; continue; }
        const float* w1 = a.in[I_CW1] + (size_t)j * 4096 * 128; const float* pos = a.in[I_CPOS] + (size_t)j * 4096;
        const int colb = (j ? C_VCM : C_KCM) + g * 128;
        float s = 0.f;
        for (int k = kq * 1024; k < kq * 1024 + 1024; ++k) { const int l = k >> 7, d = k & 127;
            const float av = bf2f(PROJ[(size_t)(b * SEQ + 16 * n + l) * PROJ_LD + colb + d]) + pos[k];
            s += av * w1[(size_t)k * 128 + c]; }
        red[kq * 128 + c] = s; __syncthreads();
        if (F.tid < 128) hdn[c] = gelu_tanh(red[c] + red[128 + c] + red[256 + c] + red[384 + c]);
        __syncthreads();
        if (F.tid < 128) { const float* w2 = a.in[I_CW2] + (size_t)j * 128 * 128; float o = 0.f; for (int k = 0; k < 128; ++k) o += hdn[k] * w2[k * 128 + c]; dst[c] = f2bf(o); }
        __syncthreads();
    }
}

__device__ __forceinline__ void hgrn_naive_unit(const Frame& F, const Args& a, int unit) {
    unsigned char* ws = F.ws; const bf16_t* PROJ = (const bf16_t*)(ws + WS_PROJ); bf16_t* YM = (bf16_t*)(ws + WS_YMIX);
    const float* lbv = (const float*)(ws + WS_LB);
    const int b = unit >> 3, h = unit & 7, v = F.tid & 127, kg = F.tid >> 7;
    LAS float* fs = (LAS float*)F.lds;
    LAS float* qs = fs + 2048; LAS float* is_ = qs + 2048; LAS float* red = is_ + 2048  ; LAS float* ob = red + 512  ;
    float S[32];
#pragma unroll
    for (int i = 0; i < 32; ++i) S[i] = 0.f;
    for (int t0 = 0; t0 < SEQ; t0 += 16) {
        for (int i = F.tid; i < 2048; i += NTHREADS) { const int st = i >> 7, k = i & 127; const size_t rowo = (size_t)(b * SEQ + t0 + st) * PROJ_LD + h * 128 + k;
            const float lb = lbv[h * 128 + k];
            fs[i] = lb + (1.f - lb) * sigmoidf_(bf2f(PROJ[rowo + C_HF])); qs[i] = siluf_(bf2f(PROJ[rowo + C_HQ])); is_[i] = bf2f(PROJ[rowo + C_HI]); }
        __syncthreads();
        for (int st = 0; st < 16; ++st) {
            const float iv = is_[st * 128 + v]; float po = 0.f;
#pragma unroll
            for (int kk = 0; kk < 32; ++kk) { const int k = kg * 32 + kk; const float f = fs[st * 128 + k]; S[kk] = f * S[kk] + (1.f - f) * iv; po += S[kk] * qs[st * 128 + k]; }
            red[kg * 128 + v] = po; __syncthreads();
            if (kg == 0) ob[st * 128 + v] = red[v] + red[128 + v] + red[256 + v] + red[384 + v];
            __syncthreads();
        }
        for (int s2 = 0; s2 < 2; ++s2) { const int st = F.wid * 2 + s2; const float o0 = ob[st * 128 + F.lane], o1 = ob[st * 128 + 64 + F.lane];
            const float ss = wave_sum(o0 * o0 + o1 * o1); const float rs = rsqrtf(ss * (1.f / 128.f) + EPS);
            const size_t row = (size_t)(b * SEQ + t0 + st);
            const float g0 = bf2f(PROJ[row * PROJ_LD + C_HGT + h * 128 + F.lane]), g1 = bf2f(PROJ[row * PROJ_LD + C_HGT + h * 128 + 64 + F.lane]);
            YM[row * DM + h * 128 + F.lane] = f2bf(o0 * rs * a.in[I_HGNG][F.lane] * siluf_(g0));
            YM[row * DM + h * 128 + 64 + F.lane] = f2bf(o1 * rs * a.in[I_HGNG][64 + F.lane] * siluf_(g1)); }
        __syncthreads();
    }
}

__device__ __forceinline__ float dot128_bf(const LAS float* q, const bf16_t* k) {
    float s = 0.f;
#pragma unroll
    for (int c = 0; c < 16; ++c) { const u32x4 w = *(const u32x4*)(k + c * 8); float f[8]; unpack8(w, f);
#pragma unroll
        for (int j = 0; j < 8; ++j) s += q[c * 8 + j] * f[j]; }
    return s;
}
__device__ __forceinline__ void softmax4(const Frame& F, LAS float* sc, int stride, int n, LAS float* tmp  ) {
    const int r = F.tid >> 7, i0 = F.tid & 127;
    float m = -INFINITY; for (int i = i0; i < n; i += 128) m = fmaxf(m, sc[r * stride + i]);
    m = wave_max(m); if (F.lane == 0) tmp[F.wid] = m; __syncthreads();
    m = fmaxf(tmp[2 * r], tmp[2 * r + 1]); __syncthreads();
    float s = 0.f;
    for (int i = i0; i < n; i += 128) { const float x = sc[r * stride + i]; const float p = (x == -INFINITY) ? 0.f : __expf(x - m); sc[r * stride + i] = p; s += p; }
    s = wave_sum(s); if (F.lane == 0) tmp[F.wid] = s; __syncthreads();
    s = tmp[2 * r] + tmp[2 * r + 1]; const float inv = s > 0.f ? 1.f / s : 0.f;
    for (int i = i0; i < n; i += 128) sc[r * stride + i] *= inv;
    __syncthreads();
}
__device__ __forceinline__ void attn_naive_unit(const Frame& F, const Args& a, int unit) {
    unsigned char* ws = F.ws; const bf16_t* PROJ = (const bf16_t*)(ws + WS_PROJ); bf16_t* YM = (bf16_t*)(ws + WS_YMIX);
    const int b = unit >> 12, g = (unit >> 11) & 1, t = unit & 2047, bg = b * 2 + g;
    LAS float* qs = (LAS float*)F.lds;
    LAS float* sc = qs + 512;
    LAS float* tmp = sc + 4096;
    LAS float* imp = tmp + 16;
    LAS int* selk = (LAS int*)(imp + 32);
    LAS float* oacc = (LAS float*)(selk + 32);
    const int r4 = F.tid >> 7, d = F.tid & 127;
    const size_t rowq = (size_t)(b * SEQ + t) * PROJ_LD;
    qs[F.tid] = bf2f(PROJ[rowq + C_NQ + (g * 4 + r4) * 128 + d]);
    const float slope = exp2f(-(float)(g * 4 + r4 + 1));
    const float scale = 0.08838834764831845f;
    float gate[3];
#pragma unroll
    for (int c = 0; c < 3; ++c) gate[c] = sigmoidf_(bf2f(PROJ[rowq + C_NGT + (g * 4 + r4) * 3 + c]));
    __syncthreads();
    { const int n = d; float s = -INFINITY;
      if (n < NCMP) { const int dist = t - (16 * n + 31); if (dist >= 0) s = dot128_bf(qs + r4 * 128, (const bf16_t*)(ws + WS_KC) + ((size_t)bg * 128 + n) * 128) * scale - slope * (float)dist; }
      sc[r4 * 1024 + n] = s; }
    __syncthreads();
    softmax4(F, sc, 1024, 128, tmp);
    { float o = 0.f; const bf16_t* vc = (const bf16_t*)(ws + WS_VC) + (size_t)bg * 128 * 128;
      for (int n = 0; n < NCMP; ++n) o += sc[r4 * 1024 + n] * bf2f(vc[n * 128 + d]);
      oacc[F.tid] = gate[0] * o; }
    if (F.tid < 32) { const int j = F.tid; float s = 0.f;
        for (int r = 0; r < 4; ++r) for (int q = -1; q <= 3; ++q) { const int n = 4 * j + q; if (n >= 0 && n < NCMP) s += ((q == -1 || q == 3) ? 1.f : 2.f) * sc[r * 1024 + n]; }
        const int cur = t >> 6; const bool forced = (j == 0) || (j == cur) || (j == cur - 1);
        imp[j] = forced ? 1e4f : (j <= cur ? s : -1e4f); }
    __syncthreads();
    if (F.tid < 32) { const int j = F.tid; const float me = imp[j]; int rank = 0;
        for (int k = 0; k < 32; ++k) { const float o = imp[k]; rank += (o > me || (o == me && k < j)) ? 1 : 0; }
        const bool sel = rank < SEL_TOP && j <= (t >> 6);
        const unsigned long long mask = __ballot(sel);
        if (sel) selk[__popcll(mask & ((1ull << j) - 1ull))] = j;
        if (j == 0) selk[16] = __popcll(mask); }
    __syncthreads();
    { const int nsel = selk[16];
      for (int i = F.tid; i < 4 * 1024; i += NTHREADS) sc[i] = -INFINITY;
      __syncthreads();
      const int l = F.tid & 63, r = (F.tid >> 6) & 3, which = F.tid >> 8;
      for (int s0 = 0; s0 < nsel; s0 += 2) { const int si = s0 + which;
          if (si < nsel) { const int kp = selk[si] * 64 + l;
              if (kp <= t) { const float s = dot128_bf(qs + r * 128, PROJ + (size_t)(b * SEQ + kp) * PROJ_LD + C_KSL + g * 128) * scale - exp2f(-(float)(g * 4 + r + 1)) * (float)(t - kp); sc[r * 1024 + si * 64 + l] = s; } } }
      __syncthreads();
      softmax4(F, sc, 1024, nsel * 64, tmp);
      float o = 0.f;
      for (int si = 0; si < nsel; ++si) { const int kb = selk[si] * 64;
          for (int l2 = 0; l2 < 64; ++l2) { const int kp = kb + l2; if (kp > t) break; o += sc[r4 * 1024 + si * 64 + l2] * bf2f(PROJ[(size_t)(b * SEQ + kp) * PROJ_LD + C_VSL + g * 128 + d]); } }
      oacc[F.tid] += gate[1] * o; }
    __syncthreads();
    { for (int i = F.tid; i < 4 * 1024; i += NTHREADS) sc[i] = -INFINITY;
      __syncthreads();
      for (int i = F.tid; i < 4 * 512; i += NTHREADS) { const int r = i >> 9, w = i & 511, kp = t - 511 + w;
          if (kp >= 0) sc[r * 1024 + w] = dot128_bf(qs + r * 128, PROJ + (size_t)(b * SEQ + kp) * PROJ_LD + C_KWN + g * 128) * scale - exp2f(-(float)(g * 4 + r + 1)) * (float)(t - kp); }
      __syncthreads();
      softmax4(F, sc, 1024, 512, tmp);
      float o = 0.f;
      for (int w = 0; w < 512; ++w) { const int kp = t - 511 + w; if (kp >= 0) o += sc[r4 * 1024 + w] * bf2f(PROJ[(size_t)(b * SEQ + kp) * PROJ_LD + C_VWN + g * 128 + d]); }
      oacc[F.tid] += gate[2] * o; }
    __syncthreads();
    { const float o = oacc[F.tid]; float ss = wave_sum(o * o); if (F.lane == 0) tmp[F.wid] = ss; __syncthreads();
      ss = tmp[2 * r4] + tmp[2 * r4 + 1]; const float rs = rsqrtf(ss * (1.f / 128.f) + EPS);
      YM[(size_t)(b * SEQ + t) * DM + HG_W + (g * 4 + r4) * 128 + d] = f2bf(o * rs * a.in[I_NSAG][d]); }
    __syncthreads();
}

namespace at {
constexpr int SHM_T = 64 * 128 * 2;
constexpr int BUF_B = 2 * SHM_T;
constexpr int OFF_V = 0, OFF_K = SHM_T, OFF_IMP = 2 * BUF_B  , OFF_SELM = 3 * BUF_B, OFF_WSC = OFF_SELM + 256;
constexpr float SCALE = 0.08838834764831845f, LOG2E = 1.4426950408889634f, THR = 8.f;
#define AT_KSWZ(row, colB) ((row) * 256 + ((colB) ^ (((row) & 7) << 4)))
__device__ __forceinline__ int v_st(int k, int c) { const int kk = (k & ~0xC) | ((k & 4) << 1) | ((k & 8) >> 1); return ((kk >> 3) * 4 + (c >> 5)) * 512 + ((kk & 7) * 32 + (c & 31)) * 2; }
__device__ __forceinline__ int v_rd_base(int lane) { return ((lane & 3) << 3) | (((lane >> 2) & 3) << 6) | (((lane >> 4) & 1) << 5) | (((lane >> 5) & 1) << 8); }
__device__ __forceinline__ int crow(int r, int hi) { return (r & 3) + 8 * (r >> 2) + 4 * hi; }
typedef short s16x4 __attribute__((ext_vector_type(4)));
struct Stage { u32x4 k0, k1, v0, v1; };
__device__ __forceinline__ void stage_load(Stage& S, const bf16_t* Kp, const bf16_t* Vp, int ld, int row0, int sr, int sc) {
    S.k0 = *(const u32x4*)(Kp + (size_t)(row0 + sr) * ld + sc); S.k1 = *(const u32x4*)(Kp + (size_t)(row0 + 32 + sr) * ld + sc);
    S.v0 = *(const u32x4*)(Vp + (size_t)(row0 + sr) * ld + sc); S.v1 = *(const u32x4*)(Vp + (size_t)(row0 + 32 + sr) * ld + sc);
}
__device__ __forceinline__ void stage_write(const Stage& S, LAS unsigned char* lds, int buf, int sr, int sc) {
    const int kws = AT_KSWZ(sr, sc * 2);
    *(LAS u32x4*)(lds + OFF_K + buf * BUF_B + kws) = S.k0; *(LAS u32x4*)(lds + OFF_K + buf * BUF_B + kws + 32 * 256) = S.k1;
    *(LAS u32x4*)(lds + OFF_V + buf * BUF_B + v_st(sr, sc)) = S.v0; *(LAS u32x4*)(lds + OFF_V + buf * BUF_B + v_st(32 + sr, sc)) = S.v1;
}
__device__ __forceinline__ void qkt(f32x16& p0, f32x16& p1, const LAS unsigned char* ktile, int r32, int hi, const bf16x8 (&qr)[8]) {
#pragma unroll
    for (int r = 0; r < 16; ++r) { p0[r] = 0.f; p1[r] = 0.f; }
    const LAS unsigned char* kb[4];
#pragma unroll
    for (int dd = 0; dd < 4; ++dd) kb[dd] = ktile + AT_KSWZ(r32, (dd * 16 + hi * 8) * 2);
#pragma unroll
    for (int d0 = 0; d0 < 8; ++d0) { const LAS unsigned char* a = kb[d0 & 3] + (d0 >> 2) * 128;
        const bf16x8 b0 = *(const LAS bf16x8*)a; const bf16x8 b1 = *(const LAS bf16x8*)(a + 32 * 256);
        p0 = __builtin_amdgcn_mfma_f32_32x32x16_bf16(b0, qr[d0], p0, 0, 0, 0);
        p1 = __builtin_amdgcn_mfma_f32_32x32x16_bf16(b1, qr[d0], p1, 0, 0, 0); }
}
__device__ __forceinline__ void pv_tile(f32x16 (&o)[4], int vb, bf16x8 pa0, bf16x8 pa1, bf16x8 pa2, bf16x8 pa3) {
#define AT_TRRD(dst, off) asm volatile("ds_read_b64_tr_b16 %0, %1 offset:%2" : "=&v"(dst) : "v"(vb), "i"(off) : "memory")
#define AT_PV_D0(d0) do { s16x4 l0, l1, l2, l3, h0, h1, h2, h3; constexpr int b_ = (d0) * 512; \
        AT_TRRD(l0, b_); AT_TRRD(h0, b_ + 2048); AT_TRRD(l1, b_ + 4096); AT_TRRD(h1, b_ + 6144); AT_TRRD(l2, b_ + 8192); AT_TRRD(h2, b_ + 10240); AT_TRRD(l3, b_ + 12288); AT_TRRD(h3, b_ + 14336); \
        asm volatile("s_waitcnt lgkmcnt(0)" ::: "memory"); __builtin_amdgcn_sched_barrier(0); \
        o[d0] = __builtin_amdgcn_mfma_f32_32x32x16_bf16(pa0, (bf16x8){l0[0], l0[1], l0[2], l0[3], h0[0], h0[1], h0[2], h0[3]}, o[d0], 0, 0, 0); \
        o[d0] = __builtin_amdgcn_mfma_f32_32x32x16_bf16(pa1, (bf16x8){l1[0], l1[1], l1[2], l1[3], h1[0], h1[1], h1[2], h1[3]}, o[d0], 0, 0, 0); \
        o[d0] = __builtin_amdgcn_mfma_f32_32x32x16_bf16(pa2, (bf16x8){l2[0], l2[1], l2[2], l2[3], h2[0], h2[1], h2[2], h2[3]}, o[d0], 0, 0, 0); \
        o[d0] = __builtin_amdgcn_mfma_f32_32x32x16_bf16(pa3, (bf16x8){l3[0], l3[1], l3[2], l3[3], h3[0], h3[1], h3[2], h3[3]}, o[d0], 0, 0, 0); } while (0)
    AT_PV_D0(0); AT_PV_D0(1); AT_PV_D0(2); AT_PV_D0(3);
#undef AT_PV_D0
#undef AT_TRRD
}
__device__ __forceinline__ float swap_max(float v) { auto rr = __builtin_amdgcn_permlane32_swap(__float_as_uint(v), __float_as_uint(v), false, false); return fmaxf(__uint_as_float(rr[0]), __uint_as_float(rr[1])); }
__device__ __forceinline__ float swap_sum(float v) { auto rr = __builtin_amdgcn_permlane32_swap(__float_as_uint(v), __float_as_uint(v), false, false); return __uint_as_float(rr[0]) + __uint_as_float(rr[1]); }
__device__ __forceinline__ void pack_p(const f32x16& P, bf16x8& outA, bf16x8& outB) {
#define AT_PK4(B_, OUT) do { unsigned a0 = cvt_pk_bf16(P[B_ + 0], P[B_ + 1]), a1 = cvt_pk_bf16(P[B_ + 2], P[B_ + 3]); \
        unsigned b0 = cvt_pk_bf16(P[B_ + 4], P[B_ + 5]), b1 = cvt_pk_bf16(P[B_ + 6], P[B_ + 7]); \
        auto r0 = __builtin_amdgcn_permlane32_swap(a0, b0, false, false); auto r1 = __builtin_amdgcn_permlane32_swap(a1, b1, false, false); \
        u32x4 w = {r0[0], r1[0], r0[1], r1[1]}; OUT = *reinterpret_cast<bf16x8*>(&w); } while (0)
    AT_PK4(0, outA); AT_PK4(8, outB);
#undef AT_PK4
}
__device__ __forceinline__ float online_sm1(const f32x16& p0, const f32x16& p1, float& m_reg, float& mnL) {
    float pmax = p0[0];
#pragma unroll
    for (int r = 1; r < 16; ++r) pmax = fmaxf(pmax, p0[r]);
#pragma unroll
    for (int r = 0; r < 16; ++r) pmax = fmaxf(pmax, p1[r]);
    pmax = swap_max(pmax);
    float mn, alpha;
    if (__all(pmax - m_reg <= THR)) { mn = m_reg; alpha = 1.f; }
    else { mn = fmaxf(m_reg, pmax); alpha = __builtin_amdgcn_exp2f((m_reg - mn) * LOG2E); m_reg = mn; }
    mnL = -mn * LOG2E;
    return alpha;
}
__device__ __forceinline__ void online_sm2(f32x16& p0, f32x16& p1, float mnL, float alpha, float& l_reg) {
    float ps = 0.f;
#pragma unroll
    for (int r = 0; r < 16; ++r) { p0[r] = __builtin_amdgcn_exp2f(fmaf(p0[r], LOG2E, mnL)); p1[r] = __builtin_amdgcn_exp2f(fmaf(p1[r], LOG2E, mnL)); ps += p0[r] + p1[r]; }
    ps = swap_sum(ps);
    l_reg = l_reg * alpha + ps;
}
template <int MODE>
__device__ __forceinline__ void branch_loop(f32x16 (&o)[4], float& l_out, LAS unsigned char* lds, const bf16_t* Kp, const bf16_t* Vp, int jlo, int qt,
                                            const bf16x8 (&qr)[8], int tq, float slope, unsigned selbits, int r32, int hi, int sr, int sc, LAS float* wsc, int wave_tmin, int grpB) {
    float m_reg = -1e30f, l_reg = 0.f;
#pragma unroll
    for (int d = 0; d < 4; ++d)
#pragma unroll
        for (int r = 0; r < 16; ++r) o[d][r] = 0.f;
    const int vb0 = (int)(uintptr_t)(lds + OFF_V) + v_rd_base(r32 + 32 * hi);
    const int NT = qt - jlo + 1;
#define AT_LGKM0() asm volatile("s_waitcnt lgkmcnt(0)" ::: "memory")
#define AT_BAR() do { AT_LGKM0(); __builtin_amdgcn_s_barrier(); asm volatile("" ::: "memory"); } while (0)
    Stage S0, S1; stage_load(S0, Kp, Vp, PROJ_LD, jlo * 64, sr, sc); stage_write(S0, lds, 0, sr, sc);
    if (NT > 1) { stage_load(S1, Kp, Vp, PROJ_LD, (jlo + 1) * 64, sr, sc); stage_write(S1, lds, 1, sr, sc); }
    if (NT > 2) stage_load(S0, Kp, Vp, PROJ_LD, (jlo + 2) * 64, sr, sc);
    if (NT > 3) stage_load(S1, Kp, Vp, PROJ_LD, (jlo + 3) * 64, sr, sc);
    __syncthreads();
    if (grpB) AT_BAR();
    int buf = 0;
#define AT_STEP(tau, SX) do { \
        const int j = jlo + (tau); \
        f32x16 p0, p1; \
        qkt(p0, p1, lds + OFF_K + buf * BUF_B, r32, hi, qr); \
        const int kbase = j * 64; const int dq = tq - kbase - 4 * hi; \
        const float base_f = slope * (float)(-dq); \
        _Pragma("unroll") for (int r = 0; r < 16; ++r) { const int cc = (r & 3) + 8 * (r >> 2); \
            p0[r] = fmaf(p0[r], SCALE, fmaf(slope, (float)cc, base_f)); p1[r] = fmaf(p1[r], SCALE, fmaf(slope, (float)(cc + 32), base_f)); } \
        if (MODE == 1) { \
            const bool on = (selbits >> j) & 1u; \
            if (j == qt) { \
                _Pragma("unroll") for (int r = 0; r < 16; ++r) { const int cc = (r & 3) + 8 * (r >> 2); if (!on || cc > dq) p0[r] = -INFINITY; if (!on || cc + 32 > dq) p1[r] = -INFINITY; } \
            } else if (!__all(on)) { \
                _Pragma("unroll") for (int r = 0; r < 16; ++r) { if (!on) { p0[r] = -INFINITY; p1[r] = -INFINITY; } } \
            } \
        } else { \
            if (kbase + 63 > wave_tmin || kbase < wave_tmin + 31 - (WINDOW - 1)) { \
                _Pragma("unroll") for (int r = 0; r < 16; ++r) { const int cc = (r & 3) + 8 * (r >> 2); \
                    if ((unsigned)(dq - cc) >= (unsigned)WINDOW) p0[r] = -INFINITY; if ((unsigned)(dq - cc - 32) >= (unsigned)WINDOW) p1[r] = -INFINITY; } \
            } \
        } \
        float mnL; const float alpha = online_sm1(p0, p1, m_reg, mnL); \
        AT_BAR(); \
        if ((tau) + 2 < NT) { int b2 = buf + 2; if (b2 >= 3) b2 -= 3; stage_write(SX, lds, b2, sr, sc); } \
        if ((tau) + 4 < NT) stage_load(SX, Kp, Vp, PROJ_LD, (j + 4) * 64, sr, sc); \
        online_sm2(p0, p1, mnL, alpha, l_reg); \
        bf16x8 pa0, pa1, pa2, pa3; pack_p(p0, pa0, pa1); pack_p(p1, pa2, pa3); \
        if (__any(alpha < 1.f)) { if (hi == 0) wsc[r32] = alpha; \
            _Pragma("unroll") for (int r = 0; r < 16; ++r) { const float al = wsc[crow(r, hi)]; \
                _Pragma("unroll") for (int d = 0; d < 4; ++d) o[d][r] *= al; } } \
        pv_tile(o, vb0 + buf * BUF_B, pa0, pa1, pa2, pa3); \
        AT_BAR(); \
        buf = buf + 1; if (buf >= 3) buf = 0; } while (0)
    for (int tau = 0; tau < NT; tau += 2) {
        AT_STEP(tau, S0);
        if (tau + 1 < NT) AT_STEP(tau + 1, S1);
    }
#undef AT_STEP
    if (!grpB) AT_BAR();
#undef AT_BAR
#undef AT_LGKM0
    l_out = l_reg;
    __syncthreads();
}
}

__device__ __forceinline__ void attn_fast_unit(const Frame& F, const Args& a, int unit) {
    using namespace at;
    unsigned char* ws = F.ws; const bf16_t* PROJ = (const bf16_t*)(ws + WS_PROJ); bf16_t* YM = (bf16_t*)(ws + WS_YMIX);
    LAS unsigned char* lds = F.lds;
    const int qt = 31 - (unit >> 4), bg = unit & 15, b = bg >> 1, g = bg & 1;
    int tz = threadIdx.x; asm volatile("" : "+v"(tz));
    const int lane = tz & 63, r32 = lane & 31, hi = lane >> 5, head = F.wid & 3, qh = F.wid >> 2;
    const int t0 = qt * 64, tq = t0 + qh * 32 + r32, wave_tmin = t0 + qh * 32;
    const int sr = tz >> 4, sc = (tz & 15) * 8;
    const float slope = exp2f(-(float)(g * 4 + head + 1));
    LAS float* wsc = (LAS float*)(lds + OFF_WSC) + F.wid * 256;
    LAS float* imph = (LAS float*)(lds + OFF_IMP);
    LAS unsigned* selm = (LAS unsigned*)(lds + OFF_SELM);
    bf16x8 qr[8];
    { const bf16_t* qp = PROJ + (size_t)(b * SEQ + tq) * PROJ_LD + C_NQ + (g * 4 + head) * 128 + hi * 8;
#pragma unroll
      for (int d0 = 0; d0 < 8; ++d0) qr[d0] = *(const bf16x8*)(qp + d0 * 16); }
    float gate[3];
    { const bf16_t* gp = PROJ + (size_t)(b * SEQ + tq) * PROJ_LD + C_NGT + (g * 4 + head) * 3;
#pragma unroll
      for (int c = 0; c < 3; ++c) gate[c] = sigmoidf_(bf2f(gp[c])); }
    f32x16 o[4];
    float* otp = (float*)(ws + WS_OT) + ((size_t)F.bid * 512 + tz) * 64;
    { const bf16_t* Kc = (const bf16_t*)(ws + WS_KC) + (size_t)bg * 128 * 128; const bf16_t* Vc = (const bf16_t*)(ws + WS_VC) + (size_t)bg * 128 * 128;
      Stage S; stage_load(S, Kc, Vc, 128, 0, sr, sc); stage_write(S, lds, 0, sr, sc);
      stage_load(S, Kc, Vc, 128, 64, sr, sc); stage_write(S, lds, 1, sr, sc);
      __syncthreads();
      f32x16 p0, p1, p2, p3;
      qkt(p0, p1, lds + OFF_K, r32, hi, qr); qkt(p2, p3, lds + OFF_K + BUF_B, r32, hi, qr);
      const int dl0 = ((tq - 31) >> 4) - 4 * hi;
      const float base_f = slope * (float)(16 * 4 * hi + 31 - tq);
      float mx = -INFINITY;
#pragma unroll
      for (int r = 0; r < 16; ++r) { const int cc = (r & 3) + 8 * (r >> 2);
          p0[r] = (cc <= dl0)      ? fmaf(p0[r], SCALE, fmaf(slope, (float)(16 * cc), base_f))        : -INFINITY;
          p1[r] = (cc + 32 <= dl0) ? fmaf(p1[r], SCALE, fmaf(slope, (float)(16 * (cc + 32)), base_f)) : -INFINITY;
          p2[r] = (cc + 64 <= dl0) ? fmaf(p2[r], SCALE, fmaf(slope, (float)(16 * (cc + 64)), base_f)) : -INFINITY;
          p3[r] = (cc + 96 <= dl0) ? fmaf(p3[r], SCALE, fmaf(slope, (float)(16 * (cc + 96)), base_f)) : -INFINITY;
          mx = fmaxf(fmaxf(mx, p0[r]), fmaxf(p1[r], fmaxf(p2[r], p3[r]))); }
      mx = swap_max(mx);
      const float mL = (mx == -INFINITY) ? 0.f : -mx * LOG2E;
      float ps = 0.f;
#pragma unroll
      for (int r = 0; r < 16; ++r) { p0[r] = __builtin_amdgcn_exp2f(fmaf(p0[r], LOG2E, mL)); p1[r] = __builtin_amdgcn_exp2f(fmaf(p1[r], LOG2E, mL));
          p2[r] = __builtin_amdgcn_exp2f(fmaf(p2[r], LOG2E, mL)); p3[r] = __builtin_amdgcn_exp2f(fmaf(p3[r], LOG2E, mL)); ps += (p0[r] + p1[r]) + (p2[r] + p3[r]); }
      ps = swap_sum(ps);
      const float inv = ps > 0.f ? 1.f / ps : 0.f;
#pragma unroll
      for (int r = 0; r < 16; ++r) { p0[r] *= inv; p1[r] *= inv; p2[r] *= inv; p3[r] *= inv; }
      { LAS float* dst = imph + ((size_t)head * 64 + qh * 32 + r32) * 32;
        float prev = 0.f;
#define AT_GRP(P, blk) do { _Pragma("unroll") for (int i = 0; i < 4; ++i) { const float av = 2.f * (P[4 * i] + P[4 * i + 1] + P[4 * i + 2]) + P[4 * i + 3]; const float bv = P[4 * i + 3]; \
            auto rr = __builtin_amdgcn_permlane32_swap(__float_as_uint(bv), __float_as_uint(bv), false, false); const float pb = __uint_as_float(hi ? rr[0] : rr[1]); \
            dst[2 * ((blk) * 4 + i) + hi] = av + (hi ? pb : prev); prev = pb; } } while (0)
        AT_GRP(p0, 0); AT_GRP(p1, 1); AT_GRP(p2, 2); AT_GRP(p3, 3);
#undef AT_GRP
      }
      bf16x8 pa0, pa1, pa2, pa3;
#pragma unroll
      for (int d = 0; d < 4; ++d)
#pragma unroll
          for (int r = 0; r < 16; ++r) o[d][r] = 0.f;
      const int vb0 = (int)(uintptr_t)(lds + OFF_V) + v_rd_base(lane);
      pack_p(p0, pa0, pa1); pack_p(p1, pa2, pa3); pv_tile(o, vb0, pa0, pa1, pa2, pa3);
      pack_p(p2, pa0, pa1); pack_p(p3, pa2, pa3); pv_tile(o, vb0 + BUF_B, pa0, pa1, pa2, pa3);
      if (hi == 0) wsc[r32] = gate[0];
#pragma unroll
      for (int r = 0; r < 16; ++r) { const float f = wsc[crow(r, hi)];
#pragma unroll
          for (int d = 0; d < 4; ++d) o[d][r] *= f; }
#pragma unroll
      for (int d = 0; d < 4; ++d)
#pragma unroll
          for (int k = 0; k < 4; ++k) *(f32x4*)(otp + d * 16 + 4 * k) = (f32x4){o[d][4 * k], o[d][4 * k + 1], o[d][4 * k + 2], o[d][4 * k + 3]};
    }
    __syncthreads();
    { const int q = tz >> 3, part = tz & 7, tqq = t0 + q, cur = tqq >> 6;
      unsigned bits = 0u;
      if (cur < SEL_TOP) { bits = (part == 0) ? ((2u << cur) - 1u) : 0u; }
      else {
          float sc_[4];
#pragma unroll
          for (int k = 0; k < 4; ++k) { const int j = part * 4 + k; const float v = ((imph[(0 * 64 + q) * 32 + j] + imph[(1 * 64 + q) * 32 + j]) + imph[(2 * 64 + q) * 32 + j]) + imph[(3 * 64 + q) * 32 + j];
              const bool forced = (j == 0) || (j == cur) || (j == cur - 1); sc_[k] = forced ? 1e4f : (j <= cur ? v : -1e4f); }
          int rank[4] = {0, 0, 0, 0};
          for (int jj = 0; jj < 32; ++jj) { const float v = ((imph[(0 * 64 + q) * 32 + jj] + imph[(1 * 64 + q) * 32 + jj]) + imph[(2 * 64 + q) * 32 + jj]) + imph[(3 * 64 + q) * 32 + jj];
              const bool forced = (jj == 0) || (jj == cur) || (jj == cur - 1); const float s2 = forced ? 1e4f : (jj <= cur ? v : -1e4f);
#pragma unroll
              for (int k = 0; k < 4; ++k) { const int j = part * 4 + k; rank[k] += (s2 > sc_[k] || (s2 == sc_[k] && jj < j)) ? 1 : 0; } }
#pragma unroll
          for (int k = 0; k < 4; ++k) { const int j = part * 4 + k; if (rank[k] < SEL_TOP && j <= cur) bits |= 1u << j; }
      }
      bits |= __shfl_xor(bits, 1); bits |= __shfl_xor(bits, 2); bits |= __shfl_xor(bits, 4);
      if (part == 0) selm[q] = bits; }
    __syncthreads();
    const unsigned selbits = selm[qh * 32 + r32];
    { float l_sel;
      branch_loop<1>(o, l_sel, lds, PROJ + (size_t)(b * SEQ) * PROJ_LD + C_KSL + g * 128, PROJ + (size_t)(b * SEQ) * PROJ_LD + C_VSL + g * 128, 0, qt, qr, tq, slope, selbits, r32, hi, sr, sc, wsc, wave_tmin, qh);
      if (hi == 0) wsc[r32] = gate[1] / l_sel;
#pragma unroll
      for (int r = 0; r < 16; ++r) { const float f = wsc[crow(r, hi)];
#pragma unroll
          for (int d = 0; d < 4; ++d) o[d][r] *= f; }
#pragma unroll
      for (int d = 0; d < 4; ++d)
#pragma unroll
          for (int k = 0; k < 4; ++k) { const f32x4 pv = *(const f32x4*)(otp + d * 16 + 4 * k); *(f32x4*)(otp + d * 16 + 4 * k) = pv + (f32x4){o[d][4 * k], o[d][4 * k + 1], o[d][4 * k + 2], o[d][4 * k + 3]}; } }
    { float l_win; const int jlo = (t0 - (WINDOW - 1)) > 0 ? (t0 - (WINDOW - 1)) >> 6 : 0;
      branch_loop<2>(o, l_win, lds, PROJ + (size_t)(b * SEQ) * PROJ_LD + C_KWN + g * 128, PROJ + (size_t)(b * SEQ) * PROJ_LD + C_VWN + g * 128, jlo, qt, qr, tq, slope, 0u, r32, hi, sr, sc, wsc, wave_tmin, qh);
      if (hi == 0) wsc[r32] = gate[2] / l_win;
#pragma unroll
      for (int r = 0; r < 16; ++r) { const float f = wsc[crow(r, hi)];
#pragma unroll
          for (int d = 0; d < 4; ++d) o[d][r] *= f; }
#pragma unroll
      for (int d = 0; d < 4; ++d)
#pragma unroll
          for (int k = 0; k < 4; ++k) { const f32x4 pv = *(const f32x4*)(otp + d * 16 + 4 * k); o[d][4 * k] += pv[0]; o[d][4 * k + 1] += pv[1]; o[d][4 * k + 2] += pv[2]; o[d][4 * k + 3] += pv[3]; } }
    { const float* ng = a.in[I_NSAG];
      float gsc[4];
#pragma unroll
      for (int d = 0; d < 4; ++d) gsc[d] = ng[d * 32 + r32];
#pragma unroll
      for (int r = 0; r < 16; ++r) { float ss = 0.f;
#pragma unroll
          for (int d = 0; d < 4; ++d) ss += o[d][r] * o[d][r];
          ss += __shfl_xor(ss, 1); ss += __shfl_xor(ss, 2); ss += __shfl_xor(ss, 4); ss += __shfl_xor(ss, 8); ss += __shfl_xor(ss, 16);
          const float rs = rsqrtf(ss * (1.f / 128.f) + EPS);
          const int row = b * SEQ + t0 + qh * 32 + crow(r, hi);
          bf16_t* yp = YM + (size_t)row * DM + HG_W + (g * 4 + head) * 128 + r32;
#pragma unroll
          for (int d = 0; d < 4; ++d) yp[d * 32] = f2bf(o[d][r] * rs * gsc[d]); } }
    __syncthreads();
}

namespace hg {
constexpr int T_KD = 0, T_QD = 16384, T_V = 32768, T_KL = 49152, T_FR = 65536, T_QR = 81920, T_OR = 98304, T_PART = 114688, T_DL = T_PART + 2048, T_SSQ = T_DL + 512;
}
__device__ __forceinline__ void hgrn_fast_unit(const Frame& F, const Args& a, int unit) {
    using namespace hg; using at::crow; using at::v_st; using at::v_rd_base; typedef at::s16x4 s16x4;
    unsigned char* ws = F.ws; const bf16_t* PROJ = (const bf16_t*)(ws + WS_PROJ); bf16_t* YM = (bf16_t*)(ws + WS_YMIX);
    LAS unsigned char* lds = F.lds;
    const int b = unit >> 3, h = unit & 7;
    int tz = threadIdx.x; asm volatile("" : "+v"(tz));
    const int lane = tz & 63, r32 = lane & 31, hi = lane >> 5, th = F.wid & 1, vq = F.wid >> 1;
    const int lr = tz >> 4, lc = (tz & 15) * 8;
    const int kc = tz & 127, tg = tz >> 7;
    LAS float* part = (LAS float*)(lds + T_PART); LAS float* dl = (LAS float*)(lds + T_DL); LAS float* ssq = (LAS float*)(lds + T_SSQ);
    f32x16 Sacc[4];
#pragma unroll
    for (int k = 0; k < 4; ++k)
#pragma unroll
        for (int r = 0; r < 16; ++r) Sacc[k][r] = 0.f;
    const bf16_t* base = PROJ + (size_t)(b * SEQ) * PROJ_LD + h * 128;
    u32x4 rf0, rf1, rq0, rq1, ri0, ri1, ro0, ro1;
    const bf16_t* obase = (const bf16_t*)(ws + WS_OMF) + (size_t)(b * SEQ) * HG_W + h * 128;
#define HG_LOAD(t0_) do { const bf16_t* p0_ = base + (size_t)((t0_) + lr) * PROJ_LD + lc; const bf16_t* p1_ = p0_ + (size_t)32 * PROJ_LD; \
        rf0 = *(const u32x4*)(p0_ + C_HF); rf1 = *(const u32x4*)(p1_ + C_HF); rq0 = *(const u32x4*)(p0_ + C_HQ); rq1 = *(const u32x4*)(p1_ + C_HQ); \
        ri0 = *(const u32x4*)(p0_ + C_HI); ri1 = *(const u32x4*)(p1_ + C_HI); \
        ro0 = *(const u32x4*)(obase + (size_t)((t0_) + lr) * HG_W + lc); ro1 = *(const u32x4*)(obase + (size_t)((t0_) + lr + 32) * HG_W + lc); } while (0)
    HG_LOAD(0);
    const float ngv = a.in[I_HGNG][vq * 32 + r32];
    for (int c = 0; c < SEQ / 64; ++c) {
        const int t0 = c * 64;
        *(LAS u32x4*)(lds + T_FR + lr * 256 + lc * 2) = rf0; *(LAS u32x4*)(lds + T_FR + (lr + 32) * 256 + lc * 2) = rf1;
        *(LAS u32x4*)(lds + T_QR + lr * 256 + lc * 2) = rq0; *(LAS u32x4*)(lds + T_QR + (lr + 32) * 256 + lc * 2) = rq1;
        *(LAS u32x4*)(lds + T_OR + lr * 256 + lc * 2) = ro0; *(LAS u32x4*)(lds + T_OR + (lr + 32) * 256 + lc * 2) = ro1;
        *(LAS u32x4*)(lds + T_V + v_st(lr, lc)) = ri0; *(LAS u32x4*)(lds + T_V + v_st(lr + 32, lc)) = ri1;
        __syncthreads();
        float lf[16]; float run = 0.f;
#pragma unroll
        for (int i = 0; i < 16; ++i) { const int t = tg * 16 + i; run += bf2f(*(const LAS bf16_t*)(lds + T_FR + t * 256 + kc * 2)); lf[i] = run; }
        part[tg * 128 + kc] = run;
        __syncthreads();
        { const float p0_ = part[kc], p1_ = part[128 + kc], p2_ = part[256 + kc], p3_ = part[384 + kc];
          const float pre = (tg > 0 ? p0_ : 0.f) + (tg > 1 ? p1_ : 0.f) + (tg > 2 ? p2_ : 0.f); const float tot = ((p0_ + p1_) + p2_) + p3_;
          const float dlast = __builtin_amdgcn_exp2f(tot);
          if (tg == 0) dl[kc] = dlast;
#pragma unroll
          for (int i = 0; i < 16; ++i) { const int t = tg * 16 + i; const float bb = pre + lf[i];
              const float qv = bf2f(*(const LAS bf16_t*)(lds + T_QR + t * 256 + kc * 2)), om = bf2f(*(const LAS bf16_t*)(lds + T_OR + t * 256 + kc * 2));
              const float qd = qv * __builtin_amdgcn_exp2f(bb), kd = om * __builtin_amdgcn_exp2f(-bb), kl = kd * dlast;
              const int ko = AT_KSWZ(t, kc * 2);
              *(LAS bf16_t*)(lds + T_QD + ko) = f2bf(qd); *(LAS bf16_t*)(lds + T_KD + ko) = f2bf(kd); *(LAS bf16_t*)(lds + T_KL + v_st(t, kc)) = f2bf(kl); } }
        __syncthreads();
        if (c + 1 < SEQ / 64) HG_LOAD(t0 + 64);
        const int tl = th * 32 + r32;
        bf16x8 qr[8];
#pragma unroll
        for (int d0 = 0; d0 < 8; ++d0) qr[d0] = *(const LAS bf16x8*)(lds + T_QD + AT_KSWZ(tl, (d0 * 16 + hi * 8) * 2));
        f32x16 p0, p1;
        at::qkt(p0, p1, lds + T_KD, r32, hi, qr);
#pragma unroll
        for (int r = 0; r < 16; ++r) { const int s = crow(r, hi); if (s > tl) p0[r] = 0.f; if (s + 32 > tl) p1[r] = 0.f; }
        bf16x8 pa0, pa1, pa2, pa3; at::pack_p(p0, pa0, pa1); at::pack_p(p1, pa2, pa3);
        f32x16 o;
#pragma unroll
        for (int r = 0; r < 16; ++r) o[r] = 0.f;
        const int vb = (int)(uintptr_t)(lds + T_V) + v_rd_base(lane) + vq * 512;
        const int klb = (int)(uintptr_t)(lds + T_KL) + v_rd_base(lane);
#define HG_TRRD(dst, addr, off) asm volatile("ds_read_b64_tr_b16 %0, %1 offset:%2" : "=&v"(dst) : "v"(addr), "i"(off) : "memory")
        s16x4 vl0, vh0, vl1, vh1, vl2, vh2, vl3, vh3;
        HG_TRRD(vl0, vb, 0); HG_TRRD(vh0, vb, 2048); HG_TRRD(vl1, vb, 4096); HG_TRRD(vh1, vb, 6144); HG_TRRD(vl2, vb, 8192); HG_TRRD(vh2, vb, 10240); HG_TRRD(vl3, vb, 12288); HG_TRRD(vh3, vb, 14336);
        asm volatile("s_waitcnt lgkmcnt(0)" ::: "memory"); __builtin_amdgcn_sched_barrier(0);
        const bf16x8 vf0 = (bf16x8){vl0[0], vl0[1], vl0[2], vl0[3], vh0[0], vh0[1], vh0[2], vh0[3]}, vf1 = (bf16x8){vl1[0], vl1[1], vl1[2], vl1[3], vh1[0], vh1[1], vh1[2], vh1[3]};
        const bf16x8 vf2 = (bf16x8){vl2[0], vl2[1], vl2[2], vl2[3], vh2[0], vh2[1], vh2[2], vh2[3]}, vf3 = (bf16x8){vl3[0], vl3[1], vl3[2], vl3[3], vh3[0], vh3[1], vh3[2], vh3[3]};
        o = __builtin_amdgcn_mfma_f32_32x32x16_bf16(pa0, vf0, o, 0, 0, 0); o = __builtin_amdgcn_mfma_f32_32x32x16_bf16(pa1, vf1, o, 0, 0, 0);
        o = __builtin_amdgcn_mfma_f32_32x32x16_bf16(pa2, vf2, o, 0, 0, 0); o = __builtin_amdgcn_mfma_f32_32x32x16_bf16(pa3, vf3, o, 0, 0, 0);
#pragma unroll
        for (int kb = 0; kb < 4; ++kb)
#pragma unroll
            for (int sp = 0; sp < 2; ++sp) {
                const u32x2 a_lo = *(const LAS u32x2*)(lds + T_QD + tl * 256 + ((((4 * kb + 2 * sp) * 16)) ^ ((tl & 7) << 4)) + 8 * hi);
                const u32x2 a_hi = *(const LAS u32x2*)(lds + T_QD + tl * 256 + ((((4 * kb + 2 * sp + 1) * 16)) ^ ((tl & 7) << 4)) + 8 * hi);
                u32x4 aw = {a_lo[0], a_lo[1], a_hi[0], a_hi[1]};
                u32x4 bw = {cvt_pk_bf16(Sacc[kb][8 * sp + 0], Sacc[kb][8 * sp + 1]), cvt_pk_bf16(Sacc[kb][8 * sp + 2], Sacc[kb][8 * sp + 3]),
                            cvt_pk_bf16(Sacc[kb][8 * sp + 4], Sacc[kb][8 * sp + 5]), cvt_pk_bf16(Sacc[kb][8 * sp + 6], Sacc[kb][8 * sp + 7])};
                o = __builtin_amdgcn_mfma_f32_32x32x16_bf16(*reinterpret_cast<bf16x8*>(&aw), *reinterpret_cast<bf16x8*>(&bw), o, 0, 0, 0); }
        float gt[16];
#pragma unroll
        for (int r = 0; r < 16; ++r) gt[r] = bf2f(base[(size_t)(t0 + th * 32 + crow(r, hi)) * PROJ_LD + C_HGT + vq * 32 + r32]);
#define HG_SUPD(kb) do { \
            _Pragma("unroll") for (int i4 = 0; i4 < 4; ++i4) { const f32x4 dv = *(const LAS f32x4*)(dl + (kb) * 32 + 8 * i4 + 4 * hi); \
                Sacc[kb][4 * i4] *= dv[0]; Sacc[kb][4 * i4 + 1] *= dv[1]; Sacc[kb][4 * i4 + 2] *= dv[2]; Sacc[kb][4 * i4 + 3] *= dv[3]; } \
            s16x4 al0, ah0, al1, ah1, al2, ah2, al3, ah3; \
            HG_TRRD(al0, klb, (kb) * 512); HG_TRRD(ah0, klb, (kb) * 512 + 2048); HG_TRRD(al1, klb, (kb) * 512 + 4096); HG_TRRD(ah1, klb, (kb) * 512 + 6144); \
            HG_TRRD(al2, klb, (kb) * 512 + 8192); HG_TRRD(ah2, klb, (kb) * 512 + 10240); HG_TRRD(al3, klb, (kb) * 512 + 12288); HG_TRRD(ah3, klb, (kb) * 512 + 14336); \
            asm volatile("s_waitcnt lgkmcnt(0)" ::: "memory"); __builtin_amdgcn_sched_barrier(0); \
            Sacc[kb] = __builtin_amdgcn_mfma_f32_32x32x16_bf16((bf16x8){al0[0], al0[1], al0[2], al0[3], ah0[0], ah0[1], ah0[2], ah0[3]}, vf0, Sacc[kb], 0, 0, 0); \
            Sacc[kb] = __builtin_amdgcn_mfma_f32_32x32x16_bf16((bf16x8){al1[0], al1[1], al1[2], al1[3], ah1[0], ah1[1], ah1[2], ah1[3]}, vf1, Sacc[kb], 0, 0, 0); \
            Sacc[kb] = __builtin_amdgcn_mfma_f32_32x32x16_bf16((bf16x8){al2[0], al2[1], al2[2], al2[3], ah2[0], ah2[1], ah2[2], ah2[3]}, vf2, Sacc[kb], 0, 0, 0); \
            Sacc[kb] = __builtin_amdgcn_mfma_f32_32x32x16_bf16((bf16x8){al3[0], al3[1], al3[2], al3[3], ah3[0], ah3[1], ah3[2], ah3[3]}, vf3, Sacc[kb], 0, 0, 0); } while (0)
        HG_SUPD(0); HG_SUPD(1); HG_SUPD(2); HG_SUPD(3);
#undef HG_SUPD
#undef HG_TRRD
        { float y8[8], y4[4], y2[2], y1;
          const bool b4 = (r32 & 16) != 0, b3 = (r32 & 8) != 0, b2 = (r32 & 4) != 0, b1 = (r32 & 2) != 0;
#pragma unroll
          for (int i = 0; i < 8; ++i) { const float lo = o[i] * o[i], hi_ = o[8 + i] * o[8 + i]; const float keep = b4 ? hi_ : lo, send = b4 ? lo : hi_; y8[i] = keep + __shfl_xor(send, 16); }
#pragma unroll
          for (int i = 0; i < 4; ++i) { const float keep = b3 ? y8[4 + i] : y8[i], send = b3 ? y8[i] : y8[4 + i]; y4[i] = keep + __shfl_xor(send, 8); }
#pragma unroll
          for (int i = 0; i < 2; ++i) { const float keep = b2 ? y4[2 + i] : y4[i], send = b2 ? y4[i] : y4[2 + i]; y2[i] = keep + __shfl_xor(send, 4); }
          { const float keep = b1 ? y2[1] : y2[0], send = b1 ? y2[0] : y2[1]; y1 = keep + __shfl_xor(send, 2); }
          y1 += __shfl_xor(y1, 1);
          const int rf = ((r32 >> 1) & 15);
          if ((r32 & 1) == 0) ssq[vq * 64 + th * 32 + crow(rf, hi)] = y1; }
        __syncthreads();
        { bf16_t* yb = YM + (size_t)(b * SEQ + t0 + th * 32) * DM + h * 128 + vq * 32;
          const unsigned loff = (unsigned)(4 * hi) * DM + (unsigned)r32;
#pragma unroll
          for (int r = 0; r < 16; ++r) { const int tc = (r & 3) + 8 * (r >> 2); const int t = th * 32 + tc + 4 * hi; const float ss = ((ssq[t] + ssq[64 + t]) + ssq[128 + t]) + ssq[192 + t];
              const float rs = rsqrtf(ss * (1.f / 128.f) + EPS);
              (yb + (size_t)tc * DM)[loff] = f2bf(o[r] * rs * ngv * gt[r]); } }
    }
#undef HG_LOAD
    __syncthreads();
}

__device__ __forceinline__ void compress_fast_unit(const Frame& F, const Args& a, int u) {
    unsigned char* ws = F.ws; const bf16_t* PROJ = (const bf16_t*)(ws + WS_PROJ); LAS unsigned char* lds = F.lds;
    const int j = u >> 6, bg = (u >> 2) & 15, mt = u & 3, b = bg >> 1, g = bg & 1;
    int tz = threadIdx.x; asm volatile("" : "+v"(tz));
    const int lane = tz & 63, r32 = lane & 31, hi = lane >> 5, w = F.wid;
    const int n = mt * 32 + r32, nl = n < 126 ? n : 126;
    const bf16_t* W1T = (const bf16_t*)(ws + WS_W1T) + (size_t)j * 128 * 4096; const bf16_t* W2T = (const bf16_t*)(ws + WS_W2T) + (size_t)j * 128 * 128;
    const int colb = (j ? C_VCM : C_KCM) + g * 128;
    const bf16_t* arow = PROJ + (size_t)(b * SEQ + 16 * nl) * PROJ_LD + colb + hi * 8;
    const bf16_t* brow = W1T + (size_t)r32 * 4096 + w * 512 + hi * 8;
    f32x16 acc[4];
#pragma unroll
    for (int c = 0; c < 4; ++c)
#pragma unroll
        for (int r = 0; r < 16; ++r) acc[c][r] = 0.f;
#pragma unroll 4
    for (int ks = 0; ks < 32; ++ks) {
        const int l = 4 * w + (ks >> 3), d = (ks & 7) * 16;
        const bf16x8 af = *(const bf16x8*)(arow + (size_t)l * PROJ_LD + d);
#pragma unroll
        for (int c = 0; c < 4; ++c) { const bf16x8 bfr = *(const bf16x8*)(brow + (size_t)c * 32 * 4096 + ks * 16);
            acc[c] = __builtin_amdgcn_mfma_f32_32x32x16_bf16(af, bfr, acc[c], 0, 0, 0); }
    }
    LAS float* red = (LAS float*)lds;
#pragma unroll
    for (int c = 0; c < 4; ++c)
#pragma unroll
        for (int r = 0; r < 16; ++r) red[(w * 32 + at::crow(r, hi)) * 128 + c * 32 + r32] = acc[c][r];
    __syncthreads();
    LAS unsigned char* hdn = lds + 131072 - 8192;
    { const int nn = tz >> 4, c8 = (tz & 15) * 8; float sv[8];
      const float* b1 = (const float*)(ws + WS_B1P) + (size_t)j * 32 * 128 + c8;
#pragma unroll
      for (int i = 0; i < 8; ++i) sv[i] = 0.f;
#pragma unroll 4
      for (int kg = 0; kg < 32; ++kg) { const f32x4 x0 = *(const f32x4*)(b1 + kg * 128), x1 = *(const f32x4*)(b1 + kg * 128 + 4);
#pragma unroll
          for (int i = 0; i < 4; ++i) { sv[i] += x0[i]; sv[4 + i] += x1[i]; } }
#pragma unroll
      for (int ww = 0; ww < 8; ++ww) { const f32x4 x0 = *(const LAS f32x4*)(red + (ww * 32 + nn) * 128 + c8), x1 = *(const LAS f32x4*)(red + (ww * 32 + nn) * 128 + c8 + 4);
#pragma unroll
          for (int i = 0; i < 4; ++i) { sv[i] += x0[i]; sv[4 + i] += x1[i]; } }
      __syncthreads();
#pragma unroll
      for (int i = 0; i < 8; ++i) sv[i] = gelu_tanh(sv[i]);
      u32x4 pw; pw[0] = cvt_pk_bf16(sv[0], sv[1]); pw[1] = cvt_pk_bf16(sv[2], sv[3]); pw[2] = cvt_pk_bf16(sv[4], sv[5]); pw[3] = cvt_pk_bf16(sv[6], sv[7]);
      *(LAS u32x4*)(hdn + AT_KSWZ(nn, c8 * 2)) = pw; }
    __syncthreads();
    if (w < 4) {
        f32x16 o2;
#pragma unroll
        for (int r = 0; r < 16; ++r) o2[r] = 0.f;
#pragma unroll
        for (int ks = 0; ks < 8; ++ks) { const bf16x8 af = *(const LAS bf16x8*)(hdn + AT_KSWZ(r32, (ks * 16 + hi * 8) * 2));
            const bf16x8 bfr = *(const bf16x8*)(W2T + (size_t)(w * 32 + r32) * 128 + ks * 16 + hi * 8);
            o2 = __builtin_amdgcn_mfma_f32_32x32x16_bf16(af, bfr, o2, 0, 0, 0); }
        bf16_t* dst = (bf16_t*)(ws + (DEBUG_CMP ? (j ? WS_Y + 1048576 : WS_Y) : (j ? WS_VC : WS_KC))) + (size_t)bg * 128 * 128;
#pragma unroll
        for (int r = 0; r < 16; ++r) { const int nn = mt * 32 + at::crow(r, hi); dst[(size_t)nn * 128 + w * 32 + r32] = (nn < NCMP) ? f2bf(o2[r]) : (bf16_t)0; }
    }
    __syncthreads();
}

__device__ __forceinline__ void p5_router(const Frame& F, const Args& a) {
    unsigned char* ws = F.ws; const bf16_t* H1 = (const bf16_t*)(ws + WS_H1); unsigned char* XN = ws + WS_U;
    const float* wr2 = (const float*)(ws + WS_WR2); const float* g2 = a.in[I_N2G]; const float* br = a.in[I_BR];
    float* tokw = (float*)(ws + WS_TOKW); int* slot = (int*)(ws + WS_SLOT); unsigned* cnt = F.ctl + CW_CNT;
    constexpr int HS_LD = 4104;
    LAS unsigned char* hs = F.lds; LAS float* rsv = (LAS float*)(F.lds + 32 * HS_LD); LAS float* red = (LAS float*)F.lds;
    LAS unsigned* lcnt = (LAS unsigned*)(F.lds + 32 * HS_LD + 256); LAS unsigned* lbase = lcnt + 32;
    if (F.tid < 32) lcnt[F.tid] = 0u;
    int myexp[2] = {0, 0}, myrank[2] = {0, 0};
    __syncthreads();
    for (int it = F.bid; it < NTOK / 32; it += F.G) {
#pragma unroll
        for (int rr = 0; rr < 4; ++rr) { const int tl = F.wid * 4 + rr, row = it * 32 + tl;
            const bf16_t* hr = H1 + (size_t)row * DM; u32x4 hw[4]; float ss = 0.f;
#pragma unroll
            for (int i = 0; i < 4; ++i) { hw[i] = *(const u32x4*)(hr + i * 512 + F.lane * 8); float hf[8]; unpack8(hw[i], hf);
#pragma unroll
                for (int j = 0; j < 8; ++j) ss += hf[j] * hf[j]; }
            ss = wave_sum(ss); const float rs = rsqrtf(ss * (1.f / DM) + EPS);
            if (F.lane == 0) rsv[tl] = rs;
#pragma unroll
            for (int i = 0; i < 4; ++i) { const f32x4 g0 = *(const f32x4*)(g2 + i * 512 + F.lane * 8), g1 = *(const f32x4*)(g2 + i * 512 + F.lane * 8 + 4);
                float hf[8]; unpack8(hw[i], hf);
                const f32x4 a0 = (f32x4){hf[0], hf[1], hf[2], hf[3]} * rs * g0, a1 = (f32x4){hf[4], hf[5], hf[6], hf[7]} * rs * g1;
                u32x2 w; w[0] = cvt4_fp8(a0[0], a0[1], a0[2], a0[3]); w[1] = cvt4_fp8(a1[0], a1[1], a1[2], a1[3]);
                *(u32x2*)(XN + (size_t)row * DM + i * 512 + F.lane * 8) = w;
                LAS unsigned char* hp = hs + tl * HS_LD + (i * 512 + F.lane * 8) * 2;
                *(LAS u32x2*)hp = (u32x2){hw[i][0], hw[i][1]}; *(LAS u32x2*)(hp + 8) = (u32x2){hw[i][2], hw[i][3]}; } }
        __syncthreads();
        f32x4 c00 = {0.f, 0.f, 0.f, 0.f}, c01 = c00, c10 = c00, c11 = c00;
        { const int ti = F.lane & 15, kq = F.lane >> 4, kb = F.wid * 256 + kq;
          const LAS unsigned char* ha = hs + ti * HS_LD + kb * 2; const float* wb = wr2 + (size_t)kb * 32 + ti;
#pragma unroll 16
          for (int s_ = 0; s_ < 64; ++s_) {
              const float a0 = bf2f(*(const LAS bf16_t*)(ha + s_ * 8)), a1 = bf2f(*(const LAS bf16_t*)(ha + 16 * HS_LD + s_ * 8));
              const float b0 = wb[(size_t)s_ * 128], b1 = wb[(size_t)s_ * 128 + 16];
              c00 = __builtin_amdgcn_mfma_f32_16x16x4f32(a0, b0, c00, 0, 0, 0); c01 = __builtin_amdgcn_mfma_f32_16x16x4f32(a0, b1, c01, 0, 0, 0);
              c10 = __builtin_amdgcn_mfma_f32_16x16x4f32(a1, b0, c10, 0, 0, 0); c11 = __builtin_amdgcn_mfma_f32_16x16x4f32(a1, b1, c11, 0, 0, 0); } }
        float rsl[2];
        rsl[0] = rsv[F.tid >> 5]; rsl[1] = rsv[16 + (F.tid >> 5)];
        __syncthreads();
        { const int cj = F.lane & 15, rq = (F.lane >> 4) * 4; LAS float* rw = red + F.wid * 1024;
#pragma unroll
          for (int r = 0; r < 4; ++r) { rw[(rq + r) * 32 + cj] = c00[r]; rw[(rq + r) * 32 + 16 + cj] = c01[r]; rw[(16 + rq + r) * 32 + cj] = c10[r]; rw[(16 + rq + r) * 32 + 16 + cj] = c11[r]; } }
        __syncthreads();
#pragma unroll
        for (int ps = 0; ps < 2; ++ps) {
            const int tl = ps * 16 + (F.tid >> 5), e = F.tid & 31, row = it * 32 + tl;
            float acc = 0.f;
#pragma unroll
            for (int w = 0; w < 8; ++w) acc += red[w * 1024 + tl * 32 + e];
            const float logit = acc * rsl[ps] + br[e];
            float tv[4]; int ti[4]; float cur = logit;
#pragma unroll
            for (int k = 0; k < 4; ++k) { float bv = cur; int bi = e;
#pragma unroll
                for (int o = 16; o > 0; o >>= 1) { const float ov = __shfl_xor(bv, o); const int oi = __shfl_xor(bi, o); if (ov > bv || (ov == bv && oi < bi)) { bv = ov; bi = oi; } }
                tv[k] = bv; ti[k] = bi; if (e == bi) cur = -INFINITY; }
            const float m = tv[0]; const float e0 = 1.f, e1 = __expf(tv[1] - m), e2 = __expf(tv[2] - m), e3 = __expf(tv[3] - m); const float inv = 1.f / (e0 + e1 + e2 + e3);
            if (e < 4) { const int k = e; const int ee = k == 0 ? ti[0] : k == 1 ? ti[1] : k == 2 ? ti[2] : ti[3]; const float w = (k == 0 ? e0 : k == 1 ? e1 : k == 2 ? e2 : e3) * inv;
                tokw[(size_t)row * 4 + k] = w;
                myexp[ps] = ee; myrank[ps] = (int)__hip_atomic_fetch_add(lcnt + ee, 1u, __ATOMIC_RELAXED, __HIP_MEMORY_SCOPE_WORKGROUP); } }
        __syncthreads();
        if (F.tid < 32) { const unsigned c = lcnt[F.tid]; lbase[F.tid] = c ? atomicAdd(&cnt[F.tid], c) : 0u; lcnt[F.tid] = 0u; }
        __syncthreads();
#pragma unroll
        for (int ps = 0; ps < 2; ++ps) { const int e = F.tid & 31; if (e < 4) { const int row = it * 32 + ps * 16 + (F.tid >> 5);
                slot[(size_t)myexp[ps] * NTOK + lbase[myexp[ps]] + myrank[ps]] = row * 4 + e; } }
        __syncthreads();
    }
}

__device__ __forceinline__ void moe_build_tiles(const Frame& F, LAS int* tstart, LAS int* cntl) {
    if (F.tid == 0) { int acc = 0; for (int e = 0; e < NEXP; ++e) { const int c = (int)__hip_atomic_load(F.ctl + CW_CNT + e, __ATOMIC_RELAXED, __HIP_MEMORY_SCOPE_AGENT); cntl[e] = c; tstart[e] = acc; acc += (c + 255) >> 8; } tstart[NEXP] = acc; }
    if (F.tid < 64) { const int sh = amax_shift(__hip_atomic_load(F.ctl + CW_AMAX + F.tid, __ATOMIC_RELAXED, __HIP_MEMORY_SCOPE_AGENT)); const unsigned b_ = (unsigned)(127 - sh) & 0xffu;
        cntl[40 + F.tid] = (int)(b_ | (b_ << 8) | (b_ << 16) | (b_ << 24)); }
    __syncthreads();
}

__device__ __forceinline__ void p9_combine(const Frame& F, const Args& a) {
    unsigned char* ws = F.ws; const bf16_t* H1 = (const bf16_t*)(ws + WS_H1); const bf16_t* Y = (const bf16_t*)(ws + WS_Y);
    const float* tokw = (const float*)(ws + WS_TOKW); const float* gf = a.in[I_FNG]; float* out = a.out;
    for (int row = F.bid * 8 + F.wid; row < NTOK; row += F.G * 8) {
        const bf16_t* hr = H1 + (size_t)row * DM; f32x4 v[8]; float ss = 0.f;
        const f32x4 w4 = *(const f32x4*)(tokw + (size_t)row * 4);
#pragma unroll
        for (int i = 0; i < 4; ++i) { const int c0 = i * 512 + F.lane * 8; { const u32x4 hw = *(const u32x4*)(hr + c0); float hf[8]; unpack8(hw, hf);
                v[2 * i] = (f32x4){hf[0], hf[1], hf[2], hf[3]}; v[2 * i + 1] = (f32x4){hf[4], hf[5], hf[6], hf[7]}; }
#pragma unroll
            for (int k = 0; k < 4; ++k) { const u32x4 yw = *(const u32x4*)(Y + ((size_t)row * 4 + k) * DM + c0); float f[8]; unpack8(yw, f);
#pragma unroll
                for (int j = 0; j < 4; ++j) { v[2 * i][j] += w4[k] * f[j]; v[2 * i + 1][j] += w4[k] * f[4 + j]; } }
#pragma unroll
            for (int j = 0; j < 4; ++j) ss += v[2 * i][j] * v[2 * i][j] + v[2 * i + 1][j] * v[2 * i + 1][j]; }
        ss = wave_sum(ss); const float rs = rsqrtf(ss * (1.f / DM) + EPS);
#pragma unroll
        for (int i = 0; i < 4; ++i) { const int c0 = i * 512 + F.lane * 8; const f32x4 g0 = *(const f32x4*)(gf + c0), g1 = *(const f32x4*)(gf + c0 + 4);
            *(f32x4*)(out + (size_t)row * DM + c0) = v[2 * i] * rs * g0; *(f32x4*)(out + (size_t)row * DM + c0 + 4) = v[2 * i + 1] * rs * g1; }
    }
}

#if DEBUG_CMP
__device__ __noinline__ void dbg_compare(unsigned char* ws, unsigned* ctl, LAS unsigned char* lds) {
    const int tid = threadIdx.x, lane = tid & 63, wid = tid >> 6;
    float mx = 0.f, md = 0.f; const bf16_t* r0 = (const bf16_t*)(ws + WS_KC); const bf16_t* r1 = (const bf16_t*)(ws + WS_Y);
    for (int i = tid; i < 2 * 16 * 128 * 128; i += NTHREADS) { const float x = bf2f(i < 262144 ? r0[i] : ((const bf16_t*)(ws + WS_VC))[i - 262144]); const float y = bf2f(i < 262144 ? r1[i] : ((const bf16_t*)(ws + WS_Y + 1048576))[i - 262144]);
        mx = fmaxf(mx, fabsf(x)); md = fmaxf(md, fabsf(x - y)); if (!(y == y)) md = 1e30f; }
    mx = wave_max(mx); md = wave_max(md); LAS float* t2 = (LAS float*)lds; if (lane == 0) { t2[wid] = mx; t2[8 + wid] = md; } __syncthreads();
    if (tid == 0) { float a1 = 0.f, a2 = 0.f; for (int i = 0; i < 8; ++i) { a1 = fmaxf(a1, t2[i]); a2 = fmaxf(a2, t2[8 + i]); }
        const float rel = a2 / fmaxf(a1, 1e-20f); int code = 0;
        if (rel >= 1.f) code = 10; else if (rel >= 0.3f) code = 11; else if (rel >= 0.1f) code = 12; else if (rel >= 0.03f) code = 13; else if (rel >= 0.01f) code = 14; else if (rel >= 0.003f) code = 15;
        if (blockIdx.x == 0) ctl[CW_ERR] = (unsigned)code; }
    __syncthreads();
}
#endif
constexpr int N_PHASES = 9;
extern "C" __global__ void __launch_bounds__(NTHREADS, 2) fwd(Args args) {
    extern __shared__ __attribute__((aligned(16))) unsigned char shm[];
    LAS unsigned char* lds = (LAS unsigned char*)shm;
    Frame F; F.lds = lds; F.ws = args.ws; F.ctl = (unsigned*)(args.ws + WS_CTL);
    F.tid = threadIdx.x; F.wid = __builtin_amdgcn_readfirstlane(F.tid >> 6); F.lane = F.tid & 63; F.G = gridDim.x; F.bid = blockIdx.x;
    LAS unsigned* misc = (LAS unsigned*)(lds + LDS_MISC);
    if (F.tid < 4) misc[F.tid] = 0u;
    __syncthreads();
    const int lo = args.ph_lo, hi = args.ph_hi;
    XcdBarrier bar; bar.bar = F.ctl; bar.x = 0; bar.st = nullptr;
    if (hi - lo > 1) bar = xcd_barrier_post(F.ctl, (volatile LAS unsigned*)misc);
#define IN(k) (lo <= (k) && (k) < hi)
#define SEAM(k) do { if (IN(k) && IN((k) + 1)) xcd_barrier(bar); } while (0)
    unsigned char* ws = args.ws;

    if (IN(0)) { p0_prologue(F, args); }
#if (REP_MASK >> 0) & 1
    if (IN(0)) { p0_prologue(F, args); }
#endif
    SEAM(0);
    if (IN(1)) {
        const int gi = F.bid >> 3, g8i = gi & 7; const bool split = (F.G == 256), conv = split && (g8i == 2 || g8i == 5 || g8i == 7);
        if (conv) { const int crank = ((gi >> 3) * 3 + (g8i == 2 ? 0 : (g8i == 5 ? 1 : 2))) * 8 + (F.bid & 7); conv_experts(F, args, CONV_P2 + crank, 96, 12288); bias1_partials(F, args, crank, 96); }
        else {
            const int grank = (gi >> 3) * 5 + (g8i < 2 ? g8i : (g8i < 5 ? g8i - 1 : 4));
            g8::DenseSched<DM, DM> S; S.init(ws + WS_U, ws + WS_WINT, NTOK, PROJ_LD, split ? 160 : F.G, split ? grank * 8 + (F.bid & 7) : F.bid);
            g8::EpiProj E{(bf16_t*)(ws + WS_PROJ), PROJ_LD, (bf16_t*)(ws + WS_OMF), (const float*)(ws + WS_LB)};
            g8::gemm_phase(lds, S, E);
            if (!split) { conv_experts(F, args, CONV_P2 + F.bid, F.G, 12288); bias1_partials(F, args, F.bid, F.G); }
        }
    }
#if (REP_MASK >> 1) & 1
    if (IN(1)) {
        g8::DenseSched<DM, DM> S; S.init(ws + WS_U, ws + WS_WINT, NTOK, PROJ_LD, F.G, F.bid);
        g8::EpiProj E{(bf16_t*)(ws + WS_PROJ), PROJ_LD, (bf16_t*)(ws + WS_OMF), (const float*)(ws + WS_LB)};
        g8::gemm_phase(lds, S, E);
    }
#endif
    SEAM(1);
    if (IN(2)) {
#if DEBUG_CMP
        p2_compress_naive(F, args);
#endif
        for (int u = F.bid; u < 128; u += F.G) compress_fast_unit(F, args, u);
        if (F.G == 256) { if (F.bid >= 128) conv_experts(F, args, CONV_P0 + (F.bid - 128), 128, CONV_P2); }
        else conv_experts(F, args, CONV_P0 + F.bid, F.G, CONV_P2); }
#if (REP_MASK >> 2) & 1
    if (IN(2)) {
#if DEBUG_CMP
        p2_compress_naive(F, args);
#endif
        for (int u = F.bid; u < 128; u += F.G) compress_fast_unit(F, args, u); }
#endif
    SEAM(2);
    if (IN(3)) {
#if DEBUG_CMP
        dbg_compare(ws, F.ctl, lds);
#endif
        if (F.bid < 64) hgrn_fast_unit(F, args, F.bid);
        for (;;) { if (F.tid == 0) misc[8] = atomicAdd(F.ctl + CW_QUEUE, 1u);
            __syncthreads();
            const int u = (int)misc[8];
            if (u >= BATCH * NSA_G * 32) break;
            attn_fast_unit(F, args, u); }
    }
#if (REP_MASK >> 3) & 1
    if (IN(3)) {
#if DEBUG_CMP
        dbg_compare(ws, F.ctl, lds);
#endif
        if (F.bid < 64) hgrn_fast_unit(F, args, F.bid);
        for (;;) { if (F.tid == 0) misc[8] = atomicAdd(F.ctl + CW_QUEUE + 64, 1u);
            __syncthreads();
            const int u = (int)misc[8];
            if (u >= BATCH * NSA_G * 32) break;
            attn_fast_unit(F, args, u); }
    }
#endif
    SEAM(3);
    if (IN(4)) {
        g8::DenseSched<DM, DM> S; S.init(ws + WS_YMIX, ws + WS_WOUTT, NTOK, DM, F.G, F.bid);
        g8::EpiResBf16 E{(bf16_t*)(ws + WS_H1), args.in[I_X], DM};
        g8::gemm_phase(lds, S, E);
    }
#if (REP_MASK >> 4) & 1
    if (IN(4)) {
        g8::DenseSched<DM, DM> S; S.init(ws + WS_YMIX, ws + WS_WOUTT, NTOK, DM, F.G, F.bid);
        g8::EpiResBf16 E{(bf16_t*)(ws + WS_H1), args.in[I_X], DM};
        g8::gemm_phase(lds, S, E);
    }
#endif
    SEAM(4);
    if (IN(5)) { p5_router(F, args); }
#if (REP_MASK >> 5) & 1
    if (IN(5)) { p5_router(F, args); }
#endif
    SEAM(5);
    if (IN(6)) {
        LAS int* tstart = (LAS int*)(misc + 64); LAS int* cntl = tstart + 40;
        moe_build_tiles(F, tstart, cntl);
        g8::MoeSched<16, 2, true> S{(const char*)(ws + WS_U), (const char*)(ws + WS_WGUT), (const int*)(ws + WS_SLOT), args.in[I_BGU], tstart, cntl, F.G, F.bid};
        g8::EpiGateUp E{(unsigned char*)(ws + WS_ACT), args.in[I_BGU]};
        g8::gemm_phase(lds, S, E);
    }
#if (REP_MASK >> 6) & 1
    if (IN(6)) {
        LAS int* tstart = (LAS int*)(misc + 64); LAS int* cntl = tstart + 40;
        moe_build_tiles(F, tstart, cntl);
        g8::MoeSched<16, 2, true> S{(const char*)(ws + WS_U), (const char*)(ws + WS_WGUT), (const int*)(ws + WS_SLOT), args.in[I_BGU], tstart, cntl, F.G, F.bid};
        g8::EpiGateUp E{(unsigned char*)(ws + WS_ACT), args.in[I_BGU]};
        g8::gemm_phase(lds, S, E);
    }
#endif
    SEAM(6);
    if (IN(7)) {
        LAS int* tstart = (LAS int*)(misc + 64); LAS int* cntl = tstart + 40;
        moe_build_tiles(F, tstart, cntl);
        g8::MoeSched<8, 0, false> S{(const char*)(ws + WS_ACT), (const char*)(ws + WS_WDT), (const int*)(ws + WS_SLOT), args.in[I_BD], tstart, cntl, F.G, F.bid};
        g8::EpiDown E{(bf16_t*)(ws + WS_Y), args.in[I_BD]};
        g8::gemm_phase(lds, S, E);
    }
#if (REP_MASK >> 7) & 1
    if (IN(7)) {
        LAS int* tstart = (LAS int*)(misc + 64); LAS int* cntl = tstart + 40;
        moe_build_tiles(F, tstart, cntl);
        g8::MoeSched<8, 0, false> S{(const char*)(ws + WS_ACT), (const char*)(ws + WS_WDT), (const int*)(ws + WS_SLOT), args.in[I_BD], tstart, cntl, F.G, F.bid};
        g8::EpiDown E{(bf16_t*)(ws + WS_Y), args.in[I_BD]};
        g8::gemm_phase(lds, S, E);
    }
#endif
    SEAM(7);
    if (IN(8)) { p9_combine(F, args);
#if DEBUG_CMP
        { const unsigned code = __hip_atomic_load(F.ctl + CW_ERR, __ATOMIC_RELAXED, __HIP_MEMORY_SCOPE_AGENT);
          if (code) { const float cval = sqrtf((float)code); for (size_t i = (size_t)F.bid * NTHREADS + F.tid; i < (size_t)NTOK * DM; i += (size_t)F.G * NTHREADS) args.out[i] = cval; } }
#endif
    }
#if (REP_MASK >> 8) & 1
    if (IN(8)) { p9_combine(F, args);
#if DEBUG_CMP
        { const unsigned code = __hip_atomic_load(F.ctl + CW_ERR, __ATOMIC_RELAXED, __HIP_MEMORY_SCOPE_AGENT);
          if (code) { const float cval = sqrtf((float)code); for (size_t i = (size_t)F.bid * NTHREADS + F.tid; i < (size_t)NTOK * DM; i += (size_t)F.G * NTHREADS) args.out[i] = cval; } }
#endif
    }
#endif
#undef IN
#undef SEAM
}

extern "C" void kernel_launch(void* const* d_in, const int* in_sizes, int n_in, void* d_out, int out_size, void* d_ws, size_t ws_size, hipStream_t stream) {
    static int grid = 0;
    if (grid == 0) {
        if (n_in != 18 || ws_size < WS_END) { fprintf(stderr, "kernel_launch: n_in %d ws %zu (need %zu)\n", n_in, ws_size, (size_t)WS_END); grid = -1; return; }
        int dev = 0, cus = 0, per_cu = 0;
        if (hipGetDevice(&dev) != hipSuccess || hipDeviceGetAttribute(&cus, hipDeviceAttributeMultiprocessorCount, dev) != hipSuccess) { grid = -1; return; }
        if (hipFuncSetAttribute((const void*)fwd, hipFuncAttributeMaxDynamicSharedMemorySize, LDS_BYTES) != hipSuccess) { fprintf(stderr, "kernel_launch: hipFuncSetAttribute failed\n"); grid = -1; return; }
        if (hipOccupancyMaxActiveBlocksPerMultiprocessor(&per_cu, (const void*)fwd, NTHREADS, LDS_BYTES) != hipSuccess || per_cu < 1) { fprintf(stderr, "kernel_launch: occupancy query says %d\n", per_cu); }
        (void)hipGetLastError();
        grid = cus;
    }
    if (grid < 0) return;
    (void)hipMemsetAsync((char*)d_ws + WS_CTL, 0, CTL_BYTES, stream);
    Args a{};
    for (int i = 0; i < 18; ++i) a.in[i] = (const float*)d_in[i];
    a.out = (float*)d_out; a.ws = (unsigned char*)d_ws;
#if N_LAUNCH_PER_PHASE
    for (int p = 0; p < N_PHASES; ++p) { a.ph_lo = p; a.ph_hi = p + 1; hipLaunchKernelGGL(fwd, dim3(grid), dim3(NTHREADS), LDS_BYTES, stream, a); }
#else
    a.ph_lo = 0; a.ph_hi = N_PHASES; hipLaunchKernelGGL(fwd, dim3(grid), dim3(NTHREADS), LDS_BYTES, stream, a);
#endif
}
```

```cpp
#include <hip/hip_runtime.h>
#include <stdint.h>
#include <stdio.h>

#ifndef N_LAUNCH_PER_PHASE
#define N_LAUNCH_PER_PHASE 0
#endif

#define DEBUG_CMP 0
#ifndef REP_MASK
#define REP_MASK 0
#endif
#define LAS __attribute__((address_space(3)))
typedef unsigned short bf16_t;
typedef short bf16x8 __attribute__((ext_vector_type(8)));
typedef float f32x4 __attribute__((ext_vector_type(4)));
typedef float f32x2 __attribute__((ext_vector_type(2)));
typedef float f32x16 __attribute__((ext_vector_type(16)));
typedef unsigned u32x4 __attribute__((ext_vector_type(4)));
typedef unsigned u32x2 __attribute__((ext_vector_type(2)));
typedef int i32x8 __attribute__((ext_vector_type(8)));

constexpr int BATCH = 8, SEQ = 2048, NTOK = BATCH * SEQ, DM = 2048;
constexpr int HG_W = 1024, HG_H = 8, HG_DK = 128, HG_DV = 128;
constexpr int NSA_H = 8, NSA_G = 2, NSA_R = 4, HD = 128, KVW = 256;
constexpr int IN_COLS = 6680, PROJ_LD = 6912;
constexpr int C_HQ = 0, C_HF = 1024, C_HI = 2048, C_HGT = 3072, C_NQ = 4096, C_KCM = 5120, C_VCM = 5376, C_KSL = 5632, C_VSL = 5888, C_KWN = 6144, C_VWN = 6400, C_NGT = 6656;
constexpr int NCMP = 127, NSEL = 32, SEL_TOP = 16, WINDOW = 512;
constexpr int NEXP = 32, TOPK = 4, DFF = 2048, NASG = NTOK * TOPK;
constexpr float EPS = 1e-6f;
constexpr int NTHREADS = 512;
constexpr int CONV_P0 = 0, CONV_P2 = 1280;

constexpr size_t al256(size_t x) { return (x + 255) & ~(size_t)255; }
constexpr size_t WS_CTL = 0, CTL_BYTES = 65536;
constexpr size_t WS_WINT = WS_CTL + CTL_BYTES;
constexpr size_t WS_WOUTT = WS_WINT + (size_t)PROJ_LD * DM * 2;
constexpr size_t WS_WGUT = WS_WOUTT + (size_t)DM * DM * 2;
constexpr size_t WS_WDT = WS_WGUT + (size_t)NEXP * 2 * DFF * DM * 2;
constexpr size_t WS_W1T = WS_WDT + (size_t)NEXP * DM * DFF * 2;
constexpr size_t WS_W2T = WS_W1T + (size_t)2 * 128 * 4096 * 2;
constexpr size_t WS_BIAS1 = WS_W2T + (size_t)2 * 128 * 128 * 2;
constexpr size_t WS_WR2 = WS_BIAS1 + 1024;
constexpr size_t WS_LB = WS_WR2 + (size_t)DM * NEXP * 4;
constexpr size_t WS_U = WS_LB + 4096;
constexpr size_t WS_PROJ = WS_U + (size_t)NTOK * DM * 2;
constexpr size_t WS_KC = WS_PROJ + (size_t)(NTOK + 64) * PROJ_LD * 2;
constexpr size_t WS_VC = WS_KC + (size_t)16 * 128 * 128 * 2;
constexpr size_t WS_YMIX = WS_VC + (size_t)16 * 128 * 128 * 2;
constexpr size_t WS_H1 = WS_YMIX + (size_t)NTOK * DM * 2;
constexpr size_t WS_TOKW = WS_H1 + (size_t)NTOK * DM * 4;
constexpr size_t WS_SLOT = WS_TOKW + (size_t)NTOK * 4 * 4;
constexpr size_t WS_ACT = WS_SLOT + (size_t)NEXP * NTOK * 4;
constexpr size_t WS_Y = WS_ACT + (size_t)NASG * DFF * 2;
constexpr size_t WS_OT = WS_Y + (size_t)NASG * DM * 2;
constexpr size_t WS_OMF = WS_OT + (size_t)256 * 64 * 512 * 4;
constexpr size_t WS_B1P = WS_OMF + (size_t)NTOK * HG_W * 2;
constexpr size_t WS_END = WS_B1P + (size_t)2 * 32 * 128 * 4;
constexpr int CW_CNT = 4096, CW_QUEUE = 4160, CW_ERR = 4224, CW_AMAX = 4544;

__device__ __forceinline__ float bf2f(bf16_t b) { return __uint_as_float(((unsigned)b) << 16); }
typedef __bf16 bf16v2_t __attribute__((ext_vector_type(2)));
__device__ __forceinline__ unsigned cvt_pk_bf16(float lo, float hi) { f32x2 v = {lo, hi}; bf16v2_t r = __builtin_convertvector(v, bf16v2_t); return __builtin_bit_cast(unsigned, r); }
__device__ __forceinline__ unsigned cvt4_fp8(float a, float b, float c, float d) { unsigned w = 0u; w = __builtin_amdgcn_cvt_pk_fp8_f32(a, b, w, false); w = __builtin_amdgcn_cvt_pk_fp8_f32(c, d, w, true); return w; }
__device__ __forceinline__ unsigned cvt4_bf8(float a, float b, float c, float d) { unsigned w = 0u; w = __builtin_amdgcn_cvt_pk_bf8_f32(a, b, w, false); w = __builtin_amdgcn_cvt_pk_bf8_f32(c, d, w, true); return w; }
__device__ __forceinline__ int amax_shift(unsigned bits) { if (bits == 0u) return 0; int s_ = 5 - ((int)(bits >> 23) - 127); return s_ < -60 ? -60 : (s_ > 60 ? 60 : s_); }
__device__ __forceinline__ float shift_mult(int s_) { return __uint_as_float((unsigned)(s_ + 127) << 23); }
__device__ __forceinline__ unsigned cvt4_fp8s(float a, float b, float c, float d, float m) {
    return cvt4_fp8(__builtin_amdgcn_fmed3f(a * m, -448.f, 448.f), __builtin_amdgcn_fmed3f(b * m, -448.f, 448.f), __builtin_amdgcn_fmed3f(c * m, -448.f, 448.f), __builtin_amdgcn_fmed3f(d * m, -448.f, 448.f)); }
__device__ __forceinline__ bf16_t f2bf(float f) { return (bf16_t)(cvt_pk_bf16(f, 0.f) & 0xffffu); }
__device__ __forceinline__ float sigmoidf_(float x) { return 1.f / (1.f + __expf(-x)); }
__device__ __forceinline__ float siluf_(float x) { return x * sigmoidf_(x); }
__device__ __forceinline__ float wave_sum(float v) {
#pragma unroll
    for (int o = 32; o > 0; o >>= 1) v += __shfl_xor(v, o);
    return v;
}
__device__ __forceinline__ float wave_max(float v) {
#pragma unroll
    for (int o = 32; o > 0; o >>= 1) v = fmaxf(v, __shfl_xor(v, o));
    return v;
}
__device__ __forceinline__ void unpack8(const u32x4 w, float (&f)[8]) {
#pragma unroll
    for (int i = 0; i < 4; ++i) { f[2 * i] = __uint_as_float(w[i] << 16); f[2 * i + 1] = __uint_as_float(w[i] & 0xffff0000u); }
}

#define XB_TMO      128
#define XB_XCNT(j)  (256  + 64 * (j))
#define XB_XSUB(j)  (1280 + 64 * (j))
#define XB_XGEN(j)  (2304 + 64 * (j))
#define XB_TOP      3328
#define XB_TOPGEN   3392
#define XCD_BAR_WORDS 3456
#define XB_SPIN_CAP (1u << 18)
__device__ __forceinline__ unsigned xb_ld(unsigned* p)              { return __hip_atomic_load(p, __ATOMIC_RELAXED, __HIP_MEMORY_SCOPE_AGENT); }
__device__ __forceinline__ unsigned xb_add(unsigned* p, unsigned v) { return __hip_atomic_fetch_add(p, v, __ATOMIC_RELAXED, __HIP_MEMORY_SCOPE_AGENT); }
__device__ __forceinline__ unsigned xb_xcc_id() { return (unsigned)__builtin_amdgcn_s_getreg((3 << 11) | 20) & 0xFu; }
#define XB_SPIN(cond, bar) do { unsigned _sp = 0; while (cond) { __builtin_amdgcn_s_sleep(1); \
    if ((++_sp & 255u) == 0u) { if (xb_ld(&(bar)[XB_TMO])) break; if (_sp > XB_SPIN_CAP) { atomicAdd(&(bar)[XB_TMO], 1u); break; } } } } while (0)
struct XcdBarrier { unsigned* bar; unsigned x; volatile LAS unsigned* st; };
__device__ __forceinline__ XcdBarrier xcd_barrier_post(unsigned* bar, volatile LAS unsigned* st) {
    XcdBarrier b; b.bar = bar; b.x = xb_xcc_id(); b.st = st;
    if (threadIdx.x == 0) (void)xb_add(&bar[XB_XCNT(b.x)], 1u);
    return b;
}
__device__ __forceinline__ void xcd_barrier_complete(unsigned* bar, unsigned x, unsigned& nloc, unsigned& nx) {
    const unsigned G = gridDim.x * gridDim.y * gridDim.z;
    unsigned sum, cnt, mine, sp = 0u;
    for (;;) {
        sum = 0u; cnt = 0u; mine = 0u;
#pragma unroll
        for (unsigned j = 0; j < 16; ++j) { const unsigned c = xb_ld(&bar[XB_XCNT(j)]); sum += c; cnt += (c > 0u) ? 1u : 0u; mine = (j == x) ? c : mine; }
        if (sum == G) break;
        __builtin_amdgcn_s_sleep(1);
        if ((++sp & 255u) == 0u) { if (xb_ld(&bar[XB_TMO])) break; if (sp > XB_SPIN_CAP) { atomicAdd(&bar[XB_TMO], 1u); break; } }
    }
    nloc = mine > 0u ? mine : 1u; nx = cnt > 0u ? cnt : 1u;
}
__device__ __forceinline__ void xcd_barrier(const XcdBarrier& b) {
    asm volatile("s_waitcnt vmcnt(0)" ::: "memory");
    __syncthreads();
    if (threadIdx.x == 0) {
        unsigned* bar = b.bar;
        __builtin_amdgcn_s_waitcnt(0);
        unsigned nloc = b.st[0], nx = b.st[1];
        if (nloc == 0u) { xcd_barrier_complete(bar, b.x, nloc, nx); b.st[0] = nloc; b.st[1] = nx; }
        const unsigned old = xb_add(&bar[XB_XSUB(b.x)], 1u);
        const unsigned gen = old / nloc;
        if (old + 1u == (gen + 1u) * nloc) {
            __builtin_amdgcn_fence(__ATOMIC_RELEASE, "agent");
            asm volatile("s_waitcnt vmcnt(0)" ::: "memory");
            const unsigned og = xb_add(&bar[XB_TOP], 1u);
            const unsigned tg = og / nx;
            if (og + 1u == (tg + 1u) * nx) xb_add(&bar[XB_TOPGEN], 1u);
            else XB_SPIN(xb_ld(&bar[XB_TOPGEN]) == tg, bar);
            __builtin_amdgcn_fence(__ATOMIC_ACQUIRE, "agent");
            xb_add(&bar[XB_XGEN(b.x)], 1u);
            asm volatile("s_waitcnt vmcnt(0)" ::: "memory");
        } else {
            XB_SPIN(xb_ld(&bar[XB_XGEN(b.x)]) == gen, bar);
            __builtin_amdgcn_fence(__ATOMIC_ACQUIRE, "agent");
            asm volatile("s_waitcnt vmcnt(0)" ::: "memory");
        }
    }
    __syncthreads();
}

namespace g8 {
constexpr int BM = 256, BK = 64, HALF = 128, HTB = HALF * BK * 2, STAGE_BYTES = 8 * HTB, NXCD = 8;
__host__ __device__ __forceinline__ int lds_byte(int r, int c) { const int st = (r >> 4) * 2 + (c >> 5), rr = r & 15, cc = c & 31, ob = rr * 64 + cc * 2; return st * 1024 + (ob ^ (((ob >> 9) & 1) << 5)); }
__host__ __device__ __forceinline__ void stage_rc(int b, int& R, int& C) { const int st = b / 1024, sb = b % 1024, swz = sb ^ (((sb >> 9) & 1) << 5); R = (st >> 1) * 16 + swz / 64; C = (st & 1) * 32 + (swz % 64) / 2; }
__host__ __device__ __forceinline__ int perm32(int rho) { const int n = rho >> 4, i = rho & 15; return 8 * (i >> 2) + 4 * n + (i & 3); }

struct Unit { const char* A; const char* B0; const char* B1; const int* rows; const float* bias0; const float* bias1; int nvalid; int m0, n0, e; int wscale; };

template <class Sched>
__device__ __forceinline__ void a_offsets(const Unit& u, const int (&R)[2], const int (&C)[2], unsigned (&vo)[2][2]) {
#pragma unroll
    for (int h = 0; h < 2; ++h)
#pragma unroll
        for (int i = 0; i < 2; ++i) {
            if constexpr (Sched::GATHER) {
                const int r = h * HALF + R[i];
                const int idx = u.rows[r < u.nvalid ? r : 0] >> Sched::SHIFT;
                vo[h][i] = (unsigned)idx * (unsigned)(Sched::LDA * Sched::ESZ) + (unsigned)C[i] * 2u;
            } else {
                vo[h][i] = (unsigned)(h * HALF + R[i]) * (unsigned)(Sched::LDA * Sched::ESZ) + (unsigned)C[i] * 2u;
            }
        }
}

__device__ __forceinline__ const char* uni_ptr(const char* p) { const unsigned long long v = (unsigned long long)p;
    const unsigned lo = (unsigned)__builtin_amdgcn_readfirstlane((int)(unsigned)v), hi = (unsigned)__builtin_amdgcn_readfirstlane((int)(unsigned)(v >> 32));
    return (const char*)(((unsigned long long)hi << 32) | lo); }
template <class Sched, class Epi>
__device__ __forceinline__ void gemm_phase(LAS unsigned char* lds, const Sched& S, const Epi& E) {
    const int tid = threadIdx.x, wid = __builtin_amdgcn_readfirstlane(tid >> 6), lane = tid & 63, wr = wid >> 2, wc = wid & 3, fr = lane & 15, fq = lane >> 4;
    constexpr int K = Sched::K, nt = K * Sched::ESZ / (BK * 2);
    int Rr[2], Cc[2]; unsigned voffB[2];
#pragma unroll
    for (int i = 0; i < 2; ++i) { stage_rc(tid * 16 + i * 8192, Rr[i], Cc[i]); const int Rb = Epi::PERM ? ((Rr[i] & ~31) + perm32(Rr[i] & 31)) : Rr[i];
        voffB[i] = (unsigned)Rb * (unsigned)(K * Sched::ESZ) + (unsigned)Cc[i] * 2u; }
    const size_t kstep = (size_t)(BK * 2);
    const unsigned ldsw = (unsigned)wid * 1024u;
    const int aoff = lds_byte(wr * 64 + fr, fq * 8), boff = lds_byte(wc * 32 + fr, fq * 8);
#define G8_SA(b, h) (((b) * 2 + (h)) * HTB)
#define G8_SB(b, h) ((4 + (b) * 2 + (h)) * HTB)
#define G8_STAGE(bufoff, gbase, voff) do { _Pragma("unroll") for (int _i = 0; _i < 2; ++_i) \
        __builtin_amdgcn_global_load_lds((const unsigned*)((const char*)(gbase) + (voff)[_i]), (LAS unsigned*)(lds + (bufoff) + ldsw + _i * 8192), 16, 0, 0); } while (0)
#define G8_LDA(dst, b, h) do { _Pragma("unroll") for (int m = 0; m < 4; ++m) _Pragma("unroll") for (int k = 0; k < 2; ++k) dst[m][k] = *(const LAS bf16x8*)(lds + G8_SA(b, h) + aoff + m * 2048 + k * 1024); } while (0)
#define G8_LDB(dst, b, h) do { _Pragma("unroll") for (int n = 0; n < 2; ++n) _Pragma("unroll") for (int k = 0; k < 2; ++k) dst[n][k] = *(const LAS bf16x8*)(lds + G8_SB(b, h) + boff + n * 2048 + k * 1024); } while (0)
#define G8_MMA(ai, bj, At, Bt) do { __builtin_amdgcn_s_setprio(1); _Pragma("unroll") for (int m = 0; m < 4; ++m) _Pragma("unroll") for (int n = 0; n < 2; ++n) { \
        if constexpr (Sched::ESZ == 2) { _Pragma("unroll") for (int k = 0; k < 2; ++k) acc[ai][bj][m][n] = __builtin_amdgcn_mfma_f32_16x16x32_bf16(Bt[n][k], At[m][k], acc[ai][bj][m][n], 0, 0, 0); } \
        else { const u32x4 b0_ = __builtin_bit_cast(u32x4, Bt[n][0]), b1_ = __builtin_bit_cast(u32x4, Bt[n][1]), a0_ = __builtin_bit_cast(u32x4, At[m][0]), a1_ = __builtin_bit_cast(u32x4, At[m][1]); \
            const i32x8 bw_ = {(int)b0_[0], (int)b0_[1], (int)b0_[2], (int)b0_[3], (int)b1_[0], (int)b1_[1], (int)b1_[2], (int)b1_[3]}; \
            const i32x8 aw_ = {(int)a0_[0], (int)a0_[1], (int)a0_[2], (int)a0_[3], (int)a1_[0], (int)a1_[1], (int)a1_[2], (int)a1_[3]}; \
            acc[ai][bj][m][n] = __builtin_amdgcn_mfma_scale_f32_16x16x128_f8f6f4(bw_, aw_, acc[ai][bj][m][n], Sched::FMT_W, Sched::FMT_A, 0, wsc_cur, 0, 0x7f7f7f7f); } } \
        __builtin_amdgcn_s_setprio(0); } while (0)
#define G8_WAIT_V(n) asm volatile("s_waitcnt vmcnt(" #n ")" ::: "memory")
#define G8_WAIT_L(n) asm volatile("s_waitcnt lgkmcnt(" #n ")" ::: "memory")
#define G8_BAR __builtin_amdgcn_s_barrier()
#define G8_SCHED __builtin_amdgcn_sched_barrier(0)
    Unit cur, nxt; int ui = 0;
    if (!S.next(0, cur)) return;
    f32x4 acc[2][2][4][2];
#pragma unroll
    for (int a = 0; a < 2; ++a)
#pragma unroll
        for (int b = 0; b < 2; ++b)
#pragma unroll
            for (int m = 0; m < 4; ++m)
#pragma unroll
                for (int n = 0; n < 2; ++n) acc[a][b][m][n] = (f32x4){0.f, 0.f, 0.f, 0.f};
    bf16x8 At[4][2], B0[2][2], B1[2][2];
    unsigned voffA[2][2], nvoffA[2][2];
    LAS unsigned char* auxb = lds + STAGE_BYTES; int par_cur = 0, par_nxt = 1;
#define G8_AUX_ISSUE(U, PAR) do { if (wid < 4) { const int r_ = wid * 64 + lane; __builtin_amdgcn_global_load_lds((const unsigned*)((U).rows + (r_ < (U).nvalid ? r_ : 0)), (LAS unsigned*)(auxb + (PAR) * 2048 + wid * 256), 4, 0, 0); } \
        else { const float* b_ = (wid < 6 ? (U).bias0 + (wid - 4) * 64 : (U).bias1 + (wid - 6) * 64) + lane; __builtin_amdgcn_global_load_lds((const unsigned*)b_, (LAS unsigned*)(auxb + (PAR) * 2048 + 1024 + (wid - 4) * 256), 4, 0, 0); } } while (0)
#define G8_AUX_OFFS(PAR) do { _Pragma("unroll") for (int h = 0; h < 2; ++h) _Pragma("unroll") for (int i = 0; i < 2; ++i) { \
        const int idx_ = *(const LAS int*)(auxb + (PAR) * 2048 + (h * HALF + Rr[i]) * 4) >> Sched::SHIFT; voffA[h][i] = (unsigned)idx_ * (unsigned)(Sched::LDA * Sched::ESZ) + (unsigned)Cc[i] * 2u; } } while (0)
    if constexpr (Sched::LDSAUX) { G8_AUX_ISSUE(cur, 0); G8_WAIT_V(0); __syncthreads(); G8_AUX_OFFS(0); }
    else a_offsets<Sched>(cur, Rr, Cc, voffA);
    const char* cA = cur.A; const char* cB0 = cur.B0; const char* cB1 = cur.B1;
    int wsc_cur = cur.wscale;
    G8_STAGE(G8_SB(0, 0), cB0, voffB); G8_STAGE(G8_SA(0, 0), cA, voffA[0]); G8_STAGE(G8_SB(0, 1), cB1, voffB); G8_STAGE(G8_SA(0, 1), cA, voffA[1]);
    if (wr == 1) G8_BAR;
    G8_WAIT_V(4); G8_BAR;
    G8_STAGE(G8_SB(1, 0), cB0 + kstep, voffB); G8_STAGE(G8_SA(1, 0), cA + kstep, voffA[0]); G8_STAGE(G8_SB(1, 1), cB1 + kstep, voffB);
    G8_WAIT_V(6); G8_BAR;
    for (;;) {
        const bool has_next = S.next(ui + 1, nxt);
        const char* nA = has_next ? nxt.A : cA; const char* nB0 = has_next ? nxt.B0 : cB0; const char* nB1 = has_next ? nxt.B1 : cB1;
        if constexpr (Sched::LDSAUX) { if (has_next) G8_AUX_ISSUE(nxt, par_nxt); }
        else if constexpr (Sched::GATHER) {
            if (has_next) a_offsets<Sched>(nxt, Rr, Cc, nvoffA);
            else {
#pragma unroll
                for (int h = 0; h < 2; ++h)
#pragma unroll
                    for (int i = 0; i < 2; ++i) nvoffA[h][i] = voffA[h][i];
            }
        }
        for (int t = 0; t < nt; t += 2) {
            const bool last = (t == nt - 2);
            const char* a1 = cA + (size_t)(t + 1) * kstep;
            const char* a2 = last ? nA : cA + (size_t)(t + 2) * kstep;
            const char* b20 = last ? nB0 : cB0 + (size_t)(t + 2) * kstep; const char* b21 = last ? nB1 : cB1 + (size_t)(t + 2) * kstep;
            const char* a3 = a2 + kstep; const char* b30 = b20 + kstep; const char* b31 = b21 + kstep;
            G8_LDB(B0, 0, 0); G8_SCHED; G8_LDA(At, 0, 0); G8_STAGE(G8_SA(1, 1), a1, voffA[1]);
            G8_WAIT_L(8); G8_BAR; G8_WAIT_L(0); G8_MMA(0, 0, At, B0); G8_BAR; G8_SCHED;
            if constexpr (Sched::LDSAUX) { if (last && has_next) G8_AUX_OFFS(par_nxt); }
            else if constexpr (Sched::GATHER) { if (last) {
#pragma unroll
                for (int h = 0; h < 2; ++h)
#pragma unroll
                    for (int i = 0; i < 2; ++i) voffA[h][i] = nvoffA[h][i]; } }
            G8_LDB(B1, 0, 1); G8_STAGE(G8_SB(0, 0), b20, voffB);
            G8_BAR; G8_WAIT_L(0); G8_MMA(0, 1, At, B1); G8_BAR;
            G8_LDA(At, 0, 1); G8_STAGE(G8_SA(0, 0), a2, voffA[0]);
            G8_BAR; G8_WAIT_L(0); G8_MMA(1, 0, At, B0); G8_BAR; G8_SCHED;
            G8_STAGE(G8_SB(0, 1), b21, voffB);
            G8_WAIT_V(6); G8_BAR; G8_MMA(1, 1, At, B1); G8_BAR;
            G8_LDB(B0, 1, 0); G8_SCHED; G8_LDA(At, 1, 0); G8_STAGE(G8_SA(0, 1), a2, voffA[1]);
            G8_WAIT_L(8); G8_BAR; G8_WAIT_L(0); G8_MMA(0, 0, At, B0); G8_BAR; G8_SCHED;
            G8_LDB(B1, 1, 1); G8_STAGE(G8_SB(1, 0), b30, voffB);
            G8_BAR; G8_WAIT_L(0); G8_MMA(0, 1, At, B1); G8_BAR;
            G8_LDA(At, 1, 1); G8_STAGE(G8_SA(1, 0), a3, voffA[0]);
            G8_BAR; G8_WAIT_L(0); G8_MMA(1, 0, At, B0); G8_BAR; G8_SCHED;
            G8_STAGE(G8_SB(1, 1), b31, voffB);
            G8_WAIT_V(6); G8_BAR; G8_MMA(1, 1, At, B1); G8_BAR;
        }
        E(acc, cur, wr, wc, fr, fq, (const LAS int*)(auxb + par_cur * 2048), (const LAS float*)(auxb + par_cur * 2048 + 1024));
        if (!has_next) break;
#pragma unroll
        for (int a = 0; a < 2; ++a)
#pragma unroll
            for (int b = 0; b < 2; ++b)
#pragma unroll
                for (int m = 0; m < 4; ++m)
#pragma unroll
                    for (int n = 0; n < 2; ++n) acc[a][b][m][n] = (f32x4){0.f, 0.f, 0.f, 0.f};
        cur = nxt; cA = nA; cB0 = nB0; cB1 = nB1; ++ui; wsc_cur = cur.wscale; par_cur = par_nxt; par_nxt = par_nxt == 2 ? 0 : par_nxt + 1;
    }
    G8_WAIT_V(0);
    if (wr == 0) G8_BAR;
    G8_BAR;
#undef G8_AUX_ISSUE
#undef G8_AUX_OFFS
#undef G8_SA
#undef G8_SB
#undef G8_STAGE
#undef G8_LDA
#undef G8_LDB
#undef G8_MMA
#undef G8_WAIT_V
#undef G8_WAIT_L
#undef G8_BAR
#undef G8_SCHED
}

template <int K_, int LDA_>
struct DenseSched {
    static constexpr int K = K_, LDA = LDA_, SHIFT = 0, ESZ = 2, FMT_W = 0, FMT_A = 0; static constexpr bool GATHER = false, LDSAUX = false;
    const char* A; const char* Bt; int nM, nN, nwg, G, c;
    __device__ void init(const void* A_, const void* Bt_, int M, int N, int G_, int c_) { A = (const char*)A_; Bt = (const char*)Bt_; nM = M / BM; nN = N / BM; nwg = nM * nN; G = G_; c = c_; }
    __device__ __forceinline__ bool next(int i, Unit& u) const {
        const long L = (long)i * G + c; if (L >= nwg) return false;
        int wgid = (int)L; { const int q = nwg / NXCD, r = nwg % NXCD, xcd = wgid % NXCD, off = wgid / NXCD; wgid = (xcd < r ? xcd * (q + 1) : r * (q + 1) + (xcd - r) * q) + off; }
        constexpr int WGM = 8;
        const int nig = WGM * nN, gid = wgid / nig, fm = gid * WGM, gsz = (nM - fm) < WGM ? (nM - fm) : WGM;
        const int pm = fm + ((wgid % nig) % gsz), pn = (wgid % nig) / gsz;
        u.A = A + (size_t)pm * BM * LDA * 2; u.B0 = Bt + (size_t)pn * BM * K * 2; u.B1 = u.B0 + (size_t)HALF * K * 2;
        u.rows = nullptr; u.bias0 = nullptr; u.bias1 = nullptr; u.wscale = 0x7f7f7f7f; u.nvalid = BM; u.m0 = pm * BM; u.n0 = pn * BM; u.e = 0; return true;
    }
};

template <int NPN  , int SHIFT_, bool GU>
struct MoeSched {
    static constexpr int K = 2048, LDA = 2048, SHIFT = SHIFT_, ESZ = 1, FMT_W = 0  , FMT_A = 0  ; static constexpr bool GATHER = true, LDSAUX = true;
    const char* A; const char* Bt; const int* slot; const float* bias; const LAS int* tstart; const LAS int* cnt; int G, c;
    __device__ __forceinline__ bool next(int i, Unit& u) const {
        const int ntile = tstart[NEXP]; const int nwg = ntile * NPN;
        const long L = (long)i * G + c; if (L >= nwg) return false;
        int wgid = (int)L; { const int q = nwg / NXCD, r = nwg % NXCD, xcd = wgid % NXCD, off = wgid / NXCD; wgid = (xcd < r ? xcd * (q + 1) : r * (q + 1) + (xcd - r) * q) + off; }
        int e = 0;
        for (int s = 16; s > 0; s >>= 1) if (tstart[e + s] * NPN <= wgid) e += s;
        const int mt = tstart[e + 1] - tstart[e], w = wgid - tstart[e] * NPN, pn = w / mt, m = w % mt;
        u.A = A; u.e = e; u.m0 = m * BM; u.n0 = pn; u.wscale = cnt[40 + (GU ? 0 : 32) + e]; u.rows = slot + (size_t)e * NTOK + m * BM;
        const int left = cnt[e] - m * BM; u.nvalid = left < BM ? left : BM;
        if (GU) { u.B0 = Bt + ((size_t)e * 4096 + (size_t)pn * HALF) * K * ESZ; u.B1 = u.B0 + (size_t)2048 * K * ESZ; u.bias0 = bias + (size_t)e * 4096 + pn * HALF; u.bias1 = u.bias0 + 2048; }
        else { u.B0 = Bt + ((size_t)e * 2048 + (size_t)pn * BM) * K * ESZ; u.B1 = u.B0 + (size_t)HALF * K * ESZ; u.bias0 = bias + (size_t)e * 2048 + pn * BM; u.bias1 = u.bias0 + HALF; }
        return true;
    }
};

struct EpiBf16 {
    static constexpr bool PERM = true;
    bf16_t* O; int ldc;
    __device__ __forceinline__ void operator()(const f32x4 (&acc)[2][2][4][2], const Unit& u, int wr, int wc, int fr, int fq, const LAS int* lrows, const LAS float* lbias) const {
        const int row0 = u.m0 + wr * 64 + fr, col0 = u.n0 + wc * 32 + 8 * fq;
#pragma unroll
        for (int ai = 0; ai < 2; ++ai)
#pragma unroll
            for (int m = 0; m < 4; ++m) { bf16_t* rowp = O + (size_t)(row0 + ai * HALF + m * 16) * ldc + col0;
#pragma unroll
                for (int bj = 0; bj < 2; ++bj) { const f32x4 v0 = acc[ai][bj][m][0], v1 = acc[ai][bj][m][1];
                    u32x4 w; w[0] = cvt_pk_bf16(v0[0], v0[1]); w[1] = cvt_pk_bf16(v0[2], v0[3]); w[2] = cvt_pk_bf16(v1[0], v1[1]); w[3] = cvt_pk_bf16(v1[2], v1[3]);
                    *(u32x4*)(rowp + bj * HALF) = w; } }
    }
};
struct EpiProj {
    static constexpr bool PERM = true;
    bf16_t* O; int ldc; bf16_t* OMF; const float* lb;
    __device__ __forceinline__ void operator()(const f32x4 (&acc)[2][2][4][2], const Unit& u, int wr, int wc, int fr, int fq, const LAS int* lrows, const LAS float* lbias) const {
        const int row0 = u.m0 + wr * 64 + fr, col0 = u.n0 + wc * 32 + 8 * fq;
        const int mode = (u.n0 < 1024 || (u.n0 >= 3072 && u.n0 < 4096)) ? 1 : ((u.n0 >= 1024 && u.n0 < 2048) ? 2 : 0);
        f32x4 lbv[2][2];
        if (mode == 2) {
#pragma unroll
            for (int bj = 0; bj < 2; ++bj) { lbv[bj][0] = *(const f32x4*)(lb + col0 - 1024 + bj * HALF); lbv[bj][1] = *(const f32x4*)(lb + col0 - 1024 + bj * HALF + 4); } }
#pragma unroll
        for (int ai = 0; ai < 2; ++ai)
#pragma unroll
            for (int m = 0; m < 4; ++m) { const size_t rowi = (size_t)(row0 + ai * HALF + m * 16); bf16_t* rowp = O + rowi * ldc + col0;
#pragma unroll
                for (int bj = 0; bj < 2; ++bj) { f32x4 v0 = acc[ai][bj][m][0], v1 = acc[ai][bj][m][1];
                    f32x4 o0 = {0.f, 0.f, 0.f, 0.f}, o1 = o0;
                    if (mode != 0) {
                        f32x4 e0 = v0 * (-1.4426950408889634f), e1 = v1 * (-1.4426950408889634f);
#pragma unroll
                        for (int j = 0; j < 4; ++j) { e0[j] = __builtin_amdgcn_exp2f(e0[j]); e1[j] = __builtin_amdgcn_exp2f(e1[j]); }
                        e0 = e0 + 1.f; e1 = e1 + 1.f;
#pragma unroll
                        for (int j = 0; j < 4; ++j) { e0[j] = __builtin_amdgcn_rcpf(e0[j]); e1[j] = __builtin_amdgcn_rcpf(e1[j]); }
                        if (mode == 1) { v0 = v0 * e0; v1 = v1 * e1; }
                        else { const f32x4 f0 = lbv[bj][0] + (1.f - lbv[bj][0]) * e0, f1 = lbv[bj][1] + (1.f - lbv[bj][1]) * e1;
#pragma unroll
                            for (int j = 0; j < 4; ++j) { v0[j] = __builtin_amdgcn_logf(f0[j]); v1[j] = __builtin_amdgcn_logf(f1[j]); }
                            o0 = 1.f - f0; o1 = 1.f - f1; } }
                    if (mode == 2) {
                        u32x4 w2; w2[0] = cvt_pk_bf16(o0[0], o0[1]); w2[1] = cvt_pk_bf16(o0[2], o0[3]); w2[2] = cvt_pk_bf16(o1[0], o1[1]); w2[3] = cvt_pk_bf16(o1[2], o1[3]);
                        *(u32x4*)(OMF + rowi * HG_W + (col0 - 1024) + bj * HALF) = w2; }
                    u32x4 w; w[0] = cvt_pk_bf16(v0[0], v0[1]); w[1] = cvt_pk_bf16(v0[2], v0[3]); w[2] = cvt_pk_bf16(v1[0], v1[1]); w[3] = cvt_pk_bf16(v1[2], v1[3]);
                    *(u32x4*)(rowp + bj * HALF) = w; } }
    }
};
struct EpiResF32 {
    static constexpr bool PERM = false;
    float* C; const float* res; int ldc;
    __device__ __forceinline__ void operator()(const f32x4 (&acc)[2][2][4][2], const Unit& u, int wr, int wc, int fr, int fq, const LAS int* lrows, const LAS float* lbias) const {
        const int row0 = u.m0 + wr * 64 + fr, col0 = u.n0 + wc * 32 + 4 * fq;
#pragma unroll
        for (int ai = 0; ai < 2; ++ai)
#pragma unroll
            for (int m = 0; m < 4; ++m) { const size_t off = (size_t)(row0 + ai * HALF + m * 16) * ldc + col0;
#pragma unroll
                for (int bj = 0; bj < 2; ++bj)
#pragma unroll
                    for (int n = 0; n < 2; ++n) { const f32x4 r = *(const f32x4*)(res + off + bj * HALF + n * 16); *(f32x4*)(C + off + bj * HALF + n * 16) = acc[ai][bj][m][n] + r; } }
    }
};
struct EpiResBf16 {
    static constexpr bool PERM = true;
    bf16_t* C; const float* res; int ldc;
    __device__ __forceinline__ void operator()(const f32x4 (&acc)[2][2][4][2], const Unit& u, int wr, int wc, int fr, int fq, const LAS int*, const LAS float*) const {
        const int row0 = u.m0 + wr * 64 + fr, col0 = u.n0 + wc * 32 + 8 * fq;
#pragma unroll
        for (int ai = 0; ai < 2; ++ai)
#pragma unroll
            for (int m = 0; m < 4; ++m) { const size_t off = (size_t)(row0 + ai * HALF + m * 16) * ldc + col0;
#pragma unroll
                for (int bj = 0; bj < 2; ++bj) { const f32x4 r0 = *(const f32x4*)(res + off + bj * HALF), r1 = *(const f32x4*)(res + off + bj * HALF + 4);
                    const f32x4 v0 = acc[ai][bj][m][0] + r0, v1 = acc[ai][bj][m][1] + r1;
                    u32x4 w; w[0] = cvt_pk_bf16(v0[0], v0[1]); w[1] = cvt_pk_bf16(v0[2], v0[3]); w[2] = cvt_pk_bf16(v1[0], v1[1]); w[3] = cvt_pk_bf16(v1[2], v1[3]);
                    *(u32x4*)(C + off + bj * HALF) = w; } }
    }
};
struct EpiGateUp {
    static constexpr bool PERM = true;
    unsigned char* ACT; const float* bias;
    __device__ __forceinline__ void operator()(const f32x4 (&acc)[2][2][4][2], const Unit& u, int wr, int wc, int fr, int fq, const LAS int* lrows, const LAS float* lbias) const {
        const int colh = u.n0 * HALF + wc * 32 + 8 * fq;
        const LAS float* bp = lbias + wc * 32 + 8 * fq;
        const f32x4 bg0 = *(const LAS f32x4*)bp, bg1 = *(const LAS f32x4*)(bp + 4), bu0 = *(const LAS f32x4*)(bp + 128), bu1 = *(const LAS f32x4*)(bp + 132);
#pragma unroll
        for (int ai = 0; ai < 2; ++ai)
#pragma unroll
            for (int m = 0; m < 4; ++m) { const int r = ai * HALF + wr * 64 + m * 16 + fr;
                if (r < u.nvalid) { const int asg = lrows[r];
                    f32x4 g0 = acc[ai][0][m][0] + bg0, g1 = acc[ai][0][m][1] + bg1, u0 = acc[ai][1][m][0] + bu0, u1 = acc[ai][1][m][1] + bu1;
                    f32x4 e0, e1;
#pragma unroll
                    for (int j = 0; j < 4; ++j) { g0[j] = fminf(g0[j], 7.f); g1[j] = fminf(g1[j], 7.f); u0[j] = __builtin_amdgcn_fmed3f(u0[j], -7.f, 7.f); u1[j] = __builtin_amdgcn_fmed3f(u1[j], -7.f, 7.f); }
                    const f32x4 z0 = g0 * (-1.702f * 1.4426950408889634f), z1 = g1 * (-1.702f * 1.4426950408889634f);
#pragma unroll
                    for (int j = 0; j < 4; ++j) { e0[j] = __builtin_amdgcn_exp2f(z0[j]); e1[j] = __builtin_amdgcn_exp2f(z1[j]); }
                    e0 = e0 + 1.f; e1 = e1 + 1.f;
#pragma unroll
                    for (int j = 0; j < 4; ++j) { e0[j] = __builtin_amdgcn_rcpf(e0[j]); e1[j] = __builtin_amdgcn_rcpf(e1[j]); }
                    const f32x4 o0 = (g0 * e0) * (u0 + 1.f), o1 = (g1 * e1) * (u1 + 1.f);
                    u32x2 w; w[0] = cvt4_fp8(o0[0], o0[1], o0[2], o0[3]); w[1] = cvt4_fp8(o1[0], o1[1], o1[2], o1[3]);
                    *(u32x2*)(ACT + (size_t)asg * DFF + colh) = w; } }
    }
};
struct EpiDown {
    static constexpr bool PERM = true;
    bf16_t* Y; const float* bias;
    __device__ __forceinline__ void operator()(const f32x4 (&acc)[2][2][4][2], const Unit& u, int wr, int wc, int fr, int fq, const LAS int* lrows, const LAS float* lbias) const {
        const int col0 = u.n0 * BM + wc * 32 + 8 * fq;
        const LAS float* bp = lbias + wc * 32 + 8 * fq;
        f32x4 bv[2][2];
#pragma unroll
        for (int bj = 0; bj < 2; ++bj) { bv[bj][0] = *(const LAS f32x4*)(bp + bj * HALF); bv[bj][1] = *(const LAS f32x4*)(bp + bj * HALF + 4); }
#pragma unroll
        for (int ai = 0; ai < 2; ++ai)
#pragma unroll
            for (int m = 0; m < 4; ++m) { const int r = ai * HALF + wr * 64 + m * 16 + fr;
                if (r < u.nvalid) { const int asg = lrows[r]; bf16_t* rowp = Y + (size_t)asg * DM + col0;
#pragma unroll
                    for (int bj = 0; bj < 2; ++bj) { const f32x4 v0 = acc[ai][bj][m][0] + bv[bj][0], v1 = acc[ai][bj][m][1] + bv[bj][1];
                        u32x4 w; w[0] = cvt_pk_bf16(v0[0], v0[1]); w[1] = cvt_pk_bf16(v0[2], v0[3]); w[2] = cvt_pk_bf16(v1[0], v1[1]); w[3] = cvt_pk_bf16(v1[2], v1[3]);
                        *(u32x4*)(rowp + bj * HALF) = w; } } }
    }
};
}

struct Args { const float* in[18]; float* out; unsigned char* ws; int ph_lo, ph_hi; };
enum { I_X = 0, I_N1G, I_WIN, I_LBL, I_HGNG, I_CPOS, I_CW1, I_CW2, I_NSAG, I_WOUT, I_N2G, I_WR, I_BR, I_WGU, I_BGU, I_WD, I_BD, I_FNG };
constexpr int LDS_STAGE = 131072, LDS_BYTES = LDS_STAGE + 16384, LDS_MISC = LDS_BYTES - 4096;

struct Frame {
    LAS unsigned char* lds; unsigned char* ws; unsigned* ctl; int tid, wid, lane, G, bid;
};

__device__ __forceinline__ void conv_tile(const Frame& F, const float* src, int lds_, int k0, int n0, int N, bf16_t* dst, int ldd) {
    LAS float* tile = (LAS float*)F.lds;
#pragma unroll
    for (int p = 0; p < 2; ++p) { const int k = p * 32 + (F.tid >> 4), n = (F.tid & 15) * 4;
        f32x4 v = (f32x4){0.f, 0.f, 0.f, 0.f};
        if (n0 + n < N) v = *(const f32x4*)(src + (size_t)(k0 + k) * lds_ + n0 + n);
        tile[k * 65 + n] = v[0]; tile[k * 65 + n + 1] = v[1]; tile[k * 65 + n + 2] = v[2]; tile[k * 65 + n + 3] = v[3]; }
    __syncthreads();
    { const int n = F.tid >> 3, kc = (F.tid & 7) * 8;
      if (n0 + n < N) { float f[8];
#pragma unroll
          for (int j = 0; j < 8; ++j) f[j] = tile[(kc + j) * 65 + n];
          u32x4 w; w[0] = cvt_pk_bf16(f[0], f[1]); w[1] = cvt_pk_bf16(f[2], f[3]); w[2] = cvt_pk_bf16(f[4], f[5]); w[3] = cvt_pk_bf16(f[6], f[7]);
          *(u32x4*)(dst + (size_t)(n0 + n) * ldd + k0 + kc) = w; } }
    __syncthreads();
}
struct ConvJob { const float* src; unsigned char* dst; int N; };
__device__ __forceinline__ ConvJob conv_job(const Args& a, unsigned char* ws, int st, int& kt, int& ntile) {
    ConvJob j;
    if (st < 8192) { const int e = st >> 8, r = st & 255; kt = r >> 4; ntile = r & 15; j.src = a.in[I_WGU] + (size_t)e * DM * 4096; j.dst = ws + WS_WGUT + (size_t)e * 4096 * DM; j.N = 4096; }
    else { const int q = st - 8192, e = q >> 7, r = q & 127; kt = r >> 3; ntile = r & 7; j.src = a.in[I_WD] + (size_t)e * DFF * DM; j.dst = ws + WS_WDT + (size_t)e * DM * DFF; j.N = 2048; }
    return j;
}
__device__ __forceinline__ void conv_experts(const Frame& F, const Args& a, int first, int stride, int limit) {
    unsigned char* ws = F.ws; LAS unsigned* tile = (LAS unsigned*)F.lds;
    LAS float* mtab = (LAS float*)(F.lds + 32768);
    if (F.tid < 64) mtab[F.tid] = shift_mult(amax_shift(__hip_atomic_load(F.ctl + CW_AMAX + F.tid, __ATOMIC_RELAXED, __HIP_MEMORY_SCOPE_AGENT)));
    __syncthreads();
    const int NST = limit;
    const int lk = F.tid >> 5, lc = F.tid & 31;
    f32x4 v[16];
    int st = first, kt = 0, ntile = 0; ConvJob J{};
#define CV_LOAD() do { _Pragma("unroll") for (int T = 0; T < 2; ++T) _Pragma("unroll") for (int pp = 0; pp < 8; ++pp) \
        v[T * 8 + pp] = __builtin_nontemporal_load((const f32x4*)(J.src + (size_t)(kt * 128 + pp * 16 + lk) * J.N + ntile * 256 + T * 128 + lc * 4)); } while (0)
    if (st < NST) { J = conv_job(a, ws, st, kt, ntile); CV_LOAD(); }
    for (; st < NST; st += stride) {
        const float mlt = mtab[st < 8192 ? (st >> 8) : 32 + ((st - 8192) >> 7)];
#pragma unroll
        for (int T = 0; T < 2; ++T)
#pragma unroll
            for (int pp = 0; pp < 8; ++pp) { const int k = pp * 16 + lk; const f32x4 x = v[T * 8 + pp];
                tile[T * 4096 + k * 32 + (lc ^ (4 * (k >> 4)))] = cvt4_fp8s(x[0], x[1], x[2], x[3], mlt); }
        __syncthreads();
        const ConvJob Jc = J; const int ktc = kt, ntc = ntile;
        const int nx = st + stride;
        if (nx < NST) { J = conv_job(a, ws, nx, kt, ntile); CV_LOAD(); }
        { const int i = F.tid & 7, n4g = (F.tid >> 3) & 31, T = F.tid >> 8;
          unsigned d[16];
#pragma unroll
          for (int jj = 0; jj < 16; ++jj) d[jj] = tile[T * 4096 + (16 * i + jj) * 32 + (n4g ^ (4 * i))];
          u32x4 o[4];
#pragma unroll
          for (int q = 0; q < 4; ++q) {
              const unsigned a0 = __builtin_amdgcn_perm(d[4 * q + 1], d[4 * q], 0x05010400u), a1 = __builtin_amdgcn_perm(d[4 * q + 1], d[4 * q], 0x07030602u);
              const unsigned a2 = __builtin_amdgcn_perm(d[4 * q + 3], d[4 * q + 2], 0x05010400u), a3 = __builtin_amdgcn_perm(d[4 * q + 3], d[4 * q + 2], 0x07030602u);
              o[0][q] = __builtin_amdgcn_perm(a2, a0, 0x05040100u); o[1][q] = __builtin_amdgcn_perm(a2, a0, 0x07060302u);
              o[2][q] = __builtin_amdgcn_perm(a3, a1, 0x05040100u); o[3][q] = __builtin_amdgcn_perm(a3, a1, 0x07060302u); }
          unsigned char* dp = Jc.dst + (size_t)(ntc * 256 + T * 128 + n4g * 4) * DM + ktc * 128 + 16 * i;
#pragma unroll
          for (int r = 0; r < 4; ++r) *(u32x4*)(dp + (size_t)r * DM) = o[r]; }
        __syncthreads();
    }
#undef CV_LOAD
}
__device__ __forceinline__ void conv_matrix4(const Frame& F, const float* src, int K, int N, bf16_t* dst) {
    LAS float* tile = (LAS float*)F.lds;
    const int tn4 = (N + 255) / 256, tk = K / 64, cnt = tn4 * tk;
    for (int t = F.bid; t < cnt; t += F.G) { const int k0 = (t / tn4) * 64, n00 = (t % tn4) * 256;
        f32x4 v[8];
#pragma unroll
        for (int q = 0; q < 4; ++q)
#pragma unroll
            for (int p = 0; p < 2; ++p) { const int k = p * 32 + (F.tid >> 4), n = n00 + q * 64 + (F.tid & 15) * 4;
                v[q * 2 + p] = (n < N) ? *(const f32x4*)(src + (size_t)(k0 + k) * N + n) : (f32x4){0.f, 0.f, 0.f, 0.f}; }
#pragma unroll
        for (int q = 0; q < 4; ++q)
#pragma unroll
            for (int p = 0; p < 2; ++p) { LAS float* tp = tile + q * (64 * 65) + (p * 32 + (F.tid >> 4)) * 65 + (F.tid & 15) * 4; const f32x4 x = v[q * 2 + p]; tp[0] = x[0]; tp[1] = x[1]; tp[2] = x[2]; tp[3] = x[3]; }
        __syncthreads();
        { const int n = F.tid >> 3, kc = (F.tid & 7) * 8;
#pragma unroll
          for (int q = 0; q < 4; ++q) { const int nn = n00 + q * 64 + n;
              if (nn < N) { float f[8];
#pragma unroll
                  for (int j = 0; j < 8; ++j) f[j] = tile[q * (64 * 65) + (kc + j) * 65 + n];
                  u32x4 w; w[0] = cvt_pk_bf16(f[0], f[1]); w[1] = cvt_pk_bf16(f[2], f[3]); w[2] = cvt_pk_bf16(f[4], f[5]); w[3] = cvt_pk_bf16(f[6], f[7]);
                  *(u32x4*)(dst + (size_t)nn * K + k0 + kc) = w; } } }
        __syncthreads(); }
}
__device__ __forceinline__ void conv_matrix(const Frame& F, const float* src, int K, int N, bf16_t* dst, long& base) {
    const int tn = (N + 63) / 64, tk = K / 64; const long cnt = (long)tn * tk;
    long first = ((long)F.bid - base) % F.G; if (first < 0) first += F.G;
    for (long t = first; t < cnt; t += F.G) { const int kt = (int)(t / tn), nt_ = (int)(t % tn); conv_tile(F, src, N, kt * 64, nt_ * 64, N, dst, K); }
    base += cnt;
}
__device__ __forceinline__ void bias1_partials(const Frame& F, const Args& a, int rank, int nranks) {
    LAS float* red = (LAS float*)F.lds;
    const int c = F.tid & 127, kq = F.tid >> 7;
    for (int job = rank; job < 64; job += nranks) { const int j = job >> 5, kg = job & 31;
        const float* pos = a.in[I_CPOS] + (size_t)j * 4096 + kg * 128 + kq * 32; const float* w1 = a.in[I_CW1] + ((size_t)j * 4096 + kg * 128 + kq * 32) * 128 + c;
        float s0 = 0.f, s1 = 0.f, s2 = 0.f, s3 = 0.f;
#pragma unroll
        for (int k = 0; k < 32; k += 4) { s0 += pos[k] * w1[(size_t)k * 128]; s1 += pos[k + 1] * w1[(size_t)(k + 1) * 128]; s2 += pos[k + 2] * w1[(size_t)(k + 2) * 128]; s3 += pos[k + 3] * w1[(size_t)(k + 3) * 128]; }
        red[kq * 128 + c] = (s0 + s1) + (s2 + s3);
        __syncthreads();
        if (F.tid < 128) ((float*)(F.ws + WS_B1P))[((size_t)j * 32 + kg) * 128 + c] = ((red[c] + red[128 + c]) + red[256 + c]) + red[384 + c];
        __syncthreads(); }
}
__device__ __forceinline__ void p0_sample(const Frame& F, const Args& a) {
    const int j = F.bid & 63, q = F.bid >> 6, nq = (F.G + 63 - j) >> 6;
    const float* src; size_t stride; int nalt;
    if (j < 32) { src = a.in[I_WGU] + (size_t)j * DM * 4096; stride = (size_t)DM * 4096 / 64; nalt = 2; }
    else { src = a.in[I_WD] + (size_t)(j - 32) * DFF * DM; stride = (size_t)DFF * DM / 64; nalt = 1; }
    float mx = 0.f;
    for (int c = q; c < 64; c += nq) { const f32x4 v = *(const f32x4*)(src + (size_t)c * stride + (size_t)(c % nalt) * 2048 + F.tid * 4);
        mx = fmaxf(fmaxf(mx, fmaxf(fabsf(v[0]), fabsf(v[1]))), fmaxf(fabsf(v[2]), fabsf(v[3]))); }
    mx = wave_max(mx);
    if (F.lane == 0 && mx > 0.f) atomicMax(F.ctl + CW_AMAX + j, __float_as_uint(mx));
}
__device__ __forceinline__ void p0_prologue(const Frame& F, const Args& a) {
    unsigned char* ws = F.ws;
    long base = 0;
    p0_sample(F, a);
    static_assert(CONV_P0 == 0, "expert tiles need the sampled scales: none may be converted in the prologue");
    conv_matrix4(F, a.in[I_WIN], DM, IN_COLS, (bf16_t*)(ws + WS_WINT));
    conv_matrix(F, a.in[I_WOUT], DM, DM, (bf16_t*)(ws + WS_WOUTT), base);
    for (int fi = F.bid * NTHREADS + F.tid; fi < 2 * 8 * 32 * 4 * 64; fi += F.G * NTHREADS) {
        const int ln_ = fi & 63, ct = (fi >> 6) & 3, ks = (fi >> 8) & 31, w = (fi >> 13) & 7, j = fi >> 16;
        const float* wp = a.in[I_CW1] + ((size_t)j * 4096 + w * 512 + ks * 16 + (ln_ >> 5) * 8) * 128 + ct * 32 + (ln_ & 31);
        u32x4 fw; fw[0] = cvt_pk_bf16(wp[0], wp[128]); fw[1] = cvt_pk_bf16(wp[256], wp[384]); fw[2] = cvt_pk_bf16(wp[512], wp[640]); fw[3] = cvt_pk_bf16(wp[768], wp[896]);
        *(u32x4*)((bf16_t*)(ws + WS_W1T) + (size_t)fi * 8) = fw; }
    for (int j = 0; j < 2; ++j) conv_matrix(F, a.in[I_CW2] + (size_t)j * 128 * 128, 128, 128, (bf16_t*)(ws + WS_W2T) + (size_t)j * 128 * 128, base);
    { const float* x = a.in[I_X]; const float* g = a.in[I_N1G]; bf16_t* U = (bf16_t*)(ws + WS_U);
      f32x4 vn[8]; int row = F.bid * 8 + F.wid;
#define P0_LDROW(r_) do { const float* xr_ = x + (size_t)(r_) * DM; _Pragma("unroll") for (int i = 0; i < 4; ++i) { vn[2 * i] = *(const f32x4*)(xr_ + i * 512 + F.lane * 8); vn[2 * i + 1] = *(const f32x4*)(xr_ + i * 512 + F.lane * 8 + 4); } } while (0)
      if (row < NTOK) P0_LDROW(row);
      for (; row < NTOK; row += F.G * 8) {
          f32x4 v[8]; float ss = 0.f;
#pragma unroll
          for (int i = 0; i < 8; ++i) v[i] = vn[i];
          if (row + F.G * 8 < NTOK) P0_LDROW(row + F.G * 8);
#pragma unroll
          for (int i = 0; i < 8; ++i)
#pragma unroll
              for (int j = 0; j < 4; ++j) ss += v[i][j] * v[i][j];
          ss = wave_sum(ss); const float rs = rsqrtf(ss * (1.f / DM) + EPS);
#pragma unroll
          for (int i = 0; i < 4; ++i) { const f32x4 g0 = *(const f32x4*)(g + i * 512 + F.lane * 8), g1 = *(const f32x4*)(g + i * 512 + F.lane * 8 + 4);
              const f32x4 a0 = v[2 * i] * rs * g0, a1 = v[2 * i + 1] * rs * g1;
              u32x4 w; w[0] = cvt_pk_bf16(a0[0], a0[1]); w[1] = cvt_pk_bf16(a0[2], a0[3]); w[2] = cvt_pk_bf16(a1[0], a1[1]); w[3] = cvt_pk_bf16(a1[2], a1[3]);
              *(u32x4*)(U + (size_t)row * DM + i * 512 + F.lane * 8) = w; } }
#undef P0_LDROW
    }
    { const int gw = F.bid * 8 + F.wid;
      (void)gw;
      for (int i = F.bid * NTHREADS + F.tid; i < DM * NEXP; i += F.G * NTHREADS) ((float*)(ws + WS_WR2))[i] = a.in[I_N2G][i >> 5] * a.in[I_WR][i];
      for (int i = F.bid * NTHREADS + F.tid; i < HG_W; i += F.G * NTHREADS) { const float l0 = a.in[I_LBL][i], l1 = a.in[I_LBL][HG_W + i]; const float m = fmaxf(l0, l1);
          const float e0 = __expf(l0 - m), e1 = __expf(l1 - m); ((float*)(ws + WS_LB))[i] = e0 / (e0 + e1); } }
}

__device__ __forceinline__ float gelu_tanh(float x) { const float u = 0.7978845608028654f * (x + 0.044715f * x * x * x); return 0.5f * x * (1.f + tanhf(u)); }
__device__ __forceinline__ void p2_compress_naive(const Frame& F, const Args& a) {
    unsigned char* ws = F.ws; const bf16_t* PROJ = (const bf16_t*)(ws + WS_PROJ);
    LAS float* red = (LAS float*)F.lds;
    LAS float* hdn = red + 512;
    const int c = F.tid & 127, kq = F.tid >> 7;
    for (int u = F.bid; u < 2 * 16 * 128; u += F.G) {
        const int j = u >> 11, bg = (u >> 7) & 15, n = u & 127, b = bg >> 1, g = bg & 1;
        bf16_t* dst = (bf16_t*)(ws + (j ? WS_VC : WS_KC)) + ((size_t)bg * 128 + n) * 128;
        if (n == 127) { if (F.tid < 128) dst[F.tid] = 0; continue; }
        const float* w1 = a.in[I_CW1] + (size_t)j * 4096 * 128; const float* pos = a.in[I_CPOS] + (size_t)j * 4096;
        const int colb = (j ? C_VCM : C_KCM) + g * 128;
        float s = 0.f;
        for (int k = kq * 1024; k < kq * 1024 + 1024; ++k) { const int l = k >> 7, d = k & 127;
            const float av = bf2f(PROJ[(size_t)(b * SEQ + 16 * n + l) * PROJ_LD + colb + d]) + pos[k];
            s += av * w1[(size_t)k * 128 + c]; }
        red[kq * 128 + c] = s; __syncthreads();
        if (F.tid < 128) hdn[c] = gelu_tanh(red[c] + red[128 + c] + red[256 + c] + red[384 + c]);
        __syncthreads();
        if (F.tid < 128) { const float* w2 = a.in[I_CW2] + (size_t)j * 128 * 128; float o = 0.f; for (int k = 0; k < 128; ++k) o += hdn[k] * w2[k * 128 + c]; dst[c] = f2bf(o); }
        __syncthreads();
    }
}

__device__ __forceinline__ void hgrn_naive_unit(const Frame& F, const Args& a, int unit) {
    unsigned char* ws = F.ws; const bf16_t* PROJ = (const bf16_t*)(ws + WS_PROJ); bf16_t* YM = (bf16_t*)(ws + WS_YMIX);
    const float* lbv = (const float*)(ws + WS_LB);
    const int b = unit >> 3, h = unit & 7, v = F.tid & 127, kg = F.tid >> 7;
    LAS float* fs = (LAS float*)F.lds;
    LAS float* qs = fs + 2048; LAS float* is_ = qs + 2048; LAS float* red = is_ + 2048  ; LAS float* ob = red + 512  ;
    float S[32];
#pragma unroll
    for (int i = 0; i < 32; ++i) S[i] = 0.f;
    for (int t0 = 0; t0 < SEQ; t0 += 16) {
        for (int i = F.tid; i < 2048; i += NTHREADS) { const int st = i >> 7, k = i & 127; const size_t rowo = (size_t)(b * SEQ + t0 + st) * PROJ_LD + h * 128 + k;
            const float lb = lbv[h * 128 + k];
            fs[i] = lb + (1.f - lb) * sigmoidf_(bf2f(PROJ[rowo + C_HF])); qs[i] = siluf_(bf2f(PROJ[rowo + C_HQ])); is_[i] = bf2f(PROJ[rowo + C_HI]); }
        __syncthreads();
        for (int st = 0; st < 16; ++st) {
            const float iv = is_[st * 128 + v]; float po = 0.f;
#pragma unroll
            for (int kk = 0; kk < 32; ++kk) { const int k = kg * 32 + kk; const float f = fs[st * 128 + k]; S[kk] = f * S[kk] + (1.f - f) * iv; po += S[kk] * qs[st * 128 + k]; }
            red[kg * 128 + v] = po; __syncthreads();
            if (kg == 0) ob[st * 128 + v] = red[v] + red[128 + v] + red[256 + v] + red[384 + v];
            __syncthreads();
        }
        for (int s2 = 0; s2 < 2; ++s2) { const int st = F.wid * 2 + s2; const float o0 = ob[st * 128 + F.lane], o1 = ob[st * 128 + 64 + F.lane];
            const float ss = wave_sum(o0 * o0 + o1 * o1); const float rs = rsqrtf(ss * (1.f / 128.f) + EPS);
            const size_t row = (size_t)(b * SEQ + t0 + st);
            const float g0 = bf2f(PROJ[row * PROJ_LD + C_HGT + h * 128 + F.lane]), g1 = bf2f(PROJ[row * PROJ_LD + C_HGT + h * 128 + 64 + F.lane]);
            YM[row * DM + h * 128 + F.lane] = f2bf(o0 * rs * a.in[I_HGNG][F.lane] * siluf_(g0));
            YM[row * DM + h * 128 + 64 + F.lane] = f2bf(o1 * rs * a.in[I_HGNG][64 + F.lane] * siluf_(g1)); }
        __syncthreads();
    }
}

__device__ __forceinline__ float dot128_bf(const LAS float* q, const bf16_t* k) {
    float s = 0.f;
#pragma unroll
    for (int c = 0; c < 16; ++c) { const u32x4 w = *(const u32x4*)(k + c * 8); float f[8]; unpack8(w, f);
#pragma unroll
        for (int j = 0; j < 8; ++j) s += q[c * 8 + j] * f[j]; }
    return s;
}
__device__ __forceinline__ void softmax4(const Frame& F, LAS float* sc, int stride, int n, LAS float* tmp  ) {
    const int r = F.tid >> 7, i0 = F.tid & 127;
    float m = -INFINITY; for (int i = i0; i < n; i += 128) m = fmaxf(m, sc[r * stride + i]);
    m = wave_max(m); if (F.lane == 0) tmp[F.wid] = m; __syncthreads();
    m = fmaxf(tmp[2 * r], tmp[2 * r + 1]); __syncthreads();
    float s = 0.f;
    for (int i = i0; i < n; i += 128) { const float x = sc[r * stride + i]; const float p = (x == -INFINITY) ? 0.f : __expf(x - m); sc[r * stride + i] = p; s += p; }
    s = wave_sum(s); if (F.lane == 0) tmp[F.wid] = s; __syncthreads();
    s = tmp[2 * r] + tmp[2 * r + 1]; const float inv = s > 0.f ? 1.f / s : 0.f;
    for (int i = i0; i < n; i += 128) sc[r * stride + i] *= inv;
    __syncthreads();
}
__device__ __forceinline__ void attn_naive_unit(const Frame& F, const Args& a, int unit) {
    unsigned char* ws = F.ws; const bf16_t* PROJ = (const bf16_t*)(ws + WS_PROJ); bf16_t* YM = (bf16_t*)(ws + WS_YMIX);
    const int b = unit >> 12, g = (unit >> 11) & 1, t = unit & 2047, bg = b * 2 + g;
    LAS float* qs = (LAS float*)F.lds;
    LAS float* sc = qs + 512;
    LAS float* tmp = sc + 4096;
    LAS float* imp = tmp + 16;
    LAS int* selk = (LAS int*)(imp + 32);
    LAS float* oacc = (LAS float*)(selk + 32);
    const int r4 = F.tid >> 7, d = F.tid & 127;
    const size_t rowq = (size_t)(b * SEQ + t) * PROJ_LD;
    qs[F.tid] = bf2f(PROJ[rowq + C_NQ + (g * 4 + r4) * 128 + d]);
    const float slope = exp2f(-(float)(g * 4 + r4 + 1));
    const float scale = 0.08838834764831845f;
    float gate[3];
#pragma unroll
    for (int c = 0; c < 3; ++c) gate[c] = sigmoidf_(bf2f(PROJ[rowq + C_NGT + (g * 4 + r4) * 3 + c]));
    __syncthreads();
    { const int n = d; float s = -INFINITY;
      if (n < NCMP) { const int dist = t - (16 * n + 31); if (dist >= 0) s = dot128_bf(qs + r4 * 128, (const bf16_t*)(ws + WS_KC) + ((size_t)bg * 128 + n) * 128) * scale - slope * (float)dist; }
      sc[r4 * 1024 + n] = s; }
    __syncthreads();
    softmax4(F, sc, 1024, 128, tmp);
    { float o = 0.f; const bf16_t* vc = (const bf16_t*)(ws + WS_VC) + (size_t)bg * 128 * 128;
      for (int n = 0; n < NCMP; ++n) o += sc[r4 * 1024 + n] * bf2f(vc[n * 128 + d]);
      oacc[F.tid] = gate[0] * o; }
    if (F.tid < 32) { const int j = F.tid; float s = 0.f;
        for (int r = 0; r < 4; ++r) for (int q = -1; q <= 3; ++q) { const int n = 4 * j + q; if (n >= 0 && n < NCMP) s += ((q == -1 || q == 3) ? 1.f : 2.f) * sc[r * 1024 + n]; }
        const int cur = t >> 6; const bool forced = (j == 0) || (j == cur) || (j == cur - 1);
        imp[j] = forced ? 1e4f : (j <= cur ? s : -1e4f); }
    __syncthreads();
    if (F.tid < 32) { const int j = F.tid; const float me = imp[j]; int rank = 0;
        for (int k = 0; k < 32; ++k) { const float o = imp[k]; rank += (o > me || (o == me && k < j)) ? 1 : 0; }
        const bool sel = rank < SEL_TOP && j <= (t >> 6);
        const unsigned long long mask = __ballot(sel);
        if (sel) selk[__popcll(mask & ((1ull << j) - 1ull))] = j;
        if (j == 0) selk[16] = __popcll(mask); }
    __syncthreads();
    { const int nsel = selk[16];
      for (int i = F.tid; i < 4 * 1024; i += NTHREADS) sc[i] = -INFINITY;
      __syncthreads();
      const int l = F.tid & 63, r = (F.tid >> 6) & 3, which = F.tid >> 8;
      for (int s0 = 0; s0 < nsel; s0 += 2) { const int si = s0 + which;
          if (si < nsel) { const int kp = selk[si] * 64 + l;
              if (kp <= t) { const float s = dot128_bf(qs + r * 128, PROJ + (size_t)(b * SEQ + kp) * PROJ_LD + C_KSL + g * 128) * scale - exp2f(-(float)(g * 4 + r + 1)) * (float)(t - kp); sc[r * 1024 + si * 64 + l] = s; } } }
      __syncthreads();
      softmax4(F, sc, 1024, nsel * 64, tmp);
      float o = 0.f;
      for (int si = 0; si < nsel; ++si) { const int kb = selk[si] * 64;
          for (int l2 = 0; l2 < 64; ++l2) { const int kp = kb + l2; if (kp > t) break; o += sc[r4 * 1024 + si * 64 + l2] * bf2f(PROJ[(size_t)(b * SEQ + kp) * PROJ_LD + C_VSL + g * 128 + d]); } }
      oacc[F.tid] += gate[1] * o; }
    __syncthreads();
    { for (int i = F.tid; i < 4 * 1024; i += NTHREADS) sc[i] = -INFINITY;
      __syncthreads();
      for (int i = F.tid; i < 4 * 512; i += NTHREADS) { const int r = i >> 9, w = i & 511, kp = t - 511 + w;
          if (kp >= 0) sc[r * 1024 + w] = dot128_bf(qs + r * 128, PROJ + (size_t)(b * SEQ + kp) * PROJ_LD + C_KWN + g * 128) * scale - exp2f(-(float)(g * 4 + r + 1)) * (float)(t - kp); }
      __syncthreads();
      softmax4(F, sc, 1024, 512, tmp);
      float o = 0.f;
      for (int w = 0; w < 512; ++w) { const int kp = t - 511 + w; if (kp >= 0) o += sc[r4 * 1024 + w] * bf2f(PROJ[(size_t)(b * SEQ + kp) * PROJ_LD + C_VWN + g * 128 + d]); }
      oacc[F.tid] += gate[2] * o; }
    __syncthreads();
    { const float o = oacc[F.tid]; float ss = wave_sum(o * o); if (F.lane == 0) tmp[F.wid] = ss; __syncthreads();
      ss = tmp[2 * r4] + tmp[2 * r4 + 1]; const float rs = rsqrtf(ss * (1.f / 128.f) + EPS);
      YM[(size_t)(b * SEQ + t) * DM + HG_W + (g * 4 + r4) * 128 + d] = f2bf(o * rs * a.in[I_NSAG][d]); }
    __syncthreads();
}

namespace at {
constexpr int SHM_T = 64 * 128 * 2;
constexpr int BUF_B = 2 * SHM_T;
constexpr int OFF_V = 0, OFF_K = SHM_T, OFF_IMP = 2 * BUF_B  , OFF_SELM = 3 * BUF_B, OFF_WSC = OFF_SELM + 256;
constexpr float SCALE = 0.08838834764831845f, LOG2E = 1.4426950408889634f, THR = 8.f;
#define AT_KSWZ(row, colB) ((row) * 256 + ((colB) ^ (((row) & 7) << 4)))
__device__ __forceinline__ int v_st(int k, int c) { const int kk = (k & ~0xC) | ((k & 4) << 1) | ((k & 8) >> 1); return ((kk >> 3) * 4 + (c >> 5)) * 512 + ((kk & 7) * 32 + (c & 31)) * 2; }
__device__ __forceinline__ int v_rd_base(int lane) { return ((lane & 3) << 3) | (((lane >> 2) & 3) << 6) | (((lane >> 4) & 1) << 5) | (((lane >> 5) & 1) << 8); }
__device__ __forceinline__ int crow(int r, int hi) { return (r & 3) + 8 * (r >> 2) + 4 * hi; }
typedef short s16x4 __attribute__((ext_vector_type(4)));
struct Stage { u32x4 k0, k1, v0, v1; };
__device__ __forceinline__ void stage_load(Stage& S, const bf16_t* Kp, const bf16_t* Vp, int ld, int row0, int sr, int sc) {
    S.k0 = *(const u32x4*)(Kp + (size_t)(row0 + sr) * ld + sc); S.k1 = *(const u32x4*)(Kp + (size_t)(row0 + 32 + sr) * ld + sc);
    S.v0 = *(const u32x4*)(Vp + (size_t)(row0 + sr) * ld + sc); S.v1 = *(const u32x4*)(Vp + (size_t)(row0 + 32 + sr) * ld + sc);
}
__device__ __forceinline__ void stage_write(const Stage& S, LAS unsigned char* lds, int buf, int sr, int sc) {
    const int kws = AT_KSWZ(sr, sc * 2);
    *(LAS u32x4*)(lds + OFF_K + buf * BUF_B + kws) = S.k0; *(LAS u32x4*)(lds + OFF_K + buf * BUF_B + kws + 32 * 256) = S.k1;
    *(LAS u32x4*)(lds + OFF_V + buf * BUF_B + v_st(sr, sc)) = S.v0; *(LAS u32x4*)(lds + OFF_V + buf * BUF_B + v_st(32 + sr, sc)) = S.v1;
}
__device__ __forceinline__ void qkt(f32x16& p0, f32x16& p1, const LAS unsigned char* ktile, int r32, int hi, const bf16x8 (&qr)[8]) {
#pragma unroll
    for (int r = 0; r < 16; ++r) { p0[r] = 0.f; p1[r] = 0.f; }
    const LAS unsigned char* kb[4];
#pragma unroll
    for (int dd = 0; dd < 4; ++dd) kb[dd] = ktile + AT_KSWZ(r32, (dd * 16 + hi * 8) * 2);
#pragma unroll
    for (int d0 = 0; d0 < 8; ++d0) { const LAS unsigned char* a = kb[d0 & 3] + (d0 >> 2) * 128;
        const bf16x8 b0 = *(const LAS bf16x8*)a; const bf16x8 b1 = *(const LAS bf16x8*)(a + 32 * 256);
        p0 = __builtin_amdgcn_mfma_f32_32x32x16_bf16(b0, qr[d0], p0, 0, 0, 0);
        p1 = __builtin_amdgcn_mfma_f32_32x32x16_bf16(b1, qr[d0], p1, 0, 0, 0); }
}
__device__ __forceinline__ void pv_tile(f32x16 (&o)[4], int vb, bf16x8 pa0, bf16x8 pa1, bf16x8 pa2, bf16x8 pa3) {
#define AT_TRRD(dst, off) asm volatile("ds_read_b64_tr_b16 %0, %1 offset:%2" : "=&v"(dst) : "v"(vb), "i"(off) : "memory")
#define AT_PV_D0(d0) do { s16x4 l0, l1, l2, l3, h0, h1, h2, h3; constexpr int b_ = (d0) * 512; \
        AT_TRRD(l0, b_); AT_TRRD(h0, b_ + 2048); AT_TRRD(l1, b_ + 4096); AT_TRRD(h1, b_ + 6144); AT_TRRD(l2, b_ + 8192); AT_TRRD(h2, b_ + 10240); AT_TRRD(l3, b_ + 12288); AT_TRRD(h3, b_ + 14336); \
        asm volatile("s_waitcnt lgkmcnt(0)" ::: "memory"); __builtin_amdgcn_sched_barrier(0); \
        o[d0] = __builtin_amdgcn_mfma_f32_32x32x16_bf16(pa0, (bf16x8){l0[0], l0[1], l0[2], l0[3], h0[0], h0[1], h0[2], h0[3]}, o[d0], 0, 0, 0); \
        o[d0] = __builtin_amdgcn_mfma_f32_32x32x16_bf16(pa1, (bf16x8){l1[0], l1[1], l1[2], l1[3], h1[0], h1[1], h1[2], h1[3]}, o[d0], 0, 0, 0); \
        o[d0] = __builtin_amdgcn_mfma_f32_32x32x16_bf16(pa2, (bf16x8){l2[0], l2[1], l2[2], l2[3], h2[0], h2[1], h2[2], h2[3]}, o[d0], 0, 0, 0); \
        o[d0] = __builtin_amdgcn_mfma_f32_32x32x16_bf16(pa3, (bf16x8){l3[0], l3[1], l3[2], l3[3], h3[0], h3[1], h3[2], h3[3]}, o[d0], 0, 0, 0); } while (0)
    AT_PV_D0(0); AT_PV_D0(1); AT_PV_D0(2); AT_PV_D0(3);
#undef AT_PV_D0
#undef AT_TRRD
}
__device__ __forceinline__ float swap_max(float v) { auto rr = __builtin_amdgcn_permlane32_swap(__float_as_uint(v), __float_as_uint(v), false, false); return fmaxf(__uint_as_float(rr[0]), __uint_as_float(rr[1])); }
__device__ __forceinline__ float swap_sum(float v) { auto rr = __builtin_amdgcn_permlane32_swap(__float_as_uint(v), __float_as_uint(v), false, false); return __uint_as_float(rr[0]) + __uint_as_float(rr[1]); }
__device__ __forceinline__ void pack_p(const f32x16& P, bf16x8& outA, bf16x8& outB) {
#define AT_PK4(B_, OUT) do { unsigned a0 = cvt_pk_bf16(P[B_ + 0], P[B_ + 1]), a1 = cvt_pk_bf16(P[B_ + 2], P[B_ + 3]); \
        unsigned b0 = cvt_pk_bf16(P[B_ + 4], P[B_ + 5]), b1 = cvt_pk_bf16(P[B_ + 6], P[B_ + 7]); \
        auto r0 = __builtin_amdgcn_permlane32_swap(a0, b0, false, false); auto r1 = __builtin_amdgcn_permlane32_swap(a1, b1, false, false); \
        u32x4 w = {r0[0], r1[0], r0[1], r1[1]}; OUT = *reinterpret_cast<bf16x8*>(&w); } while (0)
    AT_PK4(0, outA); AT_PK4(8, outB);
#undef AT_PK4
}
__device__ __forceinline__ float online_sm1(const f32x16& p0, const f32x16& p1, float& m_reg, float& mnL) {
    float pmax = p0[0];
#pragma unroll
    for (int r = 1; r < 16; ++r) pmax = fmaxf(pmax, p0[r]);
#pragma unroll
    for (int r = 0; r < 16; ++r) pmax = fmaxf(pmax, p1[r]);
    pmax = swap_max(pmax);
    float mn, alpha;
    if (__all(pmax - m_reg <= THR)) { mn = m_reg; alpha = 1.f; }
    else { mn = fmaxf(m_reg, pmax); alpha = __builtin_amdgcn_exp2f((m_reg - mn) * LOG2E); m_reg = mn; }
    mnL = -mn * LOG2E;
    return alpha;
}
__device__ __forceinline__ void online_sm2(f32x16& p0, f32x16& p1, float mnL, float alpha, float& l_reg) {
    float ps = 0.f;
#pragma unroll
    for (int r = 0; r < 16; ++r) { p0[r] = __builtin_amdgcn_exp2f(fmaf(p0[r], LOG2E, mnL)); p1[r] = __builtin_amdgcn_exp2f(fmaf(p1[r], LOG2E, mnL)); ps += p0[r] + p1[r]; }
    ps = swap_sum(ps);
    l_reg = l_reg * alpha + ps;
}
template <int MODE>
__device__ __forceinline__ void branch_loop(f32x16 (&o)[4], float& l_out, LAS unsigned char* lds, const bf16_t* Kp, const bf16_t* Vp, int jlo, int qt,
                                            const bf16x8 (&qr)[8], int tq, float slope, unsigned selbits, int r32, int hi, int sr, int sc, LAS float* wsc, int wave_tmin, int grpB) {
    float m_reg = -1e30f, l_reg = 0.f;
#pragma unroll
    for (int d = 0; d < 4; ++d)
#pragma unroll
        for (int r = 0; r < 16; ++r) o[d][r] = 0.f;
    const int vb0 = (int)(uintptr_t)(lds + OFF_V) + v_rd_base(r32 + 32 * hi);
    const int NT = qt - jlo + 1;
#define AT_LGKM0() asm volatile("s_waitcnt lgkmcnt(0)" ::: "memory")
#define AT_BAR() do { AT_LGKM0(); __builtin_amdgcn_s_barrier(); asm volatile("" ::: "memory"); } while (0)
    Stage S0, S1; stage_load(S0, Kp, Vp, PROJ_LD, jlo * 64, sr, sc); stage_write(S0, lds, 0, sr, sc);
    if (NT > 1) { stage_load(S1, Kp, Vp, PROJ_LD, (jlo + 1) * 64, sr, sc); stage_write(S1, lds, 1, sr, sc); }
    if (NT > 2) stage_load(S0, Kp, Vp, PROJ_LD, (jlo + 2) * 64, sr, sc);
    if (NT > 3) stage_load(S1, Kp, Vp, PROJ_LD, (jlo + 3) * 64, sr, sc);
    __syncthreads();
    if (grpB) AT_BAR();
    int buf = 0;
#define AT_STEP(tau, SX) do { \
        const int j = jlo + (tau); \
        f32x16 p0, p1; \
        qkt(p0, p1, lds + OFF_K + buf * BUF_B, r32, hi, qr); \
        const int kbase = j * 64; const int dq = tq - kbase - 4 * hi; \
        const float base_f = slope * (float)(-dq); \
        _Pragma("unroll") for (int r = 0; r < 16; ++r) { const int cc = (r & 3) + 8 * (r >> 2); \
            p0[r] = fmaf(p0[r], SCALE, fmaf(slope, (float)cc, base_f)); p1[r] = fmaf(p1[r], SCALE, fmaf(slope, (float)(cc + 32), base_f)); } \
        if (MODE == 1) { \
            const bool on = (selbits >> j) & 1u; \
            if (j == qt) { \
                _Pragma("unroll") for (int r = 0; r < 16; ++r) { const int cc = (r & 3) + 8 * (r >> 2); if (!on || cc > dq) p0[r] = -INFINITY; if (!on || cc + 32 > dq) p1[r] = -INFINITY; } \
            } else if (!__all(on)) { \
                _Pragma("unroll") for (int r = 0; r < 16; ++r) { if (!on) { p0[r] = -INFINITY; p1[r] = -INFINITY; } } \
            } \
        } else { \
            if (kbase + 63 > wave_tmin || kbase < wave_tmin + 31 - (WINDOW - 1)) { \
                _Pragma("unroll") for (int r = 0; r < 16; ++r) { const int cc = (r & 3) + 8 * (r >> 2); \
                    if ((unsigned)(dq - cc) >= (unsigned)WINDOW) p0[r] = -INFINITY; if ((unsigned)(dq - cc - 32) >= (unsigned)WINDOW) p1[r] = -INFINITY; } \
            } \
        } \
        float mnL; const float alpha = online_sm1(p0, p1, m_reg, mnL); \
        AT_BAR(); \
        if ((tau) + 2 < NT) { int b2 = buf + 2; if (b2 >= 3) b2 -= 3; stage_write(SX, lds, b2, sr, sc); } \
        if ((tau) + 4 < NT) stage_load(SX, Kp, Vp, PROJ_LD, (j + 4) * 64, sr, sc); \
        online_sm2(p0, p1, mnL, alpha, l_reg); \
        bf16x8 pa0, pa1, pa2, pa3; pack_p(p0, pa0, pa1); pack_p(p1, pa2, pa3); \
        if (__any(alpha < 1.f)) { if (hi == 0) wsc[r32] = alpha; \
            _Pragma("unroll") for (int r = 0; r < 16; ++r) { const float al = wsc[crow(r, hi)]; \
                _Pragma("unroll") for (int d = 0; d < 4; ++d) o[d][r] *= al; } } \
        pv_tile(o, vb0 + buf * BUF_B, pa0, pa1, pa2, pa3); \
        AT_BAR(); \
        buf = buf + 1; if (buf >= 3) buf = 0; } while (0)
    for (int tau = 0; tau < NT; tau += 2) {
        AT_STEP(tau, S0);
        if (tau + 1 < NT) AT_STEP(tau + 1, S1);
    }
#undef AT_STEP
    if (!grpB) AT_BAR();
#undef AT_BAR
#undef AT_LGKM0
    l_out = l_reg;
    __syncthreads();
}
}

__device__ __forceinline__ void attn_fast_unit(const Frame& F, const Args& a, int unit) {
    using namespace at;
    unsigned char* ws = F.ws; const bf16_t* PROJ = (const bf16_t*)(ws + WS_PROJ); bf16_t* YM = (bf16_t*)(ws + WS_YMIX);
    LAS unsigned char* lds = F.lds;
    const int qt = 31 - (unit >> 4), bg = unit & 15, b = bg >> 1, g = bg & 1;
    int tz = threadIdx.x; asm volatile("" : "+v"(tz));
    const int lane = tz & 63, r32 = lane & 31, hi = lane >> 5, head = F.wid & 3, qh = F.wid >> 2;
    const int t0 = qt * 64, tq = t0 + qh * 32 + r32, wave_tmin = t0 + qh * 32;
    const int sr = tz >> 4, sc = (tz & 15) * 8;
    const float slope = exp2f(-(float)(g * 4 + head + 1));
    LAS float* wsc = (LAS float*)(lds + OFF_WSC) + F.wid * 256;
    LAS float* imph = (LAS float*)(lds + OFF_IMP);
    LAS unsigned* selm = (LAS unsigned*)(lds + OFF_SELM);
    bf16x8 qr[8];
    { const bf16_t* qp = PROJ + (size_t)(b * SEQ + tq) * PROJ_LD + C_NQ + (g * 4 + head) * 128 + hi * 8;
#pragma unroll
      for (int d0 = 0; d0 < 8; ++d0) qr[d0] = *(const bf16x8*)(qp + d0 * 16); }
    float gate[3];
    { const bf16_t* gp = PROJ + (size_t)(b * SEQ + tq) * PROJ_LD + C_NGT + (g * 4 + head) * 3;
#pragma unroll
      for (int c = 0; c < 3; ++c) gate[c] = sigmoidf_(bf2f(gp[c])); }
    f32x16 o[4];
    float* otp = (float*)(ws + WS_OT) + ((size_t)F.bid * 512 + tz) * 64;
    { const bf16_t* Kc = (const bf16_t*)(ws + WS_KC) + (size_t)bg * 128 * 128; const bf16_t* Vc = (const bf16_t*)(ws + WS_VC) + (size_t)bg * 128 * 128;
      Stage S; stage_load(S, Kc, Vc, 128, 0, sr, sc); stage_write(S, lds, 0, sr, sc);
      stage_load(S, Kc, Vc, 128, 64, sr, sc); stage_write(S, lds, 1, sr, sc);
      __syncthreads();
      f32x16 p0, p1, p2, p3;
      qkt(p0, p1, lds + OFF_K, r32, hi, qr); qkt(p2, p3, lds + OFF_K + BUF_B, r32, hi, qr);
      const int dl0 = ((tq - 31) >> 4) - 4 * hi;
      const float base_f = slope * (float)(16 * 4 * hi + 31 - tq);
      float mx = -INFINITY;
#pragma unroll
      for (int r = 0; r < 16; ++r) { const int cc = (r & 3) + 8 * (r >> 2);
          p0[r] = (cc <= dl0)      ? fmaf(p0[r], SCALE, fmaf(slope, (float)(16 * cc), base_f))        : -INFINITY;
          p1[r] = (cc + 32 <= dl0) ? fmaf(p1[r], SCALE, fmaf(slope, (float)(16 * (cc + 32)), base_f)) : -INFINITY;
          p2[r] = (cc + 64 <= dl0) ? fmaf(p2[r], SCALE, fmaf(slope, (float)(16 * (cc + 64)), base_f)) : -INFINITY;
          p3[r] = (cc + 96 <= dl0) ? fmaf(p3[r], SCALE, fmaf(slope, (float)(16 * (cc + 96)), base_f)) : -INFINITY;
          mx = fmaxf(fmaxf(mx, p0[r]), fmaxf(p1[r], fmaxf(p2[r], p3[r]))); }
      mx = swap_max(mx);
      const float mL = (mx == -INFINITY) ? 0.f : -mx * LOG2E;
      float ps = 0.f;
#pragma unroll
      for (int r = 0; r < 16; ++r) { p0[r] = __builtin_amdgcn_exp2f(fmaf(p0[r], LOG2E, mL)); p1[r] = __builtin_amdgcn_exp2f(fmaf(p1[r], LOG2E, mL));
          p2[r] = __builtin_amdgcn_exp2f(fmaf(p2[r], LOG2E, mL)); p3[r] = __builtin_amdgcn_exp2f(fmaf(p3[r], LOG2E, mL)); ps += (p0[r] + p1[r]) + (p2[r] + p3[r]); }
      ps = swap_sum(ps);
      const float inv = ps > 0.f ? 1.f / ps : 0.f;
#pragma unroll
      for (int r = 0; r < 16; ++r) { p0[r] *= inv; p1[r] *= inv; p2[r] *= inv; p3[r] *= inv; }
      { LAS float* dst = imph + ((size_t)head * 64 + qh * 32 + r32) * 32;
        float prev = 0.f;
#define AT_GRP(P, blk) do { _Pragma("unroll") for (int i = 0; i < 4; ++i) { const float av = 2.f * (P[4 * i] + P[4 * i + 1] + P[4 * i + 2]) + P[4 * i + 3]; const float bv = P[4 * i + 3]; \
            auto rr = __builtin_amdgcn_permlane32_swap(__float_as_uint(bv), __float_as_uint(bv), false, false); const float pb = __uint_as_float(hi ? rr[0] : rr[1]); \
            dst[2 * ((blk) * 4 + i) + hi] = av + (hi ? pb : prev); prev = pb; } } while (0)
        AT_GRP(p0, 0); AT_GRP(p1, 1); AT_GRP(p2, 2); AT_GRP(p3, 3);
#undef AT_GRP
      }
      bf16x8 pa0, pa1, pa2, pa3;
#pragma unroll
      for (int d = 0; d < 4; ++d)
#pragma unroll
          for (int r = 0; r < 16; ++r) o[d][r] = 0.f;
      const int vb0 = (int)(uintptr_t)(lds + OFF_V) + v_rd_base(lane);
      pack_p(p0, pa0, pa1); pack_p(p1, pa2, pa3); pv_tile(o, vb0, pa0, pa1, pa2, pa3);
      pack_p(p2, pa0, pa1); pack_p(p3, pa2, pa3); pv_tile(o, vb0 + BUF_B, pa0, pa1, pa2, pa3);
      if (hi == 0) wsc[r32] = gate[0];
#pragma unroll
      for (int r = 0; r < 16; ++r) { const float f = wsc[crow(r, hi)];
#pragma unroll
          for (int d = 0; d < 4; ++d) o[d][r] *= f; }
#pragma unroll
      for (int d = 0; d < 4; ++d)
#pragma unroll
          for (int k = 0; k < 4; ++k) *(f32x4*)(otp + d * 16 + 4 * k) = (f32x4){o[d][4 * k], o[d][4 * k + 1], o[d][4 * k + 2], o[d][4 * k + 3]};
    }
    __syncthreads();
    { const int q = tz >> 3, part = tz & 7, tqq = t0 + q, cur = tqq >> 6;
      unsigned bits = 0u;
      if (cur < SEL_TOP) { bits = (part == 0) ? ((2u << cur) - 1u) : 0u; }
      else {
          float sc_[4];
#pragma unroll
          for (int k = 0; k < 4; ++k) { const int j = part * 4 + k; const float v = ((imph[(0 * 64 + q) * 32 + j] + imph[(1 * 64 + q) * 32 + j]) + imph[(2 * 64 + q) * 32 + j]) + imph[(3 * 64 + q) * 32 + j];
              const bool forced = (j == 0) || (j == cur) || (j == cur - 1); sc_[k] = forced ? 1e4f : (j <= cur ? v : -1e4f); }
          int rank[4] = {0, 0, 0, 0};
          for (int jj = 0; jj < 32; ++jj) { const float v = ((imph[(0 * 64 + q) * 32 + jj] + imph[(1 * 64 + q) * 32 + jj]) + imph[(2 * 64 + q) * 32 + jj]) + imph[(3 * 64 + q) * 32 + jj];
              const bool forced = (jj == 0) || (jj == cur) || (jj == cur - 1); const float s2 = forced ? 1e4f : (jj <= cur ? v : -1e4f);
#pragma unroll
              for (int k = 0; k < 4; ++k) { const int j = part * 4 + k; rank[k] += (s2 > sc_[k] || (s2 == sc_[k] && jj < j)) ? 1 : 0; } }
#pragma unroll
          for (int k = 0; k < 4; ++k) { const int j = part * 4 + k; if (rank[k] < SEL_TOP && j <= cur) bits |= 1u << j; }
      }
      bits |= __shfl_xor(bits, 1); bits |= __shfl_xor(bits, 2); bits |= __shfl_xor(bits, 4);
      if (part == 0) selm[q] = bits; }
    __syncthreads();
    const unsigned selbits = selm[qh * 32 + r32];
    { float l_sel;
      branch_loop<1>(o, l_sel, lds, PROJ + (size_t)(b * SEQ) * PROJ_LD + C_KSL + g * 128, PROJ + (size_t)(b * SEQ) * PROJ_LD + C_VSL + g * 128, 0, qt, qr, tq, slope, selbits, r32, hi, sr, sc, wsc, wave_tmin, qh);
      if (hi == 0) wsc[r32] = gate[1] / l_sel;
#pragma unroll
      for (int r = 0; r < 16; ++r) { const float f = wsc[crow(r, hi)];
#pragma unroll
          for (int d = 0; d < 4; ++d) o[d][r] *= f; }
#pragma unroll
      for (int d = 0; d < 4; ++d)
#pragma unroll
          for (int k = 0; k < 4; ++k) { const f32x4 pv = *(const f32x4*)(otp + d * 16 + 4 * k); *(f32x4*)(otp + d * 16 + 4 * k) = pv + (f32x4){o[d][4 * k], o[d][4 * k + 1], o[d][4 * k + 2], o[d][4 * k + 3]}; } }
    { float l_win; const int jlo = (t0 - (WINDOW - 1)) > 0 ? (t0 - (WINDOW - 1)) >> 6 : 0;
      branch_loop<2>(o, l_win, lds, PROJ + (size_t)(b * SEQ) * PROJ_LD + C_KWN + g * 128, PROJ + (size_t)(b * SEQ) * PROJ_LD + C_VWN + g * 128, jlo, qt, qr, tq, slope, 0u, r32, hi, sr, sc, wsc, wave_tmin, qh);
      if (hi == 0) wsc[r32] = gate[2] / l_win;
#pragma unroll
      for (int r = 0; r < 16; ++r) { const float f = wsc[crow(r, hi)];
#pragma unroll
          for (int d = 0; d < 4; ++d) o[d][r] *= f; }
#pragma unroll
      for (int d = 0; d < 4; ++d)
#pragma unroll
          for (int k = 0; k < 4; ++k) { const f32x4 pv = *(const f32x4*)(otp + d * 16 + 4 * k); o[d][4 * k] += pv[0]; o[d][4 * k + 1] += pv[1]; o[d][4 * k + 2] += pv[2]; o[d][4 * k + 3] += pv[3]; } }
    { const float* ng = a.in[I_NSAG];
      float gsc[4];
#pragma unroll
      for (int d = 0; d < 4; ++d) gsc[d] = ng[d * 32 + r32];
#pragma unroll
      for (int r = 0; r < 16; ++r) { float ss = 0.f;
#pragma unroll
          for (int d = 0; d < 4; ++d) ss += o[d][r] * o[d][r];
          ss += __shfl_xor(ss, 1); ss += __shfl_xor(ss, 2); ss += __shfl_xor(ss, 4); ss += __shfl_xor(ss, 8); ss += __shfl_xor(ss, 16);
          const float rs = rsqrtf(ss * (1.f / 128.f) + EPS);
          const int row = b * SEQ + t0 + qh * 32 + crow(r, hi);
          bf16_t* yp = YM + (size_t)row * DM + HG_W + (g * 4 + head) * 128 + r32;
#pragma unroll
          for (int d = 0; d < 4; ++d) yp[d * 32] = f2bf(o[d][r] * rs * gsc[d]); } }
    __syncthreads();
}

namespace hg {
constexpr int T_KD = 0, T_QD = 16384, T_V = 32768, T_KL = 49152, T_FR = 65536, T_QR = 81920, T_OR = 98304, T_PART = 114688, T_DL = T_PART + 2048, T_SSQ = T_DL + 512;
}
__device__ __forceinline__ void hgrn_fast_unit(const Frame& F, const Args& a, int unit) {
    using namespace hg; using at::crow; using at::v_st; using at::v_rd_base; typedef at::s16x4 s16x4;
    unsigned char* ws = F.ws; const bf16_t* PROJ = (const bf16_t*)(ws + WS_PROJ); bf16_t* YM = (bf16_t*)(ws + WS_YMIX);
    LAS unsigned char* lds = F.lds;
    const int b = unit >> 3, h = unit & 7;
    int tz = threadIdx.x; asm volatile("" : "+v"(tz));
    const int lane = tz & 63, r32 = lane & 31, hi = lane >> 5, th = F.wid & 1, vq = F.wid >> 1;
    const int lr = tz >> 4, lc = (tz & 15) * 8;
    const int kc = tz & 127, tg = tz >> 7;
    LAS float* part = (LAS float*)(lds + T_PART); LAS float* dl = (LAS float*)(lds + T_DL); LAS float* ssq = (LAS float*)(lds + T_SSQ);
    f32x16 Sacc[4];
#pragma unroll
    for (int k = 0; k < 4; ++k)
#pragma unroll
        for (int r = 0; r < 16; ++r) Sacc[k][r] = 0.f;
    const bf16_t* base = PROJ + (size_t)(b * SEQ) * PROJ_LD + h * 128;
    u32x4 rf0, rf1, rq0, rq1, ri0, ri1, ro0, ro1;
    const bf16_t* obase = (const bf16_t*)(ws + WS_OMF) + (size_t)(b * SEQ) * HG_W + h * 128;
#define HG_LOAD(t0_) do { const bf16_t* p0_ = base + (size_t)((t0_) + lr) * PROJ_LD + lc; const bf16_t* p1_ = p0_ + (size_t)32 * PROJ_LD; \
        rf0 = *(const u32x4*)(p0_ + C_HF); rf1 = *(const u32x4*)(p1_ + C_HF); rq0 = *(const u32x4*)(p0_ + C_HQ); rq1 = *(const u32x4*)(p1_ + C_HQ); \
        ri0 = *(const u32x4*)(p0_ + C_HI); ri1 = *(const u32x4*)(p1_ + C_HI); \
        ro0 = *(const u32x4*)(obase + (size_t)((t0_) + lr) * HG_W + lc); ro1 = *(const u32x4*)(obase + (size_t)((t0_) + lr + 32) * HG_W + lc); } while (0)
    HG_LOAD(0);
    const float ngv = a.in[I_HGNG][vq * 32 + r32];
    for (int c = 0; c < SEQ / 64; ++c) {
        const int t0 = c * 64;
        *(LAS u32x4*)(lds + T_FR + lr * 256 + lc * 2) = rf0; *(LAS u32x4*)(lds + T_FR + (lr + 32) * 256 + lc * 2) = rf1;
        *(LAS u32x4*)(lds + T_QR + lr * 256 + lc * 2) = rq0; *(LAS u32x4*)(lds + T_QR + (lr + 32) * 256 + lc * 2) = rq1;
        *(LAS u32x4*)(lds + T_OR + lr * 256 + lc * 2) = ro0; *(LAS u32x4*)(lds + T_OR + (lr + 32) * 256 + lc * 2) = ro1;
        *(LAS u32x4*)(lds + T_V + v_st(lr, lc)) = ri0; *(LAS u32x4*)(lds + T_V + v_st(lr + 32, lc)) = ri1;
        __syncthreads();
        float lf[16]; float run = 0.f;
#pragma unroll
        for (int i = 0; i < 16; ++i) { const int t = tg * 16 + i; run += bf2f(*(const LAS bf16_t*)(lds + T_FR + t * 256 + kc * 2)); lf[i] = run; }
        part[tg * 128 + kc] = run;
        __syncthreads();
        { const float p0_ = part[kc], p1_ = part[128 + kc], p2_ = part[256 + kc], p3_ = part[384 + kc];
          const float pre = (tg > 0 ? p0_ : 0.f) + (tg > 1 ? p1_ : 0.f) + (tg > 2 ? p2_ : 0.f); const float tot = ((p0_ + p1_) + p2_) + p3_;
          const float dlast = __builtin_amdgcn_exp2f(tot);
          if (tg == 0) dl[kc] = dlast;
#pragma unroll
          for (int i = 0; i < 16; ++i) { const int t = tg * 16 + i; const float bb = pre + lf[i];
              const float qv = bf2f(*(const LAS bf16_t*)(lds + T_QR + t * 256 + kc * 2)), om = bf2f(*(const LAS bf16_t*)(lds + T_OR + t * 256 + kc * 2));
              const float qd = qv * __builtin_amdgcn_exp2f(bb), kd = om * __builtin_amdgcn_exp2f(-bb), kl = kd * dlast;
              const int ko = AT_KSWZ(t, kc * 2);
              *(LAS bf16_t*)(lds + T_QD + ko) = f2bf(qd); *(LAS bf16_t*)(lds + T_KD + ko) = f2bf(kd); *(LAS bf16_t*)(lds + T_KL + v_st(t, kc)) = f2bf(kl); } }
        __syncthreads();
        if (c + 1 < SEQ / 64) HG_LOAD(t0 + 64);
        const int tl = th * 32 + r32;
        bf16x8 qr[8];
#pragma unroll
        for (int d0 = 0; d0 < 8; ++d0) qr[d0] = *(const LAS bf16x8*)(lds + T_QD + AT_KSWZ(tl, (d0 * 16 + hi * 8) * 2));
        f32x16 p0, p1;
        at::qkt(p0, p1, lds + T_KD, r32, hi, qr);
#pragma unroll
        for (int r = 0; r < 16; ++r) { const int s = crow(r, hi); if (s > tl) p0[r] = 0.f; if (s + 32 > tl) p1[r] = 0.f; }
        bf16x8 pa0, pa1, pa2, pa3; at::pack_p(p0, pa0, pa1); at::pack_p(p1, pa2, pa3);
        f32x16 o;
#pragma unroll
        for (int r = 0; r < 16; ++r) o[r] = 0.f;
        const int vb = (int)(uintptr_t)(lds + T_V) + v_rd_base(lane) + vq * 512;
        const int klb = (int)(uintptr_t)(lds + T_KL) + v_rd_base(lane);
#define HG_TRRD(dst, addr, off) asm volatile("ds_read_b64_tr_b16 %0, %1 offset:%2" : "=&v"(dst) : "v"(addr), "i"(off) : "memory")
        s16x4 vl0, vh0, vl1, vh1, vl2, vh2, vl3, vh3;
        HG_TRRD(vl0, vb, 0); HG_TRRD(vh0, vb, 2048); HG_TRRD(vl1, vb, 4096); HG_TRRD(vh1, vb, 6144); HG_TRRD(vl2, vb, 8192); HG_TRRD(vh2, vb, 10240); HG_TRRD(vl3, vb, 12288); HG_TRRD(vh3, vb, 14336);
        asm volatile("s_waitcnt lgkmcnt(0)" ::: "memory"); __builtin_amdgcn_sched_barrier(0);
        const bf16x8 vf0 = (bf16x8){vl0[0], vl0[1], vl0[2], vl0[3], vh0[0], vh0[1], vh0[2], vh0[3]}, vf1 = (bf16x8){vl1[0], vl1[1], vl1[2], vl1[3], vh1[0], vh1[1], vh1[2], vh1[3]};
        const bf16x8 vf2 = (bf16x8){vl2[0], vl2[1], vl2[2], vl2[3], vh2[0], vh2[1], vh2[2], vh2[3]}, vf3 = (bf16x8){vl3[0], vl3[1], vl3[2], vl3[3], vh3[0], vh3[1], vh3[2], vh3[3]};
        o = __builtin_amdgcn_mfma_f32_32x32x16_bf16(pa0, vf0, o, 0, 0, 0); o = __builtin_amdgcn_mfma_f32_32x32x16_bf16(pa1, vf1, o, 0, 0, 0);
        o = __builtin_amdgcn_mfma_f32_32x32x16_bf16(pa2, vf2, o, 0, 0, 0); o = __builtin_amdgcn_mfma_f32_32x32x16_bf16(pa3, vf3, o, 0, 0, 0);
#pragma unroll
        for (int kb = 0; kb < 4; ++kb)
#pragma unroll
            for (int sp = 0; sp < 2; ++sp) {
                const u32x2 a_lo = *(const LAS u32x2*)(lds + T_QD + tl * 256 + ((((4 * kb + 2 * sp) * 16)) ^ ((tl & 7) << 4)) + 8 * hi);
                const u32x2 a_hi = *(const LAS u32x2*)(lds + T_QD + tl * 256 + ((((4 * kb + 2 * sp + 1) * 16)) ^ ((tl & 7) << 4)) + 8 * hi);
                u32x4 aw = {a_lo[0], a_lo[1], a_hi[0], a_hi[1]};
                u32x4 bw = {cvt_pk_bf16(Sacc[kb][8 * sp + 0], Sacc[kb][8 * sp + 1]), cvt_pk_bf16(Sacc[kb][8 * sp + 2], Sacc[kb][8 * sp + 3]),
                            cvt_pk_bf16(Sacc[kb][8 * sp + 4], Sacc[kb][8 * sp + 5]), cvt_pk_bf16(Sacc[kb][8 * sp + 6], Sacc[kb][8 * sp + 7])};
                o = __builtin_amdgcn_mfma_f32_32x32x16_bf16(*reinterpret_cast<bf16x8*>(&aw), *reinterpret_cast<bf16x8*>(&bw), o, 0, 0, 0); }
        float gt[16];
#pragma unroll
        for (int r = 0; r < 16; ++r) gt[r] = bf2f(base[(size_t)(t0 + th * 32 + crow(r, hi)) * PROJ_LD + C_HGT + vq * 32 + r32]);
#define HG_SUPD(kb) do { \
            _Pragma("unroll") for (int i4 = 0; i4 < 4; ++i4) { const f32x4 dv = *(const LAS f32x4*)(dl + (kb) * 32 + 8 * i4 + 4 * hi); \
                Sacc[kb][4 * i4] *= dv[0]; Sacc[kb][4 * i4 + 1] *= dv[1]; Sacc[kb][4 * i4 + 2] *= dv[2]; Sacc[kb][4 * i4 + 3] *= dv[3]; } \
            s16x4 al0, ah0, al1, ah1, al2, ah2, al3, ah3; \
            HG_TRRD(al0, klb, (kb) * 512); HG_TRRD(ah0, klb, (kb) * 512 + 2048); HG_TRRD(al1, klb, (kb) * 512 + 4096); HG_TRRD(ah1, klb, (kb) * 512 + 6144); \
            HG_TRRD(al2, klb, (kb) * 512 + 8192); HG_TRRD(ah2, klb, (kb) * 512 + 10240); HG_TRRD(al3, klb, (kb) * 512 + 12288); HG_TRRD(ah3, klb, (kb) * 512 + 14336); \
            asm volatile("s_waitcnt lgkmcnt(0)" ::: "memory"); __builtin_amdgcn_sched_barrier(0); \
            Sacc[kb] = __builtin_amdgcn_mfma_f32_32x32x16_bf16((bf16x8){al0[0], al0[1], al0[2], al0[3], ah0[0], ah0[1], ah0[2], ah0[3]}, vf0, Sacc[kb], 0, 0, 0); \
            Sacc[kb] = __builtin_amdgcn_mfma_f32_32x32x16_bf16((bf16x8){al1[0], al1[1], al1[2], al1[3], ah1[0], ah1[1], ah1[2], ah1[3]}, vf1, Sacc[kb], 0, 0, 0); \
            Sacc[kb] = __builtin_amdgcn_mfma_f32_32x32x16_bf16((bf16x8){al2[0], al2[1], al2[2], al2[3], ah2[0], ah2[1], ah2[2], ah2[3]}, vf2, Sacc[kb], 0, 0, 0); \
            Sacc[kb] = __builtin_amdgcn_mfma_f32_32x32x16_bf16((bf16x8){al3[0], al3[1], al3[2], al3[3], ah3[0], ah3[1], ah3[2], ah3[3]}, vf3, Sacc[kb], 0, 0, 0); } while (0)
        HG_SUPD(0); HG_SUPD(1); HG_SUPD(2); HG_SUPD(3);
#undef HG_SUPD
#undef HG_TRRD
        { float y8[8], y4[4], y2[2], y1;
          const bool b4 = (r32 & 16) != 0, b3 = (r32 & 8) != 0, b2 = (r32 & 4) != 0, b1 = (r32 & 2) != 0;
#pragma unroll
          for (int i = 0; i < 8; ++i) { const float lo = o[i] * o[i], hi_ = o[8 + i] * o[8 + i]; const float keep = b4 ? hi_ : lo, send = b4 ? lo : hi_; y8[i] = keep + __shfl_xor(send, 16); }
#pragma unroll
          for (int i = 0; i < 4; ++i) { const float keep = b3 ? y8[4 + i] : y8[i], send = b3 ? y8[i] : y8[4 + i]; y4[i] = keep + __shfl_xor(send, 8); }
#pragma unroll
          for (int i = 0; i < 2; ++i) { const float keep = b2 ? y4[2 + i] : y4[i], send = b2 ? y4[i] : y4[2 + i]; y2[i] = keep + __shfl_xor(send, 4); }
          { const float keep = b1 ? y2[1] : y2[0], send = b1 ? y2[0] : y2[1]; y1 = keep + __shfl_xor(send, 2); }
          y1 += __shfl_xor(y1, 1);
          const int rf = ((r32 >> 1) & 15);
          if ((r32 & 1) == 0) ssq[vq * 64 + th * 32 + crow(rf, hi)] = y1; }
        __syncthreads();
        { bf16_t* yb = YM + (size_t)(b * SEQ + t0 + th * 32) * DM + h * 128 + vq * 32;
          const unsigned loff = (unsigned)(4 * hi) * DM + (unsigned)r32;
#pragma unroll
          for (int r = 0; r < 16; ++r) { const int tc = (r & 3) + 8 * (r >> 2); const int t = th * 32 + tc + 4 * hi; const float ss = ((ssq[t] + ssq[64 + t]) + ssq[128 + t]) + ssq[192 + t];
              const float rs = rsqrtf(ss * (1.f / 128.f) + EPS);
              (yb + (size_t)tc * DM)[loff] = f2bf(o[r] * rs * ngv * gt[r]); } }
    }
#undef HG_LOAD
    __syncthreads();
}

__device__ __forceinline__ void compress_fast_unit(const Frame& F, const Args& a, int u) {
    unsigned char* ws = F.ws; const bf16_t* PROJ = (const bf16_t*)(ws + WS_PROJ); LAS unsigned char* lds = F.lds;
    const int j = u >> 6, bg = (u >> 2) & 15, mt = u & 3, b = bg >> 1, g = bg & 1;
    int tz = threadIdx.x; asm volatile("" : "+v"(tz));
    const int lane = tz & 63, r32 = lane & 31, hi = lane >> 5, w = F.wid;
    const int n = mt * 32 + r32, nl = n < 126 ? n : 126;
    const bf16_t* W2T = (const bf16_t*)(ws + WS_W2T) + (size_t)j * 128 * 128;
    const int colb = (j ? C_VCM : C_KCM) + g * 128;
    const bf16_t* arow = PROJ + (size_t)(b * SEQ + 16 * nl) * PROJ_LD + colb + hi * 8;
    const bf16_t* bfrag = (const bf16_t*)(ws + WS_W1T) + ((size_t)(j * 8 + w) * 32 * 4 * 64 + lane) * 8;
    f32x16 acc[4];
#pragma unroll
    for (int c = 0; c < 4; ++c)
#pragma unroll
        for (int r = 0; r < 16; ++r) acc[c][r] = 0.f;
#pragma unroll 4
    for (int ks = 0; ks < 32; ++ks) {
        const int l = 4 * w + (ks >> 3), d = (ks & 7) * 16;
        const bf16x8 af = *(const bf16x8*)(arow + (size_t)l * PROJ_LD + d);
#pragma unroll
        for (int c = 0; c < 4; ++c) { const bf16x8 bfr = *(const bf16x8*)(bfrag + (size_t)(ks * 4 + c) * 64 * 8);
            acc[c] = __builtin_amdgcn_mfma_f32_32x32x16_bf16(af, bfr, acc[c], 0, 0, 0); }
    }
    LAS float* red = (LAS float*)lds;
#pragma unroll
    for (int c = 0; c < 4; ++c)
#pragma unroll
        for (int r = 0; r < 16; ++r) red[(w * 32 + at::crow(r, hi)) * 128 + c * 32 + r32] = acc[c][r];
    __syncthreads();
    LAS unsigned char* hdn = lds + 131072 - 8192;
    { const int nn = tz >> 4, c8 = (tz & 15) * 8; float sv[8];
      const float* b1 = (const float*)(ws + WS_B1P) + (size_t)j * 32 * 128 + c8;
#pragma unroll
      for (int i = 0; i < 8; ++i) sv[i] = 0.f;
#pragma unroll 4
      for (int kg = 0; kg < 32; ++kg) { const f32x4 x0 = *(const f32x4*)(b1 + kg * 128), x1 = *(const f32x4*)(b1 + kg * 128 + 4);
#pragma unroll
          for (int i = 0; i < 4; ++i) { sv[i] += x0[i]; sv[4 + i] += x1[i]; } }
#pragma unroll
      for (int ww = 0; ww < 8; ++ww) { const f32x4 x0 = *(const LAS f32x4*)(red + (ww * 32 + nn) * 128 + c8), x1 = *(const LAS f32x4*)(red + (ww * 32 + nn) * 128 + c8 + 4);
#pragma unroll
          for (int i = 0; i < 4; ++i) { sv[i] += x0[i]; sv[4 + i] += x1[i]; } }
      __syncthreads();
#pragma unroll
      for (int i = 0; i < 8; ++i) sv[i] = gelu_tanh(sv[i]);
      u32x4 pw; pw[0] = cvt_pk_bf16(sv[0], sv[1]); pw[1] = cvt_pk_bf16(sv[2], sv[3]); pw[2] = cvt_pk_bf16(sv[4], sv[5]); pw[3] = cvt_pk_bf16(sv[6], sv[7]);
      *(LAS u32x4*)(hdn + AT_KSWZ(nn, c8 * 2)) = pw; }
    __syncthreads();
    if (w < 4) {
        f32x16 o2;
#pragma unroll
        for (int r = 0; r < 16; ++r) o2[r] = 0.f;
#pragma unroll
        for (int ks = 0; ks < 8; ++ks) { const bf16x8 af = *(const LAS bf16x8*)(hdn + AT_KSWZ(r32, (ks * 16 + hi * 8) * 2));
            const bf16x8 bfr = *(const bf16x8*)(W2T + (size_t)(w * 32 + r32) * 128 + ks * 16 + hi * 8);
            o2 = __builtin_amdgcn_mfma_f32_32x32x16_bf16(af, bfr, o2, 0, 0, 0); }
        bf16_t* dst = (bf16_t*)(ws + (DEBUG_CMP ? (j ? WS_Y + 1048576 : WS_Y) : (j ? WS_VC : WS_KC))) + (size_t)bg * 128 * 128;
#pragma unroll
        for (int r = 0; r < 16; ++r) { const int nn = mt * 32 + at::crow(r, hi); dst[(size_t)nn * 128 + w * 32 + r32] = (nn < NCMP) ? f2bf(o2[r]) : (bf16_t)0; }
    }
    __syncthreads();
}

__device__ __forceinline__ void p5_router(const Frame& F, const Args& a) {
    unsigned char* ws = F.ws; const bf16_t* H1 = (const bf16_t*)(ws + WS_H1); unsigned char* XN = ws + WS_U;
    const float* wr2 = (const float*)(ws + WS_WR2); const float* g2 = a.in[I_N2G]; const float* br = a.in[I_BR];
    float* tokw = (float*)(ws + WS_TOKW); int* slot = (int*)(ws + WS_SLOT); unsigned* cnt = F.ctl + CW_CNT;
    constexpr int HS_LD = 4104;
    LAS unsigned char* hs = F.lds; LAS float* rsv = (LAS float*)(F.lds + 32 * HS_LD); LAS float* red = (LAS float*)F.lds;
    LAS unsigned* lcnt = (LAS unsigned*)(F.lds + 32 * HS_LD + 256); LAS unsigned* lbase = lcnt + 32;
    if (F.tid < 32) lcnt[F.tid] = 0u;
    int myexp[2] = {0, 0}, myrank[2] = {0, 0};
    __syncthreads();
    for (int it = F.bid; it < NTOK / 32; it += F.G) {
#pragma unroll
        for (int rr = 0; rr < 4; ++rr) { const int tl = F.wid * 4 + rr, row = it * 32 + tl;
            const bf16_t* hr = H1 + (size_t)row * DM; u32x4 hw[4]; float ss = 0.f;
#pragma unroll
            for (int i = 0; i < 4; ++i) { hw[i] = *(const u32x4*)(hr + i * 512 + F.lane * 8); float hf[8]; unpack8(hw[i], hf);
#pragma unroll
                for (int j = 0; j < 8; ++j) ss += hf[j] * hf[j]; }
            ss = wave_sum(ss); const float rs = rsqrtf(ss * (1.f / DM) + EPS);
            if (F.lane == 0) rsv[tl] = rs;
#pragma unroll
            for (int i = 0; i < 4; ++i) { const f32x4 g0 = *(const f32x4*)(g2 + i * 512 + F.lane * 8), g1 = *(const f32x4*)(g2 + i * 512 + F.lane * 8 + 4);
                float hf[8]; unpack8(hw[i], hf);
                const f32x4 a0 = (f32x4){hf[0], hf[1], hf[2], hf[3]} * rs * g0, a1 = (f32x4){hf[4], hf[5], hf[6], hf[7]} * rs * g1;
                u32x2 w; w[0] = cvt4_fp8(a0[0], a0[1], a0[2], a0[3]); w[1] = cvt4_fp8(a1[0], a1[1], a1[2], a1[3]);
                *(u32x2*)(XN + (size_t)row * DM + i * 512 + F.lane * 8) = w;
                LAS unsigned char* hp = hs + tl * HS_LD + (i * 512 + F.lane * 8) * 2;
                *(LAS u32x2*)hp = (u32x2){hw[i][0], hw[i][1]}; *(LAS u32x2*)(hp + 8) = (u32x2){hw[i][2], hw[i][3]}; } }
        __syncthreads();
        f32x4 c00 = {0.f, 0.f, 0.f, 0.f}, c01 = c00, c10 = c00, c11 = c00;
        { const int ti = F.lane & 15, kq = F.lane >> 4, kb = F.wid * 256 + kq;
          const LAS unsigned char* ha = hs + ti * HS_LD + kb * 2; const float* wb = wr2 + (size_t)kb * 32 + ti;
#pragma unroll 16
          for (int s_ = 0; s_ < 64; ++s_) {
              const float a0 = bf2f(*(const LAS bf16_t*)(ha + s_ * 8)), a1 = bf2f(*(const LAS bf16_t*)(ha + 16 * HS_LD + s_ * 8));
              const float b0 = wb[(size_t)s_ * 128], b1 = wb[(size_t)s_ * 128 + 16];
              c00 = __builtin_amdgcn_mfma_f32_16x16x4f32(a0, b0, c00, 0, 0, 0); c01 = __builtin_amdgcn_mfma_f32_16x16x4f32(a0, b1, c01, 0, 0, 0);
              c10 = __builtin_amdgcn_mfma_f32_16x16x4f32(a1, b0, c10, 0, 0, 0); c11 = __builtin_amdgcn_mfma_f32_16x16x4f32(a1, b1, c11, 0, 0, 0); } }
        float rsl[2];
        rsl[0] = rsv[F.tid >> 5]; rsl[1] = rsv[16 + (F.tid >> 5)];
        __syncthreads();
        { const int cj = F.lane & 15, rq = (F.lane >> 4) * 4; LAS float* rw = red + F.wid * 1024;
#pragma unroll
          for (int r = 0; r < 4; ++r) { rw[(rq + r) * 32 + cj] = c00[r]; rw[(rq + r) * 32 + 16 + cj] = c01[r]; rw[(16 + rq + r) * 32 + cj] = c10[r]; rw[(16 + rq + r) * 32 + 16 + cj] = c11[r]; } }
        __syncthreads();
#pragma unroll
        for (int ps = 0; ps < 2; ++ps) {
            const int tl = ps * 16 + (F.tid >> 5), e = F.tid & 31, row = it * 32 + tl;
            float acc = 0.f;
#pragma unroll
            for (int w = 0; w < 8; ++w) acc += red[w * 1024 + tl * 32 + e];
            const float logit = acc * rsl[ps] + br[e];
            float tv[4]; int ti[4]; float cur = logit;
#pragma unroll
            for (int k = 0; k < 4; ++k) { float bv = cur; int bi = e;
#pragma unroll
                for (int o = 16; o > 0; o >>= 1) { const float ov = __shfl_xor(bv, o); const int oi = __shfl_xor(bi, o); if (ov > bv || (ov == bv && oi < bi)) { bv = ov; bi = oi; } }
                tv[k] = bv; ti[k] = bi; if (e == bi) cur = -INFINITY; }
            const float m = tv[0]; const float e0 = 1.f, e1 = __expf(tv[1] - m), e2 = __expf(tv[2] - m), e3 = __expf(tv[3] - m); const float inv = 1.f / (e0 + e1 + e2 + e3);
            if (e < 4) { const int k = e; const int ee = k == 0 ? ti[0] : k == 1 ? ti[1] : k == 2 ? ti[2] : ti[3]; const float w = (k == 0 ? e0 : k == 1 ? e1 : k == 2 ? e2 : e3) * inv;
                tokw[(size_t)row * 4 + k] = w;
                myexp[ps] = ee; myrank[ps] = (int)__hip_atomic_fetch_add(lcnt + ee, 1u, __ATOMIC_RELAXED, __HIP_MEMORY_SCOPE_WORKGROUP); } }
        __syncthreads();
        if (F.tid < 32) { const unsigned c = lcnt[F.tid]; lbase[F.tid] = c ? atomicAdd(&cnt[F.tid], c) : 0u; lcnt[F.tid] = 0u; }
        __syncthreads();
#pragma unroll
        for (int ps = 0; ps < 2; ++ps) { const int e = F.tid & 31; if (e < 4) { const int row = it * 32 + ps * 16 + (F.tid >> 5);
                slot[(size_t)myexp[ps] * NTOK + lbase[myexp[ps]] + myrank[ps]] = row * 4 + e; } }
        __syncthreads();
    }
}

__device__ __forceinline__ void moe_build_tiles(const Frame& F, LAS int* tstart, LAS int* cntl) {
    if (F.tid == 0) { int acc = 0; for (int e = 0; e < NEXP; ++e) { const int c = (int)__hip_atomic_load(F.ctl + CW_CNT + e, __ATOMIC_RELAXED, __HIP_MEMORY_SCOPE_AGENT); cntl[e] = c; tstart[e] = acc; acc += (c + 255) >> 8; } tstart[NEXP] = acc; }
    if (F.tid < 64) { const int sh = amax_shift(__hip_atomic_load(F.ctl + CW_AMAX + F.tid, __ATOMIC_RELAXED, __HIP_MEMORY_SCOPE_AGENT)); const unsigned b_ = (unsigned)(127 - sh) & 0xffu;
        cntl[40 + F.tid] = (int)(b_ | (b_ << 8) | (b_ << 16) | (b_ << 24)); }
    __syncthreads();
}

__device__ __forceinline__ void p9_combine(const Frame& F, const Args& a) {
    unsigned char* ws = F.ws; const bf16_t* H1 = (const bf16_t*)(ws + WS_H1); const bf16_t* Y = (const bf16_t*)(ws + WS_Y);
    const float* tokw = (const float*)(ws + WS_TOKW); const float* gf = a.in[I_FNG]; float* out = a.out;
    for (int row = F.bid * 8 + F.wid; row < NTOK; row += F.G * 8) {
        const bf16_t* hr = H1 + (size_t)row * DM; f32x4 v[8]; float ss = 0.f;
        const f32x4 w4 = *(const f32x4*)(tokw + (size_t)row * 4);
#pragma unroll
        for (int i = 0; i < 4; ++i) { const int c0 = i * 512 + F.lane * 8; { const u32x4 hw = *(const u32x4*)(hr + c0); float hf[8]; unpack8(hw, hf);
                v[2 * i] = (f32x4){hf[0], hf[1], hf[2], hf[3]}; v[2 * i + 1] = (f32x4){hf[4], hf[5], hf[6], hf[7]}; }
#pragma unroll
            for (int k = 0; k < 4; ++k) { const u32x4 yw = *(const u32x4*)(Y + ((size_t)row * 4 + k) * DM + c0); float f[8]; unpack8(yw, f);
#pragma unroll
                for (int j = 0; j < 4; ++j) { v[2 * i][j] += w4[k] * f[j]; v[2 * i + 1][j] += w4[k] * f[4 + j]; } }
#pragma unroll
            for (int j = 0; j < 4; ++j) ss += v[2 * i][j] * v[2 * i][j] + v[2 * i + 1][j] * v[2 * i + 1][j]; }
        ss = wave_sum(ss); const float rs = rsqrtf(ss * (1.f / DM) + EPS);
#pragma unroll
        for (int i = 0; i < 4; ++i) { const int c0 = i * 512 + F.lane * 8; const f32x4 g0 = *(const f32x4*)(gf + c0), g1 = *(const f32x4*)(gf + c0 + 4);
            *(f32x4*)(out + (size_t)row * DM + c0) = v[2 * i] * rs * g0; *(f32x4*)(out + (size_t)row * DM + c0 + 4) = v[2 * i + 1] * rs * g1; }
    }
}

#if DEBUG_CMP
__device__ __noinline__ void dbg_compare(unsigned char* ws, unsigned* ctl, LAS unsigned char* lds) {
    const int tid = threadIdx.x, lane = tid & 63, wid = tid >> 6;
    float mx = 0.f, md = 0.f; const bf16_t* r0 = (const bf16_t*)(ws + WS_KC); const bf16_t* r1 = (const bf16_t*)(ws + WS_Y);
    for (int i = tid; i < 2 * 16 * 128 * 128; i += NTHREADS) { const float x = bf2f(i < 262144 ? r0[i] : ((const bf16_t*)(ws + WS_VC))[i - 262144]); const float y = bf2f(i < 262144 ? r1[i] : ((const bf16_t*)(ws + WS_Y + 1048576))[i - 262144]);
        mx = fmaxf(mx, fabsf(x)); md = fmaxf(md, fabsf(x - y)); if (!(y == y)) md = 1e30f; }
    mx = wave_max(mx); md = wave_max(md); LAS float* t2 = (LAS float*)lds; if (lane == 0) { t2[wid] = mx; t2[8 + wid] = md; } __syncthreads();
    if (tid == 0) { float a1 = 0.f, a2 = 0.f; for (int i = 0; i < 8; ++i) { a1 = fmaxf(a1, t2[i]); a2 = fmaxf(a2, t2[8 + i]); }
        const float rel = a2 / fmaxf(a1, 1e-20f); int code = 0;
        if (rel >= 1.f) code = 10; else if (rel >= 0.3f) code = 11; else if (rel >= 0.1f) code = 12; else if (rel >= 0.03f) code = 13; else if (rel >= 0.01f) code = 14; else if (rel >= 0.003f) code = 15;
        if (blockIdx.x == 0) ctl[CW_ERR] = (unsigned)code; }
    __syncthreads();
}
#endif
constexpr int N_PHASES = 9;
extern "C" __global__ void __launch_bounds__(NTHREADS, 2) fwd(Args args) {
    extern __shared__ __attribute__((aligned(16))) unsigned char shm[];
    LAS unsigned char* lds = (LAS unsigned char*)shm;
    Frame F; F.lds = lds; F.ws = args.ws; F.ctl = (unsigned*)(args.ws + WS_CTL);
    F.tid = threadIdx.x; F.wid = __builtin_amdgcn_readfirstlane(F.tid >> 6); F.lane = F.tid & 63; F.G = gridDim.x; F.bid = blockIdx.x;
    LAS unsigned* misc = (LAS unsigned*)(lds + LDS_MISC);
    if (F.tid < 4) misc[F.tid] = 0u;
    __syncthreads();
    const int lo = args.ph_lo, hi = args.ph_hi;
    XcdBarrier bar; bar.bar = F.ctl; bar.x = 0; bar.st = nullptr;
    if (hi - lo > 1) bar = xcd_barrier_post(F.ctl, (volatile LAS unsigned*)misc);
#define IN(k) (lo <= (k) && (k) < hi)
#define SEAM(k) do { if (IN(k) && IN((k) + 1)) xcd_barrier(bar); } while (0)
    unsigned char* ws = args.ws;

    if (IN(0)) { p0_prologue(F, args); }
#if (REP_MASK >> 0) & 1
    if (IN(0)) { p0_prologue(F, args); }
#endif
    SEAM(0);
    if (IN(1)) {
        const int gi = F.bid >> 3, g8i = gi & 7; const bool split = (F.G == 256), conv = split && (g8i == 2 || g8i == 5 || g8i == 7);
        if (conv) { const int crank = ((gi >> 3) * 3 + (g8i == 2 ? 0 : (g8i == 5 ? 1 : 2))) * 8 + (F.bid & 7); conv_experts(F, args, CONV_P2 + crank, 96, 12288); bias1_partials(F, args, crank, 96); }
        else {
            const int grank = (gi >> 3) * 5 + (g8i < 2 ? g8i : (g8i < 5 ? g8i - 1 : 4));
            g8::DenseSched<DM, DM> S; S.init(ws + WS_U, ws + WS_WINT, NTOK, PROJ_LD, split ? 160 : F.G, split ? grank * 8 + (F.bid & 7) : F.bid);
            g8::EpiProj E{(bf16_t*)(ws + WS_PROJ), PROJ_LD, (bf16_t*)(ws + WS_OMF), (const float*)(ws + WS_LB)};
            g8::gemm_phase(lds, S, E);
            if (!split) { conv_experts(F, args, CONV_P2 + F.bid, F.G, 12288); bias1_partials(F, args, F.bid, F.G); }
        }
    }
#if (REP_MASK >> 1) & 1
    if (IN(1)) {
        g8::DenseSched<DM, DM> S; S.init(ws + WS_U, ws + WS_WINT, NTOK, PROJ_LD, F.G, F.bid);
        g8::EpiProj E{(bf16_t*)(ws + WS_PROJ), PROJ_LD, (bf16_t*)(ws + WS_OMF), (const float*)(ws + WS_LB)};
        g8::gemm_phase(lds, S, E);
    }
#endif
    SEAM(1);
    if (IN(2)) {
#if DEBUG_CMP
        p2_compress_naive(F, args);
#endif
        for (int u = F.bid; u < 128; u += F.G) compress_fast_unit(F, args, u);
        if (F.G == 256) { if (F.bid >= 128) conv_experts(F, args, CONV_P0 + (F.bid - 128), 128, CONV_P2); }
        else conv_experts(F, args, CONV_P0 + F.bid, F.G, CONV_P2); }
#if (REP_MASK >> 2) & 1
    if (IN(2)) {
#if DEBUG_CMP
        p2_compress_naive(F, args);
#endif
        for (int u = F.bid; u < 128; u += F.G) compress_fast_unit(F, args, u); }
#endif
    SEAM(2);
    if (IN(3)) {
#if DEBUG_CMP
        dbg_compare(ws, F.ctl, lds);
#endif
        if (F.bid < 64) hgrn_fast_unit(F, args, F.bid);
        for (;;) { if (F.tid == 0) misc[8] = atomicAdd(F.ctl + CW_QUEUE, 1u);
            __syncthreads();
            const int u = (int)misc[8];
            if (u >= BATCH * NSA_G * 32) break;
            attn_fast_unit(F, args, u); }
    }
#if (REP_MASK >> 3) & 1
    if (IN(3)) {
#if DEBUG_CMP
        dbg_compare(ws, F.ctl, lds);
#endif
        if (F.bid < 64) hgrn_fast_unit(F, args, F.bid);
        for (;;) { if (F.tid == 0) misc[8] = atomicAdd(F.ctl + CW_QUEUE + 64, 1u);
            __syncthreads();
            const int u = (int)misc[8];
            if (u >= BATCH * NSA_G * 32) break;
            attn_fast_unit(F, args, u); }
    }
#endif
    SEAM(3);
    if (IN(4)) {
        g8::DenseSched<DM, DM> S; S.init(ws + WS_YMIX, ws + WS_WOUTT, NTOK, DM, F.G, F.bid);
        g8::EpiResBf16 E{(bf16_t*)(ws + WS_H1), args.in[I_X], DM};
        g8::gemm_phase(lds, S, E);
    }
#if (REP_MASK >> 4) & 1
    if (IN(4)) {
        g8::DenseSched<DM, DM> S; S.init(ws + WS_YMIX, ws + WS_WOUTT, NTOK, DM, F.G, F.bid);
        g8::EpiResBf16 E{(bf16_t*)(ws + WS_H1), args.in[I_X], DM};
        g8::gemm_phase(lds, S, E);
    }
#endif
    SEAM(4);
    if (IN(5)) { p5_router(F, args); }
#if (REP_MASK >> 5) & 1
    if (IN(5)) { p5_router(F, args); }
#endif
    SEAM(5);
    if (IN(6)) {
        LAS int* tstart = (LAS int*)(misc + 64); LAS int* cntl = tstart + 40;
        moe_build_tiles(F, tstart, cntl);
        g8::MoeSched<16, 2, true> S{(const char*)(ws + WS_U), (const char*)(ws + WS_WGUT), (const int*)(ws + WS_SLOT), args.in[I_BGU], tstart, cntl, F.G, F.bid};
        g8::EpiGateUp E{(unsigned char*)(ws + WS_ACT), args.in[I_BGU]};
        g8::gemm_phase(lds, S, E);
    }
#if (REP_MASK >> 6) & 1
    if (IN(6)) {
        LAS int* tstart = (LAS int*)(misc + 64); LAS int* cntl = tstart + 40;
        moe_build_tiles(F, tstart, cntl);
        g8::MoeSched<16, 2, true> S{(const char*)(ws + WS_U), (const char*)(ws + WS_WGUT), (const int*)(ws + WS_SLOT), args.in[I_BGU], tstart, cntl, F.G, F.bid};
        g8::EpiGateUp E{(unsigned char*)(ws + WS_ACT), args.in[I_BGU]};
        g8::gemm_phase(lds, S, E);
    }
#endif
    SEAM(6);
    if (IN(7)) {
        LAS int* tstart = (LAS int*)(misc + 64); LAS int* cntl = tstart + 40;
        moe_build_tiles(F, tstart, cntl);
        g8::MoeSched<8, 0, false> S{(const char*)(ws + WS_ACT), (const char*)(ws + WS_WDT), (const int*)(ws + WS_SLOT), args.in[I_BD], tstart, cntl, F.G, F.bid};
        g8::EpiDown E{(bf16_t*)(ws + WS_Y), args.in[I_BD]};
        g8::gemm_phase(lds, S, E);
    }
#if (REP_MASK >> 7) & 1
    if (IN(7)) {
        LAS int* tstart = (LAS int*)(misc + 64); LAS int* cntl = tstart + 40;
        moe_build_tiles(F, tstart, cntl);
        g8::MoeSched<8, 0, false> S{(const char*)(ws + WS_ACT), (const char*)(ws + WS_WDT), (const int*)(ws + WS_SLOT), args.in[I_BD], tstart, cntl, F.G, F.bid};
        g8::EpiDown E{(bf16_t*)(ws + WS_Y), args.in[I_BD]};
        g8::gemm_phase(lds, S, E);
    }
#endif
    SEAM(7);
    if (IN(8)) { p9_combine(F, args);
#if DEBUG_CMP
        { const unsigned code = __hip_atomic_load(F.ctl + CW_ERR, __ATOMIC_RELAXED, __HIP_MEMORY_SCOPE_AGENT);
          if (code) { const float cval = sqrtf((float)code); for (size_t i = (size_t)F.bid * NTHREADS + F.tid; i < (size_t)NTOK * DM; i += (size_t)F.G * NTHREADS) args.out[i] = cval; } }
#endif
    }
#if (REP_MASK >> 8) & 1
    if (IN(8)) { p9_combine(F, args);
#if DEBUG_CMP
        { const unsigned code = __hip_atomic_load(F.ctl + CW_ERR, __ATOMIC_RELAXED, __HIP_MEMORY_SCOPE_AGENT);
          if (code) { const float cval = sqrtf((float)code); for (size_t i = (size_t)F.bid * NTHREADS + F.tid; i < (size_t)NTOK * DM; i += (size_t)F.G * NTHREADS) args.out[i] = cval; } }
#endif
    }
#endif
#undef IN
#undef SEAM
}

extern "C" void kernel_launch(void* const* d_in, const int* in_sizes, int n_in, void* d_out, int out_size, void* d_ws, size_t ws_size, hipStream_t stream) {
    static int grid = 0;
    if (grid == 0) {
        if (n_in != 18 || ws_size < WS_END) { fprintf(stderr, "kernel_launch: n_in %d ws %zu (need %zu)\n", n_in, ws_size, (size_t)WS_END); grid = -1; return; }
        int dev = 0, cus = 0, per_cu = 0;
        if (hipGetDevice(&dev) != hipSuccess || hipDeviceGetAttribute(&cus, hipDeviceAttributeMultiprocessorCount, dev) != hipSuccess) { grid = -1; return; }
        if (hipFuncSetAttribute((const void*)fwd, hipFuncAttributeMaxDynamicSharedMemorySize, LDS_BYTES) != hipSuccess) { fprintf(stderr, "kernel_launch: hipFuncSetAttribute failed\n"); grid = -1; return; }
        if (hipOccupancyMaxActiveBlocksPerMultiprocessor(&per_cu, (const void*)fwd, NTHREADS, LDS_BYTES) != hipSuccess || per_cu < 1) { fprintf(stderr, "kernel_launch: occupancy query says %d\n", per_cu); }
        (void)hipGetLastError();
        grid = cus;
    }
    if (grid < 0) return;
    (void)hipMemsetAsync((char*)d_ws + WS_CTL, 0, CTL_BYTES, stream);
    Args a{};
    for (int i = 0; i < 18; ++i) a.in[i] = (const float*)d_in[i];
    a.out = (float*)d_out; a.ws = (unsigned char*)d_ws;
#if N_LAUNCH_PER_PHASE
    for (int p = 0; p < N_PHASES; ++p) { a.ph_lo = p; a.ph_hi = p + 1; hipLaunchKernelGGL(fwd, dim3(grid), dim3(NTHREADS), LDS_BYTES, stream, a); }
#else
    a.ph_lo = 0; a.ph_hi = N_PHASES; hipLaunchKernelGGL(fwd, dim3(grid), dim3(NTHREADS), LDS_BYTES, stream, a);
#endif
}
```

```cpp
#include <hip/hip_runtime.h>
#include <stdint.h>
#include <stdio.h>

#ifndef N_LAUNCH_PER_PHASE
#define N_LAUNCH_PER_PHASE 0
#endif

#define DEBUG_CMP 0
#ifndef REP_MASK
#define REP_MASK 0
#endif
#define LAS __attribute__((address_space(3)))
typedef unsigned short bf16_t;
typedef short bf16x8 __attribute__((ext_vector_type(8)));
typedef float f32x4 __attribute__((ext_vector_type(4)));
typedef float f32x2 __attribute__((ext_vector_type(2)));
typedef float f32x16 __attribute__((ext_vector_type(16)));
typedef unsigned u32x4 __attribute__((ext_vector_type(4)));
typedef unsigned u32x2 __attribute__((ext_vector_type(2)));
typedef int i32x8 __attribute__((ext_vector_type(8)));

constexpr int BATCH = 8, SEQ = 2048, NTOK = BATCH * SEQ, DM = 2048;
constexpr int HG_W = 1024, HG_H = 8, HG_DK = 128, HG_DV = 128;
constexpr int NSA_H = 8, NSA_G = 2, NSA_R = 4, HD = 128, KVW = 256;
constexpr int IN_COLS = 6680, PROJ_LD = 6912;
constexpr int C_HQ = 0, C_HF = 1024, C_HI = 2048, C_HGT = 3072, C_NQ = 4096, C_KCM = 5120, C_VCM = 5376, C_KSL = 5632, C_VSL = 5888, C_KWN = 6144, C_VWN = 6400, C_NGT = 6656;
constexpr int NCMP = 127, NSEL = 32, SEL_TOP = 16, WINDOW = 512;
constexpr int NEXP = 32, TOPK = 4, DFF = 2048, NASG = NTOK * TOPK;
constexpr float EPS = 1e-6f;
constexpr int NTHREADS = 512;
constexpr int CONV_P0 = 0, CONV_P2 = 1280;

constexpr size_t al256(size_t x) { return (x + 255) & ~(size_t)255; }
constexpr size_t WS_CTL = 0, CTL_BYTES = 65536;
constexpr size_t WS_WINT = WS_CTL + CTL_BYTES;
constexpr size_t WS_WOUTT = WS_WINT + (size_t)PROJ_LD * DM * 2;
constexpr size_t WS_WGUT = WS_WOUTT + (size_t)DM * DM * 2;
constexpr size_t WS_WDT = WS_WGUT + (size_t)NEXP * 2 * DFF * DM * 2;
constexpr size_t WS_W1T = WS_WDT + (size_t)NEXP * DM * DFF * 2;
constexpr size_t WS_W2T = WS_W1T + (size_t)2 * 128 * 4096 * 2;
constexpr size_t WS_BIAS1 = WS_W2T + (size_t)2 * 128 * 128 * 2;
constexpr size_t WS_WR2 = WS_BIAS1 + 1024;
constexpr size_t WS_LB = WS_WR2 + (size_t)DM * NEXP * 4;
constexpr size_t WS_U = WS_LB + 4096;
constexpr size_t WS_PROJ = WS_U + (size_t)NTOK * DM * 2;
constexpr size_t WS_KC = WS_PROJ + (size_t)(NTOK + 64) * PROJ_LD * 2;
constexpr size_t WS_VC = WS_KC + (size_t)16 * 128 * 128 * 2;
constexpr size_t WS_YMIX = WS_VC + (size_t)16 * 128 * 128 * 2;
constexpr size_t WS_H1 = WS_YMIX + (size_t)NTOK * DM * 2;
constexpr size_t WS_TOKW = WS_H1 + (size_t)NTOK * DM * 4;
constexpr size_t WS_SLOT = WS_TOKW + (size_t)NTOK * 4 * 4;
constexpr size_t WS_ACT = WS_SLOT + (size_t)NEXP * NTOK * 4;
constexpr size_t WS_Y = WS_ACT + (size_t)NASG * DFF * 2;
constexpr size_t WS_OT = WS_Y + (size_t)NASG * DM * 2;
constexpr size_t WS_OMF = WS_OT + (size_t)256 * 64 * 512 * 4;
constexpr size_t WS_B1P = WS_OMF + (size_t)NTOK * HG_W * 2;
constexpr size_t WS_END = WS_B1P + (size_t)2 * 32 * 128 * 4;
constexpr int CW_CNT = 4096, CW_QUEUE = 4160, CW_ERR = 4224, CW_AMAX = 4544;

__device__ __forceinline__ float bf2f(bf16_t b) { return __uint_as_float(((unsigned)b) << 16); }
typedef __bf16 bf16v2_t __attribute__((ext_vector_type(2)));
__device__ __forceinline__ unsigned cvt_pk_bf16(float lo, float hi) { f32x2 v = {lo, hi}; bf16v2_t r = __builtin_convertvector(v, bf16v2_t); return __builtin_bit_cast(unsigned, r); }
__device__ __forceinline__ unsigned cvt4_fp8(float a, float b, float c, float d) { unsigned w = 0u; w = __builtin_amdgcn_cvt_pk_fp8_f32(a, b, w, false); w = __builtin_amdgcn_cvt_pk_fp8_f32(c, d, w, true); return w; }
__device__ __forceinline__ unsigned cvt4_bf8(float a, float b, float c, float d) { unsigned w = 0u; w = __builtin_amdgcn_cvt_pk_bf8_f32(a, b, w, false); w = __builtin_amdgcn_cvt_pk_bf8_f32(c, d, w, true); return w; }
__device__ __forceinline__ int amax_shift(unsigned bits) { if (bits == 0u) return 0; int s_ = 5 - ((int)(bits >> 23) - 127); return s_ < -60 ? -60 : (s_ > 60 ? 60 : s_); }
__device__ __forceinline__ float shift_mult(int s_) { return __uint_as_float((unsigned)(s_ + 127) << 23); }
__device__ __forceinline__ unsigned cvt4_fp8s(float a, float b, float c, float d, float m) {
    return cvt4_fp8(__builtin_amdgcn_fmed3f(a * m, -448.f, 448.f), __builtin_amdgcn_fmed3f(b * m, -448.f, 448.f), __builtin_amdgcn_fmed3f(c * m, -448.f, 448.f), __builtin_amdgcn_fmed3f(d * m, -448.f, 448.f)); }
__device__ __forceinline__ bf16_t f2bf(float f) { return (bf16_t)(cvt_pk_bf16(f, 0.f) & 0xffffu); }
__device__ __forceinline__ float sigmoidf_(float x) { return 1.f / (1.f + __expf(-x)); }
__device__ __forceinline__ float siluf_(float x) { return x * sigmoidf_(x); }
__device__ __forceinline__ float wave_sum(float v) {
#pragma unroll
    for (int o = 32; o > 0; o >>= 1) v += __shfl_xor(v, o);
    return v;
}
__device__ __forceinline__ float wave_max(float v) {
#pragma unroll
    for (int o = 32; o > 0; o >>= 1) v = fmaxf(v, __shfl_xor(v, o));
    return v;
}
__device__ __forceinline__ void unpack8(const u32x4 w, float (&f)[8]) {
#pragma unroll
    for (int i = 0; i < 4; ++i) { f[2 * i] = __uint_as_float(w[i] << 16); f[2 * i + 1] = __uint_as_float(w[i] & 0xffff0000u); }
}

#define XB_TMO      128
#define XB_XCNT(j)  (256  + 64 * (j))
#define XB_XSUB(j)  (1280 + 64 * (j))
#define XB_XGEN(j)  (2304 + 64 * (j))
#define XB_TOP      3328
#define XB_TOPGEN   3392
#define XCD_BAR_WORDS 3456
#define XB_SPIN_CAP (1u << 18)
__device__ __forceinline__ unsigned xb_ld(unsigned* p)              { return __hip_atomic_load(p, __ATOMIC_RELAXED, __HIP_MEMORY_SCOPE_AGENT); }
__device__ __forceinline__ unsigned xb_add(unsigned* p, unsigned v) { return __hip_atomic_fetch_add(p, v, __ATOMIC_RELAXED, __HIP_MEMORY_SCOPE_AGENT); }
__device__ __forceinline__ unsigned xb_xcc_id() { return (unsigned)__builtin_amdgcn_s_getreg((3 << 11) | 20) & 0xFu; }
#define XB_SPIN(cond, bar) do { unsigned _sp = 0; while (cond) { __builtin_amdgcn_s_sleep(1); \
    if ((++_sp & 255u) == 0u) { if (xb_ld(&(bar)[XB_TMO])) break; if (_sp > XB_SPIN_CAP) { atomicAdd(&(bar)[XB_TMO], 1u); break; } } } } while (0)
struct XcdBarrier { unsigned* bar; unsigned x; volatile LAS unsigned* st; };
__device__ __forceinline__ XcdBarrier xcd_barrier_post(unsigned* bar, volatile LAS unsigned* st) {
    XcdBarrier b; b.bar = bar; b.x = xb_xcc_id(); b.st = st;
    if (threadIdx.x == 0) (void)xb_add(&bar[XB_XCNT(b.x)], 1u);
    return b;
}
__device__ __forceinline__ void xcd_barrier_complete(unsigned* bar, unsigned x, unsigned& nloc, unsigned& nx) {
    const unsigned G = gridDim.x * gridDim.y * gridDim.z;
    unsigned sum, cnt, mine, sp = 0u;
    for (;;) {
        sum = 0u; cnt = 0u; mine = 0u;
#pragma unroll
        for (unsigned j = 0; j < 16; ++j) { const unsigned c = xb_ld(&bar[XB_XCNT(j)]); sum += c; cnt += (c > 0u) ? 1u : 0u; mine = (j == x) ? c : mine; }
        if (sum == G) break;
        __builtin_amdgcn_s_sleep(1);
        if ((++sp & 255u) == 0u) { if (xb_ld(&bar[XB_TMO])) break; if (sp > XB_SPIN_CAP) { atomicAdd(&bar[XB_TMO], 1u); break; } }
    }
    nloc = mine > 0u ? mine : 1u; nx = cnt > 0u ? cnt : 1u;
}
__device__ __forceinline__ void xcd_barrier(const XcdBarrier& b) {
    asm volatile("s_waitcnt vmcnt(0)" ::: "memory");
    __syncthreads();
    if (threadIdx.x == 0) {
        unsigned* bar = b.bar;
        __builtin_amdgcn_s_waitcnt(0);
        unsigned nloc = b.st[0], nx = b.st[1];
        if (nloc == 0u) { xcd_barrier_complete(bar, b.x, nloc, nx); b.st[0] = nloc; b.st[1] = nx; }
        const unsigned old = xb_add(&bar[XB_XSUB(b.x)], 1u);
        const unsigned gen = old / nloc;
        if (old + 1u == (gen + 1u) * nloc) {
            __builtin_amdgcn_fence(__ATOMIC_RELEASE, "agent");
            asm volatile("s_waitcnt vmcnt(0)" ::: "memory");
            const unsigned og = xb_add(&bar[XB_TOP], 1u);
            const unsigned tg = og / nx;
            if (og + 1u == (tg + 1u) * nx) xb_add(&bar[XB_TOPGEN], 1u);
            else XB_SPIN(xb_ld(&bar[XB_TOPGEN]) == tg, bar);
            __builtin_amdgcn_fence(__ATOMIC_ACQUIRE, "agent");
            xb_add(&bar[XB_XGEN(b.x)], 1u);
            asm volatile("s_waitcnt vmcnt(0)" ::: "memory");
        } else {
            XB_SPIN(xb_ld(&bar[XB_XGEN(b.x)]) == gen, bar);
            __builtin_amdgcn_fence(__ATOMIC_ACQUIRE, "agent");
            asm volatile("s_waitcnt vmcnt(0)" ::: "memory");
        }
    }
    __syncthreads();
}

namespace g8 {
constexpr int BM = 256, BK = 64, HALF = 128, HTB = HALF * BK * 2, STAGE_BYTES = 8 * HTB, NXCD = 8;
__host__ __device__ __forceinline__ int lds_byte(int r, int c) { const int st = (r >> 4) * 2 + (c >> 5), rr = r & 15, cc = c & 31, ob = rr * 64 + cc * 2; return st * 1024 + (ob ^ (((ob >> 9) & 1) << 5)); }
__host__ __device__ __forceinline__ void stage_rc(int b, int& R, int& C) { const int st = b / 1024, sb = b % 1024, swz = sb ^ (((sb >> 9) & 1) << 5); R = (st >> 1) * 16 + swz / 64; C = (st & 1) * 32 + (swz % 64) / 2; }
__host__ __device__ __forceinline__ int perm32(int rho) { const int n = rho >> 4, i = rho & 15; return 8 * (i >> 2) + 4 * n + (i & 3); }

struct Unit { const char* A; const char* B0; const char* B1; const int* rows; const float* bias0; const float* bias1; int nvalid; int m0, n0, e; int wscale; };

template <class Sched>
__device__ __forceinline__ void a_offsets(const Unit& u, const int (&R)[2], const int (&C)[2], unsigned (&vo)[2][2]) {
#pragma unroll
    for (int h = 0; h < 2; ++h)
#pragma unroll
        for (int i = 0; i < 2; ++i) {
            if constexpr (Sched::GATHER) {
                const int r = h * HALF + R[i];
                const int idx = u.rows[r < u.nvalid ? r : 0] >> Sched::SHIFT;
                vo[h][i] = (unsigned)idx * (unsigned)(Sched::LDA * Sched::ESZ) + (unsigned)C[i] * 2u;
            } else {
                vo[h][i] = (unsigned)(h * HALF + R[i]) * (unsigned)(Sched::LDA * Sched::ESZ) + (unsigned)C[i] * 2u;
            }
        }
}

__device__ __forceinline__ const char* uni_ptr(const char* p) { const unsigned long long v = (unsigned long long)p;
    const unsigned lo = (unsigned)__builtin_amdgcn_readfirstlane((int)(unsigned)v), hi = (unsigned)__builtin_amdgcn_readfirstlane((int)(unsigned)(v >> 32));
    return (const char*)(((unsigned long long)hi << 32) | lo); }
template <class Sched, class Epi>
__device__ __forceinline__ void gemm_phase(LAS unsigned char* lds, const Sched& S, const Epi& E) {
    const int tid = threadIdx.x, wid = __builtin_amdgcn_readfirstlane(tid >> 6), lane = tid & 63, wr = wid >> 2, wc = wid & 3, fr = lane & 15, fq = lane >> 4;
    constexpr int K = Sched::K, nt = K * Sched::ESZ / (BK * 2);
    int Rr[2], Cc[2]; unsigned voffB[2];
#pragma unroll
    for (int i = 0; i < 2; ++i) { stage_rc(tid * 16 + i * 8192, Rr[i], Cc[i]); const int Rb = Epi::PERM ? ((Rr[i] & ~31) + perm32(Rr[i] & 31)) : Rr[i];
        voffB[i] = (unsigned)Rb * (unsigned)(K * Sched::ESZ) + (unsigned)Cc[i] * 2u; }
    const size_t kstep = (size_t)(BK * 2);
    const unsigned ldsw = (unsigned)wid * 1024u;
    const int aoff = lds_byte(wr * 64 + fr, fq * 8), boff = lds_byte(wc * 32 + fr, fq * 8);
#define G8_SA(b, h) (((b) * 2 + (h)) * HTB)
#define G8_SB(b, h) ((4 + (b) * 2 + (h)) * HTB)
#define G8_STAGE(bufoff, gbase, voff) do { _Pragma("unroll") for (int _i = 0; _i < 2; ++_i) \
        __builtin_amdgcn_global_load_lds((const unsigned*)((const char*)(gbase) + (voff)[_i]), (LAS unsigned*)(lds + (bufoff) + ldsw + _i * 8192), 16, 0, 0); } while (0)
#define G8_LDA(dst, b, h) do { _Pragma("unroll") for (int m = 0; m < 4; ++m) _Pragma("unroll") for (int k = 0; k < 2; ++k) dst[m][k] = *(const LAS bf16x8*)(lds + G8_SA(b, h) + aoff + m * 2048 + k * 1024); } while (0)
#define G8_LDB(dst, b, h) do { _Pragma("unroll") for (int n = 0; n < 2; ++n) _Pragma("unroll") for (int k = 0; k < 2; ++k) dst[n][k] = *(const LAS bf16x8*)(lds + G8_SB(b, h) + boff + n * 2048 + k * 1024); } while (0)
#define G8_MMA(ai, bj, At, Bt) do { __builtin_amdgcn_s_setprio(1); _Pragma("unroll") for (int m = 0; m < 4; ++m) _Pragma("unroll") for (int n = 0; n < 2; ++n) { \
        if constexpr (Sched::ESZ == 2) { _Pragma("unroll") for (int k = 0; k < 2; ++k) acc[ai][bj][m][n] = __builtin_amdgcn_mfma_f32_16x16x32_bf16(Bt[n][k], At[m][k], acc[ai][bj][m][n], 0, 0, 0); } \
        else { const u32x4 b0_ = __builtin_bit_cast(u32x4, Bt[n][0]), b1_ = __builtin_bit_cast(u32x4, Bt[n][1]), a0_ = __builtin_bit_cast(u32x4, At[m][0]), a1_ = __builtin_bit_cast(u32x4, At[m][1]); \
            const i32x8 bw_ = {(int)b0_[0], (int)b0_[1], (int)b0_[2], (int)b0_[3], (int)b1_[0], (int)b1_[1], (int)b1_[2], (int)b1_[3]}; \
            const i32x8 aw_ = {(int)a0_[0], (int)a0_[1], (int)a0_[2], (int)a0_[3], (int)a1_[0], (int)a1_[1], (int)a1_[2], (int)a1_[3]}; \
            acc[ai][bj][m][n] = __builtin_amdgcn_mfma_scale_f32_16x16x128_f8f6f4(bw_, aw_, acc[ai][bj][m][n], Sched::FMT_W, Sched::FMT_A, 0, wsc_cur, 0, 0x7f7f7f7f); } } \
        __builtin_amdgcn_s_setprio(0); } while (0)
#define G8_WAIT_V(n) asm volatile("s_waitcnt vmcnt(" #n ")" ::: "memory")
#define G8_WAIT_L(n) asm volatile("s_waitcnt lgkmcnt(" #n ")" ::: "memory")
#define G8_BAR __builtin_amdgcn_s_barrier()
#define G8_SCHED __builtin_amdgcn_sched_barrier(0)
    Unit cur, nxt; int ui = 0;
    if (!S.next(0, cur)) return;
    f32x4 acc[2][2][4][2];
#pragma unroll
    for (int a = 0; a < 2; ++a)
#pragma unroll
        for (int b = 0; b < 2; ++b)
#pragma unroll
            for (int m = 0; m < 4; ++m)
#pragma unroll
                for (int n = 0; n < 2; ++n) acc[a][b][m][n] = (f32x4){0.f, 0.f, 0.f, 0.f};
    bf16x8 At[4][2], B0[2][2], B1[2][2];
    unsigned voffA[2][2], nvoffA[2][2];
    LAS unsigned char* auxb = lds + STAGE_BYTES; int par_cur = 0, par_nxt = 1;
#define G8_AUX_ISSUE(U, PAR) do { if (wid < 4) { const int r_ = wid * 64 + lane; __builtin_amdgcn_global_load_lds((const unsigned*)((U).rows + (r_ < (U).nvalid ? r_ : 0)), (LAS unsigned*)(auxb + (PAR) * 2048 + wid * 256), 4, 0, 0); } \
        else { const float* b_ = (wid < 6 ? (U).bias0 + (wid - 4) * 64 : (U).bias1 + (wid - 6) * 64) + lane; __builtin_amdgcn_global_load_lds((const unsigned*)b_, (LAS unsigned*)(auxb + (PAR) * 2048 + 1024 + (wid - 4) * 256), 4, 0, 0); } } while (0)
#define G8_AUX_OFFS(PAR) do { _Pragma("unroll") for (int h = 0; h < 2; ++h) _Pragma("unroll") for (int i = 0; i < 2; ++i) { \
        const int idx_ = *(const LAS int*)(auxb + (PAR) * 2048 + (h * HALF + Rr[i]) * 4) >> Sched::SHIFT; voffA[h][i] = (unsigned)idx_ * (unsigned)(Sched::LDA * Sched::ESZ) + (unsigned)Cc[i] * 2u; } } while (0)
    if constexpr (Sched::LDSAUX) { G8_AUX_ISSUE(cur, 0); G8_WAIT_V(0); __syncthreads(); G8_AUX_OFFS(0); }
    else a_offsets<Sched>(cur, Rr, Cc, voffA);
    const char* cA = cur.A; const char* cB0 = cur.B0; const char* cB1 = cur.B1;
    int wsc_cur = cur.wscale;
    G8_STAGE(G8_SB(0, 0), cB0, voffB); G8_STAGE(G8_SA(0, 0), cA, voffA[0]); G8_STAGE(G8_SB(0, 1), cB1, voffB); G8_STAGE(G8_SA(0, 1), cA, voffA[1]);
    if (wr == 1) G8_BAR;
    G8_WAIT_V(4); G8_BAR;
    G8_STAGE(G8_SB(1, 0), cB0 + kstep, voffB); G8_STAGE(G8_SA(1, 0), cA + kstep, voffA[0]); G8_STAGE(G8_SB(1, 1), cB1 + kstep, voffB);
    G8_WAIT_V(6); G8_BAR;
    for (;;) {
        const bool has_next = S.next(ui + 1, nxt);
        const char* nA = has_next ? nxt.A : cA; const char* nB0 = has_next ? nxt.B0 : cB0; const char* nB1 = has_next ? nxt.B1 : cB1;
        if constexpr (Sched::LDSAUX) { if (has_next) G8_AUX_ISSUE(nxt, par_nxt); }
        else if constexpr (Sched::GATHER) {
            if (has_next) a_offsets<Sched>(nxt, Rr, Cc, nvoffA);
            else {
#pragma unroll
                for (int h = 0; h < 2; ++h)
#pragma unroll
                    for (int i = 0; i < 2; ++i) nvoffA[h][i] = voffA[h][i];
            }
        }
        for (int t = 0; t < nt; t += 2) {
            const bool last = (t == nt - 2);
            const char* a1 = cA + (size_t)(t + 1) * kstep;
            const char* a2 = last ? nA : cA + (size_t)(t + 2) * kstep;
            const char* b20 = last ? nB0 : cB0 + (size_t)(t + 2) * kstep; const char* b21 = last ? nB1 : cB1 + (size_t)(t + 2) * kstep;
            const char* a3 = a2 + kstep; const char* b30 = b20 + kstep; const char* b31 = b21 + kstep;
            G8_LDB(B0, 0, 0); G8_SCHED; G8_LDA(At, 0, 0); G8_STAGE(G8_SA(1, 1), a1, voffA[1]);
            G8_WAIT_L(8); G8_BAR; G8_WAIT_L(0); G8_MMA(0, 0, At, B0); G8_BAR; G8_SCHED;
            if constexpr (Sched::LDSAUX) { if (last && has_next) G8_AUX_OFFS(par_nxt); }
            else if constexpr (Sched::GATHER) { if (last) {
#pragma unroll
                for (int h = 0; h < 2; ++h)
#pragma unroll
                    for (int i = 0; i < 2; ++i) voffA[h][i] = nvoffA[h][i]; } }
            G8_LDB(B1, 0, 1); G8_STAGE(G8_SB(0, 0), b20, voffB);
            G8_BAR; G8_WAIT_L(0); G8_MMA(0, 1, At, B1); G8_BAR;
            G8_LDA(At, 0, 1); G8_STAGE(G8_SA(0, 0), a2, voffA[0]);
            G8_BAR; G8_WAIT_L(0); G8_MMA(1, 0, At, B0); G8_BAR; G8_SCHED;
            G8_STAGE(G8_SB(0, 1), b21, voffB);
            G8_WAIT_V(6); G8_BAR; G8_MMA(1, 1, At, B1); G8_BAR;
            G8_LDB(B0, 1, 0); G8_SCHED; G8_LDA(At, 1, 0); G8_STAGE(G8_SA(0, 1), a2, voffA[1]);
            G8_WAIT_L(8); G8_BAR; G8_WAIT_L(0); G8_MMA(0, 0, At, B0); G8_BAR; G8_SCHED;
            G8_LDB(B1, 1, 1); G8_STAGE(G8_SB(1, 0), b30, voffB);
            G8_BAR; G8_WAIT_L(0); G8_MMA(0, 1, At, B1); G8_BAR;
            G8_LDA(At, 1, 1); G8_STAGE(G8_SA(1, 0), a3, voffA[0]);
            G8_BAR; G8_WAIT_L(0); G8_MMA(1, 0, At, B0); G8_BAR; G8_SCHED;
            G8_STAGE(G8_SB(1, 1), b31, voffB);
            G8_WAIT_V(6); G8_BAR; G8_MMA(1, 1, At, B1); G8_BAR;
        }
        E(acc, cur, wr, wc, fr, fq, (const LAS int*)(auxb + par_cur * 2048), (const LAS float*)(auxb + par_cur * 2048 + 1024));
        if (!has_next) break;
#pragma unroll
        for (int a = 0; a < 2; ++a)
#pragma unroll
            for (int b = 0; b < 2; ++b)
#pragma unroll
                for (int m = 0; m < 4; ++m)
#pragma unroll
                    for (int n = 0; n < 2; ++n) acc[a][b][m][n] = (f32x4){0.f, 0.f, 0.f, 0.f};
        cur = nxt; cA = nA; cB0 = nB0; cB1 = nB1; ++ui; wsc_cur = cur.wscale; par_cur = par_nxt; par_nxt = par_nxt == 2 ? 0 : par_nxt + 1;
    }
    G8_WAIT_V(0);
    if (wr == 0) G8_BAR;
    G8_BAR;
#undef G8_AUX_ISSUE
#undef G8_AUX_OFFS
#undef G8_SA
#undef G8_SB
#undef G8_STAGE
#undef G8_LDA
#undef G8_LDB
#undef G8_MMA
#undef G8_WAIT_V
#undef G8_WAIT_L
#undef G8_BAR
#undef G8_SCHED
}

template <int K_, int LDA_>
struct DenseSched {
    static constexpr int K = K_, LDA = LDA_, SHIFT = 0, ESZ = 2, FMT_W = 0, FMT_A = 0; static constexpr bool GATHER = false, LDSAUX = false;
    const char* A; const char* Bt; int nM, nN, nwg, G, c;
    __device__ void init(const void* A_, const void* Bt_, int M, int N, int G_, int c_) { A = (const char*)A_; Bt = (const char*)Bt_; nM = M / BM; nN = N / BM; nwg = nM * nN; G = G_; c = c_; }
    __device__ __forceinline__ bool next(int i, Unit& u) const {
        const long L = (long)i * G + c; if (L >= nwg) return false;
        int wgid = (int)L; { const int q = nwg / NXCD, r = nwg % NXCD, xcd = wgid % NXCD, off = wgid / NXCD; wgid = (xcd < r ? xcd * (q + 1) : r * (q + 1) + (xcd - r) * q) + off; }
        constexpr int WGM = 8;
        const int nig = WGM * nN, gid = wgid / nig, fm = gid * WGM, gsz = (nM - fm) < WGM ? (nM - fm) : WGM;
        const int pm = fm + ((wgid % nig) % gsz), pn = (wgid % nig) / gsz;
        u.A = A + (size_t)pm * BM * LDA * 2; u.B0 = Bt + (size_t)pn * BM * K * 2; u.B1 = u.B0 + (size_t)HALF * K * 2;
        u.rows = nullptr; u.bias0 = nullptr; u.bias1 = nullptr; u.wscale = 0x7f7f7f7f; u.nvalid = BM; u.m0 = pm * BM; u.n0 = pn * BM; u.e = 0; return true;
    }
};

template <int NPN  , int SHIFT_, bool GU>
struct MoeSched {
    static constexpr int K = 2048, LDA = 2048, SHIFT = SHIFT_, ESZ = 1, FMT_W = 0  , FMT_A = 0  ; static constexpr bool GATHER = true, LDSAUX = true;
    const char* A; const char* Bt; const int* slot; const float* bias; const LAS int* tstart; const LAS int* cnt; int G, c;
    __device__ __forceinline__ bool next(int i, Unit& u) const {
        const int ntile = tstart[NEXP]; const int nwg = ntile * NPN;
        const long L = (long)i * G + c; if (L >= nwg) return false;
        int wgid = (int)L; { const int q = nwg / NXCD, r = nwg % NXCD, xcd = wgid % NXCD, off = wgid / NXCD; wgid = (xcd < r ? xcd * (q + 1) : r * (q + 1) + (xcd - r) * q) + off; }
        int e = 0;
        for (int s = 16; s > 0; s >>= 1) if (tstart[e + s] * NPN <= wgid) e += s;
        const int mt = tstart[e + 1] - tstart[e], w = wgid - tstart[e] * NPN, pn = w / mt, m = w % mt;
        u.A = A; u.e = e; u.m0 = m * BM; u.n0 = pn; u.wscale = cnt[40 + (GU ? 0 : 32) + e]; u.rows = slot + (size_t)e * NTOK + m * BM;
        const int left = cnt[e] - m * BM; u.nvalid = left < BM ? left : BM;
        if (GU) { u.B0 = Bt + ((size_t)e * 4096 + (size_t)pn * HALF) * K * ESZ; u.B1 = u.B0 + (size_t)2048 * K * ESZ; u.bias0 = bias + (size_t)e * 4096 + pn * HALF; u.bias1 = u.bias0 + 2048; }
        else { u.B0 = Bt + ((size_t)e * 2048 + (size_t)pn * BM) * K * ESZ; u.B1 = u.B0 + (size_t)HALF * K * ESZ; u.bias0 = bias + (size_t)e * 2048 + pn * BM; u.bias1 = u.bias0 + HALF; }
        return true;
    }
};

struct EpiBf16 {
    static constexpr bool PERM = true;
    bf16_t* O; int ldc;
    __device__ __forceinline__ void operator()(const f32x4 (&acc)[2][2][4][2], const Unit& u, int wr, int wc, int fr, int fq, const LAS int* lrows, const LAS float* lbias) const {
        const int row0 = u.m0 + wr * 64 + fr, col0 = u.n0 + wc * 32 + 8 * fq;
#pragma unroll
        for (int ai = 0; ai < 2; ++ai)
#pragma unroll
            for (int m = 0; m < 4; ++m) { bf16_t* rowp = O + (size_t)(row0 + ai * HALF + m * 16) * ldc + col0;
#pragma unroll
                for (int bj = 0; bj < 2; ++bj) { const f32x4 v0 = acc[ai][bj][m][0], v1 = acc[ai][bj][m][1];
                    u32x4 w; w[0] = cvt_pk_bf16(v0[0], v0[1]); w[1] = cvt_pk_bf16(v0[2], v0[3]); w[2] = cvt_pk_bf16(v1[0], v1[1]); w[3] = cvt_pk_bf16(v1[2], v1[3]);
                    *(u32x4*)(rowp + bj * HALF) = w; } }
    }
};
struct EpiProj {
    static constexpr bool PERM = true;
    bf16_t* O; int ldc; bf16_t* OMF; const float* lb;
    __device__ __forceinline__ void operator()(const f32x4 (&acc)[2][2][4][2], const Unit& u, int wr, int wc, int fr, int fq, const LAS int* lrows, const LAS float* lbias) const {
        const int row0 = u.m0 + wr * 64 + fr, col0 = u.n0 + wc * 32 + 8 * fq;
        const int mode = (u.n0 < 1024 || (u.n0 >= 3072 && u.n0 < 4096)) ? 1 : ((u.n0 >= 1024 && u.n0 < 2048) ? 2 : 0);
        f32x4 lbv[2][2];
        if (mode == 2) {
#pragma unroll
            for (int bj = 0; bj < 2; ++bj) { lbv[bj][0] = *(const f32x4*)(lb + col0 - 1024 + bj * HALF); lbv[bj][1] = *(const f32x4*)(lb + col0 - 1024 + bj * HALF + 4); } }
#pragma unroll
        for (int ai = 0; ai < 2; ++ai)
#pragma unroll
            for (int m = 0; m < 4; ++m) { const size_t rowi = (size_t)(row0 + ai * HALF + m * 16); bf16_t* rowp = O + rowi * ldc + col0;
#pragma unroll
                for (int bj = 0; bj < 2; ++bj) { f32x4 v0 = acc[ai][bj][m][0], v1 = acc[ai][bj][m][1];
                    f32x4 o0 = {0.f, 0.f, 0.f, 0.f}, o1 = o0;
                    if (mode != 0) {
                        f32x4 e0 = v0 * (-1.4426950408889634f), e1 = v1 * (-1.4426950408889634f);
#pragma unroll
                        for (int j = 0; j < 4; ++j) { e0[j] = __builtin_amdgcn_exp2f(e0[j]); e1[j] = __builtin_amdgcn_exp2f(e1[j]); }
                        e0 = e0 + 1.f; e1 = e1 + 1.f;
#pragma unroll
                        for (int j = 0; j < 4; ++j) { e0[j] = __builtin_amdgcn_rcpf(e0[j]); e1[j] = __builtin_amdgcn_rcpf(e1[j]); }
                        if (mode == 1) { v0 = v0 * e0; v1 = v1 * e1; }
                        else { const f32x4 f0 = lbv[bj][0] + (1.f - lbv[bj][0]) * e0, f1 = lbv[bj][1] + (1.f - lbv[bj][1]) * e1;
#pragma unroll
                            for (int j = 0; j < 4; ++j) { v0[j] = __builtin_amdgcn_logf(f0[j]); v1[j] = __builtin_amdgcn_logf(f1[j]); }
                            o0 = 1.f - f0; o1 = 1.f - f1; } }
                    if (mode == 2) {
                        u32x4 w2; w2[0] = cvt_pk_bf16(o0[0], o0[1]); w2[1] = cvt_pk_bf16(o0[2], o0[3]); w2[2] = cvt_pk_bf16(o1[0], o1[1]); w2[3] = cvt_pk_bf16(o1[2], o1[3]);
                        *(u32x4*)(OMF + rowi * HG_W + (col0 - 1024) + bj * HALF) = w2; }
                    u32x4 w; w[0] = cvt_pk_bf16(v0[0], v0[1]); w[1] = cvt_pk_bf16(v0[2], v0[3]); w[2] = cvt_pk_bf16(v1[0], v1[1]); w[3] = cvt_pk_bf16(v1[2], v1[3]);
                    *(u32x4*)(rowp + bj * HALF) = w; } }
    }
};
struct EpiResF32 {
    static constexpr bool PERM = false;
    float* C; const float* res; int ldc;
    __device__ __forceinline__ void operator()(const f32x4 (&acc)[2][2][4][2], const Unit& u, int wr, int wc, int fr, int fq, const LAS int* lrows, const LAS float* lbias) const {
        const int row0 = u.m0 + wr * 64 + fr, col0 = u.n0 + wc * 32 + 4 * fq;
#pragma unroll
        for (int ai = 0; ai < 2; ++ai)
#pragma unroll
            for (int m = 0; m < 4; ++m) { const size_t off = (size_t)(row0 + ai * HALF + m * 16) * ldc + col0;
#pragma unroll
                for (int bj = 0; bj < 2; ++bj)
#pragma unroll
                    for (int n = 0; n < 2; ++n) { const f32x4 r = *(const f32x4*)(res + off + bj * HALF + n * 16); *(f32x4*)(C + off + bj * HALF + n * 16) = acc[ai][bj][m][n] + r; } }
    }
};
struct EpiResBf16 {
    static constexpr bool PERM = true;
    bf16_t* C; const float* res; int ldc;
    __device__ __forceinline__ void operator()(const f32x4 (&acc)[2][2][4][2], const Unit& u, int wr, int wc, int fr, int fq, const LAS int*, const LAS float*) const {
        const int row0 = u.m0 + wr * 64 + fr, col0 = u.n0 + wc * 32 + 8 * fq;
#pragma unroll
        for (int ai = 0; ai < 2; ++ai)
#pragma unroll
            for (int m = 0; m < 4; ++m) { const size_t off = (size_t)(row0 + ai * HALF + m * 16) * ldc + col0;
#pragma unroll
                for (int bj = 0; bj < 2; ++bj) { const f32x4 r0 = *(const f32x4*)(res + off + bj * HALF), r1 = *(const f32x4*)(res + off + bj * HALF + 4);
                    const f32x4 v0 = acc[ai][bj][m][0] + r0, v1 = acc[ai][bj][m][1] + r1;
                    u32x4 w; w[0] = cvt_pk_bf16(v0[0], v0[1]); w[1] = cvt_pk_bf16(v0[2], v0[3]); w[2] = cvt_pk_bf16(v1[0], v1[1]); w[3] = cvt_pk_bf16(v1[2], v1[3]);
                    *(u32x4*)(C + off + bj * HALF) = w; } }
    }
};
struct EpiGateUp {
    static constexpr bool PERM = true;
    unsigned char* ACT; const float* bias;
    __device__ __forceinline__ void operator()(const f32x4 (&acc)[2][2][4][2], const Unit& u, int wr, int wc, int fr, int fq, const LAS int* lrows, const LAS float* lbias) const {
        const int colh = u.n0 * HALF + wc * 32 + 8 * fq;
        const LAS float* bp = lbias + wc * 32 + 8 * fq;
        const f32x4 bg0 = *(const LAS f32x4*)bp, bg1 = *(const LAS f32x4*)(bp + 4), bu0 = *(const LAS f32x4*)(bp + 128), bu1 = *(const LAS f32x4*)(bp + 132);
#pragma unroll
        for (int ai = 0; ai < 2; ++ai)
#pragma unroll
            for (int m = 0; m < 4; ++m) { const int r = ai * HALF + wr * 64 + m * 16 + fr;
                if (r < u.nvalid) { const int asg = lrows[r];
                    f32x4 g0 = acc[ai][0][m][0] + bg0, g1 = acc[ai][0][m][1] + bg1, u0 = acc[ai][1][m][0] + bu0, u1 = acc[ai][1][m][1] + bu1;
                    f32x4 e0, e1;
#pragma unroll
                    for (int j = 0; j < 4; ++j) { g0[j] = fminf(g0[j], 7.f); g1[j] = fminf(g1[j], 7.f); u0[j] = __builtin_amdgcn_fmed3f(u0[j], -7.f, 7.f); u1[j] = __builtin_amdgcn_fmed3f(u1[j], -7.f, 7.f); }
                    const f32x4 z0 = g0 * (-1.702f * 1.4426950408889634f), z1 = g1 * (-1.702f * 1.4426950408889634f);
#pragma unroll
                    for (int j = 0; j < 4; ++j) { e0[j] = __builtin_amdgcn_exp2f(z0[j]); e1[j] = __builtin_amdgcn_exp2f(z1[j]); }
                    e0 = e0 + 1.f; e1 = e1 + 1.f;
#pragma unroll
                    for (int j = 0; j < 4; ++j) { e0[j] = __builtin_amdgcn_rcpf(e0[j]); e1[j] = __builtin_amdgcn_rcpf(e1[j]); }
                    const f32x4 o0 = (g0 * e0) * (u0 + 1.f), o1 = (g1 * e1) * (u1 + 1.f);
                    u32x2 w; w[0] = cvt4_fp8(o0[0], o0[1], o0[2], o0[3]); w[1] = cvt4_fp8(o1[0], o1[1], o1[2], o1[3]);
                    *(u32x2*)(ACT + (size_t)asg * DFF + colh) = w; } }
    }
};
struct EpiDown {
    static constexpr bool PERM = true;
    unsigned char* Y; const float* bias;
    __device__ __forceinline__ void operator()(const f32x4 (&acc)[2][2][4][2], const Unit& u, int wr, int wc, int fr, int fq, const LAS int* lrows, const LAS float* lbias) const {
        const int col0 = u.n0 * BM + wc * 32 + 8 * fq;
        const LAS float* bp = lbias + wc * 32 + 8 * fq;
        f32x4 bv[2][2];
#pragma unroll
        for (int bj = 0; bj < 2; ++bj) { bv[bj][0] = *(const LAS f32x4*)(bp + bj * HALF); bv[bj][1] = *(const LAS f32x4*)(bp + bj * HALF + 4); }
#pragma unroll
        for (int ai = 0; ai < 2; ++ai)
#pragma unroll
            for (int m = 0; m < 4; ++m) { const int r = ai * HALF + wr * 64 + m * 16 + fr;
                if (r < u.nvalid) { const int asg = lrows[r]; unsigned char* rowp = Y + (size_t)asg * DM + col0;
#pragma unroll
                    for (int bj = 0; bj < 2; ++bj) { const f32x4 v0 = acc[ai][bj][m][0] + bv[bj][0], v1 = acc[ai][bj][m][1] + bv[bj][1];
                        u32x2 w; w[0] = cvt4_fp8(v0[0], v0[1], v0[2], v0[3]); w[1] = cvt4_fp8(v1[0], v1[1], v1[2], v1[3]);
                        *(u32x2*)(rowp + bj * HALF) = w; } } }
    }
};
}

struct Args { const float* in[18]; float* out; unsigned char* ws; int ph_lo, ph_hi; };
enum { I_X = 0, I_N1G, I_WIN, I_LBL, I_HGNG, I_CPOS, I_CW1, I_CW2, I_NSAG, I_WOUT, I_N2G, I_WR, I_BR, I_WGU, I_BGU, I_WD, I_BD, I_FNG };
constexpr int LDS_STAGE = 131072, LDS_BYTES = LDS_STAGE + 16384, LDS_MISC = LDS_BYTES - 4096;

struct Frame {
    LAS unsigned char* lds; unsigned char* ws; unsigned* ctl; int tid, wid, lane, G, bid;
};

__device__ __forceinline__ void conv_tile(const Frame& F, const float* src, int lds_, int k0, int n0, int N, bf16_t* dst, int ldd) {
    LAS float* tile = (LAS float*)F.lds;
#pragma unroll
    for (int p = 0; p < 2; ++p) { const int k = p * 32 + (F.tid >> 4), n = (F.tid & 15) * 4;
        f32x4 v = (f32x4){0.f, 0.f, 0.f, 0.f};
        if (n0 + n < N) v = *(const f32x4*)(src + (size_t)(k0 + k) * lds_ + n0 + n);
        tile[k * 65 + n] = v[0]; tile[k * 65 + n + 1] = v[1]; tile[k * 65 + n + 2] = v[2]; tile[k * 65 + n + 3] = v[3]; }
    __syncthreads();
    { const int n = F.tid >> 3, kc = (F.tid & 7) * 8;
      if (n0 + n < N) { float f[8];
#pragma unroll
          for (int j = 0; j < 8; ++j) f[j] = tile[(kc + j) * 65 + n];
          u32x4 w; w[0] = cvt_pk_bf16(f[0], f[1]); w[1] = cvt_pk_bf16(f[2], f[3]); w[2] = cvt_pk_bf16(f[4], f[5]); w[3] = cvt_pk_bf16(f[6], f[7]);
          *(u32x4*)(dst + (size_t)(n0 + n) * ldd + k0 + kc) = w; } }
    __syncthreads();
}
struct ConvJob { const float* src; unsigned char* dst; int N; };
__device__ __forceinline__ ConvJob conv_job(const Args& a, unsigned char* ws, int st, int& kt, int& ntile) {
    ConvJob j;
    if (st < 8192) { const int e = st >> 8, r = st & 255; kt = r >> 4; ntile = r & 15; j.src = a.in[I_WGU] + (size_t)e * DM * 4096; j.dst = ws + WS_WGUT + (size_t)e * 4096 * DM; j.N = 4096; }
    else { const int q = st - 8192, e = q >> 7, r = q & 127; kt = r >> 3; ntile = r & 7; j.src = a.in[I_WD] + (size_t)e * DFF * DM; j.dst = ws + WS_WDT + (size_t)e * DM * DFF; j.N = 2048; }
    return j;
}
__device__ __forceinline__ void conv_experts(const Frame& F, const Args& a, int first, int stride, int limit) {
    unsigned char* ws = F.ws; LAS unsigned* tile = (LAS unsigned*)F.lds;
    LAS float* mtab = (LAS float*)(F.lds + 32768);
    if (F.tid < 64) mtab[F.tid] = shift_mult(amax_shift(__hip_atomic_load(F.ctl + CW_AMAX + F.tid, __ATOMIC_RELAXED, __HIP_MEMORY_SCOPE_AGENT)));
    __syncthreads();
    const int NST = limit;
    const int lk = F.tid >> 5, lc = F.tid & 31;
    f32x4 v[16];
    int st = first, kt = 0, ntile = 0; ConvJob J{};
#define CV_LOAD() do { _Pragma("unroll") for (int T = 0; T < 2; ++T) _Pragma("unroll") for (int pp = 0; pp < 8; ++pp) \
        v[T * 8 + pp] = __builtin_nontemporal_load((const f32x4*)(J.src + (size_t)(kt * 128 + pp * 16 + lk) * J.N + ntile * 256 + T * 128 + lc * 4)); } while (0)
    if (st < NST) { J = conv_job(a, ws, st, kt, ntile); CV_LOAD(); }
    for (; st < NST; st += stride) {
        const float mlt = mtab[st < 8192 ? (st >> 8) : 32 + ((st - 8192) >> 7)];
#pragma unroll
        for (int T = 0; T < 2; ++T)
#pragma unroll
            for (int pp = 0; pp < 8; ++pp) { const int k = pp * 16 + lk; const f32x4 x = v[T * 8 + pp];
                tile[T * 4096 + k * 32 + (lc ^ (4 * (k >> 4)))] = cvt4_fp8s(x[0], x[1], x[2], x[3], mlt); }
        __syncthreads();
        const ConvJob Jc = J; const int ktc = kt, ntc = ntile;
        const int nx = st + stride;
        if (nx < NST) { J = conv_job(a, ws, nx, kt, ntile); CV_LOAD(); }
        { const int i = F.tid & 7, n4g = (F.tid >> 3) & 31, T = F.tid >> 8;
          unsigned d[16];
#pragma unroll
          for (int jj = 0; jj < 16; ++jj) d[jj] = tile[T * 4096 + (16 * i + jj) * 32 + (n4g ^ (4 * i))];
          u32x4 o[4];
#pragma unroll
          for (int q = 0; q < 4; ++q) {
              const unsigned a0 = __builtin_amdgcn_perm(d[4 * q + 1], d[4 * q], 0x05010400u), a1 = __builtin_amdgcn_perm(d[4 * q + 1], d[4 * q], 0x07030602u);
              const unsigned a2 = __builtin_amdgcn_perm(d[4 * q + 3], d[4 * q + 2], 0x05010400u), a3 = __builtin_amdgcn_perm(d[4 * q + 3], d[4 * q + 2], 0x07030602u);
              o[0][q] = __builtin_amdgcn_perm(a2, a0, 0x05040100u); o[1][q] = __builtin_amdgcn_perm(a2, a0, 0x07060302u);
              o[2][q] = __builtin_amdgcn_perm(a3, a1, 0x05040100u); o[3][q] = __builtin_amdgcn_perm(a3, a1, 0x07060302u); }
          unsigned char* dp = Jc.dst + (size_t)(ntc * 256 + T * 128 + n4g * 4) * DM + ktc * 128 + 16 * i;
#pragma unroll
          for (int r = 0; r < 4; ++r) *(u32x4*)(dp + (size_t)r * DM) = o[r]; }
        __syncthreads();
    }
#undef CV_LOAD
}
__device__ __forceinline__ void conv_matrix4(const Frame& F, const float* src, int K, int N, bf16_t* dst) {
    LAS float* tile = (LAS float*)F.lds;
    const int tn4 = (N + 255) / 256, tk = K / 64, cnt = tn4 * tk;
    for (int t = F.bid; t < cnt; t += F.G) { const int k0 = (t / tn4) * 64, n00 = (t % tn4) * 256;
        f32x4 v[8];
#pragma unroll
        for (int q = 0; q < 4; ++q)
#pragma unroll
            for (int p = 0; p < 2; ++p) { const int k = p * 32 + (F.tid >> 4), n = n00 + q * 64 + (F.tid & 15) * 4;
                v[q * 2 + p] = (n < N) ? *(const f32x4*)(src + (size_t)(k0 + k) * N + n) : (f32x4){0.f, 0.f, 0.f, 0.f}; }
#pragma unroll
        for (int q = 0; q < 4; ++q)
#pragma unroll
            for (int p = 0; p < 2; ++p) { LAS float* tp = tile + q * (64 * 65) + (p * 32 + (F.tid >> 4)) * 65 + (F.tid & 15) * 4; const f32x4 x = v[q * 2 + p]; tp[0] = x[0]; tp[1] = x[1]; tp[2] = x[2]; tp[3] = x[3]; }
        __syncthreads();
        { const int n = F.tid >> 3, kc = (F.tid & 7) * 8;
#pragma unroll
          for (int q = 0; q < 4; ++q) { const int nn = n00 + q * 64 + n;
              if (nn < N) { float f[8];
#pragma unroll
                  for (int j = 0; j < 8; ++j) f[j] = tile[q * (64 * 65) + (kc + j) * 65 + n];
                  u32x4 w; w[0] = cvt_pk_bf16(f[0], f[1]); w[1] = cvt_pk_bf16(f[2], f[3]); w[2] = cvt_pk_bf16(f[4], f[5]); w[3] = cvt_pk_bf16(f[6], f[7]);
                  *(u32x4*)(dst + (size_t)nn * K + k0 + kc) = w; } } }
        __syncthreads(); }
}
__device__ __forceinline__ void conv_matrix(const Frame& F, const float* src, int K, int N, bf16_t* dst, long& base) {
    const int tn = (N + 63) / 64, tk = K / 64; const long cnt = (long)tn * tk;
    long first = ((long)F.bid - base) % F.G; if (first < 0) first += F.G;
    for (long t = first; t < cnt; t += F.G) { const int kt = (int)(t / tn), nt_ = (int)(t % tn); conv_tile(F, src, N, kt * 64, nt_ * 64, N, dst, K); }
    base += cnt;
}
__device__ __forceinline__ void bias1_partials(const Frame& F, const Args& a, int rank, int nranks) {
    LAS float* red = (LAS float*)F.lds;
    const int c = F.tid & 127, kq = F.tid >> 7;
    for (int job = rank; job < 64; job += nranks) { const int j = job >> 5, kg = job & 31;
        const float* pos = a.in[I_CPOS] + (size_t)j * 4096 + kg * 128 + kq * 32; const float* w1 = a.in[I_CW1] + ((size_t)j * 4096 + kg * 128 + kq * 32) * 128 + c;
        float s0 = 0.f, s1 = 0.f, s2 = 0.f, s3 = 0.f;
#pragma unroll
        for (int k = 0; k < 32; k += 4) { s0 += pos[k] * w1[(size_t)k * 128]; s1 += pos[k + 1] * w1[(size_t)(k + 1) * 128]; s2 += pos[k + 2] * w1[(size_t)(k + 2) * 128]; s3 += pos[k + 3] * w1[(size_t)(k + 3) * 128]; }
        red[kq * 128 + c] = (s0 + s1) + (s2 + s3);
        __syncthreads();
        if (F.tid < 128) ((float*)(F.ws + WS_B1P))[((size_t)j * 32 + kg) * 128 + c] = ((red[c] + red[128 + c]) + red[256 + c]) + red[384 + c];
        __syncthreads(); }
}
__device__ __forceinline__ void p0_sample(const Frame& F, const Args& a) {
    const int j = F.bid & 63, q = F.bid >> 6, nq = (F.G + 63 - j) >> 6;
    const float* src; size_t stride; int nalt;
    if (j < 32) { src = a.in[I_WGU] + (size_t)j * DM * 4096; stride = (size_t)DM * 4096 / 64; nalt = 2; }
    else { src = a.in[I_WD] + (size_t)(j - 32) * DFF * DM; stride = (size_t)DFF * DM / 64; nalt = 1; }
    float mx = 0.f;
    for (int c = q; c < 64; c += nq) { const f32x4 v = *(const f32x4*)(src + (size_t)c * stride + (size_t)(c % nalt) * 2048 + F.tid * 4);
        mx = fmaxf(fmaxf(mx, fmaxf(fabsf(v[0]), fabsf(v[1]))), fmaxf(fabsf(v[2]), fabsf(v[3]))); }
    mx = wave_max(mx);
    if (F.lane == 0 && mx > 0.f) atomicMax(F.ctl + CW_AMAX + j, __float_as_uint(mx));
}
__device__ __forceinline__ void p0_prologue(const Frame& F, const Args& a) {
    unsigned char* ws = F.ws;
    long base = 0;
    p0_sample(F, a);
    static_assert(CONV_P0 == 0, "expert tiles need the sampled scales: none may be converted in the prologue");
    conv_matrix4(F, a.in[I_WIN], DM, IN_COLS, (bf16_t*)(ws + WS_WINT));
    conv_matrix(F, a.in[I_WOUT], DM, DM, (bf16_t*)(ws + WS_WOUTT), base);
    for (int fi = F.bid * NTHREADS + F.tid; fi < 2 * 8 * 32 * 4 * 64; fi += F.G * NTHREADS) {
        const int ln_ = fi & 63, ct = (fi >> 6) & 3, ks = (fi >> 8) & 31, w = (fi >> 13) & 7, j = fi >> 16;
        const float* wp = a.in[I_CW1] + ((size_t)j * 4096 + w * 512 + ks * 16 + (ln_ >> 5) * 8) * 128 + ct * 32 + (ln_ & 31);
        u32x4 fw; fw[0] = cvt_pk_bf16(wp[0], wp[128]); fw[1] = cvt_pk_bf16(wp[256], wp[384]); fw[2] = cvt_pk_bf16(wp[512], wp[640]); fw[3] = cvt_pk_bf16(wp[768], wp[896]);
        *(u32x4*)((bf16_t*)(ws + WS_W1T) + (size_t)fi * 8) = fw; }
    for (int j = 0; j < 2; ++j) conv_matrix(F, a.in[I_CW2] + (size_t)j * 128 * 128, 128, 128, (bf16_t*)(ws + WS_W2T) + (size_t)j * 128 * 128, base);
    { const float* x = a.in[I_X]; const float* g = a.in[I_N1G]; bf16_t* U = (bf16_t*)(ws + WS_U);
      f32x4 vn[8]; int row = F.bid * 8 + F.wid;
#define P0_LDROW(r_) do { const float* xr_ = x + (size_t)(r_) * DM; _Pragma("unroll") for (int i = 0; i < 4; ++i) { vn[2 * i] = *(const f32x4*)(xr_ + i * 512 + F.lane * 8); vn[2 * i + 1] = *(const f32x4*)(xr_ + i * 512 + F.lane * 8 + 4); } } while (0)
      if (row < NTOK) P0_LDROW(row);
      for (; row < NTOK; row += F.G * 8) {
          f32x4 v[8]; float ss = 0.f;
#pragma unroll
          for (int i = 0; i < 8; ++i) v[i] = vn[i];
          if (row + F.G * 8 < NTOK) P0_LDROW(row + F.G * 8);
#pragma unroll
          for (int i = 0; i < 8; ++i)
#pragma unroll
              for (int j = 0; j < 4; ++j) ss += v[i][j] * v[i][j];
          ss = wave_sum(ss); const float rs = rsqrtf(ss * (1.f / DM) + EPS);
#pragma unroll
          for (int i = 0; i < 4; ++i) { const f32x4 g0 = *(const f32x4*)(g + i * 512 + F.lane * 8), g1 = *(const f32x4*)(g + i * 512 + F.lane * 8 + 4);
              const f32x4 a0 = v[2 * i] * rs * g0, a1 = v[2 * i + 1] * rs * g1;
              u32x4 w; w[0] = cvt_pk_bf16(a0[0], a0[1]); w[1] = cvt_pk_bf16(a0[2], a0[3]); w[2] = cvt_pk_bf16(a1[0], a1[1]); w[3] = cvt_pk_bf16(a1[2], a1[3]);
              *(u32x4*)(U + (size_t)row * DM + i * 512 + F.lane * 8) = w; } }
#undef P0_LDROW
    }
    { const int gw = F.bid * 8 + F.wid;
      (void)gw;
      for (int i = F.bid * NTHREADS + F.tid; i < DM * NEXP; i += F.G * NTHREADS) ((float*)(ws + WS_WR2))[i] = a.in[I_N2G][i >> 5] * a.in[I_WR][i];
      for (int i = F.bid * NTHREADS + F.tid; i < HG_W; i += F.G * NTHREADS) { const float l0 = a.in[I_LBL][i], l1 = a.in[I_LBL][HG_W + i]; const float m = fmaxf(l0, l1);
          const float e0 = __expf(l0 - m), e1 = __expf(l1 - m); ((float*)(ws + WS_LB))[i] = e0 / (e0 + e1); } }
}

__device__ __forceinline__ float gelu_tanh(float x) { const float u = 0.7978845608028654f * (x + 0.044715f * x * x * x); return 0.5f * x * (1.f + tanhf(u)); }
__device__ __forceinline__ void p2_compress_naive(const Frame& F, const Args& a) {
    unsigned char* ws = F.ws; const bf16_t* PROJ = (const bf16_t*)(ws + WS_PROJ);
    LAS float* red = (LAS float*)F.lds;
    LAS float* hdn = red + 512;
    const int c = F.tid & 127, kq = F.tid >> 7;
    for (int u = F.bid; u < 2 * 16 * 128; u += F.G) {
        const int j = u >> 11, bg = (u >> 7) & 15, n = u & 127, b = bg >> 1, g = bg & 1;
        bf16_t* dst = (bf16_t*)(ws + (j ? WS_VC : WS_KC)) + ((size_t)bg * 128 + n) * 128;
        if (n == 127) { if (F.tid < 128) dst[F.tid] = 0; continue; }
        const float* w1 = a.in[I_CW1] + (size_t)j * 4096 * 128; const float* pos = a.in[I_CPOS] + (size_t)j * 4096;
        const int colb = (j ? C_VCM : C_KCM) + g * 128;
        float s = 0.f;
        for (int k = kq * 1024; k < kq * 1024 + 1024; ++k) { const int l = k >> 7, d = k & 127;
            const float av = bf2f(PROJ[(size_t)(b * SEQ + 16 * n + l) * PROJ_LD + colb + d]) + pos[k];
            s += av * w1[(size_t)k * 128 + c]; }
        red[kq * 128 + c] = s; __syncthreads();
        if (F.tid < 128) hdn[c] = gelu_tanh(red[c] + red[128 + c] + red[256 + c] + red[384 + c]);
        __syncthreads();
        if (F.tid < 128) { const float* w2 = a.in[I_CW2] + (size_t)j * 128 * 128; float o = 0.f; for (int k = 0; k < 128; ++k) o += hdn[k] * w2[k * 128 + c]; dst[c] = f2bf(o); }
        __syncthreads();
    }
}

__device__ __forceinline__ void hgrn_naive_unit(const Frame& F, const Args& a, int unit) {
    unsigned char* ws = F.ws; const bf16_t* PROJ = (const bf16_t*)(ws + WS_PROJ); bf16_t* YM = (bf16_t*)(ws + WS_YMIX);
    const float* lbv = (const float*)(ws + WS_LB);
    const int b = unit >> 3, h = unit & 7, v = F.tid & 127, kg = F.tid >> 7;
    LAS float* fs = (LAS float*)F.lds;
    LAS float* qs = fs + 2048; LAS float* is_ = qs + 2048; LAS float* red = is_ + 2048  ; LAS float* ob = red + 512  ;
    float S[32];
#pragma unroll
    for (int i = 0; i < 32; ++i) S[i] = 0.f;
    for (int t0 = 0; t0 < SEQ; t0 += 16) {
        for (int i = F.tid; i < 2048; i += NTHREADS) { const int st = i >> 7, k = i & 127; const size_t rowo = (size_t)(b * SEQ + t0 + st) * PROJ_LD + h * 128 + k;
            const float lb = lbv[h * 128 + k];
            fs[i] = lb + (1.f - lb) * sigmoidf_(bf2f(PROJ[rowo + C_HF])); qs[i] = siluf_(bf2f(PROJ[rowo + C_HQ])); is_[i] = bf2f(PROJ[rowo + C_HI]); }
        __syncthreads();
        for (int st = 0; st < 16; ++st) {
            const float iv = is_[st * 128 + v]; float po = 0.f;
#pragma unroll
            for (int kk = 0; kk < 32; ++kk) { const int k = kg * 32 + kk; const float f = fs[st * 128 + k]; S[kk] = f * S[kk] + (1.f - f) * iv; po += S[kk] * qs[st * 128 + k]; }
            red[kg * 128 + v] = po; __syncthreads();
            if (kg == 0) ob[st * 128 + v] = red[v] + red[128 + v] + red[256 + v] + red[384 + v];
            __syncthreads();
        }
        for (int s2 = 0; s2 < 2; ++s2) { const int st = F.wid * 2 + s2; const float o0 = ob[st * 128 + F.lane], o1 = ob[st * 128 + 64 + F.lane];
            const float ss = wave_sum(o0 * o0 + o1 * o1); const float rs = rsqrtf(ss * (1.f / 128.f) + EPS);
            const size_t row = (size_t)(b * SEQ + t0 + st);
            const float g0 = bf2f(PROJ[row * PROJ_LD + C_HGT + h * 128 + F.lane]), g1 = bf2f(PROJ[row * PROJ_LD + C_HGT + h * 128 + 64 + F.lane]);
            YM[row * DM + h * 128 + F.lane] = f2bf(o0 * rs * a.in[I_HGNG][F.lane] * siluf_(g0));
            YM[row * DM + h * 128 + 64 + F.lane] = f2bf(o1 * rs * a.in[I_HGNG][64 + F.lane] * siluf_(g1)); }
        __syncthreads();
    }
}

__device__ __forceinline__ float dot128_bf(const LAS float* q, const bf16_t* k) {
    float s = 0.f;
#pragma unroll
    for (int c = 0; c < 16; ++c) { const u32x4 w = *(const u32x4*)(k + c * 8); float f[8]; unpack8(w, f);
#pragma unroll
        for (int j = 0; j < 8; ++j) s += q[c * 8 + j] * f[j]; }
    return s;
}
__device__ __forceinline__ void softmax4(const Frame& F, LAS float* sc, int stride, int n, LAS float* tmp  ) {
    const int r = F.tid >> 7, i0 = F.tid & 127;
    float m = -INFINITY; for (int i = i0; i < n; i += 128) m = fmaxf(m, sc[r * stride + i]);
    m = wave_max(m); if (F.lane == 0) tmp[F.wid] = m; __syncthreads();
    m = fmaxf(tmp[2 * r], tmp[2 * r + 1]); __syncthreads();
    float s = 0.f;
    for (int i = i0; i < n; i += 128) { const float x = sc[r * stride + i]; const float p = (x == -INFINITY) ? 0.f : __expf(x - m); sc[r * stride + i] = p; s += p; }
    s = wave_sum(s); if (F.lane == 0) tmp[F.wid] = s; __syncthreads();
    s = tmp[2 * r] + tmp[2 * r + 1]; const float inv = s > 0.f ? 1.f / s : 0.f;
    for (int i = i0; i < n; i += 128) sc[r * stride + i] *= inv;
    __syncthreads();
}
__device__ __forceinline__ void attn_naive_unit(const Frame& F, const Args& a, int unit) {
    unsigned char* ws = F.ws; const bf16_t* PROJ = (const bf16_t*)(ws + WS_PROJ); bf16_t* YM = (bf16_t*)(ws + WS_YMIX);
    const int b = unit >> 12, g = (unit >> 11) & 1, t = unit & 2047, bg = b * 2 + g;
    LAS float* qs = (LAS float*)F.lds;
    LAS float* sc = qs + 512;
    LAS float* tmp = sc + 4096;
    LAS float* imp = tmp + 16;
    LAS int* selk = (LAS int*)(imp + 32);
    LAS float* oacc = (LAS float*)(selk + 32);
    const int r4 = F.tid >> 7, d = F.tid & 127;
    const size_t rowq = (size_t)(b * SEQ + t) * PROJ_LD;
    qs[F.tid] = bf2f(PROJ[rowq + C_NQ + (g * 4 + r4) * 128 + d]);
    const float slope = exp2f(-(float)(g * 4 + r4 + 1));
    const float scale = 0.08838834764831845f;
    float gate[3];
#pragma unroll
    for (int c = 0; c < 3; ++c) gate[c] = sigmoidf_(bf2f(PROJ[rowq + C_NGT + (g * 4 + r4) * 3 + c]));
    __syncthreads();
    { const int n = d; float s = -INFINITY;
      if (n < NCMP) { const int dist = t - (16 * n + 31); if (dist >= 0) s = dot128_bf(qs + r4 * 128, (const bf16_t*)(ws + WS_KC) + ((size_t)bg * 128 + n) * 128) * scale - slope * (float)dist; }
      sc[r4 * 1024 + n] = s; }
    __syncthreads();
    softmax4(F, sc, 1024, 128, tmp);
    { float o = 0.f; const bf16_t* vc = (const bf16_t*)(ws + WS_VC) + (size_t)bg * 128 * 128;
      for (int n = 0; n < NCMP; ++n) o += sc[r4 * 1024 + n] * bf2f(vc[n * 128 + d]);
      oacc[F.tid] = gate[0] * o; }
    if (F.tid < 32) { const int j = F.tid; float s = 0.f;
        for (int r = 0; r < 4; ++r) for (int q = -1; q <= 3; ++q) { const int n = 4 * j + q; if (n >= 0 && n < NCMP) s += ((q == -1 || q == 3) ? 1.f : 2.f) * sc[r * 1024 + n]; }
        const int cur = t >> 6; const bool forced = (j == 0) || (j == cur) || (j == cur - 1);
        imp[j] = forced ? 1e4f : (j <= cur ? s : -1e4f); }
    __syncthreads();
    if (F.tid < 32) { const int j = F.tid; const float me = imp[j]; int rank = 0;
        for (int k = 0; k < 32; ++k) { const float o = imp[k]; rank += (o > me || (o == me && k < j)) ? 1 : 0; }
        const bool sel = rank < SEL_TOP && j <= (t >> 6);
        const unsigned long long mask = __ballot(sel);
        if (sel) selk[__popcll(mask & ((1ull << j) - 1ull))] = j;
        if (j == 0) selk[16] = __popcll(mask); }
    __syncthreads();
    { const int nsel = selk[16];
      for (int i = F.tid; i < 4 * 1024; i += NTHREADS) sc[i] = -INFINITY;
      __syncthreads();
      const int l = F.tid & 63, r = (F.tid >> 6) & 3, which = F.tid >> 8;
      for (int s0 = 0; s0 < nsel; s0 += 2) { const int si = s0 + which;
          if (si < nsel) { const int kp = selk[si] * 64 + l;
              if (kp <= t) { const float s = dot128_bf(qs + r * 128, PROJ + (size_t)(b * SEQ + kp) * PROJ_LD + C_KSL + g * 128) * scale - exp2f(-(float)(g * 4 + r + 1)) * (float)(t - kp); sc[r * 1024 + si * 64 + l] = s; } } }
      __syncthreads();
      softmax4(F, sc, 1024, nsel * 64, tmp);
      float o = 0.f;
      for (int si = 0; si < nsel; ++si) { const int kb = selk[si] * 64;
          for (int l2 = 0; l2 < 64; ++l2) { const int kp = kb + l2; if (kp > t) break; o += sc[r4 * 1024 + si * 64 + l2] * bf2f(PROJ[(size_t)(b * SEQ + kp) * PROJ_LD + C_VSL + g * 128 + d]); } }
      oacc[F.tid] += gate[1] * o; }
    __syncthreads();
    { for (int i = F.tid; i < 4 * 1024; i += NTHREADS) sc[i] = -INFINITY;
      __syncthreads();
      for (int i = F.tid; i < 4 * 512; i += NTHREADS) { const int r = i >> 9, w = i & 511, kp = t - 511 + w;
          if (kp >= 0) sc[r * 1024 + w] = dot128_bf(qs + r * 128, PROJ + (size_t)(b * SEQ + kp) * PROJ_LD + C_KWN + g * 128) * scale - exp2f(-(float)(g * 4 + r + 1)) * (float)(t - kp); }
      __syncthreads();
      softmax4(F, sc, 1024, 512, tmp);
      float o = 0.f;
      for (int w = 0; w < 512; ++w) { const int kp = t - 511 + w; if (kp >= 0) o += sc[r4 * 1024 + w] * bf2f(PROJ[(size_t)(b * SEQ + kp) * PROJ_LD + C_VWN + g * 128 + d]); }
      oacc[F.tid] += gate[2] * o; }
    __syncthreads();
    { const float o = oacc[F.tid]; float ss = wave_sum(o * o); if (F.lane == 0) tmp[F.wid] = ss; __syncthreads();
      ss = tmp[2 * r4] + tmp[2 * r4 + 1]; const float rs = rsqrtf(ss * (1.f / 128.f) + EPS);
      YM[(size_t)(b * SEQ + t) * DM + HG_W + (g * 4 + r4) * 128 + d] = f2bf(o * rs * a.in[I_NSAG][d]); }
    __syncthreads();
}

namespace at {
constexpr int SHM_T = 64 * 128 * 2;
constexpr int BUF_B = 2 * SHM_T;
constexpr int OFF_V = 0, OFF_K = SHM_T, OFF_IMP = 2 * BUF_B  , OFF_SELM = 3 * BUF_B, OFF_WSC = OFF_SELM + 256;
constexpr float SCALE = 0.08838834764831845f, LOG2E = 1.4426950408889634f, THR = 8.f;
#define AT_KSWZ(row, colB) ((row) * 256 + ((colB) ^ (((row) & 7) << 4)))
__device__ __forceinline__ int v_st(int k, int c) { const int kk = (k & ~0xC) | ((k & 4) << 1) | ((k & 8) >> 1); return ((kk >> 3) * 4 + (c >> 5)) * 512 + ((kk & 7) * 32 + (c & 31)) * 2; }
__device__ __forceinline__ int v_rd_base(int lane) { return ((lane & 3) << 3) | (((lane >> 2) & 3) << 6) | (((lane >> 4) & 1) << 5) | (((lane >> 5) & 1) << 8); }
__device__ __forceinline__ int crow(int r, int hi) { return (r & 3) + 8 * (r >> 2) + 4 * hi; }
typedef short s16x4 __attribute__((ext_vector_type(4)));
struct Stage { u32x4 k0, k1, v0, v1; };
__device__ __forceinline__ void stage_load(Stage& S, const bf16_t* Kp, const bf16_t* Vp, int ld, int row0, int sr, int sc) {
    S.k0 = *(const u32x4*)(Kp + (size_t)(row0 + sr) * ld + sc); S.k1 = *(const u32x4*)(Kp + (size_t)(row0 + 32 + sr) * ld + sc);
    S.v0 = *(const u32x4*)(Vp + (size_t)(row0 + sr) * ld + sc); S.v1 = *(const u32x4*)(Vp + (size_t)(row0 + 32 + sr) * ld + sc);
}
__device__ __forceinline__ void stage_write(const Stage& S, LAS unsigned char* lds, int buf, int sr, int sc) {
    const int kws = AT_KSWZ(sr, sc * 2);
    *(LAS u32x4*)(lds + OFF_K + buf * BUF_B + kws) = S.k0; *(LAS u32x4*)(lds + OFF_K + buf * BUF_B + kws + 32 * 256) = S.k1;
    *(LAS u32x4*)(lds + OFF_V + buf * BUF_B + v_st(sr, sc)) = S.v0; *(LAS u32x4*)(lds + OFF_V + buf * BUF_B + v_st(32 + sr, sc)) = S.v1;
}
__device__ __forceinline__ void qkt(f32x16& p0, f32x16& p1, const LAS unsigned char* ktile, int r32, int hi, const bf16x8 (&qr)[8]) {
#pragma unroll
    for (int r = 0; r < 16; ++r) { p0[r] = 0.f; p1[r] = 0.f; }
    const LAS unsigned char* kb[4];
#pragma unroll
    for (int dd = 0; dd < 4; ++dd) kb[dd] = ktile + AT_KSWZ(r32, (dd * 16 + hi * 8) * 2);
#pragma unroll
    for (int d0 = 0; d0 < 8; ++d0) { const LAS unsigned char* a = kb[d0 & 3] + (d0 >> 2) * 128;
        const bf16x8 b0 = *(const LAS bf16x8*)a; const bf16x8 b1 = *(const LAS bf16x8*)(a + 32 * 256);
        p0 = __builtin_amdgcn_mfma_f32_32x32x16_bf16(b0, qr[d0], p0, 0, 0, 0);
        p1 = __builtin_amdgcn_mfma_f32_32x32x16_bf16(b1, qr[d0], p1, 0, 0, 0); }
}
__device__ __forceinline__ void pv_tile(f32x16 (&o)[4], int vb, bf16x8 pa0, bf16x8 pa1, bf16x8 pa2, bf16x8 pa3) {
#define AT_TRRD(dst, off) asm volatile("ds_read_b64_tr_b16 %0, %1 offset:%2" : "=&v"(dst) : "v"(vb), "i"(off) : "memory")
#define AT_PV_D0(d0) do { s16x4 l0, l1, l2, l3, h0, h1, h2, h3; constexpr int b_ = (d0) * 512; \
        AT_TRRD(l0, b_); AT_TRRD(h0, b_ + 2048); AT_TRRD(l1, b_ + 4096); AT_TRRD(h1, b_ + 6144); AT_TRRD(l2, b_ + 8192); AT_TRRD(h2, b_ + 10240); AT_TRRD(l3, b_ + 12288); AT_TRRD(h3, b_ + 14336); \
        asm volatile("s_waitcnt lgkmcnt(0)" ::: "memory"); __builtin_amdgcn_sched_barrier(0); \
        o[d0] = __builtin_amdgcn_mfma_f32_32x32x16_bf16(pa0, (bf16x8){l0[0], l0[1], l0[2], l0[3], h0[0], h0[1], h0[2], h0[3]}, o[d0], 0, 0, 0); \
        o[d0] = __builtin_amdgcn_mfma_f32_32x32x16_bf16(pa1, (bf16x8){l1[0], l1[1], l1[2], l1[3], h1[0], h1[1], h1[2], h1[3]}, o[d0], 0, 0, 0); \
        o[d0] = __builtin_amdgcn_mfma_f32_32x32x16_bf16(pa2, (bf16x8){l2[0], l2[1], l2[2], l2[3], h2[0], h2[1], h2[2], h2[3]}, o[d0], 0, 0, 0); \
        o[d0] = __builtin_amdgcn_mfma_f32_32x32x16_bf16(pa3, (bf16x8){l3[0], l3[1], l3[2], l3[3], h3[0], h3[1], h3[2], h3[3]}, o[d0], 0, 0, 0); } while (0)
    AT_PV_D0(0); AT_PV_D0(1); AT_PV_D0(2); AT_PV_D0(3);
#undef AT_PV_D0
#undef AT_TRRD
}
__device__ __forceinline__ float swap_max(float v) { auto rr = __builtin_amdgcn_permlane32_swap(__float_as_uint(v), __float_as_uint(v), false, false); return fmaxf(__uint_as_float(rr[0]), __uint_as_float(rr[1])); }
__device__ __forceinline__ float swap_sum(float v) { auto rr = __builtin_amdgcn_permlane32_swap(__float_as_uint(v), __float_as_uint(v), false, false); return __uint_as_float(rr[0]) + __uint_as_float(rr[1]); }
__device__ __forceinline__ void pack_p(const f32x16& P, bf16x8& outA, bf16x8& outB) {
#define AT_PK4(B_, OUT) do { unsigned a0 = cvt_pk_bf16(P[B_ + 0], P[B_ + 1]), a1 = cvt_pk_bf16(P[B_ + 2], P[B_ + 3]); \
        unsigned b0 = cvt_pk_bf16(P[B_ + 4], P[B_ + 5]), b1 = cvt_pk_bf16(P[B_ + 6], P[B_ + 7]); \
        auto r0 = __builtin_amdgcn_permlane32_swap(a0, b0, false, false); auto r1 = __builtin_amdgcn_permlane32_swap(a1, b1, false, false); \
        u32x4 w = {r0[0], r1[0], r0[1], r1[1]}; OUT = *reinterpret_cast<bf16x8*>(&w); } while (0)
    AT_PK4(0, outA); AT_PK4(8, outB);
#undef AT_PK4
}
__device__ __forceinline__ float online_sm1(const f32x16& p0, const f32x16& p1, float& m_reg, float& mnL) {
    float pmax = p0[0];
#pragma unroll
    for (int r = 1; r < 16; ++r) pmax = fmaxf(pmax, p0[r]);
#pragma unroll
    for (int r = 0; r < 16; ++r) pmax = fmaxf(pmax, p1[r]);
    pmax = swap_max(pmax);
    float mn, alpha;
    if (__all(pmax - m_reg <= THR)) { mn = m_reg; alpha = 1.f; }
    else { mn = fmaxf(m_reg, pmax); alpha = __builtin_amdgcn_exp2f((m_reg - mn) * LOG2E); m_reg = mn; }
    mnL = -mn * LOG2E;
    return alpha;
}
__device__ __forceinline__ void online_sm2(f32x16& p0, f32x16& p1, float mnL, float alpha, float& l_reg) {
    float ps = 0.f;
#pragma unroll
    for (int r = 0; r < 16; ++r) { p0[r] = __builtin_amdgcn_exp2f(fmaf(p0[r], LOG2E, mnL)); p1[r] = __builtin_amdgcn_exp2f(fmaf(p1[r], LOG2E, mnL)); ps += p0[r] + p1[r]; }
    ps = swap_sum(ps);
    l_reg = l_reg * alpha + ps;
}
template <int MODE>
__device__ __forceinline__ void branch_loop(f32x16 (&o)[4], float& l_out, LAS unsigned char* lds, const bf16_t* Kp, const bf16_t* Vp, int jlo, int qt,
                                            const bf16x8 (&qr)[8], int tq, float slope, unsigned selbits, int r32, int hi, int sr, int sc, LAS float* wsc, int wave_tmin, int grpB) {
    float m_reg = -1e30f, l_reg = 0.f;
#pragma unroll
    for (int d = 0; d < 4; ++d)
#pragma unroll
        for (int r = 0; r < 16; ++r) o[d][r] = 0.f;
    const int vb0 = (int)(uintptr_t)(lds + OFF_V) + v_rd_base(r32 + 32 * hi);
    const int NT = qt - jlo + 1;
#define AT_LGKM0() asm volatile("s_waitcnt lgkmcnt(0)" ::: "memory")
#define AT_BAR() do { AT_LGKM0(); __builtin_amdgcn_s_barrier(); asm volatile("" ::: "memory"); } while (0)
    Stage S0, S1; stage_load(S0, Kp, Vp, PROJ_LD, jlo * 64, sr, sc); stage_write(S0, lds, 0, sr, sc);
    if (NT > 1) { stage_load(S1, Kp, Vp, PROJ_LD, (jlo + 1) * 64, sr, sc); stage_write(S1, lds, 1, sr, sc); }
    if (NT > 2) stage_load(S0, Kp, Vp, PROJ_LD, (jlo + 2) * 64, sr, sc);
    if (NT > 3) stage_load(S1, Kp, Vp, PROJ_LD, (jlo + 3) * 64, sr, sc);
    __syncthreads();
    if (grpB) AT_BAR();
    int buf = 0;
#define AT_STEP(tau, SX) do { \
        const int j = jlo + (tau); \
        f32x16 p0, p1; \
        qkt(p0, p1, lds + OFF_K + buf * BUF_B, r32, hi, qr); \
        const int kbase = j * 64; const int dq = tq - kbase - 4 * hi; \
        const float base_f = slope * (float)(-dq); \
        _Pragma("unroll") for (int r = 0; r < 16; ++r) { const int cc = (r & 3) + 8 * (r >> 2); \
            p0[r] = fmaf(p0[r], SCALE, fmaf(slope, (float)cc, base_f)); p1[r] = fmaf(p1[r], SCALE, fmaf(slope, (float)(cc + 32), base_f)); } \
        if (MODE == 1) { \
            const bool on = (selbits >> j) & 1u; \
            if (j == qt) { \
                _Pragma("unroll") for (int r = 0; r < 16; ++r) { const int cc = (r & 3) + 8 * (r >> 2); if (!on || cc > dq) p0[r] = -INFINITY; if (!on || cc + 32 > dq) p1[r] = -INFINITY; } \
            } else if (!__all(on)) { \
                _Pragma("unroll") for (int r = 0; r < 16; ++r) { if (!on) { p0[r] = -INFINITY; p1[r] = -INFINITY; } } \
            } \
        } else { \
            if (kbase + 63 > wave_tmin || kbase < wave_tmin + 31 - (WINDOW - 1)) { \
                _Pragma("unroll") for (int r = 0; r < 16; ++r) { const int cc = (r & 3) + 8 * (r >> 2); \
                    if ((unsigned)(dq - cc) >= (unsigned)WINDOW) p0[r] = -INFINITY; if ((unsigned)(dq - cc - 32) >= (unsigned)WINDOW) p1[r] = -INFINITY; } \
            } \
        } \
        float mnL; const float alpha = online_sm1(p0, p1, m_reg, mnL); \
        AT_BAR(); \
        if ((tau) + 2 < NT) { int b2 = buf + 2; if (b2 >= 3) b2 -= 3; stage_write(SX, lds, b2, sr, sc); } \
        if ((tau) + 4 < NT) stage_load(SX, Kp, Vp, PROJ_LD, (j + 4) * 64, sr, sc); \
        online_sm2(p0, p1, mnL, alpha, l_reg); \
        bf16x8 pa0, pa1, pa2, pa3; pack_p(p0, pa0, pa1); pack_p(p1, pa2, pa3); \
        if (__any(alpha < 1.f)) { if (hi == 0) wsc[r32] = alpha; \
            _Pragma("unroll") for (int r = 0; r < 16; ++r) { const float al = wsc[crow(r, hi)]; \
                _Pragma("unroll") for (int d = 0; d < 4; ++d) o[d][r] *= al; } } \
        pv_tile(o, vb0 + buf * BUF_B, pa0, pa1, pa2, pa3); \
        AT_BAR(); \
        buf = buf + 1; if (buf >= 3) buf = 0; } while (0)
    for (int tau = 0; tau < NT; tau += 2) {
        AT_STEP(tau, S0);
        if (tau + 1 < NT) AT_STEP(tau + 1, S1);
    }
#undef AT_STEP
    if (!grpB) AT_BAR();
#undef AT_BAR
#undef AT_LGKM0
    l_out = l_reg;
    __syncthreads();
}
}

__device__ __forceinline__ void attn_fast_unit(const Frame& F, const Args& a, int unit) {
    using namespace at;
    unsigned char* ws = F.ws; const bf16_t* PROJ = (const bf16_t*)(ws + WS_PROJ); bf16_t* YM = (bf16_t*)(ws + WS_YMIX);
    LAS unsigned char* lds = F.lds;
    const int qt = 31 - (unit >> 4), bg = unit & 15, b = bg >> 1, g = bg & 1;
    int tz = threadIdx.x; asm volatile("" : "+v"(tz));
    const int lane = tz & 63, r32 = lane & 31, hi = lane >> 5, head = F.wid & 3, qh = F.wid >> 2;
    const int t0 = qt * 64, tq = t0 + qh * 32 + r32, wave_tmin = t0 + qh * 32;
    const int sr = tz >> 4, sc = (tz & 15) * 8;
    const float slope = exp2f(-(float)(g * 4 + head + 1));
    LAS float* wsc = (LAS float*)(lds + OFF_WSC) + F.wid * 256;
    LAS float* imph = (LAS float*)(lds + OFF_IMP);
    LAS unsigned* selm = (LAS unsigned*)(lds + OFF_SELM);
    bf16x8 qr[8];
    { const bf16_t* qp = PROJ + (size_t)(b * SEQ + tq) * PROJ_LD + C_NQ + (g * 4 + head) * 128 + hi * 8;
#pragma unroll
      for (int d0 = 0; d0 < 8; ++d0) qr[d0] = *(const bf16x8*)(qp + d0 * 16); }
    float gate[3];
    { const bf16_t* gp = PROJ + (size_t)(b * SEQ + tq) * PROJ_LD + C_NGT + (g * 4 + head) * 3;
#pragma unroll
      for (int c = 0; c < 3; ++c) gate[c] = sigmoidf_(bf2f(gp[c])); }
    f32x16 o[4];
    float* otp = (float*)(ws + WS_OT) + ((size_t)F.bid * 512 + tz) * 64;
    { const bf16_t* Kc = (const bf16_t*)(ws + WS_KC) + (size_t)bg * 128 * 128; const bf16_t* Vc = (const bf16_t*)(ws + WS_VC) + (size_t)bg * 128 * 128;
      Stage S; stage_load(S, Kc, Vc, 128, 0, sr, sc); stage_write(S, lds, 0, sr, sc);
      stage_load(S, Kc, Vc, 128, 64, sr, sc); stage_write(S, lds, 1, sr, sc);
      __syncthreads();
      f32x16 p0, p1, p2, p3;
      qkt(p0, p1, lds + OFF_K, r32, hi, qr); qkt(p2, p3, lds + OFF_K + BUF_B, r32, hi, qr);
      const int dl0 = ((tq - 31) >> 4) - 4 * hi;
      const float base_f = slope * (float)(16 * 4 * hi + 31 - tq);
      float mx = -INFINITY;
#pragma unroll
      for (int r = 0; r < 16; ++r) { const int cc = (r & 3) + 8 * (r >> 2);
          p0[r] = (cc <= dl0)      ? fmaf(p0[r], SCALE, fmaf(slope, (float)(16 * cc), base_f))        : -INFINITY;
          p1[r] = (cc + 32 <= dl0) ? fmaf(p1[r], SCALE, fmaf(slope, (float)(16 * (cc + 32)), base_f)) : -INFINITY;
          p2[r] = (cc + 64 <= dl0) ? fmaf(p2[r], SCALE, fmaf(slope, (float)(16 * (cc + 64)), base_f)) : -INFINITY;
          p3[r] = (cc + 96 <= dl0) ? fmaf(p3[r], SCALE, fmaf(slope, (float)(16 * (cc + 96)), base_f)) : -INFINITY;
          mx = fmaxf(fmaxf(mx, p0[r]), fmaxf(p1[r], fmaxf(p2[r], p3[r]))); }
      mx = swap_max(mx);
      const float mL = (mx == -INFINITY) ? 0.f : -mx * LOG2E;
      float ps = 0.f;
#pragma unroll
      for (int r = 0; r < 16; ++r) { p0[r] = __builtin_amdgcn_exp2f(fmaf(p0[r], LOG2E, mL)); p1[r] = __builtin_amdgcn_exp2f(fmaf(p1[r], LOG2E, mL));
          p2[r] = __builtin_amdgcn_exp2f(fmaf(p2[r], LOG2E, mL)); p3[r] = __builtin_amdgcn_exp2f(fmaf(p3[r], LOG2E, mL)); ps += (p0[r] + p1[r]) + (p2[r] + p3[r]); }
      ps = swap_sum(ps);
      const float inv = ps > 0.f ? 1.f / ps : 0.f;
#pragma unroll
      for (int r = 0; r < 16; ++r) { p0[r] *= inv; p1[r] *= inv; p2[r] *= inv; p3[r] *= inv; }
      { LAS float* dst = imph + ((size_t)head * 64 + qh * 32 + r32) * 32;
        float prev = 0.f;
#define AT_GRP(P, blk) do { _Pragma("unroll") for (int i = 0; i < 4; ++i) { const float av = 2.f * (P[4 * i] + P[4 * i + 1] + P[4 * i + 2]) + P[4 * i + 3]; const float bv = P[4 * i + 3]; \
            auto rr = __builtin_amdgcn_permlane32_swap(__float_as_uint(bv), __float_as_uint(bv), false, false); const float pb = __uint_as_float(hi ? rr[0] : rr[1]); \
            dst[2 * ((blk) * 4 + i) + hi] = av + (hi ? pb : prev); prev = pb; } } while (0)
        AT_GRP(p0, 0); AT_GRP(p1, 1); AT_GRP(p2, 2); AT_GRP(p3, 3);
#undef AT_GRP
      }
      bf16x8 pa0, pa1, pa2, pa3;
#pragma unroll
      for (int d = 0; d < 4; ++d)
#pragma unroll
          for (int r = 0; r < 16; ++r) o[d][r] = 0.f;
      const int vb0 = (int)(uintptr_t)(lds + OFF_V) + v_rd_base(lane);
      pack_p(p0, pa0, pa1); pack_p(p1, pa2, pa3); pv_tile(o, vb0, pa0, pa1, pa2, pa3);
      pack_p(p2, pa0, pa1); pack_p(p3, pa2, pa3); pv_tile(o, vb0 + BUF_B, pa0, pa1, pa2, pa3);
      if (hi == 0) wsc[r32] = gate[0];
#pragma unroll
      for (int r = 0; r < 16; ++r) { const float f = wsc[crow(r, hi)];
#pragma unroll
          for (int d = 0; d < 4; ++d) o[d][r] *= f; }
#pragma unroll
      for (int d = 0; d < 4; ++d)
#pragma unroll
          for (int k = 0; k < 4; ++k) *(f32x4*)(otp + d * 16 + 4 * k) = (f32x4){o[d][4 * k], o[d][4 * k + 1], o[d][4 * k + 2], o[d][4 * k + 3]};
    }
    __syncthreads();
    { const int q = tz >> 3, part = tz & 7, tqq = t0 + q, cur = tqq >> 6;
      unsigned bits = 0u;
      if (cur < SEL_TOP) { bits = (part == 0) ? ((2u << cur) - 1u) : 0u; }
      else {
          float sc_[4];
#pragma unroll
          for (int k = 0; k < 4; ++k) { const int j = part * 4 + k; const float v = ((imph[(0 * 64 + q) * 32 + j] + imph[(1 * 64 + q) * 32 + j]) + imph[(2 * 64 + q) * 32 + j]) + imph[(3 * 64 + q) * 32 + j];
              const bool forced = (j == 0) || (j == cur) || (j == cur - 1); sc_[k] = forced ? 1e4f : (j <= cur ? v : -1e4f); }
          int rank[4] = {0, 0, 0, 0};
          for (int jj = 0; jj < 32; ++jj) { const float v = ((imph[(0 * 64 + q) * 32 + jj] + imph[(1 * 64 + q) * 32 + jj]) + imph[(2 * 64 + q) * 32 + jj]) + imph[(3 * 64 + q) * 32 + jj];
              const bool forced = (jj == 0) || (jj == cur) || (jj == cur - 1); const float s2 = forced ? 1e4f : (jj <= cur ? v : -1e4f);
#pragma unroll
              for (int k = 0; k < 4; ++k) { const int j = part * 4 + k; rank[k] += (s2 > sc_[k] || (s2 == sc_[k] && jj < j)) ? 1 : 0; } }
#pragma unroll
          for (int k = 0; k < 4; ++k) { const int j = part * 4 + k; if (rank[k] < SEL_TOP && j <= cur) bits |= 1u << j; }
      }
      bits |= __shfl_xor(bits, 1); bits |= __shfl_xor(bits, 2); bits |= __shfl_xor(bits, 4);
      if (part == 0) selm[q] = bits; }
    __syncthreads();
    const unsigned selbits = selm[qh * 32 + r32];
    { float l_sel;
      branch_loop<1>(o, l_sel, lds, PROJ + (size_t)(b * SEQ) * PROJ_LD + C_KSL + g * 128, PROJ + (size_t)(b * SEQ) * PROJ_LD + C_VSL + g * 128, 0, qt, qr, tq, slope, selbits, r32, hi, sr, sc, wsc, wave_tmin, qh);
      if (hi == 0) wsc[r32] = gate[1] / l_sel;
#pragma unroll
      for (int r = 0; r < 16; ++r) { const float f = wsc[crow(r, hi)];
#pragma unroll
          for (int d = 0; d < 4; ++d) o[d][r] *= f; }
#pragma unroll
      for (int d = 0; d < 4; ++d)
#pragma unroll
          for (int k = 0; k < 4; ++k) { const f32x4 pv = *(const f32x4*)(otp + d * 16 + 4 * k); *(f32x4*)(otp + d * 16 + 4 * k) = pv + (f32x4){o[d][4 * k], o[d][4 * k + 1], o[d][4 * k + 2], o[d][4 * k + 3]}; } }
    { float l_win; const int jlo = (t0 - (WINDOW - 1)) > 0 ? (t0 - (WINDOW - 1)) >> 6 : 0;
      branch_loop<2>(o, l_win, lds, PROJ + (size_t)(b * SEQ) * PROJ_LD + C_KWN + g * 128, PROJ + (size_t)(b * SEQ) * PROJ_LD + C_VWN + g * 128, jlo, qt, qr, tq, slope, 0u, r32, hi, sr, sc, wsc, wave_tmin, qh);
      if (hi == 0) wsc[r32] = gate[2] / l_win;
#pragma unroll
      for (int r = 0; r < 16; ++r) { const float f = wsc[crow(r, hi)];
#pragma unroll
          for (int d = 0; d < 4; ++d) o[d][r] *= f; }
#pragma unroll
      for (int d = 0; d < 4; ++d)
#pragma unroll
          for (int k = 0; k < 4; ++k) { const f32x4 pv = *(const f32x4*)(otp + d * 16 + 4 * k); o[d][4 * k] += pv[0]; o[d][4 * k + 1] += pv[1]; o[d][4 * k + 2] += pv[2]; o[d][4 * k + 3] += pv[3]; } }
    { const float* ng = a.in[I_NSAG];
      float gsc[4];
#pragma unroll
      for (int d = 0; d < 4; ++d) gsc[d] = ng[d * 32 + r32];
#pragma unroll
      for (int r = 0; r < 16; ++r) { float ss = 0.f;
#pragma unroll
          for (int d = 0; d < 4; ++d) ss += o[d][r] * o[d][r];
          ss += __shfl_xor(ss, 1); ss += __shfl_xor(ss, 2); ss += __shfl_xor(ss, 4); ss += __shfl_xor(ss, 8); ss += __shfl_xor(ss, 16);
          const float rs = rsqrtf(ss * (1.f / 128.f) + EPS);
          const int row = b * SEQ + t0 + qh * 32 + crow(r, hi);
          bf16_t* yp = YM + (size_t)row * DM + HG_W + (g * 4 + head) * 128 + r32;
#pragma unroll
          for (int d = 0; d < 4; ++d) yp[d * 32] = f2bf(o[d][r] * rs * gsc[d]); } }
    __syncthreads();
}

namespace hg {
constexpr int T_KD = 0, T_QD = 16384, T_V = 32768, T_KL = 49152, T_FR = 65536, T_QR = 81920, T_OR = 98304, T_PART = 114688, T_DL = T_PART + 2048, T_SSQ = T_DL + 512;
}
__device__ __forceinline__ void hgrn_fast_unit(const Frame& F, const Args& a, int unit) {
    using namespace hg; using at::crow; using at::v_st; using at::v_rd_base; typedef at::s16x4 s16x4;
    unsigned char* ws = F.ws; const bf16_t* PROJ = (const bf16_t*)(ws + WS_PROJ); bf16_t* YM = (bf16_t*)(ws + WS_YMIX);
    LAS unsigned char* lds = F.lds;
    const int b = unit >> 3, h = unit & 7;
    int tz = threadIdx.x; asm volatile("" : "+v"(tz));
    const int lane = tz & 63, r32 = lane & 31, hi = lane >> 5, th = F.wid & 1, vq = F.wid >> 1;
    const int lr = tz >> 4, lc = (tz & 15) * 8;
    const int kc = tz & 127, tg = tz >> 7;
    LAS float* part = (LAS float*)(lds + T_PART); LAS float* dl = (LAS float*)(lds + T_DL); LAS float* ssq = (LAS float*)(lds + T_SSQ);
    f32x16 Sacc[4];
#pragma unroll
    for (int k = 0; k < 4; ++k)
#pragma unroll
        for (int r = 0; r < 16; ++r) Sacc[k][r] = 0.f;
    const bf16_t* base = PROJ + (size_t)(b * SEQ) * PROJ_LD + h * 128;
    u32x4 rf0, rf1, rq0, rq1, ri0, ri1, ro0, ro1;
    const bf16_t* obase = (const bf16_t*)(ws + WS_OMF) + (size_t)(b * SEQ) * HG_W + h * 128;
#define HG_LOAD(t0_) do { const bf16_t* p0_ = base + (size_t)((t0_) + lr) * PROJ_LD + lc; const bf16_t* p1_ = p0_ + (size_t)32 * PROJ_LD; \
        rf0 = *(const u32x4*)(p0_ + C_HF); rf1 = *(const u32x4*)(p1_ + C_HF); rq0 = *(const u32x4*)(p0_ + C_HQ); rq1 = *(const u32x4*)(p1_ + C_HQ); \
        ri0 = *(const u32x4*)(p0_ + C_HI); ri1 = *(const u32x4*)(p1_ + C_HI); \
        ro0 = *(const u32x4*)(obase + (size_t)((t0_) + lr) * HG_W + lc); ro1 = *(const u32x4*)(obase + (size_t)((t0_) + lr + 32) * HG_W + lc); } while (0)
    HG_LOAD(0);
    const float ngv = a.in[I_HGNG][vq * 32 + r32];
    for (int c = 0; c < SEQ / 64; ++c) {
        const int t0 = c * 64;
        *(LAS u32x4*)(lds + T_FR + lr * 256 + lc * 2) = rf0; *(LAS u32x4*)(lds + T_FR + (lr + 32) * 256 + lc * 2) = rf1;
        *(LAS u32x4*)(lds + T_QR + lr * 256 + lc * 2) = rq0; *(LAS u32x4*)(lds + T_QR + (lr + 32) * 256 + lc * 2) = rq1;
        *(LAS u32x4*)(lds + T_OR + lr * 256 + lc * 2) = ro0; *(LAS u32x4*)(lds + T_OR + (lr + 32) * 256 + lc * 2) = ro1;
        *(LAS u32x4*)(lds + T_V + v_st(lr, lc)) = ri0; *(LAS u32x4*)(lds + T_V + v_st(lr + 32, lc)) = ri1;
        __syncthreads();
        float lf[16]; float run = 0.f;
#pragma unroll
        for (int i = 0; i < 16; ++i) { const int t = tg * 16 + i; run += bf2f(*(const LAS bf16_t*)(lds + T_FR + t * 256 + kc * 2)); lf[i] = run; }
        part[tg * 128 + kc] = run;
        __syncthreads();
        { const float p0_ = part[kc], p1_ = part[128 + kc], p2_ = part[256 + kc], p3_ = part[384 + kc];
          const float pre = (tg > 0 ? p0_ : 0.f) + (tg > 1 ? p1_ : 0.f) + (tg > 2 ? p2_ : 0.f); const float tot = ((p0_ + p1_) + p2_) + p3_;
          const float dlast = __builtin_amdgcn_exp2f(tot);
          if (tg == 0) dl[kc] = dlast;
#pragma unroll
          for (int i = 0; i < 16; ++i) { const int t = tg * 16 + i; const float bb = pre + lf[i];
              const float qv = bf2f(*(const LAS bf16_t*)(lds + T_QR + t * 256 + kc * 2)), om = bf2f(*(const LAS bf16_t*)(lds + T_OR + t * 256 + kc * 2));
              const float qd = qv * __builtin_amdgcn_exp2f(bb), kd = om * __builtin_amdgcn_exp2f(-bb), kl = kd * dlast;
              const int ko = AT_KSWZ(t, kc * 2);
              *(LAS bf16_t*)(lds + T_QD + ko) = f2bf(qd); *(LAS bf16_t*)(lds + T_KD + ko) = f2bf(kd); *(LAS bf16_t*)(lds + T_KL + v_st(t, kc)) = f2bf(kl); } }
        __syncthreads();
        if (c + 1 < SEQ / 64) HG_LOAD(t0 + 64);
        const int tl = th * 32 + r32;
        bf16x8 qr[8];
#pragma unroll
        for (int d0 = 0; d0 < 8; ++d0) qr[d0] = *(const LAS bf16x8*)(lds + T_QD + AT_KSWZ(tl, (d0 * 16 + hi * 8) * 2));
        f32x16 p0, p1;
        at::qkt(p0, p1, lds + T_KD, r32, hi, qr);
#pragma unroll
        for (int r = 0; r < 16; ++r) { const int s = crow(r, hi); if (s > tl) p0[r] = 0.f; if (s + 32 > tl) p1[r] = 0.f; }
        bf16x8 pa0, pa1, pa2, pa3; at::pack_p(p0, pa0, pa1); at::pack_p(p1, pa2, pa3);
        f32x16 o;
#pragma unroll
        for (int r = 0; r < 16; ++r) o[r] = 0.f;
        const int vb = (int)(uintptr_t)(lds + T_V) + v_rd_base(lane) + vq * 512;
        const int klb = (int)(uintptr_t)(lds + T_KL) + v_rd_base(lane);
#define HG_TRRD(dst, addr, off) asm volatile("ds_read_b64_tr_b16 %0, %1 offset:%2" : "=&v"(dst) : "v"(addr), "i"(off) : "memory")
        s16x4 vl0, vh0, vl1, vh1, vl2, vh2, vl3, vh3;
        HG_TRRD(vl0, vb, 0); HG_TRRD(vh0, vb, 2048); HG_TRRD(vl1, vb, 4096); HG_TRRD(vh1, vb, 6144); HG_TRRD(vl2, vb, 8192); HG_TRRD(vh2, vb, 10240); HG_TRRD(vl3, vb, 12288); HG_TRRD(vh3, vb, 14336);
        asm volatile("s_waitcnt lgkmcnt(0)" ::: "memory"); __builtin_amdgcn_sched_barrier(0);
        const bf16x8 vf0 = (bf16x8){vl0[0], vl0[1], vl0[2], vl0[3], vh0[0], vh0[1], vh0[2], vh0[3]}, vf1 = (bf16x8){vl1[0], vl1[1], vl1[2], vl1[3], vh1[0], vh1[1], vh1[2], vh1[3]};
        const bf16x8 vf2 = (bf16x8){vl2[0], vl2[1], vl2[2], vl2[3], vh2[0], vh2[1], vh2[2], vh2[3]}, vf3 = (bf16x8){vl3[0], vl3[1], vl3[2], vl3[3], vh3[0], vh3[1], vh3[2], vh3[3]};
        o = __builtin_amdgcn_mfma_f32_32x32x16_bf16(pa0, vf0, o, 0, 0, 0); o = __builtin_amdgcn_mfma_f32_32x32x16_bf16(pa1, vf1, o, 0, 0, 0);
        o = __builtin_amdgcn_mfma_f32_32x32x16_bf16(pa2, vf2, o, 0, 0, 0); o = __builtin_amdgcn_mfma_f32_32x32x16_bf16(pa3, vf3, o, 0, 0, 0);
#pragma unroll
        for (int kb = 0; kb < 4; ++kb)
#pragma unroll
            for (int sp = 0; sp < 2; ++sp) {
                const u32x2 a_lo = *(const LAS u32x2*)(lds + T_QD + tl * 256 + ((((4 * kb + 2 * sp) * 16)) ^ ((tl & 7) << 4)) + 8 * hi);
                const u32x2 a_hi = *(const LAS u32x2*)(lds + T_QD + tl * 256 + ((((4 * kb + 2 * sp + 1) * 16)) ^ ((tl & 7) << 4)) + 8 * hi);
                u32x4 aw = {a_lo[0], a_lo[1], a_hi[0], a_hi[1]};
                u32x4 bw = {cvt_pk_bf16(Sacc[kb][8 * sp + 0], Sacc[kb][8 * sp + 1]), cvt_pk_bf16(Sacc[kb][8 * sp + 2], Sacc[kb][8 * sp + 3]),
                            cvt_pk_bf16(Sacc[kb][8 * sp + 4], Sacc[kb][8 * sp + 5]), cvt_pk_bf16(Sacc[kb][8 * sp + 6], Sacc[kb][8 * sp + 7])};
                o = __builtin_amdgcn_mfma_f32_32x32x16_bf16(*reinterpret_cast<bf16x8*>(&aw), *reinterpret_cast<bf16x8*>(&bw), o, 0, 0, 0); }
        float gt[16];
#pragma unroll
        for (int r = 0; r < 16; ++r) gt[r] = bf2f(base[(size_t)(t0 + th * 32 + crow(r, hi)) * PROJ_LD + C_HGT + vq * 32 + r32]);
#define HG_SUPD(kb) do { \
            _Pragma("unroll") for (int i4 = 0; i4 < 4; ++i4) { const f32x4 dv = *(const LAS f32x4*)(dl + (kb) * 32 + 8 * i4 + 4 * hi); \
                Sacc[kb][4 * i4] *= dv[0]; Sacc[kb][4 * i4 + 1] *= dv[1]; Sacc[kb][4 * i4 + 2] *= dv[2]; Sacc[kb][4 * i4 + 3] *= dv[3]; } \
            s16x4 al0, ah0, al1, ah1, al2, ah2, al3, ah3; \
            HG_TRRD(al0, klb, (kb) * 512); HG_TRRD(ah0, klb, (kb) * 512 + 2048); HG_TRRD(al1, klb, (kb) * 512 + 4096); HG_TRRD(ah1, klb, (kb) * 512 + 6144); \
            HG_TRRD(al2, klb, (kb) * 512 + 8192); HG_TRRD(ah2, klb, (kb) * 512 + 10240); HG_TRRD(al3, klb, (kb) * 512 + 12288); HG_TRRD(ah3, klb, (kb) * 512 + 14336); \
            asm volatile("s_waitcnt lgkmcnt(0)" ::: "memory"); __builtin_amdgcn_sched_barrier(0); \
            Sacc[kb] = __builtin_amdgcn_mfma_f32_32x32x16_bf16((bf16x8){al0[0], al0[1], al0[2], al0[3], ah0[0], ah0[1], ah0[2], ah0[3]}, vf0, Sacc[kb], 0, 0, 0); \
            Sacc[kb] = __builtin_amdgcn_mfma_f32_32x32x16_bf16((bf16x8){al1[0], al1[1], al1[2], al1[3], ah1[0], ah1[1], ah1[2], ah1[3]}, vf1, Sacc[kb], 0, 0, 0); \
            Sacc[kb] = __builtin_amdgcn_mfma_f32_32x32x16_bf16((bf16x8){al2[0], al2[1], al2[2], al2[3], ah2[0], ah2[1], ah2[2], ah2[3]}, vf2, Sacc[kb], 0, 0, 0); \
            Sacc[kb] = __builtin_amdgcn_mfma_f32_32x32x16_bf16((bf16x8){al3[0], al3[1], al3[2], al3[3], ah3[0], ah3[1], ah3[2], ah3[3]}, vf3, Sacc[kb], 0, 0, 0); } while (0)
        HG_SUPD(0); HG_SUPD(1); HG_SUPD(2); HG_SUPD(3);
#undef HG_SUPD
#undef HG_TRRD
        { float y8[8], y4[4], y2[2], y1;
          const bool b4 = (r32 & 16) != 0, b3 = (r32 & 8) != 0, b2 = (r32 & 4) != 0, b1 = (r32 & 2) != 0;
#pragma unroll
          for (int i = 0; i < 8; ++i) { const float lo = o[i] * o[i], hi_ = o[8 + i] * o[8 + i]; const float keep = b4 ? hi_ : lo, send = b4 ? lo : hi_; y8[i] = keep + __shfl_xor(send, 16); }
#pragma unroll
          for (int i = 0; i < 4; ++i) { const float keep = b3 ? y8[4 + i] : y8[i], send = b3 ? y8[i] : y8[4 + i]; y4[i] = keep + __shfl_xor(send, 8); }
#pragma unroll
          for (int i = 0; i < 2; ++i) { const float keep = b2 ? y4[2 + i] : y4[i], send = b2 ? y4[i] : y4[2 + i]; y2[i] = keep + __shfl_xor(send, 4); }
          { const float keep = b1 ? y2[1] : y2[0], send = b1 ? y2[0] : y2[1]; y1 = keep + __shfl_xor(send, 2); }
          y1 += __shfl_xor(y1, 1);
          const int rf = ((r32 >> 1) & 15);
          if ((r32 & 1) == 0) ssq[vq * 64 + th * 32 + crow(rf, hi)] = y1; }
        __syncthreads();
        { bf16_t* yb = YM + (size_t)(b * SEQ + t0 + th * 32) * DM + h * 128 + vq * 32;
          const unsigned loff = (unsigned)(4 * hi) * DM + (unsigned)r32;
#pragma unroll
          for (int r = 0; r < 16; ++r) { const int tc = (r & 3) + 8 * (r >> 2); const int t = th * 32 + tc + 4 * hi; const float ss = ((ssq[t] + ssq[64 + t]) + ssq[128 + t]) + ssq[192 + t];
              const float rs = rsqrtf(ss * (1.f / 128.f) + EPS);
              (yb + (size_t)tc * DM)[loff] = f2bf(o[r] * rs * ngv * gt[r]); } }
    }
#undef HG_LOAD
    __syncthreads();
}

__device__ __forceinline__ void compress_fast_unit(const Frame& F, const Args& a, int u) {
    unsigned char* ws = F.ws; const bf16_t* PROJ = (const bf16_t*)(ws + WS_PROJ); LAS unsigned char* lds = F.lds;
    const int j = u >> 6, bg = (u >> 2) & 15, mt = u & 3, b = bg >> 1, g = bg & 1;
    int tz = threadIdx.x; asm volatile("" : "+v"(tz));
    const int lane = tz & 63, r32 = lane & 31, hi = lane >> 5, w = F.wid;
    const int n = mt * 32 + r32, nl = n < 126 ? n : 126;
    const bf16_t* W2T = (const bf16_t*)(ws + WS_W2T) + (size_t)j * 128 * 128;
    const int colb = (j ? C_VCM : C_KCM) + g * 128;
    const bf16_t* arow = PROJ + (size_t)(b * SEQ + 16 * nl) * PROJ_LD + colb + hi * 8;
    const bf16_t* bfrag = (const bf16_t*)(ws + WS_W1T) + ((size_t)(j * 8 + w) * 32 * 4 * 64 + lane) * 8;
    f32x16 acc[4];
#pragma unroll
    for (int c = 0; c < 4; ++c)
#pragma unroll
        for (int r = 0; r < 16; ++r) acc[c][r] = 0.f;
#pragma unroll 4
    for (int ks = 0; ks < 32; ++ks) {
        const int l = 4 * w + (ks >> 3), d = (ks & 7) * 16;
        const bf16x8 af = *(const bf16x8*)(arow + (size_t)l * PROJ_LD + d);
#pragma unroll
        for (int c = 0; c < 4; ++c) { const bf16x8 bfr = *(const bf16x8*)(bfrag + (size_t)(ks * 4 + c) * 64 * 8);
            acc[c] = __builtin_amdgcn_mfma_f32_32x32x16_bf16(af, bfr, acc[c], 0, 0, 0); }
    }
    LAS float* red = (LAS float*)lds;
#pragma unroll
    for (int c = 0; c < 4; ++c)
#pragma unroll
        for (int r = 0; r < 16; ++r) red[(w * 32 + at::crow(r, hi)) * 128 + c * 32 + r32] = acc[c][r];
    __syncthreads();
    LAS unsigned char* hdn = lds + 131072 - 8192;
    { const int nn = tz >> 4, c8 = (tz & 15) * 8; float sv[8];
      const float* b1 = (const float*)(ws + WS_B1P) + (size_t)j * 32 * 128 + c8;
#pragma unroll
      for (int i = 0; i < 8; ++i) sv[i] = 0.f;
#pragma unroll 4
      for (int kg = 0; kg < 32; ++kg) { const f32x4 x0 = *(const f32x4*)(b1 + kg * 128), x1 = *(const f32x4*)(b1 + kg * 128 + 4);
#pragma unroll
          for (int i = 0; i < 4; ++i) { sv[i] += x0[i]; sv[4 + i] += x1[i]; } }
#pragma unroll
      for (int ww = 0; ww < 8; ++ww) { const f32x4 x0 = *(const LAS f32x4*)(red + (ww * 32 + nn) * 128 + c8), x1 = *(const LAS f32x4*)(red + (ww * 32 + nn) * 128 + c8 + 4);
#pragma unroll
          for (int i = 0; i < 4; ++i) { sv[i] += x0[i]; sv[4 + i] += x1[i]; } }
      __syncthreads();
#pragma unroll
      for (int i = 0; i < 8; ++i) sv[i] = gelu_tanh(sv[i]);
      u32x4 pw; pw[0] = cvt_pk_bf16(sv[0], sv[1]); pw[1] = cvt_pk_bf16(sv[2], sv[3]); pw[2] = cvt_pk_bf16(sv[4], sv[5]); pw[3] = cvt_pk_bf16(sv[6], sv[7]);
      *(LAS u32x4*)(hdn + AT_KSWZ(nn, c8 * 2)) = pw; }
    __syncthreads();
    if (w < 4) {
        f32x16 o2;
#pragma unroll
        for (int r = 0; r < 16; ++r) o2[r] = 0.f;
#pragma unroll
        for (int ks = 0; ks < 8; ++ks) { const bf16x8 af = *(const LAS bf16x8*)(hdn + AT_KSWZ(r32, (ks * 16 + hi * 8) * 2));
            const bf16x8 bfr = *(const bf16x8*)(W2T + (size_t)(w * 32 + r32) * 128 + ks * 16 + hi * 8);
            o2 = __builtin_amdgcn_mfma_f32_32x32x16_bf16(af, bfr, o2, 0, 0, 0); }
        bf16_t* dst = (bf16_t*)(ws + (DEBUG_CMP ? (j ? WS_Y + 1048576 : WS_Y) : (j ? WS_VC : WS_KC))) + (size_t)bg * 128 * 128;
#pragma unroll
        for (int r = 0; r < 16; ++r) { const int nn = mt * 32 + at::crow(r, hi); dst[(size_t)nn * 128 + w * 32 + r32] = (nn < NCMP) ? f2bf(o2[r]) : (bf16_t)0; }
    }
    __syncthreads();
}

__device__ __forceinline__ void p5_router(const Frame& F, const Args& a) {
    unsigned char* ws = F.ws; const bf16_t* H1 = (const bf16_t*)(ws + WS_H1); unsigned char* XN = ws + WS_U;
    const float* wr2 = (const float*)(ws + WS_WR2); const float* g2 = a.in[I_N2G]; const float* br = a.in[I_BR];
    float* tokw = (float*)(ws + WS_TOKW); int* slot = (int*)(ws + WS_SLOT); unsigned* cnt = F.ctl + CW_CNT;
    constexpr int HS_LD = 4104;
    LAS unsigned char* hs = F.lds; LAS float* rsv = (LAS float*)(F.lds + 32 * HS_LD); LAS float* red = (LAS float*)F.lds;
    LAS unsigned* lcnt = (LAS unsigned*)(F.lds + 32 * HS_LD + 256); LAS unsigned* lbase = lcnt + 32;
    if (F.tid < 32) lcnt[F.tid] = 0u;
    int myexp[2] = {0, 0}, myrank[2] = {0, 0};
    __syncthreads();
    for (int it = F.bid; it < NTOK / 32; it += F.G) {
#pragma unroll
        for (int rr = 0; rr < 4; ++rr) { const int tl = F.wid * 4 + rr, row = it * 32 + tl;
            const bf16_t* hr = H1 + (size_t)row * DM; u32x4 hw[4]; float ss = 0.f;
#pragma unroll
            for (int i = 0; i < 4; ++i) { hw[i] = *(const u32x4*)(hr + i * 512 + F.lane * 8); float hf[8]; unpack8(hw[i], hf);
#pragma unroll
                for (int j = 0; j < 8; ++j) ss += hf[j] * hf[j]; }
            ss = wave_sum(ss); const float rs = rsqrtf(ss * (1.f / DM) + EPS);
            if (F.lane == 0) rsv[tl] = rs;
#pragma unroll
            for (int i = 0; i < 4; ++i) { const f32x4 g0 = *(const f32x4*)(g2 + i * 512 + F.lane * 8), g1 = *(const f32x4*)(g2 + i * 512 + F.lane * 8 + 4);
                float hf[8]; unpack8(hw[i], hf);
                const f32x4 a0 = (f32x4){hf[0], hf[1], hf[2], hf[3]} * rs * g0, a1 = (f32x4){hf[4], hf[5], hf[6], hf[7]} * rs * g1;
                u32x2 w; w[0] = cvt4_fp8(a0[0], a0[1], a0[2], a0[3]); w[1] = cvt4_fp8(a1[0], a1[1], a1[2], a1[3]);
                *(u32x2*)(XN + (size_t)row * DM + i * 512 + F.lane * 8) = w;
                LAS unsigned char* hp = hs + tl * HS_LD + (i * 512 + F.lane * 8) * 2;
                *(LAS u32x2*)hp = (u32x2){hw[i][0], hw[i][1]}; *(LAS u32x2*)(hp + 8) = (u32x2){hw[i][2], hw[i][3]}; } }
        __syncthreads();
        f32x4 c00 = {0.f, 0.f, 0.f, 0.f}, c01 = c00, c10 = c00, c11 = c00;
        { const int ti = F.lane & 15, kq = F.lane >> 4, kb = F.wid * 256 + kq;
          const LAS unsigned char* ha = hs + ti * HS_LD + kb * 2; const float* wb = wr2 + (size_t)kb * 32 + ti;
#pragma unroll 16
          for (int s_ = 0; s_ < 64; ++s_) {
              const float a0 = bf2f(*(const LAS bf16_t*)(ha + s_ * 8)), a1 = bf2f(*(const LAS bf16_t*)(ha + 16 * HS_LD + s_ * 8));
              const float b0 = wb[(size_t)s_ * 128], b1 = wb[(size_t)s_ * 128 + 16];
              c00 = __builtin_amdgcn_mfma_f32_16x16x4f32(a0, b0, c00, 0, 0, 0); c01 = __builtin_amdgcn_mfma_f32_16x16x4f32(a0, b1, c01, 0, 0, 0);
              c10 = __builtin_amdgcn_mfma_f32_16x16x4f32(a1, b0, c10, 0, 0, 0); c11 = __builtin_amdgcn_mfma_f32_16x16x4f32(a1, b1, c11, 0, 0, 0); } }
        float rsl[2];
        rsl[0] = rsv[F.tid >> 5]; rsl[1] = rsv[16 + (F.tid >> 5)];
        __syncthreads();
        { const int cj = F.lane & 15, rq = (F.lane >> 4) * 4; LAS float* rw = red + F.wid * 1024;
#pragma unroll
          for (int r = 0; r < 4; ++r) { rw[(rq + r) * 32 + cj] = c00[r]; rw[(rq + r) * 32 + 16 + cj] = c01[r]; rw[(16 + rq + r) * 32 + cj] = c10[r]; rw[(16 + rq + r) * 32 + 16 + cj] = c11[r]; } }
        __syncthreads();
#pragma unroll
        for (int ps = 0; ps < 2; ++ps) {
            const int tl = ps * 16 + (F.tid >> 5), e = F.tid & 31, row = it * 32 + tl;
            float acc = 0.f;
#pragma unroll
            for (int w = 0; w < 8; ++w) acc += red[w * 1024 + tl * 32 + e];
            const float logit = acc * rsl[ps] + br[e];
            float tv[4]; int ti[4]; float cur = logit;
#pragma unroll
            for (int k = 0; k < 4; ++k) { float bv = cur; int bi = e;
#pragma unroll
                for (int o = 16; o > 0; o >>= 1) { const float ov = __shfl_xor(bv, o); const int oi = __shfl_xor(bi, o); if (ov > bv || (ov == bv && oi < bi)) { bv = ov; bi = oi; } }
                tv[k] = bv; ti[k] = bi; if (e == bi) cur = -INFINITY; }
            const float m = tv[0]; const float e0 = 1.f, e1 = __expf(tv[1] - m), e2 = __expf(tv[2] - m), e3 = __expf(tv[3] - m); const float inv = 1.f / (e0 + e1 + e2 + e3);
            if (e < 4) { const int k = e; const int ee = k == 0 ? ti[0] : k == 1 ? ti[1] : k == 2 ? ti[2] : ti[3]; const float w = (k == 0 ? e0 : k == 1 ? e1 : k == 2 ? e2 : e3) * inv;
                tokw[(size_t)row * 4 + k] = w;
                myexp[ps] = ee; myrank[ps] = (int)__hip_atomic_fetch_add(lcnt + ee, 1u, __ATOMIC_RELAXED, __HIP_MEMORY_SCOPE_WORKGROUP); } }
        __syncthreads();
        if (F.tid < 32) { const unsigned c = lcnt[F.tid]; lbase[F.tid] = c ? atomicAdd(&cnt[F.tid], c) : 0u; lcnt[F.tid] = 0u; }
        __syncthreads();
#pragma unroll
        for (int ps = 0; ps < 2; ++ps) { const int e = F.tid & 31; if (e < 4) { const int row = it * 32 + ps * 16 + (F.tid >> 5);
                slot[(size_t)myexp[ps] * NTOK + lbase[myexp[ps]] + myrank[ps]] = row * 4 + e; } }
        __syncthreads();
    }
}

__device__ __forceinline__ void moe_build_tiles(const Frame& F, LAS int* tstart, LAS int* cntl) {
    if (F.tid == 0) { int acc = 0; for (int e = 0; e < NEXP; ++e) { const int c = (int)__hip_atomic_load(F.ctl + CW_CNT + e, __ATOMIC_RELAXED, __HIP_MEMORY_SCOPE_AGENT); cntl[e] = c; tstart[e] = acc; acc += (c + 255) >> 8; } tstart[NEXP] = acc; }
    if (F.tid < 64) { const int sh = amax_shift(__hip_atomic_load(F.ctl + CW_AMAX + F.tid, __ATOMIC_RELAXED, __HIP_MEMORY_SCOPE_AGENT)); const unsigned b_ = (unsigned)(127 - sh) & 0xffu;
        cntl[40 + F.tid] = (int)(b_ | (b_ << 8) | (b_ << 16) | (b_ << 24)); }
    __syncthreads();
}

__device__ __forceinline__ void p9_combine(const Frame& F, const Args& a) {
    unsigned char* ws = F.ws; const bf16_t* H1 = (const bf16_t*)(ws + WS_H1); const unsigned char* Y = ws + WS_Y;
    const float* tokw = (const float*)(ws + WS_TOKW); const float* gf = a.in[I_FNG]; float* out = a.out;
    for (int row = F.bid * 8 + F.wid; row < NTOK; row += F.G * 8) {
        const bf16_t* hr = H1 + (size_t)row * DM; f32x4 v[8]; float ss = 0.f;
        const f32x4 w4 = *(const f32x4*)(tokw + (size_t)row * 4);
#pragma unroll
        for (int i = 0; i < 4; ++i) { const int c0 = i * 512 + F.lane * 8; { const u32x4 hw = *(const u32x4*)(hr + c0); float hf[8]; unpack8(hw, hf);
                v[2 * i] = (f32x4){hf[0], hf[1], hf[2], hf[3]}; v[2 * i + 1] = (f32x4){hf[4], hf[5], hf[6], hf[7]}; }
#pragma unroll
            for (int k = 0; k < 4; ++k) { const u32x2 yw = *(const u32x2*)(Y + ((size_t)row * 4 + k) * DM + c0); float f[8];
                { const f32x2 t0 = __builtin_amdgcn_cvt_pk_f32_fp8(yw[0], false), t1 = __builtin_amdgcn_cvt_pk_f32_fp8(yw[0], true), t2 = __builtin_amdgcn_cvt_pk_f32_fp8(yw[1], false), t3 = __builtin_amdgcn_cvt_pk_f32_fp8(yw[1], true);
                  f[0] = t0[0]; f[1] = t0[1]; f[2] = t1[0]; f[3] = t1[1]; f[4] = t2[0]; f[5] = t2[1]; f[6] = t3[0]; f[7] = t3[1]; }
#pragma unroll
                for (int j = 0; j < 4; ++j) { v[2 * i][j] += w4[k] * f[j]; v[2 * i + 1][j] += w4[k] * f[4 + j]; } }
#pragma unroll
            for (int j = 0; j < 4; ++j) ss += v[2 * i][j] * v[2 * i][j] + v[2 * i + 1][j] * v[2 * i + 1][j]; }
        ss = wave_sum(ss); const float rs = rsqrtf(ss * (1.f / DM) + EPS);
#pragma unroll
        for (int i = 0; i < 4; ++i) { const int c0 = i * 512 + F.lane * 8; const f32x4 g0 = *(const f32x4*)(gf + c0), g1 = *(const f32x4*)(gf + c0 + 4);
            *(f32x4*)(out + (size_t)row * DM + c0) = v[2 * i] * rs * g0; *(f32x4*)(out + (size_t)row * DM + c0 + 4) = v[2 * i + 1] * rs * g1; }
    }
}

#if DEBUG_CMP
__device__ __noinline__ void dbg_compare(unsigned char* ws, unsigned* ctl, LAS unsigned char* lds) {
    const int tid = threadIdx.x, lane = tid & 63, wid = tid >> 6;
    float mx = 0.f, md = 0.f; const bf16_t* r0 = (const bf16_t*)(ws + WS_KC); const bf16_t* r1 = (const bf16_t*)(ws + WS_Y);
    for (int i = tid; i < 2 * 16 * 128 * 128; i += NTHREADS) { const float x = bf2f(i < 262144 ? r0[i] : ((const bf16_t*)(ws + WS_VC))[i - 262144]); const float y = bf2f(i < 262144 ? r1[i] : ((const bf16_t*)(ws + WS_Y + 1048576))[i - 262144]);
        mx = fmaxf(mx, fabsf(x)); md = fmaxf(md, fabsf(x - y)); if (!(y == y)) md = 1e30f; }
    mx = wave_max(mx); md = wave_max(md); LAS float* t2 = (LAS float*)lds; if (lane == 0) { t2[wid] = mx; t2[8 + wid] = md; } __syncthreads();
    if (tid == 0) { float a1 = 0.f, a2 = 0.f; for (int i = 0; i < 8; ++i) { a1 = fmaxf(a1, t2[i]); a2 = fmaxf(a2, t2[8 + i]); }
        const float rel = a2 / fmaxf(a1, 1e-20f); int code = 0;
        if (rel >= 1.f) code = 10; else if (rel >= 0.3f) code = 11; else if (rel >= 0.1f) code = 12; else if (rel >= 0.03f) code = 13; else if (rel >= 0.01f) code = 14; else if (rel >= 0.003f) code = 15;
        if (blockIdx.x == 0) ctl[CW_ERR] = (unsigned)code; }
    __syncthreads();
}
#endif
constexpr int N_PHASES = 9;
extern "C" __global__ void __launch_bounds__(NTHREADS, 2) fwd(Args args) {
    extern __shared__ __attribute__((aligned(16))) unsigned char shm[];
    LAS unsigned char* lds = (LAS unsigned char*)shm;
    Frame F; F.lds = lds; F.ws = args.ws; F.ctl = (unsigned*)(args.ws + WS_CTL);
    F.tid = threadIdx.x; F.wid = __builtin_amdgcn_readfirstlane(F.tid >> 6); F.lane = F.tid & 63; F.G = gridDim.x; F.bid = blockIdx.x;
    LAS unsigned* misc = (LAS unsigned*)(lds + LDS_MISC);
    if (F.tid < 4) misc[F.tid] = 0u;
    __syncthreads();
    const int lo = args.ph_lo, hi = args.ph_hi;
    XcdBarrier bar; bar.bar = F.ctl; bar.x = 0; bar.st = nullptr;
    if (hi - lo > 1) bar = xcd_barrier_post(F.ctl, (volatile LAS unsigned*)misc);
#define IN(k) (lo <= (k) && (k) < hi)
#define SEAM(k) do { if (IN(k) && IN((k) + 1)) xcd_barrier(bar); } while (0)
    unsigned char* ws = args.ws;

    if (IN(0)) { p0_prologue(F, args); }
#if (REP_MASK >> 0) & 1
    if (IN(0)) { p0_prologue(F, args); }
#endif
    SEAM(0);
    if (IN(1)) {
        const int gi = F.bid >> 3, g8i = gi & 7; const bool split = (F.G == 256), conv = split && (g8i == 2 || g8i == 5 || g8i == 7);
        if (conv) { const int crank = ((gi >> 3) * 3 + (g8i == 2 ? 0 : (g8i == 5 ? 1 : 2))) * 8 + (F.bid & 7); conv_experts(F, args, CONV_P2 + crank, 96, 12288); bias1_partials(F, args, crank, 96); }
        else {
            const int grank = (gi >> 3) * 5 + (g8i < 2 ? g8i : (g8i < 5 ? g8i - 1 : 4));
            g8::DenseSched<DM, DM> S; S.init(ws + WS_U, ws + WS_WINT, NTOK, PROJ_LD, split ? 160 : F.G, split ? grank * 8 + (F.bid & 7) : F.bid);
            g8::EpiProj E{(bf16_t*)(ws + WS_PROJ), PROJ_LD, (bf16_t*)(ws + WS_OMF), (const float*)(ws + WS_LB)};
            g8::gemm_phase(lds, S, E);
            if (!split) { conv_experts(F, args, CONV_P2 + F.bid, F.G, 12288); bias1_partials(F, args, F.bid, F.G); }
        }
    }
#if (REP_MASK >> 1) & 1
    if (IN(1)) {
        g8::DenseSched<DM, DM> S; S.init(ws + WS_U, ws + WS_WINT, NTOK, PROJ_LD, F.G, F.bid);
        g8::EpiProj E{(bf16_t*)(ws + WS_PROJ), PROJ_LD, (bf16_t*)(ws + WS_OMF), (const float*)(ws + WS_LB)};
        g8::gemm_phase(lds, S, E);
    }
#endif
    SEAM(1);
    if (IN(2)) {
#if DEBUG_CMP
        p2_compress_naive(F, args);
#endif
        for (int u = F.bid; u < 128; u += F.G) compress_fast_unit(F, args, u);
        if (F.G == 256) { if (F.bid >= 128) conv_experts(F, args, CONV_P0 + (F.bid - 128), 128, CONV_P2); }
        else conv_experts(F, args, CONV_P0 + F.bid, F.G, CONV_P2); }
#if (REP_MASK >> 2) & 1
    if (IN(2)) {
#if DEBUG_CMP
        p2_compress_naive(F, args);
#endif
        for (int u = F.bid; u < 128; u += F.G) compress_fast_unit(F, args, u); }
#endif
    SEAM(2);
    if (IN(3)) {
#if DEBUG_CMP
        dbg_compare(ws, F.ctl, lds);
#endif
        if (F.bid < 64) hgrn_fast_unit(F, args, F.bid);
        for (;;) { if (F.tid == 0) misc[8] = atomicAdd(F.ctl + CW_QUEUE, 1u);
            __syncthreads();
            const int u = (int)misc[8];
            if (u >= BATCH * NSA_G * 32) break;
            attn_fast_unit(F, args, u); }
    }
#if (REP_MASK >> 3) & 1
    if (IN(3)) {
#if DEBUG_CMP
        dbg_compare(ws, F.ctl, lds);
#endif
        if (F.bid < 64) hgrn_fast_unit(F, args, F.bid);
        for (;;) { if (F.tid == 0) misc[8] = atomicAdd(F.ctl + CW_QUEUE + 64, 1u);
            __syncthreads();
            const int u = (int)misc[8];
            if (u >= BATCH * NSA_G * 32) break;
            attn_fast_unit(F, args, u); }
    }
#endif
    SEAM(3);
    if (IN(4)) {
        g8::DenseSched<DM, DM> S; S.init(ws + WS_YMIX, ws + WS_WOUTT, NTOK, DM, F.G, F.bid);
        g8::EpiResBf16 E{(bf16_t*)(ws + WS_H1), args.in[I_X], DM};
        g8::gemm_phase(lds, S, E);
    }
#if (REP_MASK >> 4) & 1
    if (IN(4)) {
        g8::DenseSched<DM, DM> S; S.init(ws + WS_YMIX, ws + WS_WOUTT, NTOK, DM, F.G, F.bid);
        g8::EpiResBf16 E{(bf16_t*)(ws + WS_H1), args.in[I_X], DM};
        g8::gemm_phase(lds, S, E);
    }
#endif
    SEAM(4);
    if (IN(5)) { p5_router(F, args); }
#if (REP_MASK >> 5) & 1
    if (IN(5)) { p5_router(F, args); }
#endif
    SEAM(5);
    if (IN(6)) {
        LAS int* tstart = (LAS int*)(misc + 64); LAS int* cntl = tstart + 40;
        moe_build_tiles(F, tstart, cntl);
        g8::MoeSched<16, 2, true> S{(const char*)(ws + WS_U), (const char*)(ws + WS_WGUT), (const int*)(ws + WS_SLOT), args.in[I_BGU], tstart, cntl, F.G, F.bid};
        g8::EpiGateUp E{(unsigned char*)(ws + WS_ACT), args.in[I_BGU]};
        g8::gemm_phase(lds, S, E);
    }
#if (REP_MASK >> 6) & 1
    if (IN(6)) {
        LAS int* tstart = (LAS int*)(misc + 64); LAS int* cntl = tstart + 40;
        moe_build_tiles(F, tstart, cntl);
        g8::MoeSched<16, 2, true> S{(const char*)(ws + WS_U), (const char*)(ws + WS_WGUT), (const int*)(ws + WS_SLOT), args.in[I_BGU], tstart, cntl, F.G, F.bid};
        g8::EpiGateUp E{(unsigned char*)(ws + WS_ACT), args.in[I_BGU]};
        g8::gemm_phase(lds, S, E);
    }
#endif
    SEAM(6);
    if (IN(7)) {
        LAS int* tstart = (LAS int*)(misc + 64); LAS int* cntl = tstart + 40;
        moe_build_tiles(F, tstart, cntl);
        g8::MoeSched<8, 0, false> S{(const char*)(ws + WS_ACT), (const char*)(ws + WS_WDT), (const int*)(ws + WS_SLOT), args.in[I_BD], tstart, cntl, F.G, F.bid};
        g8::EpiDown E{ws + WS_Y, args.in[I_BD]};
        g8::gemm_phase(lds, S, E);
    }
#if (REP_MASK >> 7) & 1
    if (IN(7)) {
        LAS int* tstart = (LAS int*)(misc + 64); LAS int* cntl = tstart + 40;
        moe_build_tiles(F, tstart, cntl);
        g8::MoeSched<8, 0, false> S{(const char*)(ws + WS_ACT), (const char*)(ws + WS_WDT), (const int*)(ws + WS_SLOT), args.in[I_BD], tstart, cntl, F.G, F.bid};
        g8::EpiDown E{ws + WS_Y, args.in[I_BD]};
        g8::gemm_phase(lds, S, E);
    }
#endif
    SEAM(7);
    if (IN(8)) { p9_combine(F, args);
#if DEBUG_CMP
        { const unsigned code = __hip_atomic_load(F.ctl + CW_ERR, __ATOMIC_RELAXED, __HIP_MEMORY_SCOPE_AGENT);
          if (code) { const float cval = sqrtf((float)code); for (size_t i = (size_t)F.bid * NTHREADS + F.tid; i < (size_t)NTOK * DM; i += (size_t)F.G * NTHREADS) args.out[i] = cval; } }
#endif
    }
#if (REP_MASK >> 8) & 1
    if (IN(8)) { p9_combine(F, args);
#if DEBUG_CMP
        { const unsigned code = __hip_atomic_load(F.ctl + CW_ERR, __ATOMIC_RELAXED, __HIP_MEMORY_SCOPE_AGENT);
          if (code) { const float cval = sqrtf((float)code); for (size_t i = (size_t)F.bid * NTHREADS + F.tid; i < (size_t)NTOK * DM; i += (size_t)F.G * NTHREADS) args.out[i] = cval; } }
#endif
    }
#endif
#undef IN
#undef SEAM
}

extern "C" void kernel_launch(void* const* d_in, const int* in_sizes, int n_in, void* d_out, int out_size, void* d_ws, size_t ws_size, hipStream_t stream) {
    static int grid = 0;
    if (grid == 0) {
        if (n_in != 18 || ws_size < WS_END) { fprintf(stderr, "kernel_launch: n_in %d ws %zu (need %zu)\n", n_in, ws_size, (size_t)WS_END); grid = -1; return; }
        int dev = 0, cus = 0, per_cu = 0;
        if (hipGetDevice(&dev) != hipSuccess || hipDeviceGetAttribute(&cus, hipDeviceAttributeMultiprocessorCount, dev) != hipSuccess) { grid = -1; return; }
        if (hipFuncSetAttribute((const void*)fwd, hipFuncAttributeMaxDynamicSharedMemorySize, LDS_BYTES) != hipSuccess) { fprintf(stderr, "kernel_launch: hipFuncSetAttribute failed\n"); grid = -1; return; }
        if (hipOccupancyMaxActiveBlocksPerMultiprocessor(&per_cu, (const void*)fwd, NTHREADS, LDS_BYTES) != hipSuccess || per_cu < 1) { fprintf(stderr, "kernel_launch: occupancy query says %d\n", per_cu); }
        (void)hipGetLastError();
        grid = cus;
    }
    if (grid < 0) return;
    (void)hipMemsetAsync((char*)d_ws + WS_CTL, 0, CTL_BYTES, stream);
    Args a{};
    for (int i = 0; i < 18; ++i) a.in[i] = (const float*)d_in[i];
    a.out = (float*)d_out; a.ws = (unsigned char*)d_ws;
#if N_LAUNCH_PER_PHASE
    for (int p = 0; p < N_PHASES; ++p) { a.ph_lo = p; a.ph_hi = p + 1; hipLaunchKernelGGL(fwd, dim3(grid), dim3(NTHREADS), LDS_BYTES, stream, a); }
#else
    a.ph_lo = 0; a.ph_hi = N_PHASES; hipLaunchKernelGGL(fwd, dim3(grid), dim3(NTHREADS), LDS_BYTES, stream, a);
#endif
}
```

```cpp
#include <hip/hip_runtime.h>
#include <stdint.h>
#include <stdio.h>

#ifndef N_LAUNCH_PER_PHASE
#define N_LAUNCH_PER_PHASE 0
#endif

#define DEBUG_CMP 0
#ifndef REP_MASK
#define REP_MASK 0
#endif
#define LAS __attribute__((address_space(3)))
typedef unsigned short bf16_t;
typedef short bf16x8 __attribute__((ext_vector_type(8)));
typedef float f32x4 __attribute__((ext_vector_type(4)));
typedef float f32x2 __attribute__((ext_vector_type(2)));
typedef float f32x16 __attribute__((ext_vector_type(16)));
typedef unsigned u32x4 __attribute__((ext_vector_type(4)));
typedef unsigned u32x2 __attribute__((ext_vector_type(2)));
typedef int i32x8 __attribute__((ext_vector_type(8)));

constexpr int BATCH = 8, SEQ = 2048, NTOK = BATCH * SEQ, DM = 2048;
constexpr int HG_W = 1024, HG_H = 8, HG_DK = 128, HG_DV = 128;
constexpr int NSA_H = 8, NSA_G = 2, NSA_R = 4, HD = 128, KVW = 256;
constexpr int IN_COLS = 6680, PROJ_LD = 6912;
constexpr int C_HQ = 0, C_HF = 1024, C_HI = 2048, C_HGT = 3072, C_NQ = 4096, C_KCM = 5120, C_VCM = 5376, C_KSL = 5632, C_VSL = 5888, C_KWN = 6144, C_VWN = 6400, C_NGT = 6656;
constexpr int NCMP = 127, NSEL = 32, SEL_TOP = 16, WINDOW = 512;
constexpr int NEXP = 32, TOPK = 4, DFF = 2048, NASG = NTOK * TOPK;
constexpr float EPS = 1e-6f;
constexpr int NTHREADS = 512;
constexpr int CONV_P0 = 0, CONV_P2 = 1280;

constexpr size_t al256(size_t x) { return (x + 255) & ~(size_t)255; }
constexpr size_t WS_CTL = 0, CTL_BYTES = 65536;
constexpr size_t WS_WINT = WS_CTL + CTL_BYTES;
constexpr size_t WS_WOUTT = WS_WINT + (size_t)PROJ_LD * DM * 2;
constexpr size_t WS_WGUT = WS_WOUTT + (size_t)DM * DM * 2;
constexpr size_t WS_WDT = WS_WGUT + (size_t)NEXP * 2 * DFF * DM * 2;
constexpr size_t WS_W1T = WS_WDT + (size_t)NEXP * DM * DFF * 2;
constexpr size_t WS_W2T = WS_W1T + (size_t)2 * 128 * 4096 * 2;
constexpr size_t WS_BIAS1 = WS_W2T + (size_t)2 * 128 * 128 * 2;
constexpr size_t WS_WR2 = WS_BIAS1 + 1024;
constexpr size_t WS_LB = WS_WR2 + (size_t)DM * NEXP * 4;
constexpr size_t WS_U = WS_LB + 4096;
constexpr size_t WS_PROJ = WS_U + (size_t)NTOK * DM * 2;
constexpr size_t WS_KC = WS_PROJ + (size_t)(NTOK + 64) * PROJ_LD * 2;
constexpr size_t WS_VC = WS_KC + (size_t)16 * 128 * 128 * 2;
constexpr size_t WS_YMIX = WS_VC + (size_t)16 * 128 * 128 * 2;
constexpr size_t WS_H1 = WS_YMIX + (size_t)NTOK * DM * 2;
constexpr size_t WS_TOKW = WS_H1 + (size_t)NTOK * DM * 4;
constexpr size_t WS_SLOT = WS_TOKW + (size_t)NTOK * 4 * 4;
constexpr size_t WS_ACT = WS_SLOT + (size_t)NEXP * NTOK * 4;
constexpr size_t WS_Y = WS_ACT + (size_t)NASG * DFF * 2;
constexpr size_t WS_OT = WS_Y + (size_t)NASG * DM * 2;
constexpr size_t WS_OMF = WS_OT + (size_t)256 * 64 * 512 * 4;
constexpr size_t WS_B1P = WS_OMF + (size_t)NTOK * HG_W * 2;
constexpr size_t WS_END = WS_B1P + (size_t)2 * 32 * 128 * 4;
constexpr int CW_CNT = 4096, CW_QUEUE = 4160, CW_ERR = 4224, CW_AMAX = 4544;

__device__ __forceinline__ float bf2f(bf16_t b) { return __uint_as_float(((unsigned)b) << 16); }
typedef __bf16 bf16v2_t __attribute__((ext_vector_type(2)));
__device__ __forceinline__ unsigned cvt_pk_bf16(float lo, float hi) { f32x2 v = {lo, hi}; bf16v2_t r = __builtin_convertvector(v, bf16v2_t); return __builtin_bit_cast(unsigned, r); }
__device__ __forceinline__ unsigned cvt4_fp8(float a, float b, float c, float d) { unsigned w = 0u; w = __builtin_amdgcn_cvt_pk_fp8_f32(a, b, w, false); w = __builtin_amdgcn_cvt_pk_fp8_f32(c, d, w, true); return w; }
__device__ __forceinline__ unsigned cvt4_bf8(float a, float b, float c, float d) { unsigned w = 0u; w = __builtin_amdgcn_cvt_pk_bf8_f32(a, b, w, false); w = __builtin_amdgcn_cvt_pk_bf8_f32(c, d, w, true); return w; }
__device__ __forceinline__ int amax_shift(unsigned bits) { if (bits == 0u) return 0; int s_ = 5 - ((int)(bits >> 23) - 127); return s_ < -60 ? -60 : (s_ > 60 ? 60 : s_); }
__device__ __forceinline__ float shift_mult(int s_) { return __uint_as_float((unsigned)(s_ + 127) << 23); }
__device__ __forceinline__ unsigned cvt4_fp8s(float a, float b, float c, float d, float m) {
    return cvt4_fp8(__builtin_amdgcn_fmed3f(a * m, -448.f, 448.f), __builtin_amdgcn_fmed3f(b * m, -448.f, 448.f), __builtin_amdgcn_fmed3f(c * m, -448.f, 448.f), __builtin_amdgcn_fmed3f(d * m, -448.f, 448.f)); }
__device__ __forceinline__ bf16_t f2bf(float f) { return (bf16_t)(cvt_pk_bf16(f, 0.f) & 0xffffu); }
__device__ __forceinline__ float sigmoidf_(float x) { return 1.f / (1.f + __expf(-x)); }
__device__ __forceinline__ float siluf_(float x) { return x * sigmoidf_(x); }
__device__ __forceinline__ float wave_sum(float v) {
#pragma unroll
    for (int o = 32; o > 0; o >>= 1) v += __shfl_xor(v, o);
    return v;
}
__device__ __forceinline__ float wave_max(float v) {
#pragma unroll
    for (int o = 32; o > 0; o >>= 1) v = fmaxf(v, __shfl_xor(v, o));
    return v;
}
__device__ __forceinline__ void unpack8(const u32x4 w, float (&f)[8]) {
#pragma unroll
    for (int i = 0; i < 4; ++i) { f[2 * i] = __uint_as_float(w[i] << 16); f[2 * i + 1] = __uint_as_float(w[i] & 0xffff0000u); }
}

#define XB_TMO      128
#define XB_XCNT(j)  (256  + 64 * (j))
#define XB_XSUB(j)  (1280 + 64 * (j))
#define XB_XGEN(j)  (2304 + 64 * (j))
#define XB_TOP      3328
#define XB_TOPGEN   3392
#define XCD_BAR_WORDS 3456
#define XB_SPIN_CAP (1u << 18)
__device__ __forceinline__ unsigned xb_ld(unsigned* p)              { return __hip_atomic_load(p, __ATOMIC_RELAXED, __HIP_MEMORY_SCOPE_AGENT); }
__device__ __forceinline__ unsigned xb_add(unsigned* p, unsigned v) { return __hip_atomic_fetch_add(p, v, __ATOMIC_RELAXED, __HIP_MEMORY_SCOPE_AGENT); }
__device__ __forceinline__ unsigned xb_xcc_id() { return (unsigned)__builtin_amdgcn_s_getreg((3 << 11) | 20) & 0xFu; }
#define XB_SPIN(cond, bar) do { unsigned _sp = 0; while (cond) { __builtin_amdgcn_s_sleep(1); \
    if ((++_sp & 255u) == 0u) { if (xb_ld(&(bar)[XB_TMO])) break; if (_sp > XB_SPIN_CAP) { atomicAdd(&(bar)[XB_TMO], 1u); break; } } } } while (0)
struct XcdBarrier { unsigned* bar; unsigned x; volatile LAS unsigned* st; };
__device__ __forceinline__ XcdBarrier xcd_barrier_post(unsigned* bar, volatile LAS unsigned* st) {
    XcdBarrier b; b.bar = bar; b.x = xb_xcc_id(); b.st = st;
    if (threadIdx.x == 0) (void)xb_add(&bar[XB_XCNT(b.x)], 1u);
    return b;
}
__device__ __forceinline__ void xcd_barrier_complete(unsigned* bar, unsigned x, unsigned& nloc, unsigned& nx) {
    const unsigned G = gridDim.x * gridDim.y * gridDim.z;
    unsigned sum, cnt, mine, sp = 0u;
    for (;;) {
        sum = 0u; cnt = 0u; mine = 0u;
#pragma unroll
        for (unsigned j = 0; j < 16; ++j) { const unsigned c = xb_ld(&bar[XB_XCNT(j)]); sum += c; cnt += (c > 0u) ? 1u : 0u; mine = (j == x) ? c : mine; }
        if (sum == G) break;
        __builtin_amdgcn_s_sleep(1);
        if ((++sp & 255u) == 0u) { if (xb_ld(&bar[XB_TMO])) break; if (sp > XB_SPIN_CAP) { atomicAdd(&bar[XB_TMO], 1u); break; } }
    }
    nloc = mine > 0u ? mine : 1u; nx = cnt > 0u ? cnt : 1u;
}
__device__ __forceinline__ void xcd_barrier(const XcdBarrier& b) {
    asm volatile("s_waitcnt vmcnt(0)" ::: "memory");
    __syncthreads();
    if (threadIdx.x == 0) {
        unsigned* bar = b.bar;
        __builtin_amdgcn_s_waitcnt(0);
        unsigned nloc = b.st[0], nx = b.st[1];
        if (nloc == 0u) { xcd_barrier_complete(bar, b.x, nloc, nx); b.st[0] = nloc; b.st[1] = nx; }
        const unsigned old = xb_add(&bar[XB_XSUB(b.x)], 1u);
        const unsigned gen = old / nloc;
        if (old + 1u == (gen + 1u) * nloc) {
            __builtin_amdgcn_fence(__ATOMIC_RELEASE, "agent");
            asm volatile("s_waitcnt vmcnt(0)" ::: "memory");
            const unsigned og = xb_add(&bar[XB_TOP], 1u);
            const unsigned tg = og / nx;
            if (og + 1u == (tg + 1u) * nx) xb_add(&bar[XB_TOPGEN], 1u);
            else XB_SPIN(xb_ld(&bar[XB_TOPGEN]) == tg, bar);
            __builtin_amdgcn_fence(__ATOMIC_ACQUIRE, "agent");
            xb_add(&bar[XB_XGEN(b.x)], 1u);
            asm volatile("s_waitcnt vmcnt(0)" ::: "memory");
        } else {
            XB_SPIN(xb_ld(&bar[XB_XGEN(b.x)]) == gen, bar);
            __builtin_amdgcn_fence(__ATOMIC_ACQUIRE, "agent");
            asm volatile("s_waitcnt vmcnt(0)" ::: "memory");
        }
    }
    __syncthreads();
}

namespace g8 {
constexpr int BM = 256, BK = 64, HALF = 128, HTB = HALF * BK * 2, STAGE_BYTES = 8 * HTB, NXCD = 8;
__host__ __device__ __forceinline__ int lds_byte(int r, int c) { const int st = (r >> 4) * 2 + (c >> 5), rr = r & 15, cc = c & 31, ob = rr * 64 + cc * 2; return st * 1024 + (ob ^ (((ob >> 9) & 1) << 5)); }
__host__ __device__ __forceinline__ void stage_rc(int b, int& R, int& C) { const int st = b / 1024, sb = b % 1024, swz = sb ^ (((sb >> 9) & 1) << 5); R = (st >> 1) * 16 + swz / 64; C = (st & 1) * 32 + (swz % 64) / 2; }
__host__ __device__ __forceinline__ int perm32(int rho) { const int n = rho >> 4, i = rho & 15; return 8 * (i >> 2) + 4 * n + (i & 3); }

struct Unit { const char* A; const char* B0; const char* B1; const int* rows; const float* bias0; const float* bias1; int nvalid; int m0, n0, e; int wscale; };

template <class Sched>
__device__ __forceinline__ void a_offsets(const Unit& u, const int (&R)[2], const int (&C)[2], unsigned (&vo)[2][2]) {
#pragma unroll
    for (int h = 0; h < 2; ++h)
#pragma unroll
        for (int i = 0; i < 2; ++i) {
            if constexpr (Sched::GATHER) {
                const int r = h * HALF + R[i];
                const int idx = u.rows[r < u.nvalid ? r : 0] >> Sched::SHIFT;
                vo[h][i] = (unsigned)idx * (unsigned)(Sched::LDA * Sched::ESZ) + (unsigned)C[i] * 2u;
            } else {
                vo[h][i] = (unsigned)(h * HALF + R[i]) * (unsigned)(Sched::LDA * Sched::ESZ) + (unsigned)C[i] * 2u;
            }
        }
}

__device__ __forceinline__ const char* uni_ptr(const char* p) { const unsigned long long v = (unsigned long long)p;
    const unsigned lo = (unsigned)__builtin_amdgcn_readfirstlane((int)(unsigned)v), hi = (unsigned)__builtin_amdgcn_readfirstlane((int)(unsigned)(v >> 32));
    return (const char*)(((unsigned long long)hi << 32) | lo); }
template <class Sched, class Epi>
__device__ __forceinline__ void gemm_phase(LAS unsigned char* lds, const Sched& S, const Epi& E) {
    const int tid = threadIdx.x, wid = __builtin_amdgcn_readfirstlane(tid >> 6), lane = tid & 63, wr = wid >> 2, wc = wid & 3, fr = lane & 15, fq = lane >> 4;
    constexpr int K = Sched::K, nt = K * Sched::ESZ / (BK * 2);
    int Rr[2], Cc[2]; unsigned voffB[2];
#pragma unroll
    for (int i = 0; i < 2; ++i) { stage_rc(tid * 16 + i * 8192, Rr[i], Cc[i]); const int Rb = Epi::PERM ? ((Rr[i] & ~31) + perm32(Rr[i] & 31)) : Rr[i];
        voffB[i] = (unsigned)Rb * (unsigned)(K * Sched::ESZ) + (unsigned)Cc[i] * 2u; }
    const size_t kstep = (size_t)(BK * 2);
    const unsigned ldsw = (unsigned)wid * 1024u;
    const int aoff = lds_byte(wr * 64 + fr, fq * 8), boff = lds_byte(wc * 32 + fr, fq * 8);
#define G8_SA(b, h) (((b) * 2 + (h)) * HTB)
#define G8_SB(b, h) ((4 + (b) * 2 + (h)) * HTB)
#define G8_STAGE(bufoff, gbase, voff) do { _Pragma("unroll") for (int _i = 0; _i < 2; ++_i) \
        __builtin_amdgcn_global_load_lds((const unsigned*)((const char*)(gbase) + (voff)[_i]), (LAS unsigned*)(lds + (bufoff) + ldsw + _i * 8192), 16, 0, 0); } while (0)
#define G8_LDA(dst, b, h) do { _Pragma("unroll") for (int m = 0; m < 4; ++m) _Pragma("unroll") for (int k = 0; k < 2; ++k) dst[m][k] = *(const LAS bf16x8*)(lds + G8_SA(b, h) + aoff + m * 2048 + k * 1024); } while (0)
#define G8_LDB(dst, b, h) do { _Pragma("unroll") for (int n = 0; n < 2; ++n) _Pragma("unroll") for (int k = 0; k < 2; ++k) dst[n][k] = *(const LAS bf16x8*)(lds + G8_SB(b, h) + boff + n * 2048 + k * 1024); } while (0)
#define G8_MMA(ai, bj, At, Bt) do { __builtin_amdgcn_s_setprio(1); _Pragma("unroll") for (int m = 0; m < 4; ++m) _Pragma("unroll") for (int n = 0; n < 2; ++n) { \
        if constexpr (Sched::ESZ == 2) { _Pragma("unroll") for (int k = 0; k < 2; ++k) acc[ai][bj][m][n] = __builtin_amdgcn_mfma_f32_16x16x32_bf16(Bt[n][k], At[m][k], acc[ai][bj][m][n], 0, 0, 0); } \
        else { const u32x4 b0_ = __builtin_bit_cast(u32x4, Bt[n][0]), b1_ = __builtin_bit_cast(u32x4, Bt[n][1]), a0_ = __builtin_bit_cast(u32x4, At[m][0]), a1_ = __builtin_bit_cast(u32x4, At[m][1]); \
            const i32x8 bw_ = {(int)b0_[0], (int)b0_[1], (int)b0_[2], (int)b0_[3], (int)b1_[0], (int)b1_[1], (int)b1_[2], (int)b1_[3]}; \
            const i32x8 aw_ = {(int)a0_[0], (int)a0_[1], (int)a0_[2], (int)a0_[3], (int)a1_[0], (int)a1_[1], (int)a1_[2], (int)a1_[3]}; \
            acc[ai][bj][m][n] = __builtin_amdgcn_mfma_scale_f32_16x16x128_f8f6f4(bw_, aw_, acc[ai][bj][m][n], Sched::FMT_W, Sched::FMT_A, 0, wsc_cur, 0, 0x7f7f7f7f); } } \
        __builtin_amdgcn_s_setprio(0); } while (0)
#define G8_WAIT_V(n) asm volatile("s_waitcnt vmcnt(" #n ")" ::: "memory")
#define G8_WAIT_L(n) asm volatile("s_waitcnt lgkmcnt(" #n ")" ::: "memory")
#define G8_BAR __builtin_amdgcn_s_barrier()
#define G8_SCHED __builtin_amdgcn_sched_barrier(0)
    Unit cur, nxt; int ui = 0;
    if (!S.next(0, cur)) return;
    f32x4 acc[2][2][4][2];
#pragma unroll
    for (int a = 0; a < 2; ++a)
#pragma unroll
        for (int b = 0; b < 2; ++b)
#pragma unroll
            for (int m = 0; m < 4; ++m)
#pragma unroll
                for (int n = 0; n < 2; ++n) acc[a][b][m][n] = (f32x4){0.f, 0.f, 0.f, 0.f};
    bf16x8 At[4][2], B0[2][2], B1[2][2];
    unsigned voffA[2][2], nvoffA[2][2];
    LAS unsigned char* auxb = lds + STAGE_BYTES; int par_cur = 0, par_nxt = 1;
#define G8_AUX_ISSUE(U, PAR) do { if (wid < 4) { const int r_ = wid * 64 + lane; __builtin_amdgcn_global_load_lds((const unsigned*)((U).rows + (r_ < (U).nvalid ? r_ : 0)), (LAS unsigned*)(auxb + (PAR) * 2048 + wid * 256), 4, 0, 0); } \
        else { const float* b_ = (wid < 6 ? (U).bias0 + (wid - 4) * 64 : (U).bias1 + (wid - 6) * 64) + lane; __builtin_amdgcn_global_load_lds((const unsigned*)b_, (LAS unsigned*)(auxb + (PAR) * 2048 + 1024 + (wid - 4) * 256), 4, 0, 0); } } while (0)
#define G8_AUX_OFFS(PAR) do { _Pragma("unroll") for (int h = 0; h < 2; ++h) _Pragma("unroll") for (int i = 0; i < 2; ++i) { \
        const int idx_ = *(const LAS int*)(auxb + (PAR) * 2048 + (h * HALF + Rr[i]) * 4) >> Sched::SHIFT; voffA[h][i] = (unsigned)idx_ * (unsigned)(Sched::LDA * Sched::ESZ) + (unsigned)Cc[i] * 2u; } } while (0)
    if constexpr (Sched::LDSAUX) { G8_AUX_ISSUE(cur, 0); G8_WAIT_V(0); __syncthreads(); G8_AUX_OFFS(0); }
    else a_offsets<Sched>(cur, Rr, Cc, voffA);
    const char* cA = cur.A; const char* cB0 = cur.B0; const char* cB1 = cur.B1;
    int wsc_cur = cur.wscale;
    G8_STAGE(G8_SB(0, 0), cB0, voffB); G8_STAGE(G8_SA(0, 0), cA, voffA[0]); G8_STAGE(G8_SB(0, 1), cB1, voffB); G8_STAGE(G8_SA(0, 1), cA, voffA[1]);
    if (wr == 1) G8_BAR;
    G8_WAIT_V(4); G8_BAR;
    G8_STAGE(G8_SB(1, 0), cB0 + kstep, voffB); G8_STAGE(G8_SA(1, 0), cA + kstep, voffA[0]); G8_STAGE(G8_SB(1, 1), cB1 + kstep, voffB);
    G8_WAIT_V(6); G8_BAR;
    for (;;) {
        const bool has_next = S.next(ui + 1, nxt);
        const char* nA = has_next ? nxt.A : cA; const char* nB0 = has_next ? nxt.B0 : cB0; const char* nB1 = has_next ? nxt.B1 : cB1;
        if constexpr (Sched::LDSAUX) { if (has_next) G8_AUX_ISSUE(nxt, par_nxt); }
        else if constexpr (Sched::GATHER) {
            if (has_next) a_offsets<Sched>(nxt, Rr, Cc, nvoffA);
            else {
#pragma unroll
                for (int h = 0; h < 2; ++h)
#pragma unroll
                    for (int i = 0; i < 2; ++i) nvoffA[h][i] = voffA[h][i];
            }
        }
        for (int t = 0; t < nt; t += 2) {
            const bool last = (t == nt - 2);
            const char* a1 = cA + (size_t)(t + 1) * kstep;
            const char* a2 = last ? nA : cA + (size_t)(t + 2) * kstep;
            const char* b20 = last ? nB0 : cB0 + (size_t)(t + 2) * kstep; const char* b21 = last ? nB1 : cB1 + (size_t)(t + 2) * kstep;
            const char* a3 = a2 + kstep; const char* b30 = b20 + kstep; const char* b31 = b21 + kstep;
            G8_LDB(B0, 0, 0); G8_SCHED; G8_LDA(At, 0, 0); G8_STAGE(G8_SA(1, 1), a1, voffA[1]);
            G8_WAIT_L(8); G8_BAR; G8_WAIT_L(0); G8_MMA(0, 0, At, B0); G8_BAR; G8_SCHED;
            if constexpr (Sched::LDSAUX) { if (last && has_next) G8_AUX_OFFS(par_nxt); }
            else if constexpr (Sched::GATHER) { if (last) {
#pragma unroll
                for (int h = 0; h < 2; ++h)
#pragma unroll
                    for (int i = 0; i < 2; ++i) voffA[h][i] = nvoffA[h][i]; } }
            G8_LDB(B1, 0, 1); G8_STAGE(G8_SB(0, 0), b20, voffB);
            G8_BAR; G8_WAIT_L(0); G8_MMA(0, 1, At, B1); G8_BAR;
            G8_LDA(At, 0, 1); G8_STAGE(G8_SA(0, 0), a2, voffA[0]);
            G8_BAR; G8_WAIT_L(0); G8_MMA(1, 0, At, B0); G8_BAR; G8_SCHED;
            G8_STAGE(G8_SB(0, 1), b21, voffB);
            G8_WAIT_V(6); G8_BAR; G8_MMA(1, 1, At, B1); G8_BAR;
            G8_LDB(B0, 1, 0); G8_SCHED; G8_LDA(At, 1, 0); G8_STAGE(G8_SA(0, 1), a2, voffA[1]);
            G8_WAIT_L(8); G8_BAR; G8_WAIT_L(0); G8_MMA(0, 0, At, B0); G8_BAR; G8_SCHED;
            G8_LDB(B1, 1, 1); G8_STAGE(G8_SB(1, 0), b30, voffB);
            G8_BAR; G8_WAIT_L(0); G8_MMA(0, 1, At, B1); G8_BAR;
            G8_LDA(At, 1, 1); G8_STAGE(G8_SA(1, 0), a3, voffA[0]);
            G8_BAR; G8_WAIT_L(0); G8_MMA(1, 0, At, B0); G8_BAR; G8_SCHED;
            G8_STAGE(G8_SB(1, 1), b31, voffB);
            G8_WAIT_V(6); G8_BAR; G8_MMA(1, 1, At, B1); G8_BAR;
        }
        E(acc, cur, wr, wc, fr, fq, (const LAS int*)(auxb + par_cur * 2048), (const LAS float*)(auxb + par_cur * 2048 + 1024));
        if (!has_next) break;
#pragma unroll
        for (int a = 0; a < 2; ++a)
#pragma unroll
            for (int b = 0; b < 2; ++b)
#pragma unroll
                for (int m = 0; m < 4; ++m)
#pragma unroll
                    for (int n = 0; n < 2; ++n) acc[a][b][m][n] = (f32x4){0.f, 0.f, 0.f, 0.f};
        cur = nxt; cA = nA; cB0 = nB0; cB1 = nB1; ++ui; wsc_cur = cur.wscale; par_cur = par_nxt; par_nxt = par_nxt == 2 ? 0 : par_nxt + 1;
    }
    G8_WAIT_V(0);
    if (wr == 0) G8_BAR;
    G8_BAR;
#undef G8_AUX_ISSUE
#undef G8_AUX_OFFS
#undef G8_SA
#undef G8_SB
#undef G8_STAGE
#undef G8_LDA
#undef G8_LDB
#undef G8_MMA
#undef G8_WAIT_V
#undef G8_WAIT_L
#undef G8_BAR
#undef G8_SCHED
}

template <int K_, int LDA_>
struct DenseSched {
    static constexpr int K = K_, LDA = LDA_, SHIFT = 0, ESZ = 2, FMT_W = 0, FMT_A = 0; static constexpr bool GATHER = false, LDSAUX = false;
    const char* A; const char* Bt; int nM, nN, nwg, G, c;
    __device__ void init(const void* A_, const void* Bt_, int M, int N, int G_, int c_) { A = (const char*)A_; Bt = (const char*)Bt_; nM = M / BM; nN = N / BM; nwg = nM * nN; G = G_; c = c_; }
    __device__ __forceinline__ bool next(int i, Unit& u) const {
        const long L = (long)i * G + c; if (L >= nwg) return false;
        int wgid = (int)L; { const int q = nwg / NXCD, r = nwg % NXCD, xcd = wgid % NXCD, off = wgid / NXCD; wgid = (xcd < r ? xcd * (q + 1) : r * (q + 1) + (xcd - r) * q) + off; }
        constexpr int WGM = 8;
        const int nig = WGM * nN, gid = wgid / nig, fm = gid * WGM, gsz = (nM - fm) < WGM ? (nM - fm) : WGM;
        const int pm = fm + ((wgid % nig) % gsz), pn = (wgid % nig) / gsz;
        u.A = A + (size_t)pm * BM * LDA * 2; u.B0 = Bt + (size_t)pn * BM * K * 2; u.B1 = u.B0 + (size_t)HALF * K * 2;
        u.rows = nullptr; u.bias0 = nullptr; u.bias1 = nullptr; u.wscale = 0x7f7f7f7f; u.nvalid = BM; u.m0 = pm * BM; u.n0 = pn * BM; u.e = 0; return true;
    }
};

template <int NPN  , int SHIFT_, bool GU>
struct MoeSched {
    static constexpr int K = 2048, LDA = 2048, SHIFT = SHIFT_, ESZ = 1, FMT_W = 0  , FMT_A = 0  ; static constexpr bool GATHER = true, LDSAUX = true;
    const char* A; const char* Bt; const int* slot; const float* bias; const LAS int* tstart; const LAS int* cnt; int G, c;
    __device__ __forceinline__ bool next(int i, Unit& u) const {
        const int ntile = tstart[NEXP]; const int nwg = ntile * NPN;
        const long L = (long)i * G + c; if (L >= nwg) return false;
        int wgid = (int)L; { const int q = nwg / NXCD, r = nwg % NXCD, xcd = wgid % NXCD, off = wgid / NXCD; wgid = (xcd < r ? xcd * (q + 1) : r * (q + 1) + (xcd - r) * q) + off; }
        int e = 0;
        for (int s = 16; s > 0; s >>= 1) if (tstart[e + s] * NPN <= wgid) e += s;
        const int mt = tstart[e + 1] - tstart[e], w = wgid - tstart[e] * NPN, pn = w / mt, m = w % mt;
        u.A = A; u.e = e; u.m0 = m * BM; u.n0 = pn; u.wscale = cnt[40 + (GU ? 0 : 32) + e]; u.rows = slot + (size_t)e * NTOK + m * BM;
        const int left = cnt[e] - m * BM; u.nvalid = left < BM ? left : BM;
        if (GU) { u.B0 = Bt + ((size_t)e * 4096 + (size_t)pn * HALF) * K * ESZ; u.B1 = u.B0 + (size_t)2048 * K * ESZ; u.bias0 = bias + (size_t)e * 4096 + pn * HALF; u.bias1 = u.bias0 + 2048; }
        else { u.B0 = Bt + ((size_t)e * 2048 + (size_t)pn * BM) * K * ESZ; u.B1 = u.B0 + (size_t)HALF * K * ESZ; u.bias0 = bias + (size_t)e * 2048 + pn * BM; u.bias1 = u.bias0 + HALF; }
        return true;
    }
};

struct EpiBf16 {
    static constexpr bool PERM = true;
    bf16_t* O; int ldc;
    __device__ __forceinline__ void operator()(const f32x4 (&acc)[2][2][4][2], const Unit& u, int wr, int wc, int fr, int fq, const LAS int* lrows, const LAS float* lbias) const {
        const int row0 = u.m0 + wr * 64 + fr, col0 = u.n0 + wc * 32 + 8 * fq;
#pragma unroll
        for (int ai = 0; ai < 2; ++ai)
#pragma unroll
            for (int m = 0; m < 4; ++m) { bf16_t* rowp = O + (size_t)(row0 + ai * HALF + m * 16) * ldc + col0;
#pragma unroll
                for (int bj = 0; bj < 2; ++bj) { const f32x4 v0 = acc[ai][bj][m][0], v1 = acc[ai][bj][m][1];
                    u32x4 w; w[0] = cvt_pk_bf16(v0[0], v0[1]); w[1] = cvt_pk_bf16(v0[2], v0[3]); w[2] = cvt_pk_bf16(v1[0], v1[1]); w[3] = cvt_pk_bf16(v1[2], v1[3]);
                    *(u32x4*)(rowp + bj * HALF) = w; } }
    }
};
struct EpiProj {
    static constexpr bool PERM = true;
    bf16_t* O; int ldc; bf16_t* OMF; const float* lb;
    __device__ __forceinline__ void operator()(const f32x4 (&acc)[2][2][4][2], const Unit& u, int wr, int wc, int fr, int fq, const LAS int* lrows, const LAS float* lbias) const {
        const int row0 = u.m0 + wr * 64 + fr, col0 = u.n0 + wc * 32 + 8 * fq;
        const int mode = (u.n0 < 1024 || (u.n0 >= 3072 && u.n0 < 4096)) ? 1 : ((u.n0 >= 1024 && u.n0 < 2048) ? 2 : 0);
        f32x4 lbv[2][2];
        if (mode == 2) {
#pragma unroll
            for (int bj = 0; bj < 2; ++bj) { lbv[bj][0] = *(const f32x4*)(lb + col0 - 1024 + bj * HALF); lbv[bj][1] = *(const f32x4*)(lb + col0 - 1024 + bj * HALF + 4); } }
#pragma unroll
        for (int ai = 0; ai < 2; ++ai)
#pragma unroll
            for (int m = 0; m < 4; ++m) { const size_t rowi = (size_t)(row0 + ai * HALF + m * 16); bf16_t* rowp = O + rowi * ldc + col0;
#pragma unroll
                for (int bj = 0; bj < 2; ++bj) { f32x4 v0 = acc[ai][bj][m][0], v1 = acc[ai][bj][m][1];
                    f32x4 o0 = {0.f, 0.f, 0.f, 0.f}, o1 = o0;
                    if (mode != 0) {
                        f32x4 e0 = v0 * (-1.4426950408889634f), e1 = v1 * (-1.4426950408889634f);
#pragma unroll
                        for (int j = 0; j < 4; ++j) { e0[j] = __builtin_amdgcn_exp2f(e0[j]); e1[j] = __builtin_amdgcn_exp2f(e1[j]); }
                        e0 = e0 + 1.f; e1 = e1 + 1.f;
#pragma unroll
                        for (int j = 0; j < 4; ++j) { e0[j] = __builtin_amdgcn_rcpf(e0[j]); e1[j] = __builtin_amdgcn_rcpf(e1[j]); }
                        if (mode == 1) { v0 = v0 * e0; v1 = v1 * e1; }
                        else { const f32x4 f0 = lbv[bj][0] + (1.f - lbv[bj][0]) * e0, f1 = lbv[bj][1] + (1.f - lbv[bj][1]) * e1;
#pragma unroll
                            for (int j = 0; j < 4; ++j) { v0[j] = __builtin_amdgcn_logf(f0[j]); v1[j] = __builtin_amdgcn_logf(f1[j]); }
                            o0 = 1.f - f0; o1 = 1.f - f1; } }
                    if (mode == 2) {
                        u32x4 w2; w2[0] = cvt_pk_bf16(o0[0], o0[1]); w2[1] = cvt_pk_bf16(o0[2], o0[3]); w2[2] = cvt_pk_bf16(o1[0], o1[1]); w2[3] = cvt_pk_bf16(o1[2], o1[3]);
                        *(u32x4*)(OMF + rowi * HG_W + (col0 - 1024) + bj * HALF) = w2; }
                    u32x4 w; w[0] = cvt_pk_bf16(v0[0], v0[1]); w[1] = cvt_pk_bf16(v0[2], v0[3]); w[2] = cvt_pk_bf16(v1[0], v1[1]); w[3] = cvt_pk_bf16(v1[2], v1[3]);
                    *(u32x4*)(rowp + bj * HALF) = w; } }
    }
};
struct EpiResF32 {
    static constexpr bool PERM = false;
    float* C; const float* res; int ldc;
    __device__ __forceinline__ void operator()(const f32x4 (&acc)[2][2][4][2], const Unit& u, int wr, int wc, int fr, int fq, const LAS int* lrows, const LAS float* lbias) const {
        const int row0 = u.m0 + wr * 64 + fr, col0 = u.n0 + wc * 32 + 4 * fq;
#pragma unroll
        for (int ai = 0; ai < 2; ++ai)
#pragma unroll
            for (int m = 0; m < 4; ++m) { const size_t off = (size_t)(row0 + ai * HALF + m * 16) * ldc + col0;
#pragma unroll
                for (int bj = 0; bj < 2; ++bj)
#pragma unroll
                    for (int n = 0; n < 2; ++n) { const f32x4 r = *(const f32x4*)(res + off + bj * HALF + n * 16); *(f32x4*)(C + off + bj * HALF + n * 16) = acc[ai][bj][m][n] + r; } }
    }
};
struct EpiResBf16 {
    static constexpr bool PERM = true;
    bf16_t* C; const float* res; int ldc;
    __device__ __forceinline__ void operator()(const f32x4 (&acc)[2][2][4][2], const Unit& u, int wr, int wc, int fr, int fq, const LAS int*, const LAS float*) const {
        const int row0 = u.m0 + wr * 64 + fr, col0 = u.n0 + wc * 32 + 8 * fq;
#pragma unroll
        for (int ai = 0; ai < 2; ++ai)
#pragma unroll
            for (int m = 0; m < 4; ++m) { const size_t off = (size_t)(row0 + ai * HALF + m * 16) * ldc + col0;
#pragma unroll
                for (int bj = 0; bj < 2; ++bj) { const f32x4 r0 = *(const f32x4*)(res + off + bj * HALF), r1 = *(const f32x4*)(res + off + bj * HALF + 4);
                    const f32x4 v0 = acc[ai][bj][m][0] + r0, v1 = acc[ai][bj][m][1] + r1;
                    u32x4 w; w[0] = cvt_pk_bf16(v0[0], v0[1]); w[1] = cvt_pk_bf16(v0[2], v0[3]); w[2] = cvt_pk_bf16(v1[0], v1[1]); w[3] = cvt_pk_bf16(v1[2], v1[3]);
                    *(u32x4*)(C + off + bj * HALF) = w; } }
    }
};
struct EpiGateUp {
    static constexpr bool PERM = true;
    unsigned char* ACT; const float* bias;
    __device__ __forceinline__ void operator()(const f32x4 (&acc)[2][2][4][2], const Unit& u, int wr, int wc, int fr, int fq, const LAS int* lrows, const LAS float* lbias) const {
        const int colh = u.n0 * HALF + wc * 32 + 8 * fq;
        const LAS float* bp = lbias + wc * 32 + 8 * fq;
        const f32x4 bg0 = *(const LAS f32x4*)bp, bg1 = *(const LAS f32x4*)(bp + 4), bu0 = *(const LAS f32x4*)(bp + 128), bu1 = *(const LAS f32x4*)(bp + 132);
#pragma unroll
        for (int ai = 0; ai < 2; ++ai)
#pragma unroll
            for (int m = 0; m < 4; ++m) { const int r = ai * HALF + wr * 64 + m * 16 + fr;
                if (r < u.nvalid) { const int asg = lrows[r];
                    f32x4 g0 = acc[ai][0][m][0] + bg0, g1 = acc[ai][0][m][1] + bg1, u0 = acc[ai][1][m][0] + bu0, u1 = acc[ai][1][m][1] + bu1;
                    f32x4 e0, e1;
#pragma unroll
                    for (int j = 0; j < 4; ++j) { g0[j] = fminf(g0[j], 7.f); g1[j] = fminf(g1[j], 7.f); u0[j] = __builtin_amdgcn_fmed3f(u0[j], -7.f, 7.f); u1[j] = __builtin_amdgcn_fmed3f(u1[j], -7.f, 7.f); }
                    const f32x4 z0 = g0 * (-1.702f * 1.4426950408889634f), z1 = g1 * (-1.702f * 1.4426950408889634f);
#pragma unroll
                    for (int j = 0; j < 4; ++j) { e0[j] = __builtin_amdgcn_exp2f(z0[j]); e1[j] = __builtin_amdgcn_exp2f(z1[j]); }
                    e0 = e0 + 1.f; e1 = e1 + 1.f;
#pragma unroll
                    for (int j = 0; j < 4; ++j) { e0[j] = __builtin_amdgcn_rcpf(e0[j]); e1[j] = __builtin_amdgcn_rcpf(e1[j]); }
                    const f32x4 o0 = (g0 * e0) * (u0 + 1.f), o1 = (g1 * e1) * (u1 + 1.f);
                    u32x2 w; w[0] = cvt4_fp8(o0[0], o0[1], o0[2], o0[3]); w[1] = cvt4_fp8(o1[0], o1[1], o1[2], o1[3]);
                    *(u32x2*)(ACT + (size_t)asg * DFF + colh) = w; } }
    }
};
struct EpiDown {
    static constexpr bool PERM = true;
    unsigned char* Y; const float* bias;
    __device__ __forceinline__ void operator()(const f32x4 (&acc)[2][2][4][2], const Unit& u, int wr, int wc, int fr, int fq, const LAS int* lrows, const LAS float* lbias) const {
        const int col0 = u.n0 * BM + wc * 32 + 8 * fq;
        const LAS float* bp = lbias + wc * 32 + 8 * fq;
        f32x4 bv[2][2];
#pragma unroll
        for (int bj = 0; bj < 2; ++bj) { bv[bj][0] = *(const LAS f32x4*)(bp + bj * HALF); bv[bj][1] = *(const LAS f32x4*)(bp + bj * HALF + 4); }
#pragma unroll
        for (int ai = 0; ai < 2; ++ai)
#pragma unroll
            for (int m = 0; m < 4; ++m) { const int r = ai * HALF + wr * 64 + m * 16 + fr;
                if (r < u.nvalid) { const int asg = lrows[r]; unsigned char* rowp = Y + (size_t)asg * DM + col0;
#pragma unroll
                    for (int bj = 0; bj < 2; ++bj) { const f32x4 v0 = acc[ai][bj][m][0] + bv[bj][0], v1 = acc[ai][bj][m][1] + bv[bj][1];
                        u32x2 w; w[0] = cvt4_fp8(v0[0], v0[1], v0[2], v0[3]); w[1] = cvt4_fp8(v1[0], v1[1], v1[2], v1[3]);
                        *(u32x2*)(rowp + bj * HALF) = w; } } }
    }
};
}

struct Args { const float* in[18]; float* out; unsigned char* ws; int ph_lo, ph_hi; };
enum { I_X = 0, I_N1G, I_WIN, I_LBL, I_HGNG, I_CPOS, I_CW1, I_CW2, I_NSAG, I_WOUT, I_N2G, I_WR, I_BR, I_WGU, I_BGU, I_WD, I_BD, I_FNG };
constexpr int LDS_STAGE = 131072, LDS_BYTES = LDS_STAGE + 16384, LDS_MISC = LDS_BYTES - 4096;

struct Frame {
    LAS unsigned char* lds; unsigned char* ws; unsigned* ctl; int tid, wid, lane, G, bid;
};

__device__ __forceinline__ void conv_tile(const Frame& F, const float* src, int lds_, int k0, int n0, int N, bf16_t* dst, int ldd) {
    LAS float* tile = (LAS float*)F.lds;
#pragma unroll
    for (int p = 0; p < 2; ++p) { const int k = p * 32 + (F.tid >> 4), n = (F.tid & 15) * 4;
        f32x4 v = (f32x4){0.f, 0.f, 0.f, 0.f};
        if (n0 + n < N) v = *(const f32x4*)(src + (size_t)(k0 + k) * lds_ + n0 + n);
        tile[k * 65 + n] = v[0]; tile[k * 65 + n + 1] = v[1]; tile[k * 65 + n + 2] = v[2]; tile[k * 65 + n + 3] = v[3]; }
    __syncthreads();
    { const int n = F.tid >> 3, kc = (F.tid & 7) * 8;
      if (n0 + n < N) { float f[8];
#pragma unroll
          for (int j = 0; j < 8; ++j) f[j] = tile[(kc + j) * 65 + n];
          u32x4 w; w[0] = cvt_pk_bf16(f[0], f[1]); w[1] = cvt_pk_bf16(f[2], f[3]); w[2] = cvt_pk_bf16(f[4], f[5]); w[3] = cvt_pk_bf16(f[6], f[7]);
          *(u32x4*)(dst + (size_t)(n0 + n) * ldd + k0 + kc) = w; } }
    __syncthreads();
}
struct ConvJob { const float* src; unsigned char* dst; int N; };
__device__ __forceinline__ ConvJob conv_job(const Args& a, unsigned char* ws, int st, int& kt, int& ntile) {
    ConvJob j;
    if (st < 8192) { const int e = st >> 8, r = st & 255; kt = r >> 4; ntile = r & 15; j.src = a.in[I_WGU] + (size_t)e * DM * 4096; j.dst = ws + WS_WGUT + (size_t)e * 4096 * DM; j.N = 4096; }
    else { const int q = st - 8192, e = q >> 7, r = q & 127; kt = r >> 3; ntile = r & 7; j.src = a.in[I_WD] + (size_t)e * DFF * DM; j.dst = ws + WS_WDT + (size_t)e * DM * DFF; j.N = 2048; }
    return j;
}
__device__ __forceinline__ void conv_experts(const Frame& F, const Args& a, int first, int stride, int limit) {
    unsigned char* ws = F.ws; LAS unsigned* tile = (LAS unsigned*)F.lds;
    LAS float* mtab = (LAS float*)(F.lds + 32768);
    if (F.tid < 64) mtab[F.tid] = shift_mult(amax_shift(__hip_atomic_load(F.ctl + CW_AMAX + F.tid, __ATOMIC_RELAXED, __HIP_MEMORY_SCOPE_AGENT)));
    __syncthreads();
    const int NST = limit;
    const int lk = F.tid >> 5, lc = F.tid & 31;
    f32x4 v[16];
    int st = first, kt = 0, ntile = 0; ConvJob J{};
#define CV_LOAD() do { _Pragma("unroll") for (int T = 0; T < 2; ++T) _Pragma("unroll") for (int pp = 0; pp < 8; ++pp) \
        v[T * 8 + pp] = __builtin_nontemporal_load((const f32x4*)(J.src + (size_t)(kt * 128 + pp * 16 + lk) * J.N + ntile * 256 + T * 128 + lc * 4)); } while (0)
    if (st < NST) { J = conv_job(a, ws, st, kt, ntile); CV_LOAD(); }
    for (; st < NST; st += stride) {
        const float mlt = mtab[st < 8192 ? (st >> 8) : 32 + ((st - 8192) >> 7)];
#pragma unroll
        for (int T = 0; T < 2; ++T)
#pragma unroll
            for (int pp = 0; pp < 8; ++pp) { const int k = pp * 16 + lk; const f32x4 x = v[T * 8 + pp];
                tile[T * 4096 + k * 32 + (lc ^ (4 * (k >> 4)))] = cvt4_fp8s(x[0], x[1], x[2], x[3], mlt); }
        __syncthreads();
        const ConvJob Jc = J; const int ktc = kt, ntc = ntile;
        const int nx = st + stride;
        if (nx < NST) { J = conv_job(a, ws, nx, kt, ntile); CV_LOAD(); }
        { const int i = F.tid & 7, n4g = (F.tid >> 3) & 31, T = F.tid >> 8;
          unsigned d[16];
#pragma unroll
          for (int jj = 0; jj < 16; ++jj) d[jj] = tile[T * 4096 + (16 * i + jj) * 32 + (n4g ^ (4 * i))];
          u32x4 o[4];
#pragma unroll
          for (int q = 0; q < 4; ++q) {
              const unsigned a0 = __builtin_amdgcn_perm(d[4 * q + 1], d[4 * q], 0x05010400u), a1 = __builtin_amdgcn_perm(d[4 * q + 1], d[4 * q], 0x07030602u);
              const unsigned a2 = __builtin_amdgcn_perm(d[4 * q + 3], d[4 * q + 2], 0x05010400u), a3 = __builtin_amdgcn_perm(d[4 * q + 3], d[4 * q + 2], 0x07030602u);
              o[0][q] = __builtin_amdgcn_perm(a2, a0, 0x05040100u); o[1][q] = __builtin_amdgcn_perm(a2, a0, 0x07060302u);
              o[2][q] = __builtin_amdgcn_perm(a3, a1, 0x05040100u); o[3][q] = __builtin_amdgcn_perm(a3, a1, 0x07060302u); }
          unsigned char* dp = Jc.dst + (size_t)(ntc * 256 + T * 128 + n4g * 4) * DM + ktc * 128 + 16 * i;
#pragma unroll
          for (int r = 0; r < 4; ++r) *(u32x4*)(dp + (size_t)r * DM) = o[r]; }
        __syncthreads();
    }
#undef CV_LOAD
}
__device__ __forceinline__ void conv_matrix4(const Frame& F, const float* src, int K, int N, bf16_t* dst) {
    LAS float* tile = (LAS float*)F.lds;
    const int tn4 = (N + 255) / 256, tk = K / 64, cnt = tn4 * tk;
    for (int t = F.bid; t < cnt; t += F.G) { const int k0 = (t / tn4) * 64, n00 = (t % tn4) * 256;
        f32x4 v[8];
#pragma unroll
        for (int q = 0; q < 4; ++q)
#pragma unroll
            for (int p = 0; p < 2; ++p) { const int k = p * 32 + (F.tid >> 4), n = n00 + q * 64 + (F.tid & 15) * 4;
                v[q * 2 + p] = (n < N) ? *(const f32x4*)(src + (size_t)(k0 + k) * N + n) : (f32x4){0.f, 0.f, 0.f, 0.f}; }
#pragma unroll
        for (int q = 0; q < 4; ++q)
#pragma unroll
            for (int p = 0; p < 2; ++p) { LAS float* tp = tile + q * (64 * 65) + (p * 32 + (F.tid >> 4)) * 65 + (F.tid & 15) * 4; const f32x4 x = v[q * 2 + p]; tp[0] = x[0]; tp[1] = x[1]; tp[2] = x[2]; tp[3] = x[3]; }
        __syncthreads();
        { const int n = F.tid >> 3, kc = (F.tid & 7) * 8;
#pragma unroll
          for (int q = 0; q < 4; ++q) { const int nn = n00 + q * 64 + n;
              if (nn < N) { float f[8];
#pragma unroll
                  for (int j = 0; j < 8; ++j) f[j] = tile[q * (64 * 65) + (kc + j) * 65 + n];
                  u32x4 w; w[0] = cvt_pk_bf16(f[0], f[1]); w[1] = cvt_pk_bf16(f[2], f[3]); w[2] = cvt_pk_bf16(f[4], f[5]); w[3] = cvt_pk_bf16(f[6], f[7]);
                  *(u32x4*)(dst + (size_t)nn * K + k0 + kc) = w; } } }
        __syncthreads(); }
}
__device__ __forceinline__ void conv_matrix(const Frame& F, const float* src, int K, int N, bf16_t* dst, long& base) {
    const int tn = (N + 63) / 64, tk = K / 64; const long cnt = (long)tn * tk;
    long first = ((long)F.bid - base) % F.G; if (first < 0) first += F.G;
    for (long t = first; t < cnt; t += F.G) { const int kt = (int)(t / tn), nt_ = (int)(t % tn); conv_tile(F, src, N, kt * 64, nt_ * 64, N, dst, K); }
    base += cnt;
}
__device__ __forceinline__ void bias1_partials(const Frame& F, const Args& a, int rank, int nranks) {
    LAS float* red = (LAS float*)F.lds;
    const int c = F.tid & 127, kq = F.tid >> 7;
    for (int job = rank; job < 64; job += nranks) { const int j = job >> 5, kg = job & 31;
        const float* pos = a.in[I_CPOS] + (size_t)j * 4096 + kg * 128 + kq * 32; const float* w1 = a.in[I_CW1] + ((size_t)j * 4096 + kg * 128 + kq * 32) * 128 + c;
        float s0 = 0.f, s1 = 0.f, s2 = 0.f, s3 = 0.f;
#pragma unroll
        for (int k = 0; k < 32; k += 4) { s0 += pos[k] * w1[(size_t)k * 128]; s1 += pos[k + 1] * w1[(size_t)(k + 1) * 128]; s2 += pos[k + 2] * w1[(size_t)(k + 2) * 128]; s3 += pos[k + 3] * w1[(size_t)(k + 3) * 128]; }
        red[kq * 128 + c] = (s0 + s1) + (s2 + s3);
        __syncthreads();
        if (F.tid < 128) ((float*)(F.ws + WS_B1P))[((size_t)j * 32 + kg) * 128 + c] = ((red[c] + red[128 + c]) + red[256 + c]) + red[384 + c];
        __syncthreads(); }
}
__device__ __forceinline__ void p0_sample(const Frame& F, const Args& a) {
    const int j = F.bid & 63, q = F.bid >> 6, nq = (F.G + 63 - j) >> 6;
    const float* src; size_t stride; int nalt;
    if (j < 32) { src = a.in[I_WGU] + (size_t)j * DM * 4096; stride = (size_t)DM * 4096 / 64; nalt = 2; }
    else { src = a.in[I_WD] + (size_t)(j - 32) * DFF * DM; stride = (size_t)DFF * DM / 64; nalt = 1; }
    float mx = 0.f;
    for (int c = q; c < 64; c += nq) { const f32x4 v = *(const f32x4*)(src + (size_t)c * stride + (size_t)(c % nalt) * 2048 + F.tid * 4);
        mx = fmaxf(fmaxf(mx, fmaxf(fabsf(v[0]), fabsf(v[1]))), fmaxf(fabsf(v[2]), fabsf(v[3]))); }
    mx = wave_max(mx);
    if (F.lane == 0 && mx > 0.f) atomicMax(F.ctl + CW_AMAX + j, __float_as_uint(mx));
}
__device__ __forceinline__ void p0_prologue(const Frame& F, const Args& a) {
    unsigned char* ws = F.ws;
    long base = 0;
    p0_sample(F, a);
    static_assert(CONV_P0 == 0, "expert tiles need the sampled scales: none may be converted in the prologue");
    conv_matrix4(F, a.in[I_WIN], DM, IN_COLS, (bf16_t*)(ws + WS_WINT));
    conv_matrix(F, a.in[I_WOUT], DM, DM, (bf16_t*)(ws + WS_WOUTT), base);
    for (int fi = F.bid * NTHREADS + F.tid; fi < 2 * 8 * 32 * 4 * 64; fi += F.G * NTHREADS) {
        const int ln_ = fi & 63, ct = (fi >> 6) & 3, ks = (fi >> 8) & 31, w = (fi >> 13) & 7, j = fi >> 16;
        const float* wp = a.in[I_CW1] + ((size_t)j * 4096 + w * 512 + ks * 16 + (ln_ >> 5) * 8) * 128 + ct * 32 + (ln_ & 31);
        u32x4 fw; fw[0] = cvt_pk_bf16(wp[0], wp[128]); fw[1] = cvt_pk_bf16(wp[256], wp[384]); fw[2] = cvt_pk_bf16(wp[512], wp[640]); fw[3] = cvt_pk_bf16(wp[768], wp[896]);
        *(u32x4*)((bf16_t*)(ws + WS_W1T) + (size_t)fi * 8) = fw; }
    for (int j = 0; j < 2; ++j) conv_matrix(F, a.in[I_CW2] + (size_t)j * 128 * 128, 128, 128, (bf16_t*)(ws + WS_W2T) + (size_t)j * 128 * 128, base);
    { const float* x = a.in[I_X]; const float* g = a.in[I_N1G]; bf16_t* U = (bf16_t*)(ws + WS_U);
      f32x4 vn[8]; int row = F.bid * 8 + F.wid;
#define P0_LDROW(r_) do { const float* xr_ = x + (size_t)(r_) * DM; _Pragma("unroll") for (int i = 0; i < 4; ++i) { vn[2 * i] = *(const f32x4*)(xr_ + i * 512 + F.lane * 8); vn[2 * i + 1] = *(const f32x4*)(xr_ + i * 512 + F.lane * 8 + 4); } } while (0)
      if (row < NTOK) P0_LDROW(row);
      for (; row < NTOK; row += F.G * 8) {
          f32x4 v[8]; float ss = 0.f;
#pragma unroll
          for (int i = 0; i < 8; ++i) v[i] = vn[i];
          if (row + F.G * 8 < NTOK) P0_LDROW(row + F.G * 8);
#pragma unroll
          for (int i = 0; i < 8; ++i)
#pragma unroll
              for (int j = 0; j < 4; ++j) ss += v[i][j] * v[i][j];
          ss = wave_sum(ss); const float rs = rsqrtf(ss * (1.f / DM) + EPS);
#pragma unroll
          for (int i = 0; i < 4; ++i) { const f32x4 g0 = *(const f32x4*)(g + i * 512 + F.lane * 8), g1 = *(const f32x4*)(g + i * 512 + F.lane * 8 + 4);
              const f32x4 a0 = v[2 * i] * rs * g0, a1 = v[2 * i + 1] * rs * g1;
              u32x4 w; w[0] = cvt_pk_bf16(a0[0], a0[1]); w[1] = cvt_pk_bf16(a0[2], a0[3]); w[2] = cvt_pk_bf16(a1[0], a1[1]); w[3] = cvt_pk_bf16(a1[2], a1[3]);
              *(u32x4*)(U + (size_t)row * DM + i * 512 + F.lane * 8) = w; } }
#undef P0_LDROW
    }
    { const int gw = F.bid * 8 + F.wid;
      (void)gw;
      for (int i = F.bid * NTHREADS + F.tid; i < DM * NEXP; i += F.G * NTHREADS) ((float*)(ws + WS_WR2))[i] = a.in[I_N2G][i >> 5] * a.in[I_WR][i];
      for (int i = F.bid * NTHREADS + F.tid; i < HG_W; i += F.G * NTHREADS) { const float l0 = a.in[I_LBL][i], l1 = a.in[I_LBL][HG_W + i]; const float m = fmaxf(l0, l1);
          const float e0 = __expf(l0 - m), e1 = __expf(l1 - m); ((float*)(ws + WS_LB))[i] = e0 / (e0 + e1); } }
}

__device__ __forceinline__ float gelu_tanh(float x) { const float u = 0.7978845608028654f * (x + 0.044715f * x * x * x); return 0.5f * x * (1.f + tanhf(u)); }
__device__ __forceinline__ void p2_compress_naive(const Frame& F, const Args& a) {
    unsigned char* ws = F.ws; const bf16_t* PROJ = (const bf16_t*)(ws + WS_PROJ);
    LAS float* red = (LAS float*)F.lds;
    LAS float* hdn = red + 512;
    const int c = F.tid & 127, kq = F.tid >> 7;
    for (int u = F.bid; u < 2 * 16 * 128; u += F.G) {
        const int j = u >> 11, bg = (u >> 7) & 15, n = u & 127, b = bg >> 1, g = bg & 1;
        bf16_t* dst = (bf16_t*)(ws + (j ? WS_VC : WS_KC)) + ((size_t)bg * 128 + n) * 128;
        if (n == 127) { if (F.tid < 128) dst[F.tid] = 0; continue; }
        const float* w1 = a.in[I_CW1] + (size_t)j * 4096 * 128; const float* pos = a.in[I_CPOS] + (size_t)j * 4096;
        const int colb = (j ? C_VCM : C_KCM) + g * 128;
        float s = 0.f;
        for (int k = kq * 1024; k < kq * 1024 + 1024; ++k) { const int l = k >> 7, d = k & 127;
            const float av = bf2f(PROJ[(size_t)(b * SEQ + 16 * n + l) * PROJ_LD + colb + d]) + pos[k];
            s += av * w1[(size_t)k * 128 + c]; }
        red[kq * 128 + c] = s; __syncthreads();
        if (F.tid < 128) hdn[c] = gelu_tanh(red[c] + red[128 + c] + red[256 + c] + red[384 + c]);
        __syncthreads();
        if (F.tid < 128) { const float* w2 = a.in[I_CW2] + (size_t)j * 128 * 128; float o = 0.f; for (int k = 0; k < 128; ++k) o += hdn[k] * w2[k * 128 + c]; dst[c] = f2bf(o); }
        __syncthreads();
    }
}

__device__ __forceinline__ void hgrn_naive_unit(const Frame& F, const Args& a, int unit) {
    unsigned char* ws = F.ws; const bf16_t* PROJ = (const bf16_t*)(ws + WS_PROJ); bf16_t* YM = (bf16_t*)(ws + WS_YMIX);
    const float* lbv = (const float*)(ws + WS_LB);
    const int b = unit >> 3, h = unit & 7, v = F.tid & 127, kg = F.tid >> 7;
    LAS float* fs = (LAS float*)F.lds;
    LAS float* qs = fs + 2048; LAS float* is_ = qs + 2048; LAS float* red = is_ + 2048  ; LAS float* ob = red + 512  ;
    float S[32];
#pragma unroll
    for (int i = 0; i < 32; ++i) S[i] = 0.f;
    for (int t0 = 0; t0 < SEQ; t0 += 16) {
        for (int i = F.tid; i < 2048; i += NTHREADS) { const int st = i >> 7, k = i & 127; const size_t rowo = (size_t)(b * SEQ + t0 + st) * PROJ_LD + h * 128 + k;
            const float lb = lbv[h * 128 + k];
            fs[i] = lb + (1.f - lb) * sigmoidf_(bf2f(PROJ[rowo + C_HF])); qs[i] = siluf_(bf2f(PROJ[rowo + C_HQ])); is_[i] = bf2f(PROJ[rowo + C_HI]); }
        __syncthreads();
        for (int st = 0; st < 16; ++st) {
            const float iv = is_[st * 128 + v]; float po = 0.f;
#pragma unroll
            for (int kk = 0; kk < 32; ++kk) { const int k = kg * 32 + kk; const float f = fs[st * 128 + k]; S[kk] = f * S[kk] + (1.f - f) * iv; po += S[kk] * qs[st * 128 + k]; }
            red[kg * 128 + v] = po; __syncthreads();
            if (kg == 0) ob[st * 128 + v] = red[v] + red[128 + v] + red[256 + v] + red[384 + v];
            __syncthreads();
        }
        for (int s2 = 0; s2 < 2; ++s2) { const int st = F.wid * 2 + s2; const float o0 = ob[st * 128 + F.lane], o1 = ob[st * 128 + 64 + F.lane];
            const float ss = wave_sum(o0 * o0 + o1 * o1); const float rs = rsqrtf(ss * (1.f / 128.f) + EPS);
            const size_t row = (size_t)(b * SEQ + t0 + st);
            const float g0 = bf2f(PROJ[row * PROJ_LD + C_HGT + h * 128 + F.lane]), g1 = bf2f(PROJ[row * PROJ_LD + C_HGT + h * 128 + 64 + F.lane]);
            YM[row * DM + h * 128 + F.lane] = f2bf(o0 * rs * a.in[I_HGNG][F.lane] * siluf_(g0));
            YM[row * DM + h * 128 + 64 + F.lane] = f2bf(o1 * rs * a.in[I_HGNG][64 + F.lane] * siluf_(g1)); }
        __syncthreads();
    }
}

__device__ __forceinline__ float dot128_bf(const LAS float* q, const bf16_t* k) {
    float s = 0.f;
#pragma unroll
    for (int c = 0; c < 16; ++c) { const u32x4 w = *(const u32x4*)(k + c * 8); float f[8]; unpack8(w, f);
#pragma unroll
        for (int j = 0; j < 8; ++j) s += q[c * 8 + j] * f[j]; }
    return s;
}
__device__ __forceinline__ void softmax4(const Frame& F, LAS float* sc, int stride, int n, LAS float* tmp  ) {
    const int r = F.tid >> 7, i0 = F.tid & 127;
    float m = -INFINITY; for (int i = i0; i < n; i += 128) m = fmaxf(m, sc[r * stride + i]);
    m = wave_max(m); if (F.lane == 0) tmp[F.wid] = m; __syncthreads();
    m = fmaxf(tmp[2 * r], tmp[2 * r + 1]); __syncthreads();
    float s = 0.f;
    for (int i = i0; i < n; i += 128) { const float x = sc[r * stride + i]; const float p = (x == -INFINITY) ? 0.f : __expf(x - m); sc[r * stride + i] = p; s += p; }
    s = wave_sum(s); if (F.lane == 0) tmp[F.wid] = s; __syncthreads();
    s = tmp[2 * r] + tmp[2 * r + 1]; const float inv = s > 0.f ? 1.f / s : 0.f;
    for (int i = i0; i < n; i += 128) sc[r * stride + i] *= inv;
    __syncthreads();
}
__device__ __forceinline__ void attn_naive_unit(const Frame& F, const Args& a, int unit) {
    unsigned char* ws = F.ws; const bf16_t* PROJ = (const bf16_t*)(ws + WS_PROJ); bf16_t* YM = (bf16_t*)(ws + WS_YMIX);
    const int b = unit >> 12, g = (unit >> 11) & 1, t = unit & 2047, bg = b * 2 + g;
    LAS float* qs = (LAS float*)F.lds;
    LAS float* sc = qs + 512;
    LAS float* tmp = sc + 4096;
    LAS float* imp = tmp + 16;
    LAS int* selk = (LAS int*)(imp + 32);
    LAS float* oacc = (LAS float*)(selk + 32);
    const int r4 = F.tid >> 7, d = F.tid & 127;
    const size_t rowq = (size_t)(b * SEQ + t) * PROJ_LD;
    qs[F.tid] = bf2f(PROJ[rowq + C_NQ + (g * 4 + r4) * 128 + d]);
    const float slope = exp2f(-(float)(g * 4 + r4 + 1));
    const float scale = 0.08838834764831845f;
    float gate[3];
#pragma unroll
    for (int c = 0; c < 3; ++c) gate[c] = sigmoidf_(bf2f(PROJ[rowq + C_NGT + (g * 4 + r4) * 3 + c]));
    __syncthreads();
    { const int n = d; float s = -INFINITY;
      if (n < NCMP) { const int dist = t - (16 * n + 31); if (dist >= 0) s = dot128_bf(qs + r4 * 128, (const bf16_t*)(ws + WS_KC) + ((size_t)bg * 128 + n) * 128) * scale - slope * (float)dist; }
      sc[r4 * 1024 + n] = s; }
    __syncthreads();
    softmax4(F, sc, 1024, 128, tmp);
    { float o = 0.f; const bf16_t* vc = (const bf16_t*)(ws + WS_VC) + (size_t)bg * 128 * 128;
      for (int n = 0; n < NCMP; ++n) o += sc[r4 * 1024 + n] * bf2f(vc[n * 128 + d]);
      oacc[F.tid] = gate[0] * o; }
    if (F.tid < 32) { const int j = F.tid; float s = 0.f;
        for (int r = 0; r < 4; ++r) for (int q = -1; q <= 3; ++q) { const int n = 4 * j + q; if (n >= 0 && n < NCMP) s += ((q == -1 || q == 3) ? 1.f : 2.f) * sc[r * 1024 + n]; }
        const int cur = t >> 6; const bool forced = (j == 0) || (j == cur) || (j == cur - 1);
        imp[j] = forced ? 1e4f : (j <= cur ? s : -1e4f); }
    __syncthreads();
    if (F.tid < 32) { const int j = F.tid; const float me = imp[j]; int rank = 0;
        for (int k = 0; k < 32; ++k) { const float o = imp[k]; rank += (o > me || (o == me && k < j)) ? 1 : 0; }
        const bool sel = rank < SEL_TOP && j <= (t >> 6);
        const unsigned long long mask = __ballot(sel);
        if (sel) selk[__popcll(mask & ((1ull << j) - 1ull))] = j;
        if (j == 0) selk[16] = __popcll(mask); }
    __syncthreads();
    { const int nsel = selk[16];
      for (int i = F.tid; i < 4 * 1024; i += NTHREADS) sc[i] = -INFINITY;
      __syncthreads();
      const int l = F.tid & 63, r = (F.tid >> 6) & 3, which = F.tid >> 8;
      for (int s0 = 0; s0 < nsel; s0 += 2) { const int si = s0 + which;
          if (si < nsel) { const int kp = selk[si] * 64 + l;
              if (kp <= t) { const float s = dot128_bf(qs + r * 128, PROJ + (size_t)(b * SEQ + kp) * PROJ_LD + C_KSL + g * 128) * scale - exp2f(-(float)(g * 4 + r + 1)) * (float)(t - kp); sc[r * 1024 + si * 64 + l] = s; } } }
      __syncthreads();
      softmax4(F, sc, 1024, nsel * 64, tmp);
      float o = 0.f;
      for (int si = 0; si < nsel; ++si) { const int kb = selk[si] * 64;
          for (int l2 = 0; l2 < 64; ++l2) { const int kp = kb + l2; if (kp > t) break; o += sc[r4 * 1024 + si * 64 + l2] * bf2f(PROJ[(size_t)(b * SEQ + kp) * PROJ_LD + C_VSL + g * 128 + d]); } }
      oacc[F.tid] += gate[1] * o; }
    __syncthreads();
    { for (int i = F.tid; i < 4 * 1024; i += NTHREADS) sc[i] = -INFINITY;
      __syncthreads();
      for (int i = F.tid; i < 4 * 512; i += NTHREADS) { const int r = i >> 9, w = i & 511, kp = t - 511 + w;
          if (kp >= 0) sc[r * 1024 + w] = dot128_bf(qs + r * 128, PROJ + (size_t)(b * SEQ + kp) * PROJ_LD + C_KWN + g * 128) * scale - exp2f(-(float)(g * 4 + r + 1)) * (float)(t - kp); }
      __syncthreads();
      softmax4(F, sc, 1024, 512, tmp);
      float o = 0.f;
      for (int w = 0; w < 512; ++w) { const int kp = t - 511 + w; if (kp >= 0) o += sc[r4 * 1024 + w] * bf2f(PROJ[(size_t)(b * SEQ + kp) * PROJ_LD + C_VWN + g * 128 + d]); }
      oacc[F.tid] += gate[2] * o; }
    __syncthreads();
    { const float o = oacc[F.tid]; float ss = wave_sum(o * o); if (F.lane == 0) tmp[F.wid] = ss; __syncthreads();
      ss = tmp[2 * r4] + tmp[2 * r4 + 1]; const float rs = rsqrtf(ss * (1.f / 128.f) + EPS);
      YM[(size_t)(b * SEQ + t) * DM + HG_W + (g * 4 + r4) * 128 + d] = f2bf(o * rs * a.in[I_NSAG][d]); }
    __syncthreads();
}

namespace at {
constexpr int SHM_T = 64 * 128 * 2;
constexpr int BUF_B = 2 * SHM_T;
constexpr int OFF_V = 0, OFF_K = SHM_T, OFF_IMP = 2 * BUF_B  , OFF_SELM = 3 * BUF_B, OFF_WSC = OFF_SELM + 256;
constexpr float SCALE = 0.08838834764831845f, LOG2E = 1.4426950408889634f, THR = 8.f;
#define AT_KSWZ(row, colB) ((row) * 256 + ((colB) ^ (((row) & 7) << 4)))
__device__ __forceinline__ int v_st(int k, int c) { const int kk = (k & ~0xC) | ((k & 4) << 1) | ((k & 8) >> 1); return ((kk >> 3) * 4 + (c >> 5)) * 512 + ((kk & 7) * 32 + (c & 31)) * 2; }
__device__ __forceinline__ int v_rd_base(int lane) { return ((lane & 3) << 3) | (((lane >> 2) & 3) << 6) | (((lane >> 4) & 1) << 5) | (((lane >> 5) & 1) << 8); }
__device__ __forceinline__ int crow(int r, int hi) { return (r & 3) + 8 * (r >> 2) + 4 * hi; }
typedef short s16x4 __attribute__((ext_vector_type(4)));
struct Stage { u32x4 k0, k1, v0, v1; };
__device__ __forceinline__ void stage_load(Stage& S, const bf16_t* Kp, const bf16_t* Vp, int ld, int row0, int sr, int sc) {
    S.k0 = *(const u32x4*)(Kp + (size_t)(row0 + sr) * ld + sc); S.k1 = *(const u32x4*)(Kp + (size_t)(row0 + 32 + sr) * ld + sc);
    S.v0 = *(const u32x4*)(Vp + (size_t)(row0 + sr) * ld + sc); S.v1 = *(const u32x4*)(Vp + (size_t)(row0 + 32 + sr) * ld + sc);
}
__device__ __forceinline__ void stage_write(const Stage& S, LAS unsigned char* lds, int buf, int sr, int sc) {
    const int kws = AT_KSWZ(sr, sc * 2);
    *(LAS u32x4*)(lds + OFF_K + buf * BUF_B + kws) = S.k0; *(LAS u32x4*)(lds + OFF_K + buf * BUF_B + kws + 32 * 256) = S.k1;
    *(LAS u32x4*)(lds + OFF_V + buf * BUF_B + v_st(sr, sc)) = S.v0; *(LAS u32x4*)(lds + OFF_V + buf * BUF_B + v_st(32 + sr, sc)) = S.v1;
}
template <bool EXTRA = false>
__device__ __forceinline__ void qkt(f32x16& p0, f32x16& p1, const LAS unsigned char* ktile, int r32, int hi, const bf16x8 (&qr)[8], bf16x8 kx0 = bf16x8{}, bf16x8 kx1 = bf16x8{}, bf16x8 qx = bf16x8{}) {
#pragma unroll
    for (int r = 0; r < 16; ++r) { p0[r] = 0.f; p1[r] = 0.f; }
    const LAS unsigned char* kb[4];
#pragma unroll
    for (int dd = 0; dd < 4; ++dd) kb[dd] = ktile + AT_KSWZ(r32, (dd * 16 + hi * 8) * 2);
#pragma unroll
    for (int d0 = 0; d0 < 8; ++d0) { const LAS unsigned char* a = kb[d0 & 3] + (d0 >> 2) * 128;
        const bf16x8 b0 = *(const LAS bf16x8*)a; const bf16x8 b1 = *(const LAS bf16x8*)(a + 32 * 256);
        p0 = __builtin_amdgcn_mfma_f32_32x32x16_bf16(b0, qr[d0], p0, 0, 0, 0);
        p1 = __builtin_amdgcn_mfma_f32_32x32x16_bf16(b1, qr[d0], p1, 0, 0, 0); }
    if constexpr (EXTRA) {
        p0 = __builtin_amdgcn_mfma_f32_32x32x16_bf16(kx0, qx, p0, 0, 0, 0);
        p1 = __builtin_amdgcn_mfma_f32_32x32x16_bf16(kx1, qx, p1, 0, 0, 0); }
}
__device__ __forceinline__ void pv_tile(f32x16 (&o)[4], int vb, bf16x8 pa0, bf16x8 pa1, bf16x8 pa2, bf16x8 pa3) {
#define AT_TRRD(dst, off) asm volatile("ds_read_b64_tr_b16 %0, %1 offset:%2" : "=&v"(dst) : "v"(vb), "i"(off) : "memory")
#define AT_PV_D0(d0) do { s16x4 l0, l1, l2, l3, h0, h1, h2, h3; constexpr int b_ = (d0) * 512; \
        AT_TRRD(l0, b_); AT_TRRD(h0, b_ + 2048); AT_TRRD(l1, b_ + 4096); AT_TRRD(h1, b_ + 6144); AT_TRRD(l2, b_ + 8192); AT_TRRD(h2, b_ + 10240); AT_TRRD(l3, b_ + 12288); AT_TRRD(h3, b_ + 14336); \
        asm volatile("s_waitcnt lgkmcnt(0)" ::: "memory"); __builtin_amdgcn_sched_barrier(0); \
        o[d0] = __builtin_amdgcn_mfma_f32_32x32x16_bf16(pa0, (bf16x8){l0[0], l0[1], l0[2], l0[3], h0[0], h0[1], h0[2], h0[3]}, o[d0], 0, 0, 0); \
        o[d0] = __builtin_amdgcn_mfma_f32_32x32x16_bf16(pa1, (bf16x8){l1[0], l1[1], l1[2], l1[3], h1[0], h1[1], h1[2], h1[3]}, o[d0], 0, 0, 0); \
        o[d0] = __builtin_amdgcn_mfma_f32_32x32x16_bf16(pa2, (bf16x8){l2[0], l2[1], l2[2], l2[3], h2[0], h2[1], h2[2], h2[3]}, o[d0], 0, 0, 0); \
        o[d0] = __builtin_amdgcn_mfma_f32_32x32x16_bf16(pa3, (bf16x8){l3[0], l3[1], l3[2], l3[3], h3[0], h3[1], h3[2], h3[3]}, o[d0], 0, 0, 0); } while (0)
    AT_PV_D0(0); AT_PV_D0(1); AT_PV_D0(2); AT_PV_D0(3);
#undef AT_PV_D0
#undef AT_TRRD
}
__device__ __forceinline__ float swap_max(float v) { auto rr = __builtin_amdgcn_permlane32_swap(__float_as_uint(v), __float_as_uint(v), false, false); return fmaxf(__uint_as_float(rr[0]), __uint_as_float(rr[1])); }
__device__ __forceinline__ float swap_sum(float v) { auto rr = __builtin_amdgcn_permlane32_swap(__float_as_uint(v), __float_as_uint(v), false, false); return __uint_as_float(rr[0]) + __uint_as_float(rr[1]); }
__device__ __forceinline__ void pack_p(const f32x16& P, bf16x8& outA, bf16x8& outB) {
#define AT_PK4(B_, OUT) do { unsigned a0 = cvt_pk_bf16(P[B_ + 0], P[B_ + 1]), a1 = cvt_pk_bf16(P[B_ + 2], P[B_ + 3]); \
        unsigned b0 = cvt_pk_bf16(P[B_ + 4], P[B_ + 5]), b1 = cvt_pk_bf16(P[B_ + 6], P[B_ + 7]); \
        auto r0 = __builtin_amdgcn_permlane32_swap(a0, b0, false, false); auto r1 = __builtin_amdgcn_permlane32_swap(a1, b1, false, false); \
        u32x4 w = {r0[0], r1[0], r0[1], r1[1]}; OUT = *reinterpret_cast<bf16x8*>(&w); } while (0)
    AT_PK4(0, outA); AT_PK4(8, outB);
#undef AT_PK4
}
__device__ __forceinline__ float online_sm1(const f32x16& p0, const f32x16& p1, float& m_reg, float& mnL) {
    float pmax = p0[0];
#pragma unroll
    for (int r = 1; r < 16; ++r) pmax = fmaxf(pmax, p0[r]);
#pragma unroll
    for (int r = 0; r < 16; ++r) pmax = fmaxf(pmax, p1[r]);
    pmax = swap_max(pmax);
    float mn, alpha;
    if (__all(pmax - m_reg <= THR)) { mn = m_reg; alpha = 1.f; }
    else { mn = fmaxf(m_reg, pmax); alpha = __builtin_amdgcn_exp2f((m_reg - mn) * LOG2E); m_reg = mn; }
    mnL = -mn * LOG2E;
    return alpha;
}
__device__ __forceinline__ float online_sm1_raw(const f32x16& p0, const f32x16& p1, float& m_reg, float& mnL, float base2) {
    float pmax = p0[0];
#pragma unroll
    for (int r = 1; r < 16; ++r) pmax = fmaxf(pmax, p0[r]);
#pragma unroll
    for (int r = 0; r < 16; ++r) pmax = fmaxf(pmax, p1[r]);
    pmax = fmaf(swap_max(pmax), SCALE, base2);
    float mn, alpha;
    if (__all(pmax - m_reg <= THR)) { mn = m_reg; alpha = 1.f; }
    else { mn = fmaxf(m_reg, pmax); alpha = __builtin_amdgcn_exp2f((m_reg - mn) * LOG2E); m_reg = mn; }
    mnL = (base2 - mn) * LOG2E;
    return alpha;
}
__device__ __forceinline__ void online_sm2_raw(f32x16& p0, f32x16& p1, float mnL, float alpha, float& l_reg) {
    constexpr float C2 = SCALE * LOG2E;
    float ps = 0.f;
#pragma unroll
    for (int r = 0; r < 16; ++r) { p0[r] = __builtin_amdgcn_exp2f(fmaf(p0[r], C2, mnL)); p1[r] = __builtin_amdgcn_exp2f(fmaf(p1[r], C2, mnL)); ps += p0[r] + p1[r]; }
    ps = swap_sum(ps);
    l_reg = l_reg * alpha + ps;
}
__device__ __forceinline__ void online_sm2(f32x16& p0, f32x16& p1, float mnL, float alpha, float& l_reg) {
    float ps = 0.f;
#pragma unroll
    for (int r = 0; r < 16; ++r) { p0[r] = __builtin_amdgcn_exp2f(fmaf(p0[r], LOG2E, mnL)); p1[r] = __builtin_amdgcn_exp2f(fmaf(p1[r], LOG2E, mnL)); ps += p0[r] + p1[r]; }
    ps = swap_sum(ps);
    l_reg = l_reg * alpha + ps;
}
template <int MODE>
__device__ __forceinline__ void branch_loop(f32x16 (&o)[4], float& l_out, LAS unsigned char* lds, const bf16_t* Kp, const bf16_t* Vp, int jlo, int qt,
                                            const bf16x8 (&qr)[8], int tq, float slope, unsigned selbits, int r32, int hi, int sr, int sc, LAS float* wsc, int wave_tmin, int grpB) {
    float m_reg = -1e30f, l_reg = 0.f;
#pragma unroll
    for (int d = 0; d < 4; ++d)
#pragma unroll
        for (int r = 0; r < 16; ++r) o[d][r] = 0.f;
    const int vb0 = (int)(uintptr_t)(lds + OFF_V) + v_rd_base(r32 + 32 * hi);
    const int NT = qt - jlo + 1;
    unsigned xk0w, xk1w, xqw;
    { const float sv = slope * (1.f / SCALE); const bf16_t shi = f2bf(sv), slo = f2bf(sv - bf2f(shi));
      xk0w = hi ? 0u : (unsigned)f2bf((float)r32) * 0x10001u; xk1w = hi ? 0u : (unsigned)f2bf((float)(32 + r32)) * 0x10001u; xqw = hi ? 0u : ((unsigned)shi | ((unsigned)slo << 16)); }
#define AT_LGKM0() asm volatile("s_waitcnt lgkmcnt(0)" ::: "memory")
#define AT_BAR() do { AT_LGKM0(); __builtin_amdgcn_s_barrier(); asm volatile("" ::: "memory"); } while (0)
    Stage S0; stage_load(S0, Kp, Vp, PROJ_LD, jlo * 64, sr, sc); stage_write(S0, lds, 0, sr, sc);
    if (NT > 1) { stage_load(S0, Kp, Vp, PROJ_LD, (jlo + 1) * 64, sr, sc); stage_write(S0, lds, 1, sr, sc); }
    if (NT > 2) stage_load(S0, Kp, Vp, PROJ_LD, (jlo + 2) * 64, sr, sc);
    __syncthreads();
    if (grpB) AT_BAR();
    int buf = 0;
#define AT_STEP(tau, SX) do { \
        const int j = jlo + (tau); \
        f32x16 p0, p1; \
        bf16x8 kx0, kx1, qx; { unsigned t0_ = xk0w, t1_ = xk1w, t2_ = xqw; asm volatile("" : "+v"(t0_), "+v"(t1_), "+v"(t2_)); \
            u32x4 a0_ = {t0_, 0u, 0u, 0u}, a1_ = {t1_, 0u, 0u, 0u}, b0_ = {t2_, 0u, 0u, 0u}; kx0 = *reinterpret_cast<bf16x8*>(&a0_); kx1 = *reinterpret_cast<bf16x8*>(&a1_); qx = *reinterpret_cast<bf16x8*>(&b0_); } \
        qkt<true>(p0, p1, lds + OFF_K + buf * BUF_B, r32, hi, qr, kx0, kx1, qx); \
        const int kbase = j * 64; const int dq = tq - kbase - 4 * hi; \
        const float base2 = slope * (float)(kbase - tq); \
        if (MODE == 1) { \
            const bool on = (selbits >> j) & 1u; \
            if (j == qt) { \
                _Pragma("unroll") for (int r = 0; r < 16; ++r) { const int cc = (r & 3) + 8 * (r >> 2); if (!on || cc > dq) p0[r] = -INFINITY; if (!on || cc + 32 > dq) p1[r] = -INFINITY; } \
            } else if (!__all(on)) { \
                _Pragma("unroll") for (int r = 0; r < 16; ++r) { if (!on) { p0[r] = -INFINITY; p1[r] = -INFINITY; } } \
            } \
        } else { \
            if (kbase + 63 > wave_tmin || kbase < wave_tmin + 31 - (WINDOW - 1)) { \
                _Pragma("unroll") for (int r = 0; r < 16; ++r) { const int cc = (r & 3) + 8 * (r >> 2); \
                    if ((unsigned)(dq - cc) >= (unsigned)WINDOW) p0[r] = -INFINITY; if ((unsigned)(dq - cc - 32) >= (unsigned)WINDOW) p1[r] = -INFINITY; } \
            } \
        } \
        float mnL; const float alpha = online_sm1_raw(p0, p1, m_reg, mnL, base2); \
        AT_BAR(); \
        if ((tau) + 2 < NT) { int b2 = buf + 2; if (b2 >= 3) b2 -= 3; stage_write(SX, lds, b2, sr, sc); } \
        if ((tau) + 3 < NT) stage_load(SX, Kp, Vp, PROJ_LD, (j + 3) * 64, sr, sc); \
        online_sm2_raw(p0, p1, mnL, alpha, l_reg); \
        bf16x8 pa0, pa1, pa2, pa3; pack_p(p0, pa0, pa1); pack_p(p1, pa2, pa3); \
        if (__any(alpha < 1.f)) { if (hi == 0) wsc[r32] = alpha; \
            _Pragma("unroll") for (int r = 0; r < 16; ++r) { const float al = wsc[crow(r, hi)]; \
                _Pragma("unroll") for (int d = 0; d < 4; ++d) o[d][r] *= al; } } \
        pv_tile(o, vb0 + buf * BUF_B, pa0, pa1, pa2, pa3); \
        AT_BAR(); \
        buf = buf + 1; if (buf >= 3) buf = 0; } while (0)
    for (int tau = 0; tau < NT; ++tau) { AT_STEP(tau, S0); }
#undef AT_STEP
    if (!grpB) AT_BAR();
#undef AT_BAR
#undef AT_LGKM0
    l_out = l_reg;
    __syncthreads();
}
}

__device__ __forceinline__ void attn_fast_unit(const Frame& F, const Args& a, int unit) {
    using namespace at;
    unsigned char* ws = F.ws; const bf16_t* PROJ = (const bf16_t*)(ws + WS_PROJ); bf16_t* YM = (bf16_t*)(ws + WS_YMIX);
    LAS unsigned char* lds = F.lds;
    const int qt = 31 - (unit >> 4), bg = unit & 15, b = bg >> 1, g = bg & 1;
    int tz = threadIdx.x; asm volatile("" : "+v"(tz));
    const int lane = tz & 63, r32 = lane & 31, hi = lane >> 5, head = F.wid & 3, qh = F.wid >> 2;
    const int t0 = qt * 64, tq = t0 + qh * 32 + r32, wave_tmin = t0 + qh * 32;
    const int sr = tz >> 4, sc = (tz & 15) * 8;
    const float slope = exp2f(-(float)(g * 4 + head + 1));
    LAS float* wsc = (LAS float*)(lds + OFF_WSC) + F.wid * 256;
    LAS float* imph = (LAS float*)(lds + OFF_IMP);
    LAS unsigned* selm = (LAS unsigned*)(lds + OFF_SELM);
    bf16x8 qr[8];
    { const bf16_t* qp = PROJ + (size_t)(b * SEQ + tq) * PROJ_LD + C_NQ + (g * 4 + head) * 128 + hi * 8;
#pragma unroll
      for (int d0 = 0; d0 < 8; ++d0) qr[d0] = *(const bf16x8*)(qp + d0 * 16); }
    float gate[3];
    { const bf16_t* gp = PROJ + (size_t)(b * SEQ + tq) * PROJ_LD + C_NGT + (g * 4 + head) * 3;
#pragma unroll
      for (int c = 0; c < 3; ++c) gate[c] = sigmoidf_(bf2f(gp[c])); }
    f32x16 o[4];
    float* otp = (float*)(ws + WS_OT) + ((size_t)F.bid * 512 + tz) * 64;
    { const bf16_t* Kc = (const bf16_t*)(ws + WS_KC) + (size_t)bg * 128 * 128; const bf16_t* Vc = (const bf16_t*)(ws + WS_VC) + (size_t)bg * 128 * 128;
      Stage S; stage_load(S, Kc, Vc, 128, 0, sr, sc); stage_write(S, lds, 0, sr, sc);
      stage_load(S, Kc, Vc, 128, 64, sr, sc); stage_write(S, lds, 1, sr, sc);
      __syncthreads();
      f32x16 p0, p1, p2, p3;
      qkt(p0, p1, lds + OFF_K, r32, hi, qr); qkt(p2, p3, lds + OFF_K + BUF_B, r32, hi, qr);
      const int dl0 = ((tq - 31) >> 4) - 4 * hi;
      const float base_f = slope * (float)(16 * 4 * hi + 31 - tq);
      float mx = -INFINITY;
#pragma unroll
      for (int r = 0; r < 16; ++r) { const int cc = (r & 3) + 8 * (r >> 2);
          p0[r] = (cc <= dl0)      ? fmaf(p0[r], SCALE, fmaf(slope, (float)(16 * cc), base_f))        : -INFINITY;
          p1[r] = (cc + 32 <= dl0) ? fmaf(p1[r], SCALE, fmaf(slope, (float)(16 * (cc + 32)), base_f)) : -INFINITY;
          p2[r] = (cc + 64 <= dl0) ? fmaf(p2[r], SCALE, fmaf(slope, (float)(16 * (cc + 64)), base_f)) : -INFINITY;
          p3[r] = (cc + 96 <= dl0) ? fmaf(p3[r], SCALE, fmaf(slope, (float)(16 * (cc + 96)), base_f)) : -INFINITY;
          mx = fmaxf(fmaxf(mx, p0[r]), fmaxf(p1[r], fmaxf(p2[r], p3[r]))); }
      mx = swap_max(mx);
      const float mL = (mx == -INFINITY) ? 0.f : -mx * LOG2E;
      float ps = 0.f;
#pragma unroll
      for (int r = 0; r < 16; ++r) { p0[r] = __builtin_amdgcn_exp2f(fmaf(p0[r], LOG2E, mL)); p1[r] = __builtin_amdgcn_exp2f(fmaf(p1[r], LOG2E, mL));
          p2[r] = __builtin_amdgcn_exp2f(fmaf(p2[r], LOG2E, mL)); p3[r] = __builtin_amdgcn_exp2f(fmaf(p3[r], LOG2E, mL)); ps += (p0[r] + p1[r]) + (p2[r] + p3[r]); }
      ps = swap_sum(ps);
      const float inv = ps > 0.f ? 1.f / ps : 0.f;
#pragma unroll
      for (int r = 0; r < 16; ++r) { p0[r] *= inv; p1[r] *= inv; p2[r] *= inv; p3[r] *= inv; }
      { LAS float* dst = imph + ((size_t)head * 64 + qh * 32 + r32) * 32;
        float prev = 0.f;
#define AT_GRP(P, blk) do { _Pragma("unroll") for (int i = 0; i < 4; ++i) { const float av = 2.f * (P[4 * i] + P[4 * i + 1] + P[4 * i + 2]) + P[4 * i + 3]; const float bv = P[4 * i + 3]; \
            auto rr = __builtin_amdgcn_permlane32_swap(__float_as_uint(bv), __float_as_uint(bv), false, false); const float pb = __uint_as_float(hi ? rr[0] : rr[1]); \
            dst[2 * ((blk) * 4 + i) + hi] = av + (hi ? pb : prev); prev = pb; } } while (0)
        AT_GRP(p0, 0); AT_GRP(p1, 1); AT_GRP(p2, 2); AT_GRP(p3, 3);
#undef AT_GRP
      }
      bf16x8 pa0, pa1, pa2, pa3;
#pragma unroll
      for (int d = 0; d < 4; ++d)
#pragma unroll
          for (int r = 0; r < 16; ++r) o[d][r] = 0.f;
      const int vb0 = (int)(uintptr_t)(lds + OFF_V) + v_rd_base(lane);
      pack_p(p0, pa0, pa1); pack_p(p1, pa2, pa3); pv_tile(o, vb0, pa0, pa1, pa2, pa3);
      pack_p(p2, pa0, pa1); pack_p(p3, pa2, pa3); pv_tile(o, vb0 + BUF_B, pa0, pa1, pa2, pa3);
      if (hi == 0) wsc[r32] = gate[0];
#pragma unroll
      for (int r = 0; r < 16; ++r) { const float f = wsc[crow(r, hi)];
#pragma unroll
          for (int d = 0; d < 4; ++d) o[d][r] *= f; }
#pragma unroll
      for (int d = 0; d < 4; ++d)
#pragma unroll
          for (int k = 0; k < 4; ++k) *(f32x4*)(otp + d * 16 + 4 * k) = (f32x4){o[d][4 * k], o[d][4 * k + 1], o[d][4 * k + 2], o[d][4 * k + 3]};
    }
    __syncthreads();
    { const int q = tz >> 3, part = tz & 7, tqq = t0 + q, cur = tqq >> 6;
      unsigned bits = 0u;
      if (cur < SEL_TOP) { bits = (part == 0) ? ((2u << cur) - 1u) : 0u; }
      else {
          float sc_[4];
#pragma unroll
          for (int k = 0; k < 4; ++k) { const int j = part * 4 + k; const float v = ((imph[(0 * 64 + q) * 32 + j] + imph[(1 * 64 + q) * 32 + j]) + imph[(2 * 64 + q) * 32 + j]) + imph[(3 * 64 + q) * 32 + j];
              const bool forced = (j == 0) || (j == cur) || (j == cur - 1); sc_[k] = forced ? 1e4f : (j <= cur ? v : -1e4f); }
          int rank[4] = {0, 0, 0, 0};
          for (int jj = 0; jj < 32; ++jj) { const float v = ((imph[(0 * 64 + q) * 32 + jj] + imph[(1 * 64 + q) * 32 + jj]) + imph[(2 * 64 + q) * 32 + jj]) + imph[(3 * 64 + q) * 32 + jj];
              const bool forced = (jj == 0) || (jj == cur) || (jj == cur - 1); const float s2 = forced ? 1e4f : (jj <= cur ? v : -1e4f);
#pragma unroll
              for (int k = 0; k < 4; ++k) { const int j = part * 4 + k; rank[k] += (s2 > sc_[k] || (s2 == sc_[k] && jj < j)) ? 1 : 0; } }
#pragma unroll
          for (int k = 0; k < 4; ++k) { const int j = part * 4 + k; if (rank[k] < SEL_TOP && j <= cur) bits |= 1u << j; }
      }
      bits |= __shfl_xor(bits, 1); bits |= __shfl_xor(bits, 2); bits |= __shfl_xor(bits, 4);
      if (part == 0) selm[q] = bits; }
    __syncthreads();
    const unsigned selbits = selm[qh * 32 + r32];
    { float l_sel;
      branch_loop<1>(o, l_sel, lds, PROJ + (size_t)(b * SEQ) * PROJ_LD + C_KSL + g * 128, PROJ + (size_t)(b * SEQ) * PROJ_LD + C_VSL + g * 128, 0, qt, qr, tq, slope, selbits, r32, hi, sr, sc, wsc, wave_tmin, qh);
      if (hi == 0) wsc[r32] = gate[1] / l_sel;
#pragma unroll
      for (int r = 0; r < 16; ++r) { const float f = wsc[crow(r, hi)];
#pragma unroll
          for (int d = 0; d < 4; ++d) o[d][r] *= f; }
#pragma unroll
      for (int d = 0; d < 4; ++d)
#pragma unroll
          for (int k = 0; k < 4; ++k) { const f32x4 pv = *(const f32x4*)(otp + d * 16 + 4 * k); *(f32x4*)(otp + d * 16 + 4 * k) = pv + (f32x4){o[d][4 * k], o[d][4 * k + 1], o[d][4 * k + 2], o[d][4 * k + 3]}; } }
    { float l_win; const int jlo = (t0 - (WINDOW - 1)) > 0 ? (t0 - (WINDOW - 1)) >> 6 : 0;
      branch_loop<2>(o, l_win, lds, PROJ + (size_t)(b * SEQ) * PROJ_LD + C_KWN + g * 128, PROJ + (size_t)(b * SEQ) * PROJ_LD + C_VWN + g * 128, jlo, qt, qr, tq, slope, 0u, r32, hi, sr, sc, wsc, wave_tmin, qh);
      if (hi == 0) wsc[r32] = gate[2] / l_win;
#pragma unroll
      for (int r = 0; r < 16; ++r) { const float f = wsc[crow(r, hi)];
#pragma unroll
          for (int d = 0; d < 4; ++d) o[d][r] *= f; }
#pragma unroll
      for (int d = 0; d < 4; ++d)
#pragma unroll
          for (int k = 0; k < 4; ++k) { const f32x4 pv = *(const f32x4*)(otp + d * 16 + 4 * k); o[d][4 * k] += pv[0]; o[d][4 * k + 1] += pv[1]; o[d][4 * k + 2] += pv[2]; o[d][4 * k + 3] += pv[3]; } }
    { const float* ng = a.in[I_NSAG];
      float gsc[4];
#pragma unroll
      for (int d = 0; d < 4; ++d) gsc[d] = ng[d * 32 + r32];
#pragma unroll
      for (int r = 0; r < 16; ++r) { float ss = 0.f;
#pragma unroll
          for (int d = 0; d < 4; ++d) ss += o[d][r] * o[d][r];
          ss += __shfl_xor(ss, 1); ss += __shfl_xor(ss, 2); ss += __shfl_xor(ss, 4); ss += __shfl_xor(ss, 8); ss += __shfl_xor(ss, 16);
          const float rs = rsqrtf(ss * (1.f / 128.f) + EPS);
          const int row = b * SEQ + t0 + qh * 32 + crow(r, hi);
          bf16_t* yp = YM + (size_t)row * DM + HG_W + (g * 4 + head) * 128 + r32;
#pragma unroll
          for (int d = 0; d < 4; ++d) yp[d * 32] = f2bf(o[d][r] * rs * gsc[d]); } }
    __syncthreads();
}

namespace hg {
constexpr int T_KD = 0, T_QD = 16384, T_V = 32768, T_KL = 49152, T_FR = 65536, T_QR = 81920, T_OR = 98304, T_PART = 114688, T_DL = T_PART + 2048, T_SSQ = T_DL + 512;
}
__device__ __forceinline__ void hgrn_fast_unit(const Frame& F, const Args& a, int unit) {
    using namespace hg; using at::crow; using at::v_st; using at::v_rd_base; typedef at::s16x4 s16x4;
    unsigned char* ws = F.ws; const bf16_t* PROJ = (const bf16_t*)(ws + WS_PROJ); bf16_t* YM = (bf16_t*)(ws + WS_YMIX);
    LAS unsigned char* lds = F.lds;
    const int b = unit >> 3, h = unit & 7;
    int tz = threadIdx.x; asm volatile("" : "+v"(tz));
    const int lane = tz & 63, r32 = lane & 31, hi = lane >> 5, th = F.wid & 1, vq = F.wid >> 1;
    const int lr = tz >> 4, lc = (tz & 15) * 8;
    const int kc = tz & 127, tg = tz >> 7;
    LAS float* part = (LAS float*)(lds + T_PART); LAS float* dl = (LAS float*)(lds + T_DL); LAS float* ssq = (LAS float*)(lds + T_SSQ);
    f32x16 Sacc[4];
#pragma unroll
    for (int k = 0; k < 4; ++k)
#pragma unroll
        for (int r = 0; r < 16; ++r) Sacc[k][r] = 0.f;
    const bf16_t* base = PROJ + (size_t)(b * SEQ) * PROJ_LD + h * 128;
    u32x4 rf0, rf1, rq0, rq1, ri0, ri1, ro0, ro1;
    const bf16_t* obase = (const bf16_t*)(ws + WS_OMF) + (size_t)(b * SEQ) * HG_W + h * 128;
#define HG_LOAD(t0_) do { const bf16_t* p0_ = base + (size_t)((t0_) + lr) * PROJ_LD + lc; const bf16_t* p1_ = p0_ + (size_t)32 * PROJ_LD; \
        rf0 = *(const u32x4*)(p0_ + C_HF); rf1 = *(const u32x4*)(p1_ + C_HF); rq0 = *(const u32x4*)(p0_ + C_HQ); rq1 = *(const u32x4*)(p1_ + C_HQ); \
        ri0 = *(const u32x4*)(p0_ + C_HI); ri1 = *(const u32x4*)(p1_ + C_HI); \
        ro0 = *(const u32x4*)(obase + (size_t)((t0_) + lr) * HG_W + lc); ro1 = *(const u32x4*)(obase + (size_t)((t0_) + lr + 32) * HG_W + lc); } while (0)
    HG_LOAD(0);
    const float ngv = a.in[I_HGNG][vq * 32 + r32];
    for (int c = 0; c < SEQ / 64; ++c) {
        const int t0 = c * 64;
        *(LAS u32x4*)(lds + T_FR + lr * 256 + lc * 2) = rf0; *(LAS u32x4*)(lds + T_FR + (lr + 32) * 256 + lc * 2) = rf1;
        *(LAS u32x4*)(lds + T_QR + lr * 256 + lc * 2) = rq0; *(LAS u32x4*)(lds + T_QR + (lr + 32) * 256 + lc * 2) = rq1;
        *(LAS u32x4*)(lds + T_OR + lr * 256 + lc * 2) = ro0; *(LAS u32x4*)(lds + T_OR + (lr + 32) * 256 + lc * 2) = ro1;
        *(LAS u32x4*)(lds + T_V + v_st(lr, lc)) = ri0; *(LAS u32x4*)(lds + T_V + v_st(lr + 32, lc)) = ri1;
        __syncthreads();
        float lf[16]; float run = 0.f;
#pragma unroll
        for (int i = 0; i < 16; ++i) { const int t = tg * 16 + i; run += bf2f(*(const LAS bf16_t*)(lds + T_FR + t * 256 + kc * 2)); lf[i] = run; }
        part[tg * 128 + kc] = run;
        __syncthreads();
        { const float p0_ = part[kc], p1_ = part[128 + kc], p2_ = part[256 + kc], p3_ = part[384 + kc];
          const float pre = (tg > 0 ? p0_ : 0.f) + (tg > 1 ? p1_ : 0.f) + (tg > 2 ? p2_ : 0.f); const float tot = ((p0_ + p1_) + p2_) + p3_;
          const float dlast = __builtin_amdgcn_exp2f(tot);
          if (tg == 0) dl[kc] = dlast;
#pragma unroll
          for (int i = 0; i < 16; ++i) { const int t = tg * 16 + i; const float bb = pre + lf[i];
              const float qv = bf2f(*(const LAS bf16_t*)(lds + T_QR + t * 256 + kc * 2)), om = bf2f(*(const LAS bf16_t*)(lds + T_OR + t * 256 + kc * 2));
              const float qd = qv * __builtin_amdgcn_exp2f(bb), kd = om * __builtin_amdgcn_exp2f(-bb), kl = kd * dlast;
              const int ko = AT_KSWZ(t, kc * 2);
              *(LAS bf16_t*)(lds + T_QD + ko) = f2bf(qd); *(LAS bf16_t*)(lds + T_KD + ko) = f2bf(kd); *(LAS bf16_t*)(lds + T_KL + v_st(t, kc)) = f2bf(kl); } }
        __syncthreads();
        if (c + 1 < SEQ / 64) HG_LOAD(t0 + 64);
        const int tl = th * 32 + r32;
        bf16x8 qr[8];
#pragma unroll
        for (int d0 = 0; d0 < 8; ++d0) qr[d0] = *(const LAS bf16x8*)(lds + T_QD + AT_KSWZ(tl, (d0 * 16 + hi * 8) * 2));
        f32x16 p0, p1;
        at::qkt(p0, p1, lds + T_KD, r32, hi, qr);
#pragma unroll
        for (int r = 0; r < 16; ++r) { const int s = crow(r, hi); if (s > tl) p0[r] = 0.f; if (s + 32 > tl) p1[r] = 0.f; }
        bf16x8 pa0, pa1, pa2, pa3; at::pack_p(p0, pa0, pa1); at::pack_p(p1, pa2, pa3);
        f32x16 o;
#pragma unroll
        for (int r = 0; r < 16; ++r) o[r] = 0.f;
        const int vb = (int)(uintptr_t)(lds + T_V) + v_rd_base(lane) + vq * 512;
        const int klb = (int)(uintptr_t)(lds + T_KL) + v_rd_base(lane);
#define HG_TRRD(dst, addr, off) asm volatile("ds_read_b64_tr_b16 %0, %1 offset:%2" : "=&v"(dst) : "v"(addr), "i"(off) : "memory")
        s16x4 vl0, vh0, vl1, vh1, vl2, vh2, vl3, vh3;
        HG_TRRD(vl0, vb, 0); HG_TRRD(vh0, vb, 2048); HG_TRRD(vl1, vb, 4096); HG_TRRD(vh1, vb, 6144); HG_TRRD(vl2, vb, 8192); HG_TRRD(vh2, vb, 10240); HG_TRRD(vl3, vb, 12288); HG_TRRD(vh3, vb, 14336);
        asm volatile("s_waitcnt lgkmcnt(0)" ::: "memory"); __builtin_amdgcn_sched_barrier(0);
        const bf16x8 vf0 = (bf16x8){vl0[0], vl0[1], vl0[2], vl0[3], vh0[0], vh0[1], vh0[2], vh0[3]}, vf1 = (bf16x8){vl1[0], vl1[1], vl1[2], vl1[3], vh1[0], vh1[1], vh1[2], vh1[3]};
        const bf16x8 vf2 = (bf16x8){vl2[0], vl2[1], vl2[2], vl2[3], vh2[0], vh2[1], vh2[2], vh2[3]}, vf3 = (bf16x8){vl3[0], vl3[1], vl3[2], vl3[3], vh3[0], vh3[1], vh3[2], vh3[3]};
        o = __builtin_amdgcn_mfma_f32_32x32x16_bf16(pa0, vf0, o, 0, 0, 0); o = __builtin_amdgcn_mfma_f32_32x32x16_bf16(pa1, vf1, o, 0, 0, 0);
        o = __builtin_amdgcn_mfma_f32_32x32x16_bf16(pa2, vf2, o, 0, 0, 0); o = __builtin_amdgcn_mfma_f32_32x32x16_bf16(pa3, vf3, o, 0, 0, 0);
#pragma unroll
        for (int kb = 0; kb < 4; ++kb)
#pragma unroll
            for (int sp = 0; sp < 2; ++sp) {
                const u32x2 a_lo = *(const LAS u32x2*)(lds + T_QD + tl * 256 + ((((4 * kb + 2 * sp) * 16)) ^ ((tl & 7) << 4)) + 8 * hi);
                const u32x2 a_hi = *(const LAS u32x2*)(lds + T_QD + tl * 256 + ((((4 * kb + 2 * sp + 1) * 16)) ^ ((tl & 7) << 4)) + 8 * hi);
                u32x4 aw = {a_lo[0], a_lo[1], a_hi[0], a_hi[1]};
                u32x4 bw = {cvt_pk_bf16(Sacc[kb][8 * sp + 0], Sacc[kb][8 * sp + 1]), cvt_pk_bf16(Sacc[kb][8 * sp + 2], Sacc[kb][8 * sp + 3]),
                            cvt_pk_bf16(Sacc[kb][8 * sp + 4], Sacc[kb][8 * sp + 5]), cvt_pk_bf16(Sacc[kb][8 * sp + 6], Sacc[kb][8 * sp + 7])};
                o = __builtin_amdgcn_mfma_f32_32x32x16_bf16(*reinterpret_cast<bf16x8*>(&aw), *reinterpret_cast<bf16x8*>(&bw), o, 0, 0, 0); }
        float gt[16];
#pragma unroll
        for (int r = 0; r < 16; ++r) gt[r] = bf2f(base[(size_t)(t0 + th * 32 + crow(r, hi)) * PROJ_LD + C_HGT + vq * 32 + r32]);
#define HG_SUPD(kb) do { \
            _Pragma("unroll") for (int i4 = 0; i4 < 4; ++i4) { const f32x4 dv = *(const LAS f32x4*)(dl + (kb) * 32 + 8 * i4 + 4 * hi); \
                Sacc[kb][4 * i4] *= dv[0]; Sacc[kb][4 * i4 + 1] *= dv[1]; Sacc[kb][4 * i4 + 2] *= dv[2]; Sacc[kb][4 * i4 + 3] *= dv[3]; } \
            s16x4 al0, ah0, al1, ah1, al2, ah2, al3, ah3; \
            HG_TRRD(al0, klb, (kb) * 512); HG_TRRD(ah0, klb, (kb) * 512 + 2048); HG_TRRD(al1, klb, (kb) * 512 + 4096); HG_TRRD(ah1, klb, (kb) * 512 + 6144); \
            HG_TRRD(al2, klb, (kb) * 512 + 8192); HG_TRRD(ah2, klb, (kb) * 512 + 10240); HG_TRRD(al3, klb, (kb) * 512 + 12288); HG_TRRD(ah3, klb, (kb) * 512 + 14336); \
            asm volatile("s_waitcnt lgkmcnt(0)" ::: "memory"); __builtin_amdgcn_sched_barrier(0); \
            Sacc[kb] = __builtin_amdgcn_mfma_f32_32x32x16_bf16((bf16x8){al0[0], al0[1], al0[2], al0[3], ah0[0], ah0[1], ah0[2], ah0[3]}, vf0, Sacc[kb], 0, 0, 0); \
            Sacc[kb] = __builtin_amdgcn_mfma_f32_32x32x16_bf16((bf16x8){al1[0], al1[1], al1[2], al1[3], ah1[0], ah1[1], ah1[2], ah1[3]}, vf1, Sacc[kb], 0, 0, 0); \
            Sacc[kb] = __builtin_amdgcn_mfma_f32_32x32x16_bf16((bf16x8){al2[0], al2[1], al2[2], al2[3], ah2[0], ah2[1], ah2[2], ah2[3]}, vf2, Sacc[kb], 0, 0, 0); \
            Sacc[kb] = __builtin_amdgcn_mfma_f32_32x32x16_bf16((bf16x8){al3[0], al3[1], al3[2], al3[3], ah3[0], ah3[1], ah3[2], ah3[3]}, vf3, Sacc[kb], 0, 0, 0); } while (0)
        HG_SUPD(0); HG_SUPD(1); HG_SUPD(2); HG_SUPD(3);
#undef HG_SUPD
#undef HG_TRRD
        { float y8[8], y4[4], y2[2], y1;
          const bool b4 = (r32 & 16) != 0, b3 = (r32 & 8) != 0, b2 = (r32 & 4) != 0, b1 = (r32 & 2) != 0;
#pragma unroll
          for (int i = 0; i < 8; ++i) { const float lo = o[i] * o[i], hi_ = o[8 + i] * o[8 + i]; const float keep = b4 ? hi_ : lo, send = b4 ? lo : hi_; y8[i] = keep + __shfl_xor(send, 16); }
#pragma unroll
          for (int i = 0; i < 4; ++i) { const float keep = b3 ? y8[4 + i] : y8[i], send = b3 ? y8[i] : y8[4 + i]; y4[i] = keep + __shfl_xor(send, 8); }
#pragma unroll
          for (int i = 0; i < 2; ++i) { const float keep = b2 ? y4[2 + i] : y4[i], send = b2 ? y4[i] : y4[2 + i]; y2[i] = keep + __shfl_xor(send, 4); }
          { const float keep = b1 ? y2[1] : y2[0], send = b1 ? y2[0] : y2[1]; y1 = keep + __shfl_xor(send, 2); }
          y1 += __shfl_xor(y1, 1);
          const int rf = ((r32 >> 1) & 15);
          if ((r32 & 1) == 0) ssq[vq * 64 + th * 32 + crow(rf, hi)] = y1; }
        __syncthreads();
        { bf16_t* yb = YM + (size_t)(b * SEQ + t0 + th * 32) * DM + h * 128 + vq * 32;
          const unsigned loff = (unsigned)(4 * hi) * DM + (unsigned)r32;
#pragma unroll
          for (int r = 0; r < 16; ++r) { const int tc = (r & 3) + 8 * (r >> 2); const int t = th * 32 + tc + 4 * hi; const float ss = ((ssq[t] + ssq[64 + t]) + ssq[128 + t]) + ssq[192 + t];
              const float rs = rsqrtf(ss * (1.f / 128.f) + EPS);
              (yb + (size_t)tc * DM)[loff] = f2bf(o[r] * rs * ngv * gt[r]); } }
    }
#undef HG_LOAD
    __syncthreads();
}

__device__ __forceinline__ void compress_fast_unit(const Frame& F, const Args& a, int u) {
    unsigned char* ws = F.ws; const bf16_t* PROJ = (const bf16_t*)(ws + WS_PROJ); LAS unsigned char* lds = F.lds;
    const int j = u >> 6, bg = (u >> 2) & 15, mt = u & 3, b = bg >> 1, g = bg & 1;
    int tz = threadIdx.x; asm volatile("" : "+v"(tz));
    const int lane = tz & 63, r32 = lane & 31, hi = lane >> 5, w = F.wid;
    const int n = mt * 32 + r32, nl = n < 126 ? n : 126;
    const bf16_t* W2T = (const bf16_t*)(ws + WS_W2T) + (size_t)j * 128 * 128;
    const int colb = (j ? C_VCM : C_KCM) + g * 128;
    const bf16_t* arow = PROJ + (size_t)(b * SEQ + 16 * nl) * PROJ_LD + colb + hi * 8;
    const bf16_t* bfrag = (const bf16_t*)(ws + WS_W1T) + ((size_t)(j * 8 + w) * 32 * 4 * 64 + lane) * 8;
    f32x16 acc[4];
#pragma unroll
    for (int c = 0; c < 4; ++c)
#pragma unroll
        for (int r = 0; r < 16; ++r) acc[c][r] = 0.f;
#pragma unroll 4
    for (int ks = 0; ks < 32; ++ks) {
        const int l = 4 * w + (ks >> 3), d = (ks & 7) * 16;
        const bf16x8 af = *(const bf16x8*)(arow + (size_t)l * PROJ_LD + d);
#pragma unroll
        for (int c = 0; c < 4; ++c) { const bf16x8 bfr = *(const bf16x8*)(bfrag + (size_t)(ks * 4 + c) * 64 * 8);
            acc[c] = __builtin_amdgcn_mfma_f32_32x32x16_bf16(af, bfr, acc[c], 0, 0, 0); }
    }
    LAS float* red = (LAS float*)lds;
#pragma unroll
    for (int c = 0; c < 4; ++c)
#pragma unroll
        for (int r = 0; r < 16; ++r) red[(w * 32 + at::crow(r, hi)) * 128 + c * 32 + r32] = acc[c][r];
    __syncthreads();
    LAS unsigned char* hdn = lds + 131072 - 8192;
    { const int nn = tz >> 4, c8 = (tz & 15) * 8; float sv[8];
      const float* b1 = (const float*)(ws + WS_B1P) + (size_t)j * 32 * 128 + c8;
#pragma unroll
      for (int i = 0; i < 8; ++i) sv[i] = 0.f;
#pragma unroll 4
      for (int kg = 0; kg < 32; ++kg) { const f32x4 x0 = *(const f32x4*)(b1 + kg * 128), x1 = *(const f32x4*)(b1 + kg * 128 + 4);
#pragma unroll
          for (int i = 0; i < 4; ++i) { sv[i] += x0[i]; sv[4 + i] += x1[i]; } }
#pragma unroll
      for (int ww = 0; ww < 8; ++ww) { const f32x4 x0 = *(const LAS f32x4*)(red + (ww * 32 + nn) * 128 + c8), x1 = *(const LAS f32x4*)(red + (ww * 32 + nn) * 128 + c8 + 4);
#pragma unroll
          for (int i = 0; i < 4; ++i) { sv[i] += x0[i]; sv[4 + i] += x1[i]; } }
      __syncthreads();
#pragma unroll
      for (int i = 0; i < 8; ++i) sv[i] = gelu_tanh(sv[i]);
      u32x4 pw; pw[0] = cvt_pk_bf16(sv[0], sv[1]); pw[1] = cvt_pk_bf16(sv[2], sv[3]); pw[2] = cvt_pk_bf16(sv[4], sv[5]); pw[3] = cvt_pk_bf16(sv[6], sv[7]);
      *(LAS u32x4*)(hdn + AT_KSWZ(nn, c8 * 2)) = pw; }
    __syncthreads();
    if (w < 4) {
        f32x16 o2;
#pragma unroll
        for (int r = 0; r < 16; ++r) o2[r] = 0.f;
#pragma unroll
        for (int ks = 0; ks < 8; ++ks) { const bf16x8 af = *(const LAS bf16x8*)(hdn + AT_KSWZ(r32, (ks * 16 + hi * 8) * 2));
            const bf16x8 bfr = *(const bf16x8*)(W2T + (size_t)(w * 32 + r32) * 128 + ks * 16 + hi * 8);
            o2 = __builtin_amdgcn_mfma_f32_32x32x16_bf16(af, bfr, o2, 0, 0, 0); }
        bf16_t* dst = (bf16_t*)(ws + (DEBUG_CMP ? (j ? WS_Y + 1048576 : WS_Y) : (j ? WS_VC : WS_KC))) + (size_t)bg * 128 * 128;
#pragma unroll
        for (int r = 0; r < 16; ++r) { const int nn = mt * 32 + at::crow(r, hi); dst[(size_t)nn * 128 + w * 32 + r32] = (nn < NCMP) ? f2bf(o2[r]) : (bf16_t)0; }
    }
    __syncthreads();
}

__device__ __forceinline__ void p5_router(const Frame& F, const Args& a) {
    unsigned char* ws = F.ws; const bf16_t* H1 = (const bf16_t*)(ws + WS_H1); unsigned char* XN = ws + WS_U;
    const float* wr2 = (const float*)(ws + WS_WR2); const float* g2 = a.in[I_N2G]; const float* br = a.in[I_BR];
    float* tokw = (float*)(ws + WS_TOKW); int* slot = (int*)(ws + WS_SLOT); unsigned* cnt = F.ctl + CW_CNT;
    constexpr int HS_LD = 4104;
    LAS unsigned char* hs = F.lds; LAS float* rsv = (LAS float*)(F.lds + 32 * HS_LD); LAS float* red = (LAS float*)F.lds;
    LAS unsigned* lcnt = (LAS unsigned*)(F.lds + 32 * HS_LD + 256); LAS unsigned* lbase = lcnt + 32;
    if (F.tid < 32) lcnt[F.tid] = 0u;
    int myexp[2] = {0, 0}, myrank[2] = {0, 0};
    __syncthreads();
    for (int it = F.bid; it < NTOK / 32; it += F.G) {
#pragma unroll
        for (int rr = 0; rr < 4; ++rr) { const int tl = F.wid * 4 + rr, row = it * 32 + tl;
            const bf16_t* hr = H1 + (size_t)row * DM; u32x4 hw[4]; float ss = 0.f;
#pragma unroll
            for (int i = 0; i < 4; ++i) { hw[i] = *(const u32x4*)(hr + i * 512 + F.lane * 8); float hf[8]; unpack8(hw[i], hf);
#pragma unroll
                for (int j = 0; j < 8; ++j) ss += hf[j] * hf[j]; }
            ss = wave_sum(ss); const float rs = rsqrtf(ss * (1.f / DM) + EPS);
            if (F.lane == 0) rsv[tl] = rs;
#pragma unroll
            for (int i = 0; i < 4; ++i) { const f32x4 g0 = *(const f32x4*)(g2 + i * 512 + F.lane * 8), g1 = *(const f32x4*)(g2 + i * 512 + F.lane * 8 + 4);
                float hf[8]; unpack8(hw[i], hf);
                const f32x4 a0 = (f32x4){hf[0], hf[1], hf[2], hf[3]} * rs * g0, a1 = (f32x4){hf[4], hf[5], hf[6], hf[7]} * rs * g1;
                u32x2 w; w[0] = cvt4_fp8(a0[0], a0[1], a0[2], a0[3]); w[1] = cvt4_fp8(a1[0], a1[1], a1[2], a1[3]);
                *(u32x2*)(XN + (size_t)row * DM + i * 512 + F.lane * 8) = w;
                LAS unsigned char* hp = hs + tl * HS_LD + (i * 512 + F.lane * 8) * 2;
                *(LAS u32x2*)hp = (u32x2){hw[i][0], hw[i][1]}; *(LAS u32x2*)(hp + 8) = (u32x2){hw[i][2], hw[i][3]}; } }
        __syncthreads();
        f32x4 c00 = {0.f, 0.f, 0.f, 0.f}, c01 = c00, c10 = c00, c11 = c00;
        { const int ti = F.lane & 15, kq = F.lane >> 4, kb = F.wid * 256 + kq;
          const LAS unsigned char* ha = hs + ti * HS_LD + kb * 2; const float* wb = wr2 + (size_t)kb * 32 + ti;
#pragma unroll 16
          for (int s_ = 0; s_ < 64; ++s_) {
              const float a0 = bf2f(*(const LAS bf16_t*)(ha + s_ * 8)), a1 = bf2f(*(const LAS bf16_t*)(ha + 16 * HS_LD + s_ * 8));
              const float b0 = wb[(size_t)s_ * 128], b1 = wb[(size_t)s_ * 128 + 16];
              c00 = __builtin_amdgcn_mfma_f32_16x16x4f32(a0, b0, c00, 0, 0, 0); c01 = __builtin_amdgcn_mfma_f32_16x16x4f32(a0, b1, c01, 0, 0, 0);
              c10 = __builtin_amdgcn_mfma_f32_16x16x4f32(a1, b0, c10, 0, 0, 0); c11 = __builtin_amdgcn_mfma_f32_16x16x4f32(a1, b1, c11, 0, 0, 0); } }
        float rsl[2];
        rsl[0] = rsv[F.tid >> 5]; rsl[1] = rsv[16 + (F.tid >> 5)];
        __syncthreads();
        { const int cj = F.lane & 15, rq = (F.lane >> 4) * 4; LAS float* rw = red + F.wid * 1024;
#pragma unroll
          for (int r = 0; r < 4; ++r) { rw[(rq + r) * 32 + cj] = c00[r]; rw[(rq + r) * 32 + 16 + cj] = c01[r]; rw[(16 + rq + r) * 32 + cj] = c10[r]; rw[(16 + rq + r) * 32 + 16 + cj] = c11[r]; } }
        __syncthreads();
#pragma unroll
        for (int ps = 0; ps < 2; ++ps) {
            const int tl = ps * 16 + (F.tid >> 5), e = F.tid & 31, row = it * 32 + tl;
            float acc = 0.f;
#pragma unroll
            for (int w = 0; w < 8; ++w) acc += red[w * 1024 + tl * 32 + e];
            const float logit = acc * rsl[ps] + br[e];
            float tv[4]; int ti[4]; float cur = logit;
#pragma unroll
            for (int k = 0; k < 4; ++k) { float bv = cur; int bi = e;
#pragma unroll
                for (int o = 16; o > 0; o >>= 1) { const float ov = __shfl_xor(bv, o); const int oi = __shfl_xor(bi, o); if (ov > bv || (ov == bv && oi < bi)) { bv = ov; bi = oi; } }
                tv[k] = bv; ti[k] = bi; if (e == bi) cur = -INFINITY; }
            const float m = tv[0]; const float e0 = 1.f, e1 = __expf(tv[1] - m), e2 = __expf(tv[2] - m), e3 = __expf(tv[3] - m); const float inv = 1.f / (e0 + e1 + e2 + e3);
            if (e < 4) { const int k = e; const int ee = k == 0 ? ti[0] : k == 1 ? ti[1] : k == 2 ? ti[2] : ti[3]; const float w = (k == 0 ? e0 : k == 1 ? e1 : k == 2 ? e2 : e3) * inv;
                tokw[(size_t)row * 4 + k] = w;
                myexp[ps] = ee; myrank[ps] = (int)__hip_atomic_fetch_add(lcnt + ee, 1u, __ATOMIC_RELAXED, __HIP_MEMORY_SCOPE_WORKGROUP); } }
        __syncthreads();
        if (F.tid < 32) { const unsigned c = lcnt[F.tid]; lbase[F.tid] = c ? atomicAdd(&cnt[F.tid], c) : 0u; lcnt[F.tid] = 0u; }
        __syncthreads();
#pragma unroll
        for (int ps = 0; ps < 2; ++ps) { const int e = F.tid & 31; if (e < 4) { const int row = it * 32 + ps * 16 + (F.tid >> 5);
                slot[(size_t)myexp[ps] * NTOK + lbase[myexp[ps]] + myrank[ps]] = row * 4 + e; } }
        __syncthreads();
    }
}

__device__ __forceinline__ void moe_build_tiles(const Frame& F, LAS int* tstart, LAS int* cntl) {
    if (F.tid == 0) { int acc = 0; for (int e = 0; e < NEXP; ++e) { const int c = (int)__hip_atomic_load(F.ctl + CW_CNT + e, __ATOMIC_RELAXED, __HIP_MEMORY_SCOPE_AGENT); cntl[e] = c; tstart[e] = acc; acc += (c + 255) >> 8; } tstart[NEXP] = acc; }
    if (F.tid < 64) { const int sh = amax_shift(__hip_atomic_load(F.ctl + CW_AMAX + F.tid, __ATOMIC_RELAXED, __HIP_MEMORY_SCOPE_AGENT)); const unsigned b_ = (unsigned)(127 - sh) & 0xffu;
        cntl[40 + F.tid] = (int)(b_ | (b_ << 8) | (b_ << 16) | (b_ << 24)); }
    __syncthreads();
}

__device__ __forceinline__ void p9_combine(const Frame& F, const Args& a) {
    unsigned char* ws = F.ws; const bf16_t* H1 = (const bf16_t*)(ws + WS_H1); const unsigned char* Y = ws + WS_Y;
    const float* tokw = (const float*)(ws + WS_TOKW); const float* gf = a.in[I_FNG]; float* out = a.out;
    for (int row = F.bid * 8 + F.wid; row < NTOK; row += F.G * 8) {
        const bf16_t* hr = H1 + (size_t)row * DM; f32x4 v[8]; float ss = 0.f;
        const f32x4 w4 = *(const f32x4*)(tokw + (size_t)row * 4);
#pragma unroll
        for (int i = 0; i < 4; ++i) { const int c0 = i * 512 + F.lane * 8; { const u32x4 hw = *(const u32x4*)(hr + c0); float hf[8]; unpack8(hw, hf);
                v[2 * i] = (f32x4){hf[0], hf[1], hf[2], hf[3]}; v[2 * i + 1] = (f32x4){hf[4], hf[5], hf[6], hf[7]}; }
#pragma unroll
            for (int k = 0; k < 4; ++k) { const u32x2 yw = *(const u32x2*)(Y + ((size_t)row * 4 + k) * DM + c0); float f[8];
                { const f32x2 t0 = __builtin_amdgcn_cvt_pk_f32_fp8(yw[0], false), t1 = __builtin_amdgcn_cvt_pk_f32_fp8(yw[0], true), t2 = __builtin_amdgcn_cvt_pk_f32_fp8(yw[1], false), t3 = __builtin_amdgcn_cvt_pk_f32_fp8(yw[1], true);
                  f[0] = t0[0]; f[1] = t0[1]; f[2] = t1[0]; f[3] = t1[1]; f[4] = t2[0]; f[5] = t2[1]; f[6] = t3[0]; f[7] = t3[1]; }
#pragma unroll
                for (int j = 0; j < 4; ++j) { v[2 * i][j] += w4[k] * f[j]; v[2 * i + 1][j] += w4[k] * f[4 + j]; } }
#pragma unroll
            for (int j = 0; j < 4; ++j) ss += v[2 * i][j] * v[2 * i][j] + v[2 * i + 1][j] * v[2 * i + 1][j]; }
        ss = wave_sum(ss); const float rs = rsqrtf(ss * (1.f / DM) + EPS);
#pragma unroll
        for (int i = 0; i < 4; ++i) { const int c0 = i * 512 + F.lane * 8; const f32x4 g0 = *(const f32x4*)(gf + c0), g1 = *(const f32x4*)(gf + c0 + 4);
            *(f32x4*)(out + (size_t)row * DM + c0) = v[2 * i] * rs * g0; *(f32x4*)(out + (size_t)row * DM + c0 + 4) = v[2 * i + 1] * rs * g1; }
    }
}

#if DEBUG_CMP
__device__ __noinline__ void dbg_compare(unsigned char* ws, unsigned* ctl, LAS unsigned char* lds) {
    const int tid = threadIdx.x, lane = tid & 63, wid = tid >> 6;
    float mx = 0.f, md = 0.f; const bf16_t* r0 = (const bf16_t*)(ws + WS_KC); const bf16_t* r1 = (const bf16_t*)(ws + WS_Y);
    for (int i = tid; i < 2 * 16 * 128 * 128; i += NTHREADS) { const float x = bf2f(i < 262144 ? r0[i] : ((const bf16_t*)(ws + WS_VC))[i - 262144]); const float y = bf2f(i < 262144 ? r1[i] : ((const bf16_t*)(ws + WS_Y + 1048576))[i - 262144]);
        mx = fmaxf(mx, fabsf(x)); md = fmaxf(md, fabsf(x - y)); if (!(y == y)) md = 1e30f; }
    mx = wave_max(mx); md = wave_max(md); LAS float* t2 = (LAS float*)lds; if (lane == 0) { t2[wid] = mx; t2[8 + wid] = md; } __syncthreads();
    if (tid == 0) { float a1 = 0.f, a2 = 0.f; for (int i = 0; i < 8; ++i) { a1 = fmaxf(a1, t2[i]); a2 = fmaxf(a2, t2[8 + i]); }
        const float rel = a2 / fmaxf(a1, 1e-20f); int code = 0;
        if (rel >= 1.f) code = 10; else if (rel >= 0.3f) code = 11; else if (rel >= 0.1f) code = 12; else if (rel >= 0.03f) code = 13; else if (rel >= 0.01f) code = 14; else if (rel >= 0.003f) code = 15;
        if (blockIdx.x == 0) ctl[CW_ERR] = (unsigned)code; }
    __syncthreads();
}
#endif
constexpr int N_PHASES = 9;
extern "C" __global__ void __launch_bounds__(NTHREADS, 2) fwd(Args args) {
    extern __shared__ __attribute__((aligned(16))) unsigned char shm[];
    LAS unsigned char* lds = (LAS unsigned char*)shm;
    Frame F; F.lds = lds; F.ws = args.ws; F.ctl = (unsigned*)(args.ws + WS_CTL);
    F.tid = threadIdx.x; F.wid = __builtin_amdgcn_readfirstlane(F.tid >> 6); F.lane = F.tid & 63; F.G = gridDim.x; F.bid = blockIdx.x;
    LAS unsigned* misc = (LAS unsigned*)(lds + LDS_MISC);
    if (F.tid < 4) misc[F.tid] = 0u;
    __syncthreads();
    const int lo = args.ph_lo, hi = args.ph_hi;
    XcdBarrier bar; bar.bar = F.ctl; bar.x = 0; bar.st = nullptr;
    if (hi - lo > 1) bar = xcd_barrier_post(F.ctl, (volatile LAS unsigned*)misc);
#define IN(k) (lo <= (k) && (k) < hi)
#define SEAM(k) do { if (IN(k) && IN((k) + 1)) xcd_barrier(bar); } while (0)
    unsigned char* ws = args.ws;

    if (IN(0)) { p0_prologue(F, args); }
#if (REP_MASK >> 0) & 1
    if (IN(0)) { p0_prologue(F, args); }
#endif
    SEAM(0);
    if (IN(1)) {
        const int gi = F.bid >> 3, g8i = gi & 7; const bool split = (F.G == 256), conv = split && (g8i == 2 || g8i == 5 || g8i == 7);
        if (conv) { const int crank = ((gi >> 3) * 3 + (g8i == 2 ? 0 : (g8i == 5 ? 1 : 2))) * 8 + (F.bid & 7); conv_experts(F, args, CONV_P2 + crank, 96, 12288); bias1_partials(F, args, crank, 96); }
        else {
            const int grank = (gi >> 3) * 5 + (g8i < 2 ? g8i : (g8i < 5 ? g8i - 1 : 4));
            g8::DenseSched<DM, DM> S; S.init(ws + WS_U, ws + WS_WINT, NTOK, PROJ_LD, split ? 160 : F.G, split ? grank * 8 + (F.bid & 7) : F.bid);
            g8::EpiProj E{(bf16_t*)(ws + WS_PROJ), PROJ_LD, (bf16_t*)(ws + WS_OMF), (const float*)(ws + WS_LB)};
            g8::gemm_phase(lds, S, E);
            if (!split) { conv_experts(F, args, CONV_P2 + F.bid, F.G, 12288); bias1_partials(F, args, F.bid, F.G); }
        }
    }
#if (REP_MASK >> 1) & 1
    if (IN(1)) {
        g8::DenseSched<DM, DM> S; S.init(ws + WS_U, ws + WS_WINT, NTOK, PROJ_LD, F.G, F.bid);
        g8::EpiProj E{(bf16_t*)(ws + WS_PROJ), PROJ_LD, (bf16_t*)(ws + WS_OMF), (const float*)(ws + WS_LB)};
        g8::gemm_phase(lds, S, E);
    }
#endif
    SEAM(1);
    if (IN(2)) {
#if DEBUG_CMP
        p2_compress_naive(F, args);
#endif
        for (int u = F.bid; u < 128; u += F.G) compress_fast_unit(F, args, u);
        if (F.G == 256) { if (F.bid >= 128) conv_experts(F, args, CONV_P0 + (F.bid - 128), 128, CONV_P2); }
        else conv_experts(F, args, CONV_P0 + F.bid, F.G, CONV_P2); }
#if (REP_MASK >> 2) & 1
    if (IN(2)) {
#if DEBUG_CMP
        p2_compress_naive(F, args);
#endif
        for (int u = F.bid; u < 128; u += F.G) compress_fast_unit(F, args, u); }
#endif
    SEAM(2);
    if (IN(3)) {
#if DEBUG_CMP
        dbg_compare(ws, F.ctl, lds);
#endif
        if (F.bid < 64) hgrn_fast_unit(F, args, F.bid);
        for (;;) { if (F.tid == 0) misc[8] = atomicAdd(F.ctl + CW_QUEUE, 1u);
            __syncthreads();
            const int u = (int)misc[8];
            if (u >= BATCH * NSA_G * 32) break;
            attn_fast_unit(F, args, u); }
    }
#if (REP_MASK >> 3) & 1
    if (IN(3)) {
#if DEBUG_CMP
        dbg_compare(ws, F.ctl, lds);
#endif
        if (F.bid < 64) hgrn_fast_unit(F, args, F.bid);
        for (;;) { if (F.tid == 0) misc[8] = atomicAdd(F.ctl + CW_QUEUE + 64, 1u);
            __syncthreads();
            const int u = (int)misc[8];
            if (u >= BATCH * NSA_G * 32) break;
            attn_fast_unit(F, args, u); }
    }
#endif
    SEAM(3);
    if (IN(4)) {
        g8::DenseSched<DM, DM> S; S.init(ws + WS_YMIX, ws + WS_WOUTT, NTOK, DM, F.G, F.bid);
        g8::EpiResBf16 E{(bf16_t*)(ws + WS_H1), args.in[I_X], DM};
        g8::gemm_phase(lds, S, E);
    }
#if (REP_MASK >> 4) & 1
    if (IN(4)) {
        g8::DenseSched<DM, DM> S; S.init(ws + WS_YMIX, ws + WS_WOUTT, NTOK, DM, F.G, F.bid);
        g8::EpiResBf16 E{(bf16_t*)(ws + WS_H1), args.in[I_X], DM};
        g8::gemm_phase(lds, S, E);
    }
#endif
    SEAM(4);
    if (IN(5)) { p5_router(F, args); }
#if (REP_MASK >> 5) & 1
    if (IN(5)) { p5_router(F, args); }
#endif
    SEAM(5);
    if (IN(6)) {
        LAS int* tstart = (LAS int*)(misc + 64); LAS int* cntl = tstart + 40;
        moe_build_tiles(F, tstart, cntl);
        g8::MoeSched<16, 2, true> S{(const char*)(ws + WS_U), (const char*)(ws + WS_WGUT), (const int*)(ws + WS_SLOT), args.in[I_BGU], tstart, cntl, F.G, F.bid};
        g8::EpiGateUp E{(unsigned char*)(ws + WS_ACT), args.in[I_BGU]};
        g8::gemm_phase(lds, S, E);
    }
#if (REP_MASK >> 6) & 1
    if (IN(6)) {
        LAS int* tstart = (LAS int*)(misc + 64); LAS int* cntl = tstart + 40;
        moe_build_tiles(F, tstart, cntl);
        g8::MoeSched<16, 2, true> S{(const char*)(ws + WS_U), (const char*)(ws + WS_WGUT), (const int*)(ws + WS_SLOT), args.in[I_BGU], tstart, cntl, F.G, F.bid};
        g8::EpiGateUp E{(unsigned char*)(ws + WS_ACT), args.in[I_BGU]};
        g8::gemm_phase(lds, S, E);
    }
#endif
    SEAM(6);
    if (IN(7)) {
        LAS int* tstart = (LAS int*)(misc + 64); LAS int* cntl = tstart + 40;
        moe_build_tiles(F, tstart, cntl);
        g8::MoeSched<8, 0, false> S{(const char*)(ws + WS_ACT), (const char*)(ws + WS_WDT), (const int*)(ws + WS_SLOT), args.in[I_BD], tstart, cntl, F.G, F.bid};
        g8::EpiDown E{ws + WS_Y, args.in[I_BD]};
        g8::gemm_phase(lds, S, E);
    }
#if (REP_MASK >> 7) & 1
    if (IN(7)) {
        LAS int* tstart = (LAS int*)(misc + 64); LAS int* cntl = tstart + 40;
        moe_build_tiles(F, tstart, cntl);
        g8::MoeSched<8, 0, false> S{(const char*)(ws + WS_ACT), (const char*)(ws + WS_WDT), (const int*)(ws + WS_SLOT), args.in[I_BD], tstart, cntl, F.G, F.bid};
        g8::EpiDown E{ws + WS_Y, args.in[I_BD]};
        g8::gemm_phase(lds, S, E);
    }
#endif
    SEAM(7);
    if (IN(8)) { p9_combine(F, args);
#if DEBUG_CMP
        { const unsigned code = __hip_atomic_load(F.ctl + CW_ERR, __ATOMIC_RELAXED, __HIP_MEMORY_SCOPE_AGENT);
          if (code) { const float cval = sqrtf((float)code); for (size_t i = (size_t)F.bid * NTHREADS + F.tid; i < (size_t)NTOK * DM; i += (size_t)F.G * NTHREADS) args.out[i] = cval; } }
#endif
    }
#if (REP_MASK >> 8) & 1
    if (IN(8)) { p9_combine(F, args);
#if DEBUG_CMP
        { const unsigned code = __hip_atomic_load(F.ctl + CW_ERR, __ATOMIC_RELAXED, __HIP_MEMORY_SCOPE_AGENT);
          if (code) { const float cval = sqrtf((float)code); for (size_t i = (size_t)F.bid * NTHREADS + F.tid; i < (size_t)NTOK * DM; i += (size_t)F.G * NTHREADS) args.out[i] = cval; } }
#endif
    }
#endif
#undef IN
#undef SEAM
}

extern "C" void kernel_launch(void* const* d_in, const int* in_sizes, int n_in, void* d_out, int out_size, void* d_ws, size_t ws_size, hipStream_t stream) {
    static int grid = 0;
    if (grid == 0) {
        if (n_in != 18 || ws_size < WS_END) { fprintf(stderr, "kernel_launch: n_in %d ws %zu (need %zu)\n", n_in, ws_size, (size_t)WS_END); grid = -1; return; }
        int dev = 0, cus = 0, per_cu = 0;
        if (hipGetDevice(&dev) != hipSuccess || hipDeviceGetAttribute(&cus, hipDeviceAttributeMultiprocessorCount, dev) != hipSuccess) { grid = -1; return; }
        if (hipFuncSetAttribute((const void*)fwd, hipFuncAttributeMaxDynamicSharedMemorySize, LDS_BYTES) != hipSuccess) { fprintf(stderr, "kernel_launch: hipFuncSetAttribute failed\n"); grid = -1; return; }
        if (hipOccupancyMaxActiveBlocksPerMultiprocessor(&per_cu, (const void*)fwd, NTHREADS, LDS_BYTES) != hipSuccess || per_cu < 1) { fprintf(stderr, "kernel_launch: occupancy query says %d\n", per_cu); }
        (void)hipGetLastError();
        grid = cus;
    }
    if (grid < 0) return;
    (void)hipMemsetAsync((char*)d_ws + WS_CTL, 0, CTL_BYTES, stream);
    Args a{};
    for (int i = 0; i < 18; ++i) a.in[i] = (const float*)d_in[i];
    a.out = (float*)d_out; a.ws = (unsigned char*)d_ws;
#if N_LAUNCH_PER_PHASE
    for (int p = 0; p < N_PHASES; ++p) { a.ph_lo = p; a.ph_hi = p + 1; hipLaunchKernelGGL(fwd, dim3(grid), dim3(NTHREADS), LDS_BYTES, stream, a); }
#else
    a.ph_lo = 0; a.ph_hi = N_PHASES; hipLaunchKernelGGL(fwd, dim3(grid), dim3(NTHREADS), LDS_BYTES, stream, a);
#endif
}
```

```cpp
#include <hip/hip_runtime.h>
#include <stdint.h>
#include <stdio.h>

#ifndef N_LAUNCH_PER_PHASE
#define N_LAUNCH_PER_PHASE 0
#endif

#define DEBUG_CMP 0
#ifndef REP_MASK
#define REP_MASK 0
#endif
#define LAS __attribute__((address_space(3)))
typedef unsigned short bf16_t;
typedef short bf16x8 __attribute__((ext_vector_type(8)));
typedef float f32x4 __attribute__((ext_vector_type(4)));
typedef float f32x2 __attribute__((ext_vector_type(2)));
typedef float f32x16 __attribute__((ext_vector_type(16)));
typedef unsigned u32x4 __attribute__((ext_vector_type(4)));
typedef unsigned u32x2 __attribute__((ext_vector_type(2)));
typedef int i32x8 __attribute__((ext_vector_type(8)));

constexpr int BATCH = 8, SEQ = 2048, NTOK = BATCH * SEQ, DM = 2048;
constexpr int HG_W = 1024, HG_H = 8, HG_DK = 128, HG_DV = 128;
constexpr int NSA_H = 8, NSA_G = 2, NSA_R = 4, HD = 128, KVW = 256;
constexpr int IN_COLS = 6680, PROJ_LD = 6912;
constexpr int C_HQ = 0, C_HF = 1024, C_HI = 2048, C_HGT = 3072, C_NQ = 4096, C_KCM = 5120, C_VCM = 5376, C_KSL = 5632, C_VSL = 5888, C_KWN = 6144, C_VWN = 6400, C_NGT = 6656;
constexpr int NCMP = 127, NSEL = 32, SEL_TOP = 16, WINDOW = 512;
constexpr int NEXP = 32, TOPK = 4, DFF = 2048, NASG = NTOK * TOPK;
constexpr float EPS = 1e-6f;
constexpr int NTHREADS = 512;
constexpr int CONV_P0 = 0, CONV_P2 = 1280;

constexpr size_t al256(size_t x) { return (x + 255) & ~(size_t)255; }
constexpr size_t WS_CTL = 0, CTL_BYTES = 65536;
constexpr size_t WS_WINT = WS_CTL + CTL_BYTES;
constexpr size_t WS_WOUTT = WS_WINT + (size_t)PROJ_LD * DM * 2;
constexpr size_t WS_WGUT = WS_WOUTT + (size_t)DM * DM * 2;
constexpr size_t WS_WDT = WS_WGUT + (size_t)NEXP * 2 * DFF * DM * 2;
constexpr size_t WS_W1T = WS_WDT + (size_t)NEXP * DM * DFF * 2;
constexpr size_t WS_W2T = WS_W1T + (size_t)2 * 128 * 4096 * 2;
constexpr size_t WS_BIAS1 = WS_W2T + (size_t)2 * 128 * 128 * 2;
constexpr size_t WS_WR2 = WS_BIAS1 + 1024;
constexpr size_t WS_LB = WS_WR2 + (size_t)DM * NEXP * 4;
constexpr size_t WS_U = WS_LB + 4096;
constexpr size_t WS_PROJ = WS_U + (size_t)NTOK * DM * 2;
constexpr size_t WS_KC = WS_PROJ + (size_t)(NTOK + 64) * PROJ_LD * 2;
constexpr size_t WS_VC = WS_KC + (size_t)16 * 128 * 128 * 2;
constexpr size_t WS_YMIX = WS_VC + (size_t)16 * 128 * 128 * 2;
constexpr size_t WS_H1 = WS_YMIX + (size_t)NTOK * DM * 2;
constexpr size_t WS_TOKW = WS_H1 + (size_t)NTOK * DM * 4;
constexpr size_t WS_SLOT = WS_TOKW + (size_t)NTOK * 4 * 4;
constexpr size_t WS_ACT = WS_SLOT + (size_t)NEXP * NTOK * 4;
constexpr size_t WS_Y = WS_ACT + (size_t)NASG * DFF * 2;
constexpr size_t WS_OT = WS_Y + (size_t)NASG * DM * 2;
constexpr size_t WS_OMF = WS_OT + (size_t)256 * 64 * 512 * 4;
constexpr size_t WS_B1P = WS_OMF + (size_t)NTOK * HG_W * 2;
constexpr size_t WS_END = WS_B1P + (size_t)2 * 32 * 128 * 4;
constexpr int CW_CNT = 4096, CW_QUEUE = 4160, CW_ERR = 4224, CW_AMAX = 4544;

__device__ __forceinline__ float bf2f(bf16_t b) { return __uint_as_float(((unsigned)b) << 16); }
typedef __bf16 bf16v2_t __attribute__((ext_vector_type(2)));
__device__ __forceinline__ unsigned cvt_pk_bf16(float lo, float hi) { f32x2 v = {lo, hi}; bf16v2_t r = __builtin_convertvector(v, bf16v2_t); return __builtin_bit_cast(unsigned, r); }
__device__ __forceinline__ unsigned cvt4_fp8(float a, float b, float c, float d) { unsigned w = 0u; w = __builtin_amdgcn_cvt_pk_fp8_f32(a, b, w, false); w = __builtin_amdgcn_cvt_pk_fp8_f32(c, d, w, true); return w; }
__device__ __forceinline__ unsigned cvt4_bf8(float a, float b, float c, float d) { unsigned w = 0u; w = __builtin_amdgcn_cvt_pk_bf8_f32(a, b, w, false); w = __builtin_amdgcn_cvt_pk_bf8_f32(c, d, w, true); return w; }
__device__ __forceinline__ int amax_shift(unsigned bits) { if (bits == 0u) return 0; int s_ = 5 - ((int)(bits >> 23) - 127); return s_ < -60 ? -60 : (s_ > 60 ? 60 : s_); }
__device__ __forceinline__ float shift_mult(int s_) { return __uint_as_float((unsigned)(s_ + 127) << 23); }
__device__ __forceinline__ unsigned cvt4_fp8s(float a, float b, float c, float d, float m) {
    return cvt4_fp8(__builtin_amdgcn_fmed3f(a * m, -448.f, 448.f), __builtin_amdgcn_fmed3f(b * m, -448.f, 448.f), __builtin_amdgcn_fmed3f(c * m, -448.f, 448.f), __builtin_amdgcn_fmed3f(d * m, -448.f, 448.f)); }
__device__ __forceinline__ bf16_t f2bf(float f) { return (bf16_t)(cvt_pk_bf16(f, 0.f) & 0xffffu); }
__device__ __forceinline__ float sigmoidf_(float x) { return 1.f / (1.f + __expf(-x)); }
__device__ __forceinline__ float siluf_(float x) { return x * sigmoidf_(x); }
__device__ __forceinline__ float wave_sum(float v) {
#pragma unroll
    for (int o = 32; o > 0; o >>= 1) v += __shfl_xor(v, o);
    return v;
}
__device__ __forceinline__ float wave_max(float v) {
#pragma unroll
    for (int o = 32; o > 0; o >>= 1) v = fmaxf(v, __shfl_xor(v, o));
    return v;
}
__device__ __forceinline__ void unpack8(const u32x4 w, float (&f)[8]) {
#pragma unroll
    for (int i = 0; i < 4; ++i) { f[2 * i] = __uint_as_float(w[i] << 16); f[2 * i + 1] = __uint_as_float(w[i] & 0xffff0000u); }
}

#define XB_TMO      128
#define XB_XCNT(j)  (256  + 64 * (j))
#define XB_XSUB(j)  (1280 + 64 * (j))
#define XB_XGEN(j)  (2304 + 64 * (j))
#define XB_TOP      3328
#define XB_TOPGEN   3392
#define XCD_BAR_WORDS 3456
#define XB_SPIN_CAP (1u << 18)
__device__ __forceinline__ unsigned xb_ld(unsigned* p)              { return __hip_atomic_load(p, __ATOMIC_RELAXED, __HIP_MEMORY_SCOPE_AGENT); }
__device__ __forceinline__ unsigned xb_add(unsigned* p, unsigned v) { return __hip_atomic_fetch_add(p, v, __ATOMIC_RELAXED, __HIP_MEMORY_SCOPE_AGENT); }
__device__ __forceinline__ unsigned xb_xcc_id() { return (unsigned)__builtin_amdgcn_s_getreg((3 << 11) | 20) & 0xFu; }
#define XB_SPIN(cond, bar) do { unsigned _sp = 0; while (cond) { __builtin_amdgcn_s_sleep(1); \
    if ((++_sp & 255u) == 0u) { if (xb_ld(&(bar)[XB_TMO])) break; if (_sp > XB_SPIN_CAP) { atomicAdd(&(bar)[XB_TMO], 1u); break; } } } } while (0)
struct XcdBarrier { unsigned* bar; unsigned x; volatile LAS unsigned* st; };
__device__ __forceinline__ XcdBarrier xcd_barrier_post(unsigned* bar, volatile LAS unsigned* st) {
    XcdBarrier b; b.bar = bar; b.x = xb_xcc_id(); b.st = st;
    if (threadIdx.x == 0) (void)xb_add(&bar[XB_XCNT(b.x)], 1u);
    return b;
}
__device__ __forceinline__ void xcd_barrier_complete(unsigned* bar, unsigned x, unsigned& nloc, unsigned& nx) {
    const unsigned G = gridDim.x * gridDim.y * gridDim.z;
    unsigned sum, cnt, mine, sp = 0u;
    for (;;) {
        sum = 0u; cnt = 0u; mine = 0u;
#pragma unroll
        for (unsigned j = 0; j < 16; ++j) { const unsigned c = xb_ld(&bar[XB_XCNT(j)]); sum += c; cnt += (c > 0u) ? 1u : 0u; mine = (j == x) ? c : mine; }
        if (sum == G) break;
        __builtin_amdgcn_s_sleep(1);
        if ((++sp & 255u) == 0u) { if (xb_ld(&bar[XB_TMO])) break; if (sp > XB_SPIN_CAP) { atomicAdd(&bar[XB_TMO], 1u); break; } }
    }
    nloc = mine > 0u ? mine : 1u; nx = cnt > 0u ? cnt : 1u;
}
__device__ __forceinline__ void xcd_barrier(const XcdBarrier& b) {
    asm volatile("s_waitcnt vmcnt(0)" ::: "memory");
    __syncthreads();
    if (threadIdx.x == 0) {
        unsigned* bar = b.bar;
        __builtin_amdgcn_s_waitcnt(0);
        unsigned nloc = b.st[0], nx = b.st[1];
        if (nloc == 0u) { xcd_barrier_complete(bar, b.x, nloc, nx); b.st[0] = nloc; b.st[1] = nx; }
        const unsigned old = xb_add(&bar[XB_XSUB(b.x)], 1u);
        const unsigned gen = old / nloc;
        if (old + 1u == (gen + 1u) * nloc) {
            __builtin_amdgcn_fence(__ATOMIC_RELEASE, "agent");
            asm volatile("s_waitcnt vmcnt(0)" ::: "memory");
            const unsigned og = xb_add(&bar[XB_TOP], 1u);
            const unsigned tg = og / nx;
            if (og + 1u == (tg + 1u) * nx) xb_add(&bar[XB_TOPGEN], 1u);
            else XB_SPIN(xb_ld(&bar[XB_TOPGEN]) == tg, bar);
            __builtin_amdgcn_fence(__ATOMIC_ACQUIRE, "agent");
            xb_add(&bar[XB_XGEN(b.x)], 1u);
            asm volatile("s_waitcnt vmcnt(0)" ::: "memory");
        } else {
            XB_SPIN(xb_ld(&bar[XB_XGEN(b.x)]) == gen, bar);
            __builtin_amdgcn_fence(__ATOMIC_ACQUIRE, "agent");
            asm volatile("s_waitcnt vmcnt(0)" ::: "memory");
        }
    }
    __syncthreads();
}

namespace g8 {
constexpr int BM = 256, BK = 64, HALF = 128, HTB = HALF * BK * 2, STAGE_BYTES = 8 * HTB, NXCD = 8;
__host__ __device__ __forceinline__ int lds_byte(int r, int c) { const int st = (r >> 4) * 2 + (c >> 5), rr = r & 15, cc = c & 31, ob = rr * 64 + cc * 2; return st * 1024 + (ob ^ (((ob >> 9) & 1) << 5)); }
__host__ __device__ __forceinline__ void stage_rc(int b, int& R, int& C) { const int st = b / 1024, sb = b % 1024, swz = sb ^ (((sb >> 9) & 1) << 5); R = (st >> 1) * 16 + swz / 64; C = (st & 1) * 32 + (swz % 64) / 2; }
__host__ __device__ __forceinline__ int perm32(int rho) { const int n = rho >> 4, i = rho & 15; return 8 * (i >> 2) + 4 * n + (i & 3); }

struct Unit { const char* A; const char* B0; const char* B1; const int* rows; const float* bias0; const float* bias1; int nvalid; int m0, n0, e; int wscale; };

template <class Sched>
__device__ __forceinline__ void a_offsets(const Unit& u, const int (&R)[2], const int (&C)[2], unsigned (&vo)[2][2]) {
#pragma unroll
    for (int h = 0; h < 2; ++h)
#pragma unroll
        for (int i = 0; i < 2; ++i) {
            if constexpr (Sched::GATHER) {
                const int r = h * HALF + R[i];
                const int idx = u.rows[r < u.nvalid ? r : 0] >> Sched::SHIFT;
                vo[h][i] = (unsigned)idx * (unsigned)(Sched::LDA * Sched::ESZ) + (unsigned)C[i] * 2u;
            } else {
                vo[h][i] = (unsigned)(h * HALF + R[i]) * (unsigned)(Sched::LDA * Sched::ESZ) + (unsigned)C[i] * 2u;
            }
        }
}

__device__ __forceinline__ const char* uni_ptr(const char* p) { const unsigned long long v = (unsigned long long)p;
    const unsigned lo = (unsigned)__builtin_amdgcn_readfirstlane((int)(unsigned)v), hi = (unsigned)__builtin_amdgcn_readfirstlane((int)(unsigned)(v >> 32));
    return (const char*)(((unsigned long long)hi << 32) | lo); }
template <class Sched, class Epi>
__device__ __forceinline__ void gemm_phase(LAS unsigned char* lds, const Sched& S, const Epi& E) {
    const int tid = threadIdx.x, wid = __builtin_amdgcn_readfirstlane(tid >> 6), lane = tid & 63, wr = wid >> 2, wc = wid & 3, fr = lane & 15, fq = lane >> 4;
    constexpr int K = Sched::K, nt = K * Sched::ESZ / (BK * 2);
    int Rr[2], Cc[2]; unsigned voffB[2];
#pragma unroll
    for (int i = 0; i < 2; ++i) { stage_rc(tid * 16 + i * 8192, Rr[i], Cc[i]); const int Rb = Epi::PERM ? ((Rr[i] & ~31) + perm32(Rr[i] & 31)) : Rr[i];
        voffB[i] = (unsigned)Rb * (unsigned)(K * Sched::ESZ) + (unsigned)Cc[i] * 2u; }
    const size_t kstep = (size_t)(BK * 2);
    const unsigned ldsw = (unsigned)wid * 1024u;
    const int aoff = lds_byte(wr * 64 + fr, fq * 8), boff = lds_byte(wc * 32 + fr, fq * 8);
#define G8_SA(b, h) (((b) * 2 + (h)) * HTB)
#define G8_SB(b, h) ((4 + (b) * 2 + (h)) * HTB)
#define G8_STAGE(bufoff, gbase, voff) do { _Pragma("unroll") for (int _i = 0; _i < 2; ++_i) \
        __builtin_amdgcn_global_load_lds((const unsigned*)((const char*)(gbase) + (voff)[_i]), (LAS unsigned*)(lds + (bufoff) + ldsw + _i * 8192), 16, 0, 0); } while (0)
#define G8_LDA(dst, b, h) do { if constexpr (Sched::MV != 0 && (h) == 1) break; _Pragma("unroll") for (int m = 0; m < 4; ++m) _Pragma("unroll") for (int k = 0; k < 2; ++k) dst[m][k] = *(const LAS bf16x8*)(lds + G8_SA(b, h) + aoff + m * 2048 + k * 1024); } while (0)
#define G8_LDB(dst, b, h) do { _Pragma("unroll") for (int n = 0; n < 2; ++n) _Pragma("unroll") for (int k = 0; k < 2; ++k) dst[n][k] = *(const LAS bf16x8*)(lds + G8_SB(b, h) + boff + n * 2048 + k * 1024); } while (0)
#define G8_MMA(ai, bj, At, Bt) do { if constexpr (Sched::MV != 0 && (ai) == 1) break; __builtin_amdgcn_s_setprio(1); _Pragma("unroll") for (int m = 0; m < 4; ++m) _Pragma("unroll") for (int n = 0; n < 2; ++n) { \
        if constexpr (Sched::ESZ == 2) { _Pragma("unroll") for (int k = 0; k < 2; ++k) acc[ai][bj][m][n] = __builtin_amdgcn_mfma_f32_16x16x32_bf16(Bt[n][k], At[m][k], acc[ai][bj][m][n], 0, 0, 0); } \
        else { const u32x4 b0_ = __builtin_bit_cast(u32x4, Bt[n][0]), b1_ = __builtin_bit_cast(u32x4, Bt[n][1]), a0_ = __builtin_bit_cast(u32x4, At[m][0]), a1_ = __builtin_bit_cast(u32x4, At[m][1]); \
            const i32x8 bw_ = {(int)b0_[0], (int)b0_[1], (int)b0_[2], (int)b0_[3], (int)b1_[0], (int)b1_[1], (int)b1_[2], (int)b1_[3]}; \
            const i32x8 aw_ = {(int)a0_[0], (int)a0_[1], (int)a0_[2], (int)a0_[3], (int)a1_[0], (int)a1_[1], (int)a1_[2], (int)a1_[3]}; \
            acc[ai][bj][m][n] = __builtin_amdgcn_mfma_scale_f32_16x16x128_f8f6f4(bw_, aw_, acc[ai][bj][m][n], Sched::FMT_W, Sched::FMT_A, 0, wsc_cur, 0, 0x7f7f7f7f); } } \
        __builtin_amdgcn_s_setprio(0); } while (0)
#define G8_WAIT_V(n) asm volatile("s_waitcnt vmcnt(" #n ")" ::: "memory")
#define G8_WAIT_L(n) asm volatile("s_waitcnt lgkmcnt(" #n ")" ::: "memory")
#define G8_BAR __builtin_amdgcn_s_barrier()
#define G8_SCHED __builtin_amdgcn_sched_barrier(0)
    Unit cur, nxt; int ui = 0;
    if (!S.next(0, cur)) return;
    f32x4 acc[2][2][4][2];
#pragma unroll
    for (int a = 0; a < 2; ++a)
#pragma unroll
        for (int b = 0; b < 2; ++b)
#pragma unroll
            for (int m = 0; m < 4; ++m)
#pragma unroll
                for (int n = 0; n < 2; ++n) acc[a][b][m][n] = (f32x4){0.f, 0.f, 0.f, 0.f};
    bf16x8 At[4][2], B0[2][2], B1[2][2];
    unsigned voffA[2][2], nvoffA[2][2];
    LAS unsigned char* auxb = lds + STAGE_BYTES; int par_cur = 0, par_nxt = 1;
#define G8_AUX_ISSUE(U, PAR) do { if (wid < 4) { const int r_ = wid * 64 + lane; __builtin_amdgcn_global_load_lds((const unsigned*)((U).rows + (r_ < (U).nvalid ? r_ : 0)), (LAS unsigned*)(auxb + (PAR) * 2048 + wid * 256), 4, 0, 0); } \
        else { const float* b_ = (wid < 6 ? (U).bias0 + (wid - 4) * 64 : (U).bias1 + (wid - 6) * 64) + lane; __builtin_amdgcn_global_load_lds((const unsigned*)b_, (LAS unsigned*)(auxb + (PAR) * 2048 + 1024 + (wid - 4) * 256), 4, 0, 0); } } while (0)
#define G8_AUX_OFFS(PAR) do { _Pragma("unroll") for (int h = 0; h < 2; ++h) _Pragma("unroll") for (int i = 0; i < 2; ++i) { \
        const int idx_ = *(const LAS int*)(auxb + (PAR) * 2048 + (h * HALF + Rr[i]) * 4) >> Sched::SHIFT; voffA[h][i] = (unsigned)idx_ * (unsigned)(Sched::LDA * Sched::ESZ) + (unsigned)Cc[i] * 2u; } } while (0)
    if constexpr (Sched::LDSAUX) { G8_AUX_ISSUE(cur, 0); G8_WAIT_V(0); __syncthreads(); G8_AUX_OFFS(0); }
    else a_offsets<Sched>(cur, Rr, Cc, voffA);
    const char* cA = cur.A; const char* cB0 = cur.B0; const char* cB1 = cur.B1;
    int wsc_cur = cur.wscale;
    G8_STAGE(G8_SB(0, 0), cB0, voffB); G8_STAGE(G8_SA(0, 0), cA, voffA[0]); G8_STAGE(G8_SB(0, 1), cB1, voffB); G8_STAGE(G8_SA(0, 1), cA, voffA[1]);
    if (wr == 1) G8_BAR;
    G8_WAIT_V(4); G8_BAR;
    G8_STAGE(G8_SB(1, 0), cB0 + kstep, voffB); G8_STAGE(G8_SA(1, 0), cA + kstep, voffA[0]); G8_STAGE(G8_SB(1, 1), cB1 + kstep, voffB);
    G8_WAIT_V(6); G8_BAR;
    for (;;) {
        const bool has_next = S.next(ui + 1, nxt);
        const char* nA = has_next ? nxt.A : cA; const char* nB0 = has_next ? nxt.B0 : cB0; const char* nB1 = has_next ? nxt.B1 : cB1;
        if constexpr (Sched::LDSAUX) { if (has_next) G8_AUX_ISSUE(nxt, par_nxt); }
        else if constexpr (Sched::GATHER) {
            if (has_next) a_offsets<Sched>(nxt, Rr, Cc, nvoffA);
            else {
#pragma unroll
                for (int h = 0; h < 2; ++h)
#pragma unroll
                    for (int i = 0; i < 2; ++i) nvoffA[h][i] = voffA[h][i];
            }
        }
        for (int t = 0; t < nt; t += 2) {
            const bool last = (t == nt - 2);
            const char* a1 = cA + (size_t)(t + 1) * kstep;
            const char* a2 = last ? nA : cA + (size_t)(t + 2) * kstep;
            const char* b20 = last ? nB0 : cB0 + (size_t)(t + 2) * kstep; const char* b21 = last ? nB1 : cB1 + (size_t)(t + 2) * kstep;
            const char* a3 = a2 + kstep; const char* b30 = b20 + kstep; const char* b31 = b21 + kstep;
            G8_LDB(B0, 0, 0); G8_SCHED; G8_LDA(At, 0, 0); G8_STAGE(G8_SA(1, 1), a1, voffA[1]);
            G8_WAIT_L(8); G8_BAR; G8_WAIT_L(0); G8_MMA(0, 0, At, B0); G8_BAR; G8_SCHED;
            if constexpr (Sched::LDSAUX) { if (last && has_next) G8_AUX_OFFS(par_nxt); }
            else if constexpr (Sched::GATHER) { if (last) {
#pragma unroll
                for (int h = 0; h < 2; ++h)
#pragma unroll
                    for (int i = 0; i < 2; ++i) voffA[h][i] = nvoffA[h][i]; } }
            G8_LDB(B1, 0, 1); G8_STAGE(G8_SB(0, 0), b20, voffB);
            G8_BAR; G8_WAIT_L(0); G8_MMA(0, 1, At, B1); G8_BAR;
            G8_LDA(At, 0, 1); G8_STAGE(G8_SA(0, 0), a2, voffA[0]);
            G8_BAR; G8_WAIT_L(0); G8_MMA(1, 0, At, B0); G8_BAR; G8_SCHED;
            G8_STAGE(G8_SB(0, 1), b21, voffB);
            G8_WAIT_V(6); G8_BAR; G8_MMA(1, 1, At, B1); G8_BAR;
            G8_LDB(B0, 1, 0); G8_SCHED; G8_LDA(At, 1, 0); G8_STAGE(G8_SA(0, 1), a2, voffA[1]);
            G8_WAIT_L(8); G8_BAR; G8_WAIT_L(0); G8_MMA(0, 0, At, B0); G8_BAR; G8_SCHED;
            G8_LDB(B1, 1, 1); G8_STAGE(G8_SB(1, 0), b30, voffB);
            G8_BAR; G8_WAIT_L(0); G8_MMA(0, 1, At, B1); G8_BAR;
            G8_LDA(At, 1, 1); G8_STAGE(G8_SA(1, 0), a3, voffA[0]);
            G8_BAR; G8_WAIT_L(0); G8_MMA(1, 0, At, B0); G8_BAR; G8_SCHED;
            G8_STAGE(G8_SB(1, 1), b31, voffB);
            G8_WAIT_V(6); G8_BAR; G8_MMA(1, 1, At, B1); G8_BAR;
        }
        E.template run<(Sched::MV != 0 ? 1 : 2)>(acc, cur, wr, wc, fr, fq, (const LAS int*)(auxb + par_cur * 2048), (const LAS float*)(auxb + par_cur * 2048 + 1024));
        if (!has_next) break;
#pragma unroll
        for (int a = 0; a < 2; ++a)
#pragma unroll
            for (int b = 0; b < 2; ++b)
#pragma unroll
                for (int m = 0; m < 4; ++m)
#pragma unroll
                    for (int n = 0; n < 2; ++n) acc[a][b][m][n] = (f32x4){0.f, 0.f, 0.f, 0.f};
        cur = nxt; cA = nA; cB0 = nB0; cB1 = nB1; ++ui; wsc_cur = cur.wscale; par_cur = par_nxt; par_nxt = par_nxt == 2 ? 0 : par_nxt + 1;
    }
    G8_WAIT_V(0);
    if (wr == 0) G8_BAR;
    G8_BAR;
#undef G8_AUX_ISSUE
#undef G8_AUX_OFFS
#undef G8_SA
#undef G8_SB
#undef G8_STAGE
#undef G8_LDA
#undef G8_LDB
#undef G8_MMA
#undef G8_WAIT_V
#undef G8_WAIT_L
#undef G8_BAR
#undef G8_SCHED
}

template <int K_, int LDA_>
struct DenseSched {
    static constexpr int K = K_, LDA = LDA_, SHIFT = 0, ESZ = 2, FMT_W = 0, FMT_A = 0, MV = 0; static constexpr bool GATHER = false, LDSAUX = false;
    const char* A; const char* Bt; int nM, nN, nwg, G, c;
    __device__ void init(const void* A_, const void* Bt_, int M, int N, int G_, int c_) { A = (const char*)A_; Bt = (const char*)Bt_; nM = M / BM; nN = N / BM; nwg = nM * nN; G = G_; c = c_; }
    __device__ __forceinline__ bool next(int i, Unit& u) const {
        const long L = (long)i * G + c; if (L >= nwg) return false;
        int wgid = (int)L; { const int q = nwg / NXCD, r = nwg % NXCD, xcd = wgid % NXCD, off = wgid / NXCD; wgid = (xcd < r ? xcd * (q + 1) : r * (q + 1) + (xcd - r) * q) + off; }
        constexpr int WGM = 8;
        const int nig = WGM * nN, gid = wgid / nig, fm = gid * WGM, gsz = (nM - fm) < WGM ? (nM - fm) : WGM;
        const int pm = fm + ((wgid % nig) % gsz), pn = (wgid % nig) / gsz;
        u.A = A + (size_t)pm * BM * LDA * 2; u.B0 = Bt + (size_t)pn * BM * K * 2; u.B1 = u.B0 + (size_t)HALF * K * 2;
        u.rows = nullptr; u.bias0 = nullptr; u.bias1 = nullptr; u.wscale = 0x7f7f7f7f; u.nvalid = BM; u.m0 = pm * BM; u.n0 = pn * BM; u.e = 0; return true;
    }
};

template <int NPN  , int SHIFT_, bool GU, int MV_ = 0>
struct MoeSched {
    static constexpr int K = 2048, LDA = 2048, SHIFT = SHIFT_, ESZ = 1, MV = MV_, FMT_W = 0  , FMT_A = 0  ; static constexpr bool GATHER = true, LDSAUX = true;
    const char* A; const char* Bt; const int* slot; const float* bias; const LAS int* tstart; const LAS int* cnt; int G, c;
    __device__ __forceinline__ bool next(int i, Unit& u) const {
        const int ntile = tstart[NEXP]; const int nwg = ntile * NPN;
        const long L = (long)i * G + c; if (L >= nwg) return false;
        int wgid = (int)L; { const int q = nwg / NXCD, r = nwg % NXCD, xcd = wgid % NXCD, off = wgid / NXCD; wgid = (xcd < r ? xcd * (q + 1) : r * (q + 1) + (xcd - r) * q) + off; }
        int e = 0;
        for (int s = 16; s > 0; s >>= 1) if (tstart[e + s] * NPN <= wgid) e += s;
        const int mt = tstart[e + 1] - tstart[e], w = wgid - tstart[e] * NPN, pn = MV ? w : w / mt, m = MV ? (cnt[e] >> 8) : w % mt;
        u.A = A; u.e = e; u.m0 = m * BM; u.n0 = pn; u.wscale = cnt[40 + (GU ? 0 : 32) + e]; u.rows = slot + (size_t)e * NTOK + m * BM;
        const int left = cnt[e] - m * BM; u.nvalid = left < BM ? left : BM;
        if (GU) { u.B0 = Bt + ((size_t)e * 4096 + (size_t)pn * HALF) * K * ESZ; u.B1 = u.B0 + (size_t)2048 * K * ESZ; u.bias0 = bias + (size_t)e * 4096 + pn * HALF; u.bias1 = u.bias0 + 2048; }
        else { u.B0 = Bt + ((size_t)e * 2048 + (size_t)pn * BM) * K * ESZ; u.B1 = u.B0 + (size_t)HALF * K * ESZ; u.bias0 = bias + (size_t)e * 2048 + pn * BM; u.bias1 = u.bias0 + HALF; }
        return true;
    }
};

struct EpiBf16 {
    static constexpr bool PERM = true;
    bf16_t* O; int ldc;
    template <int NAI> __device__ __forceinline__ void run(const f32x4 (&acc)[2][2][4][2], const Unit& u, int wr, int wc, int fr, int fq, const LAS int* lrows, const LAS float* lbias) const {
        const int row0 = u.m0 + wr * 64 + fr, col0 = u.n0 + wc * 32 + 8 * fq;
#pragma unroll
        for (int ai = 0; ai < NAI; ++ai)
#pragma unroll
            for (int m = 0; m < 4; ++m) { bf16_t* rowp = O + (size_t)(row0 + ai * HALF + m * 16) * ldc + col0;
#pragma unroll
                for (int bj = 0; bj < 2; ++bj) { const f32x4 v0 = acc[ai][bj][m][0], v1 = acc[ai][bj][m][1];
                    u32x4 w; w[0] = cvt_pk_bf16(v0[0], v0[1]); w[1] = cvt_pk_bf16(v0[2], v0[3]); w[2] = cvt_pk_bf16(v1[0], v1[1]); w[3] = cvt_pk_bf16(v1[2], v1[3]);
                    *(u32x4*)(rowp + bj * HALF) = w; } }
    }
};
struct EpiProj {
    static constexpr bool PERM = true;
    bf16_t* O; int ldc; bf16_t* OMF; const float* lb;
    template <int NAI> __device__ __forceinline__ void run(const f32x4 (&acc)[2][2][4][2], const Unit& u, int wr, int wc, int fr, int fq, const LAS int* lrows, const LAS float* lbias) const {
        const int row0 = u.m0 + wr * 64 + fr, col0 = u.n0 + wc * 32 + 8 * fq;
        const int mode = (u.n0 < 1024 || (u.n0 >= 3072 && u.n0 < 4096)) ? 1 : ((u.n0 >= 1024 && u.n0 < 2048) ? 2 : 0);
        f32x4 lbv[2][2];
        if (mode == 2) {
#pragma unroll
            for (int bj = 0; bj < 2; ++bj) { lbv[bj][0] = *(const f32x4*)(lb + col0 - 1024 + bj * HALF); lbv[bj][1] = *(const f32x4*)(lb + col0 - 1024 + bj * HALF + 4); } }
#pragma unroll
        for (int ai = 0; ai < NAI; ++ai)
#pragma unroll
            for (int m = 0; m < 4; ++m) { const size_t rowi = (size_t)(row0 + ai * HALF + m * 16); bf16_t* rowp = O + rowi * ldc + col0;
#pragma unroll
                for (int bj = 0; bj < 2; ++bj) { f32x4 v0 = acc[ai][bj][m][0], v1 = acc[ai][bj][m][1];
                    f32x4 o0 = {0.f, 0.f, 0.f, 0.f}, o1 = o0;
                    if (mode != 0) {
                        f32x4 e0 = v0 * (-1.4426950408889634f), e1 = v1 * (-1.4426950408889634f);
#pragma unroll
                        for (int j = 0; j < 4; ++j) { e0[j] = __builtin_amdgcn_exp2f(e0[j]); e1[j] = __builtin_amdgcn_exp2f(e1[j]); }
                        e0 = e0 + 1.f; e1 = e1 + 1.f;
#pragma unroll
                        for (int j = 0; j < 4; ++j) { e0[j] = __builtin_amdgcn_rcpf(e0[j]); e1[j] = __builtin_amdgcn_rcpf(e1[j]); }
                        if (mode == 1) { v0 = v0 * e0; v1 = v1 * e1; }
                        else { const f32x4 f0 = lbv[bj][0] + (1.f - lbv[bj][0]) * e0, f1 = lbv[bj][1] + (1.f - lbv[bj][1]) * e1;
#pragma unroll
                            for (int j = 0; j < 4; ++j) { v0[j] = __builtin_amdgcn_logf(f0[j]); v1[j] = __builtin_amdgcn_logf(f1[j]); }
                            o0 = 1.f - f0; o1 = 1.f - f1; } }
                    if (mode == 2) {
                        u32x4 w2; w2[0] = cvt_pk_bf16(o0[0], o0[1]); w2[1] = cvt_pk_bf16(o0[2], o0[3]); w2[2] = cvt_pk_bf16(o1[0], o1[1]); w2[3] = cvt_pk_bf16(o1[2], o1[3]);
                        *(u32x4*)(OMF + rowi * HG_W + (col0 - 1024) + bj * HALF) = w2; }
                    u32x4 w; w[0] = cvt_pk_bf16(v0[0], v0[1]); w[1] = cvt_pk_bf16(v0[2], v0[3]); w[2] = cvt_pk_bf16(v1[0], v1[1]); w[3] = cvt_pk_bf16(v1[2], v1[3]);
                    *(u32x4*)(rowp + bj * HALF) = w; } }
    }
};
struct EpiResF32 {
    static constexpr bool PERM = false;
    float* C; const float* res; int ldc;
    template <int NAI> __device__ __forceinline__ void run(const f32x4 (&acc)[2][2][4][2], const Unit& u, int wr, int wc, int fr, int fq, const LAS int* lrows, const LAS float* lbias) const {
        const int row0 = u.m0 + wr * 64 + fr, col0 = u.n0 + wc * 32 + 4 * fq;
#pragma unroll
        for (int ai = 0; ai < NAI; ++ai)
#pragma unroll
            for (int m = 0; m < 4; ++m) { const size_t off = (size_t)(row0 + ai * HALF + m * 16) * ldc + col0;
#pragma unroll
                for (int bj = 0; bj < 2; ++bj)
#pragma unroll
                    for (int n = 0; n < 2; ++n) { const f32x4 r = *(const f32x4*)(res + off + bj * HALF + n * 16); *(f32x4*)(C + off + bj * HALF + n * 16) = acc[ai][bj][m][n] + r; } }
    }
};
struct EpiResBf16 {
    static constexpr bool PERM = true;
    bf16_t* C; const float* res; int ldc;
    template <int NAI> __device__ __forceinline__ void run(const f32x4 (&acc)[2][2][4][2], const Unit& u, int wr, int wc, int fr, int fq, const LAS int*, const LAS float*) const {
        const int row0 = u.m0 + wr * 64 + fr, col0 = u.n0 + wc * 32 + 8 * fq;
#pragma unroll
        for (int ai = 0; ai < NAI; ++ai)
#pragma unroll
            for (int m = 0; m < 4; ++m) { const size_t off = (size_t)(row0 + ai * HALF + m * 16) * ldc + col0;
#pragma unroll
                for (int bj = 0; bj < 2; ++bj) { const f32x4 r0 = *(const f32x4*)(res + off + bj * HALF), r1 = *(const f32x4*)(res + off + bj * HALF + 4);
                    const f32x4 v0 = acc[ai][bj][m][0] + r0, v1 = acc[ai][bj][m][1] + r1;
                    u32x4 w; w[0] = cvt_pk_bf16(v0[0], v0[1]); w[1] = cvt_pk_bf16(v0[2], v0[3]); w[2] = cvt_pk_bf16(v1[0], v1[1]); w[3] = cvt_pk_bf16(v1[2], v1[3]);
                    *(u32x4*)(C + off + bj * HALF) = w; } }
    }
};
struct EpiGateUp {
    static constexpr bool PERM = true;
    unsigned char* ACT; const float* bias;
    template <int NAI> __device__ __forceinline__ void run(const f32x4 (&acc)[2][2][4][2], const Unit& u, int wr, int wc, int fr, int fq, const LAS int* lrows, const LAS float* lbias) const {
        const int colh = u.n0 * HALF + wc * 32 + 8 * fq;
        const LAS float* bp = lbias + wc * 32 + 8 * fq;
        const f32x4 bg0 = *(const LAS f32x4*)bp, bg1 = *(const LAS f32x4*)(bp + 4), bu0 = *(const LAS f32x4*)(bp + 128), bu1 = *(const LAS f32x4*)(bp + 132);
#pragma unroll
        for (int ai = 0; ai < NAI; ++ai)
#pragma unroll
            for (int m = 0; m < 4; ++m) { const int r = ai * HALF + wr * 64 + m * 16 + fr;
                if (r < u.nvalid) { const int asg = lrows[r];
                    f32x4 g0 = acc[ai][0][m][0] + bg0, g1 = acc[ai][0][m][1] + bg1, u0 = acc[ai][1][m][0] + bu0, u1 = acc[ai][1][m][1] + bu1;
                    f32x4 e0, e1;
#pragma unroll
                    for (int j = 0; j < 4; ++j) { g0[j] = fminf(g0[j], 7.f); g1[j] = fminf(g1[j], 7.f); u0[j] = __builtin_amdgcn_fmed3f(u0[j], -7.f, 7.f); u1[j] = __builtin_amdgcn_fmed3f(u1[j], -7.f, 7.f); }
                    const f32x4 z0 = g0 * (-1.702f * 1.4426950408889634f), z1 = g1 * (-1.702f * 1.4426950408889634f);
#pragma unroll
                    for (int j = 0; j < 4; ++j) { e0[j] = __builtin_amdgcn_exp2f(z0[j]); e1[j] = __builtin_amdgcn_exp2f(z1[j]); }
                    e0 = e0 + 1.f; e1 = e1 + 1.f;
#pragma unroll
                    for (int j = 0; j < 4; ++j) { e0[j] = __builtin_amdgcn_rcpf(e0[j]); e1[j] = __builtin_amdgcn_rcpf(e1[j]); }
                    const f32x4 o0 = (g0 * e0) * (u0 + 1.f), o1 = (g1 * e1) * (u1 + 1.f);
                    u32x2 w; w[0] = cvt4_fp8(o0[0], o0[1], o0[2], o0[3]); w[1] = cvt4_fp8(o1[0], o1[1], o1[2], o1[3]);
                    *(u32x2*)(ACT + (size_t)asg * DFF + colh) = w; } }
    }
};
struct EpiDown {
    static constexpr bool PERM = true;
    unsigned char* Y; const float* bias;
    template <int NAI> __device__ __forceinline__ void run(const f32x4 (&acc)[2][2][4][2], const Unit& u, int wr, int wc, int fr, int fq, const LAS int* lrows, const LAS float* lbias) const {
        const int col0 = u.n0 * BM + wc * 32 + 8 * fq;
        const LAS float* bp = lbias + wc * 32 + 8 * fq;
        f32x4 bv[2][2];
#pragma unroll
        for (int bj = 0; bj < 2; ++bj) { bv[bj][0] = *(const LAS f32x4*)(bp + bj * HALF); bv[bj][1] = *(const LAS f32x4*)(bp + bj * HALF + 4); }
#pragma unroll
        for (int ai = 0; ai < NAI; ++ai)
#pragma unroll
            for (int m = 0; m < 4; ++m) { const int r = ai * HALF + wr * 64 + m * 16 + fr;
                if (r < u.nvalid) { const int asg = lrows[r]; unsigned char* rowp = Y + (size_t)asg * DM + col0;
#pragma unroll
                    for (int bj = 0; bj < 2; ++bj) { const f32x4 v0 = acc[ai][bj][m][0] + bv[bj][0], v1 = acc[ai][bj][m][1] + bv[bj][1];
                        u32x2 w; w[0] = cvt4_fp8(v0[0], v0[1], v0[2], v0[3]); w[1] = cvt4_fp8(v1[0], v1[1], v1[2], v1[3]);
                        *(u32x2*)(rowp + bj * HALF) = w; } } }
    }
};
}

struct Args { const float* in[18]; float* out; unsigned char* ws; int ph_lo, ph_hi; };
enum { I_X = 0, I_N1G, I_WIN, I_LBL, I_HGNG, I_CPOS, I_CW1, I_CW2, I_NSAG, I_WOUT, I_N2G, I_WR, I_BR, I_WGU, I_BGU, I_WD, I_BD, I_FNG };
constexpr int LDS_STAGE = 131072, LDS_BYTES = LDS_STAGE + 16384, LDS_MISC = LDS_BYTES - 4096;

struct Frame {
    LAS unsigned char* lds; unsigned char* ws; unsigned* ctl; int tid, wid, lane, G, bid;
};

__device__ __forceinline__ void conv_tile(const Frame& F, const float* src, int lds_, int k0, int n0, int N, bf16_t* dst, int ldd) {
    LAS float* tile = (LAS float*)F.lds;
#pragma unroll
    for (int p = 0; p < 2; ++p) { const int k = p * 32 + (F.tid >> 4), n = (F.tid & 15) * 4;
        f32x4 v = (f32x4){0.f, 0.f, 0.f, 0.f};
        if (n0 + n < N) v = *(const f32x4*)(src + (size_t)(k0 + k) * lds_ + n0 + n);
        tile[k * 65 + n] = v[0]; tile[k * 65 + n + 1] = v[1]; tile[k * 65 + n + 2] = v[2]; tile[k * 65 + n + 3] = v[3]; }
    __syncthreads();
    { const int n = F.tid >> 3, kc = (F.tid & 7) * 8;
      if (n0 + n < N) { float f[8];
#pragma unroll
          for (int j = 0; j < 8; ++j) f[j] = tile[(kc + j) * 65 + n];
          u32x4 w; w[0] = cvt_pk_bf16(f[0], f[1]); w[1] = cvt_pk_bf16(f[2], f[3]); w[2] = cvt_pk_bf16(f[4], f[5]); w[3] = cvt_pk_bf16(f[6], f[7]);
          *(u32x4*)(dst + (size_t)(n0 + n) * ldd + k0 + kc) = w; } }
    __syncthreads();
}
struct ConvJob { const float* src; unsigned char* dst; int N; };
__device__ __forceinline__ ConvJob conv_job(const Args& a, unsigned char* ws, int st, int& kt, int& ntile) {
    ConvJob j;
    if (st < 8192) { const int e = st >> 8, r = st & 255; kt = r >> 4; ntile = r & 15; j.src = a.in[I_WGU] + (size_t)e * DM * 4096; j.dst = ws + WS_WGUT + (size_t)e * 4096 * DM; j.N = 4096; }
    else { const int q = st - 8192, e = q >> 7, r = q & 127; kt = r >> 3; ntile = r & 7; j.src = a.in[I_WD] + (size_t)e * DFF * DM; j.dst = ws + WS_WDT + (size_t)e * DM * DFF; j.N = 2048; }
    return j;
}
__device__ __forceinline__ void conv_experts(const Frame& F, const Args& a, int first, int stride, int limit) {
    unsigned char* ws = F.ws; LAS unsigned* tile = (LAS unsigned*)F.lds;
    LAS float* mtab = (LAS float*)(F.lds + 32768);
    if (F.tid < 64) mtab[F.tid] = shift_mult(amax_shift(__hip_atomic_load(F.ctl + CW_AMAX + F.tid, __ATOMIC_RELAXED, __HIP_MEMORY_SCOPE_AGENT)));
    __syncthreads();
    const int NST = limit;
    const int lk = F.tid >> 5, lc = F.tid & 31;
    f32x4 v[16];
    int st = first, kt = 0, ntile = 0; ConvJob J{};
#define CV_LOAD() do { _Pragma("unroll") for (int T = 0; T < 2; ++T) _Pragma("unroll") for (int pp = 0; pp < 8; ++pp) \
        v[T * 8 + pp] = __builtin_nontemporal_load((const f32x4*)(J.src + (size_t)(kt * 128 + pp * 16 + lk) * J.N + ntile * 256 + T * 128 + lc * 4)); } while (0)
    if (st < NST) { J = conv_job(a, ws, st, kt, ntile); CV_LOAD(); }
    for (; st < NST; st += stride) {
        const float mlt = mtab[st < 8192 ? (st >> 8) : 32 + ((st - 8192) >> 7)];
#pragma unroll
        for (int T = 0; T < 2; ++T)
#pragma unroll
            for (int pp = 0; pp < 8; ++pp) { const int k = pp * 16 + lk; const f32x4 x = v[T * 8 + pp];
                tile[T * 4096 + k * 32 + (lc ^ (4 * (k >> 4)))] = cvt4_fp8s(x[0], x[1], x[2], x[3], mlt); }
        __syncthreads();
        const ConvJob Jc = J; const int ktc = kt, ntc = ntile;
        const int nx = st + stride;
        if (nx < NST) { J = conv_job(a, ws, nx, kt, ntile); CV_LOAD(); }
        { const int i = F.tid & 7, n4g = (F.tid >> 3) & 31, T = F.tid >> 8;
          unsigned d[16];
#pragma unroll
          for (int jj = 0; jj < 16; ++jj) d[jj] = tile[T * 4096 + (16 * i + jj) * 32 + (n4g ^ (4 * i))];
          u32x4 o[4];
#pragma unroll
          for (int q = 0; q < 4; ++q) {
              const unsigned a0 = __builtin_amdgcn_perm(d[4 * q + 1], d[4 * q], 0x05010400u), a1 = __builtin_amdgcn_perm(d[4 * q + 1], d[4 * q], 0x07030602u);
              const unsigned a2 = __builtin_amdgcn_perm(d[4 * q + 3], d[4 * q + 2], 0x05010400u), a3 = __builtin_amdgcn_perm(d[4 * q + 3], d[4 * q + 2], 0x07030602u);
              o[0][q] = __builtin_amdgcn_perm(a2, a0, 0x05040100u); o[1][q] = __builtin_amdgcn_perm(a2, a0, 0x07060302u);
              o[2][q] = __builtin_amdgcn_perm(a3, a1, 0x05040100u); o[3][q] = __builtin_amdgcn_perm(a3, a1, 0x07060302u); }
          unsigned char* dp = Jc.dst + (size_t)(ntc * 256 + T * 128 + n4g * 4) * DM + ktc * 128 + 16 * i;
#pragma unroll
          for (int r = 0; r < 4; ++r) *(u32x4*)(dp + (size_t)r * DM) = o[r]; }
        __syncthreads();
    }
#undef CV_LOAD
}
__device__ __forceinline__ void conv_matrix4(const Frame& F, const float* src, int K, int N, bf16_t* dst) {
    LAS float* tile = (LAS float*)F.lds;
    const int tn4 = (N + 255) / 256, tk = K / 64, cnt = tn4 * tk;
    for (int t = F.bid; t < cnt; t += F.G) { const int k0 = (t / tn4) * 64, n00 = (t % tn4) * 256;
        f32x4 v[8];
#pragma unroll
        for (int q = 0; q < 4; ++q)
#pragma unroll
            for (int p = 0; p < 2; ++p) { const int k = p * 32 + (F.tid >> 4), n = n00 + q * 64 + (F.tid & 15) * 4;
                v[q * 2 + p] = (n < N) ? *(const f32x4*)(src + (size_t)(k0 + k) * N + n) : (f32x4){0.f, 0.f, 0.f, 0.f}; }
#pragma unroll
        for (int q = 0; q < 4; ++q)
#pragma unroll
            for (int p = 0; p < 2; ++p) { LAS float* tp = tile + q * (64 * 65) + (p * 32 + (F.tid >> 4)) * 65 + (F.tid & 15) * 4; const f32x4 x = v[q * 2 + p]; tp[0] = x[0]; tp[1] = x[1]; tp[2] = x[2]; tp[3] = x[3]; }
        __syncthreads();
        { const int n = F.tid >> 3, kc = (F.tid & 7) * 8;
#pragma unroll
          for (int q = 0; q < 4; ++q) { const int nn = n00 + q * 64 + n;
              if (nn < N) { float f[8];
#pragma unroll
                  for (int j = 0; j < 8; ++j) f[j] = tile[q * (64 * 65) + (kc + j) * 65 + n];
                  u32x4 w; w[0] = cvt_pk_bf16(f[0], f[1]); w[1] = cvt_pk_bf16(f[2], f[3]); w[2] = cvt_pk_bf16(f[4], f[5]); w[3] = cvt_pk_bf16(f[6], f[7]);
                  *(u32x4*)(dst + (size_t)nn * K + k0 + kc) = w; } } }
        __syncthreads(); }
}
__device__ __forceinline__ void conv_matrix(const Frame& F, const float* src, int K, int N, bf16_t* dst, long& base) {
    const int tn = (N + 63) / 64, tk = K / 64; const long cnt = (long)tn * tk;
    long first = ((long)F.bid - base) % F.G; if (first < 0) first += F.G;
    for (long t = first; t < cnt; t += F.G) { const int kt = (int)(t / tn), nt_ = (int)(t % tn); conv_tile(F, src, N, kt * 64, nt_ * 64, N, dst, K); }
    base += cnt;
}
__device__ __forceinline__ void bias1_partials(const Frame& F, const Args& a, int rank, int nranks) {
    LAS float* red = (LAS float*)F.lds;
    const int c = F.tid & 127, kq = F.tid >> 7;
    for (int job = rank; job < 64; job += nranks) { const int j = job >> 5, kg = job & 31;
        const float* pos = a.in[I_CPOS] + (size_t)j * 4096 + kg * 128 + kq * 32; const float* w1 = a.in[I_CW1] + ((size_t)j * 4096 + kg * 128 + kq * 32) * 128 + c;
        float s0 = 0.f, s1 = 0.f, s2 = 0.f, s3 = 0.f;
#pragma unroll
        for (int k = 0; k < 32; k += 4) { s0 += pos[k] * w1[(size_t)k * 128]; s1 += pos[k + 1] * w1[(size_t)(k + 1) * 128]; s2 += pos[k + 2] * w1[(size_t)(k + 2) * 128]; s3 += pos[k + 3] * w1[(size_t)(k + 3) * 128]; }
        red[kq * 128 + c] = (s0 + s1) + (s2 + s3);
        __syncthreads();
        if (F.tid < 128) ((float*)(F.ws + WS_B1P))[((size_t)j * 32 + kg) * 128 + c] = ((red[c] + red[128 + c]) + red[256 + c]) + red[384 + c];
        __syncthreads(); }
}
__device__ __forceinline__ void p0_sample(const Frame& F, const Args& a) {
    const int j = F.bid & 63, q = F.bid >> 6, nq = (F.G + 63 - j) >> 6;
    const float* src; size_t stride; int nalt;
    if (j < 32) { src = a.in[I_WGU] + (size_t)j * DM * 4096; stride = (size_t)DM * 4096 / 64; nalt = 2; }
    else { src = a.in[I_WD] + (size_t)(j - 32) * DFF * DM; stride = (size_t)DFF * DM / 64; nalt = 1; }
    float mx = 0.f;
    for (int c = q; c < 64; c += nq) { const f32x4 v = *(const f32x4*)(src + (size_t)c * stride + (size_t)(c % nalt) * 2048 + F.tid * 4);
        mx = fmaxf(fmaxf(mx, fmaxf(fabsf(v[0]), fabsf(v[1]))), fmaxf(fabsf(v[2]), fabsf(v[3]))); }
    mx = wave_max(mx);
    if (F.lane == 0 && mx > 0.f) atomicMax(F.ctl + CW_AMAX + j, __float_as_uint(mx));
}
__device__ __forceinline__ void p0_prologue(const Frame& F, const Args& a) {
    unsigned char* ws = F.ws;
    long base = 0;
    p0_sample(F, a);
    static_assert(CONV_P0 == 0, "expert tiles need the sampled scales: none may be converted in the prologue");
    conv_matrix4(F, a.in[I_WIN], DM, IN_COLS, (bf16_t*)(ws + WS_WINT));
    conv_matrix(F, a.in[I_WOUT], DM, DM, (bf16_t*)(ws + WS_WOUTT), base);
    for (int fi = F.bid * NTHREADS + F.tid; fi < 2 * 8 * 32 * 4 * 64; fi += F.G * NTHREADS) {
        const int ln_ = fi & 63, ct = (fi >> 6) & 3, ks = (fi >> 8) & 31, w = (fi >> 13) & 7, j = fi >> 16;
        const float* wp = a.in[I_CW1] + ((size_t)j * 4096 + w * 512 + ks * 16 + (ln_ >> 5) * 8) * 128 + ct * 32 + (ln_ & 31);
        u32x4 fw; fw[0] = cvt_pk_bf16(wp[0], wp[128]); fw[1] = cvt_pk_bf16(wp[256], wp[384]); fw[2] = cvt_pk_bf16(wp[512], wp[640]); fw[3] = cvt_pk_bf16(wp[768], wp[896]);
        *(u32x4*)((bf16_t*)(ws + WS_W1T) + (size_t)fi * 8) = fw; }
    for (int j = 0; j < 2; ++j) conv_matrix(F, a.in[I_CW2] + (size_t)j * 128 * 128, 128, 128, (bf16_t*)(ws + WS_W2T) + (size_t)j * 128 * 128, base);
    { const float* x = a.in[I_X]; const float* g = a.in[I_N1G]; bf16_t* U = (bf16_t*)(ws + WS_U);
      f32x4 vn[8]; int row = F.bid * 8 + F.wid;
#define P0_LDROW(r_) do { const float* xr_ = x + (size_t)(r_) * DM; _Pragma("unroll") for (int i = 0; i < 4; ++i) { vn[2 * i] = *(const f32x4*)(xr_ + i * 512 + F.lane * 8); vn[2 * i + 1] = *(const f32x4*)(xr_ + i * 512 + F.lane * 8 + 4); } } while (0)
      if (row < NTOK) P0_LDROW(row);
      for (; row < NTOK; row += F.G * 8) {
          f32x4 v[8]; float ss = 0.f;
#pragma unroll
          for (int i = 0; i < 8; ++i) v[i] = vn[i];
          if (row + F.G * 8 < NTOK) P0_LDROW(row + F.G * 8);
#pragma unroll
          for (int i = 0; i < 8; ++i)
#pragma unroll
              for (int j = 0; j < 4; ++j) ss += v[i][j] * v[i][j];
          ss = wave_sum(ss); const float rs = rsqrtf(ss * (1.f / DM) + EPS);
#pragma unroll
          for (int i = 0; i < 4; ++i) { const f32x4 g0 = *(const f32x4*)(g + i * 512 + F.lane * 8), g1 = *(const f32x4*)(g + i * 512 + F.lane * 8 + 4);
              const f32x4 a0 = v[2 * i] * rs * g0, a1 = v[2 * i + 1] * rs * g1;
              u32x4 w; w[0] = cvt_pk_bf16(a0[0], a0[1]); w[1] = cvt_pk_bf16(a0[2], a0[3]); w[2] = cvt_pk_bf16(a1[0], a1[1]); w[3] = cvt_pk_bf16(a1[2], a1[3]);
              *(u32x4*)(U + (size_t)row * DM + i * 512 + F.lane * 8) = w; } }
#undef P0_LDROW
    }
    { const int gw = F.bid * 8 + F.wid;
      (void)gw;
      for (int i = F.bid * NTHREADS + F.tid; i < DM * NEXP; i += F.G * NTHREADS) ((float*)(ws + WS_WR2))[i] = a.in[I_N2G][i >> 5] * a.in[I_WR][i];
      for (int i = F.bid * NTHREADS + F.tid; i < HG_W; i += F.G * NTHREADS) { const float l0 = a.in[I_LBL][i], l1 = a.in[I_LBL][HG_W + i]; const float m = fmaxf(l0, l1);
          const float e0 = __expf(l0 - m), e1 = __expf(l1 - m); ((float*)(ws + WS_LB))[i] = e0 / (e0 + e1); } }
}

__device__ __forceinline__ float gelu_tanh(float x) { const float u = 0.7978845608028654f * (x + 0.044715f * x * x * x); return 0.5f * x * (1.f + tanhf(u)); }
__device__ __forceinline__ void p2_compress_naive(const Frame& F, const Args& a) {
    unsigned char* ws = F.ws; const bf16_t* PROJ = (const bf16_t*)(ws + WS_PROJ);
    LAS float* red = (LAS float*)F.lds;
    LAS float* hdn = red + 512;
    const int c = F.tid & 127, kq = F.tid >> 7;
    for (int u = F.bid; u < 2 * 16 * 128; u += F.G) {
        const int j = u >> 11, bg = (u >> 7) & 15, n = u & 127, b = bg >> 1, g = bg & 1;
        bf16_t* dst = (bf16_t*)(ws + (j ? WS_VC : WS_KC)) + ((size_t)bg * 128 + n) * 128;
        if (n == 127) { if (F.tid < 128) dst[F.tid] = 0; continue; }
        const float* w1 = a.in[I_CW1] + (size_t)j * 4096 * 128; const float* pos = a.in[I_CPOS] + (size_t)j * 4096;
        const int colb = (j ? C_VCM : C_KCM) + g * 128;
        float s = 0.f;
        for (int k = kq * 1024; k < kq * 1024 + 1024; ++k) { const int l = k >> 7, d = k & 127;
            const float av = bf2f(PROJ[(size_t)(b * SEQ + 16 * n + l) * PROJ_LD + colb + d]) + pos[k];
            s += av * w1[(size_t)k * 128 + c]; }
        red[kq * 128 + c] = s; __syncthreads();
        if (F.tid < 128) hdn[c] = gelu_tanh(red[c] + red[128 + c] + red[256 + c] + red[384 + c]);
        __syncthreads();
        if (F.tid < 128) { const float* w2 = a.in[I_CW2] + (size_t)j * 128 * 128; float o = 0.f; for (int k = 0; k < 128; ++k) o += hdn[k] * w2[k * 128 + c]; dst[c] = f2bf(o); }
        __syncthreads();
    }
}

__device__ __forceinline__ void hgrn_naive_unit(const Frame& F, const Args& a, int unit) {
    unsigned char* ws = F.ws; const bf16_t* PROJ = (const bf16_t*)(ws + WS_PROJ); bf16_t* YM = (bf16_t*)(ws + WS_YMIX);
    const float* lbv = (const float*)(ws + WS_LB);
    const int b = unit >> 3, h = unit & 7, v = F.tid & 127, kg = F.tid >> 7;
    LAS float* fs = (LAS float*)F.lds;
    LAS float* qs = fs + 2048; LAS float* is_ = qs + 2048; LAS float* red = is_ + 2048  ; LAS float* ob = red + 512  ;
    float S[32];
#pragma unroll
    for (int i = 0; i < 32; ++i) S[i] = 0.f;
    for (int t0 = 0; t0 < SEQ; t0 += 16) {
        for (int i = F.tid; i < 2048; i += NTHREADS) { const int st = i >> 7, k = i & 127; const size_t rowo = (size_t)(b * SEQ + t0 + st) * PROJ_LD + h * 128 + k;
            const float lb = lbv[h * 128 + k];
            fs[i] = lb + (1.f - lb) * sigmoidf_(bf2f(PROJ[rowo + C_HF])); qs[i] = siluf_(bf2f(PROJ[rowo + C_HQ])); is_[i] = bf2f(PROJ[rowo + C_HI]); }
        __syncthreads();
        for (int st = 0; st < 16; ++st) {
            const float iv = is_[st * 128 + v]; float po = 0.f;
#pragma unroll
            for (int kk = 0; kk < 32; ++kk) { const int k = kg * 32 + kk; const float f = fs[st * 128 + k]; S[kk] = f * S[kk] + (1.f - f) * iv; po += S[kk] * qs[st * 128 + k]; }
            red[kg * 128 + v] = po; __syncthreads();
            if (kg == 0) ob[st * 128 + v] = red[v] + red[128 + v] + red[256 + v] + red[384 + v];
            __syncthreads();
        }
        for (int s2 = 0; s2 < 2; ++s2) { const int st = F.wid * 2 + s2; const float o0 = ob[st * 128 + F.lane], o1 = ob[st * 128 + 64 + F.lane];
            const float ss = wave_sum(o0 * o0 + o1 * o1); const float rs = rsqrtf(ss * (1.f / 128.f) + EPS);
            const size_t row = (size_t)(b * SEQ + t0 + st);
            const float g0 = bf2f(PROJ[row * PROJ_LD + C_HGT + h * 128 + F.lane]), g1 = bf2f(PROJ[row * PROJ_LD + C_HGT + h * 128 + 64 + F.lane]);
            YM[row * DM + h * 128 + F.lane] = f2bf(o0 * rs * a.in[I_HGNG][F.lane] * siluf_(g0));
            YM[row * DM + h * 128 + 64 + F.lane] = f2bf(o1 * rs * a.in[I_HGNG][64 + F.lane] * siluf_(g1)); }
        __syncthreads();
    }
}

__device__ __forceinline__ float dot128_bf(const LAS float* q, const bf16_t* k) {
    float s = 0.f;
#pragma unroll
    for (int c = 0; c < 16; ++c) { const u32x4 w = *(const u32x4*)(k + c * 8); float f[8]; unpack8(w, f);
#pragma unroll
        for (int j = 0; j < 8; ++j) s += q[c * 8 + j] * f[j]; }
    return s;
}
__device__ __forceinline__ void softmax4(const Frame& F, LAS float* sc, int stride, int n, LAS float* tmp  ) {
    const int r = F.tid >> 7, i0 = F.tid & 127;
    float m = -INFINITY; for (int i = i0; i < n; i += 128) m = fmaxf(m, sc[r * stride + i]);
    m = wave_max(m); if (F.lane == 0) tmp[F.wid] = m; __syncthreads();
    m = fmaxf(tmp[2 * r], tmp[2 * r + 1]); __syncthreads();
    float s = 0.f;
    for (int i = i0; i < n; i += 128) { const float x = sc[r * stride + i]; const float p = (x == -INFINITY) ? 0.f : __expf(x - m); sc[r * stride + i] = p; s += p; }
    s = wave_sum(s); if (F.lane == 0) tmp[F.wid] = s; __syncthreads();
    s = tmp[2 * r] + tmp[2 * r + 1]; const float inv = s > 0.f ? 1.f / s : 0.f;
    for (int i = i0; i < n; i += 128) sc[r * stride + i] *= inv;
    __syncthreads();
}
__device__ __forceinline__ void attn_naive_unit(const Frame& F, const Args& a, int unit) {
    unsigned char* ws = F.ws; const bf16_t* PROJ = (const bf16_t*)(ws + WS_PROJ); bf16_t* YM = (bf16_t*)(ws + WS_YMIX);
    const int b = unit >> 12, g = (unit >> 11) & 1, t = unit & 2047, bg = b * 2 + g;
    LAS float* qs = (LAS float*)F.lds;
    LAS float* sc = qs + 512;
    LAS float* tmp = sc + 4096;
    LAS float* imp = tmp + 16;
    LAS int* selk = (LAS int*)(imp + 32);
    LAS float* oacc = (LAS float*)(selk + 32);
    const int r4 = F.tid >> 7, d = F.tid & 127;
    const size_t rowq = (size_t)(b * SEQ + t) * PROJ_LD;
    qs[F.tid] = bf2f(PROJ[rowq + C_NQ + (g * 4 + r4) * 128 + d]);
    const float slope = exp2f(-(float)(g * 4 + r4 + 1));
    const float scale = 0.08838834764831845f;
    float gate[3];
#pragma unroll
    for (int c = 0; c < 3; ++c) gate[c] = sigmoidf_(bf2f(PROJ[rowq + C_NGT + (g * 4 + r4) * 3 + c]));
    __syncthreads();
    { const int n = d; float s = -INFINITY;
      if (n < NCMP) { const int dist = t - (16 * n + 31); if (dist >= 0) s = dot128_bf(qs + r4 * 128, (const bf16_t*)(ws + WS_KC) + ((size_t)bg * 128 + n) * 128) * scale - slope * (float)dist; }
      sc[r4 * 1024 + n] = s; }
    __syncthreads();
    softmax4(F, sc, 1024, 128, tmp);
    { float o = 0.f; const bf16_t* vc = (const bf16_t*)(ws + WS_VC) + (size_t)bg * 128 * 128;
      for (int n = 0; n < NCMP; ++n) o += sc[r4 * 1024 + n] * bf2f(vc[n * 128 + d]);
      oacc[F.tid] = gate[0] * o; }
    if (F.tid < 32) { const int j = F.tid; float s = 0.f;
        for (int r = 0; r < 4; ++r) for (int q = -1; q <= 3; ++q) { const int n = 4 * j + q; if (n >= 0 && n < NCMP) s += ((q == -1 || q == 3) ? 1.f : 2.f) * sc[r * 1024 + n]; }
        const int cur = t >> 6; const bool forced = (j == 0) || (j == cur) || (j == cur - 1);
        imp[j] = forced ? 1e4f : (j <= cur ? s : -1e4f); }
    __syncthreads();
    if (F.tid < 32) { const int j = F.tid; const float me = imp[j]; int rank = 0;
        for (int k = 0; k < 32; ++k) { const float o = imp[k]; rank += (o > me || (o == me && k < j)) ? 1 : 0; }
        const bool sel = rank < SEL_TOP && j <= (t >> 6);
        const unsigned long long mask = __ballot(sel);
        if (sel) selk[__popcll(mask & ((1ull << j) - 1ull))] = j;
        if (j == 0) selk[16] = __popcll(mask); }
    __syncthreads();
    { const int nsel = selk[16];
      for (int i = F.tid; i < 4 * 1024; i += NTHREADS) sc[i] = -INFINITY;
      __syncthreads();
      const int l = F.tid & 63, r = (F.tid >> 6) & 3, which = F.tid >> 8;
      for (int s0 = 0; s0 < nsel; s0 += 2) { const int si = s0 + which;
          if (si < nsel) { const int kp = selk[si] * 64 + l;
              if (kp <= t) { const float s = dot128_bf(qs + r * 128, PROJ + (size_t)(b * SEQ + kp) * PROJ_LD + C_KSL + g * 128) * scale - exp2f(-(float)(g * 4 + r + 1)) * (float)(t - kp); sc[r * 1024 + si * 64 + l] = s; } } }
      __syncthreads();
      softmax4(F, sc, 1024, nsel * 64, tmp);
      float o = 0.f;
      for (int si = 0; si < nsel; ++si) { const int kb = selk[si] * 64;
          for (int l2 = 0; l2 < 64; ++l2) { const int kp = kb + l2; if (kp > t) break; o += sc[r4 * 1024 + si * 64 + l2] * bf2f(PROJ[(size_t)(b * SEQ + kp) * PROJ_LD + C_VSL + g * 128 + d]); } }
      oacc[F.tid] += gate[1] * o; }
    __syncthreads();
    { for (int i = F.tid; i < 4 * 1024; i += NTHREADS) sc[i] = -INFINITY;
      __syncthreads();
      for (int i = F.tid; i < 4 * 512; i += NTHREADS) { const int r = i >> 9, w = i & 511, kp = t - 511 + w;
          if (kp >= 0) sc[r * 1024 + w] = dot128_bf(qs + r * 128, PROJ + (size_t)(b * SEQ + kp) * PROJ_LD + C_KWN + g * 128) * scale - exp2f(-(float)(g * 4 + r + 1)) * (float)(t - kp); }
      __syncthreads();
      softmax4(F, sc, 1024, 512, tmp);
      float o = 0.f;
      for (int w = 0; w < 512; ++w) { const int kp = t - 511 + w; if (kp >= 0) o += sc[r4 * 1024 + w] * bf2f(PROJ[(size_t)(b * SEQ + kp) * PROJ_LD + C_VWN + g * 128 + d]); }
      oacc[F.tid] += gate[2] * o; }
    __syncthreads();
    { const float o = oacc[F.tid]; float ss = wave_sum(o * o); if (F.lane == 0) tmp[F.wid] = ss; __syncthreads();
      ss = tmp[2 * r4] + tmp[2 * r4 + 1]; const float rs = rsqrtf(ss * (1.f / 128.f) + EPS);
      YM[(size_t)(b * SEQ + t) * DM + HG_W + (g * 4 + r4) * 128 + d] = f2bf(o * rs * a.in[I_NSAG][d]); }
    __syncthreads();
}

namespace at {
constexpr int SHM_T = 64 * 128 * 2;
constexpr int BUF_B = 2 * SHM_T;
constexpr int OFF_V = 0, OFF_K = SHM_T, OFF_IMP = 2 * BUF_B  , OFF_SELM = 3 * BUF_B, OFF_WSC = OFF_SELM + 256;
constexpr float SCALE = 0.08838834764831845f, LOG2E = 1.4426950408889634f, THR = 8.f;
#define AT_KSWZ(row, colB) ((row) * 256 + ((colB) ^ (((row) & 7) << 4)))
__device__ __forceinline__ int v_st(int k, int c) { const int kk = (k & ~0xC) | ((k & 4) << 1) | ((k & 8) >> 1); return ((kk >> 3) * 4 + (c >> 5)) * 512 + ((kk & 7) * 32 + (c & 31)) * 2; }
__device__ __forceinline__ int v_rd_base(int lane) { return ((lane & 3) << 3) | (((lane >> 2) & 3) << 6) | (((lane >> 4) & 1) << 5) | (((lane >> 5) & 1) << 8); }
__device__ __forceinline__ int crow(int r, int hi) { return (r & 3) + 8 * (r >> 2) + 4 * hi; }
typedef short s16x4 __attribute__((ext_vector_type(4)));
struct Stage { u32x4 k0, k1, v0, v1; };
__device__ __forceinline__ void stage_load(Stage& S, const bf16_t* Kp, const bf16_t* Vp, int ld, int row0, int sr, int sc) {
    S.k0 = *(const u32x4*)(Kp + (size_t)(row0 + sr) * ld + sc); S.k1 = *(const u32x4*)(Kp + (size_t)(row0 + 32 + sr) * ld + sc);
    S.v0 = *(const u32x4*)(Vp + (size_t)(row0 + sr) * ld + sc); S.v1 = *(const u32x4*)(Vp + (size_t)(row0 + 32 + sr) * ld + sc);
}
__device__ __forceinline__ void stage_write(const Stage& S, LAS unsigned char* lds, int buf, int sr, int sc) {
    const int kws = AT_KSWZ(sr, sc * 2);
    *(LAS u32x4*)(lds + OFF_K + buf * BUF_B + kws) = S.k0; *(LAS u32x4*)(lds + OFF_K + buf * BUF_B + kws + 32 * 256) = S.k1;
    *(LAS u32x4*)(lds + OFF_V + buf * BUF_B + v_st(sr, sc)) = S.v0; *(LAS u32x4*)(lds + OFF_V + buf * BUF_B + v_st(32 + sr, sc)) = S.v1;
}
template <bool EXTRA = false>
__device__ __forceinline__ void qkt(f32x16& p0, f32x16& p1, const LAS unsigned char* ktile, int r32, int hi, const bf16x8 (&qr)[8], bf16x8 kx0 = bf16x8{}, bf16x8 kx1 = bf16x8{}, bf16x8 qx = bf16x8{}) {
#pragma unroll
    for (int r = 0; r < 16; ++r) { p0[r] = 0.f; p1[r] = 0.f; }
    const LAS unsigned char* kb[4];
#pragma unroll
    for (int dd = 0; dd < 4; ++dd) kb[dd] = ktile + AT_KSWZ(r32, (dd * 16 + hi * 8) * 2);
#pragma unroll
    for (int d0 = 0; d0 < 8; ++d0) { const LAS unsigned char* a = kb[d0 & 3] + (d0 >> 2) * 128;
        const bf16x8 b0 = *(const LAS bf16x8*)a; const bf16x8 b1 = *(const LAS bf16x8*)(a + 32 * 256);
        p0 = __builtin_amdgcn_mfma_f32_32x32x16_bf16(b0, qr[d0], p0, 0, 0, 0);
        p1 = __builtin_amdgcn_mfma_f32_32x32x16_bf16(b1, qr[d0], p1, 0, 0, 0); }
    if constexpr (EXTRA) {
        p0 = __builtin_amdgcn_mfma_f32_32x32x16_bf16(kx0, qx, p0, 0, 0, 0);
        p1 = __builtin_amdgcn_mfma_f32_32x32x16_bf16(kx1, qx, p1, 0, 0, 0); }
}
__device__ __forceinline__ void pv_tile(f32x16 (&o)[4], int vb, bf16x8 pa0, bf16x8 pa1, bf16x8 pa2, bf16x8 pa3) {
#define AT_TRRD(dst, off) asm volatile("ds_read_b64_tr_b16 %0, %1 offset:%2" : "=&v"(dst) : "v"(vb), "i"(off) : "memory")
#define AT_PV_D0(d0) do { s16x4 l0, l1, l2, l3, h0, h1, h2, h3; constexpr int b_ = (d0) * 512; \
        AT_TRRD(l0, b_); AT_TRRD(h0, b_ + 2048); AT_TRRD(l1, b_ + 4096); AT_TRRD(h1, b_ + 6144); AT_TRRD(l2, b_ + 8192); AT_TRRD(h2, b_ + 10240); AT_TRRD(l3, b_ + 12288); AT_TRRD(h3, b_ + 14336); \
        asm volatile("s_waitcnt lgkmcnt(0)" ::: "memory"); __builtin_amdgcn_sched_barrier(0); \
        o[d0] = __builtin_amdgcn_mfma_f32_32x32x16_bf16(pa0, (bf16x8){l0[0], l0[1], l0[2], l0[3], h0[0], h0[1], h0[2], h0[3]}, o[d0], 0, 0, 0); \
        o[d0] = __builtin_amdgcn_mfma_f32_32x32x16_bf16(pa1, (bf16x8){l1[0], l1[1], l1[2], l1[3], h1[0], h1[1], h1[2], h1[3]}, o[d0], 0, 0, 0); \
        o[d0] = __builtin_amdgcn_mfma_f32_32x32x16_bf16(pa2, (bf16x8){l2[0], l2[1], l2[2], l2[3], h2[0], h2[1], h2[2], h2[3]}, o[d0], 0, 0, 0); \
        o[d0] = __builtin_amdgcn_mfma_f32_32x32x16_bf16(pa3, (bf16x8){l3[0], l3[1], l3[2], l3[3], h3[0], h3[1], h3[2], h3[3]}, o[d0], 0, 0, 0); } while (0)
    AT_PV_D0(0); AT_PV_D0(1); AT_PV_D0(2); AT_PV_D0(3);
#undef AT_PV_D0
#undef AT_TRRD
}
__device__ __forceinline__ float swap_max(float v) { auto rr = __builtin_amdgcn_permlane32_swap(__float_as_uint(v), __float_as_uint(v), false, false); return fmaxf(__uint_as_float(rr[0]), __uint_as_float(rr[1])); }
__device__ __forceinline__ float swap_sum(float v) { auto rr = __builtin_amdgcn_permlane32_swap(__float_as_uint(v), __float_as_uint(v), false, false); return __uint_as_float(rr[0]) + __uint_as_float(rr[1]); }
__device__ __forceinline__ void pack_p(const f32x16& P, bf16x8& outA, bf16x8& outB) {
#define AT_PK4(B_, OUT) do { unsigned a0 = cvt_pk_bf16(P[B_ + 0], P[B_ + 1]), a1 = cvt_pk_bf16(P[B_ + 2], P[B_ + 3]); \
        unsigned b0 = cvt_pk_bf16(P[B_ + 4], P[B_ + 5]), b1 = cvt_pk_bf16(P[B_ + 6], P[B_ + 7]); \
        auto r0 = __builtin_amdgcn_permlane32_swap(a0, b0, false, false); auto r1 = __builtin_amdgcn_permlane32_swap(a1, b1, false, false); \
        u32x4 w = {r0[0], r1[0], r0[1], r1[1]}; OUT = *reinterpret_cast<bf16x8*>(&w); } while (0)
    AT_PK4(0, outA); AT_PK4(8, outB);
#undef AT_PK4
}
__device__ __forceinline__ float online_sm1(const f32x16& p0, const f32x16& p1, float& m_reg, float& mnL) {
    float pmax = p0[0];
#pragma unroll
    for (int r = 1; r < 16; ++r) pmax = fmaxf(pmax, p0[r]);
#pragma unroll
    for (int r = 0; r < 16; ++r) pmax = fmaxf(pmax, p1[r]);
    pmax = swap_max(pmax);
    float mn, alpha;
    if (__all(pmax - m_reg <= THR)) { mn = m_reg; alpha = 1.f; }
    else { mn = fmaxf(m_reg, pmax); alpha = __builtin_amdgcn_exp2f((m_reg - mn) * LOG2E); m_reg = mn; }
    mnL = -mn * LOG2E;
    return alpha;
}
__device__ __forceinline__ float online_sm1_raw(const f32x16& p0, const f32x16& p1, float& m_reg, float& mnL, float base2) {
    float pmax = p0[0];
#pragma unroll
    for (int r = 1; r < 16; ++r) pmax = fmaxf(pmax, p0[r]);
#pragma unroll
    for (int r = 0; r < 16; ++r) pmax = fmaxf(pmax, p1[r]);
    pmax = fmaf(swap_max(pmax), SCALE, base2);
    float mn, alpha;
    if (__all(pmax - m_reg <= THR)) { mn = m_reg; alpha = 1.f; }
    else { mn = fmaxf(m_reg, pmax); alpha = __builtin_amdgcn_exp2f((m_reg - mn) * LOG2E); m_reg = mn; }
    mnL = (base2 - mn) * LOG2E;
    return alpha;
}
__device__ __forceinline__ void online_sm2_raw(f32x16& p0, f32x16& p1, float mnL, float alpha, float& l_reg) {
    constexpr float C2 = SCALE * LOG2E;
    float ps = 0.f;
#pragma unroll
    for (int r = 0; r < 16; ++r) { p0[r] = __builtin_amdgcn_exp2f(fmaf(p0[r], C2, mnL)); p1[r] = __builtin_amdgcn_exp2f(fmaf(p1[r], C2, mnL)); ps += p0[r] + p1[r]; }
    ps = swap_sum(ps);
    l_reg = l_reg * alpha + ps;
}
__device__ __forceinline__ void online_sm2(f32x16& p0, f32x16& p1, float mnL, float alpha, float& l_reg) {
    float ps = 0.f;
#pragma unroll
    for (int r = 0; r < 16; ++r) { p0[r] = __builtin_amdgcn_exp2f(fmaf(p0[r], LOG2E, mnL)); p1[r] = __builtin_amdgcn_exp2f(fmaf(p1[r], LOG2E, mnL)); ps += p0[r] + p1[r]; }
    ps = swap_sum(ps);
    l_reg = l_reg * alpha + ps;
}
template <int MODE>
__device__ __forceinline__ void branch_loop(f32x16 (&o)[4], float& l_out, LAS unsigned char* lds, const bf16_t* Kp, const bf16_t* Vp, int jlo, int qt,
                                            const bf16x8 (&qr)[8], int tq, float slope, unsigned selbits, int r32, int hi, int sr, int sc, LAS float* wsc, int wave_tmin, int grpB) {
    float m_reg = -1e30f, l_reg = 0.f;
#pragma unroll
    for (int d = 0; d < 4; ++d)
#pragma unroll
        for (int r = 0; r < 16; ++r) o[d][r] = 0.f;
    const int vb0 = (int)(uintptr_t)(lds + OFF_V) + v_rd_base(r32 + 32 * hi);
    const int NT = qt - jlo + 1;
    unsigned xk0w, xk1w, xqw;
    { const float sv = slope * (1.f / SCALE); const bf16_t shi = f2bf(sv), slo = f2bf(sv - bf2f(shi));
      xk0w = hi ? 0u : (unsigned)f2bf((float)r32) * 0x10001u; xk1w = hi ? 0u : (unsigned)f2bf((float)(32 + r32)) * 0x10001u; xqw = hi ? 0u : ((unsigned)shi | ((unsigned)slo << 16)); }
#define AT_LGKM0() asm volatile("s_waitcnt lgkmcnt(0)" ::: "memory")
#define AT_BAR() do { AT_LGKM0(); __builtin_amdgcn_s_barrier(); asm volatile("" ::: "memory"); } while (0)
    Stage S0; stage_load(S0, Kp, Vp, PROJ_LD, jlo * 64, sr, sc); stage_write(S0, lds, 0, sr, sc);
    if (NT > 1) { stage_load(S0, Kp, Vp, PROJ_LD, (jlo + 1) * 64, sr, sc); stage_write(S0, lds, 1, sr, sc); }
    if (NT > 2) stage_load(S0, Kp, Vp, PROJ_LD, (jlo + 2) * 64, sr, sc);
    __syncthreads();
    if (grpB) AT_BAR();
    int buf = 0;
#define AT_STEP(tau, SX) do { \
        const int j = jlo + (tau); \
        f32x16 p0, p1; \
        bf16x8 kx0, kx1, qx; { unsigned t0_ = xk0w, t1_ = xk1w, t2_ = xqw; asm volatile("" : "+v"(t0_), "+v"(t1_), "+v"(t2_)); \
            u32x4 a0_ = {t0_, 0u, 0u, 0u}, a1_ = {t1_, 0u, 0u, 0u}, b0_ = {t2_, 0u, 0u, 0u}; kx0 = *reinterpret_cast<bf16x8*>(&a0_); kx1 = *reinterpret_cast<bf16x8*>(&a1_); qx = *reinterpret_cast<bf16x8*>(&b0_); } \
        qkt<true>(p0, p1, lds + OFF_K + buf * BUF_B, r32, hi, qr, kx0, kx1, qx); \
        const int kbase = j * 64; const int dq = tq - kbase - 4 * hi; \
        const float base2 = slope * (float)(kbase - tq); \
        if (MODE == 1) { \
            const bool on = (selbits >> j) & 1u; \
            if (j == qt) { \
                _Pragma("unroll") for (int r = 0; r < 16; ++r) { const int cc = (r & 3) + 8 * (r >> 2); if (!on || cc > dq) p0[r] = -INFINITY; if (!on || cc + 32 > dq) p1[r] = -INFINITY; } \
            } else if (!__all(on)) { \
                _Pragma("unroll") for (int r = 0; r < 16; ++r) { if (!on) { p0[r] = -INFINITY; p1[r] = -INFINITY; } } \
            } \
        } else { \
            if (kbase + 63 > wave_tmin || kbase < wave_tmin + 31 - (WINDOW - 1)) { \
                _Pragma("unroll") for (int r = 0; r < 16; ++r) { const int cc = (r & 3) + 8 * (r >> 2); \
                    if ((unsigned)(dq - cc) >= (unsigned)WINDOW) p0[r] = -INFINITY; if ((unsigned)(dq - cc - 32) >= (unsigned)WINDOW) p1[r] = -INFINITY; } \
            } \
        } \
        float mnL; const float alpha = online_sm1_raw(p0, p1, m_reg, mnL, base2); \
        AT_BAR(); \
        if ((tau) + 2 < NT) { int b2 = buf + 2; if (b2 >= 3) b2 -= 3; stage_write(SX, lds, b2, sr, sc); } \
        if ((tau) + 3 < NT) stage_load(SX, Kp, Vp, PROJ_LD, (j + 3) * 64, sr, sc); \
        online_sm2_raw(p0, p1, mnL, alpha, l_reg); \
        bf16x8 pa0, pa1, pa2, pa3; pack_p(p0, pa0, pa1); pack_p(p1, pa2, pa3); \
        if (__any(alpha < 1.f)) { if (hi == 0) wsc[r32] = alpha; \
            _Pragma("unroll") for (int r = 0; r < 16; ++r) { const float al = wsc[crow(r, hi)]; \
                _Pragma("unroll") for (int d = 0; d < 4; ++d) o[d][r] *= al; } } \
        pv_tile(o, vb0 + buf * BUF_B, pa0, pa1, pa2, pa3); \
        AT_BAR(); \
        buf = buf + 1; if (buf >= 3) buf = 0; } while (0)
    for (int tau = 0; tau < NT; ++tau) { AT_STEP(tau, S0); }
#undef AT_STEP
    if (!grpB) AT_BAR();
#undef AT_BAR
#undef AT_LGKM0
    l_out = l_reg;
    __syncthreads();
}
}

__device__ __forceinline__ void attn_fast_unit(const Frame& F, const Args& a, int unit) {
    using namespace at;
    unsigned char* ws = F.ws; const bf16_t* PROJ = (const bf16_t*)(ws + WS_PROJ); bf16_t* YM = (bf16_t*)(ws + WS_YMIX);
    LAS unsigned char* lds = F.lds;
    const int qt = 31 - (unit >> 4), bg = unit & 15, b = bg >> 1, g = bg & 1;
    int tz = threadIdx.x; asm volatile("" : "+v"(tz));
    const int lane = tz & 63, r32 = lane & 31, hi = lane >> 5, head = F.wid & 3, qh = F.wid >> 2;
    const int t0 = qt * 64, tq = t0 + qh * 32 + r32, wave_tmin = t0 + qh * 32;
    const int sr = tz >> 4, sc = (tz & 15) * 8;
    const float slope = exp2f(-(float)(g * 4 + head + 1));
    LAS float* wsc = (LAS float*)(lds + OFF_WSC) + F.wid * 256;
    LAS float* imph = (LAS float*)(lds + OFF_IMP);
    LAS unsigned* selm = (LAS unsigned*)(lds + OFF_SELM);
    bf16x8 qr[8];
    { const bf16_t* qp = PROJ + (size_t)(b * SEQ + tq) * PROJ_LD + C_NQ + (g * 4 + head) * 128 + hi * 8;
#pragma unroll
      for (int d0 = 0; d0 < 8; ++d0) qr[d0] = *(const bf16x8*)(qp + d0 * 16); }
    float gate[3];
    { const bf16_t* gp = PROJ + (size_t)(b * SEQ + tq) * PROJ_LD + C_NGT + (g * 4 + head) * 3;
#pragma unroll
      for (int c = 0; c < 3; ++c) gate[c] = sigmoidf_(bf2f(gp[c])); }
    f32x16 o[4];
    float* otp = (float*)(ws + WS_OT) + ((size_t)F.bid * 512 + tz) * 64;
    { const bf16_t* Kc = (const bf16_t*)(ws + WS_KC) + (size_t)bg * 128 * 128; const bf16_t* Vc = (const bf16_t*)(ws + WS_VC) + (size_t)bg * 128 * 128;
      Stage S; stage_load(S, Kc, Vc, 128, 0, sr, sc); stage_write(S, lds, 0, sr, sc);
      stage_load(S, Kc, Vc, 128, 64, sr, sc); stage_write(S, lds, 1, sr, sc);
      __syncthreads();
      f32x16 p0, p1, p2, p3;
      qkt(p0, p1, lds + OFF_K, r32, hi, qr); qkt(p2, p3, lds + OFF_K + BUF_B, r32, hi, qr);
      const int dl0 = ((tq - 31) >> 4) - 4 * hi;
      const float base_f = slope * (float)(16 * 4 * hi + 31 - tq);
      float mx = -INFINITY;
#pragma unroll
      for (int r = 0; r < 16; ++r) { const int cc = (r & 3) + 8 * (r >> 2);
          p0[r] = (cc <= dl0)      ? fmaf(p0[r], SCALE, fmaf(slope, (float)(16 * cc), base_f))        : -INFINITY;
          p1[r] = (cc + 32 <= dl0) ? fmaf(p1[r], SCALE, fmaf(slope, (float)(16 * (cc + 32)), base_f)) : -INFINITY;
          p2[r] = (cc + 64 <= dl0) ? fmaf(p2[r], SCALE, fmaf(slope, (float)(16 * (cc + 64)), base_f)) : -INFINITY;
          p3[r] = (cc + 96 <= dl0) ? fmaf(p3[r], SCALE, fmaf(slope, (float)(16 * (cc + 96)), base_f)) : -INFINITY;
          mx = fmaxf(fmaxf(mx, p0[r]), fmaxf(p1[r], fmaxf(p2[r], p3[r]))); }
      mx = swap_max(mx);
      const float mL = (mx == -INFINITY) ? 0.f : -mx * LOG2E;
      float ps = 0.f;
#pragma unroll
      for (int r = 0; r < 16; ++r) { p0[r] = __builtin_amdgcn_exp2f(fmaf(p0[r], LOG2E, mL)); p1[r] = __builtin_amdgcn_exp2f(fmaf(p1[r], LOG2E, mL));
          p2[r] = __builtin_amdgcn_exp2f(fmaf(p2[r], LOG2E, mL)); p3[r] = __builtin_amdgcn_exp2f(fmaf(p3[r], LOG2E, mL)); ps += (p0[r] + p1[r]) + (p2[r] + p3[r]); }
      ps = swap_sum(ps);
      const float inv = ps > 0.f ? 1.f / ps : 0.f;
#pragma unroll
      for (int r = 0; r < 16; ++r) { p0[r] *= inv; p1[r] *= inv; p2[r] *= inv; p3[r] *= inv; }
      { LAS float* dst = imph + ((size_t)head * 64 + qh * 32 + r32) * 32;
        float prev = 0.f;
#define AT_GRP(P, blk) do { _Pragma("unroll") for (int i = 0; i < 4; ++i) { const float av = 2.f * (P[4 * i] + P[4 * i + 1] + P[4 * i + 2]) + P[4 * i + 3]; const float bv = P[4 * i + 3]; \
            auto rr = __builtin_amdgcn_permlane32_swap(__float_as_uint(bv), __float_as_uint(bv), false, false); const float pb = __uint_as_float(hi ? rr[0] : rr[1]); \
            dst[2 * ((blk) * 4 + i) + hi] = av + (hi ? pb : prev); prev = pb; } } while (0)
        AT_GRP(p0, 0); AT_GRP(p1, 1); AT_GRP(p2, 2); AT_GRP(p3, 3);
#undef AT_GRP
      }
      bf16x8 pa0, pa1, pa2, pa3;
#pragma unroll
      for (int d = 0; d < 4; ++d)
#pragma unroll
          for (int r = 0; r < 16; ++r) o[d][r] = 0.f;
      const int vb0 = (int)(uintptr_t)(lds + OFF_V) + v_rd_base(lane);
      pack_p(p0, pa0, pa1); pack_p(p1, pa2, pa3); pv_tile(o, vb0, pa0, pa1, pa2, pa3);
      pack_p(p2, pa0, pa1); pack_p(p3, pa2, pa3); pv_tile(o, vb0 + BUF_B, pa0, pa1, pa2, pa3);
      if (hi == 0) wsc[r32] = gate[0];
#pragma unroll
      for (int r = 0; r < 16; ++r) { const float f = wsc[crow(r, hi)];
#pragma unroll
          for (int d = 0; d < 4; ++d) o[d][r] *= f; }
#pragma unroll
      for (int d = 0; d < 4; ++d)
#pragma unroll
          for (int k = 0; k < 4; ++k) *(f32x4*)(otp + d * 16 + 4 * k) = (f32x4){o[d][4 * k], o[d][4 * k + 1], o[d][4 * k + 2], o[d][4 * k + 3]};
    }
    __syncthreads();
    { const int q = tz >> 3, part = tz & 7, tqq = t0 + q, cur = tqq >> 6;
      unsigned bits = 0u;
      if (cur < SEL_TOP) { bits = (part == 0) ? ((2u << cur) - 1u) : 0u; }
      else {
          float sc_[4];
#pragma unroll
          for (int k = 0; k < 4; ++k) { const int j = part * 4 + k; const float v = ((imph[(0 * 64 + q) * 32 + j] + imph[(1 * 64 + q) * 32 + j]) + imph[(2 * 64 + q) * 32 + j]) + imph[(3 * 64 + q) * 32 + j];
              const bool forced = (j == 0) || (j == cur) || (j == cur - 1); sc_[k] = forced ? 1e4f : (j <= cur ? v : -1e4f); }
          int rank[4] = {0, 0, 0, 0};
          for (int jj = 0; jj < 32; ++jj) { const float v = ((imph[(0 * 64 + q) * 32 + jj] + imph[(1 * 64 + q) * 32 + jj]) + imph[(2 * 64 + q) * 32 + jj]) + imph[(3 * 64 + q) * 32 + jj];
              const bool forced = (jj == 0) || (jj == cur) || (jj == cur - 1); const float s2 = forced ? 1e4f : (jj <= cur ? v : -1e4f);
#pragma unroll
              for (int k = 0; k < 4; ++k) { const int j = part * 4 + k; rank[k] += (s2 > sc_[k] || (s2 == sc_[k] && jj < j)) ? 1 : 0; } }
#pragma unroll
          for (int k = 0; k < 4; ++k) { const int j = part * 4 + k; if (rank[k] < SEL_TOP && j <= cur) bits |= 1u << j; }
      }
      bits |= __shfl_xor(bits, 1); bits |= __shfl_xor(bits, 2); bits |= __shfl_xor(bits, 4);
      if (part == 0) selm[q] = bits; }
    __syncthreads();
    const unsigned selbits = selm[qh * 32 + r32];
    { float l_sel;
      branch_loop<1>(o, l_sel, lds, PROJ + (size_t)(b * SEQ) * PROJ_LD + C_KSL + g * 128, PROJ + (size_t)(b * SEQ) * PROJ_LD + C_VSL + g * 128, 0, qt, qr, tq, slope, selbits, r32, hi, sr, sc, wsc, wave_tmin, qh);
      if (hi == 0) wsc[r32] = gate[1] / l_sel;
#pragma unroll
      for (int r = 0; r < 16; ++r) { const float f = wsc[crow(r, hi)];
#pragma unroll
          for (int d = 0; d < 4; ++d) o[d][r] *= f; }
#pragma unroll
      for (int d = 0; d < 4; ++d)
#pragma unroll
          for (int k = 0; k < 4; ++k) { const f32x4 pv = *(const f32x4*)(otp + d * 16 + 4 * k); *(f32x4*)(otp + d * 16 + 4 * k) = pv + (f32x4){o[d][4 * k], o[d][4 * k + 1], o[d][4 * k + 2], o[d][4 * k + 3]}; } }
    { float l_win; const int jlo = (t0 - (WINDOW - 1)) > 0 ? (t0 - (WINDOW - 1)) >> 6 : 0;
      branch_loop<2>(o, l_win, lds, PROJ + (size_t)(b * SEQ) * PROJ_LD + C_KWN + g * 128, PROJ + (size_t)(b * SEQ) * PROJ_LD + C_VWN + g * 128, jlo, qt, qr, tq, slope, 0u, r32, hi, sr, sc, wsc, wave_tmin, qh);
      if (hi == 0) wsc[r32] = gate[2] / l_win;
#pragma unroll
      for (int r = 0; r < 16; ++r) { const float f = wsc[crow(r, hi)];
#pragma unroll
          for (int d = 0; d < 4; ++d) o[d][r] *= f; }
#pragma unroll
      for (int d = 0; d < 4; ++d)
#pragma unroll
          for (int k = 0; k < 4; ++k) { const f32x4 pv = *(const f32x4*)(otp + d * 16 + 4 * k); o[d][4 * k] += pv[0]; o[d][4 * k + 1] += pv[1]; o[d][4 * k + 2] += pv[2]; o[d][4 * k + 3] += pv[3]; } }
    { const float* ng = a.in[I_NSAG];
      float gsc[4];
#pragma unroll
      for (int d = 0; d < 4; ++d) gsc[d] = ng[d * 32 + r32];
#pragma unroll
      for (int r = 0; r < 16; ++r) { float ss = 0.f;
#pragma unroll
          for (int d = 0; d < 4; ++d) ss += o[d][r] * o[d][r];
          ss += __shfl_xor(ss, 1); ss += __shfl_xor(ss, 2); ss += __shfl_xor(ss, 4); ss += __shfl_xor(ss, 8); ss += __shfl_xor(ss, 16);
          const float rs = rsqrtf(ss * (1.f / 128.f) + EPS);
          const int row = b * SEQ + t0 + qh * 32 + crow(r, hi);
          bf16_t* yp = YM + (size_t)row * DM + HG_W + (g * 4 + head) * 128 + r32;
#pragma unroll
          for (int d = 0; d < 4; ++d) yp[d * 32] = f2bf(o[d][r] * rs * gsc[d]); } }
    __syncthreads();
}

namespace hg {
constexpr int T_KD = 0, T_QD = 16384, T_V = 32768, T_KL = 49152, T_FR = 65536, T_QR = 81920, T_OR = 98304, T_PART = 114688, T_DL = T_PART + 2048, T_SSQ = T_DL + 512;
}
__device__ __forceinline__ void hgrn_fast_unit(const Frame& F, const Args& a, int unit) {
    using namespace hg; using at::crow; using at::v_st; using at::v_rd_base; typedef at::s16x4 s16x4;
    unsigned char* ws = F.ws; const bf16_t* PROJ = (const bf16_t*)(ws + WS_PROJ); bf16_t* YM = (bf16_t*)(ws + WS_YMIX);
    LAS unsigned char* lds = F.lds;
    const int b = unit >> 3, h = unit & 7;
    int tz = threadIdx.x; asm volatile("" : "+v"(tz));
    const int lane = tz & 63, r32 = lane & 31, hi = lane >> 5, th = F.wid & 1, vq = F.wid >> 1;
    const int lr = tz >> 4, lc = (tz & 15) * 8;
    const int kc = tz & 127, tg = tz >> 7;
    LAS float* part = (LAS float*)(lds + T_PART); LAS float* dl = (LAS float*)(lds + T_DL); LAS float* ssq = (LAS float*)(lds + T_SSQ);
    f32x16 Sacc[4];
#pragma unroll
    for (int k = 0; k < 4; ++k)
#pragma unroll
        for (int r = 0; r < 16; ++r) Sacc[k][r] = 0.f;
    const bf16_t* base = PROJ + (size_t)(b * SEQ) * PROJ_LD + h * 128;
    u32x4 rf0, rf1, rq0, rq1, ri0, ri1, ro0, ro1;
    const bf16_t* obase = (const bf16_t*)(ws + WS_OMF) + (size_t)(b * SEQ) * HG_W + h * 128;
#define HG_LOAD(t0_) do { const bf16_t* p0_ = base + (size_t)((t0_) + lr) * PROJ_LD + lc; const bf16_t* p1_ = p0_ + (size_t)32 * PROJ_LD; \
        rf0 = *(const u32x4*)(p0_ + C_HF); rf1 = *(const u32x4*)(p1_ + C_HF); rq0 = *(const u32x4*)(p0_ + C_HQ); rq1 = *(const u32x4*)(p1_ + C_HQ); \
        ri0 = *(const u32x4*)(p0_ + C_HI); ri1 = *(const u32x4*)(p1_ + C_HI); \
        ro0 = *(const u32x4*)(obase + (size_t)((t0_) + lr) * HG_W + lc); ro1 = *(const u32x4*)(obase + (size_t)((t0_) + lr + 32) * HG_W + lc); } while (0)
    HG_LOAD(0);
    const float ngv = a.in[I_HGNG][vq * 32 + r32];
    for (int c = 0; c < SEQ / 64; ++c) {
        const int t0 = c * 64;
        *(LAS u32x4*)(lds + T_FR + lr * 256 + lc * 2) = rf0; *(LAS u32x4*)(lds + T_FR + (lr + 32) * 256 + lc * 2) = rf1;
        *(LAS u32x4*)(lds + T_QR + lr * 256 + lc * 2) = rq0; *(LAS u32x4*)(lds + T_QR + (lr + 32) * 256 + lc * 2) = rq1;
        *(LAS u32x4*)(lds + T_OR + lr * 256 + lc * 2) = ro0; *(LAS u32x4*)(lds + T_OR + (lr + 32) * 256 + lc * 2) = ro1;
        *(LAS u32x4*)(lds + T_V + v_st(lr, lc)) = ri0; *(LAS u32x4*)(lds + T_V + v_st(lr + 32, lc)) = ri1;
        __syncthreads();
        float lf[16]; float run = 0.f;
#pragma unroll
        for (int i = 0; i < 16; ++i) { const int t = tg * 16 + i; run += bf2f(*(const LAS bf16_t*)(lds + T_FR + t * 256 + kc * 2)); lf[i] = run; }
        part[tg * 128 + kc] = run;
        __syncthreads();
        { const float p0_ = part[kc], p1_ = part[128 + kc], p2_ = part[256 + kc], p3_ = part[384 + kc];
          const float pre = (tg > 0 ? p0_ : 0.f) + (tg > 1 ? p1_ : 0.f) + (tg > 2 ? p2_ : 0.f); const float tot = ((p0_ + p1_) + p2_) + p3_;
          const float dlast = __builtin_amdgcn_exp2f(tot);
          if (tg == 0) dl[kc] = dlast;
#pragma unroll
          for (int i = 0; i < 16; ++i) { const int t = tg * 16 + i; const float bb = pre + lf[i];
              const float qv = bf2f(*(const LAS bf16_t*)(lds + T_QR + t * 256 + kc * 2)), om = bf2f(*(const LAS bf16_t*)(lds + T_OR + t * 256 + kc * 2));
              const float qd = qv * __builtin_amdgcn_exp2f(bb), kd = om * __builtin_amdgcn_exp2f(-bb), kl = kd * dlast;
              const int ko = AT_KSWZ(t, kc * 2);
              *(LAS bf16_t*)(lds + T_QD + ko) = f2bf(qd); *(LAS bf16_t*)(lds + T_KD + ko) = f2bf(kd); *(LAS bf16_t*)(lds + T_KL + v_st(t, kc)) = f2bf(kl); } }
        __syncthreads();
        if (c + 1 < SEQ / 64) HG_LOAD(t0 + 64);
        const int tl = th * 32 + r32;
        bf16x8 qr[8];
#pragma unroll
        for (int d0 = 0; d0 < 8; ++d0) qr[d0] = *(const LAS bf16x8*)(lds + T_QD + AT_KSWZ(tl, (d0 * 16 + hi * 8) * 2));
        f32x16 p0, p1;
        at::qkt(p0, p1, lds + T_KD, r32, hi, qr);
#pragma unroll
        for (int r = 0; r < 16; ++r) { const int s = crow(r, hi); if (s > tl) p0[r] = 0.f; if (s + 32 > tl) p1[r] = 0.f; }
        bf16x8 pa0, pa1, pa2, pa3; at::pack_p(p0, pa0, pa1); at::pack_p(p1, pa2, pa3);
        f32x16 o;
#pragma unroll
        for (int r = 0; r < 16; ++r) o[r] = 0.f;
        const int vb = (int)(uintptr_t)(lds + T_V) + v_rd_base(lane) + vq * 512;
        const int klb = (int)(uintptr_t)(lds + T_KL) + v_rd_base(lane);
#define HG_TRRD(dst, addr, off) asm volatile("ds_read_b64_tr_b16 %0, %1 offset:%2" : "=&v"(dst) : "v"(addr), "i"(off) : "memory")
        s16x4 vl0, vh0, vl1, vh1, vl2, vh2, vl3, vh3;
        HG_TRRD(vl0, vb, 0); HG_TRRD(vh0, vb, 2048); HG_TRRD(vl1, vb, 4096); HG_TRRD(vh1, vb, 6144); HG_TRRD(vl2, vb, 8192); HG_TRRD(vh2, vb, 10240); HG_TRRD(vl3, vb, 12288); HG_TRRD(vh3, vb, 14336);
        asm volatile("s_waitcnt lgkmcnt(0)" ::: "memory"); __builtin_amdgcn_sched_barrier(0);
        const bf16x8 vf0 = (bf16x8){vl0[0], vl0[1], vl0[2], vl0[3], vh0[0], vh0[1], vh0[2], vh0[3]}, vf1 = (bf16x8){vl1[0], vl1[1], vl1[2], vl1[3], vh1[0], vh1[1], vh1[2], vh1[3]};
        const bf16x8 vf2 = (bf16x8){vl2[0], vl2[1], vl2[2], vl2[3], vh2[0], vh2[1], vh2[2], vh2[3]}, vf3 = (bf16x8){vl3[0], vl3[1], vl3[2], vl3[3], vh3[0], vh3[1], vh3[2], vh3[3]};
        o = __builtin_amdgcn_mfma_f32_32x32x16_bf16(pa0, vf0, o, 0, 0, 0); o = __builtin_amdgcn_mfma_f32_32x32x16_bf16(pa1, vf1, o, 0, 0, 0);
        o = __builtin_amdgcn_mfma_f32_32x32x16_bf16(pa2, vf2, o, 0, 0, 0); o = __builtin_amdgcn_mfma_f32_32x32x16_bf16(pa3, vf3, o, 0, 0, 0);
#pragma unroll
        for (int kb = 0; kb < 4; ++kb)
#pragma unroll
            for (int sp = 0; sp < 2; ++sp) {
                const u32x2 a_lo = *(const LAS u32x2*)(lds + T_QD + tl * 256 + ((((4 * kb + 2 * sp) * 16)) ^ ((tl & 7) << 4)) + 8 * hi);
                const u32x2 a_hi = *(const LAS u32x2*)(lds + T_QD + tl * 256 + ((((4 * kb + 2 * sp + 1) * 16)) ^ ((tl & 7) << 4)) + 8 * hi);
                u32x4 aw = {a_lo[0], a_lo[1], a_hi[0], a_hi[1]};
                u32x4 bw = {cvt_pk_bf16(Sacc[kb][8 * sp + 0], Sacc[kb][8 * sp + 1]), cvt_pk_bf16(Sacc[kb][8 * sp + 2], Sacc[kb][8 * sp + 3]),
                            cvt_pk_bf16(Sacc[kb][8 * sp + 4], Sacc[kb][8 * sp + 5]), cvt_pk_bf16(Sacc[kb][8 * sp + 6], Sacc[kb][8 * sp + 7])};
                o = __builtin_amdgcn_mfma_f32_32x32x16_bf16(*reinterpret_cast<bf16x8*>(&aw), *reinterpret_cast<bf16x8*>(&bw), o, 0, 0, 0); }
        float gt[16];
#pragma unroll
        for (int r = 0; r < 16; ++r) gt[r] = bf2f(base[(size_t)(t0 + th * 32 + crow(r, hi)) * PROJ_LD + C_HGT + vq * 32 + r32]);
#define HG_SUPD(kb) do { \
            _Pragma("unroll") for (int i4 = 0; i4 < 4; ++i4) { const f32x4 dv = *(const LAS f32x4*)(dl + (kb) * 32 + 8 * i4 + 4 * hi); \
                Sacc[kb][4 * i4] *= dv[0]; Sacc[kb][4 * i4 + 1] *= dv[1]; Sacc[kb][4 * i4 + 2] *= dv[2]; Sacc[kb][4 * i4 + 3] *= dv[3]; } \
            s16x4 al0, ah0, al1, ah1, al2, ah2, al3, ah3; \
            HG_TRRD(al0, klb, (kb) * 512); HG_TRRD(ah0, klb, (kb) * 512 + 2048); HG_TRRD(al1, klb, (kb) * 512 + 4096); HG_TRRD(ah1, klb, (kb) * 512 + 6144); \
            HG_TRRD(al2, klb, (kb) * 512 + 8192); HG_TRRD(ah2, klb, (kb) * 512 + 10240); HG_TRRD(al3, klb, (kb) * 512 + 12288); HG_TRRD(ah3, klb, (kb) * 512 + 14336); \
            asm volatile("s_waitcnt lgkmcnt(0)" ::: "memory"); __builtin_amdgcn_sched_barrier(0); \
            Sacc[kb] = __builtin_amdgcn_mfma_f32_32x32x16_bf16((bf16x8){al0[0], al0[1], al0[2], al0[3], ah0[0], ah0[1], ah0[2], ah0[3]}, vf0, Sacc[kb], 0, 0, 0); \
            Sacc[kb] = __builtin_amdgcn_mfma_f32_32x32x16_bf16((bf16x8){al1[0], al1[1], al1[2], al1[3], ah1[0], ah1[1], ah1[2], ah1[3]}, vf1, Sacc[kb], 0, 0, 0); \
            Sacc[kb] = __builtin_amdgcn_mfma_f32_32x32x16_bf16((bf16x8){al2[0], al2[1], al2[2], al2[3], ah2[0], ah2[1], ah2[2], ah2[3]}, vf2, Sacc[kb], 0, 0, 0); \
            Sacc[kb] = __builtin_amdgcn_mfma_f32_32x32x16_bf16((bf16x8){al3[0], al3[1], al3[2], al3[3], ah3[0], ah3[1], ah3[2], ah3[3]}, vf3, Sacc[kb], 0, 0, 0); } while (0)
        HG_SUPD(0); HG_SUPD(1); HG_SUPD(2); HG_SUPD(3);
#undef HG_SUPD
#undef HG_TRRD
        { float y8[8], y4[4], y2[2], y1;
          const bool b4 = (r32 & 16) != 0, b3 = (r32 & 8) != 0, b2 = (r32 & 4) != 0, b1 = (r32 & 2) != 0;
#pragma unroll
          for (int i = 0; i < 8; ++i) { const float lo = o[i] * o[i], hi_ = o[8 + i] * o[8 + i]; const float keep = b4 ? hi_ : lo, send = b4 ? lo : hi_; y8[i] = keep + __shfl_xor(send, 16); }
#pragma unroll
          for (int i = 0; i < 4; ++i) { const float keep = b3 ? y8[4 + i] : y8[i], send = b3 ? y8[i] : y8[4 + i]; y4[i] = keep + __shfl_xor(send, 8); }
#pragma unroll
          for (int i = 0; i < 2; ++i) { const float keep = b2 ? y4[2 + i] : y4[i], send = b2 ? y4[i] : y4[2 + i]; y2[i] = keep + __shfl_xor(send, 4); }
          { const float keep = b1 ? y2[1] : y2[0], send = b1 ? y2[0] : y2[1]; y1 = keep + __shfl_xor(send, 2); }
          y1 += __shfl_xor(y1, 1);
          const int rf = ((r32 >> 1) & 15);
          if ((r32 & 1) == 0) ssq[vq * 64 + th * 32 + crow(rf, hi)] = y1; }
        __syncthreads();
        { bf16_t* yb = YM + (size_t)(b * SEQ + t0 + th * 32) * DM + h * 128 + vq * 32;
          const unsigned loff = (unsigned)(4 * hi) * DM + (unsigned)r32;
#pragma unroll
          for (int r = 0; r < 16; ++r) { const int tc = (r & 3) + 8 * (r >> 2); const int t = th * 32 + tc + 4 * hi; const float ss = ((ssq[t] + ssq[64 + t]) + ssq[128 + t]) + ssq[192 + t];
              const float rs = rsqrtf(ss * (1.f / 128.f) + EPS);
              (yb + (size_t)tc * DM)[loff] = f2bf(o[r] * rs * ngv * gt[r]); } }
    }
#undef HG_LOAD
    __syncthreads();
}

__device__ __forceinline__ void compress_fast_unit(const Frame& F, const Args& a, int u) {
    unsigned char* ws = F.ws; const bf16_t* PROJ = (const bf16_t*)(ws + WS_PROJ); LAS unsigned char* lds = F.lds;
    const int j = u >> 6, bg = (u >> 2) & 15, mt = u & 3, b = bg >> 1, g = bg & 1;
    int tz = threadIdx.x; asm volatile("" : "+v"(tz));
    const int lane = tz & 63, r32 = lane & 31, hi = lane >> 5, w = F.wid;
    const int n = mt * 32 + r32, nl = n < 126 ? n : 126;
    const bf16_t* W2T = (const bf16_t*)(ws + WS_W2T) + (size_t)j * 128 * 128;
    const int colb = (j ? C_VCM : C_KCM) + g * 128;
    const bf16_t* arow = PROJ + (size_t)(b * SEQ + 16 * nl) * PROJ_LD + colb + hi * 8;
    const bf16_t* bfrag = (const bf16_t*)(ws + WS_W1T) + ((size_t)(j * 8 + w) * 32 * 4 * 64 + lane) * 8;
    f32x16 acc[4];
#pragma unroll
    for (int c = 0; c < 4; ++c)
#pragma unroll
        for (int r = 0; r < 16; ++r) acc[c][r] = 0.f;
#pragma unroll 4
    for (int ks = 0; ks < 32; ++ks) {
        const int l = 4 * w + (ks >> 3), d = (ks & 7) * 16;
        const bf16x8 af = *(const bf16x8*)(arow + (size_t)l * PROJ_LD + d);
#pragma unroll
        for (int c = 0; c < 4; ++c) { const bf16x8 bfr = *(const bf16x8*)(bfrag + (size_t)(ks * 4 + c) * 64 * 8);
            acc[c] = __builtin_amdgcn_mfma_f32_32x32x16_bf16(af, bfr, acc[c], 0, 0, 0); }
    }
    LAS float* red = (LAS float*)lds;
#pragma unroll
    for (int c = 0; c < 4; ++c)
#pragma unroll
        for (int r = 0; r < 16; ++r) red[(w * 32 + at::crow(r, hi)) * 128 + c * 32 + r32] = acc[c][r];
    __syncthreads();
    LAS unsigned char* hdn = lds + 131072 - 8192;
    { const int nn = tz >> 4, c8 = (tz & 15) * 8; float sv[8];
      const float* b1 = (const float*)(ws + WS_B1P) + (size_t)j * 32 * 128 + c8;
#pragma unroll
      for (int i = 0; i < 8; ++i) sv[i] = 0.f;
#pragma unroll 4
      for (int kg = 0; kg < 32; ++kg) { const f32x4 x0 = *(const f32x4*)(b1 + kg * 128), x1 = *(const f32x4*)(b1 + kg * 128 + 4);
#pragma unroll
          for (int i = 0; i < 4; ++i) { sv[i] += x0[i]; sv[4 + i] += x1[i]; } }
#pragma unroll
      for (int ww = 0; ww < 8; ++ww) { const f32x4 x0 = *(const LAS f32x4*)(red + (ww * 32 + nn) * 128 + c8), x1 = *(const LAS f32x4*)(red + (ww * 32 + nn) * 128 + c8 + 4);
#pragma unroll
          for (int i = 0; i < 4; ++i) { sv[i] += x0[i]; sv[4 + i] += x1[i]; } }
      __syncthreads();
#pragma unroll
      for (int i = 0; i < 8; ++i) sv[i] = gelu_tanh(sv[i]);
      u32x4 pw; pw[0] = cvt_pk_bf16(sv[0], sv[1]); pw[1] = cvt_pk_bf16(sv[2], sv[3]); pw[2] = cvt_pk_bf16(sv[4], sv[5]); pw[3] = cvt_pk_bf16(sv[6], sv[7]);
      *(LAS u32x4*)(hdn + AT_KSWZ(nn, c8 * 2)) = pw; }
    __syncthreads();
    if (w < 4) {
        f32x16 o2;
#pragma unroll
        for (int r = 0; r < 16; ++r) o2[r] = 0.f;
#pragma unroll
        for (int ks = 0; ks < 8; ++ks) { const bf16x8 af = *(const LAS bf16x8*)(hdn + AT_KSWZ(r32, (ks * 16 + hi * 8) * 2));
            const bf16x8 bfr = *(const bf16x8*)(W2T + (size_t)(w * 32 + r32) * 128 + ks * 16 + hi * 8);
            o2 = __builtin_amdgcn_mfma_f32_32x32x16_bf16(af, bfr, o2, 0, 0, 0); }
        bf16_t* dst = (bf16_t*)(ws + (DEBUG_CMP ? (j ? WS_Y + 1048576 : WS_Y) : (j ? WS_VC : WS_KC))) + (size_t)bg * 128 * 128;
#pragma unroll
        for (int r = 0; r < 16; ++r) { const int nn = mt * 32 + at::crow(r, hi); dst[(size_t)nn * 128 + w * 32 + r32] = (nn < NCMP) ? f2bf(o2[r]) : (bf16_t)0; }
    }
    __syncthreads();
}

__device__ __forceinline__ void p5_router(const Frame& F, const Args& a) {
    unsigned char* ws = F.ws; const bf16_t* H1 = (const bf16_t*)(ws + WS_H1); unsigned char* XN = ws + WS_U;
    const float* wr2 = (const float*)(ws + WS_WR2); const float* g2 = a.in[I_N2G]; const float* br = a.in[I_BR];
    float* tokw = (float*)(ws + WS_TOKW); int* slot = (int*)(ws + WS_SLOT); unsigned* cnt = F.ctl + CW_CNT;
    constexpr int HS_LD = 4104;
    LAS unsigned char* hs = F.lds; LAS float* rsv = (LAS float*)(F.lds + 32 * HS_LD); LAS float* red = (LAS float*)F.lds;
    LAS unsigned* lcnt = (LAS unsigned*)(F.lds + 32 * HS_LD + 256); LAS unsigned* lbase = lcnt + 32;
    if (F.tid < 32) lcnt[F.tid] = 0u;
    int myexp[2] = {0, 0}, myrank[2] = {0, 0};
    __syncthreads();
    for (int it = F.bid; it < NTOK / 32; it += F.G) {
#pragma unroll
        for (int rr = 0; rr < 4; ++rr) { const int tl = F.wid * 4 + rr, row = it * 32 + tl;
            const bf16_t* hr = H1 + (size_t)row * DM; u32x4 hw[4]; float ss = 0.f;
#pragma unroll
            for (int i = 0; i < 4; ++i) { hw[i] = *(const u32x4*)(hr + i * 512 + F.lane * 8); float hf[8]; unpack8(hw[i], hf);
#pragma unroll
                for (int j = 0; j < 8; ++j) ss += hf[j] * hf[j]; }
            ss = wave_sum(ss); const float rs = rsqrtf(ss * (1.f / DM) + EPS);
            if (F.lane == 0) rsv[tl] = rs;
#pragma unroll
            for (int i = 0; i < 4; ++i) { const f32x4 g0 = *(const f32x4*)(g2 + i * 512 + F.lane * 8), g1 = *(const f32x4*)(g2 + i * 512 + F.lane * 8 + 4);
                float hf[8]; unpack8(hw[i], hf);
                const f32x4 a0 = (f32x4){hf[0], hf[1], hf[2], hf[3]} * rs * g0, a1 = (f32x4){hf[4], hf[5], hf[6], hf[7]} * rs * g1;
                u32x2 w; w[0] = cvt4_fp8(a0[0], a0[1], a0[2], a0[3]); w[1] = cvt4_fp8(a1[0], a1[1], a1[2], a1[3]);
                *(u32x2*)(XN + (size_t)row * DM + i * 512 + F.lane * 8) = w;
                LAS unsigned char* hp = hs + tl * HS_LD + (i * 512 + F.lane * 8) * 2;
                *(LAS u32x2*)hp = (u32x2){hw[i][0], hw[i][1]}; *(LAS u32x2*)(hp + 8) = (u32x2){hw[i][2], hw[i][3]}; } }
        __syncthreads();
        f32x4 c00 = {0.f, 0.f, 0.f, 0.f}, c01 = c00, c10 = c00, c11 = c00;
        { const int ti = F.lane & 15, kq = F.lane >> 4, kb = F.wid * 256 + kq;
          const LAS unsigned char* ha = hs + ti * HS_LD + kb * 2; const float* wb = wr2 + (size_t)kb * 32 + ti;
#pragma unroll 16
          for (int s_ = 0; s_ < 64; ++s_) {
              const float a0 = bf2f(*(const LAS bf16_t*)(ha + s_ * 8)), a1 = bf2f(*(const LAS bf16_t*)(ha + 16 * HS_LD + s_ * 8));
              const float b0 = wb[(size_t)s_ * 128], b1 = wb[(size_t)s_ * 128 + 16];
              c00 = __builtin_amdgcn_mfma_f32_16x16x4f32(a0, b0, c00, 0, 0, 0); c01 = __builtin_amdgcn_mfma_f32_16x16x4f32(a0, b1, c01, 0, 0, 0);
              c10 = __builtin_amdgcn_mfma_f32_16x16x4f32(a1, b0, c10, 0, 0, 0); c11 = __builtin_amdgcn_mfma_f32_16x16x4f32(a1, b1, c11, 0, 0, 0); } }
        float rsl[2];
        rsl[0] = rsv[F.tid >> 5]; rsl[1] = rsv[16 + (F.tid >> 5)];
        __syncthreads();
        { const int cj = F.lane & 15, rq = (F.lane >> 4) * 4; LAS float* rw = red + F.wid * 1024;
#pragma unroll
          for (int r = 0; r < 4; ++r) { rw[(rq + r) * 32 + cj] = c00[r]; rw[(rq + r) * 32 + 16 + cj] = c01[r]; rw[(16 + rq + r) * 32 + cj] = c10[r]; rw[(16 + rq + r) * 32 + 16 + cj] = c11[r]; } }
        __syncthreads();
#pragma unroll
        for (int ps = 0; ps < 2; ++ps) {
            const int tl = ps * 16 + (F.tid >> 5), e = F.tid & 31, row = it * 32 + tl;
            float acc = 0.f;
#pragma unroll
            for (int w = 0; w < 8; ++w) acc += red[w * 1024 + tl * 32 + e];
            const float logit = acc * rsl[ps] + br[e];
            float tv[4]; int ti[4]; float cur = logit;
#pragma unroll
            for (int k = 0; k < 4; ++k) { float bv = cur; int bi = e;
#pragma unroll
                for (int o = 16; o > 0; o >>= 1) { const float ov = __shfl_xor(bv, o); const int oi = __shfl_xor(bi, o); if (ov > bv || (ov == bv && oi < bi)) { bv = ov; bi = oi; } }
                tv[k] = bv; ti[k] = bi; if (e == bi) cur = -INFINITY; }
            const float m = tv[0]; const float e0 = 1.f, e1 = __expf(tv[1] - m), e2 = __expf(tv[2] - m), e3 = __expf(tv[3] - m); const float inv = 1.f / (e0 + e1 + e2 + e3);
            if (e < 4) { const int k = e; const int ee = k == 0 ? ti[0] : k == 1 ? ti[1] : k == 2 ? ti[2] : ti[3]; const float w = (k == 0 ? e0 : k == 1 ? e1 : k == 2 ? e2 : e3) * inv;
                tokw[(size_t)row * 4 + k] = w;
                myexp[ps] = ee; myrank[ps] = (int)__hip_atomic_fetch_add(lcnt + ee, 1u, __ATOMIC_RELAXED, __HIP_MEMORY_SCOPE_WORKGROUP); } }
        __syncthreads();
        if (F.tid < 32) { const unsigned c = lcnt[F.tid]; lbase[F.tid] = c ? atomicAdd(&cnt[F.tid], c) : 0u; lcnt[F.tid] = 0u; }
        __syncthreads();
#pragma unroll
        for (int ps = 0; ps < 2; ++ps) { const int e = F.tid & 31; if (e < 4) { const int row = it * 32 + ps * 16 + (F.tid >> 5);
                slot[(size_t)myexp[ps] * NTOK + lbase[myexp[ps]] + myrank[ps]] = row * 4 + e; } }
        __syncthreads();
    }
}

__device__ __forceinline__ void moe_build_tiles(const Frame& F, LAS int* tstart, LAS int* cntl, LAS int* tstartB) {
    if (F.tid == 0) { int acc = 0, accb = 0; for (int e = 0; e < NEXP; ++e) { const int c = (int)__hip_atomic_load(F.ctl + CW_CNT + e, __ATOMIC_RELAXED, __HIP_MEMORY_SCOPE_AGENT); const int rem = c & 255;
            cntl[e] = c; tstart[e] = acc; tstartB[e] = accb; acc += (c >> 8) + (rem > 128 ? 1 : 0); accb += (rem >= 1 && rem <= 128) ? 1 : 0; } tstart[NEXP] = acc; tstartB[NEXP] = accb; }
    if (F.tid < 64) { const int sh = amax_shift(__hip_atomic_load(F.ctl + CW_AMAX + F.tid, __ATOMIC_RELAXED, __HIP_MEMORY_SCOPE_AGENT)); const unsigned b_ = (unsigned)(127 - sh) & 0xffu;
        cntl[40 + F.tid] = (int)(b_ | (b_ << 8) | (b_ << 16) | (b_ << 24)); }
    __syncthreads();
}

__device__ __forceinline__ void p9_combine(const Frame& F, const Args& a) {
    unsigned char* ws = F.ws; const bf16_t* H1 = (const bf16_t*)(ws + WS_H1); const unsigned char* Y = ws + WS_Y;
    const float* tokw = (const float*)(ws + WS_TOKW); const float* gf = a.in[I_FNG]; float* out = a.out;
    for (int row = F.bid * 8 + F.wid; row < NTOK; row += F.G * 8) {
        const bf16_t* hr = H1 + (size_t)row * DM; f32x4 v[8]; float ss = 0.f;
        const f32x4 w4 = *(const f32x4*)(tokw + (size_t)row * 4);
#pragma unroll
        for (int i = 0; i < 4; ++i) { const int c0 = i * 512 + F.lane * 8; { const u32x4 hw = *(const u32x4*)(hr + c0); float hf[8]; unpack8(hw, hf);
                v[2 * i] = (f32x4){hf[0], hf[1], hf[2], hf[3]}; v[2 * i + 1] = (f32x4){hf[4], hf[5], hf[6], hf[7]}; }
#pragma unroll
            for (int k = 0; k < 4; ++k) { const u32x2 yw = *(const u32x2*)(Y + ((size_t)row * 4 + k) * DM + c0); float f[8];
                { const f32x2 t0 = __builtin_amdgcn_cvt_pk_f32_fp8(yw[0], false), t1 = __builtin_amdgcn_cvt_pk_f32_fp8(yw[0], true), t2 = __builtin_amdgcn_cvt_pk_f32_fp8(yw[1], false), t3 = __builtin_amdgcn_cvt_pk_f32_fp8(yw[1], true);
                  f[0] = t0[0]; f[1] = t0[1]; f[2] = t1[0]; f[3] = t1[1]; f[4] = t2[0]; f[5] = t2[1]; f[6] = t3[0]; f[7] = t3[1]; }
#pragma unroll
                for (int j = 0; j < 4; ++j) { v[2 * i][j] += w4[k] * f[j]; v[2 * i + 1][j] += w4[k] * f[4 + j]; } }
#pragma unroll
            for (int j = 0; j < 4; ++j) ss += v[2 * i][j] * v[2 * i][j] + v[2 * i + 1][j] * v[2 * i + 1][j]; }
        ss = wave_sum(ss); const float rs = rsqrtf(ss * (1.f / DM) + EPS);
#pragma unroll
        for (int i = 0; i < 4; ++i) { const int c0 = i * 512 + F.lane * 8; const f32x4 g0 = *(const f32x4*)(gf + c0), g1 = *(const f32x4*)(gf + c0 + 4);
            *(f32x4*)(out + (size_t)row * DM + c0) = v[2 * i] * rs * g0; *(f32x4*)(out + (size_t)row * DM + c0 + 4) = v[2 * i + 1] * rs * g1; }
    }
}

#if DEBUG_CMP
__device__ __noinline__ void dbg_compare(unsigned char* ws, unsigned* ctl, LAS unsigned char* lds) {
    const int tid = threadIdx.x, lane = tid & 63, wid = tid >> 6;
    float mx = 0.f, md = 0.f; const bf16_t* r0 = (const bf16_t*)(ws + WS_KC); const bf16_t* r1 = (const bf16_t*)(ws + WS_Y);
    for (int i = tid; i < 2 * 16 * 128 * 128; i += NTHREADS) { const float x = bf2f(i < 262144 ? r0[i] : ((const bf16_t*)(ws + WS_VC))[i - 262144]); const float y = bf2f(i < 262144 ? r1[i] : ((const bf16_t*)(ws + WS_Y + 1048576))[i - 262144]);
        mx = fmaxf(mx, fabsf(x)); md = fmaxf(md, fabsf(x - y)); if (!(y == y)) md = 1e30f; }
    mx = wave_max(mx); md = wave_max(md); LAS float* t2 = (LAS float*)lds; if (lane == 0) { t2[wid] = mx; t2[8 + wid] = md; } __syncthreads();
    if (tid == 0) { float a1 = 0.f, a2 = 0.f; for (int i = 0; i < 8; ++i) { a1 = fmaxf(a1, t2[i]); a2 = fmaxf(a2, t2[8 + i]); }
        const float rel = a2 / fmaxf(a1, 1e-20f); int code = 0;
        if (rel >= 1.f) code = 10; else if (rel >= 0.3f) code = 11; else if (rel >= 0.1f) code = 12; else if (rel >= 0.03f) code = 13; else if (rel >= 0.01f) code = 14; else if (rel >= 0.003f) code = 15;
        if (blockIdx.x == 0) ctl[CW_ERR] = (unsigned)code; }
    __syncthreads();
}
#endif
constexpr int N_PHASES = 9;
extern "C" __global__ void __launch_bounds__(NTHREADS, 2) fwd(Args args) {
    extern __shared__ __attribute__((aligned(16))) unsigned char shm[];
    LAS unsigned char* lds = (LAS unsigned char*)shm;
    Frame F; F.lds = lds; F.ws = args.ws; F.ctl = (unsigned*)(args.ws + WS_CTL);
    F.tid = threadIdx.x; F.wid = __builtin_amdgcn_readfirstlane(F.tid >> 6); F.lane = F.tid & 63; F.G = gridDim.x; F.bid = blockIdx.x;
    LAS unsigned* misc = (LAS unsigned*)(lds + LDS_MISC);
    if (F.tid < 4) misc[F.tid] = 0u;
    __syncthreads();
    const int lo = args.ph_lo, hi = args.ph_hi;
    XcdBarrier bar; bar.bar = F.ctl; bar.x = 0; bar.st = nullptr;
    if (hi - lo > 1) bar = xcd_barrier_post(F.ctl, (volatile LAS unsigned*)misc);
#define IN(k) (lo <= (k) && (k) < hi)
#define SEAM(k) do { if (IN(k) && IN((k) + 1)) xcd_barrier(bar); } while (0)
    unsigned char* ws = args.ws;

    if (IN(0)) { p0_prologue(F, args); }
#if (REP_MASK >> 0) & 1
    if (IN(0)) { p0_prologue(F, args); }
#endif
    SEAM(0);
    if (IN(1)) {
        const int gi = F.bid >> 3, g8i = gi & 7; const bool split = (F.G == 256), conv = split && (g8i == 2 || g8i == 5 || g8i == 7);
        if (conv) { const int crank = ((gi >> 3) * 3 + (g8i == 2 ? 0 : (g8i == 5 ? 1 : 2))) * 8 + (F.bid & 7); conv_experts(F, args, CONV_P2 + crank, 96, 12288); bias1_partials(F, args, crank, 96); }
        else {
            const int grank = (gi >> 3) * 5 + (g8i < 2 ? g8i : (g8i < 5 ? g8i - 1 : 4));
            g8::DenseSched<DM, DM> S; S.init(ws + WS_U, ws + WS_WINT, NTOK, PROJ_LD, split ? 160 : F.G, split ? grank * 8 + (F.bid & 7) : F.bid);
            g8::EpiProj E{(bf16_t*)(ws + WS_PROJ), PROJ_LD, (bf16_t*)(ws + WS_OMF), (const float*)(ws + WS_LB)};
            g8::gemm_phase(lds, S, E);
            if (!split) { conv_experts(F, args, CONV_P2 + F.bid, F.G, 12288); bias1_partials(F, args, F.bid, F.G); }
        }
    }
#if (REP_MASK >> 1) & 1
    if (IN(1)) {
        g8::DenseSched<DM, DM> S; S.init(ws + WS_U, ws + WS_WINT, NTOK, PROJ_LD, F.G, F.bid);
        g8::EpiProj E{(bf16_t*)(ws + WS_PROJ), PROJ_LD, (bf16_t*)(ws + WS_OMF), (const float*)(ws + WS_LB)};
        g8::gemm_phase(lds, S, E);
    }
#endif
    SEAM(1);
    if (IN(2)) {
#if DEBUG_CMP
        p2_compress_naive(F, args);
#endif
        for (int u = F.bid; u < 128; u += F.G) compress_fast_unit(F, args, u);
        if (F.G == 256) { if (F.bid >= 128) conv_experts(F, args, CONV_P0 + (F.bid - 128), 128, CONV_P2); }
        else conv_experts(F, args, CONV_P0 + F.bid, F.G, CONV_P2); }
#if (REP_MASK >> 2) & 1
    if (IN(2)) {
#if DEBUG_CMP
        p2_compress_naive(F, args);
#endif
        for (int u = F.bid; u < 128; u += F.G) compress_fast_unit(F, args, u); }
#endif
    SEAM(2);
    if (IN(3)) {
#if DEBUG_CMP
        dbg_compare(ws, F.ctl, lds);
#endif
        if (F.bid < 64) hgrn_fast_unit(F, args, F.bid);
        for (;;) { if (F.tid == 0) misc[8] = atomicAdd(F.ctl + CW_QUEUE, 1u);
            __syncthreads();
            const int u = (int)misc[8];
            if (u >= BATCH * NSA_G * 32) break;
            attn_fast_unit(F, args, u); }
    }
#if (REP_MASK >> 3) & 1
    if (IN(3)) {
#if DEBUG_CMP
        dbg_compare(ws, F.ctl, lds);
#endif
        if (F.bid < 64) hgrn_fast_unit(F, args, F.bid);
        for (;;) { if (F.tid == 0) misc[8] = atomicAdd(F.ctl + CW_QUEUE + 64, 1u);
            __syncthreads();
            const int u = (int)misc[8];
            if (u >= BATCH * NSA_G * 32) break;
            attn_fast_unit(F, args, u); }
    }
#endif
    SEAM(3);
    if (IN(4)) {
        g8::DenseSched<DM, DM> S; S.init(ws + WS_YMIX, ws + WS_WOUTT, NTOK, DM, F.G, F.bid);
        g8::EpiResBf16 E{(bf16_t*)(ws + WS_H1), args.in[I_X], DM};
        g8::gemm_phase(lds, S, E);
    }
#if (REP_MASK >> 4) & 1
    if (IN(4)) {
        g8::DenseSched<DM, DM> S; S.init(ws + WS_YMIX, ws + WS_WOUTT, NTOK, DM, F.G, F.bid);
        g8::EpiResBf16 E{(bf16_t*)(ws + WS_H1), args.in[I_X], DM};
        g8::gemm_phase(lds, S, E);
    }
#endif
    SEAM(4);
    if (IN(5)) { p5_router(F, args); }
#if (REP_MASK >> 5) & 1
    if (IN(5)) { p5_router(F, args); }
#endif
    SEAM(5);
    if (IN(6)) {
        LAS int* tstart = (LAS int*)(misc + 64); LAS int* cntl = tstart + 40; LAS int* tstartB = cntl + 104;
        moe_build_tiles(F, tstart, cntl, tstartB);
        g8::EpiGateUp E{(unsigned char*)(ws + WS_ACT), args.in[I_BGU]};
        { g8::MoeSched<16, 2, true, 0> S{(const char*)(ws + WS_U), (const char*)(ws + WS_WGUT), (const int*)(ws + WS_SLOT), args.in[I_BGU], tstart, cntl, F.G, F.bid}; g8::gemm_phase(lds, S, E); }
        { g8::MoeSched<16, 2, true, 1> S{(const char*)(ws + WS_U), (const char*)(ws + WS_WGUT), (const int*)(ws + WS_SLOT), args.in[I_BGU], tstartB, cntl, F.G, F.bid}; g8::gemm_phase(lds, S, E); }
    }
#if (REP_MASK >> 6) & 1
    if (IN(6)) {
        LAS int* tstart = (LAS int*)(misc + 64); LAS int* cntl = tstart + 40;
        moe_build_tiles(F, tstart, cntl);
        g8::MoeSched<16, 2, true> S{(const char*)(ws + WS_U), (const char*)(ws + WS_WGUT), (const int*)(ws + WS_SLOT), args.in[I_BGU], tstart, cntl, F.G, F.bid};
        g8::EpiGateUp E{(unsigned char*)(ws + WS_ACT), args.in[I_BGU]};
        g8::gemm_phase(lds, S, E);
    }
#endif
    SEAM(6);
    if (IN(7)) {
        LAS int* tstart = (LAS int*)(misc + 64); LAS int* cntl = tstart + 40; LAS int* tstartB = cntl + 104;
        moe_build_tiles(F, tstart, cntl, tstartB);
        g8::EpiDown E{ws + WS_Y, args.in[I_BD]};
        { g8::MoeSched<8, 0, false, 0> S{(const char*)(ws + WS_ACT), (const char*)(ws + WS_WDT), (const int*)(ws + WS_SLOT), args.in[I_BD], tstart, cntl, F.G, F.bid}; g8::gemm_phase(lds, S, E); }
        { g8::MoeSched<8, 0, false, 1> S{(const char*)(ws + WS_ACT), (const char*)(ws + WS_WDT), (const int*)(ws + WS_SLOT), args.in[I_BD], tstartB, cntl, F.G, F.bid}; g8::gemm_phase(lds, S, E); }
    }
#if (REP_MASK >> 7) & 1
    if (IN(7)) {
        LAS int* tstart = (LAS int*)(misc + 64); LAS int* cntl = tstart + 40;
        moe_build_tiles(F, tstart, cntl);
        g8::MoeSched<8, 0, false> S{(const char*)(ws + WS_ACT), (const char*)(ws + WS_WDT), (const int*)(ws + WS_SLOT), args.in[I_BD], tstart, cntl, F.G, F.bid};
        g8::EpiDown E{ws + WS_Y, args.in[I_BD]};
        g8::gemm_phase(lds, S, E);
    }
#endif
    SEAM(7);
    if (IN(8)) { p9_combine(F, args);
#if DEBUG_CMP
        { const unsigned code = __hip_atomic_load(F.ctl + CW_ERR, __ATOMIC_RELAXED, __HIP_MEMORY_SCOPE_AGENT);
          if (code) { const float cval = sqrtf((float)code); for (size_t i = (size_t)F.bid * NTHREADS + F.tid; i < (size_t)NTOK * DM; i += (size_t)F.G * NTHREADS) args.out[i] = cval; } }
#endif
    }
#if (REP_MASK >> 8) & 1
    if (IN(8)) { p9_combine(F, args);
#if DEBUG_CMP
        { const unsigned code = __hip_atomic_load(F.ctl + CW_ERR, __ATOMIC_RELAXED, __HIP_MEMORY_SCOPE_AGENT);
          if (code) { const float cval = sqrtf((float)code); for (size_t i = (size_t)F.bid * NTHREADS + F.tid; i < (size_t)NTOK * DM; i += (size_t)F.G * NTHREADS) args.out[i] = cval; } }
#endif
    }
#endif
#undef IN
#undef SEAM
}

extern "C" void kernel_launch(void* const* d_in, const int* in_sizes, int n_in, void* d_out, int out_size, void* d_ws, size_t ws_size, hipStream_t stream) {
    static int grid = 0;
    if (grid == 0) {
        if (n_in != 18 || ws_size < WS_END) { fprintf(stderr, "kernel_launch: n_in %d ws %zu (need %zu)\n", n_in, ws_size, (size_t)WS_END); grid = -1; return; }
        int dev = 0, cus = 0, per_cu = 0;
        if (hipGetDevice(&dev) != hipSuccess || hipDeviceGetAttribute(&cus, hipDeviceAttributeMultiprocessorCount, dev) != hipSuccess) { grid = -1; return; }
        if (hipFuncSetAttribute((const void*)fwd, hipFuncAttributeMaxDynamicSharedMemorySize, LDS_BYTES) != hipSuccess) { fprintf(stderr, "kernel_launch: hipFuncSetAttribute failed\n"); grid = -1; return; }
        if (hipOccupancyMaxActiveBlocksPerMultiprocessor(&per_cu, (const void*)fwd, NTHREADS, LDS_BYTES) != hipSuccess || per_cu < 1) { fprintf(stderr, "kernel_launch: occupancy query says %d\n", per_cu); }
        (void)hipGetLastError();
        grid = cus;
    }
    if (grid < 0) return;
    (void)hipMemsetAsync((char*)d_ws + WS_CTL, 0, CTL_BYTES, stream);
    Args a{};
    for (int i = 0; i < 18; ++i) a.in[i] = (const float*)d_in[i];
    a.out = (float*)d_out; a.ws = (unsigned char*)d_ws;
#if N_LAUNCH_PER_PHASE
    for (int p = 0; p < N_PHASES; ++p) { a.ph_lo = p; a.ph_hi = p + 1; hipLaunchKernelGGL(fwd, dim3(grid), dim3(NTHREADS), LDS_BYTES, stream, a); }
#else
    a.ph_lo = 0; a.ph_hi = N_PHASES; hipLaunchKernelGGL(fwd, dim3(grid), dim3(NTHREADS), LDS_BYTES, stream, a);
#endif
}
```

```cpp
#include <hip/hip_runtime.h>
#include <stdint.h>
#include <stdio.h>

#ifndef N_LAUNCH_PER_PHASE
#define N_LAUNCH_PER_PHASE 0
#endif

#define DEBUG_CMP 0
#ifndef REP_MASK
#define REP_MASK 0
#endif
#define LAS __attribute__((address_space(3)))
typedef unsigned short bf16_t;
typedef short bf16x8 __attribute__((ext_vector_type(8)));
typedef float f32x4 __attribute__((ext_vector_type(4)));
typedef float f32x2 __attribute__((ext_vector_type(2)));
typedef float f32x16 __attribute__((ext_vector_type(16)));
typedef unsigned u32x4 __attribute__((ext_vector_type(4)));
typedef unsigned u32x2 __attribute__((ext_vector_type(2)));
typedef int i32x8 __attribute__((ext_vector_type(8)));

constexpr int BATCH = 8, SEQ = 2048, NTOK = BATCH * SEQ, DM = 2048;
constexpr int HG_W = 1024, HG_H = 8, HG_DK = 128, HG_DV = 128;
constexpr int NSA_H = 8, NSA_G = 2, NSA_R = 4, HD = 128, KVW = 256;
constexpr int IN_COLS = 6680, PROJ_LD = 6912;
constexpr int C_HQ = 0, C_HF = 1024, C_HI = 2048, C_HGT = 3072, C_NQ = 4096, C_KCM = 5120, C_VCM = 5376, C_KSL = 5632, C_VSL = 5888, C_KWN = 6144, C_VWN = 6400, C_NGT = 6656;
constexpr int NCMP = 127, NSEL = 32, SEL_TOP = 16, WINDOW = 512;
constexpr int NEXP = 32, TOPK = 4, DFF = 2048, NASG = NTOK * TOPK;
constexpr float EPS = 1e-6f;
constexpr int NTHREADS = 512;
constexpr int CONV_P0 = 0, CONV_P2 = 1280;

constexpr size_t al256(size_t x) { return (x + 255) & ~(size_t)255; }
constexpr size_t WS_CTL = 0, CTL_BYTES = 65536;
constexpr size_t WS_WINT = WS_CTL + CTL_BYTES;
constexpr size_t WS_WOUTT = WS_WINT + (size_t)PROJ_LD * DM * 2;
constexpr size_t WS_WGUT = WS_WOUTT + (size_t)DM * DM * 2;
constexpr size_t WS_WDT = WS_WGUT + (size_t)NEXP * 2 * DFF * DM * 2;
constexpr size_t WS_W1T = WS_WDT + (size_t)NEXP * DM * DFF * 2;
constexpr size_t WS_W2T = WS_W1T + (size_t)2 * 128 * 4096 * 2;
constexpr size_t WS_BIAS1 = WS_W2T + (size_t)2 * 128 * 128 * 2;
constexpr size_t WS_WR2 = WS_BIAS1 + 1024;
constexpr size_t WS_LB = WS_WR2 + (size_t)DM * NEXP * 4;
constexpr size_t WS_U = WS_LB + 4096;
constexpr size_t WS_PROJ = WS_U + (size_t)NTOK * DM * 2;
constexpr size_t WS_KC = WS_PROJ + (size_t)(NTOK + 64) * PROJ_LD * 2;
constexpr size_t WS_VC = WS_KC + (size_t)16 * 128 * 128 * 2;
constexpr size_t WS_YMIX = WS_VC + (size_t)16 * 128 * 128 * 2;
constexpr size_t WS_H1 = WS_YMIX + (size_t)NTOK * DM * 2;
constexpr size_t WS_TOKW = WS_H1 + (size_t)NTOK * DM * 4;
constexpr size_t WS_SLOT = WS_TOKW + (size_t)NTOK * 4 * 4;
constexpr size_t WS_ACT = WS_SLOT + (size_t)NEXP * NTOK * 4;
constexpr size_t WS_Y = WS_ACT + (size_t)NASG * DFF * 2;
constexpr size_t WS_OT = WS_Y + (size_t)NASG * DM * 2;
constexpr size_t WS_OMF = WS_OT + (size_t)256 * 64 * 512 * 4;
constexpr size_t WS_B1P = WS_OMF + (size_t)NTOK * HG_W * 2;
constexpr size_t WS_END = WS_B1P + (size_t)2 * 32 * 128 * 4;
constexpr int CW_CNT = 4096, CW_QUEUE = 4160, CW_ERR = 4224, CW_AMAX = 4544;

__device__ __forceinline__ float bf2f(bf16_t b) { return __uint_as_float(((unsigned)b) << 16); }
typedef __bf16 bf16v2_t __attribute__((ext_vector_type(2)));
__device__ __forceinline__ unsigned cvt_pk_bf16(float lo, float hi) { f32x2 v = {lo, hi}; bf16v2_t r = __builtin_convertvector(v, bf16v2_t); return __builtin_bit_cast(unsigned, r); }
__device__ __forceinline__ unsigned cvt4_fp8(float a, float b, float c, float d) { unsigned w = 0u; w = __builtin_amdgcn_cvt_pk_fp8_f32(a, b, w, false); w = __builtin_amdgcn_cvt_pk_fp8_f32(c, d, w, true); return w; }
__device__ __forceinline__ unsigned cvt4_bf8(float a, float b, float c, float d) { unsigned w = 0u; w = __builtin_amdgcn_cvt_pk_bf8_f32(a, b, w, false); w = __builtin_amdgcn_cvt_pk_bf8_f32(c, d, w, true); return w; }
__device__ __forceinline__ int amax_shift(unsigned bits) { if (bits == 0u) return 0; int s_ = 5 - ((int)(bits >> 23) - 127); return s_ < -60 ? -60 : (s_ > 60 ? 60 : s_); }
__device__ __forceinline__ float shift_mult(int s_) { return __uint_as_float((unsigned)(s_ + 127) << 23); }
__device__ __forceinline__ unsigned cvt4_fp8s(float a, float b, float c, float d, float m) {
    return cvt4_fp8(__builtin_amdgcn_fmed3f(a * m, -448.f, 448.f), __builtin_amdgcn_fmed3f(b * m, -448.f, 448.f), __builtin_amdgcn_fmed3f(c * m, -448.f, 448.f), __builtin_amdgcn_fmed3f(d * m, -448.f, 448.f)); }
__device__ __forceinline__ bf16_t f2bf(float f) { return (bf16_t)(cvt_pk_bf16(f, 0.f) & 0xffffu); }
__device__ __forceinline__ float sigmoidf_(float x) { return 1.f / (1.f + __expf(-x)); }
__device__ __forceinline__ float siluf_(float x) { return x * sigmoidf_(x); }
__device__ __forceinline__ float wave_sum(float v) {
#pragma unroll
    for (int o = 32; o > 0; o >>= 1) v += __shfl_xor(v, o);
    return v;
}
__device__ __forceinline__ float wave_max(float v) {
#pragma unroll
    for (int o = 32; o > 0; o >>= 1) v = fmaxf(v, __shfl_xor(v, o));
    return v;
}
__device__ __forceinline__ void unpack8(const u32x4 w, float (&f)[8]) {
#pragma unroll
    for (int i = 0; i < 4; ++i) { f[2 * i] = __uint_as_float(w[i] << 16); f[2 * i + 1] = __uint_as_float(w[i] & 0xffff0000u); }
}

#define XB_TMO      128
#define XB_XCNT(j)  (256  + 64 * (j))
#define XB_XSUB(j)  (1280 + 64 * (j))
#define XB_XGEN(j)  (2304 + 64 * (j))
#define XB_TOP      3328
#define XB_TOPGEN   3392
#define XCD_BAR_WORDS 3456
#define XB_SPIN_CAP (1u << 18)
__device__ __forceinline__ unsigned xb_ld(unsigned* p)              { return __hip_atomic_load(p, __ATOMIC_RELAXED, __HIP_MEMORY_SCOPE_AGENT); }
__device__ __forceinline__ unsigned xb_add(unsigned* p, unsigned v) { return __hip_atomic_fetch_add(p, v, __ATOMIC_RELAXED, __HIP_MEMORY_SCOPE_AGENT); }
__device__ __forceinline__ unsigned xb_xcc_id() { return (unsigned)__builtin_amdgcn_s_getreg((3 << 11) | 20) & 0xFu; }
#define XB_SPIN(cond, bar) do { unsigned _sp = 0; while (cond) { __builtin_amdgcn_s_sleep(1); \
    if ((++_sp & 255u) == 0u) { if (xb_ld(&(bar)[XB_TMO])) break; if (_sp > XB_SPIN_CAP) { atomicAdd(&(bar)[XB_TMO], 1u); break; } } } } while (0)
struct XcdBarrier { unsigned* bar; unsigned x; volatile LAS unsigned* st; };
__device__ __forceinline__ XcdBarrier xcd_barrier_post(unsigned* bar, volatile LAS unsigned* st) {
    XcdBarrier b; b.bar = bar; b.x = xb_xcc_id(); b.st = st;
    if (threadIdx.x == 0) (void)xb_add(&bar[XB_XCNT(b.x)], 1u);
    return b;
}
__device__ __forceinline__ void xcd_barrier_complete(unsigned* bar, unsigned x, unsigned& nloc, unsigned& nx) {
    const unsigned G = gridDim.x * gridDim.y * gridDim.z;
    unsigned sum, cnt, mine, sp = 0u;
    for (;;) {
        sum = 0u; cnt = 0u; mine = 0u;
#pragma unroll
        for (unsigned j = 0; j < 16; ++j) { const unsigned c = xb_ld(&bar[XB_XCNT(j)]); sum += c; cnt += (c > 0u) ? 1u : 0u; mine = (j == x) ? c : mine; }
        if (sum == G) break;
        __builtin_amdgcn_s_sleep(1);
        if ((++sp & 255u) == 0u) { if (xb_ld(&bar[XB_TMO])) break; if (sp > XB_SPIN_CAP) { atomicAdd(&bar[XB_TMO], 1u); break; } }
    }
    nloc = mine > 0u ? mine : 1u; nx = cnt > 0u ? cnt : 1u;
}
__device__ __forceinline__ void xcd_barrier(const XcdBarrier& b) {
    asm volatile("s_waitcnt vmcnt(0)" ::: "memory");
    __syncthreads();
    if (threadIdx.x == 0) {
        unsigned* bar = b.bar;
        __builtin_amdgcn_s_waitcnt(0);
        unsigned nloc = b.st[0], nx = b.st[1];
        if (nloc == 0u) { xcd_barrier_complete(bar, b.x, nloc, nx); b.st[0] = nloc; b.st[1] = nx; }
        const unsigned old = xb_add(&bar[XB_XSUB(b.x)], 1u);
        const unsigned gen = old / nloc;
        if (old + 1u == (gen + 1u) * nloc) {
            __builtin_amdgcn_fence(__ATOMIC_RELEASE, "agent");
            asm volatile("s_waitcnt vmcnt(0)" ::: "memory");
            const unsigned og = xb_add(&bar[XB_TOP], 1u);
            const unsigned tg = og / nx;
            if (og + 1u == (tg + 1u) * nx) xb_add(&bar[XB_TOPGEN], 1u);
            else XB_SPIN(xb_ld(&bar[XB_TOPGEN]) == tg, bar);
            __builtin_amdgcn_fence(__ATOMIC_ACQUIRE, "agent");
            xb_add(&bar[XB_XGEN(b.x)], 1u);
            asm volatile("s_waitcnt vmcnt(0)" ::: "memory");
        } else {
            XB_SPIN(xb_ld(&bar[XB_XGEN(b.x)]) == gen, bar);
            __builtin_amdgcn_fence(__ATOMIC_ACQUIRE, "agent");
            asm volatile("s_waitcnt vmcnt(0)" ::: "memory");
        }
    }
    __syncthreads();
}

namespace g8 {
constexpr int BM = 256, BK = 64, HALF = 128, HTB = HALF * BK * 2, STAGE_BYTES = 8 * HTB, NXCD = 8;
__host__ __device__ __forceinline__ int lds_byte(int r, int c) { const int st = (r >> 4) * 2 + (c >> 5), rr = r & 15, cc = c & 31, ob = rr * 64 + cc * 2; return st * 1024 + (ob ^ (((ob >> 9) & 1) << 5)); }
__host__ __device__ __forceinline__ void stage_rc(int b, int& R, int& C) { const int st = b / 1024, sb = b % 1024, swz = sb ^ (((sb >> 9) & 1) << 5); R = (st >> 1) * 16 + swz / 64; C = (st & 1) * 32 + (swz % 64) / 2; }
__host__ __device__ __forceinline__ int perm32(int rho) { const int n = rho >> 4, i = rho & 15; return 8 * (i >> 2) + 4 * n + (i & 3); }

struct Unit { const char* A; const char* B0; const char* B1; const int* rows; const float* bias0; const float* bias1; int nvalid; int m0, n0, e; int wscale; };

template <class Sched>
__device__ __forceinline__ void a_offsets(const Unit& u, const int (&R)[2], const int (&C)[2], unsigned (&vo)[2][2]) {
#pragma unroll
    for (int h = 0; h < 2; ++h)
#pragma unroll
        for (int i = 0; i < 2; ++i) {
            if constexpr (Sched::GATHER) {
                const int r = h * HALF + R[i];
                const int idx = u.rows[r < u.nvalid ? r : 0] >> Sched::SHIFT;
                vo[h][i] = (unsigned)idx * (unsigned)(Sched::LDA * Sched::ESZ) + (unsigned)C[i] * 2u;
            } else {
                vo[h][i] = (unsigned)(h * HALF + R[i]) * (unsigned)(Sched::LDA * Sched::ESZ) + (unsigned)C[i] * 2u;
            }
        }
}

__device__ __forceinline__ const char* uni_ptr(const char* p) { const unsigned long long v = (unsigned long long)p;
    const unsigned lo = (unsigned)__builtin_amdgcn_readfirstlane((int)(unsigned)v), hi = (unsigned)__builtin_amdgcn_readfirstlane((int)(unsigned)(v >> 32));
    return (const char*)(((unsigned long long)hi << 32) | lo); }
template <class Sched, class Epi>
__device__ __forceinline__ void gemm_phase(LAS unsigned char* lds, const Sched& S, const Epi& E) {
    const int tid = threadIdx.x, wid = __builtin_amdgcn_readfirstlane(tid >> 6), lane = tid & 63, wr = wid >> 2, wc = wid & 3, fr = lane & 15, fq = lane >> 4;
    constexpr int K = Sched::K, nt = K * Sched::ESZ / (BK * 2);
    int Rr[2], Cc[2]; unsigned voffB[2];
#pragma unroll
    for (int i = 0; i < 2; ++i) { stage_rc(tid * 16 + i * 8192, Rr[i], Cc[i]); const int Rb = Epi::PERM ? ((Rr[i] & ~31) + perm32(Rr[i] & 31)) : Rr[i];
        voffB[i] = (unsigned)Rb * (unsigned)(K * Sched::ESZ) + (unsigned)Cc[i] * 2u; }
    const size_t kstep = (size_t)(BK * 2);
    const unsigned ldsw = (unsigned)wid * 1024u;
    const int aoff = lds_byte(wr * 64 + fr, fq * 8), boff = lds_byte(wc * 32 + fr, fq * 8);
#define G8_SA(b, h) (((b) * 2 + (h)) * HTB)
#define G8_SB(b, h) ((4 + (b) * 2 + (h)) * HTB)
#define G8_STAGE(bufoff, gbase, voff) do { _Pragma("unroll") for (int _i = 0; _i < 2; ++_i) \
        __builtin_amdgcn_global_load_lds((const unsigned*)((const char*)(gbase) + (voff)[_i]), (LAS unsigned*)(lds + (bufoff) + ldsw + _i * 8192), 16, 0, 0); } while (0)
#define G8_LDA(dst, b, h) do { if constexpr (Sched::MV != 0 && (h) == 1) break; _Pragma("unroll") for (int m = 0; m < 4; ++m) _Pragma("unroll") for (int k = 0; k < 2; ++k) dst[m][k] = *(const LAS bf16x8*)(lds + G8_SA(b, h) + aoff + m * 2048 + k * 1024); } while (0)
#define G8_LDB(dst, b, h) do { _Pragma("unroll") for (int n = 0; n < 2; ++n) _Pragma("unroll") for (int k = 0; k < 2; ++k) dst[n][k] = *(const LAS bf16x8*)(lds + G8_SB(b, h) + boff + n * 2048 + k * 1024); } while (0)
#define G8_MMA(ai, bj, At, Bt) do { if constexpr (Sched::MV != 0 && (ai) == 1) break; __builtin_amdgcn_s_setprio(1); _Pragma("unroll") for (int m = 0; m < 4; ++m) _Pragma("unroll") for (int n = 0; n < 2; ++n) { \
        if constexpr (Sched::ESZ == 2) { _Pragma("unroll") for (int k = 0; k < 2; ++k) acc[ai][bj][m][n] = __builtin_amdgcn_mfma_f32_16x16x32_bf16(Bt[n][k], At[m][k], acc[ai][bj][m][n], 0, 0, 0); } \
        else { const u32x4 b0_ = __builtin_bit_cast(u32x4, Bt[n][0]), b1_ = __builtin_bit_cast(u32x4, Bt[n][1]), a0_ = __builtin_bit_cast(u32x4, At[m][0]), a1_ = __builtin_bit_cast(u32x4, At[m][1]); \
            const i32x8 bw_ = {(int)b0_[0], (int)b0_[1], (int)b0_[2], (int)b0_[3], (int)b1_[0], (int)b1_[1], (int)b1_[2], (int)b1_[3]}; \
            const i32x8 aw_ = {(int)a0_[0], (int)a0_[1], (int)a0_[2], (int)a0_[3], (int)a1_[0], (int)a1_[1], (int)a1_[2], (int)a1_[3]}; \
            acc[ai][bj][m][n] = __builtin_amdgcn_mfma_scale_f32_16x16x128_f8f6f4(bw_, aw_, acc[ai][bj][m][n], Sched::FMT_W, Sched::FMT_A, 0, wsc_cur, 0, 0x7f7f7f7f); } } \
        __builtin_amdgcn_s_setprio(0); } while (0)
#define G8_WAIT_V(n) asm volatile("s_waitcnt vmcnt(" #n ")" ::: "memory")
#define G8_WAIT_L(n) asm volatile("s_waitcnt lgkmcnt(" #n ")" ::: "memory")
#define G8_BAR __builtin_amdgcn_s_barrier()
#define G8_SCHED __builtin_amdgcn_sched_barrier(0)
    Unit cur, nxt; int ui = 0;
    if (!S.next(0, cur)) return;
    f32x4 acc[2][2][4][2];
#pragma unroll
    for (int a = 0; a < 2; ++a)
#pragma unroll
        for (int b = 0; b < 2; ++b)
#pragma unroll
            for (int m = 0; m < 4; ++m)
#pragma unroll
                for (int n = 0; n < 2; ++n) acc[a][b][m][n] = (f32x4){0.f, 0.f, 0.f, 0.f};
    bf16x8 At[4][2], B0[2][2], B1[2][2];
    unsigned voffA[2][2], nvoffA[2][2];
    LAS unsigned char* auxb = lds + STAGE_BYTES; int par_cur = 0, par_nxt = 1;
#define G8_AUX_ISSUE(U, PAR) do { if (wid < 4) { const int r_ = wid * 64 + lane; __builtin_amdgcn_global_load_lds((const unsigned*)((U).rows + (r_ < (U).nvalid ? r_ : 0)), (LAS unsigned*)(auxb + (PAR) * 2048 + wid * 256), 4, 0, 0); } \
        else { const float* b_ = (wid < 6 ? (U).bias0 + (wid - 4) * 64 : (U).bias1 + (wid - 6) * 64) + lane; __builtin_amdgcn_global_load_lds((const unsigned*)b_, (LAS unsigned*)(auxb + (PAR) * 2048 + 1024 + (wid - 4) * 256), 4, 0, 0); } } while (0)
#define G8_AUX_OFFS(PAR) do { _Pragma("unroll") for (int h = 0; h < 2; ++h) _Pragma("unroll") for (int i = 0; i < 2; ++i) { \
        const int idx_ = *(const LAS int*)(auxb + (PAR) * 2048 + (h * HALF + Rr[i]) * 4) >> Sched::SHIFT; voffA[h][i] = (unsigned)idx_ * (unsigned)(Sched::LDA * Sched::ESZ) + (unsigned)Cc[i] * 2u; } } while (0)
    if constexpr (Sched::LDSAUX) { G8_AUX_ISSUE(cur, 0); G8_WAIT_V(0); __syncthreads(); G8_AUX_OFFS(0); }
    else a_offsets<Sched>(cur, Rr, Cc, voffA);
    const char* cA = cur.A; const char* cB0 = cur.B0; const char* cB1 = cur.B1;
    int wsc_cur = cur.wscale;
    G8_STAGE(G8_SB(0, 0), cB0, voffB); G8_STAGE(G8_SA(0, 0), cA, voffA[0]); G8_STAGE(G8_SB(0, 1), cB1, voffB); G8_STAGE(G8_SA(0, 1), cA, voffA[1]);
    if (wr == 1) G8_BAR;
    G8_WAIT_V(4); G8_BAR;
    G8_STAGE(G8_SB(1, 0), cB0 + kstep, voffB); G8_STAGE(G8_SA(1, 0), cA + kstep, voffA[0]); G8_STAGE(G8_SB(1, 1), cB1 + kstep, voffB);
    G8_WAIT_V(6); G8_BAR;
    for (;;) {
        const bool has_next = S.next(ui + 1, nxt);
        const char* nA = has_next ? nxt.A : cA; const char* nB0 = has_next ? nxt.B0 : cB0; const char* nB1 = has_next ? nxt.B1 : cB1;
        if constexpr (Sched::LDSAUX) { if (has_next) G8_AUX_ISSUE(nxt, par_nxt); }
        else if constexpr (Sched::GATHER) {
            if (has_next) a_offsets<Sched>(nxt, Rr, Cc, nvoffA);
            else {
#pragma unroll
                for (int h = 0; h < 2; ++h)
#pragma unroll
                    for (int i = 0; i < 2; ++i) nvoffA[h][i] = voffA[h][i];
            }
        }
        for (int t = 0; t < nt; t += 2) {
            const bool last = (t == nt - 2);
            const char* a1 = cA + (size_t)(t + 1) * kstep;
            const char* a2 = last ? nA : cA + (size_t)(t + 2) * kstep;
            const char* b20 = last ? nB0 : cB0 + (size_t)(t + 2) * kstep; const char* b21 = last ? nB1 : cB1 + (size_t)(t + 2) * kstep;
            const char* a3 = a2 + kstep; const char* b30 = b20 + kstep; const char* b31 = b21 + kstep;
            G8_LDB(B0, 0, 0); G8_SCHED; G8_LDA(At, 0, 0); G8_STAGE(G8_SA(1, 1), a1, voffA[1]);
            G8_WAIT_L(8); G8_BAR; G8_WAIT_L(0); G8_MMA(0, 0, At, B0); G8_BAR; G8_SCHED;
            if constexpr (Sched::LDSAUX) { if (last && has_next) G8_AUX_OFFS(par_nxt); }
            else if constexpr (Sched::GATHER) { if (last) {
#pragma unroll
                for (int h = 0; h < 2; ++h)
#pragma unroll
                    for (int i = 0; i < 2; ++i) voffA[h][i] = nvoffA[h][i]; } }
            G8_LDB(B1, 0, 1); G8_STAGE(G8_SB(0, 0), b20, voffB);
            G8_BAR; G8_WAIT_L(0); G8_MMA(0, 1, At, B1); G8_BAR;
            G8_LDA(At, 0, 1); G8_STAGE(G8_SA(0, 0), a2, voffA[0]);
            G8_BAR; G8_WAIT_L(0); G8_MMA(1, 0, At, B0); G8_BAR; G8_SCHED;
            G8_STAGE(G8_SB(0, 1), b21, voffB);
            G8_WAIT_V(6); G8_BAR; G8_MMA(1, 1, At, B1); G8_BAR;
            G8_LDB(B0, 1, 0); G8_SCHED; G8_LDA(At, 1, 0); G8_STAGE(G8_SA(0, 1), a2, voffA[1]);
            G8_WAIT_L(8); G8_BAR; G8_WAIT_L(0); G8_MMA(0, 0, At, B0); G8_BAR; G8_SCHED;
            G8_LDB(B1, 1, 1); G8_STAGE(G8_SB(1, 0), b30, voffB);
            G8_BAR; G8_WAIT_L(0); G8_MMA(0, 1, At, B1); G8_BAR;
            G8_LDA(At, 1, 1); G8_STAGE(G8_SA(1, 0), a3, voffA[0]);
            G8_BAR; G8_WAIT_L(0); G8_MMA(1, 0, At, B0); G8_BAR; G8_SCHED;
            G8_STAGE(G8_SB(1, 1), b31, voffB);
            G8_WAIT_V(6); G8_BAR; G8_MMA(1, 1, At, B1); G8_BAR;
        }
        E.template run<(Sched::MV != 0 ? 1 : 2)>(acc, cur, wr, wc, fr, fq, (const LAS int*)(auxb + par_cur * 2048), (const LAS float*)(auxb + par_cur * 2048 + 1024));
        if (!has_next) break;
#pragma unroll
        for (int a = 0; a < 2; ++a)
#pragma unroll
            for (int b = 0; b < 2; ++b)
#pragma unroll
                for (int m = 0; m < 4; ++m)
#pragma unroll
                    for (int n = 0; n < 2; ++n) acc[a][b][m][n] = (f32x4){0.f, 0.f, 0.f, 0.f};
        cur = nxt; cA = nA; cB0 = nB0; cB1 = nB1; ++ui; wsc_cur = cur.wscale; par_cur = par_nxt; par_nxt = par_nxt == 2 ? 0 : par_nxt + 1;
    }
    G8_WAIT_V(0);
    if (wr == 0) G8_BAR;
    G8_BAR;
#undef G8_AUX_ISSUE
#undef G8_AUX_OFFS
#undef G8_SA
#undef G8_SB
#undef G8_STAGE
#undef G8_LDA
#undef G8_LDB
#undef G8_MMA
#undef G8_WAIT_V
#undef G8_WAIT_L
#undef G8_BAR
#undef G8_SCHED
}

template <int K_, int LDA_>
struct DenseSched {
    static constexpr int K = K_, LDA = LDA_, SHIFT = 0, ESZ = 2, FMT_W = 0, FMT_A = 0, MV = 0; static constexpr bool GATHER = false, LDSAUX = false;
    const char* A; const char* Bt; int nM, nN, nwg, G, c;
    __device__ void init(const void* A_, const void* Bt_, int M, int N, int G_, int c_) { A = (const char*)A_; Bt = (const char*)Bt_; nM = M / BM; nN = N / BM; nwg = nM * nN; G = G_; c = c_; }
    __device__ __forceinline__ bool next(int i, Unit& u) const {
        const long L = (long)i * G + c; if (L >= nwg) return false;
        int wgid = (int)L; { const int q = nwg / NXCD, r = nwg % NXCD, xcd = wgid % NXCD, off = wgid / NXCD; wgid = (xcd < r ? xcd * (q + 1) : r * (q + 1) + (xcd - r) * q) + off; }
        constexpr int WGM = 8;
        const int nig = WGM * nN, gid = wgid / nig, fm = gid * WGM, gsz = (nM - fm) < WGM ? (nM - fm) : WGM;
        const int pm = fm + ((wgid % nig) % gsz), pn = (wgid % nig) / gsz;
        u.A = A + (size_t)pm * BM * LDA * 2; u.B0 = Bt + (size_t)pn * BM * K * 2; u.B1 = u.B0 + (size_t)HALF * K * 2;
        u.rows = nullptr; u.bias0 = nullptr; u.bias1 = nullptr; u.wscale = 0x7f7f7f7f; u.nvalid = BM; u.m0 = pm * BM; u.n0 = pn * BM; u.e = 0; return true;
    }
};

template <int NPN  , int SHIFT_, bool GU, int MV_ = 0>
struct MoeSched {
    static constexpr int K = 2048, LDA = 2048, SHIFT = SHIFT_, ESZ = 1, MV = MV_, FMT_W = 0  , FMT_A = 0  ; static constexpr bool GATHER = true, LDSAUX = true;
    const char* A; const char* Bt; const int* slot; const float* bias; const LAS int* tstart; const LAS int* cnt; int G, c;
    __device__ __forceinline__ bool next(int i, Unit& u) const {
        const int ntile = tstart[NEXP]; const int nwg = ntile * NPN;
        const long L = (long)i * G + c; if (L >= nwg) return false;
        int wgid = (int)L; { const int q = nwg / NXCD, r = nwg % NXCD, xcd = wgid % NXCD, off = wgid / NXCD; wgid = (xcd < r ? xcd * (q + 1) : r * (q + 1) + (xcd - r) * q) + off; }
        int e = 0;
        for (int s = 16; s > 0; s >>= 1) if (tstart[e + s] * NPN <= wgid) e += s;
        const int mt = tstart[e + 1] - tstart[e], w = wgid - tstart[e] * NPN, pn = MV ? w : w / mt, m = MV ? (cnt[e] >> 8) : w % mt;
        u.A = A; u.e = e; u.m0 = m * BM; u.n0 = pn; u.wscale = cnt[40 + (GU ? 0 : 32) + e]; u.rows = slot + (size_t)e * NTOK + m * BM;
        const int left = cnt[e] - m * BM; u.nvalid = left < BM ? left : BM;
        if (GU) { u.B0 = Bt + ((size_t)e * 4096 + (size_t)pn * HALF) * K * ESZ; u.B1 = u.B0 + (size_t)2048 * K * ESZ; u.bias0 = bias + (size_t)e * 4096 + pn * HALF; u.bias1 = u.bias0 + 2048; }
        else { u.B0 = Bt + ((size_t)e * 2048 + (size_t)pn * BM) * K * ESZ; u.B1 = u.B0 + (size_t)HALF * K * ESZ; u.bias0 = bias + (size_t)e * 2048 + pn * BM; u.bias1 = u.bias0 + HALF; }
        return true;
    }
};

struct EpiBf16 {
    static constexpr bool PERM = true;
    bf16_t* O; int ldc;
    template <int NAI> __device__ __forceinline__ void run(const f32x4 (&acc)[2][2][4][2], const Unit& u, int wr, int wc, int fr, int fq, const LAS int* lrows, const LAS float* lbias) const {
        const int row0 = u.m0 + wr * 64 + fr, col0 = u.n0 + wc * 32 + 8 * fq;
#pragma unroll
        for (int ai = 0; ai < NAI; ++ai)
#pragma unroll
            for (int m = 0; m < 4; ++m) { bf16_t* rowp = O + (size_t)(row0 + ai * HALF + m * 16) * ldc + col0;
#pragma unroll
                for (int bj = 0; bj < 2; ++bj) { const f32x4 v0 = acc[ai][bj][m][0], v1 = acc[ai][bj][m][1];
                    u32x4 w; w[0] = cvt_pk_bf16(v0[0], v0[1]); w[1] = cvt_pk_bf16(v0[2], v0[3]); w[2] = cvt_pk_bf16(v1[0], v1[1]); w[3] = cvt_pk_bf16(v1[2], v1[3]);
                    *(u32x4*)(rowp + bj * HALF) = w; } }
    }
};
struct EpiProj {
    static constexpr bool PERM = true;
    bf16_t* O; int ldc; bf16_t* OMF; const float* lb;
    template <int NAI> __device__ __forceinline__ void run(const f32x4 (&acc)[2][2][4][2], const Unit& u, int wr, int wc, int fr, int fq, const LAS int* lrows, const LAS float* lbias) const {
        const int row0 = u.m0 + wr * 64 + fr, col0 = u.n0 + wc * 32 + 8 * fq;
        const int mode = (u.n0 < 1024 || (u.n0 >= 3072 && u.n0 < 4096)) ? 1 : ((u.n0 >= 1024 && u.n0 < 2048) ? 2 : 0);
        f32x4 lbv[2][2];
        if (mode == 2) {
#pragma unroll
            for (int bj = 0; bj < 2; ++bj) { lbv[bj][0] = *(const f32x4*)(lb + col0 - 1024 + bj * HALF); lbv[bj][1] = *(const f32x4*)(lb + col0 - 1024 + bj * HALF + 4); } }
#pragma unroll
        for (int ai = 0; ai < NAI; ++ai)
#pragma unroll
            for (int m = 0; m < 4; ++m) { const size_t rowi = (size_t)(row0 + ai * HALF + m * 16); bf16_t* rowp = O + rowi * ldc + col0;
#pragma unroll
                for (int bj = 0; bj < 2; ++bj) { f32x4 v0 = acc[ai][bj][m][0], v1 = acc[ai][bj][m][1];
                    f32x4 o0 = {0.f, 0.f, 0.f, 0.f}, o1 = o0;
                    if (mode != 0) {
                        f32x4 e0 = v0 * (-1.4426950408889634f), e1 = v1 * (-1.4426950408889634f);
#pragma unroll
                        for (int j = 0; j < 4; ++j) { e0[j] = __builtin_amdgcn_exp2f(e0[j]); e1[j] = __builtin_amdgcn_exp2f(e1[j]); }
                        e0 = e0 + 1.f; e1 = e1 + 1.f;
#pragma unroll
                        for (int j = 0; j < 4; ++j) { e0[j] = __builtin_amdgcn_rcpf(e0[j]); e1[j] = __builtin_amdgcn_rcpf(e1[j]); }
                        if (mode == 1) { v0 = v0 * e0; v1 = v1 * e1; }
                        else { const f32x4 f0 = lbv[bj][0] + (1.f - lbv[bj][0]) * e0, f1 = lbv[bj][1] + (1.f - lbv[bj][1]) * e1;
#pragma unroll
                            for (int j = 0; j < 4; ++j) { v0[j] = __builtin_amdgcn_logf(f0[j]); v1[j] = __builtin_amdgcn_logf(f1[j]); }
                            o0 = 1.f - f0; o1 = 1.f - f1; } }
                    if (mode == 2) {
                        u32x4 w2; w2[0] = cvt_pk_bf16(o0[0], o0[1]); w2[1] = cvt_pk_bf16(o0[2], o0[3]); w2[2] = cvt_pk_bf16(o1[0], o1[1]); w2[3] = cvt_pk_bf16(o1[2], o1[3]);
                        *(u32x4*)(OMF + rowi * HG_W + (col0 - 1024) + bj * HALF) = w2; }
                    u32x4 w; w[0] = cvt_pk_bf16(v0[0], v0[1]); w[1] = cvt_pk_bf16(v0[2], v0[3]); w[2] = cvt_pk_bf16(v1[0], v1[1]); w[3] = cvt_pk_bf16(v1[2], v1[3]);
                    *(u32x4*)(rowp + bj * HALF) = w; } }
    }
};
struct EpiResF32 {
    static constexpr bool PERM = false;
    float* C; const float* res; int ldc;
    template <int NAI> __device__ __forceinline__ void run(const f32x4 (&acc)[2][2][4][2], const Unit& u, int wr, int wc, int fr, int fq, const LAS int* lrows, const LAS float* lbias) const {
        const int row0 = u.m0 + wr * 64 + fr, col0 = u.n0 + wc * 32 + 4 * fq;
#pragma unroll
        for (int ai = 0; ai < NAI; ++ai)
#pragma unroll
            for (int m = 0; m < 4; ++m) { const size_t off = (size_t)(row0 + ai * HALF + m * 16) * ldc + col0;
#pragma unroll
                for (int bj = 0; bj < 2; ++bj)
#pragma unroll
                    for (int n = 0; n < 2; ++n) { const f32x4 r = *(const f32x4*)(res + off + bj * HALF + n * 16); *(f32x4*)(C + off + bj * HALF + n * 16) = acc[ai][bj][m][n] + r; } }
    }
};
struct EpiResBf16 {
    static constexpr bool PERM = true;
    bf16_t* C; const float* res; int ldc;
    template <int NAI> __device__ __forceinline__ void run(const f32x4 (&acc)[2][2][4][2], const Unit& u, int wr, int wc, int fr, int fq, const LAS int*, const LAS float*) const {
        const int row0 = u.m0 + wr * 64 + fr, col0 = u.n0 + wc * 32 + 8 * fq;
#pragma unroll
        for (int ai = 0; ai < NAI; ++ai)
#pragma unroll
            for (int m = 0; m < 4; ++m) { const size_t off = (size_t)(row0 + ai * HALF + m * 16) * ldc + col0;
#pragma unroll
                for (int bj = 0; bj < 2; ++bj) { const f32x4 r0 = *(const f32x4*)(res + off + bj * HALF), r1 = *(const f32x4*)(res + off + bj * HALF + 4);
                    const f32x4 v0 = acc[ai][bj][m][0] + r0, v1 = acc[ai][bj][m][1] + r1;
                    u32x4 w; w[0] = cvt_pk_bf16(v0[0], v0[1]); w[1] = cvt_pk_bf16(v0[2], v0[3]); w[2] = cvt_pk_bf16(v1[0], v1[1]); w[3] = cvt_pk_bf16(v1[2], v1[3]);
                    *(u32x4*)(C + off + bj * HALF) = w; } }
    }
};
struct EpiGateUp {
    static constexpr bool PERM = true;
    unsigned char* ACT; const float* bias;
    template <int NAI> __device__ __forceinline__ void run(const f32x4 (&acc)[2][2][4][2], const Unit& u, int wr, int wc, int fr, int fq, const LAS int* lrows, const LAS float* lbias) const {
        const int colh = u.n0 * HALF + wc * 32 + 8 * fq;
        const LAS float* bp = lbias + wc * 32 + 8 * fq;
        const f32x4 bg0 = *(const LAS f32x4*)bp, bg1 = *(const LAS f32x4*)(bp + 4), bu0 = *(const LAS f32x4*)(bp + 128), bu1 = *(const LAS f32x4*)(bp + 132);
#pragma unroll
        for (int ai = 0; ai < NAI; ++ai)
#pragma unroll
            for (int m = 0; m < 4; ++m) { const int r = ai * HALF + wr * 64 + m * 16 + fr;
                if (r < u.nvalid) { const int asg = lrows[r];
                    f32x4 g0 = acc[ai][0][m][0] + bg0, g1 = acc[ai][0][m][1] + bg1, u0 = acc[ai][1][m][0] + bu0, u1 = acc[ai][1][m][1] + bu1;
                    f32x4 e0, e1;
#pragma unroll
                    for (int j = 0; j < 4; ++j) { g0[j] = fminf(g0[j], 7.f); g1[j] = fminf(g1[j], 7.f); u0[j] = __builtin_amdgcn_fmed3f(u0[j], -7.f, 7.f); u1[j] = __builtin_amdgcn_fmed3f(u1[j], -7.f, 7.f); }
                    const f32x4 z0 = g0 * (-1.702f * 1.4426950408889634f), z1 = g1 * (-1.702f * 1.4426950408889634f);
#pragma unroll
                    for (int j = 0; j < 4; ++j) { e0[j] = __builtin_amdgcn_exp2f(z0[j]); e1[j] = __builtin_amdgcn_exp2f(z1[j]); }
                    e0 = e0 + 1.f; e1 = e1 + 1.f;
#pragma unroll
                    for (int j = 0; j < 4; ++j) { e0[j] = __builtin_amdgcn_rcpf(e0[j]); e1[j] = __builtin_amdgcn_rcpf(e1[j]); }
                    const f32x4 o0 = (g0 * e0) * (u0 + 1.f), o1 = (g1 * e1) * (u1 + 1.f);
                    u32x2 w; w[0] = cvt4_fp8(o0[0], o0[1], o0[2], o0[3]); w[1] = cvt4_fp8(o1[0], o1[1], o1[2], o1[3]);
                    *(u32x2*)(ACT + (size_t)asg * DFF + colh) = w; } }
    }
};
struct EpiDown {
    static constexpr bool PERM = true;
    unsigned char* Y; const float* bias;
    template <int NAI> __device__ __forceinline__ void run(const f32x4 (&acc)[2][2][4][2], const Unit& u, int wr, int wc, int fr, int fq, const LAS int* lrows, const LAS float* lbias) const {
        const int col0 = u.n0 * BM + wc * 32 + 8 * fq;
        const LAS float* bp = lbias + wc * 32 + 8 * fq;
        f32x4 bv[2][2];
#pragma unroll
        for (int bj = 0; bj < 2; ++bj) { bv[bj][0] = *(const LAS f32x4*)(bp + bj * HALF); bv[bj][1] = *(const LAS f32x4*)(bp + bj * HALF + 4); }
#pragma unroll
        for (int ai = 0; ai < NAI; ++ai)
#pragma unroll
            for (int m = 0; m < 4; ++m) { const int r = ai * HALF + wr * 64 + m * 16 + fr;
                if (r < u.nvalid) { const int asg = lrows[r]; unsigned char* rowp = Y + (size_t)asg * DM + col0;
#pragma unroll
                    for (int bj = 0; bj < 2; ++bj) { const f32x4 v0 = acc[ai][bj][m][0] + bv[bj][0], v1 = acc[ai][bj][m][1] + bv[bj][1];
                        u32x2 w; w[0] = cvt4_fp8(v0[0], v0[1], v0[2], v0[3]); w[1] = cvt4_fp8(v1[0], v1[1], v1[2], v1[3]);
                        *(u32x2*)(rowp + bj * HALF) = w; } } }
    }
};
}

struct Args { const float* in[18]; float* out; unsigned char* ws; int ph_lo, ph_hi; };
enum { I_X = 0, I_N1G, I_WIN, I_LBL, I_HGNG, I_CPOS, I_CW1, I_CW2, I_NSAG, I_WOUT, I_N2G, I_WR, I_BR, I_WGU, I_BGU, I_WD, I_BD, I_FNG };
constexpr int LDS_STAGE = 131072, LDS_BYTES = LDS_STAGE + 16384, LDS_MISC = LDS_BYTES - 4096;

struct Frame {
    LAS unsigned char* lds; unsigned char* ws; unsigned* ctl; int tid, wid, lane, G, bid;
};

__device__ __forceinline__ void conv_tile(const Frame& F, const float* src, int lds_, int k0, int n0, int N, bf16_t* dst, int ldd) {
    LAS float* tile = (LAS float*)F.lds;
#pragma unroll
    for (int p = 0; p < 2; ++p) { const int k = p * 32 + (F.tid >> 4), n = (F.tid & 15) * 4;
        f32x4 v = (f32x4){0.f, 0.f, 0.f, 0.f};
        if (n0 + n < N) v = *(const f32x4*)(src + (size_t)(k0 + k) * lds_ + n0 + n);
        tile[k * 65 + n] = v[0]; tile[k * 65 + n + 1] = v[1]; tile[k * 65 + n + 2] = v[2]; tile[k * 65 + n + 3] = v[3]; }
    __syncthreads();
    { const int n = F.tid >> 3, kc = (F.tid & 7) * 8;
      if (n0 + n < N) { float f[8];
#pragma unroll
          for (int j = 0; j < 8; ++j) f[j] = tile[(kc + j) * 65 + n];
          u32x4 w; w[0] = cvt_pk_bf16(f[0], f[1]); w[1] = cvt_pk_bf16(f[2], f[3]); w[2] = cvt_pk_bf16(f[4], f[5]); w[3] = cvt_pk_bf16(f[6], f[7]);
          *(u32x4*)(dst + (size_t)(n0 + n) * ldd + k0 + kc) = w; } }
    __syncthreads();
}
struct ConvJob { const float* src; unsigned char* dst; int N; };
__device__ __forceinline__ ConvJob conv_job(const Args& a, unsigned char* ws, int st, int& kt, int& ntile) {
    ConvJob j;
    if (st < 8192) { const int e = st >> 8, r = st & 255; kt = r >> 4; ntile = r & 15; j.src = a.in[I_WGU] + (size_t)e * DM * 4096; j.dst = ws + WS_WGUT + (size_t)e * 4096 * DM; j.N = 4096; }
    else { const int q = st - 8192, e = q >> 7, r = q & 127; kt = r >> 3; ntile = r & 7; j.src = a.in[I_WD] + (size_t)e * DFF * DM; j.dst = ws + WS_WDT + (size_t)e * DM * DFF; j.N = 2048; }
    return j;
}
__device__ __forceinline__ void conv_experts(const Frame& F, const Args& a, int first, int stride, int limit) {
    unsigned char* ws = F.ws; LAS unsigned* tile = (LAS unsigned*)F.lds;
    LAS float* mtab = (LAS float*)(F.lds + 32768);
    if (F.tid < 64) mtab[F.tid] = shift_mult(amax_shift(__hip_atomic_load(F.ctl + CW_AMAX + F.tid, __ATOMIC_RELAXED, __HIP_MEMORY_SCOPE_AGENT)));
    __syncthreads();
    const int NST = limit;
    const int lk = F.tid >> 5, lc = F.tid & 31;
    f32x4 v[16];
    int st = first, kt = 0, ntile = 0; ConvJob J{};
#define CV_LOAD() do { _Pragma("unroll") for (int T = 0; T < 2; ++T) _Pragma("unroll") for (int pp = 0; pp < 8; ++pp) \
        v[T * 8 + pp] = __builtin_nontemporal_load((const f32x4*)(J.src + (size_t)(kt * 128 + pp * 16 + lk) * J.N + ntile * 256 + T * 128 + lc * 4)); } while (0)
    if (st < NST) { J = conv_job(a, ws, st, kt, ntile); CV_LOAD(); }
    for (; st < NST; st += stride) {
        const float mlt = mtab[st < 8192 ? (st >> 8) : 32 + ((st - 8192) >> 7)];
#pragma unroll
        for (int T = 0; T < 2; ++T)
#pragma unroll
            for (int pp = 0; pp < 8; ++pp) { const int k = pp * 16 + lk; const f32x4 x = v[T * 8 + pp];
                tile[T * 4096 + k * 32 + (lc ^ (4 * (k >> 4)))] = cvt4_fp8s(x[0], x[1], x[2], x[3], mlt); }
        __syncthreads();
        const ConvJob Jc = J; const int ktc = kt, ntc = ntile;
        const int nx = st + stride;
        if (nx < NST) { J = conv_job(a, ws, nx, kt, ntile); CV_LOAD(); }
        { const int i = F.tid & 7, n4g = (F.tid >> 3) & 31, T = F.tid >> 8;
          unsigned d[16];
#pragma unroll
          for (int jj = 0; jj < 16; ++jj) d[jj] = tile[T * 4096 + (16 * i + jj) * 32 + (n4g ^ (4 * i))];
          u32x4 o[4];
#pragma unroll
          for (int q = 0; q < 4; ++q) {
              const unsigned a0 = __builtin_amdgcn_perm(d[4 * q + 1], d[4 * q], 0x05010400u), a1 = __builtin_amdgcn_perm(d[4 * q + 1], d[4 * q], 0x07030602u);
              const unsigned a2 = __builtin_amdgcn_perm(d[4 * q + 3], d[4 * q + 2], 0x05010400u), a3 = __builtin_amdgcn_perm(d[4 * q + 3], d[4 * q + 2], 0x07030602u);
              o[0][q] = __builtin_amdgcn_perm(a2, a0, 0x05040100u); o[1][q] = __builtin_amdgcn_perm(a2, a0, 0x07060302u);
              o[2][q] = __builtin_amdgcn_perm(a3, a1, 0x05040100u); o[3][q] = __builtin_amdgcn_perm(a3, a1, 0x07060302u); }
          unsigned char* dp = Jc.dst + (size_t)(ntc * 256 + T * 128 + n4g * 4) * DM + ktc * 128 + 16 * i;
#pragma unroll
          for (int r = 0; r < 4; ++r) *(u32x4*)(dp + (size_t)r * DM) = o[r]; }
        __syncthreads();
    }
#undef CV_LOAD
}
__device__ __forceinline__ void conv_matrix4(const Frame& F, const float* src, int K, int N, bf16_t* dst) {
    LAS float* tile = (LAS float*)F.lds;
    const int tn4 = (N + 255) / 256, tk = K / 64, cnt = tn4 * tk;
    for (int t = F.bid; t < cnt; t += F.G) { const int k0 = (t / tn4) * 64, n00 = (t % tn4) * 256;
        f32x4 v[8];
#pragma unroll
        for (int q = 0; q < 4; ++q)
#pragma unroll
            for (int p = 0; p < 2; ++p) { const int k = p * 32 + (F.tid >> 4), n = n00 + q * 64 + (F.tid & 15) * 4;
                v[q * 2 + p] = (n < N) ? *(const f32x4*)(src + (size_t)(k0 + k) * N + n) : (f32x4){0.f, 0.f, 0.f, 0.f}; }
#pragma unroll
        for (int q = 0; q < 4; ++q)
#pragma unroll
            for (int p = 0; p < 2; ++p) { LAS float* tp = tile + q * (64 * 65) + (p * 32 + (F.tid >> 4)) * 65 + (F.tid & 15) * 4; const f32x4 x = v[q * 2 + p]; tp[0] = x[0]; tp[1] = x[1]; tp[2] = x[2]; tp[3] = x[3]; }
        __syncthreads();
        { const int n = F.tid >> 3, kc = (F.tid & 7) * 8;
#pragma unroll
          for (int q = 0; q < 4; ++q) { const int nn = n00 + q * 64 + n;
              if (nn < N) { float f[8];
#pragma unroll
                  for (int j = 0; j < 8; ++j) f[j] = tile[q * (64 * 65) + (kc + j) * 65 + n];
                  u32x4 w; w[0] = cvt_pk_bf16(f[0], f[1]); w[1] = cvt_pk_bf16(f[2], f[3]); w[2] = cvt_pk_bf16(f[4], f[5]); w[3] = cvt_pk_bf16(f[6], f[7]);
                  *(u32x4*)(dst + (size_t)nn * K + k0 + kc) = w; } } }
        __syncthreads(); }
}
__device__ __forceinline__ void conv_matrix(const Frame& F, const float* src, int K, int N, bf16_t* dst, long& base) {
    const int tn = (N + 63) / 64, tk = K / 64; const long cnt = (long)tn * tk;
    long first = ((long)F.bid - base) % F.G; if (first < 0) first += F.G;
    for (long t = first; t < cnt; t += F.G) { const int kt = (int)(t / tn), nt_ = (int)(t % tn); conv_tile(F, src, N, kt * 64, nt_ * 64, N, dst, K); }
    base += cnt;
}
__device__ __forceinline__ void bias1_partials(const Frame& F, const Args& a, int rank, int nranks) {
    LAS float* red = (LAS float*)F.lds;
    const int c = F.tid & 127, kq = F.tid >> 7;
    for (int job = rank; job < 64; job += nranks) { const int j = job >> 5, kg = job & 31;
        const float* pos = a.in[I_CPOS] + (size_t)j * 4096 + kg * 128 + kq * 32; const float* w1 = a.in[I_CW1] + ((size_t)j * 4096 + kg * 128 + kq * 32) * 128 + c;
        float s0 = 0.f, s1 = 0.f, s2 = 0.f, s3 = 0.f;
#pragma unroll
        for (int k = 0; k < 32; k += 4) { s0 += pos[k] * w1[(size_t)k * 128]; s1 += pos[k + 1] * w1[(size_t)(k + 1) * 128]; s2 += pos[k + 2] * w1[(size_t)(k + 2) * 128]; s3 += pos[k + 3] * w1[(size_t)(k + 3) * 128]; }
        red[kq * 128 + c] = (s0 + s1) + (s2 + s3);
        __syncthreads();
        if (F.tid < 128) ((float*)(F.ws + WS_B1P))[((size_t)j * 32 + kg) * 128 + c] = ((red[c] + red[128 + c]) + red[256 + c]) + red[384 + c];
        __syncthreads(); }
}
__device__ __forceinline__ void p0_sample(const Frame& F, const Args& a) {
    const int j = F.bid & 63, q = F.bid >> 6, nq = (F.G + 63 - j) >> 6;
    const float* src; size_t stride; int nalt;
    if (j < 32) { src = a.in[I_WGU] + (size_t)j * DM * 4096; stride = (size_t)DM * 4096 / 64; nalt = 2; }
    else { src = a.in[I_WD] + (size_t)(j - 32) * DFF * DM; stride = (size_t)DFF * DM / 64; nalt = 1; }
    float mx = 0.f;
    for (int c = q; c < 64; c += nq) { const f32x4 v = *(const f32x4*)(src + (size_t)c * stride + (size_t)(c % nalt) * 2048 + F.tid * 4);
        mx = fmaxf(fmaxf(mx, fmaxf(fabsf(v[0]), fabsf(v[1]))), fmaxf(fabsf(v[2]), fabsf(v[3]))); }
    mx = wave_max(mx);
    if (F.lane == 0 && mx > 0.f) atomicMax(F.ctl + CW_AMAX + j, __float_as_uint(mx));
}
__device__ __forceinline__ void p0_prologue(const Frame& F, const Args& a) {
    unsigned char* ws = F.ws;
    long base = 0;
    p0_sample(F, a);
    static_assert(CONV_P0 == 0, "expert tiles need the sampled scales: none may be converted in the prologue");
    conv_matrix4(F, a.in[I_WIN], DM, IN_COLS, (bf16_t*)(ws + WS_WINT));
    conv_matrix(F, a.in[I_WOUT], DM, DM, (bf16_t*)(ws + WS_WOUTT), base);
    for (int fi = F.bid * NTHREADS + F.tid; fi < 2 * 8 * 32 * 4 * 64; fi += F.G * NTHREADS) {
        const int ln_ = fi & 63, ct = (fi >> 6) & 3, ks = (fi >> 8) & 31, w = (fi >> 13) & 7, j = fi >> 16;
        const float* wp = a.in[I_CW1] + ((size_t)j * 4096 + w * 512 + ks * 16 + (ln_ >> 5) * 8) * 128 + ct * 32 + (ln_ & 31);
        u32x4 fw; fw[0] = cvt_pk_bf16(wp[0], wp[128]); fw[1] = cvt_pk_bf16(wp[256], wp[384]); fw[2] = cvt_pk_bf16(wp[512], wp[640]); fw[3] = cvt_pk_bf16(wp[768], wp[896]);
        *(u32x4*)((bf16_t*)(ws + WS_W1T) + (size_t)fi * 8) = fw; }
    for (int j = 0; j < 2; ++j) conv_matrix(F, a.in[I_CW2] + (size_t)j * 128 * 128, 128, 128, (bf16_t*)(ws + WS_W2T) + (size_t)j * 128 * 128, base);
    { const float* x = a.in[I_X]; const float* g = a.in[I_N1G]; bf16_t* U = (bf16_t*)(ws + WS_U);
      f32x4 vn[8]; int row = F.bid * 8 + F.wid;
#define P0_LDROW(r_) do { const float* xr_ = x + (size_t)(r_) * DM; _Pragma("unroll") for (int i = 0; i < 4; ++i) { vn[2 * i] = *(const f32x4*)(xr_ + i * 512 + F.lane * 8); vn[2 * i + 1] = *(const f32x4*)(xr_ + i * 512 + F.lane * 8 + 4); } } while (0)
      if (row < NTOK) P0_LDROW(row);
      for (; row < NTOK; row += F.G * 8) {
          f32x4 v[8]; float ss = 0.f;
#pragma unroll
          for (int i = 0; i < 8; ++i) v[i] = vn[i];
          if (row + F.G * 8 < NTOK) P0_LDROW(row + F.G * 8);
#pragma unroll
          for (int i = 0; i < 8; ++i)
#pragma unroll
              for (int j = 0; j < 4; ++j) ss += v[i][j] * v[i][j];
          ss = wave_sum(ss); const float rs = rsqrtf(ss * (1.f / DM) + EPS);
#pragma unroll
          for (int i = 0; i < 4; ++i) { const f32x4 g0 = *(const f32x4*)(g + i * 512 + F.lane * 8), g1 = *(const f32x4*)(g + i * 512 + F.lane * 8 + 4);
              const f32x4 a0 = v[2 * i] * rs * g0, a1 = v[2 * i + 1] * rs * g1;
              u32x4 w; w[0] = cvt_pk_bf16(a0[0], a0[1]); w[1] = cvt_pk_bf16(a0[2], a0[3]); w[2] = cvt_pk_bf16(a1[0], a1[1]); w[3] = cvt_pk_bf16(a1[2], a1[3]);
              *(u32x4*)(U + (size_t)row * DM + i * 512 + F.lane * 8) = w; } }
#undef P0_LDROW
    }
    { const int gw = F.bid * 8 + F.wid;
      (void)gw;
      for (int i = F.bid * NTHREADS + F.tid; i < DM * NEXP; i += F.G * NTHREADS) ((float*)(ws + WS_WR2))[i] = a.in[I_N2G][i >> 5] * a.in[I_WR][i];
      for (int i = F.bid * NTHREADS + F.tid; i < HG_W; i += F.G * NTHREADS) { const float l0 = a.in[I_LBL][i], l1 = a.in[I_LBL][HG_W + i]; const float m = fmaxf(l0, l1);
          const float e0 = __expf(l0 - m), e1 = __expf(l1 - m); ((float*)(ws + WS_LB))[i] = e0 / (e0 + e1); } }
}

__device__ __forceinline__ float gelu_tanh(float x) { const float u = 0.7978845608028654f * (x + 0.044715f * x * x * x); return 0.5f * x * (1.f + tanhf(u)); }
__device__ __forceinline__ void p2_compress_naive(const Frame& F, const Args& a) {
    unsigned char* ws = F.ws; const bf16_t* PROJ = (const bf16_t*)(ws + WS_PROJ);
    LAS float* red = (LAS float*)F.lds;
    LAS float* hdn = red + 512;
    const int c = F.tid & 127, kq = F.tid >> 7;
    for (int u = F.bid; u < 2 * 16 * 128; u += F.G) {
        const int j = u >> 11, bg = (u >> 7) & 15, n = u & 127, b = bg >> 1, g = bg & 1;
        bf16_t* dst = (bf16_t*)(ws + (j ? WS_VC : WS_KC)) + ((size_t)bg * 128 + n) * 128;
        if (n == 127) { if (F.tid < 128) dst[F.tid] = 0; continue; }
        const float* w1 = a.in[I_CW1] + (size_t)j * 4096 * 128; const float* pos = a.in[I_CPOS] + (size_t)j * 4096;
        const int colb = (j ? C_VCM : C_KCM) + g * 128;
        float s = 0.f;
        for (int k = kq * 1024; k < kq * 1024 + 1024; ++k) { const int l = k >> 7, d = k & 127;
            const float av = bf2f(PROJ[(size_t)(b * SEQ + 16 * n + l) * PROJ_LD + colb + d]) + pos[k];
            s += av * w1[(size_t)k * 128 + c]; }
        red[kq * 128 + c] = s; __syncthreads();
        if (F.tid < 128) hdn[c] = gelu_tanh(red[c] + red[128 + c] + red[256 + c] + red[384 + c]);
        __syncthreads();
        if (F.tid < 128) { const float* w2 = a.in[I_CW2] + (size_t)j * 128 * 128; float o = 0.f; for (int k = 0; k < 128; ++k) o += hdn[k] * w2[k * 128 + c]; dst[c] = f2bf(o); }
        __syncthreads();
    }
}

__device__ __forceinline__ void hgrn_naive_unit(const Frame& F, const Args& a, int unit) {
    unsigned char* ws = F.ws; const bf16_t* PROJ = (const bf16_t*)(ws + WS_PROJ); bf16_t* YM = (bf16_t*)(ws + WS_YMIX);
    const float* lbv = (const float*)(ws + WS_LB);
    const int b = unit >> 3, h = unit & 7, v = F.tid & 127, kg = F.tid >> 7;
    LAS float* fs = (LAS float*)F.lds;
    LAS float* qs = fs + 2048; LAS float* is_ = qs + 2048; LAS float* red = is_ + 2048  ; LAS float* ob = red + 512  ;
    float S[32];
#pragma unroll
    for (int i = 0; i < 32; ++i) S[i] = 0.f;
    for (int t0 = 0; t0 < SEQ; t0 += 16) {
        for (int i = F.tid; i < 2048; i += NTHREADS) { const int st = i >> 7, k = i & 127; const size_t rowo = (size_t)(b * SEQ + t0 + st) * PROJ_LD + h * 128 + k;
            const float lb = lbv[h * 128 + k];
            fs[i] = lb + (1.f - lb) * sigmoidf_(bf2f(PROJ[rowo + C_HF])); qs[i] = siluf_(bf2f(PROJ[rowo + C_HQ])); is_[i] = bf2f(PROJ[rowo + C_HI]); }
        __syncthreads();
        for (int st = 0; st < 16; ++st) {
            const float iv = is_[st * 128 + v]; float po = 0.f;
#pragma unroll
            for (int kk = 0; kk < 32; ++kk) { const int k = kg * 32 + kk; const float f = fs[st * 128 + k]; S[kk] = f * S[kk] + (1.f - f) * iv; po += S[kk] * qs[st * 128 + k]; }
            red[kg * 128 + v] = po; __syncthreads();
            if (kg == 0) ob[st * 128 + v] = red[v] + red[128 + v] + red[256 + v] + red[384 + v];
            __syncthreads();
        }
        for (int s2 = 0; s2 < 2; ++s2) { const int st = F.wid * 2 + s2; const float o0 = ob[st * 128 + F.lane], o1 = ob[st * 128 + 64 + F.lane];
            const float ss = wave_sum(o0 * o0 + o1 * o1); const float rs = rsqrtf(ss * (1.f / 128.f) + EPS);
            const size_t row = (size_t)(b * SEQ + t0 + st);
            const float g0 = bf2f(PROJ[row * PROJ_LD + C_HGT + h * 128 + F.lane]), g1 = bf2f(PROJ[row * PROJ_LD + C_HGT + h * 128 + 64 + F.lane]);
            YM[row * DM + h * 128 + F.lane] = f2bf(o0 * rs * a.in[I_HGNG][F.lane] * siluf_(g0));
            YM[row * DM + h * 128 + 64 + F.lane] = f2bf(o1 * rs * a.in[I_HGNG][64 + F.lane] * siluf_(g1)); }
        __syncthreads();
    }
}

__device__ __forceinline__ float dot128_bf(const LAS float* q, const bf16_t* k) {
    float s = 0.f;
#pragma unroll
    for (int c = 0; c < 16; ++c) { const u32x4 w = *(const u32x4*)(k + c * 8); float f[8]; unpack8(w, f);
#pragma unroll
        for (int j = 0; j < 8; ++j) s += q[c * 8 + j] * f[j]; }
    return s;
}
__device__ __forceinline__ void softmax4(const Frame& F, LAS float* sc, int stride, int n, LAS float* tmp  ) {
    const int r = F.tid >> 7, i0 = F.tid & 127;
    float m = -INFINITY; for (int i = i0; i < n; i += 128) m = fmaxf(m, sc[r * stride + i]);
    m = wave_max(m); if (F.lane == 0) tmp[F.wid] = m; __syncthreads();
    m = fmaxf(tmp[2 * r], tmp[2 * r + 1]); __syncthreads();
    float s = 0.f;
    for (int i = i0; i < n; i += 128) { const float x = sc[r * stride + i]; const float p = (x == -INFINITY) ? 0.f : __expf(x - m); sc[r * stride + i] = p; s += p; }
    s = wave_sum(s); if (F.lane == 0) tmp[F.wid] = s; __syncthreads();
    s = tmp[2 * r] + tmp[2 * r + 1]; const float inv = s > 0.f ? 1.f / s : 0.f;
    for (int i = i0; i < n; i += 128) sc[r * stride + i] *= inv;
    __syncthreads();
}
__device__ __forceinline__ void attn_naive_unit(const Frame& F, const Args& a, int unit) {
    unsigned char* ws = F.ws; const bf16_t* PROJ = (const bf16_t*)(ws + WS_PROJ); bf16_t* YM = (bf16_t*)(ws + WS_YMIX);
    const int b = unit >> 12, g = (unit >> 11) & 1, t = unit & 2047, bg = b * 2 + g;
    LAS float* qs = (LAS float*)F.lds;
    LAS float* sc = qs + 512;
    LAS float* tmp = sc + 4096;
    LAS float* imp = tmp + 16;
    LAS int* selk = (LAS int*)(imp + 32);
    LAS float* oacc = (LAS float*)(selk + 32);
    const int r4 = F.tid >> 7, d = F.tid & 127;
    const size_t rowq = (size_t)(b * SEQ + t) * PROJ_LD;
    qs[F.tid] = bf2f(PROJ[rowq + C_NQ + (g * 4 + r4) * 128 + d]);
    const float slope = exp2f(-(float)(g * 4 + r4 + 1));
    const float scale = 0.08838834764831845f;
    float gate[3];
#pragma unroll
    for (int c = 0; c < 3; ++c) gate[c] = sigmoidf_(bf2f(PROJ[rowq + C_NGT + (g * 4 + r4) * 3 + c]));
    __syncthreads();
    { const int n = d; float s = -INFINITY;
      if (n < NCMP) { const int dist = t - (16 * n + 31); if (dist >= 0) s = dot128_bf(qs + r4 * 128, (const bf16_t*)(ws + WS_KC) + ((size_t)bg * 128 + n) * 128) * scale - slope * (float)dist; }
      sc[r4 * 1024 + n] = s; }
    __syncthreads();
    softmax4(F, sc, 1024, 128, tmp);
    { float o = 0.f; const bf16_t* vc = (const bf16_t*)(ws + WS_VC) + (size_t)bg * 128 * 128;
      for (int n = 0; n < NCMP; ++n) o += sc[r4 * 1024 + n] * bf2f(vc[n * 128 + d]);
      oacc[F.tid] = gate[0] * o; }
    if (F.tid < 32) { const int j = F.tid; float s = 0.f;
        for (int r = 0; r < 4; ++r) for (int q = -1; q <= 3; ++q) { const int n = 4 * j + q; if (n >= 0 && n < NCMP) s += ((q == -1 || q == 3) ? 1.f : 2.f) * sc[r * 1024 + n]; }
        const int cur = t >> 6; const bool forced = (j == 0) || (j == cur) || (j == cur - 1);
        imp[j] = forced ? 1e4f : (j <= cur ? s : -1e4f); }
    __syncthreads();
    if (F.tid < 32) { const int j = F.tid; const float me = imp[j]; int rank = 0;
        for (int k = 0; k < 32; ++k) { const float o = imp[k]; rank += (o > me || (o == me && k < j)) ? 1 : 0; }
        const bool sel = rank < SEL_TOP && j <= (t >> 6);
        const unsigned long long mask = __ballot(sel);
        if (sel) selk[__popcll(mask & ((1ull << j) - 1ull))] = j;
        if (j == 0) selk[16] = __popcll(mask); }
    __syncthreads();
    { const int nsel = selk[16];
      for (int i = F.tid; i < 4 * 1024; i += NTHREADS) sc[i] = -INFINITY;
      __syncthreads();
      const int l = F.tid & 63, r = (F.tid >> 6) & 3, which = F.tid >> 8;
      for (int s0 = 0; s0 < nsel; s0 += 2) { const int si = s0 + which;
          if (si < nsel) { const int kp = selk[si] * 64 + l;
              if (kp <= t) { const float s = dot128_bf(qs + r * 128, PROJ + (size_t)(b * SEQ + kp) * PROJ_LD + C_KSL + g * 128) * scale - exp2f(-(float)(g * 4 + r + 1)) * (float)(t - kp); sc[r * 1024 + si * 64 + l] = s; } } }
      __syncthreads();
      softmax4(F, sc, 1024, nsel * 64, tmp);
      float o = 0.f;
      for (int si = 0; si < nsel; ++si) { const int kb = selk[si] * 64;
          for (int l2 = 0; l2 < 64; ++l2) { const int kp = kb + l2; if (kp > t) break; o += sc[r4 * 1024 + si * 64 + l2] * bf2f(PROJ[(size_t)(b * SEQ + kp) * PROJ_LD + C_VSL + g * 128 + d]); } }
      oacc[F.tid] += gate[1] * o; }
    __syncthreads();
    { for (int i = F.tid; i < 4 * 1024; i += NTHREADS) sc[i] = -INFINITY;
      __syncthreads();
      for (int i = F.tid; i < 4 * 512; i += NTHREADS) { const int r = i >> 9, w = i & 511, kp = t - 511 + w;
          if (kp >= 0) sc[r * 1024 + w] = dot128_bf(qs + r * 128, PROJ + (size_t)(b * SEQ + kp) * PROJ_LD + C_KWN + g * 128) * scale - exp2f(-(float)(g * 4 + r + 1)) * (float)(t - kp); }
      __syncthreads();
      softmax4(F, sc, 1024, 512, tmp);
      float o = 0.f;
      for (int w = 0; w < 512; ++w) { const int kp = t - 511 + w; if (kp >= 0) o += sc[r4 * 1024 + w] * bf2f(PROJ[(size_t)(b * SEQ + kp) * PROJ_LD + C_VWN + g * 128 + d]); }
      oacc[F.tid] += gate[2] * o; }
    __syncthreads();
    { const float o = oacc[F.tid]; float ss = wave_sum(o * o); if (F.lane == 0) tmp[F.wid] = ss; __syncthreads();
      ss = tmp[2 * r4] + tmp[2 * r4 + 1]; const float rs = rsqrtf(ss * (1.f / 128.f) + EPS);
      YM[(size_t)(b * SEQ + t) * DM + HG_W + (g * 4 + r4) * 128 + d] = f2bf(o * rs * a.in[I_NSAG][d]); }
    __syncthreads();
}

namespace at {
constexpr int SHM_T = 64 * 128 * 2;
constexpr int BUF_B = 2 * SHM_T;
constexpr int OFF_V = 0, OFF_K = SHM_T, OFF_IMP = 2 * BUF_B  , OFF_SELM = 3 * BUF_B, OFF_WSC = OFF_SELM + 256;
constexpr float SCALE = 0.08838834764831845f, LOG2E = 1.4426950408889634f, THR = 8.f;
#define AT_KSWZ(row, colB) ((row) * 256 + ((colB) ^ (((row) & 7) << 4)))
__device__ __forceinline__ int v_st(int k, int c) { const int kk = (k & ~0xC) | ((k & 4) << 1) | ((k & 8) >> 1); return ((kk >> 3) * 4 + (c >> 5)) * 512 + ((kk & 7) * 32 + (c & 31)) * 2; }
__device__ __forceinline__ int v_rd_base(int lane) { return ((lane & 3) << 3) | (((lane >> 2) & 3) << 6) | (((lane >> 4) & 1) << 5) | (((lane >> 5) & 1) << 8); }
__device__ __forceinline__ int crow(int r, int hi) { return (r & 3) + 8 * (r >> 2) + 4 * hi; }
typedef short s16x4 __attribute__((ext_vector_type(4)));
struct Stage { u32x4 k0, k1, v0, v1; };
__device__ __forceinline__ void stage_load(Stage& S, const bf16_t* Kp, const bf16_t* Vp, int ld, int row0, int sr, int sc) {
    S.k0 = *(const u32x4*)(Kp + (size_t)(row0 + sr) * ld + sc); S.k1 = *(const u32x4*)(Kp + (size_t)(row0 + 32 + sr) * ld + sc);
    S.v0 = *(const u32x4*)(Vp + (size_t)(row0 + sr) * ld + sc); S.v1 = *(const u32x4*)(Vp + (size_t)(row0 + 32 + sr) * ld + sc);
}
__device__ __forceinline__ void stage_write(const Stage& S, LAS unsigned char* lds, int buf, int sr, int sc) {
    const int kws = AT_KSWZ(sr, sc * 2);
    *(LAS u32x4*)(lds + OFF_K + buf * BUF_B + kws) = S.k0; *(LAS u32x4*)(lds + OFF_K + buf * BUF_B + kws + 32 * 256) = S.k1;
    *(LAS u32x4*)(lds + OFF_V + buf * BUF_B + v_st(sr, sc)) = S.v0; *(LAS u32x4*)(lds + OFF_V + buf * BUF_B + v_st(32 + sr, sc)) = S.v1;
}
template <bool EXTRA = false>
__device__ __forceinline__ void qkt(f32x16& p0, f32x16& p1, const LAS unsigned char* ktile, int r32, int hi, const bf16x8 (&qr)[8], bf16x8 kx0 = bf16x8{}, bf16x8 kx1 = bf16x8{}, bf16x8 qx = bf16x8{}) {
#pragma unroll
    for (int r = 0; r < 16; ++r) { p0[r] = 0.f; p1[r] = 0.f; }
    const LAS unsigned char* kb[4];
#pragma unroll
    for (int dd = 0; dd < 4; ++dd) kb[dd] = ktile + AT_KSWZ(r32, (dd * 16 + hi * 8) * 2);
#pragma unroll
    for (int d0 = 0; d0 < 8; ++d0) { const LAS unsigned char* a = kb[d0 & 3] + (d0 >> 2) * 128;
        const bf16x8 b0 = *(const LAS bf16x8*)a; const bf16x8 b1 = *(const LAS bf16x8*)(a + 32 * 256);
        p0 = __builtin_amdgcn_mfma_f32_32x32x16_bf16(b0, qr[d0], p0, 0, 0, 0);
        p1 = __builtin_amdgcn_mfma_f32_32x32x16_bf16(b1, qr[d0], p1, 0, 0, 0); }
    if constexpr (EXTRA) {
        p0 = __builtin_amdgcn_mfma_f32_32x32x16_bf16(kx0, qx, p0, 0, 0, 0);
        p1 = __builtin_amdgcn_mfma_f32_32x32x16_bf16(kx1, qx, p1, 0, 0, 0); }
}
__device__ __forceinline__ void pv_tile(f32x16 (&o)[4], int vb, bf16x8 pa0, bf16x8 pa1, bf16x8 pa2, bf16x8 pa3) {
#define AT_TRRD(dst, off) asm volatile("ds_read_b64_tr_b16 %0, %1 offset:%2" : "=&v"(dst) : "v"(vb), "i"(off) : "memory")
#define AT_PV_D0(d0) do { s16x4 l0, l1, l2, l3, h0, h1, h2, h3; constexpr int b_ = (d0) * 512; \
        AT_TRRD(l0, b_); AT_TRRD(h0, b_ + 2048); AT_TRRD(l1, b_ + 4096); AT_TRRD(h1, b_ + 6144); AT_TRRD(l2, b_ + 8192); AT_TRRD(h2, b_ + 10240); AT_TRRD(l3, b_ + 12288); AT_TRRD(h3, b_ + 14336); \
        asm volatile("s_waitcnt lgkmcnt(0)" ::: "memory"); __builtin_amdgcn_sched_barrier(0); \
        o[d0] = __builtin_amdgcn_mfma_f32_32x32x16_bf16(pa0, (bf16x8){l0[0], l0[1], l0[2], l0[3], h0[0], h0[1], h0[2], h0[3]}, o[d0], 0, 0, 0); \
        o[d0] = __builtin_amdgcn_mfma_f32_32x32x16_bf16(pa1, (bf16x8){l1[0], l1[1], l1[2], l1[3], h1[0], h1[1], h1[2], h1[3]}, o[d0], 0, 0, 0); \
        o[d0] = __builtin_amdgcn_mfma_f32_32x32x16_bf16(pa2, (bf16x8){l2[0], l2[1], l2[2], l2[3], h2[0], h2[1], h2[2], h2[3]}, o[d0], 0, 0, 0); \
        o[d0] = __builtin_amdgcn_mfma_f32_32x32x16_bf16(pa3, (bf16x8){l3[0], l3[1], l3[2], l3[3], h3[0], h3[1], h3[2], h3[3]}, o[d0], 0, 0, 0); } while (0)
    AT_PV_D0(0); AT_PV_D0(1); AT_PV_D0(2); AT_PV_D0(3);
#undef AT_PV_D0
#undef AT_TRRD
}
__device__ __forceinline__ float swap_max(float v) { auto rr = __builtin_amdgcn_permlane32_swap(__float_as_uint(v), __float_as_uint(v), false, false); return fmaxf(__uint_as_float(rr[0]), __uint_as_float(rr[1])); }
__device__ __forceinline__ float swap_sum(float v) { auto rr = __builtin_amdgcn_permlane32_swap(__float_as_uint(v), __float_as_uint(v), false, false); return __uint_as_float(rr[0]) + __uint_as_float(rr[1]); }
__device__ __forceinline__ void pack_p(const f32x16& P, bf16x8& outA, bf16x8& outB) {
#define AT_PK4(B_, OUT) do { unsigned a0 = cvt_pk_bf16(P[B_ + 0], P[B_ + 1]), a1 = cvt_pk_bf16(P[B_ + 2], P[B_ + 3]); \
        unsigned b0 = cvt_pk_bf16(P[B_ + 4], P[B_ + 5]), b1 = cvt_pk_bf16(P[B_ + 6], P[B_ + 7]); \
        auto r0 = __builtin_amdgcn_permlane32_swap(a0, b0, false, false); auto r1 = __builtin_amdgcn_permlane32_swap(a1, b1, false, false); \
        u32x4 w = {r0[0], r1[0], r0[1], r1[1]}; OUT = *reinterpret_cast<bf16x8*>(&w); } while (0)
    AT_PK4(0, outA); AT_PK4(8, outB);
#undef AT_PK4
}
__device__ __forceinline__ float online_sm1(const f32x16& p0, const f32x16& p1, float& m_reg, float& mnL) {
    float pmax = p0[0];
#pragma unroll
    for (int r = 1; r < 16; ++r) pmax = fmaxf(pmax, p0[r]);
#pragma unroll
    for (int r = 0; r < 16; ++r) pmax = fmaxf(pmax, p1[r]);
    pmax = swap_max(pmax);
    float mn, alpha;
    if (__all(pmax - m_reg <= THR)) { mn = m_reg; alpha = 1.f; }
    else { mn = fmaxf(m_reg, pmax); alpha = __builtin_amdgcn_exp2f((m_reg - mn) * LOG2E); m_reg = mn; }
    mnL = -mn * LOG2E;
    return alpha;
}
__device__ __forceinline__ float online_sm1_raw(const f32x16& p0, const f32x16& p1, float& m_reg, float& mnL, float base2) {
    float pmax = p0[0];
#pragma unroll
    for (int r = 1; r < 16; ++r) pmax = fmaxf(pmax, p0[r]);
#pragma unroll
    for (int r = 0; r < 16; ++r) pmax = fmaxf(pmax, p1[r]);
    pmax = fmaf(swap_max(pmax), SCALE, base2);
    float mn, alpha;
    if (__all(pmax - m_reg <= THR)) { mn = m_reg; alpha = 1.f; }
    else { mn = fmaxf(m_reg, pmax); alpha = __builtin_amdgcn_exp2f((m_reg - mn) * LOG2E); m_reg = mn; }
    mnL = (base2 - mn) * LOG2E;
    return alpha;
}
__device__ __forceinline__ void online_sm2_raw(f32x16& p0, f32x16& p1, float mnL, float alpha, float& l_reg) {
    constexpr float C2 = SCALE * LOG2E;
    float ps = 0.f;
#pragma unroll
    for (int r = 0; r < 16; ++r) { p0[r] = __builtin_amdgcn_exp2f(fmaf(p0[r], C2, mnL)); p1[r] = __builtin_amdgcn_exp2f(fmaf(p1[r], C2, mnL)); ps += p0[r] + p1[r]; }
    ps = swap_sum(ps);
    l_reg = l_reg * alpha + ps;
}
__device__ __forceinline__ void online_sm2(f32x16& p0, f32x16& p1, float mnL, float alpha, float& l_reg) {
    float ps = 0.f;
#pragma unroll
    for (int r = 0; r < 16; ++r) { p0[r] = __builtin_amdgcn_exp2f(fmaf(p0[r], LOG2E, mnL)); p1[r] = __builtin_amdgcn_exp2f(fmaf(p1[r], LOG2E, mnL)); ps += p0[r] + p1[r]; }
    ps = swap_sum(ps);
    l_reg = l_reg * alpha + ps;
}
template <int MODE>
__device__ __forceinline__ void branch_loop(f32x16 (&o)[4], float& l_out, LAS unsigned char* lds, const bf16_t* Kp, const bf16_t* Vp, int jlo, int qt,
                                            const bf16x8 (&qr)[8], int tq, float slope, unsigned selbits, int r32, int hi, int sr, int sc, LAS float* wsc, int wave_tmin, int grpB,
                                            const Stage& P0, const Stage& P1  ) {
    float m_reg = -1e30f, l_reg = 0.f;
#pragma unroll
    for (int d = 0; d < 4; ++d)
#pragma unroll
        for (int r = 0; r < 16; ++r) o[d][r] = 0.f;
    const int vb0 = (int)(uintptr_t)(lds + OFF_V) + v_rd_base(r32 + 32 * hi);
    const int NT = qt - jlo + 1;
    unsigned xk0w, xk1w, xqw;
    { const float sv = slope * (1.f / SCALE); const bf16_t shi = f2bf(sv), slo = f2bf(sv - bf2f(shi));
      xk0w = hi ? 0u : (unsigned)f2bf((float)r32) * 0x10001u; xk1w = hi ? 0u : (unsigned)f2bf((float)(32 + r32)) * 0x10001u; xqw = hi ? 0u : ((unsigned)shi | ((unsigned)slo << 16)); }
#define AT_LGKM0() asm volatile("s_waitcnt lgkmcnt(0)" ::: "memory")
#define AT_BAR() do { AT_LGKM0(); __builtin_amdgcn_s_barrier(); asm volatile("" ::: "memory"); } while (0)
    Stage S0; stage_write(P0, lds, 0, sr, sc); if (NT > 1) stage_write(P1, lds, 1, sr, sc);
    if (NT > 2) stage_load(S0, Kp, Vp, PROJ_LD, (jlo + 2) * 64, sr, sc);
    __syncthreads();
    if (grpB) AT_BAR();
    int buf = 0;
#define AT_STEP(tau, SX) do { \
        const int j = jlo + (tau); \
        f32x16 p0, p1; \
        bf16x8 kx0, kx1, qx; { unsigned t0_ = xk0w, t1_ = xk1w, t2_ = xqw; asm volatile("" : "+v"(t0_), "+v"(t1_), "+v"(t2_)); \
            u32x4 a0_ = {t0_, 0u, 0u, 0u}, a1_ = {t1_, 0u, 0u, 0u}, b0_ = {t2_, 0u, 0u, 0u}; kx0 = *reinterpret_cast<bf16x8*>(&a0_); kx1 = *reinterpret_cast<bf16x8*>(&a1_); qx = *reinterpret_cast<bf16x8*>(&b0_); } \
        qkt<true>(p0, p1, lds + OFF_K + buf * BUF_B, r32, hi, qr, kx0, kx1, qx); \
        const int kbase = j * 64; const int dq = tq - kbase - 4 * hi; \
        const float base2 = slope * (float)(kbase - tq); \
        if (MODE == 1) { \
            const bool on = (selbits >> j) & 1u; \
            if (j == qt) { \
                _Pragma("unroll") for (int r = 0; r < 16; ++r) { const int cc = (r & 3) + 8 * (r >> 2); if (!on || cc > dq) p0[r] = -INFINITY; if (!on || cc + 32 > dq) p1[r] = -INFINITY; } \
            } else if (!__all(on)) { \
                _Pragma("unroll") for (int r = 0; r < 16; ++r) { if (!on) { p0[r] = -INFINITY; p1[r] = -INFINITY; } } \
            } \
        } else { \
            if (kbase + 63 > wave_tmin || kbase < wave_tmin + 31 - (WINDOW - 1)) { \
                _Pragma("unroll") for (int r = 0; r < 16; ++r) { const int cc = (r & 3) + 8 * (r >> 2); \
                    if ((unsigned)(dq - cc) >= (unsigned)WINDOW) p0[r] = -INFINITY; if ((unsigned)(dq - cc - 32) >= (unsigned)WINDOW) p1[r] = -INFINITY; } \
            } \
        } \
        float mnL; const float alpha = online_sm1_raw(p0, p1, m_reg, mnL, base2); \
        AT_BAR(); \
        if ((tau) + 2 < NT) { int b2 = buf + 2; if (b2 >= 3) b2 -= 3; stage_write(SX, lds, b2, sr, sc); } \
        if ((tau) + 3 < NT) stage_load(SX, Kp, Vp, PROJ_LD, (j + 3) * 64, sr, sc); \
        online_sm2_raw(p0, p1, mnL, alpha, l_reg); \
        bf16x8 pa0, pa1, pa2, pa3; pack_p(p0, pa0, pa1); pack_p(p1, pa2, pa3); \
        if (__any(alpha < 1.f)) { if (hi == 0) wsc[r32] = alpha; \
            _Pragma("unroll") for (int r = 0; r < 16; ++r) { const float al = wsc[crow(r, hi)]; \
                _Pragma("unroll") for (int d = 0; d < 4; ++d) o[d][r] *= al; } } \
        pv_tile(o, vb0 + buf * BUF_B, pa0, pa1, pa2, pa3); \
        AT_BAR(); \
        buf = buf + 1; if (buf >= 3) buf = 0; } while (0)
    for (int tau = 0; tau < NT; ++tau) { AT_STEP(tau, S0); }
#undef AT_STEP
    if (!grpB) AT_BAR();
#undef AT_BAR
#undef AT_LGKM0
    l_out = l_reg;
    __syncthreads();
}
}

__device__ __forceinline__ void attn_fast_unit(const Frame& F, const Args& a, int unit) {
    using namespace at;
    unsigned char* ws = F.ws; const bf16_t* PROJ = (const bf16_t*)(ws + WS_PROJ); bf16_t* YM = (bf16_t*)(ws + WS_YMIX);
    LAS unsigned char* lds = F.lds;
    const int qt = 31 - (unit >> 4), bg = unit & 15, b = bg >> 1, g = bg & 1;
    int tz = threadIdx.x; asm volatile("" : "+v"(tz));
    const int lane = tz & 63, r32 = lane & 31, hi = lane >> 5, head = F.wid & 3, qh = F.wid >> 2;
    const int t0 = qt * 64, tq = t0 + qh * 32 + r32, wave_tmin = t0 + qh * 32;
    const int sr = tz >> 4, sc = (tz & 15) * 8;
    const float slope = exp2f(-(float)(g * 4 + head + 1));
    LAS float* wsc = (LAS float*)(lds + OFF_WSC) + F.wid * 256;
    LAS float* imph = (LAS float*)(lds + OFF_IMP);
    LAS unsigned* selm = (LAS unsigned*)(lds + OFF_SELM);
    const bf16_t* Kc = (const bf16_t*)(ws + WS_KC) + (size_t)bg * 128 * 128; const bf16_t* Vc = (const bf16_t*)(ws + WS_VC) + (size_t)bg * 128 * 128;
    Stage Sc0, Sc1; stage_load(Sc0, Kc, Vc, 128, 0, sr, sc); stage_load(Sc1, Kc, Vc, 128, 64, sr, sc);
    bf16x8 qr[8];
    { const bf16_t* qp = PROJ + (size_t)(b * SEQ + tq) * PROJ_LD + C_NQ + (g * 4 + head) * 128 + hi * 8;
#pragma unroll
      for (int d0 = 0; d0 < 8; ++d0) qr[d0] = *(const bf16x8*)(qp + d0 * 16); }
    float gate[3];
    { const bf16_t* gp = PROJ + (size_t)(b * SEQ + tq) * PROJ_LD + C_NGT + (g * 4 + head) * 3;
#pragma unroll
      for (int c = 0; c < 3; ++c) gate[c] = sigmoidf_(bf2f(gp[c])); }
    f32x16 o[4];
    float* otp = (float*)(ws + WS_OT) + ((size_t)F.bid * 512 + tz) * 64;
    { stage_write(Sc0, lds, 0, sr, sc); stage_write(Sc1, lds, 1, sr, sc);
      __syncthreads();
      f32x16 p0, p1, p2, p3;
      qkt(p0, p1, lds + OFF_K, r32, hi, qr); qkt(p2, p3, lds + OFF_K + BUF_B, r32, hi, qr);
      const int dl0 = ((tq - 31) >> 4) - 4 * hi;
      const float base_f = slope * (float)(16 * 4 * hi + 31 - tq);
      float mx = -INFINITY;
#pragma unroll
      for (int r = 0; r < 16; ++r) { const int cc = (r & 3) + 8 * (r >> 2);
          p0[r] = (cc <= dl0)      ? fmaf(p0[r], SCALE, fmaf(slope, (float)(16 * cc), base_f))        : -INFINITY;
          p1[r] = (cc + 32 <= dl0) ? fmaf(p1[r], SCALE, fmaf(slope, (float)(16 * (cc + 32)), base_f)) : -INFINITY;
          p2[r] = (cc + 64 <= dl0) ? fmaf(p2[r], SCALE, fmaf(slope, (float)(16 * (cc + 64)), base_f)) : -INFINITY;
          p3[r] = (cc + 96 <= dl0) ? fmaf(p3[r], SCALE, fmaf(slope, (float)(16 * (cc + 96)), base_f)) : -INFINITY;
          mx = fmaxf(fmaxf(mx, p0[r]), fmaxf(p1[r], fmaxf(p2[r], p3[r]))); }
      mx = swap_max(mx);
      const float mL = (mx == -INFINITY) ? 0.f : -mx * LOG2E;
      float ps = 0.f;
#pragma unroll
      for (int r = 0; r < 16; ++r) { p0[r] = __builtin_amdgcn_exp2f(fmaf(p0[r], LOG2E, mL)); p1[r] = __builtin_amdgcn_exp2f(fmaf(p1[r], LOG2E, mL));
          p2[r] = __builtin_amdgcn_exp2f(fmaf(p2[r], LOG2E, mL)); p3[r] = __builtin_amdgcn_exp2f(fmaf(p3[r], LOG2E, mL)); ps += (p0[r] + p1[r]) + (p2[r] + p3[r]); }
      ps = swap_sum(ps);
      const float inv = ps > 0.f ? 1.f / ps : 0.f;
#pragma unroll
      for (int r = 0; r < 16; ++r) { p0[r] *= inv; p1[r] *= inv; p2[r] *= inv; p3[r] *= inv; }
      { LAS float* dst = imph + ((size_t)head * 64 + qh * 32 + r32) * 32;
        float prev = 0.f;
#define AT_GRP(P, blk) do { _Pragma("unroll") for (int i = 0; i < 4; ++i) { const float av = 2.f * (P[4 * i] + P[4 * i + 1] + P[4 * i + 2]) + P[4 * i + 3]; const float bv = P[4 * i + 3]; \
            auto rr = __builtin_amdgcn_permlane32_swap(__float_as_uint(bv), __float_as_uint(bv), false, false); const float pb = __uint_as_float(hi ? rr[0] : rr[1]); \
            dst[2 * ((blk) * 4 + i) + hi] = av + (hi ? pb : prev); prev = pb; } } while (0)
        AT_GRP(p0, 0); AT_GRP(p1, 1); AT_GRP(p2, 2); AT_GRP(p3, 3);
#undef AT_GRP
      }
      bf16x8 pa0, pa1, pa2, pa3;
#pragma unroll
      for (int d = 0; d < 4; ++d)
#pragma unroll
          for (int r = 0; r < 16; ++r) o[d][r] = 0.f;
      const int vb0 = (int)(uintptr_t)(lds + OFF_V) + v_rd_base(lane);
      pack_p(p0, pa0, pa1); pack_p(p1, pa2, pa3); pv_tile(o, vb0, pa0, pa1, pa2, pa3);
      pack_p(p2, pa0, pa1); pack_p(p3, pa2, pa3); pv_tile(o, vb0 + BUF_B, pa0, pa1, pa2, pa3);
      if (hi == 0) wsc[r32] = gate[0];
#pragma unroll
      for (int r = 0; r < 16; ++r) { const float f = wsc[crow(r, hi)];
#pragma unroll
          for (int d = 0; d < 4; ++d) o[d][r] *= f; }
#pragma unroll
      for (int d = 0; d < 4; ++d)
#pragma unroll
          for (int k = 0; k < 4; ++k) *(f32x4*)(otp + d * 16 + 4 * k) = (f32x4){o[d][4 * k], o[d][4 * k + 1], o[d][4 * k + 2], o[d][4 * k + 3]};
    }
    __syncthreads();
    const bf16_t* Ksl = PROJ + (size_t)(b * SEQ) * PROJ_LD + C_KSL + g * 128; const bf16_t* Vsl = PROJ + (size_t)(b * SEQ) * PROJ_LD + C_VSL + g * 128;
    Stage Pa, Pb; stage_load(Pa, Ksl, Vsl, PROJ_LD, 0, sr, sc); stage_load(Pb, Ksl, Vsl, PROJ_LD, 64, sr, sc);
    { const int q = tz >> 3, part = tz & 7, tqq = t0 + q, cur = tqq >> 6;
      unsigned bits = 0u;
      if (cur < SEL_TOP) { bits = (part == 0) ? ((2u << cur) - 1u) : 0u; }
      else {
          float sc_[4];
#pragma unroll
          for (int k = 0; k < 4; ++k) { const int j = part * 4 + k; const float v = ((imph[(0 * 64 + q) * 32 + j] + imph[(1 * 64 + q) * 32 + j]) + imph[(2 * 64 + q) * 32 + j]) + imph[(3 * 64 + q) * 32 + j];
              const bool forced = (j == 0) || (j == cur) || (j == cur - 1); sc_[k] = forced ? 1e4f : (j <= cur ? v : -1e4f); }
          int rank[4] = {0, 0, 0, 0};
          for (int jj = 0; jj < 32; ++jj) { const float v = ((imph[(0 * 64 + q) * 32 + jj] + imph[(1 * 64 + q) * 32 + jj]) + imph[(2 * 64 + q) * 32 + jj]) + imph[(3 * 64 + q) * 32 + jj];
              const bool forced = (jj == 0) || (jj == cur) || (jj == cur - 1); const float s2 = forced ? 1e4f : (jj <= cur ? v : -1e4f);
#pragma unroll
              for (int k = 0; k < 4; ++k) { const int j = part * 4 + k; rank[k] += (s2 > sc_[k] || (s2 == sc_[k] && jj < j)) ? 1 : 0; } }
#pragma unroll
          for (int k = 0; k < 4; ++k) { const int j = part * 4 + k; if (rank[k] < SEL_TOP && j <= cur) bits |= 1u << j; }
      }
      bits |= __shfl_xor(bits, 1); bits |= __shfl_xor(bits, 2); bits |= __shfl_xor(bits, 4);
      if (part == 0) selm[q] = bits; }
    __syncthreads();
    const unsigned selbits = selm[qh * 32 + r32];
    const int jlo = (t0 - (WINDOW - 1)) > 0 ? (t0 - (WINDOW - 1)) >> 6 : 0;
    const bf16_t* Kwn = PROJ + (size_t)(b * SEQ) * PROJ_LD + C_KWN + g * 128; const bf16_t* Vwn = PROJ + (size_t)(b * SEQ) * PROJ_LD + C_VWN + g * 128;
    { float l_sel;
      branch_loop<1>(o, l_sel, lds, Ksl, Vsl, 0, qt, qr, tq, slope, selbits, r32, hi, sr, sc, wsc, wave_tmin, qh, Pa, Pb);
      stage_load(Pa, Kwn, Vwn, PROJ_LD, jlo * 64, sr, sc); stage_load(Pb, Kwn, Vwn, PROJ_LD, (jlo + 1) * 64, sr, sc);
      if (hi == 0) wsc[r32] = gate[1] / l_sel;
#pragma unroll
      for (int r = 0; r < 16; ++r) { const float f = wsc[crow(r, hi)];
#pragma unroll
          for (int d = 0; d < 4; ++d) o[d][r] *= f; }
#pragma unroll
      for (int d = 0; d < 4; ++d)
#pragma unroll
          for (int k = 0; k < 4; ++k) { const f32x4 pv = *(const f32x4*)(otp + d * 16 + 4 * k); *(f32x4*)(otp + d * 16 + 4 * k) = pv + (f32x4){o[d][4 * k], o[d][4 * k + 1], o[d][4 * k + 2], o[d][4 * k + 3]}; } }
    { float l_win;
      branch_loop<2>(o, l_win, lds, Kwn, Vwn, jlo, qt, qr, tq, slope, 0u, r32, hi, sr, sc, wsc, wave_tmin, qh, Pa, Pb);
      if (hi == 0) wsc[r32] = gate[2] / l_win;
#pragma unroll
      for (int r = 0; r < 16; ++r) { const float f = wsc[crow(r, hi)];
#pragma unroll
          for (int d = 0; d < 4; ++d) o[d][r] *= f; }
#pragma unroll
      for (int d = 0; d < 4; ++d)
#pragma unroll
          for (int k = 0; k < 4; ++k) { const f32x4 pv = *(const f32x4*)(otp + d * 16 + 4 * k); o[d][4 * k] += pv[0]; o[d][4 * k + 1] += pv[1]; o[d][4 * k + 2] += pv[2]; o[d][4 * k + 3] += pv[3]; } }
    { const float* ng = a.in[I_NSAG];
      float gsc[4];
#pragma unroll
      for (int d = 0; d < 4; ++d) gsc[d] = ng[d * 32 + r32];
#pragma unroll
      for (int r = 0; r < 16; ++r) { float ss = 0.f;
#pragma unroll
          for (int d = 0; d < 4; ++d) ss += o[d][r] * o[d][r];
          ss += __shfl_xor(ss, 1); ss += __shfl_xor(ss, 2); ss += __shfl_xor(ss, 4); ss += __shfl_xor(ss, 8); ss += __shfl_xor(ss, 16);
          const float rs = rsqrtf(ss * (1.f / 128.f) + EPS);
          const int row = b * SEQ + t0 + qh * 32 + crow(r, hi);
          bf16_t* yp = YM + (size_t)row * DM + HG_W + (g * 4 + head) * 128 + r32;
#pragma unroll
          for (int d = 0; d < 4; ++d) yp[d * 32] = f2bf(o[d][r] * rs * gsc[d]); } }
    __syncthreads();
}

namespace hg {
constexpr int T_KD = 0, T_QD = 16384, T_V = 32768, T_KL = 49152, T_FR = 65536, T_QR = 81920, T_OR = 98304, T_PART = 114688, T_DL = T_PART + 2048, T_SSQ = T_DL + 512;
}
__device__ __forceinline__ void hgrn_fast_unit(const Frame& F, const Args& a, int unit) {
    using namespace hg; using at::crow; using at::v_st; using at::v_rd_base; typedef at::s16x4 s16x4;
    unsigned char* ws = F.ws; const bf16_t* PROJ = (const bf16_t*)(ws + WS_PROJ); bf16_t* YM = (bf16_t*)(ws + WS_YMIX);
    LAS unsigned char* lds = F.lds;
    const int b = unit >> 3, h = unit & 7;
    int tz = threadIdx.x; asm volatile("" : "+v"(tz));
    const int lane = tz & 63, r32 = lane & 31, hi = lane >> 5, th = F.wid & 1, vq = F.wid >> 1;
    const int lr = tz >> 4, lc = (tz & 15) * 8;
    const int kc = tz & 127, tg = tz >> 7;
    LAS float* part = (LAS float*)(lds + T_PART); LAS float* dl = (LAS float*)(lds + T_DL); LAS float* ssq = (LAS float*)(lds + T_SSQ);
    f32x16 Sacc[4];
#pragma unroll
    for (int k = 0; k < 4; ++k)
#pragma unroll
        for (int r = 0; r < 16; ++r) Sacc[k][r] = 0.f;
    const bf16_t* base = PROJ + (size_t)(b * SEQ) * PROJ_LD + h * 128;
    u32x4 rf0, rf1, rq0, rq1, ri0, ri1, ro0, ro1;
    const bf16_t* obase = (const bf16_t*)(ws + WS_OMF) + (size_t)(b * SEQ) * HG_W + h * 128;
#define HG_LOAD(t0_) do { const bf16_t* p0_ = base + (size_t)((t0_) + lr) * PROJ_LD + lc; const bf16_t* p1_ = p0_ + (size_t)32 * PROJ_LD; \
        rf0 = *(const u32x4*)(p0_ + C_HF); rf1 = *(const u32x4*)(p1_ + C_HF); rq0 = *(const u32x4*)(p0_ + C_HQ); rq1 = *(const u32x4*)(p1_ + C_HQ); \
        ri0 = *(const u32x4*)(p0_ + C_HI); ri1 = *(const u32x4*)(p1_ + C_HI); \
        ro0 = *(const u32x4*)(obase + (size_t)((t0_) + lr) * HG_W + lc); ro1 = *(const u32x4*)(obase + (size_t)((t0_) + lr + 32) * HG_W + lc); } while (0)
    HG_LOAD(0);
    const float ngv = a.in[I_HGNG][vq * 32 + r32];
    for (int c = 0; c < SEQ / 64; ++c) {
        const int t0 = c * 64;
        *(LAS u32x4*)(lds + T_FR + lr * 256 + lc * 2) = rf0; *(LAS u32x4*)(lds + T_FR + (lr + 32) * 256 + lc * 2) = rf1;
        *(LAS u32x4*)(lds + T_QR + lr * 256 + lc * 2) = rq0; *(LAS u32x4*)(lds + T_QR + (lr + 32) * 256 + lc * 2) = rq1;
        *(LAS u32x4*)(lds + T_OR + lr * 256 + lc * 2) = ro0; *(LAS u32x4*)(lds + T_OR + (lr + 32) * 256 + lc * 2) = ro1;
        *(LAS u32x4*)(lds + T_V + v_st(lr, lc)) = ri0; *(LAS u32x4*)(lds + T_V + v_st(lr + 32, lc)) = ri1;
        __syncthreads();
        float lf[16]; float run = 0.f;
#pragma unroll
        for (int i = 0; i < 16; ++i) { const int t = tg * 16 + i; run += bf2f(*(const LAS bf16_t*)(lds + T_FR + t * 256 + kc * 2)); lf[i] = run; }
        part[tg * 128 + kc] = run;
        __syncthreads();
        { const float p0_ = part[kc], p1_ = part[128 + kc], p2_ = part[256 + kc], p3_ = part[384 + kc];
          const float pre = (tg > 0 ? p0_ : 0.f) + (tg > 1 ? p1_ : 0.f) + (tg > 2 ? p2_ : 0.f); const float tot = ((p0_ + p1_) + p2_) + p3_;
          const float dlast = __builtin_amdgcn_exp2f(tot);
          if (tg == 0) dl[kc] = dlast;
#pragma unroll
          for (int i = 0; i < 16; ++i) { const int t = tg * 16 + i; const float bb = pre + lf[i];
              const float qv = bf2f(*(const LAS bf16_t*)(lds + T_QR + t * 256 + kc * 2)), om = bf2f(*(const LAS bf16_t*)(lds + T_OR + t * 256 + kc * 2));
              const float qd = qv * __builtin_amdgcn_exp2f(bb), kd = om * __builtin_amdgcn_exp2f(-bb), kl = kd * dlast;
              const int ko = AT_KSWZ(t, kc * 2);
              *(LAS bf16_t*)(lds + T_QD + ko) = f2bf(qd); *(LAS bf16_t*)(lds + T_KD + ko) = f2bf(kd); *(LAS bf16_t*)(lds + T_KL + v_st(t, kc)) = f2bf(kl); } }
        __syncthreads();
        if (c + 1 < SEQ / 64) HG_LOAD(t0 + 64);
        const int tl = th * 32 + r32;
        bf16x8 qr[8];
#pragma unroll
        for (int d0 = 0; d0 < 8; ++d0) qr[d0] = *(const LAS bf16x8*)(lds + T_QD + AT_KSWZ(tl, (d0 * 16 + hi * 8) * 2));
        f32x16 p0, p1;
        at::qkt(p0, p1, lds + T_KD, r32, hi, qr);
#pragma unroll
        for (int r = 0; r < 16; ++r) { const int s = crow(r, hi); if (s > tl) p0[r] = 0.f; if (s + 32 > tl) p1[r] = 0.f; }
        bf16x8 pa0, pa1, pa2, pa3; at::pack_p(p0, pa0, pa1); at::pack_p(p1, pa2, pa3);
        f32x16 o;
#pragma unroll
        for (int r = 0; r < 16; ++r) o[r] = 0.f;
        const int vb = (int)(uintptr_t)(lds + T_V) + v_rd_base(lane) + vq * 512;
        const int klb = (int)(uintptr_t)(lds + T_KL) + v_rd_base(lane);
#define HG_TRRD(dst, addr, off) asm volatile("ds_read_b64_tr_b16 %0, %1 offset:%2" : "=&v"(dst) : "v"(addr), "i"(off) : "memory")
        s16x4 vl0, vh0, vl1, vh1, vl2, vh2, vl3, vh3;
        HG_TRRD(vl0, vb, 0); HG_TRRD(vh0, vb, 2048); HG_TRRD(vl1, vb, 4096); HG_TRRD(vh1, vb, 6144); HG_TRRD(vl2, vb, 8192); HG_TRRD(vh2, vb, 10240); HG_TRRD(vl3, vb, 12288); HG_TRRD(vh3, vb, 14336);
        asm volatile("s_waitcnt lgkmcnt(0)" ::: "memory"); __builtin_amdgcn_sched_barrier(0);
        const bf16x8 vf0 = (bf16x8){vl0[0], vl0[1], vl0[2], vl0[3], vh0[0], vh0[1], vh0[2], vh0[3]}, vf1 = (bf16x8){vl1[0], vl1[1], vl1[2], vl1[3], vh1[0], vh1[1], vh1[2], vh1[3]};
        const bf16x8 vf2 = (bf16x8){vl2[0], vl2[1], vl2[2], vl2[3], vh2[0], vh2[1], vh2[2], vh2[3]}, vf3 = (bf16x8){vl3[0], vl3[1], vl3[2], vl3[3], vh3[0], vh3[1], vh3[2], vh3[3]};
        o = __builtin_amdgcn_mfma_f32_32x32x16_bf16(pa0, vf0, o, 0, 0, 0); o = __builtin_amdgcn_mfma_f32_32x32x16_bf16(pa1, vf1, o, 0, 0, 0);
        o = __builtin_amdgcn_mfma_f32_32x32x16_bf16(pa2, vf2, o, 0, 0, 0); o = __builtin_amdgcn_mfma_f32_32x32x16_bf16(pa3, vf3, o, 0, 0, 0);
#pragma unroll
        for (int kb = 0; kb < 4; ++kb)
#pragma unroll
            for (int sp = 0; sp < 2; ++sp) {
                const u32x2 a_lo = *(const LAS u32x2*)(lds + T_QD + tl * 256 + ((((4 * kb + 2 * sp) * 16)) ^ ((tl & 7) << 4)) + 8 * hi);
                const u32x2 a_hi = *(const LAS u32x2*)(lds + T_QD + tl * 256 + ((((4 * kb + 2 * sp + 1) * 16)) ^ ((tl & 7) << 4)) + 8 * hi);
                u32x4 aw = {a_lo[0], a_lo[1], a_hi[0], a_hi[1]};
                u32x4 bw = {cvt_pk_bf16(Sacc[kb][8 * sp + 0], Sacc[kb][8 * sp + 1]), cvt_pk_bf16(Sacc[kb][8 * sp + 2], Sacc[kb][8 * sp + 3]),
                            cvt_pk_bf16(Sacc[kb][8 * sp + 4], Sacc[kb][8 * sp + 5]), cvt_pk_bf16(Sacc[kb][8 * sp + 6], Sacc[kb][8 * sp + 7])};
                o = __builtin_amdgcn_mfma_f32_32x32x16_bf16(*reinterpret_cast<bf16x8*>(&aw), *reinterpret_cast<bf16x8*>(&bw), o, 0, 0, 0); }
        float gt[16];
#pragma unroll
        for (int r = 0; r < 16; ++r) gt[r] = bf2f(base[(size_t)(t0 + th * 32 + crow(r, hi)) * PROJ_LD + C_HGT + vq * 32 + r32]);
#define HG_SUPD(kb) do { \
            _Pragma("unroll") for (int i4 = 0; i4 < 4; ++i4) { const f32x4 dv = *(const LAS f32x4*)(dl + (kb) * 32 + 8 * i4 + 4 * hi); \
                Sacc[kb][4 * i4] *= dv[0]; Sacc[kb][4 * i4 + 1] *= dv[1]; Sacc[kb][4 * i4 + 2] *= dv[2]; Sacc[kb][4 * i4 + 3] *= dv[3]; } \
            s16x4 al0, ah0, al1, ah1, al2, ah2, al3, ah3; \
            HG_TRRD(al0, klb, (kb) * 512); HG_TRRD(ah0, klb, (kb) * 512 + 2048); HG_TRRD(al1, klb, (kb) * 512 + 4096); HG_TRRD(ah1, klb, (kb) * 512 + 6144); \
            HG_TRRD(al2, klb, (kb) * 512 + 8192); HG_TRRD(ah2, klb, (kb) * 512 + 10240); HG_TRRD(al3, klb, (kb) * 512 + 12288); HG_TRRD(ah3, klb, (kb) * 512 + 14336); \
            asm volatile("s_waitcnt lgkmcnt(0)" ::: "memory"); __builtin_amdgcn_sched_barrier(0); \
            Sacc[kb] = __builtin_amdgcn_mfma_f32_32x32x16_bf16((bf16x8){al0[0], al0[1], al0[2], al0[3], ah0[0], ah0[1], ah0[2], ah0[3]}, vf0, Sacc[kb], 0, 0, 0); \
            Sacc[kb] = __builtin_amdgcn_mfma_f32_32x32x16_bf16((bf16x8){al1[0], al1[1], al1[2], al1[3], ah1[0], ah1[1], ah1[2], ah1[3]}, vf1, Sacc[kb], 0, 0, 0); \
            Sacc[kb] = __builtin_amdgcn_mfma_f32_32x32x16_bf16((bf16x8){al2[0], al2[1], al2[2], al2[3], ah2[0], ah2[1], ah2[2], ah2[3]}, vf2, Sacc[kb], 0, 0, 0); \
            Sacc[kb] = __builtin_amdgcn_mfma_f32_32x32x16_bf16((bf16x8){al3[0], al3[1], al3[2], al3[3], ah3[0], ah3[1], ah3[2], ah3[3]}, vf3, Sacc[kb], 0, 0, 0); } while (0)
        HG_SUPD(0); HG_SUPD(1); HG_SUPD(2); HG_SUPD(3);
#undef HG_SUPD
#undef HG_TRRD
        { float y8[8], y4[4], y2[2], y1;
          const bool b4 = (r32 & 16) != 0, b3 = (r32 & 8) != 0, b2 = (r32 & 4) != 0, b1 = (r32 & 2) != 0;
#pragma unroll
          for (int i = 0; i < 8; ++i) { const float lo = o[i] * o[i], hi_ = o[8 + i] * o[8 + i]; const float keep = b4 ? hi_ : lo, send = b4 ? lo : hi_; y8[i] = keep + __shfl_xor(send, 16); }
#pragma unroll
          for (int i = 0; i < 4; ++i) { const float keep = b3 ? y8[4 + i] : y8[i], send = b3 ? y8[i] : y8[4 + i]; y4[i] = keep + __shfl_xor(send, 8); }
#pragma unroll
          for (int i = 0; i < 2; ++i) { const float keep = b2 ? y4[2 + i] : y4[i], send = b2 ? y4[i] : y4[2 + i]; y2[i] = keep + __shfl_xor(send, 4); }
          { const float keep = b1 ? y2[1] : y2[0], send = b1 ? y2[0] : y2[1]; y1 = keep + __shfl_xor(send, 2); }
          y1 += __shfl_xor(y1, 1);
          const int rf = ((r32 >> 1) & 15);
          if ((r32 & 1) == 0) ssq[vq * 64 + th * 32 + crow(rf, hi)] = y1; }
        __syncthreads();
        { bf16_t* yb = YM + (size_t)(b * SEQ + t0 + th * 32) * DM + h * 128 + vq * 32;
          const unsigned loff = (unsigned)(4 * hi) * DM + (unsigned)r32;
#pragma unroll
          for (int r = 0; r < 16; ++r) { const int tc = (r & 3) + 8 * (r >> 2); const int t = th * 32 + tc + 4 * hi; const float ss = ((ssq[t] + ssq[64 + t]) + ssq[128 + t]) + ssq[192 + t];
              const float rs = rsqrtf(ss * (1.f / 128.f) + EPS);
              (yb + (size_t)tc * DM)[loff] = f2bf(o[r] * rs * ngv * gt[r]); } }
    }
#undef HG_LOAD
    __syncthreads();
}

__device__ __forceinline__ void compress_fast_unit(const Frame& F, const Args& a, int u) {
    unsigned char* ws = F.ws; const bf16_t* PROJ = (const bf16_t*)(ws + WS_PROJ); LAS unsigned char* lds = F.lds;
    const int j = u >> 6, bg = (u >> 2) & 15, mt = u & 3, b = bg >> 1, g = bg & 1;
    int tz = threadIdx.x; asm volatile("" : "+v"(tz));
    const int lane = tz & 63, r32 = lane & 31, hi = lane >> 5, w = F.wid;
    const int n = mt * 32 + r32, nl = n < 126 ? n : 126;
    const bf16_t* W2T = (const bf16_t*)(ws + WS_W2T) + (size_t)j * 128 * 128;
    const int colb = (j ? C_VCM : C_KCM) + g * 128;
    const bf16_t* arow = PROJ + (size_t)(b * SEQ + 16 * nl) * PROJ_LD + colb + hi * 8;
    const bf16_t* bfrag = (const bf16_t*)(ws + WS_W1T) + ((size_t)(j * 8 + w) * 32 * 4 * 64 + lane) * 8;
    f32x16 acc[4];
#pragma unroll
    for (int c = 0; c < 4; ++c)
#pragma unroll
        for (int r = 0; r < 16; ++r) acc[c][r] = 0.f;
#pragma unroll 4
    for (int ks = 0; ks < 32; ++ks) {
        const int l = 4 * w + (ks >> 3), d = (ks & 7) * 16;
        const bf16x8 af = *(const bf16x8*)(arow + (size_t)l * PROJ_LD + d);
#pragma unroll
        for (int c = 0; c < 4; ++c) { const bf16x8 bfr = *(const bf16x8*)(bfrag + (size_t)(ks * 4 + c) * 64 * 8);
            acc[c] = __builtin_amdgcn_mfma_f32_32x32x16_bf16(af, bfr, acc[c], 0, 0, 0); }
    }
    LAS float* red = (LAS float*)lds;
#pragma unroll
    for (int c = 0; c < 4; ++c)
#pragma unroll
        for (int r = 0; r < 16; ++r) red[(w * 32 + at::crow(r, hi)) * 128 + c * 32 + r32] = acc[c][r];
    __syncthreads();
    LAS unsigned char* hdn = lds + 131072 - 8192;
    { const int nn = tz >> 4, c8 = (tz & 15) * 8; float sv[8];
      const float* b1 = (const float*)(ws + WS_B1P) + (size_t)j * 32 * 128 + c8;
#pragma unroll
      for (int i = 0; i < 8; ++i) sv[i] = 0.f;
#pragma unroll 4
      for (int kg = 0; kg < 32; ++kg) { const f32x4 x0 = *(const f32x4*)(b1 + kg * 128), x1 = *(const f32x4*)(b1 + kg * 128 + 4);
#pragma unroll
          for (int i = 0; i < 4; ++i) { sv[i] += x0[i]; sv[4 + i] += x1[i]; } }
#pragma unroll
      for (int ww = 0; ww < 8; ++ww) { const f32x4 x0 = *(const LAS f32x4*)(red + (ww * 32 + nn) * 128 + c8), x1 = *(const LAS f32x4*)(red + (ww * 32 + nn) * 128 + c8 + 4);
#pragma unroll
          for (int i = 0; i < 4; ++i) { sv[i] += x0[i]; sv[4 + i] += x1[i]; } }
      __syncthreads();
#pragma unroll
      for (int i = 0; i < 8; ++i) sv[i] = gelu_tanh(sv[i]);
      u32x4 pw; pw[0] = cvt_pk_bf16(sv[0], sv[1]); pw[1] = cvt_pk_bf16(sv[2], sv[3]); pw[2] = cvt_pk_bf16(sv[4], sv[5]); pw[3] = cvt_pk_bf16(sv[6], sv[7]);
      *(LAS u32x4*)(hdn + AT_KSWZ(nn, c8 * 2)) = pw; }
    __syncthreads();
    if (w < 4) {
        f32x16 o2;
#pragma unroll
        for (int r = 0; r < 16; ++r) o2[r] = 0.f;
#pragma unroll
        for (int ks = 0; ks < 8; ++ks) { const bf16x8 af = *(const LAS bf16x8*)(hdn + AT_KSWZ(r32, (ks * 16 + hi * 8) * 2));
            const bf16x8 bfr = *(const bf16x8*)(W2T + (size_t)(w * 32 + r32) * 128 + ks * 16 + hi * 8);
            o2 = __builtin_amdgcn_mfma_f32_32x32x16_bf16(af, bfr, o2, 0, 0, 0); }
        bf16_t* dst = (bf16_t*)(ws + (DEBUG_CMP ? (j ? WS_Y + 1048576 : WS_Y) : (j ? WS_VC : WS_KC))) + (size_t)bg * 128 * 128;
#pragma unroll
        for (int r = 0; r < 16; ++r) { const int nn = mt * 32 + at::crow(r, hi); dst[(size_t)nn * 128 + w * 32 + r32] = (nn < NCMP) ? f2bf(o2[r]) : (bf16_t)0; }
    }
    __syncthreads();
}

__device__ __forceinline__ void p5_router(const Frame& F, const Args& a) {
    unsigned char* ws = F.ws; const bf16_t* H1 = (const bf16_t*)(ws + WS_H1); unsigned char* XN = ws + WS_U;
    const float* wr2 = (const float*)(ws + WS_WR2); const float* g2 = a.in[I_N2G]; const float* br = a.in[I_BR];
    float* tokw = (float*)(ws + WS_TOKW); int* slot = (int*)(ws + WS_SLOT); unsigned* cnt = F.ctl + CW_CNT;
    constexpr int HS_LD = 4104;
    LAS unsigned char* hs = F.lds; LAS float* rsv = (LAS float*)(F.lds + 32 * HS_LD); LAS float* red = (LAS float*)F.lds;
    LAS unsigned* lcnt = (LAS unsigned*)(F.lds + 32 * HS_LD + 256); LAS unsigned* lbase = lcnt + 32;
    if (F.tid < 32) lcnt[F.tid] = 0u;
    int myexp[2] = {0, 0}, myrank[2] = {0, 0};
    __syncthreads();
    for (int it = F.bid; it < NTOK / 32; it += F.G) {
#pragma unroll
        for (int rr = 0; rr < 4; ++rr) { const int tl = F.wid * 4 + rr, row = it * 32 + tl;
            const bf16_t* hr = H1 + (size_t)row * DM; u32x4 hw[4]; float ss = 0.f;
#pragma unroll
            for (int i = 0; i < 4; ++i) { hw[i] = *(const u32x4*)(hr + i * 512 + F.lane * 8); float hf[8]; unpack8(hw[i], hf);
#pragma unroll
                for (int j = 0; j < 8; ++j) ss += hf[j] * hf[j]; }
            ss = wave_sum(ss); const float rs = rsqrtf(ss * (1.f / DM) + EPS);
            if (F.lane == 0) rsv[tl] = rs;
#pragma unroll
            for (int i = 0; i < 4; ++i) { const f32x4 g0 = *(const f32x4*)(g2 + i * 512 + F.lane * 8), g1 = *(const f32x4*)(g2 + i * 512 + F.lane * 8 + 4);
                float hf[8]; unpack8(hw[i], hf);
                const f32x4 a0 = (f32x4){hf[0], hf[1], hf[2], hf[3]} * rs * g0, a1 = (f32x4){hf[4], hf[5], hf[6], hf[7]} * rs * g1;
                u32x2 w; w[0] = cvt4_fp8(a0[0], a0[1], a0[2], a0[3]); w[1] = cvt4_fp8(a1[0], a1[1], a1[2], a1[3]);
                *(u32x2*)(XN + (size_t)row * DM + i * 512 + F.lane * 8) = w;
                LAS unsigned char* hp = hs + tl * HS_LD + (i * 512 + F.lane * 8) * 2;
                *(LAS u32x2*)hp = (u32x2){hw[i][0], hw[i][1]}; *(LAS u32x2*)(hp + 8) = (u32x2){hw[i][2], hw[i][3]}; } }
        __syncthreads();
        f32x4 c00 = {0.f, 0.f, 0.f, 0.f}, c01 = c00, c10 = c00, c11 = c00;
        { const int ti = F.lane & 15, kq = F.lane >> 4, kb = F.wid * 256 + kq;
          const LAS unsigned char* ha = hs + ti * HS_LD + kb * 2; const float* wb = wr2 + (size_t)kb * 32 + ti;
#pragma unroll 16
          for (int s_ = 0; s_ < 64; ++s_) {
              const float a0 = bf2f(*(const LAS bf16_t*)(ha + s_ * 8)), a1 = bf2f(*(const LAS bf16_t*)(ha + 16 * HS_LD + s_ * 8));
              const float b0 = wb[(size_t)s_ * 128], b1 = wb[(size_t)s_ * 128 + 16];
              c00 = __builtin_amdgcn_mfma_f32_16x16x4f32(a0, b0, c00, 0, 0, 0); c01 = __builtin_amdgcn_mfma_f32_16x16x4f32(a0, b1, c01, 0, 0, 0);
              c10 = __builtin_amdgcn_mfma_f32_16x16x4f32(a1, b0, c10, 0, 0, 0); c11 = __builtin_amdgcn_mfma_f32_16x16x4f32(a1, b1, c11, 0, 0, 0); } }
        float rsl[2];
        rsl[0] = rsv[F.tid >> 5]; rsl[1] = rsv[16 + (F.tid >> 5)];
        __syncthreads();
        { const int cj = F.lane & 15, rq = (F.lane >> 4) * 4; LAS float* rw = red + F.wid * 1024;
#pragma unroll
          for (int r = 0; r < 4; ++r) { rw[(rq + r) * 32 + cj] = c00[r]; rw[(rq + r) * 32 + 16 + cj] = c01[r]; rw[(16 + rq + r) * 32 + cj] = c10[r]; rw[(16 + rq + r) * 32 + 16 + cj] = c11[r]; } }
        __syncthreads();
#pragma unroll
        for (int ps = 0; ps < 2; ++ps) {
            const int tl = ps * 16 + (F.tid >> 5), e = F.tid & 31, row = it * 32 + tl;
            float acc = 0.f;
#pragma unroll
            for (int w = 0; w < 8; ++w) acc += red[w * 1024 + tl * 32 + e];
            const float logit = acc * rsl[ps] + br[e];
            float tv[4]; int ti[4]; float cur = logit;
#pragma unroll
            for (int k = 0; k < 4; ++k) { float bv = cur; int bi = e;
#pragma unroll
                for (int o = 16; o > 0; o >>= 1) { const float ov = __shfl_xor(bv, o); const int oi = __shfl_xor(bi, o); if (ov > bv || (ov == bv && oi < bi)) { bv = ov; bi = oi; } }
                tv[k] = bv; ti[k] = bi; if (e == bi) cur = -INFINITY; }
            const float m = tv[0]; const float e0 = 1.f, e1 = __expf(tv[1] - m), e2 = __expf(tv[2] - m), e3 = __expf(tv[3] - m); const float inv = 1.f / (e0 + e1 + e2 + e3);
            if (e < 4) { const int k = e; const int ee = k == 0 ? ti[0] : k == 1 ? ti[1] : k == 2 ? ti[2] : ti[3]; const float w = (k == 0 ? e0 : k == 1 ? e1 : k == 2 ? e2 : e3) * inv;
                tokw[(size_t)row * 4 + k] = w;
                myexp[ps] = ee; myrank[ps] = (int)__hip_atomic_fetch_add(lcnt + ee, 1u, __ATOMIC_RELAXED, __HIP_MEMORY_SCOPE_WORKGROUP); } }
        __syncthreads();
        if (F.tid < 32) { const unsigned c = lcnt[F.tid]; lbase[F.tid] = c ? atomicAdd(&cnt[F.tid], c) : 0u; lcnt[F.tid] = 0u; }
        __syncthreads();
#pragma unroll
        for (int ps = 0; ps < 2; ++ps) { const int e = F.tid & 31; if (e < 4) { const int row = it * 32 + ps * 16 + (F.tid >> 5);
                slot[(size_t)myexp[ps] * NTOK + lbase[myexp[ps]] + myrank[ps]] = row * 4 + e; } }
        __syncthreads();
    }
}

__device__ __forceinline__ void moe_build_tiles(const Frame& F, LAS int* tstart, LAS int* cntl, LAS int* tstartB) {
    if (F.tid == 0) { int acc = 0, accb = 0; for (int e = 0; e < NEXP; ++e) { const int c = (int)__hip_atomic_load(F.ctl + CW_CNT + e, __ATOMIC_RELAXED, __HIP_MEMORY_SCOPE_AGENT); const int rem = c & 255;
            cntl[e] = c; tstart[e] = acc; tstartB[e] = accb; acc += (c >> 8) + (rem > 128 ? 1 : 0); accb += (rem >= 1 && rem <= 128) ? 1 : 0; } tstart[NEXP] = acc; tstartB[NEXP] = accb; }
    if (F.tid < 64) { const int sh = amax_shift(__hip_atomic_load(F.ctl + CW_AMAX + F.tid, __ATOMIC_RELAXED, __HIP_MEMORY_SCOPE_AGENT)); const unsigned b_ = (unsigned)(127 - sh) & 0xffu;
        cntl[40 + F.tid] = (int)(b_ | (b_ << 8) | (b_ << 16) | (b_ << 24)); }
    __syncthreads();
}

__device__ __forceinline__ void p9_combine(const Frame& F, const Args& a) {
    unsigned char* ws = F.ws; const bf16_t* H1 = (const bf16_t*)(ws + WS_H1); const unsigned char* Y = ws + WS_Y;
    const float* tokw = (const float*)(ws + WS_TOKW); const float* gf = a.in[I_FNG]; float* out = a.out;
    for (int row = F.bid * 8 + F.wid; row < NTOK; row += F.G * 8) {
        const bf16_t* hr = H1 + (size_t)row * DM; f32x4 v[8]; float ss = 0.f;
        const f32x4 w4 = *(const f32x4*)(tokw + (size_t)row * 4);
#pragma unroll
        for (int i = 0; i < 4; ++i) { const int c0 = i * 512 + F.lane * 8; { const u32x4 hw = *(const u32x4*)(hr + c0); float hf[8]; unpack8(hw, hf);
                v[2 * i] = (f32x4){hf[0], hf[1], hf[2], hf[3]}; v[2 * i + 1] = (f32x4){hf[4], hf[5], hf[6], hf[7]}; }
#pragma unroll
            for (int k = 0; k < 4; ++k) { const u32x2 yw = *(const u32x2*)(Y + ((size_t)row * 4 + k) * DM + c0); float f[8];
                { const f32x2 t0 = __builtin_amdgcn_cvt_pk_f32_fp8(yw[0], false), t1 = __builtin_amdgcn_cvt_pk_f32_fp8(yw[0], true), t2 = __builtin_amdgcn_cvt_pk_f32_fp8(yw[1], false), t3 = __builtin_amdgcn_cvt_pk_f32_fp8(yw[1], true);
                  f[0] = t0[0]; f[1] = t0[1]; f[2] = t1[0]; f[3] = t1[1]; f[4] = t2[0]; f[5] = t2[1]; f[6] = t3[0]; f[7] = t3[1]; }
#pragma unroll
                for (int j = 0; j < 4; ++j) { v[2 * i][j] += w4[k] * f[j]; v[2 * i + 1][j] += w4[k] * f[4 + j]; } }
#pragma unroll
            for (int j = 0; j < 4; ++j) ss += v[2 * i][j] * v[2 * i][j] + v[2 * i + 1][j] * v[2 * i + 1][j]; }
        ss = wave_sum(ss); const float rs = rsqrtf(ss * (1.f / DM) + EPS);
#pragma unroll
        for (int i = 0; i < 4; ++i) { const int c0 = i * 512 + F.lane * 8; const f32x4 g0 = *(const f32x4*)(gf + c0), g1 = *(const f32x4*)(gf + c0 + 4);
            *(f32x4*)(out + (size_t)row * DM + c0) = v[2 * i] * rs * g0; *(f32x4*)(out + (size_t)row * DM + c0 + 4) = v[2 * i + 1] * rs * g1; }
    }
}

#if DEBUG_CMP
__device__ __noinline__ void dbg_compare(unsigned char* ws, unsigned* ctl, LAS unsigned char* lds) {
    const int tid = threadIdx.x, lane = tid & 63, wid = tid >> 6;
    float mx = 0.f, md = 0.f; const bf16_t* r0 = (const bf16_t*)(ws + WS_KC); const bf16_t* r1 = (const bf16_t*)(ws + WS_Y);
    for (int i = tid; i < 2 * 16 * 128 * 128; i += NTHREADS) { const float x = bf2f(i < 262144 ? r0[i] : ((const bf16_t*)(ws + WS_VC))[i - 262144]); const float y = bf2f(i < 262144 ? r1[i] : ((const bf16_t*)(ws + WS_Y + 1048576))[i - 262144]);
        mx = fmaxf(mx, fabsf(x)); md = fmaxf(md, fabsf(x - y)); if (!(y == y)) md = 1e30f; }
    mx = wave_max(mx); md = wave_max(md); LAS float* t2 = (LAS float*)lds; if (lane == 0) { t2[wid] = mx; t2[8 + wid] = md; } __syncthreads();
    if (tid == 0) { float a1 = 0.f, a2 = 0.f; for (int i = 0; i < 8; ++i) { a1 = fmaxf(a1, t2[i]); a2 = fmaxf(a2, t2[8 + i]); }
        const float rel = a2 / fmaxf(a1, 1e-20f); int code = 0;
        if (rel >= 1.f) code = 10; else if (rel >= 0.3f) code = 11; else if (rel >= 0.1f) code = 12; else if (rel >= 0.03f) code = 13; else if (rel >= 0.01f) code = 14; else if (rel >= 0.003f) code = 15;
        if (blockIdx.x == 0) ctl[CW_ERR] = (unsigned)code; }
    __syncthreads();
}
#endif
constexpr int N_PHASES = 9;
extern "C" __global__ void __launch_bounds__(NTHREADS, 2) fwd(Args args) {
    extern __shared__ __attribute__((aligned(16))) unsigned char shm[];
    LAS unsigned char* lds = (LAS unsigned char*)shm;
    Frame F; F.lds = lds; F.ws = args.ws; F.ctl = (unsigned*)(args.ws + WS_CTL);
    F.tid = threadIdx.x; F.wid = __builtin_amdgcn_readfirstlane(F.tid >> 6); F.lane = F.tid & 63; F.G = gridDim.x; F.bid = blockIdx.x;
    LAS unsigned* misc = (LAS unsigned*)(lds + LDS_MISC);
    if (F.tid < 4) misc[F.tid] = 0u;
    __syncthreads();
    const int lo = args.ph_lo, hi = args.ph_hi;
    XcdBarrier bar; bar.bar = F.ctl; bar.x = 0; bar.st = nullptr;
    if (hi - lo > 1) bar = xcd_barrier_post(F.ctl, (volatile LAS unsigned*)misc);
#define IN(k) (lo <= (k) && (k) < hi)
#define SEAM(k) do { if (IN(k) && IN((k) + 1)) xcd_barrier(bar); } while (0)
    unsigned char* ws = args.ws;

    if (IN(0)) { p0_prologue(F, args); }
#if (REP_MASK >> 0) & 1
    if (IN(0)) { p0_prologue(F, args); }
#endif
    SEAM(0);
    if (IN(1)) {
        const int gi = F.bid >> 3, g8i = gi & 7; const bool split = (F.G == 256), conv = split && (g8i == 2 || g8i == 5 || g8i == 7);
        if (conv) { const int crank = ((gi >> 3) * 3 + (g8i == 2 ? 0 : (g8i == 5 ? 1 : 2))) * 8 + (F.bid & 7); conv_experts(F, args, CONV_P2 + crank, 96, 12288); bias1_partials(F, args, crank, 96); }
        else {
            const int grank = (gi >> 3) * 5 + (g8i < 2 ? g8i : (g8i < 5 ? g8i - 1 : 4));
            g8::DenseSched<DM, DM> S; S.init(ws + WS_U, ws + WS_WINT, NTOK, PROJ_LD, split ? 160 : F.G, split ? grank * 8 + (F.bid & 7) : F.bid);
            g8::EpiProj E{(bf16_t*)(ws + WS_PROJ), PROJ_LD, (bf16_t*)(ws + WS_OMF), (const float*)(ws + WS_LB)};
            g8::gemm_phase(lds, S, E);
            if (!split) { conv_experts(F, args, CONV_P2 + F.bid, F.G, 12288); bias1_partials(F, args, F.bid, F.G); }
        }
    }
#if (REP_MASK >> 1) & 1
    if (IN(1)) {
        g8::DenseSched<DM, DM> S; S.init(ws + WS_U, ws + WS_WINT, NTOK, PROJ_LD, F.G, F.bid);
        g8::EpiProj E{(bf16_t*)(ws + WS_PROJ), PROJ_LD, (bf16_t*)(ws + WS_OMF), (const float*)(ws + WS_LB)};
        g8::gemm_phase(lds, S, E);
    }
#endif
    SEAM(1);
    if (IN(2)) {
#if DEBUG_CMP
        p2_compress_naive(F, args);
#endif
        for (int u = F.bid; u < 128; u += F.G) compress_fast_unit(F, args, u);
        if (F.G == 256) { if (F.bid >= 128) conv_experts(F, args, CONV_P0 + (F.bid - 128), 128, CONV_P2); }
        else conv_experts(F, args, CONV_P0 + F.bid, F.G, CONV_P2); }
#if (REP_MASK >> 2) & 1
    if (IN(2)) {
#if DEBUG_CMP
        p2_compress_naive(F, args);
#endif
        for (int u = F.bid; u < 128; u += F.G) compress_fast_unit(F, args, u); }
#endif
    SEAM(2);
    if (IN(3)) {
#if DEBUG_CMP
        dbg_compare(ws, F.ctl, lds);
#endif
        if (F.bid < 64) hgrn_fast_unit(F, args, F.bid);
        for (;;) { if (F.tid == 0) misc[8] = atomicAdd(F.ctl + CW_QUEUE, 1u);
            __syncthreads();
            const int u = (int)misc[8];
            if (u >= BATCH * NSA_G * 32) break;
            attn_fast_unit(F, args, u); }
    }
#if (REP_MASK >> 3) & 1
    if (IN(3)) {
#if DEBUG_CMP
        dbg_compare(ws, F.ctl, lds);
#endif
        if (F.bid < 64) hgrn_fast_unit(F, args, F.bid);
        for (;;) { if (F.tid == 0) misc[8] = atomicAdd(F.ctl + CW_QUEUE + 64, 1u);
            __syncthreads();
            const int u = (int)misc[8];
            if (u >= BATCH * NSA_G * 32) break;
            attn_fast_unit(F, args, u); }
    }
#endif
    SEAM(3);
    if (IN(4)) {
        g8::DenseSched<DM, DM> S; S.init(ws + WS_YMIX, ws + WS_WOUTT, NTOK, DM, F.G, F.bid);
        g8::EpiResBf16 E{(bf16_t*)(ws + WS_H1), args.in[I_X], DM};
        g8::gemm_phase(lds, S, E);
    }
#if (REP_MASK >> 4) & 1
    if (IN(4)) {
        g8::DenseSched<DM, DM> S; S.init(ws + WS_YMIX, ws + WS_WOUTT, NTOK, DM, F.G, F.bid);
        g8::EpiResBf16 E{(bf16_t*)(ws + WS_H1), args.in[I_X], DM};
        g8::gemm_phase(lds, S, E);
    }
#endif
    SEAM(4);
    if (IN(5)) { p5_router(F, args); }
#if (REP_MASK >> 5) & 1
    if (IN(5)) { p5_router(F, args); }
#endif
    SEAM(5);
    if (IN(6)) {
        LAS int* tstart = (LAS int*)(misc + 64); LAS int* cntl = tstart + 40; LAS int* tstartB = cntl + 104;
        moe_build_tiles(F, tstart, cntl, tstartB);
        g8::EpiGateUp E{(unsigned char*)(ws + WS_ACT), args.in[I_BGU]};
        { g8::MoeSched<16, 2, true, 0> S{(const char*)(ws + WS_U), (const char*)(ws + WS_WGUT), (const int*)(ws + WS_SLOT), args.in[I_BGU], tstart, cntl, F.G, F.bid}; g8::gemm_phase(lds, S, E); }
        { g8::MoeSched<16, 2, true, 1> S{(const char*)(ws + WS_U), (const char*)(ws + WS_WGUT), (const int*)(ws + WS_SLOT), args.in[I_BGU], tstartB, cntl, F.G, F.bid}; g8::gemm_phase(lds, S, E); }
    }
#if (REP_MASK >> 6) & 1
    if (IN(6)) {
        LAS int* tstart = (LAS int*)(misc + 64); LAS int* cntl = tstart + 40;
        moe_build_tiles(F, tstart, cntl);
        g8::MoeSched<16, 2, true> S{(const char*)(ws + WS_U), (const char*)(ws + WS_WGUT), (const int*)(ws + WS_SLOT), args.in[I_BGU], tstart, cntl, F.G, F.bid};
        g8::EpiGateUp E{(unsigned char*)(ws + WS_ACT), args.in[I_BGU]};
        g8::gemm_phase(lds, S, E);
    }
#endif
    SEAM(6);
    if (IN(7)) {
        LAS int* tstart = (LAS int*)(misc + 64); LAS int* cntl = tstart + 40; LAS int* tstartB = cntl + 104;
        moe_build_tiles(F, tstart, cntl, tstartB);
        g8::EpiDown E{ws + WS_Y, args.in[I_BD]};
        { g8::MoeSched<8, 0, false, 0> S{(const char*)(ws + WS_ACT), (const char*)(ws + WS_WDT), (const int*)(ws + WS_SLOT), args.in[I_BD], tstart, cntl, F.G, F.bid}; g8::gemm_phase(lds, S, E); }
        { g8::MoeSched<8, 0, false, 1> S{(const char*)(ws + WS_ACT), (const char*)(ws + WS_WDT), (const int*)(ws + WS_SLOT), args.in[I_BD], tstartB, cntl, F.G, F.bid}; g8::gemm_phase(lds, S, E); }
    }
#if (REP_MASK >> 7) & 1
    if (IN(7)) {
        LAS int* tstart = (LAS int*)(misc + 64); LAS int* cntl = tstart + 40;
        moe_build_tiles(F, tstart, cntl);
        g8::MoeSched<8, 0, false> S{(const char*)(ws + WS_ACT), (const char*)(ws + WS_WDT), (const int*)(ws + WS_SLOT), args.in[I_BD], tstart, cntl, F.G, F.bid};
        g8::EpiDown E{ws + WS_Y, args.in[I_BD]};
        g8::gemm_phase(lds, S, E);
    }
#endif
    SEAM(7);
    if (IN(8)) { p9_combine(F, args);
#if DEBUG_CMP
        { const unsigned code = __hip_atomic_load(F.ctl + CW_ERR, __ATOMIC_RELAXED, __HIP_MEMORY_SCOPE_AGENT);
          if (code) { const float cval = sqrtf((float)code); for (size_t i = (size_t)F.bid * NTHREADS + F.tid; i < (size_t)NTOK * DM; i += (size_t)F.G * NTHREADS) args.out[i] = cval; } }
#endif
    }
#if (REP_MASK >> 8) & 1
    if (IN(8)) { p9_combine(F, args);
#if DEBUG_CMP
        { const unsigned code = __hip_atomic_load(F.ctl + CW_ERR, __ATOMIC_RELAXED, __HIP_MEMORY_SCOPE_AGENT);
          if (code) { const float cval = sqrtf((float)code); for (size_t i = (size_t)F.bid * NTHREADS + F.tid; i < (size_t)NTOK * DM; i += (size_t)F.G * NTHREADS) args.out[i] = cval; } }
#endif
    }
#endif
#undef IN
#undef SEAM
}

extern "C" void kernel_launch(void* const* d_in, const int* in_sizes, int n_in, void* d_out, int out_size, void* d_ws, size_t ws_size, hipStream_t stream) {
    static int grid = 0;
    if (grid == 0) {
        if (n_in != 18 || ws_size < WS_END) { fprintf(stderr, "kernel_launch: n_in %d ws %zu (need %zu)\n", n_in, ws_size, (size_t)WS_END); grid = -1; return; }
        int dev = 0, cus = 0, per_cu = 0;
        if (hipGetDevice(&dev) != hipSuccess || hipDeviceGetAttribute(&cus, hipDeviceAttributeMultiprocessorCount, dev) != hipSuccess) { grid = -1; return; }
        if (hipFuncSetAttribute((const void*)fwd, hipFuncAttributeMaxDynamicSharedMemorySize, LDS_BYTES) != hipSuccess) { fprintf(stderr, "kernel_launch: hipFuncSetAttribute failed\n"); grid = -1; return; }
        if (hipOccupancyMaxActiveBlocksPerMultiprocessor(&per_cu, (const void*)fwd, NTHREADS, LDS_BYTES) != hipSuccess || per_cu < 1) { fprintf(stderr, "kernel_launch: occupancy query says %d\n", per_cu); }
        (void)hipGetLastError();
        grid = cus;
    }
    if (grid < 0) return;
    (void)hipMemsetAsync((char*)d_ws + WS_CTL, 0, CTL_BYTES, stream);
    Args a{};
    for (int i = 0; i < 18; ++i) a.in[i] = (const float*)d_in[i];
    a.out = (float*)d_out; a.ws = (unsigned char*)d_ws;
#if N_LAUNCH_PER_PHASE
    for (int p = 0; p < N_PHASES; ++p) { a.ph_lo = p; a.ph_hi = p + 1; hipLaunchKernelGGL(fwd, dim3(grid), dim3(NTHREADS), LDS_BYTES, stream, a); }
#else
    a.ph_lo = 0; a.ph_hi = N_PHASES; hipLaunchKernelGGL(fwd, dim3(grid), dim3(NTHREADS), LDS_BYTES, stream, a);
#endif
}
```

```cpp
#include <hip/hip_runtime.h>
#include <stdint.h>
#include <stdio.h>

#ifndef N_LAUNCH_PER_PHASE
#define N_LAUNCH_PER_PHASE 0
#endif

#define DEBUG_CMP 0
#ifndef REP_MASK
#define REP_MASK 0
#endif
#define LAS __attribute__((address_space(3)))
typedef unsigned short bf16_t;
typedef short bf16x8 __attribute__((ext_vector_type(8)));
typedef float f32x4 __attribute__((ext_vector_type(4)));
typedef float f32x2 __attribute__((ext_vector_type(2)));
typedef float f32x16 __attribute__((ext_vector_type(16)));
typedef unsigned u32x4 __attribute__((ext_vector_type(4)));
typedef unsigned u32x2 __attribute__((ext_vector_type(2)));
typedef int i32x8 __attribute__((ext_vector_type(8)));

constexpr int BATCH = 8, SEQ = 2048, NTOK = BATCH * SEQ, DM = 2048;
constexpr int HG_W = 1024, HG_H = 8, HG_DK = 128, HG_DV = 128;
constexpr int NSA_H = 8, NSA_G = 2, NSA_R = 4, HD = 128, KVW = 256;
constexpr int IN_COLS = 6680, PROJ_LD = 6912;
constexpr int C_HQ = 0, C_HF = 1024, C_HI = 2048, C_HGT = 3072, C_NQ = 4096, C_KCM = 5120, C_VCM = 5376, C_KSL = 5632, C_VSL = 5888, C_KWN = 6144, C_VWN = 6400, C_NGT = 6656;
constexpr int NCMP = 127, NSEL = 32, SEL_TOP = 16, WINDOW = 512;
constexpr int NEXP = 32, TOPK = 4, DFF = 2048, NASG = NTOK * TOPK;
constexpr float EPS = 1e-6f;
constexpr int NTHREADS = 512;
constexpr int CONV_SPARE = 256;
constexpr int CONV_P0 = 0, CONV_P2 = 2048;

constexpr size_t al256(size_t x) { return (x + 255) & ~(size_t)255; }
constexpr size_t WS_CTL = 0, CTL_BYTES = 65536;
constexpr size_t WS_WINT = WS_CTL + CTL_BYTES;
constexpr size_t WS_WOUTT = WS_WINT + (size_t)PROJ_LD * DM * 2;
constexpr size_t WS_WGUT = WS_WOUTT + (size_t)DM * DM * 2;
constexpr size_t WS_WDT = WS_WGUT + (size_t)NEXP * 2 * DFF * DM * 2;
constexpr size_t WS_W1T = WS_WDT + (size_t)NEXP * DM * DFF * 2;
constexpr size_t WS_W2T = WS_W1T + (size_t)2 * 128 * 4096 * 2;
constexpr size_t WS_BIAS1 = WS_W2T + (size_t)2 * 128 * 128 * 2;
constexpr size_t WS_WR2 = WS_BIAS1 + 1024;
constexpr size_t WS_LB = WS_WR2 + (size_t)DM * NEXP * 4;
constexpr size_t WS_U = WS_LB + 4096;
constexpr size_t WS_PROJ = WS_U + (size_t)NTOK * DM * 2;
constexpr size_t WS_KC = WS_PROJ + (size_t)(NTOK + 64) * PROJ_LD * 2;
constexpr size_t WS_VC = WS_KC + (size_t)16 * 128 * 128 * 2;
constexpr size_t WS_YMIX = WS_VC + (size_t)16 * 128 * 128 * 2;
constexpr size_t WS_H1 = WS_YMIX + (size_t)NTOK * DM * 2;
constexpr size_t WS_TOKW = WS_H1 + (size_t)NTOK * DM * 4;
constexpr size_t WS_SLOT = WS_TOKW + (size_t)NTOK * 4 * 4;
constexpr size_t WS_ACT = WS_SLOT + (size_t)NEXP * NTOK * 4;
constexpr size_t WS_Y = WS_ACT + (size_t)NASG * DFF * 2;
constexpr size_t WS_OT = WS_Y + (size_t)NASG * DM * 2;
constexpr size_t WS_OMF = WS_OT + (size_t)256 * 64 * 512 * 4;
constexpr size_t WS_B1P = WS_OMF + (size_t)NTOK * HG_W * 2;
constexpr size_t WS_END = WS_B1P + (size_t)2 * 32 * 128 * 4;
constexpr int CW_CNT = 4096, CW_QUEUE = 4160, CW_ERR = 4224, CW_AMAX = 4544;

__device__ __forceinline__ float bf2f(bf16_t b) { return __uint_as_float(((unsigned)b) << 16); }
typedef __bf16 bf16v2_t __attribute__((ext_vector_type(2)));
__device__ __forceinline__ unsigned cvt_pk_bf16(float lo, float hi) { f32x2 v = {lo, hi}; bf16v2_t r = __builtin_convertvector(v, bf16v2_t); return __builtin_bit_cast(unsigned, r); }
__device__ __forceinline__ unsigned cvt4_fp8(float a, float b, float c, float d) { unsigned w = 0u; w = __builtin_amdgcn_cvt_pk_fp8_f32(a, b, w, false); w = __builtin_amdgcn_cvt_pk_fp8_f32(c, d, w, true); return w; }
__device__ __forceinline__ unsigned cvt4_bf8(float a, float b, float c, float d) { unsigned w = 0u; w = __builtin_amdgcn_cvt_pk_bf8_f32(a, b, w, false); w = __builtin_amdgcn_cvt_pk_bf8_f32(c, d, w, true); return w; }
__device__ __forceinline__ int amax_shift(unsigned bits) { if (bits == 0u) return 0; int s_ = 5 - ((int)(bits >> 23) - 127); return s_ < -60 ? -60 : (s_ > 60 ? 60 : s_); }
__device__ __forceinline__ float shift_mult(int s_) { return __uint_as_float((unsigned)(s_ + 127) << 23); }
__device__ __forceinline__ unsigned cvt4_fp8s(float a, float b, float c, float d, float m) {
    return cvt4_fp8(__builtin_amdgcn_fmed3f(a * m, -448.f, 448.f), __builtin_amdgcn_fmed3f(b * m, -448.f, 448.f), __builtin_amdgcn_fmed3f(c * m, -448.f, 448.f), __builtin_amdgcn_fmed3f(d * m, -448.f, 448.f)); }
__device__ __forceinline__ bf16_t f2bf(float f) { return (bf16_t)(cvt_pk_bf16(f, 0.f) & 0xffffu); }
__device__ __forceinline__ float sigmoidf_(float x) { return 1.f / (1.f + __expf(-x)); }
__device__ __forceinline__ float siluf_(float x) { return x * sigmoidf_(x); }
__device__ __forceinline__ float wave_sum(float v) {
#pragma unroll
    for (int o = 32; o > 0; o >>= 1) v += __shfl_xor(v, o);
    return v;
}
__device__ __forceinline__ float wave_max(float v) {
#pragma unroll
    for (int o = 32; o > 0; o >>= 1) v = fmaxf(v, __shfl_xor(v, o));
    return v;
}
__device__ __forceinline__ void unpack8(const u32x4 w, float (&f)[8]) {
#pragma unroll
    for (int i = 0; i < 4; ++i) { f[2 * i] = __uint_as_float(w[i] << 16); f[2 * i + 1] = __uint_as_float(w[i] & 0xffff0000u); }
}

#define XB_TMO      128
#define XB_XCNT(j)  (256  + 64 * (j))
#define XB_XSUB(j)  (1280 + 64 * (j))
#define XB_XGEN(j)  (2304 + 64 * (j))
#define XB_TOP      3328
#define XB_TOPGEN   3392
#define XCD_BAR_WORDS 3456
#define XB_SPIN_CAP (1u << 18)
__device__ __forceinline__ unsigned xb_ld(unsigned* p)              { return __hip_atomic_load(p, __ATOMIC_RELAXED, __HIP_MEMORY_SCOPE_AGENT); }
__device__ __forceinline__ unsigned xb_add(unsigned* p, unsigned v) { return __hip_atomic_fetch_add(p, v, __ATOMIC_RELAXED, __HIP_MEMORY_SCOPE_AGENT); }
__device__ __forceinline__ unsigned xb_xcc_id() { return (unsigned)__builtin_amdgcn_s_getreg((3 << 11) | 20) & 0xFu; }
#define XB_SPIN(cond, bar) do { unsigned _sp = 0; while (cond) { __builtin_amdgcn_s_sleep(1); \
    if ((++_sp & 255u) == 0u) { if (xb_ld(&(bar)[XB_TMO])) break; if (_sp > XB_SPIN_CAP) { atomicAdd(&(bar)[XB_TMO], 1u); break; } } } } while (0)
struct XcdBarrier { unsigned* bar; unsigned x; volatile LAS unsigned* st; };
__device__ __forceinline__ XcdBarrier xcd_barrier_post(unsigned* bar, volatile LAS unsigned* st) {
    XcdBarrier b; b.bar = bar; b.x = xb_xcc_id(); b.st = st;
    if (threadIdx.x == 0) (void)xb_add(&bar[XB_XCNT(b.x)], 1u);
    return b;
}
__device__ __forceinline__ void xcd_barrier_complete(unsigned* bar, unsigned x, unsigned& nloc, unsigned& nx) {
    const unsigned G = gridDim.x * gridDim.y * gridDim.z;
    unsigned sum, cnt, mine, sp = 0u;
    for (;;) {
        sum = 0u; cnt = 0u; mine = 0u;
#pragma unroll
        for (unsigned j = 0; j < 16; ++j) { const unsigned c = xb_ld(&bar[XB_XCNT(j)]); sum += c; cnt += (c > 0u) ? 1u : 0u; mine = (j == x) ? c : mine; }
        if (sum == G) break;
        __builtin_amdgcn_s_sleep(1);
        if ((++sp & 255u) == 0u) { if (xb_ld(&bar[XB_TMO])) break; if (sp > XB_SPIN_CAP) { atomicAdd(&bar[XB_TMO], 1u); break; } }
    }
    nloc = mine > 0u ? mine : 1u; nx = cnt > 0u ? cnt : 1u;
}
__device__ __forceinline__ void xcd_barrier(const XcdBarrier& b) {
    asm volatile("s_waitcnt vmcnt(0)" ::: "memory");
    __syncthreads();
    if (threadIdx.x == 0) {
        unsigned* bar = b.bar;
        __builtin_amdgcn_s_waitcnt(0);
        unsigned nloc = b.st[0], nx = b.st[1];
        if (nloc == 0u) { xcd_barrier_complete(bar, b.x, nloc, nx); b.st[0] = nloc; b.st[1] = nx; }
        const unsigned old = xb_add(&bar[XB_XSUB(b.x)], 1u);
        const unsigned gen = old / nloc;
        if (old + 1u == (gen + 1u) * nloc) {
            __builtin_amdgcn_fence(__ATOMIC_RELEASE, "agent");
            asm volatile("s_waitcnt vmcnt(0)" ::: "memory");
            const unsigned og = xb_add(&bar[XB_TOP], 1u);
            const unsigned tg = og / nx;
            if (og + 1u == (tg + 1u) * nx) xb_add(&bar[XB_TOPGEN], 1u);
            else XB_SPIN(xb_ld(&bar[XB_TOPGEN]) == tg, bar);
            __builtin_amdgcn_fence(__ATOMIC_ACQUIRE, "agent");
            xb_add(&bar[XB_XGEN(b.x)], 1u);
            asm volatile("s_waitcnt vmcnt(0)" ::: "memory");
        } else {
            XB_SPIN(xb_ld(&bar[XB_XGEN(b.x)]) == gen, bar);
            __builtin_amdgcn_fence(__ATOMIC_ACQUIRE, "agent");
            asm volatile("s_waitcnt vmcnt(0)" ::: "memory");
        }
    }
    __syncthreads();
}

namespace g8 {
constexpr int BM = 256, BK = 64, HALF = 128, HTB = HALF * BK * 2, STAGE_BYTES = 8 * HTB, NXCD = 8;
__host__ __device__ __forceinline__ int lds_byte(int r, int c) { const int st = (r >> 4) * 2 + (c >> 5), rr = r & 15, cc = c & 31, ob = rr * 64 + cc * 2; return st * 1024 + (ob ^ (((ob >> 9) & 1) << 5)); }
__host__ __device__ __forceinline__ void stage_rc(int b, int& R, int& C) { const int st = b / 1024, sb = b % 1024, swz = sb ^ (((sb >> 9) & 1) << 5); R = (st >> 1) * 16 + swz / 64; C = (st & 1) * 32 + (swz % 64) / 2; }
__host__ __device__ __forceinline__ int perm32(int rho) { const int n = rho >> 4, i = rho & 15; return 8 * (i >> 2) + 4 * n + (i & 3); }

struct Unit { const char* A; const char* B0; const char* B1; const int* rows; const float* bias0; const float* bias1; int nvalid; int m0, n0, e; int wscale; };

template <class Sched>
__device__ __forceinline__ void a_offsets(const Unit& u, const int (&R)[2], const int (&C)[2], unsigned (&vo)[2][2]) {
#pragma unroll
    for (int h = 0; h < 2; ++h)
#pragma unroll
        for (int i = 0; i < 2; ++i) {
            if constexpr (Sched::GATHER) {
                const int r = h * HALF + R[i];
                const int idx = u.rows[r < u.nvalid ? r : 0] >> Sched::SHIFT;
                vo[h][i] = (unsigned)idx * (unsigned)(Sched::LDA * Sched::ESZ) + (unsigned)C[i] * 2u;
            } else {
                vo[h][i] = (unsigned)(h * HALF + R[i]) * (unsigned)(Sched::LDA * Sched::ESZ) + (unsigned)C[i] * 2u;
            }
        }
}

__device__ __forceinline__ const char* uni_ptr(const char* p) { const unsigned long long v = (unsigned long long)p;
    const unsigned lo = (unsigned)__builtin_amdgcn_readfirstlane((int)(unsigned)v), hi = (unsigned)__builtin_amdgcn_readfirstlane((int)(unsigned)(v >> 32));
    return (const char*)(((unsigned long long)hi << 32) | lo); }
template <class Sched, class Epi>
__device__ __forceinline__ void gemm_phase(LAS unsigned char* lds, const Sched& S, const Epi& E) {
    const int tid = threadIdx.x, wid = __builtin_amdgcn_readfirstlane(tid >> 6), lane = tid & 63, wr = wid >> 2, wc = wid & 3, fr = lane & 15, fq = lane >> 4;
    constexpr int K = Sched::K, nt = K * Sched::ESZ / (BK * 2);
    int Rr[2], Cc[2]; unsigned voffB[2];
#pragma unroll
    for (int i = 0; i < 2; ++i) { stage_rc(tid * 16 + i * 8192, Rr[i], Cc[i]); const int Rb = Epi::PERM ? ((Rr[i] & ~31) + perm32(Rr[i] & 31)) : Rr[i];
        voffB[i] = (unsigned)Rb * (unsigned)(K * Sched::ESZ) + (unsigned)Cc[i] * 2u; }
    const size_t kstep = (size_t)(BK * 2);
    const unsigned ldsw = (unsigned)wid * 1024u;
    const int aoff = lds_byte(wr * 64 + fr, fq * 8), boff = lds_byte(wc * 32 + fr, fq * 8);
#define G8_SA(b, h) (((b) * 2 + (h)) * HTB)
#define G8_SB(b, h) ((4 + (b) * 2 + (h)) * HTB)
#define G8_STAGE(bufoff, gbase, voff) do { _Pragma("unroll") for (int _i = 0; _i < 2; ++_i) \
        __builtin_amdgcn_global_load_lds((const unsigned*)((const char*)(gbase) + (voff)[_i]), (LAS unsigned*)(lds + (bufoff) + ldsw + _i * 8192), 16, 0, 0); } while (0)
#define G8_LDA(dst, b, h) do { if constexpr (Sched::MV != 0 && (h) == 1) break; _Pragma("unroll") for (int m = 0; m < 4; ++m) _Pragma("unroll") for (int k = 0; k < 2; ++k) dst[m][k] = *(const LAS bf16x8*)(lds + G8_SA(b, h) + aoff + m * 2048 + k * 1024); } while (0)
#define G8_LDB(dst, b, h) do { _Pragma("unroll") for (int n = 0; n < 2; ++n) _Pragma("unroll") for (int k = 0; k < 2; ++k) dst[n][k] = *(const LAS bf16x8*)(lds + G8_SB(b, h) + boff + n * 2048 + k * 1024); } while (0)
#define G8_MMA(ai, bj, At, Bt) do { if constexpr (Sched::MV != 0 && (ai) == 1) break; __builtin_amdgcn_s_setprio(1); _Pragma("unroll") for (int m = 0; m < 4; ++m) _Pragma("unroll") for (int n = 0; n < 2; ++n) { \
        if constexpr (Sched::ESZ == 2) { _Pragma("unroll") for (int k = 0; k < 2; ++k) acc[ai][bj][m][n] = __builtin_amdgcn_mfma_f32_16x16x32_bf16(Bt[n][k], At[m][k], acc[ai][bj][m][n], 0, 0, 0); } \
        else { const u32x4 b0_ = __builtin_bit_cast(u32x4, Bt[n][0]), b1_ = __builtin_bit_cast(u32x4, Bt[n][1]), a0_ = __builtin_bit_cast(u32x4, At[m][0]), a1_ = __builtin_bit_cast(u32x4, At[m][1]); \
            const i32x8 bw_ = {(int)b0_[0], (int)b0_[1], (int)b0_[2], (int)b0_[3], (int)b1_[0], (int)b1_[1], (int)b1_[2], (int)b1_[3]}; \
            const i32x8 aw_ = {(int)a0_[0], (int)a0_[1], (int)a0_[2], (int)a0_[3], (int)a1_[0], (int)a1_[1], (int)a1_[2], (int)a1_[3]}; \
            acc[ai][bj][m][n] = __builtin_amdgcn_mfma_scale_f32_16x16x128_f8f6f4(bw_, aw_, acc[ai][bj][m][n], Sched::FMT_W, Sched::FMT_A, 0, wsc_cur, 0, 0x7f7f7f7f); } } \
        __builtin_amdgcn_s_setprio(0); } while (0)
#define G8_WAIT_V(n) asm volatile("s_waitcnt vmcnt(" #n ")" ::: "memory")
#define G8_WAIT_L(n) asm volatile("s_waitcnt lgkmcnt(" #n ")" ::: "memory")
#define G8_BAR __builtin_amdgcn_s_barrier()
#define G8_SCHED __builtin_amdgcn_sched_barrier(0)
    Unit cur, nxt; int ui = 0;
    if (!S.next(0, cur)) return;
    f32x4 acc[2][2][4][2];
#pragma unroll
    for (int a = 0; a < 2; ++a)
#pragma unroll
        for (int b = 0; b < 2; ++b)
#pragma unroll
            for (int m = 0; m < 4; ++m)
#pragma unroll
                for (int n = 0; n < 2; ++n) acc[a][b][m][n] = (f32x4){0.f, 0.f, 0.f, 0.f};
    bf16x8 At[4][2], B0[2][2], B1[2][2];
    unsigned voffA[2][2], nvoffA[2][2];
    LAS unsigned char* auxb = lds + STAGE_BYTES; int par_cur = 0, par_nxt = 1;
#define G8_AUX_ISSUE(U, PAR) do { if (wid < 4) { const int r_ = wid * 64 + lane; __builtin_amdgcn_global_load_lds((const unsigned*)((U).rows + (r_ < (U).nvalid ? r_ : 0)), (LAS unsigned*)(auxb + (PAR) * 2048 + wid * 256), 4, 0, 0); } \
        else { const float* b_ = (wid < 6 ? (U).bias0 + (wid - 4) * 64 : (U).bias1 + (wid - 6) * 64) + lane; __builtin_amdgcn_global_load_lds((const unsigned*)b_, (LAS unsigned*)(auxb + (PAR) * 2048 + 1024 + (wid - 4) * 256), 4, 0, 0); } } while (0)
#define G8_AUX_OFFS(PAR) do { _Pragma("unroll") for (int h = 0; h < 2; ++h) _Pragma("unroll") for (int i = 0; i < 2; ++i) { \
        const int idx_ = *(const LAS int*)(auxb + (PAR) * 2048 + (h * HALF + Rr[i]) * 4) >> Sched::SHIFT; voffA[h][i] = (unsigned)idx_ * (unsigned)(Sched::LDA * Sched::ESZ) + (unsigned)Cc[i] * 2u; } } while (0)
    if constexpr (Sched::LDSAUX) { G8_AUX_ISSUE(cur, 0); G8_WAIT_V(0); __syncthreads(); G8_AUX_OFFS(0); }
    else a_offsets<Sched>(cur, Rr, Cc, voffA);
    const char* cA = cur.A; const char* cB0 = cur.B0; const char* cB1 = cur.B1;
    int wsc_cur = cur.wscale;
    G8_STAGE(G8_SB(0, 0), cB0, voffB); G8_STAGE(G8_SA(0, 0), cA, voffA[0]); G8_STAGE(G8_SB(0, 1), cB1, voffB); G8_STAGE(G8_SA(0, 1), cA, voffA[1]);
    if (wr == 1) G8_BAR;
    G8_WAIT_V(4); G8_BAR;
    G8_STAGE(G8_SB(1, 0), cB0 + kstep, voffB); G8_STAGE(G8_SA(1, 0), cA + kstep, voffA[0]); G8_STAGE(G8_SB(1, 1), cB1 + kstep, voffB);
    G8_WAIT_V(6); G8_BAR;
    for (;;) {
        const bool has_next = S.next(ui + 1, nxt);
        const char* nA = has_next ? nxt.A : cA; const char* nB0 = has_next ? nxt.B0 : cB0; const char* nB1 = has_next ? nxt.B1 : cB1;
        if constexpr (Sched::LDSAUX) { if (has_next) G8_AUX_ISSUE(nxt, par_nxt); }
        else if constexpr (Sched::GATHER) {
            if (has_next) a_offsets<Sched>(nxt, Rr, Cc, nvoffA);
            else {
#pragma unroll
                for (int h = 0; h < 2; ++h)
#pragma unroll
                    for (int i = 0; i < 2; ++i) nvoffA[h][i] = voffA[h][i];
            }
        }
        for (int t = 0; t < nt; t += 2) {
            const bool last = (t == nt - 2);
            const char* a1 = cA + (size_t)(t + 1) * kstep;
            const char* a2 = last ? nA : cA + (size_t)(t + 2) * kstep;
            const char* b20 = last ? nB0 : cB0 + (size_t)(t + 2) * kstep; const char* b21 = last ? nB1 : cB1 + (size_t)(t + 2) * kstep;
            const char* a3 = a2 + kstep; const char* b30 = b20 + kstep; const char* b31 = b21 + kstep;
            G8_LDB(B0, 0, 0); G8_SCHED; G8_LDA(At, 0, 0); G8_STAGE(G8_SA(1, 1), a1, voffA[1]);
            G8_WAIT_L(8); G8_BAR; G8_WAIT_L(0); G8_MMA(0, 0, At, B0); G8_BAR; G8_SCHED;
            if constexpr (Sched::LDSAUX) { if (last && has_next) G8_AUX_OFFS(par_nxt); }
            else if constexpr (Sched::GATHER) { if (last) {
#pragma unroll
                for (int h = 0; h < 2; ++h)
#pragma unroll
                    for (int i = 0; i < 2; ++i) voffA[h][i] = nvoffA[h][i]; } }
            G8_LDB(B1, 0, 1); G8_STAGE(G8_SB(0, 0), b20, voffB);
            G8_BAR; G8_WAIT_L(0); G8_MMA(0, 1, At, B1); G8_BAR;
            G8_LDA(At, 0, 1); G8_STAGE(G8_SA(0, 0), a2, voffA[0]);
            G8_BAR; G8_WAIT_L(0); G8_MMA(1, 0, At, B0); G8_BAR; G8_SCHED;
            G8_STAGE(G8_SB(0, 1), b21, voffB);
            G8_WAIT_V(6); G8_BAR; G8_MMA(1, 1, At, B1); G8_BAR;
            G8_LDB(B0, 1, 0); G8_SCHED; G8_LDA(At, 1, 0); G8_STAGE(G8_SA(0, 1), a2, voffA[1]);
            G8_WAIT_L(8); G8_BAR; G8_WAIT_L(0); G8_MMA(0, 0, At, B0); G8_BAR; G8_SCHED;
            G8_LDB(B1, 1, 1); G8_STAGE(G8_SB(1, 0), b30, voffB);
            G8_BAR; G8_WAIT_L(0); G8_MMA(0, 1, At, B1); G8_BAR;
            G8_LDA(At, 1, 1); G8_STAGE(G8_SA(1, 0), a3, voffA[0]);
            G8_BAR; G8_WAIT_L(0); G8_MMA(1, 0, At, B0); G8_BAR; G8_SCHED;
            G8_STAGE(G8_SB(1, 1), b31, voffB);
            G8_WAIT_V(6); G8_BAR; G8_MMA(1, 1, At, B1); G8_BAR;
        }
        E.template run<(Sched::MV != 0 ? 1 : 2)>(acc, cur, wr, wc, fr, fq, (const LAS int*)(auxb + par_cur * 2048), (const LAS float*)(auxb + par_cur * 2048 + 1024));
        if (!has_next) break;
#pragma unroll
        for (int a = 0; a < 2; ++a)
#pragma unroll
            for (int b = 0; b < 2; ++b)
#pragma unroll
                for (int m = 0; m < 4; ++m)
#pragma unroll
                    for (int n = 0; n < 2; ++n) acc[a][b][m][n] = (f32x4){0.f, 0.f, 0.f, 0.f};
        cur = nxt; cA = nA; cB0 = nB0; cB1 = nB1; ++ui; wsc_cur = cur.wscale; par_cur = par_nxt; par_nxt = par_nxt == 2 ? 0 : par_nxt + 1;
    }
    G8_WAIT_V(0);
    if (wr == 0) G8_BAR;
    G8_BAR;
#undef G8_AUX_ISSUE
#undef G8_AUX_OFFS
#undef G8_SA
#undef G8_SB
#undef G8_STAGE
#undef G8_LDA
#undef G8_LDB
#undef G8_MMA
#undef G8_WAIT_V
#undef G8_WAIT_L
#undef G8_BAR
#undef G8_SCHED
}

template <int K_, int LDA_>
struct DenseSched {
    static constexpr int K = K_, LDA = LDA_, SHIFT = 0, ESZ = 2, FMT_W = 0, FMT_A = 0, MV = 0; static constexpr bool GATHER = false, LDSAUX = false;
    const char* A; const char* Bt; int nM, nN, nwg, G, c;
    __device__ void init(const void* A_, const void* Bt_, int M, int N, int G_, int c_) { A = (const char*)A_; Bt = (const char*)Bt_; nM = M / BM; nN = N / BM; nwg = nM * nN; G = G_; c = c_; }
    __device__ __forceinline__ bool next(int i, Unit& u) const {
        const long L = (long)i * G + c; if (L >= nwg) return false;
        int wgid = (int)L; { const int q = nwg / NXCD, r = nwg % NXCD, xcd = wgid % NXCD, off = wgid / NXCD; wgid = (xcd < r ? xcd * (q + 1) : r * (q + 1) + (xcd - r) * q) + off; }
        constexpr int WGM = 8;
        const int nig = WGM * nN, gid = wgid / nig, fm = gid * WGM, gsz = (nM - fm) < WGM ? (nM - fm) : WGM;
        const int pm = fm + ((wgid % nig) % gsz), pn = (wgid % nig) / gsz;
        u.A = A + (size_t)pm * BM * LDA * 2; u.B0 = Bt + (size_t)pn * BM * K * 2; u.B1 = u.B0 + (size_t)HALF * K * 2;
        u.rows = nullptr; u.bias0 = nullptr; u.bias1 = nullptr; u.wscale = 0x7f7f7f7f; u.nvalid = BM; u.m0 = pm * BM; u.n0 = pn * BM; u.e = 0; return true;
    }
};

template <int NPN  , int SHIFT_, bool GU, int MV_ = 0>
struct MoeSched {
    static constexpr int K = 2048, LDA = 2048, SHIFT = SHIFT_, ESZ = 1, MV = MV_, FMT_W = 0  , FMT_A = 0  ; static constexpr bool GATHER = true, LDSAUX = true;
    const char* A; const char* Bt; const int* slot; const float* bias; const LAS int* tstart; const LAS int* cnt; int G, c;
    __device__ __forceinline__ bool next(int i, Unit& u) const {
        const int ntile = tstart[NEXP]; const int nwg = ntile * NPN;
        const long L = (long)i * G + c; if (L >= nwg) return false;
        int wgid = (int)L; { const int q = nwg / NXCD, r = nwg % NXCD, xcd = wgid % NXCD, off = wgid / NXCD; wgid = (xcd < r ? xcd * (q + 1) : r * (q + 1) + (xcd - r) * q) + off; }
        int e = 0;
        for (int s = 16; s > 0; s >>= 1) if (tstart[e + s] * NPN <= wgid) e += s;
        const int mt = tstart[e + 1] - tstart[e], w = wgid - tstart[e] * NPN, pn = MV ? w : w / mt, m = MV ? (cnt[e] >> 8) : w % mt;
        u.A = A; u.e = e; u.m0 = m * BM; u.n0 = pn; u.wscale = cnt[40 + (GU ? 0 : 32) + e]; u.rows = slot + (size_t)e * NTOK + m * BM;
        const int left = cnt[e] - m * BM; u.nvalid = left < BM ? left : BM;
        if (GU) { u.B0 = Bt + ((size_t)e * 4096 + (size_t)pn * HALF) * K * ESZ; u.B1 = u.B0 + (size_t)2048 * K * ESZ; u.bias0 = bias + (size_t)e * 4096 + pn * HALF; u.bias1 = u.bias0 + 2048; }
        else { u.B0 = Bt + ((size_t)e * 2048 + (size_t)pn * BM) * K * ESZ; u.B1 = u.B0 + (size_t)HALF * K * ESZ; u.bias0 = bias + (size_t)e * 2048 + pn * BM; u.bias1 = u.bias0 + HALF; }
        return true;
    }
};

struct EpiBf16 {
    static constexpr bool PERM = true;
    bf16_t* O; int ldc;
    template <int NAI> __device__ __forceinline__ void run(const f32x4 (&acc)[2][2][4][2], const Unit& u, int wr, int wc, int fr, int fq, const LAS int* lrows, const LAS float* lbias) const {
        const int row0 = u.m0 + wr * 64 + fr, col0 = u.n0 + wc * 32 + 8 * fq;
#pragma unroll
        for (int ai = 0; ai < NAI; ++ai)
#pragma unroll
            for (int m = 0; m < 4; ++m) { bf16_t* rowp = O + (size_t)(row0 + ai * HALF + m * 16) * ldc + col0;
#pragma unroll
                for (int bj = 0; bj < 2; ++bj) { const f32x4 v0 = acc[ai][bj][m][0], v1 = acc[ai][bj][m][1];
                    u32x4 w; w[0] = cvt_pk_bf16(v0[0], v0[1]); w[1] = cvt_pk_bf16(v0[2], v0[3]); w[2] = cvt_pk_bf16(v1[0], v1[1]); w[3] = cvt_pk_bf16(v1[2], v1[3]);
                    *(u32x4*)(rowp + bj * HALF) = w; } }
    }
};
struct EpiProj {
    static constexpr bool PERM = true;
    bf16_t* O; int ldc; bf16_t* OMF; const float* lb;
    template <int NAI> __device__ __forceinline__ void run(const f32x4 (&acc)[2][2][4][2], const Unit& u, int wr, int wc, int fr, int fq, const LAS int* lrows, const LAS float* lbias) const {
        const int row0 = u.m0 + wr * 64 + fr, col0 = u.n0 + wc * 32 + 8 * fq;
        const int mode = (u.n0 < 1024 || (u.n0 >= 3072 && u.n0 < 4096)) ? 1 : ((u.n0 >= 1024 && u.n0 < 2048) ? 2 : 0);
        f32x4 lbv[2][2];
        if (mode == 2) {
#pragma unroll
            for (int bj = 0; bj < 2; ++bj) { lbv[bj][0] = *(const f32x4*)(lb + col0 - 1024 + bj * HALF); lbv[bj][1] = *(const f32x4*)(lb + col0 - 1024 + bj * HALF + 4); } }
#pragma unroll
        for (int ai = 0; ai < NAI; ++ai)
#pragma unroll
            for (int m = 0; m < 4; ++m) { const size_t rowi = (size_t)(row0 + ai * HALF + m * 16); bf16_t* rowp = O + rowi * ldc + col0;
#pragma unroll
                for (int bj = 0; bj < 2; ++bj) { f32x4 v0 = acc[ai][bj][m][0], v1 = acc[ai][bj][m][1];
                    f32x4 o0 = {0.f, 0.f, 0.f, 0.f}, o1 = o0;
                    if (mode != 0) {
                        f32x4 e0 = v0 * (-1.4426950408889634f), e1 = v1 * (-1.4426950408889634f);
#pragma unroll
                        for (int j = 0; j < 4; ++j) { e0[j] = __builtin_amdgcn_exp2f(e0[j]); e1[j] = __builtin_amdgcn_exp2f(e1[j]); }
                        e0 = e0 + 1.f; e1 = e1 + 1.f;
#pragma unroll
                        for (int j = 0; j < 4; ++j) { e0[j] = __builtin_amdgcn_rcpf(e0[j]); e1[j] = __builtin_amdgcn_rcpf(e1[j]); }
                        if (mode == 1) { v0 = v0 * e0; v1 = v1 * e1; }
                        else { const f32x4 f0 = lbv[bj][0] + (1.f - lbv[bj][0]) * e0, f1 = lbv[bj][1] + (1.f - lbv[bj][1]) * e1;
#pragma unroll
                            for (int j = 0; j < 4; ++j) { v0[j] = __builtin_amdgcn_logf(f0[j]); v1[j] = __builtin_amdgcn_logf(f1[j]); }
                            o0 = 1.f - f0; o1 = 1.f - f1; } }
                    if (mode == 2) {
                        u32x4 w2; w2[0] = cvt_pk_bf16(o0[0], o0[1]); w2[1] = cvt_pk_bf16(o0[2], o0[3]); w2[2] = cvt_pk_bf16(o1[0], o1[1]); w2[3] = cvt_pk_bf16(o1[2], o1[3]);
                        *(u32x4*)(OMF + rowi * HG_W + (col0 - 1024) + bj * HALF) = w2; }
                    u32x4 w; w[0] = cvt_pk_bf16(v0[0], v0[1]); w[1] = cvt_pk_bf16(v0[2], v0[3]); w[2] = cvt_pk_bf16(v1[0], v1[1]); w[3] = cvt_pk_bf16(v1[2], v1[3]);
                    *(u32x4*)(rowp + bj * HALF) = w; } }
    }
};
struct EpiResF32 {
    static constexpr bool PERM = false;
    float* C; const float* res; int ldc;
    template <int NAI> __device__ __forceinline__ void run(const f32x4 (&acc)[2][2][4][2], const Unit& u, int wr, int wc, int fr, int fq, const LAS int* lrows, const LAS float* lbias) const {
        const int row0 = u.m0 + wr * 64 + fr, col0 = u.n0 + wc * 32 + 4 * fq;
#pragma unroll
        for (int ai = 0; ai < NAI; ++ai)
#pragma unroll
            for (int m = 0; m < 4; ++m) { const size_t off = (size_t)(row0 + ai * HALF + m * 16) * ldc + col0;
#pragma unroll
                for (int bj = 0; bj < 2; ++bj)
#pragma unroll
                    for (int n = 0; n < 2; ++n) { const f32x4 r = *(const f32x4*)(res + off + bj * HALF + n * 16); *(f32x4*)(C + off + bj * HALF + n * 16) = acc[ai][bj][m][n] + r; } }
    }
};
struct EpiResBf16 {
    static constexpr bool PERM = true;
    bf16_t* C; const float* res; int ldc;
    template <int NAI> __device__ __forceinline__ void run(const f32x4 (&acc)[2][2][4][2], const Unit& u, int wr, int wc, int fr, int fq, const LAS int*, const LAS float*) const {
        const int row0 = u.m0 + wr * 64 + fr, col0 = u.n0 + wc * 32 + 8 * fq;
#pragma unroll
        for (int ai = 0; ai < NAI; ++ai)
#pragma unroll
            for (int m = 0; m < 4; ++m) { const size_t off = (size_t)(row0 + ai * HALF + m * 16) * ldc + col0;
#pragma unroll
                for (int bj = 0; bj < 2; ++bj) { const f32x4 r0 = *(const f32x4*)(res + off + bj * HALF), r1 = *(const f32x4*)(res + off + bj * HALF + 4);
                    const f32x4 v0 = acc[ai][bj][m][0] + r0, v1 = acc[ai][bj][m][1] + r1;
                    u32x4 w; w[0] = cvt_pk_bf16(v0[0], v0[1]); w[1] = cvt_pk_bf16(v0[2], v0[3]); w[2] = cvt_pk_bf16(v1[0], v1[1]); w[3] = cvt_pk_bf16(v1[2], v1[3]);
                    *(u32x4*)(C + off + bj * HALF) = w; } }
    }
};
struct EpiGateUp {
    static constexpr bool PERM = true;
    unsigned char* ACT; const float* bias;
    template <int NAI> __device__ __forceinline__ void run(const f32x4 (&acc)[2][2][4][2], const Unit& u, int wr, int wc, int fr, int fq, const LAS int* lrows, const LAS float* lbias) const {
        const int colh = u.n0 * HALF + wc * 32 + 8 * fq;
        const LAS float* bp = lbias + wc * 32 + 8 * fq;
        const f32x4 bg0 = *(const LAS f32x4*)bp, bg1 = *(const LAS f32x4*)(bp + 4), bu0 = *(const LAS f32x4*)(bp + 128), bu1 = *(const LAS f32x4*)(bp + 132);
#pragma unroll
        for (int ai = 0; ai < NAI; ++ai)
#pragma unroll
            for (int m = 0; m < 4; ++m) { const int r = ai * HALF + wr * 64 + m * 16 + fr;
                if (r < u.nvalid) { const int asg = lrows[r];
                    f32x4 g0 = acc[ai][0][m][0] + bg0, g1 = acc[ai][0][m][1] + bg1, u0 = acc[ai][1][m][0] + bu0, u1 = acc[ai][1][m][1] + bu1;
                    f32x4 e0, e1;
#pragma unroll
                    for (int j = 0; j < 4; ++j) { g0[j] = fminf(g0[j], 7.f); g1[j] = fminf(g1[j], 7.f); u0[j] = __builtin_amdgcn_fmed3f(u0[j], -7.f, 7.f); u1[j] = __builtin_amdgcn_fmed3f(u1[j], -7.f, 7.f); }
                    const f32x4 z0 = g0 * (-1.702f * 1.4426950408889634f), z1 = g1 * (-1.702f * 1.4426950408889634f);
#pragma unroll
                    for (int j = 0; j < 4; ++j) { e0[j] = __builtin_amdgcn_exp2f(z0[j]); e1[j] = __builtin_amdgcn_exp2f(z1[j]); }
                    e0 = e0 + 1.f; e1 = e1 + 1.f;
#pragma unroll
                    for (int j = 0; j < 4; ++j) { e0[j] = __builtin_amdgcn_rcpf(e0[j]); e1[j] = __builtin_amdgcn_rcpf(e1[j]); }
                    const f32x4 o0 = (g0 * e0) * (u0 + 1.f), o1 = (g1 * e1) * (u1 + 1.f);
                    u32x2 w; w[0] = cvt4_fp8(o0[0], o0[1], o0[2], o0[3]); w[1] = cvt4_fp8(o1[0], o1[1], o1[2], o1[3]);
                    *(u32x2*)(ACT + (size_t)asg * DFF + colh) = w; } }
    }
};
struct EpiDown {
    static constexpr bool PERM = true;
    unsigned char* Y; const float* bias;
    template <int NAI> __device__ __forceinline__ void run(const f32x4 (&acc)[2][2][4][2], const Unit& u, int wr, int wc, int fr, int fq, const LAS int* lrows, const LAS float* lbias) const {
        const int col0 = u.n0 * BM + wc * 32 + 8 * fq;
        const LAS float* bp = lbias + wc * 32 + 8 * fq;
        f32x4 bv[2][2];
#pragma unroll
        for (int bj = 0; bj < 2; ++bj) { bv[bj][0] = *(const LAS f32x4*)(bp + bj * HALF); bv[bj][1] = *(const LAS f32x4*)(bp + bj * HALF + 4); }
#pragma unroll
        for (int ai = 0; ai < NAI; ++ai)
#pragma unroll
            for (int m = 0; m < 4; ++m) { const int r = ai * HALF + wr * 64 + m * 16 + fr;
                if (r < u.nvalid) { const int asg = lrows[r]; unsigned char* rowp = Y + (size_t)asg * DM + col0;
#pragma unroll
                    for (int bj = 0; bj < 2; ++bj) { const f32x4 v0 = acc[ai][bj][m][0] + bv[bj][0], v1 = acc[ai][bj][m][1] + bv[bj][1];
                        u32x2 w; w[0] = cvt4_fp8(v0[0], v0[1], v0[2], v0[3]); w[1] = cvt4_fp8(v1[0], v1[1], v1[2], v1[3]);
                        *(u32x2*)(rowp + bj * HALF) = w; } } }
    }
};
}

struct Args { const float* in[18]; float* out; unsigned char* ws; int ph_lo, ph_hi; };
enum { I_X = 0, I_N1G, I_WIN, I_LBL, I_HGNG, I_CPOS, I_CW1, I_CW2, I_NSAG, I_WOUT, I_N2G, I_WR, I_BR, I_WGU, I_BGU, I_WD, I_BD, I_FNG };
constexpr int LDS_STAGE = 131072, LDS_BYTES = LDS_STAGE + 16384, LDS_MISC = LDS_BYTES - 4096;

struct Frame {
    LAS unsigned char* lds; unsigned char* ws; unsigned* ctl; int tid, wid, lane, G, bid;
};

__device__ __forceinline__ void conv_tile(const Frame& F, const float* src, int lds_, int k0, int n0, int N, bf16_t* dst, int ldd) {
    LAS float* tile = (LAS float*)F.lds;
#pragma unroll
    for (int p = 0; p < 2; ++p) { const int k = p * 32 + (F.tid >> 4), n = (F.tid & 15) * 4;
        f32x4 v = (f32x4){0.f, 0.f, 0.f, 0.f};
        if (n0 + n < N) v = *(const f32x4*)(src + (size_t)(k0 + k) * lds_ + n0 + n);
        tile[k * 65 + n] = v[0]; tile[k * 65 + n + 1] = v[1]; tile[k * 65 + n + 2] = v[2]; tile[k * 65 + n + 3] = v[3]; }
    __syncthreads();
    { const int n = F.tid >> 3, kc = (F.tid & 7) * 8;
      if (n0 + n < N) { float f[8];
#pragma unroll
          for (int j = 0; j < 8; ++j) f[j] = tile[(kc + j) * 65 + n];
          u32x4 w; w[0] = cvt_pk_bf16(f[0], f[1]); w[1] = cvt_pk_bf16(f[2], f[3]); w[2] = cvt_pk_bf16(f[4], f[5]); w[3] = cvt_pk_bf16(f[6], f[7]);
          *(u32x4*)(dst + (size_t)(n0 + n) * ldd + k0 + kc) = w; } }
    __syncthreads();
}
struct ConvJob { const float* src; unsigned char* dst; int N; };
__device__ __forceinline__ ConvJob conv_job(const Args& a, unsigned char* ws, int st, int& kt, int& ntile) {
    ConvJob j;
    if (st < 8192) { const int e = st >> 8, r = st & 255; kt = r >> 4; ntile = r & 15; j.src = a.in[I_WGU] + (size_t)e * DM * 4096; j.dst = ws + WS_WGUT + (size_t)e * 4096 * DM; j.N = 4096; }
    else { const int q = st - 8192, e = q >> 7, r = q & 127; kt = r >> 3; ntile = r & 7; j.src = a.in[I_WD] + (size_t)e * DFF * DM; j.dst = ws + WS_WDT + (size_t)e * DM * DFF; j.N = 2048; }
    return j;
}
__device__ __forceinline__ void conv_experts(const Frame& F, const Args& a, int first, int stride, int limit) {
    unsigned char* ws = F.ws; LAS unsigned* tile = (LAS unsigned*)F.lds;
    LAS float* mtab = (LAS float*)(F.lds + 32768);
    if (F.tid < 64) mtab[F.tid] = shift_mult(amax_shift(__hip_atomic_load(F.ctl + CW_AMAX + F.tid, __ATOMIC_RELAXED, __HIP_MEMORY_SCOPE_AGENT)));
    __syncthreads();
    const int NST = limit;
    const int lk = F.tid >> 5, lc = F.tid & 31;
    f32x4 v[16];
    int st = first, kt = 0, ntile = 0; ConvJob J{};
#define CV_LOAD() do { _Pragma("unroll") for (int T = 0; T < 2; ++T) _Pragma("unroll") for (int pp = 0; pp < 8; ++pp) \
        v[T * 8 + pp] = __builtin_nontemporal_load((const f32x4*)(J.src + (size_t)(kt * 128 + pp * 16 + lk) * J.N + ntile * 256 + T * 128 + lc * 4)); } while (0)
    if (st < NST) { J = conv_job(a, ws, st, kt, ntile); CV_LOAD(); }
    for (; st < NST; st += stride) {
        const float mlt = mtab[st < 8192 ? (st >> 8) : 32 + ((st - 8192) >> 7)];
#pragma unroll
        for (int T = 0; T < 2; ++T)
#pragma unroll
            for (int pp = 0; pp < 8; ++pp) { const int k = pp * 16 + lk; const f32x4 x = v[T * 8 + pp];
                tile[T * 4096 + k * 32 + (lc ^ (4 * (k >> 4)))] = cvt4_fp8s(x[0], x[1], x[2], x[3], mlt); }
        __syncthreads();
        const ConvJob Jc = J; const int ktc = kt, ntc = ntile;
        const int nx = st + stride;
        if (nx < NST) { J = conv_job(a, ws, nx, kt, ntile); CV_LOAD(); }
        { const int i = F.tid & 7, n4g = (F.tid >> 3) & 31, T = F.tid >> 8;
          unsigned d[16];
#pragma unroll
          for (int jj = 0; jj < 16; ++jj) d[jj] = tile[T * 4096 + (16 * i + jj) * 32 + (n4g ^ (4 * i))];
          u32x4 o[4];
#pragma unroll
          for (int q = 0; q < 4; ++q) {
              const unsigned a0 = __builtin_amdgcn_perm(d[4 * q + 1], d[4 * q], 0x05010400u), a1 = __builtin_amdgcn_perm(d[4 * q + 1], d[4 * q], 0x07030602u);
              const unsigned a2 = __builtin_amdgcn_perm(d[4 * q + 3], d[4 * q + 2], 0x05010400u), a3 = __builtin_amdgcn_perm(d[4 * q + 3], d[4 * q + 2], 0x07030602u);
              o[0][q] = __builtin_amdgcn_perm(a2, a0, 0x05040100u); o[1][q] = __builtin_amdgcn_perm(a2, a0, 0x07060302u);
              o[2][q] = __builtin_amdgcn_perm(a3, a1, 0x05040100u); o[3][q] = __builtin_amdgcn_perm(a3, a1, 0x07060302u); }
          unsigned char* dp = Jc.dst + (size_t)(ntc * 256 + T * 128 + n4g * 4) * DM + ktc * 128 + 16 * i;
#pragma unroll
          for (int r = 0; r < 4; ++r) *(u32x4*)(dp + (size_t)r * DM) = o[r]; }
        __syncthreads();
    }
#undef CV_LOAD
}
__device__ __forceinline__ void conv_matrix4(const Frame& F, const float* src, int K, int N, bf16_t* dst) {
    LAS float* tile = (LAS float*)F.lds;
    const int tn4 = (N + 255) / 256, tk = K / 64, cnt = tn4 * tk;
    for (int t = F.bid; t < cnt; t += F.G) { const int k0 = (t / tn4) * 64, n00 = (t % tn4) * 256;
        f32x4 v[8];
#pragma unroll
        for (int q = 0; q < 4; ++q)
#pragma unroll
            for (int p = 0; p < 2; ++p) { const int k = p * 32 + (F.tid >> 4), n = n00 + q * 64 + (F.tid & 15) * 4;
                v[q * 2 + p] = (n < N) ? *(const f32x4*)(src + (size_t)(k0 + k) * N + n) : (f32x4){0.f, 0.f, 0.f, 0.f}; }
#pragma unroll
        for (int q = 0; q < 4; ++q)
#pragma unroll
            for (int p = 0; p < 2; ++p) { LAS float* tp = tile + q * (64 * 65) + (p * 32 + (F.tid >> 4)) * 65 + (F.tid & 15) * 4; const f32x4 x = v[q * 2 + p]; tp[0] = x[0]; tp[1] = x[1]; tp[2] = x[2]; tp[3] = x[3]; }
        __syncthreads();
        { const int n = F.tid >> 3, kc = (F.tid & 7) * 8;
#pragma unroll
          for (int q = 0; q < 4; ++q) { const int nn = n00 + q * 64 + n;
              if (nn < N) { float f[8];
#pragma unroll
                  for (int j = 0; j < 8; ++j) f[j] = tile[q * (64 * 65) + (kc + j) * 65 + n];
                  u32x4 w; w[0] = cvt_pk_bf16(f[0], f[1]); w[1] = cvt_pk_bf16(f[2], f[3]); w[2] = cvt_pk_bf16(f[4], f[5]); w[3] = cvt_pk_bf16(f[6], f[7]);
                  *(u32x4*)(dst + (size_t)nn * K + k0 + kc) = w; } } }
        __syncthreads(); }
}
__device__ __forceinline__ void conv_matrix(const Frame& F, const float* src, int K, int N, bf16_t* dst, long& base) {
    const int tn = (N + 63) / 64, tk = K / 64; const long cnt = (long)tn * tk;
    long first = ((long)F.bid - base) % F.G; if (first < 0) first += F.G;
    for (long t = first; t < cnt; t += F.G) { const int kt = (int)(t / tn), nt_ = (int)(t % tn); conv_tile(F, src, N, kt * 64, nt_ * 64, N, dst, K); }
    base += cnt;
}
__device__ __forceinline__ void bias1_partials(const Frame& F, const Args& a, int rank, int nranks) {
    LAS float* red = (LAS float*)F.lds;
    const int c = F.tid & 127, kq = F.tid >> 7;
    for (int job = rank; job < 64; job += nranks) { const int j = job >> 5, kg = job & 31;
        const float* pos = a.in[I_CPOS] + (size_t)j * 4096 + kg * 128 + kq * 32; const float* w1 = a.in[I_CW1] + ((size_t)j * 4096 + kg * 128 + kq * 32) * 128 + c;
        float s0 = 0.f, s1 = 0.f, s2 = 0.f, s3 = 0.f;
#pragma unroll
        for (int k = 0; k < 32; k += 4) { s0 += pos[k] * w1[(size_t)k * 128]; s1 += pos[k + 1] * w1[(size_t)(k + 1) * 128]; s2 += pos[k + 2] * w1[(size_t)(k + 2) * 128]; s3 += pos[k + 3] * w1[(size_t)(k + 3) * 128]; }
        red[kq * 128 + c] = (s0 + s1) + (s2 + s3);
        __syncthreads();
        if (F.tid < 128) ((float*)(F.ws + WS_B1P))[((size_t)j * 32 + kg) * 128 + c] = ((red[c] + red[128 + c]) + red[256 + c]) + red[384 + c];
        __syncthreads(); }
}
__device__ __forceinline__ void p0_sample(const Frame& F, const Args& a) {
    const int j = F.bid & 63, q = F.bid >> 6, nq = (F.G + 63 - j) >> 6;
    const float* src; size_t stride; int nalt;
    if (j < 32) { src = a.in[I_WGU] + (size_t)j * DM * 4096; stride = (size_t)DM * 4096 / 64; nalt = 2; }
    else { src = a.in[I_WD] + (size_t)(j - 32) * DFF * DM; stride = (size_t)DFF * DM / 64; nalt = 1; }
    float mx = 0.f;
    for (int c = q; c < 64; c += nq) { const f32x4 v = *(const f32x4*)(src + (size_t)c * stride + (size_t)(c % nalt) * 2048 + F.tid * 4);
        mx = fmaxf(fmaxf(mx, fmaxf(fabsf(v[0]), fabsf(v[1]))), fmaxf(fabsf(v[2]), fabsf(v[3]))); }
    mx = wave_max(mx);
    if (F.lane == 0 && mx > 0.f) atomicMax(F.ctl + CW_AMAX + j, __float_as_uint(mx));
}
__device__ __forceinline__ void p0_prologue(const Frame& F, const Args& a) {
    unsigned char* ws = F.ws;
    long base = 0;
    p0_sample(F, a);
    static_assert(CONV_P0 == 0, "expert tiles need the sampled scales: none may be converted in the prologue");
    conv_matrix4(F, a.in[I_WIN], DM, IN_COLS, (bf16_t*)(ws + WS_WINT));
    conv_matrix(F, a.in[I_WOUT], DM, DM, (bf16_t*)(ws + WS_WOUTT), base);
    for (int fi = F.bid * NTHREADS + F.tid; fi < 2 * 8 * 32 * 4 * 64; fi += F.G * NTHREADS) {
        const int ln_ = fi & 63, ct = (fi >> 6) & 3, ks = (fi >> 8) & 31, w = (fi >> 13) & 7, j = fi >> 16;
        const float* wp = a.in[I_CW1] + ((size_t)j * 4096 + w * 512 + ks * 16 + (ln_ >> 5) * 8) * 128 + ct * 32 + (ln_ & 31);
        u32x4 fw; fw[0] = cvt_pk_bf16(wp[0], wp[128]); fw[1] = cvt_pk_bf16(wp[256], wp[384]); fw[2] = cvt_pk_bf16(wp[512], wp[640]); fw[3] = cvt_pk_bf16(wp[768], wp[896]);
        *(u32x4*)((bf16_t*)(ws + WS_W1T) + (size_t)fi * 8) = fw; }
    for (int j = 0; j < 2; ++j) conv_matrix(F, a.in[I_CW2] + (size_t)j * 128 * 128, 128, 128, (bf16_t*)(ws + WS_W2T) + (size_t)j * 128 * 128, base);
    { const float* x = a.in[I_X]; const float* g = a.in[I_N1G]; bf16_t* U = (bf16_t*)(ws + WS_U);
      f32x4 vn[8]; int row = F.bid * 8 + F.wid;
#define P0_LDROW(r_) do { const float* xr_ = x + (size_t)(r_) * DM; _Pragma("unroll") for (int i = 0; i < 4; ++i) { vn[2 * i] = *(const f32x4*)(xr_ + i * 512 + F.lane * 8); vn[2 * i + 1] = *(const f32x4*)(xr_ + i * 512 + F.lane * 8 + 4); } } while (0)
      if (row < NTOK) P0_LDROW(row);
      for (; row < NTOK; row += F.G * 8) {
          f32x4 v[8]; float ss = 0.f;
#pragma unroll
          for (int i = 0; i < 8; ++i) v[i] = vn[i];
          if (row + F.G * 8 < NTOK) P0_LDROW(row + F.G * 8);
#pragma unroll
          for (int i = 0; i < 8; ++i)
#pragma unroll
              for (int j = 0; j < 4; ++j) ss += v[i][j] * v[i][j];
          ss = wave_sum(ss); const float rs = rsqrtf(ss * (1.f / DM) + EPS);
#pragma unroll
          for (int i = 0; i < 4; ++i) { const f32x4 g0 = *(const f32x4*)(g + i * 512 + F.lane * 8), g1 = *(const f32x4*)(g + i * 512 + F.lane * 8 + 4);
              const f32x4 a0 = v[2 * i] * rs * g0, a1 = v[2 * i + 1] * rs * g1;
              u32x4 w; w[0] = cvt_pk_bf16(a0[0], a0[1]); w[1] = cvt_pk_bf16(a0[2], a0[3]); w[2] = cvt_pk_bf16(a1[0], a1[1]); w[3] = cvt_pk_bf16(a1[2], a1[3]);
              *(u32x4*)(U + (size_t)row * DM + i * 512 + F.lane * 8) = w; } }
#undef P0_LDROW
    }
    { const int gw = F.bid * 8 + F.wid;
      (void)gw;
      for (int i = F.bid * NTHREADS + F.tid; i < DM * NEXP; i += F.G * NTHREADS) ((float*)(ws + WS_WR2))[i] = a.in[I_N2G][i >> 5] * a.in[I_WR][i];
      for (int i = F.bid * NTHREADS + F.tid; i < HG_W; i += F.G * NTHREADS) { const float l0 = a.in[I_LBL][i], l1 = a.in[I_LBL][HG_W + i]; const float m = fmaxf(l0, l1);
          const float e0 = __expf(l0 - m), e1 = __expf(l1 - m); ((float*)(ws + WS_LB))[i] = e0 / (e0 + e1); } }
}

__device__ __forceinline__ float gelu_tanh(float x) { const float u = 0.7978845608028654f * (x + 0.044715f * x * x * x); return 0.5f * x * (1.f + tanhf(u)); }
__device__ __forceinline__ void p2_compress_naive(const Frame& F, const Args& a) {
    unsigned char* ws = F.ws; const bf16_t* PROJ = (const bf16_t*)(ws + WS_PROJ);
    LAS float* red = (LAS float*)F.lds;
    LAS float* hdn = red + 512;
    const int c = F.tid & 127, kq = F.tid >> 7;
    for (int u = F.bid; u < 2 * 16 * 128; u += F.G) {
        const int j = u >> 11, bg = (u >> 7) & 15, n = u & 127, b = bg >> 1, g = bg & 1;
        bf16_t* dst = (bf16_t*)(ws + (j ? WS_VC : WS_KC)) + ((size_t)bg * 128 + n) * 128;
        if (n == 127) { if (F.tid < 128) dst[F.tid] = 0; continue; }
        const float* w1 = a.in[I_CW1] + (size_t)j * 4096 * 128; const float* pos = a.in[I_CPOS] + (size_t)j * 4096;
        const int colb = (j ? C_VCM : C_KCM) + g * 128;
        float s = 0.f;
        for (int k = kq * 1024; k < kq * 1024 + 1024; ++k) { const int l = k >> 7, d = k & 127;
            const float av = bf2f(PROJ[(size_t)(b * SEQ + 16 * n + l) * PROJ_LD + colb + d]) + pos[k];
            s += av * w1[(size_t)k * 128 + c]; }
        red[kq * 128 + c] = s; __syncthreads();
        if (F.tid < 128) hdn[c] = gelu_tanh(red[c] + red[128 + c] + red[256 + c] + red[384 + c]);
        __syncthreads();
        if (F.tid < 128) { const float* w2 = a.in[I_CW2] + (size_t)j * 128 * 128; float o = 0.f; for (int k = 0; k < 128; ++k) o += hdn[k] * w2[k * 128 + c]; dst[c] = f2bf(o); }
        __syncthreads();
    }
}

__device__ __forceinline__ void hgrn_naive_unit(const Frame& F, const Args& a, int unit) {
    unsigned char* ws = F.ws; const bf16_t* PROJ = (const bf16_t*)(ws + WS_PROJ); bf16_t* YM = (bf16_t*)(ws + WS_YMIX);
    const float* lbv = (const float*)(ws + WS_LB);
    const int b = unit >> 3, h = unit & 7, v = F.tid & 127, kg = F.tid >> 7;
    LAS float* fs = (LAS float*)F.lds;
    LAS float* qs = fs + 2048; LAS float* is_ = qs + 2048; LAS float* red = is_ + 2048  ; LAS float* ob = red + 512  ;
    float S[32];
#pragma unroll
    for (int i = 0; i < 32; ++i) S[i] = 0.f;
    for (int t0 = 0; t0 < SEQ; t0 += 16) {
        for (int i = F.tid; i < 2048; i += NTHREADS) { const int st = i >> 7, k = i & 127; const size_t rowo = (size_t)(b * SEQ + t0 + st) * PROJ_LD + h * 128 + k;
            const float lb = lbv[h * 128 + k];
            fs[i] = lb + (1.f - lb) * sigmoidf_(bf2f(PROJ[rowo + C_HF])); qs[i] = siluf_(bf2f(PROJ[rowo + C_HQ])); is_[i] = bf2f(PROJ[rowo + C_HI]); }
        __syncthreads();
        for (int st = 0; st < 16; ++st) {
            const float iv = is_[st * 128 + v]; float po = 0.f;
#pragma unroll
            for (int kk = 0; kk < 32; ++kk) { const int k = kg * 32 + kk; const float f = fs[st * 128 + k]; S[kk] = f * S[kk] + (1.f - f) * iv; po += S[kk] * qs[st * 128 + k]; }
            red[kg * 128 + v] = po; __syncthreads();
            if (kg == 0) ob[st * 128 + v] = red[v] + red[128 + v] + red[256 + v] + red[384 + v];
            __syncthreads();
        }
        for (int s2 = 0; s2 < 2; ++s2) { const int st = F.wid * 2 + s2; const float o0 = ob[st * 128 + F.lane], o1 = ob[st * 128 + 64 + F.lane];
            const float ss = wave_sum(o0 * o0 + o1 * o1); const float rs = rsqrtf(ss * (1.f / 128.f) + EPS);
            const size_t row = (size_t)(b * SEQ + t0 + st);
            const float g0 = bf2f(PROJ[row * PROJ_LD + C_HGT + h * 128 + F.lane]), g1 = bf2f(PROJ[row * PROJ_LD + C_HGT + h * 128 + 64 + F.lane]);
            YM[row * DM + h * 128 + F.lane] = f2bf(o0 * rs * a.in[I_HGNG][F.lane] * siluf_(g0));
            YM[row * DM + h * 128 + 64 + F.lane] = f2bf(o1 * rs * a.in[I_HGNG][64 + F.lane] * siluf_(g1)); }
        __syncthreads();
    }
}

__device__ __forceinline__ float dot128_bf(const LAS float* q, const bf16_t* k) {
    float s = 0.f;
#pragma unroll
    for (int c = 0; c < 16; ++c) { const u32x4 w = *(const u32x4*)(k + c * 8); float f[8]; unpack8(w, f);
#pragma unroll
        for (int j = 0; j < 8; ++j) s += q[c * 8 + j] * f[j]; }
    return s;
}
__device__ __forceinline__ void softmax4(const Frame& F, LAS float* sc, int stride, int n, LAS float* tmp  ) {
    const int r = F.tid >> 7, i0 = F.tid & 127;
    float m = -INFINITY; for (int i = i0; i < n; i += 128) m = fmaxf(m, sc[r * stride + i]);
    m = wave_max(m); if (F.lane == 0) tmp[F.wid] = m; __syncthreads();
    m = fmaxf(tmp[2 * r], tmp[2 * r + 1]); __syncthreads();
    float s = 0.f;
    for (int i = i0; i < n; i += 128) { const float x = sc[r * stride + i]; const float p = (x == -INFINITY) ? 0.f : __expf(x - m); sc[r * stride + i] = p; s += p; }
    s = wave_sum(s); if (F.lane == 0) tmp[F.wid] = s; __syncthreads();
    s = tmp[2 * r] + tmp[2 * r + 1]; const float inv = s > 0.f ? 1.f / s : 0.f;
    for (int i = i0; i < n; i += 128) sc[r * stride + i] *= inv;
    __syncthreads();
}
__device__ __forceinline__ void attn_naive_unit(const Frame& F, const Args& a, int unit) {
    unsigned char* ws = F.ws; const bf16_t* PROJ = (const bf16_t*)(ws + WS_PROJ); bf16_t* YM = (bf16_t*)(ws + WS_YMIX);
    const int b = unit >> 12, g = (unit >> 11) & 1, t = unit & 2047, bg = b * 2 + g;
    LAS float* qs = (LAS float*)F.lds;
    LAS float* sc = qs + 512;
    LAS float* tmp = sc + 4096;
    LAS float* imp = tmp + 16;
    LAS int* selk = (LAS int*)(imp + 32);
    LAS float* oacc = (LAS float*)(selk + 32);
    const int r4 = F.tid >> 7, d = F.tid & 127;
    const size_t rowq = (size_t)(b * SEQ + t) * PROJ_LD;
    qs[F.tid] = bf2f(PROJ[rowq + C_NQ + (g * 4 + r4) * 128 + d]);
    const float slope = exp2f(-(float)(g * 4 + r4 + 1));
    const float scale = 0.08838834764831845f;
    float gate[3];
#pragma unroll
    for (int c = 0; c < 3; ++c) gate[c] = sigmoidf_(bf2f(PROJ[rowq + C_NGT + (g * 4 + r4) * 3 + c]));
    __syncthreads();
    { const int n = d; float s = -INFINITY;
      if (n < NCMP) { const int dist = t - (16 * n + 31); if (dist >= 0) s = dot128_bf(qs + r4 * 128, (const bf16_t*)(ws + WS_KC) + ((size_t)bg * 128 + n) * 128) * scale - slope * (float)dist; }
      sc[r4 * 1024 + n] = s; }
    __syncthreads();
    softmax4(F, sc, 1024, 128, tmp);
    { float o = 0.f; const bf16_t* vc = (const bf16_t*)(ws + WS_VC) + (size_t)bg * 128 * 128;
      for (int n = 0; n < NCMP; ++n) o += sc[r4 * 1024 + n] * bf2f(vc[n * 128 + d]);
      oacc[F.tid] = gate[0] * o; }
    if (F.tid < 32) { const int j = F.tid; float s = 0.f;
        for (int r = 0; r < 4; ++r) for (int q = -1; q <= 3; ++q) { const int n = 4 * j + q; if (n >= 0 && n < NCMP) s += ((q == -1 || q == 3) ? 1.f : 2.f) * sc[r * 1024 + n]; }
        const int cur = t >> 6; const bool forced = (j == 0) || (j == cur) || (j == cur - 1);
        imp[j] = forced ? 1e4f : (j <= cur ? s : -1e4f); }
    __syncthreads();
    if (F.tid < 32) { const int j = F.tid; const float me = imp[j]; int rank = 0;
        for (int k = 0; k < 32; ++k) { const float o = imp[k]; rank += (o > me || (o == me && k < j)) ? 1 : 0; }
        const bool sel = rank < SEL_TOP && j <= (t >> 6);
        const unsigned long long mask = __ballot(sel);
        if (sel) selk[__popcll(mask & ((1ull << j) - 1ull))] = j;
        if (j == 0) selk[16] = __popcll(mask); }
    __syncthreads();
    { const int nsel = selk[16];
      for (int i = F.tid; i < 4 * 1024; i += NTHREADS) sc[i] = -INFINITY;
      __syncthreads();
      const int l = F.tid & 63, r = (F.tid >> 6) & 3, which = F.tid >> 8;
      for (int s0 = 0; s0 < nsel; s0 += 2) { const int si = s0 + which;
          if (si < nsel) { const int kp = selk[si] * 64 + l;
              if (kp <= t) { const float s = dot128_bf(qs + r * 128, PROJ + (size_t)(b * SEQ + kp) * PROJ_LD + C_KSL + g * 128) * scale - exp2f(-(float)(g * 4 + r + 1)) * (float)(t - kp); sc[r * 1024 + si * 64 + l] = s; } } }
      __syncthreads();
      softmax4(F, sc, 1024, nsel * 64, tmp);
      float o = 0.f;
      for (int si = 0; si < nsel; ++si) { const int kb = selk[si] * 64;
          for (int l2 = 0; l2 < 64; ++l2) { const int kp = kb + l2; if (kp > t) break; o += sc[r4 * 1024 + si * 64 + l2] * bf2f(PROJ[(size_t)(b * SEQ + kp) * PROJ_LD + C_VSL + g * 128 + d]); } }
      oacc[F.tid] += gate[1] * o; }
    __syncthreads();
    { for (int i = F.tid; i < 4 * 1024; i += NTHREADS) sc[i] = -INFINITY;
      __syncthreads();
      for (int i = F.tid; i < 4 * 512; i += NTHREADS) { const int r = i >> 9, w = i & 511, kp = t - 511 + w;
          if (kp >= 0) sc[r * 1024 + w] = dot128_bf(qs + r * 128, PROJ + (size_t)(b * SEQ + kp) * PROJ_LD + C_KWN + g * 128) * scale - exp2f(-(float)(g * 4 + r + 1)) * (float)(t - kp); }
      __syncthreads();
      softmax4(F, sc, 1024, 512, tmp);
      float o = 0.f;
      for (int w = 0; w < 512; ++w) { const int kp = t - 511 + w; if (kp >= 0) o += sc[r4 * 1024 + w] * bf2f(PROJ[(size_t)(b * SEQ + kp) * PROJ_LD + C_VWN + g * 128 + d]); }
      oacc[F.tid] += gate[2] * o; }
    __syncthreads();
    { const float o = oacc[F.tid]; float ss = wave_sum(o * o); if (F.lane == 0) tmp[F.wid] = ss; __syncthreads();
      ss = tmp[2 * r4] + tmp[2 * r4 + 1]; const float rs = rsqrtf(ss * (1.f / 128.f) + EPS);
      YM[(size_t)(b * SEQ + t) * DM + HG_W + (g * 4 + r4) * 128 + d] = f2bf(o * rs * a.in[I_NSAG][d]); }
    __syncthreads();
}

namespace at {
constexpr int SHM_T = 64 * 128 * 2;
constexpr int BUF_B = 2 * SHM_T;
constexpr int OFF_V = 0, OFF_K = SHM_T, OFF_IMP = 2 * BUF_B  , OFF_SELM = 3 * BUF_B, OFF_WSC = OFF_SELM + 256;
constexpr float SCALE = 0.08838834764831845f, LOG2E = 1.4426950408889634f, THR = 8.f;
#define AT_KSWZ(row, colB) ((row) * 256 + ((colB) ^ (((row) & 7) << 4)))
__device__ __forceinline__ int v_st(int k, int c) { const int kk = (k & ~0xC) | ((k & 4) << 1) | ((k & 8) >> 1); return ((kk >> 3) * 4 + (c >> 5)) * 512 + ((kk & 7) * 32 + (c & 31)) * 2; }
__device__ __forceinline__ int v_rd_base(int lane) { return ((lane & 3) << 3) | (((lane >> 2) & 3) << 6) | (((lane >> 4) & 1) << 5) | (((lane >> 5) & 1) << 8); }
__device__ __forceinline__ int crow(int r, int hi) { return (r & 3) + 8 * (r >> 2) + 4 * hi; }
typedef short s16x4 __attribute__((ext_vector_type(4)));
struct Stage { u32x4 k0, k1, v0, v1; };
__device__ __forceinline__ void stage_load(Stage& S, const bf16_t* Kp, const bf16_t* Vp, int ld, int row0, int sr, int sc) {
    S.k0 = *(const u32x4*)(Kp + (size_t)(row0 + sr) * ld + sc); S.k1 = *(const u32x4*)(Kp + (size_t)(row0 + 32 + sr) * ld + sc);
    S.v0 = *(const u32x4*)(Vp + (size_t)(row0 + sr) * ld + sc); S.v1 = *(const u32x4*)(Vp + (size_t)(row0 + 32 + sr) * ld + sc);
}
__device__ __forceinline__ void stage_write(const Stage& S, LAS unsigned char* lds, int buf, int sr, int sc) {
    const int kws = AT_KSWZ(sr, sc * 2);
    *(LAS u32x4*)(lds + OFF_K + buf * BUF_B + kws) = S.k0; *(LAS u32x4*)(lds + OFF_K + buf * BUF_B + kws + 32 * 256) = S.k1;
    *(LAS u32x4*)(lds + OFF_V + buf * BUF_B + v_st(sr, sc)) = S.v0; *(LAS u32x4*)(lds + OFF_V + buf * BUF_B + v_st(32 + sr, sc)) = S.v1;
}
template <bool EXTRA = false>
__device__ __forceinline__ void qkt(f32x16& p0, f32x16& p1, const LAS unsigned char* ktile, int r32, int hi, const bf16x8 (&qr)[8], bf16x8 kx0 = bf16x8{}, bf16x8 kx1 = bf16x8{}, bf16x8 qx = bf16x8{}) {
#pragma unroll
    for (int r = 0; r < 16; ++r) { p0[r] = 0.f; p1[r] = 0.f; }
    const LAS unsigned char* kb[4];
#pragma unroll
    for (int dd = 0; dd < 4; ++dd) kb[dd] = ktile + AT_KSWZ(r32, (dd * 16 + hi * 8) * 2);
#pragma unroll
    for (int d0 = 0; d0 < 8; ++d0) { const LAS unsigned char* a = kb[d0 & 3] + (d0 >> 2) * 128;
        const bf16x8 b0 = *(const LAS bf16x8*)a; const bf16x8 b1 = *(const LAS bf16x8*)(a + 32 * 256);
        p0 = __builtin_amdgcn_mfma_f32_32x32x16_bf16(b0, qr[d0], p0, 0, 0, 0);
        p1 = __builtin_amdgcn_mfma_f32_32x32x16_bf16(b1, qr[d0], p1, 0, 0, 0); }
    if constexpr (EXTRA) {
        p0 = __builtin_amdgcn_mfma_f32_32x32x16_bf16(kx0, qx, p0, 0, 0, 0);
        p1 = __builtin_amdgcn_mfma_f32_32x32x16_bf16(kx1, qx, p1, 0, 0, 0); }
}
__device__ __forceinline__ void pv_tile(f32x16 (&o)[4], int vb, bf16x8 pa0, bf16x8 pa1, bf16x8 pa2, bf16x8 pa3) {
#define AT_TRRD(dst, off) asm volatile("ds_read_b64_tr_b16 %0, %1 offset:%2" : "=&v"(dst) : "v"(vb), "i"(off) : "memory")
#define AT_PV_D0(d0) do { s16x4 l0, l1, l2, l3, h0, h1, h2, h3; constexpr int b_ = (d0) * 512; \
        AT_TRRD(l0, b_); AT_TRRD(h0, b_ + 2048); AT_TRRD(l1, b_ + 4096); AT_TRRD(h1, b_ + 6144); AT_TRRD(l2, b_ + 8192); AT_TRRD(h2, b_ + 10240); AT_TRRD(l3, b_ + 12288); AT_TRRD(h3, b_ + 14336); \
        asm volatile("s_waitcnt lgkmcnt(0)" ::: "memory"); __builtin_amdgcn_sched_barrier(0); \
        o[d0] = __builtin_amdgcn_mfma_f32_32x32x16_bf16(pa0, (bf16x8){l0[0], l0[1], l0[2], l0[3], h0[0], h0[1], h0[2], h0[3]}, o[d0], 0, 0, 0); \
        o[d0] = __builtin_amdgcn_mfma_f32_32x32x16_bf16(pa1, (bf16x8){l1[0], l1[1], l1[2], l1[3], h1[0], h1[1], h1[2], h1[3]}, o[d0], 0, 0, 0); \
        o[d0] = __builtin_amdgcn_mfma_f32_32x32x16_bf16(pa2, (bf16x8){l2[0], l2[1], l2[2], l2[3], h2[0], h2[1], h2[2], h2[3]}, o[d0], 0, 0, 0); \
        o[d0] = __builtin_amdgcn_mfma_f32_32x32x16_bf16(pa3, (bf16x8){l3[0], l3[1], l3[2], l3[3], h3[0], h3[1], h3[2], h3[3]}, o[d0], 0, 0, 0); } while (0)
    AT_PV_D0(0); AT_PV_D0(1); AT_PV_D0(2); AT_PV_D0(3);
#undef AT_PV_D0
#undef AT_TRRD
}
__device__ __forceinline__ float swap_max(float v) { auto rr = __builtin_amdgcn_permlane32_swap(__float_as_uint(v), __float_as_uint(v), false, false); return fmaxf(__uint_as_float(rr[0]), __uint_as_float(rr[1])); }
__device__ __forceinline__ float swap_sum(float v) { auto rr = __builtin_amdgcn_permlane32_swap(__float_as_uint(v), __float_as_uint(v), false, false); return __uint_as_float(rr[0]) + __uint_as_float(rr[1]); }
__device__ __forceinline__ void pack_p(const f32x16& P, bf16x8& outA, bf16x8& outB) {
#define AT_PK4(B_, OUT) do { unsigned a0 = cvt_pk_bf16(P[B_ + 0], P[B_ + 1]), a1 = cvt_pk_bf16(P[B_ + 2], P[B_ + 3]); \
        unsigned b0 = cvt_pk_bf16(P[B_ + 4], P[B_ + 5]), b1 = cvt_pk_bf16(P[B_ + 6], P[B_ + 7]); \
        auto r0 = __builtin_amdgcn_permlane32_swap(a0, b0, false, false); auto r1 = __builtin_amdgcn_permlane32_swap(a1, b1, false, false); \
        u32x4 w = {r0[0], r1[0], r0[1], r1[1]}; OUT = *reinterpret_cast<bf16x8*>(&w); } while (0)
    AT_PK4(0, outA); AT_PK4(8, outB);
#undef AT_PK4
}
__device__ __forceinline__ float online_sm1(const f32x16& p0, const f32x16& p1, float& m_reg, float& mnL) {
    float pmax = p0[0];
#pragma unroll
    for (int r = 1; r < 16; ++r) pmax = fmaxf(pmax, p0[r]);
#pragma unroll
    for (int r = 0; r < 16; ++r) pmax = fmaxf(pmax, p1[r]);
    pmax = swap_max(pmax);
    float mn, alpha;
    if (__all(pmax - m_reg <= THR)) { mn = m_reg; alpha = 1.f; }
    else { mn = fmaxf(m_reg, pmax); alpha = __builtin_amdgcn_exp2f((m_reg - mn) * LOG2E); m_reg = mn; }
    mnL = -mn * LOG2E;
    return alpha;
}
__device__ __forceinline__ float online_sm1_raw(const f32x16& p0, const f32x16& p1, float& m_reg, float& mnL, float base2, bool on = true) {
    float pmax = p0[0];
#pragma unroll
    for (int r = 1; r < 16; ++r) pmax = fmaxf(pmax, p0[r]);
#pragma unroll
    for (int r = 0; r < 16; ++r) pmax = fmaxf(pmax, p1[r]);
    pmax = on ? fmaf(swap_max(pmax), SCALE, base2) : -INFINITY;
    float mn, alpha;
    if (__all(pmax - m_reg <= THR)) { mn = m_reg; alpha = 1.f; }
    else { mn = fmaxf(m_reg, pmax); alpha = __builtin_amdgcn_exp2f((m_reg - mn) * LOG2E); m_reg = mn; }
    mnL = on ? (base2 - mn) * LOG2E : -INFINITY;
    return alpha;
}
__device__ __forceinline__ void online_sm2_raw(f32x16& p0, f32x16& p1, float mnL, float alpha, float& l_reg) {
    constexpr float C2 = SCALE * LOG2E;
    float ps = 0.f;
#pragma unroll
    for (int r = 0; r < 16; ++r) { p0[r] = __builtin_amdgcn_exp2f(fmaf(p0[r], C2, mnL)); p1[r] = __builtin_amdgcn_exp2f(fmaf(p1[r], C2, mnL)); ps += p0[r] + p1[r]; }
    ps = swap_sum(ps);
    l_reg = l_reg * alpha + ps;
}
__device__ __forceinline__ void online_sm2(f32x16& p0, f32x16& p1, float mnL, float alpha, float& l_reg) {
    float ps = 0.f;
#pragma unroll
    for (int r = 0; r < 16; ++r) { p0[r] = __builtin_amdgcn_exp2f(fmaf(p0[r], LOG2E, mnL)); p1[r] = __builtin_amdgcn_exp2f(fmaf(p1[r], LOG2E, mnL)); ps += p0[r] + p1[r]; }
    ps = swap_sum(ps);
    l_reg = l_reg * alpha + ps;
}
template <int MODE>
__device__ __forceinline__ void branch_loop(f32x16 (&o)[4], float& l_out, LAS unsigned char* lds, const bf16_t* Kp, const bf16_t* Vp, int jlo, int qt,
                                            const bf16x8 (&qr)[8], int tq, float slope, unsigned selbits, int r32, int hi, int sr, int sc, LAS float* wsc, int wave_tmin, int grpB,
                                            const Stage& P0, const Stage& P1  ,
                                            const LAS int* jl  ) {
    float m_reg = -1e30f, l_reg = 0.f;
#pragma unroll
    for (int d = 0; d < 4; ++d)
#pragma unroll
        for (int r = 0; r < 16; ++r) o[d][r] = 0.f;
    const int vb0 = (int)(uintptr_t)(lds + OFF_V) + v_rd_base(r32 + 32 * hi);
    const int NT = (MODE == 1) ? __builtin_amdgcn_readfirstlane(jl[32]) : qt - jlo + 1;
#define AT_TJ(t) ((MODE == 1) ? __builtin_amdgcn_readfirstlane(jl[t]) : jlo + (t))
    unsigned xk0w, xk1w, xqw;
    { const float sv = slope * (1.f / SCALE); const bf16_t shi = f2bf(sv), slo = f2bf(sv - bf2f(shi));
      xk0w = hi ? 0u : (unsigned)f2bf((float)r32) * 0x10001u; xk1w = hi ? 0u : (unsigned)f2bf((float)(32 + r32)) * 0x10001u; xqw = hi ? 0u : ((unsigned)shi | ((unsigned)slo << 16)); }
#define AT_LGKM0() asm volatile("s_waitcnt lgkmcnt(0)" ::: "memory")
#define AT_BAR() do { AT_LGKM0(); __builtin_amdgcn_s_barrier(); asm volatile("" ::: "memory"); } while (0)
    Stage S0; stage_write(P0, lds, 0, sr, sc); if (NT > 1) stage_write(P1, lds, 1, sr, sc);
    if (NT > 2) stage_load(S0, Kp, Vp, PROJ_LD, AT_TJ(2) * 64, sr, sc);
    __syncthreads();
    if (grpB) AT_BAR();
    int buf = 0;
#define AT_STEP(tau, SX, DIAG) do { \
        const int j = AT_TJ(tau); \
        f32x16 p0, p1; \
        bf16x8 kx0, kx1, qx; { unsigned t0_ = xk0w, t1_ = xk1w, t2_ = xqw; asm volatile("" : "+v"(t0_), "+v"(t1_), "+v"(t2_)); \
            u32x4 a0_ = {t0_, 0u, 0u, 0u}, a1_ = {t1_, 0u, 0u, 0u}, b0_ = {t2_, 0u, 0u, 0u}; kx0 = *reinterpret_cast<bf16x8*>(&a0_); kx1 = *reinterpret_cast<bf16x8*>(&a1_); qx = *reinterpret_cast<bf16x8*>(&b0_); } \
        qkt<true>(p0, p1, lds + OFF_K + buf * BUF_B, r32, hi, qr, kx0, kx1, qx); \
        const int kbase = j * 64; const int dq = tq - kbase - 4 * hi; \
        const float base2 = slope * (float)(kbase - tq); \
        bool on = true; \
        if (MODE == 1) { \
            on = (selbits >> j) & 1u; \
            if (DIAG) {        \
                _Pragma("unroll") for (int r = 0; r < 16; ++r) { const int cc = (r & 3) + 8 * (r >> 2); if (cc > dq) p0[r] = -INFINITY; if (cc + 32 > dq) p1[r] = -INFINITY; } \
            } \
        } else { \
            if (kbase + 63 > wave_tmin || kbase < wave_tmin + 31 - (WINDOW - 1)) { \
                _Pragma("unroll") for (int r = 0; r < 16; ++r) { const int cc = (r & 3) + 8 * (r >> 2); \
                    if ((unsigned)(dq - cc) >= (unsigned)WINDOW) p0[r] = -INFINITY; if ((unsigned)(dq - cc - 32) >= (unsigned)WINDOW) p1[r] = -INFINITY; } \
            } \
        } \
        float mnL; const float alpha = online_sm1_raw(p0, p1, m_reg, mnL, base2, on); \
        AT_BAR(); \
        if ((tau) + 2 < NT) { int b2 = buf + 2; if (b2 >= 3) b2 -= 3; stage_write(SX, lds, b2, sr, sc); } \
        if ((tau) + 3 < NT) stage_load(SX, Kp, Vp, PROJ_LD, AT_TJ((tau) + 3) * 64, sr, sc); \
        online_sm2_raw(p0, p1, mnL, alpha, l_reg); \
        bf16x8 pa0, pa1, pa2, pa3; pack_p(p0, pa0, pa1); pack_p(p1, pa2, pa3); \
        if (__any(alpha < 1.f)) { if (hi == 0) wsc[r32] = alpha; \
            _Pragma("unroll") for (int r = 0; r < 16; ++r) { const float al = wsc[crow(r, hi)]; \
                _Pragma("unroll") for (int d = 0; d < 4; ++d) o[d][r] *= al; } } \
        pv_tile(o, vb0 + buf * BUF_B, pa0, pa1, pa2, pa3); \
        AT_BAR(); \
        buf = buf + 1; if (buf >= 3) buf = 0; } while (0)
    if (MODE == 1) { for (int tau = 0; tau < NT - 1; ++tau) { AT_STEP(tau, S0, 0); } { const int tau = NT - 1; AT_STEP(tau, S0, 1); } }
    else { for (int tau = 0; tau < NT; ++tau) { AT_STEP(tau, S0, 0); } }
#undef AT_STEP
#undef AT_TJ
    if (!grpB) AT_BAR();
#undef AT_BAR
#undef AT_LGKM0
    l_out = l_reg;
    __syncthreads();
}
}

__device__ __forceinline__ void attn_fast_unit(const Frame& F, const Args& a, int unit) {
    using namespace at;
    unsigned char* ws = F.ws; const bf16_t* PROJ = (const bf16_t*)(ws + WS_PROJ); bf16_t* YM = (bf16_t*)(ws + WS_YMIX);
    LAS unsigned char* lds = F.lds;
    const int qt = 31 - (unit >> 4), bg = unit & 15, b = bg >> 1, g = bg & 1;
    int tz = threadIdx.x; asm volatile("" : "+v"(tz));
    const int lane = tz & 63, r32 = lane & 31, hi = lane >> 5, head = F.wid & 3, qh = F.wid >> 2;
    const int t0 = qt * 64, tq = t0 + qh * 32 + r32, wave_tmin = t0 + qh * 32;
    const int sr = tz >> 4, sc = (tz & 15) * 8;
    const float slope = exp2f(-(float)(g * 4 + head + 1));
    LAS float* wsc = (LAS float*)(lds + OFF_WSC) + F.wid * 256;
    LAS float* imph = (LAS float*)(lds + OFF_IMP);
    LAS unsigned* selm = (LAS unsigned*)(lds + OFF_SELM);
    const bf16_t* Kc = (const bf16_t*)(ws + WS_KC) + (size_t)bg * 128 * 128; const bf16_t* Vc = (const bf16_t*)(ws + WS_VC) + (size_t)bg * 128 * 128;
    Stage Sc0, Sc1; stage_load(Sc0, Kc, Vc, 128, 0, sr, sc); stage_load(Sc1, Kc, Vc, 128, 64, sr, sc);
    bf16x8 qr[8];
    { const bf16_t* qp = PROJ + (size_t)(b * SEQ + tq) * PROJ_LD + C_NQ + (g * 4 + head) * 128 + hi * 8;
#pragma unroll
      for (int d0 = 0; d0 < 8; ++d0) qr[d0] = *(const bf16x8*)(qp + d0 * 16); }
    float gate[3];
    { const bf16_t* gp = PROJ + (size_t)(b * SEQ + tq) * PROJ_LD + C_NGT + (g * 4 + head) * 3;
#pragma unroll
      for (int c = 0; c < 3; ++c) gate[c] = sigmoidf_(bf2f(gp[c])); }
    f32x16 o[4];
    float* otp = (float*)(ws + WS_OT) + ((size_t)F.bid * 512 + tz) * 64;
    { stage_write(Sc0, lds, 0, sr, sc); stage_write(Sc1, lds, 1, sr, sc);
      __syncthreads();
      f32x16 p0, p1, p2, p3;
      qkt(p0, p1, lds + OFF_K, r32, hi, qr); qkt(p2, p3, lds + OFF_K + BUF_B, r32, hi, qr);
      const int dl0 = ((tq - 31) >> 4) - 4 * hi;
      const float base_f = slope * (float)(16 * 4 * hi + 31 - tq);
      float mx = -INFINITY;
#pragma unroll
      for (int r = 0; r < 16; ++r) { const int cc = (r & 3) + 8 * (r >> 2);
          p0[r] = (cc <= dl0)      ? fmaf(p0[r], SCALE, fmaf(slope, (float)(16 * cc), base_f))        : -INFINITY;
          p1[r] = (cc + 32 <= dl0) ? fmaf(p1[r], SCALE, fmaf(slope, (float)(16 * (cc + 32)), base_f)) : -INFINITY;
          p2[r] = (cc + 64 <= dl0) ? fmaf(p2[r], SCALE, fmaf(slope, (float)(16 * (cc + 64)), base_f)) : -INFINITY;
          p3[r] = (cc + 96 <= dl0) ? fmaf(p3[r], SCALE, fmaf(slope, (float)(16 * (cc + 96)), base_f)) : -INFINITY;
          mx = fmaxf(fmaxf(mx, p0[r]), fmaxf(p1[r], fmaxf(p2[r], p3[r]))); }
      mx = swap_max(mx);
      const float mL = (mx == -INFINITY) ? 0.f : -mx * LOG2E;
      float ps = 0.f;
#pragma unroll
      for (int r = 0; r < 16; ++r) { p0[r] = __builtin_amdgcn_exp2f(fmaf(p0[r], LOG2E, mL)); p1[r] = __builtin_amdgcn_exp2f(fmaf(p1[r], LOG2E, mL));
          p2[r] = __builtin_amdgcn_exp2f(fmaf(p2[r], LOG2E, mL)); p3[r] = __builtin_amdgcn_exp2f(fmaf(p3[r], LOG2E, mL)); ps += (p0[r] + p1[r]) + (p2[r] + p3[r]); }
      ps = swap_sum(ps);
      const float inv = ps > 0.f ? 1.f / ps : 0.f;
#pragma unroll
      for (int r = 0; r < 16; ++r) { p0[r] *= inv; p1[r] *= inv; p2[r] *= inv; p3[r] *= inv; }
      { LAS float* dst = imph + ((size_t)head * 64 + qh * 32 + r32) * 32;
        float prev = 0.f;
#define AT_GRP(P, blk) do { _Pragma("unroll") for (int i = 0; i < 4; ++i) { const float av = 2.f * (P[4 * i] + P[4 * i + 1] + P[4 * i + 2]) + P[4 * i + 3]; const float bv = P[4 * i + 3]; \
            auto rr = __builtin_amdgcn_permlane32_swap(__float_as_uint(bv), __float_as_uint(bv), false, false); const float pb = __uint_as_float(hi ? rr[0] : rr[1]); \
            dst[2 * ((blk) * 4 + i) + hi] = av + (hi ? pb : prev); prev = pb; } } while (0)
        AT_GRP(p0, 0); AT_GRP(p1, 1); AT_GRP(p2, 2); AT_GRP(p3, 3);
#undef AT_GRP
      }
      bf16x8 pa0, pa1, pa2, pa3;
#pragma unroll
      for (int d = 0; d < 4; ++d)
#pragma unroll
          for (int r = 0; r < 16; ++r) o[d][r] = 0.f;
      const int vb0 = (int)(uintptr_t)(lds + OFF_V) + v_rd_base(lane);
      pack_p(p0, pa0, pa1); pack_p(p1, pa2, pa3); pv_tile(o, vb0, pa0, pa1, pa2, pa3);
      pack_p(p2, pa0, pa1); pack_p(p3, pa2, pa3); pv_tile(o, vb0 + BUF_B, pa0, pa1, pa2, pa3);
      if (hi == 0) wsc[r32] = gate[0];
#pragma unroll
      for (int r = 0; r < 16; ++r) { const float f = wsc[crow(r, hi)];
#pragma unroll
          for (int d = 0; d < 4; ++d) o[d][r] *= f; }
#pragma unroll
      for (int d = 0; d < 4; ++d)
#pragma unroll
          for (int k = 0; k < 4; ++k) *(f32x4*)(otp + d * 16 + 4 * k) = (f32x4){o[d][4 * k], o[d][4 * k + 1], o[d][4 * k + 2], o[d][4 * k + 3]};
    }
    __syncthreads();
    const bf16_t* Ksl = PROJ + (size_t)(b * SEQ) * PROJ_LD + C_KSL + g * 128; const bf16_t* Vsl = PROJ + (size_t)(b * SEQ) * PROJ_LD + C_VSL + g * 128;
    Stage Pa, Pb; stage_load(Pa, Ksl, Vsl, PROJ_LD, 0, sr, sc);
    { const int q = tz >> 3, part = tz & 7, tqq = t0 + q, cur = tqq >> 6;
      unsigned bits = 0u;
      if (cur < SEL_TOP) { bits = (part == 0) ? ((2u << cur) - 1u) : 0u; }
      else {
          float sc_[4];
#pragma unroll
          for (int k = 0; k < 4; ++k) { const int j = part * 4 + k; const float v = ((imph[(0 * 64 + q) * 32 + j] + imph[(1 * 64 + q) * 32 + j]) + imph[(2 * 64 + q) * 32 + j]) + imph[(3 * 64 + q) * 32 + j];
              const bool forced = (j == 0) || (j == cur) || (j == cur - 1); sc_[k] = forced ? 1e4f : (j <= cur ? v : -1e4f); }
          int rank[4] = {0, 0, 0, 0};
          for (int jj = 0; jj < 32; ++jj) { const float v = ((imph[(0 * 64 + q) * 32 + jj] + imph[(1 * 64 + q) * 32 + jj]) + imph[(2 * 64 + q) * 32 + jj]) + imph[(3 * 64 + q) * 32 + jj];
              const bool forced = (jj == 0) || (jj == cur) || (jj == cur - 1); const float s2 = forced ? 1e4f : (jj <= cur ? v : -1e4f);
#pragma unroll
              for (int k = 0; k < 4; ++k) { const int j = part * 4 + k; rank[k] += (s2 > sc_[k] || (s2 == sc_[k] && jj < j)) ? 1 : 0; } }
#pragma unroll
          for (int k = 0; k < 4; ++k) { const int j = part * 4 + k; if (rank[k] < SEL_TOP && j <= cur) bits |= 1u << j; }
      }
      bits |= __shfl_xor(bits, 1); bits |= __shfl_xor(bits, 2); bits |= __shfl_xor(bits, 4);
      if (part == 0) selm[q] = bits; }
    __syncthreads();
    LAS int* jlist = (LAS int*)(lds + OFF_WSC + 8192);
    if (F.wid == 0) { unsigned um = selm[lane];
        um |= __shfl_xor(um, 1); um |= __shfl_xor(um, 2); um |= __shfl_xor(um, 4); um |= __shfl_xor(um, 8); um |= __shfl_xor(um, 16); um |= __shfl_xor(um, 32);
        if (lane == 0) { int n = 0; for (int j = 0; j <= qt; ++j) if ((um >> j) & 1u) jlist[n++] = j; jlist[32] = n; for (int j = n; j < 32; ++j) jlist[j] = qt; } }
    __syncthreads();
    const unsigned selbits = selm[qh * 32 + r32];
    if (jlist[32] > 1) stage_load(Pb, Ksl, Vsl, PROJ_LD, jlist[1] * 64, sr, sc);
    const int jlo = (t0 - (WINDOW - 1)) > 0 ? (t0 - (WINDOW - 1)) >> 6 : 0;
    const bf16_t* Kwn = PROJ + (size_t)(b * SEQ) * PROJ_LD + C_KWN + g * 128; const bf16_t* Vwn = PROJ + (size_t)(b * SEQ) * PROJ_LD + C_VWN + g * 128;
    { float l_sel;
      branch_loop<1>(o, l_sel, lds, Ksl, Vsl, 0, qt, qr, tq, slope, selbits, r32, hi, sr, sc, wsc, wave_tmin, qh, Pa, Pb, jlist);
      stage_load(Pa, Kwn, Vwn, PROJ_LD, jlo * 64, sr, sc); stage_load(Pb, Kwn, Vwn, PROJ_LD, (jlo + 1) * 64, sr, sc);
      if (hi == 0) wsc[r32] = gate[1] / l_sel;
#pragma unroll
      for (int r = 0; r < 16; ++r) { const float f = wsc[crow(r, hi)];
#pragma unroll
          for (int d = 0; d < 4; ++d) o[d][r] *= f; }
#pragma unroll
      for (int d = 0; d < 4; ++d)
#pragma unroll
          for (int k = 0; k < 4; ++k) { const f32x4 pv = *(const f32x4*)(otp + d * 16 + 4 * k); *(f32x4*)(otp + d * 16 + 4 * k) = pv + (f32x4){o[d][4 * k], o[d][4 * k + 1], o[d][4 * k + 2], o[d][4 * k + 3]}; } }
    { float l_win;
      branch_loop<2>(o, l_win, lds, Kwn, Vwn, jlo, qt, qr, tq, slope, 0u, r32, hi, sr, sc, wsc, wave_tmin, qh, Pa, Pb, jlist);
      if (hi == 0) wsc[r32] = gate[2] / l_win;
#pragma unroll
      for (int r = 0; r < 16; ++r) { const float f = wsc[crow(r, hi)];
#pragma unroll
          for (int d = 0; d < 4; ++d) o[d][r] *= f; }
#pragma unroll
      for (int d = 0; d < 4; ++d)
#pragma unroll
          for (int k = 0; k < 4; ++k) { const f32x4 pv = *(const f32x4*)(otp + d * 16 + 4 * k); o[d][4 * k] += pv[0]; o[d][4 * k + 1] += pv[1]; o[d][4 * k + 2] += pv[2]; o[d][4 * k + 3] += pv[3]; } }
    { const float* ng = a.in[I_NSAG];
      float gsc[4];
#pragma unroll
      for (int d = 0; d < 4; ++d) gsc[d] = ng[d * 32 + r32];
#pragma unroll
      for (int r = 0; r < 16; ++r) { float ss = 0.f;
#pragma unroll
          for (int d = 0; d < 4; ++d) ss += o[d][r] * o[d][r];
          ss += __shfl_xor(ss, 1); ss += __shfl_xor(ss, 2); ss += __shfl_xor(ss, 4); ss += __shfl_xor(ss, 8); ss += __shfl_xor(ss, 16);
          const float rs = rsqrtf(ss * (1.f / 128.f) + EPS);
          const int row = b * SEQ + t0 + qh * 32 + crow(r, hi);
          bf16_t* yp = YM + (size_t)row * DM + HG_W + (g * 4 + head) * 128 + r32;
#pragma unroll
          for (int d = 0; d < 4; ++d) yp[d * 32] = f2bf(o[d][r] * rs * gsc[d]); } }
    __syncthreads();
}

namespace hg {
constexpr int T_KD = 0, T_QD = 16384, T_V = 32768, T_KL = 49152, T_FR = 65536, T_QR = 81920, T_OR = 98304, T_PART = 114688, T_DL = T_PART + 4096, T_SSQ = T_DL + 512;
}
__device__ __forceinline__ void hgrn_fast_unit(const Frame& F, const Args& a, int unit) {
    using namespace hg; using at::crow; using at::v_st; using at::v_rd_base; typedef at::s16x4 s16x4;
    unsigned char* ws = F.ws; const bf16_t* PROJ = (const bf16_t*)(ws + WS_PROJ); bf16_t* YM = (bf16_t*)(ws + WS_YMIX);
    LAS unsigned char* lds = F.lds;
    const int b = unit >> 3, h = unit & 7;
    int tz = threadIdx.x; asm volatile("" : "+v"(tz));
    const int lane = tz & 63, r32 = lane & 31, hi = lane >> 5, th = F.wid >> 2, vq = F.wid & 3;
    const int lr = tz >> 4, lc = (tz & 15) * 8;
    const int kp = tz & 63, tg = tz >> 6;
    LAS float* part = (LAS float*)(lds + T_PART); LAS float* dl = (LAS float*)(lds + T_DL); LAS float* ssq = (LAS float*)(lds + T_SSQ);
    f32x16 Sacc[4];
#pragma unroll
    for (int k = 0; k < 4; ++k)
#pragma unroll
        for (int r = 0; r < 16; ++r) Sacc[k][r] = 0.f;
    const bf16_t* base = PROJ + (size_t)(b * SEQ) * PROJ_LD + h * 128;
    u32x4 rf0, rf1, rq0, rq1, ri0, ri1, ro0, ro1;
    const bf16_t* obase = (const bf16_t*)(ws + WS_OMF) + (size_t)(b * SEQ) * HG_W + h * 128;
#define HG_LOAD(t0_) do { const bf16_t* p0_ = base + (size_t)((t0_) + lr) * PROJ_LD + lc; const bf16_t* p1_ = p0_ + (size_t)32 * PROJ_LD; \
        rf0 = *(const u32x4*)(p0_ + C_HF); rf1 = *(const u32x4*)(p1_ + C_HF); rq0 = *(const u32x4*)(p0_ + C_HQ); rq1 = *(const u32x4*)(p1_ + C_HQ); \
        ri0 = *(const u32x4*)(p0_ + C_HI); ri1 = *(const u32x4*)(p1_ + C_HI); \
        ro0 = *(const u32x4*)(obase + (size_t)((t0_) + lr) * HG_W + lc); ro1 = *(const u32x4*)(obase + (size_t)((t0_) + lr + 32) * HG_W + lc); } while (0)
    HG_LOAD(0);
    const float ngv = a.in[I_HGNG][vq * 32 + r32];
    for (int c = 0; c < SEQ / 64; ++c) {
        const int t0 = c * 64;
        *(LAS u32x4*)(lds + T_FR + lr * 256 + lc * 2) = rf0; *(LAS u32x4*)(lds + T_FR + (lr + 32) * 256 + lc * 2) = rf1;
        *(LAS u32x4*)(lds + T_QR + lr * 256 + lc * 2) = rq0; *(LAS u32x4*)(lds + T_QR + (lr + 32) * 256 + lc * 2) = rq1;
        *(LAS u32x4*)(lds + T_OR + lr * 256 + lc * 2) = ro0; *(LAS u32x4*)(lds + T_OR + (lr + 32) * 256 + lc * 2) = ro1;
        *(LAS u32x4*)(lds + T_V + v_st(lr, lc)) = ri0; *(LAS u32x4*)(lds + T_V + v_st(lr + 32, lc)) = ri1;
        __syncthreads();
        float lf0[8], lf1[8]; float run0 = 0.f, run1 = 0.f;
#pragma unroll
        for (int i = 0; i < 8; ++i) { const int t = tg * 8 + i; const unsigned w = *(const LAS unsigned*)(lds + T_FR + t * 256 + kp * 4);
            run0 += __uint_as_float(w << 16); run1 += __uint_as_float(w & 0xffff0000u); lf0[i] = run0; lf1[i] = run1; }
        *(LAS f32x2*)(part + tg * 128 + 2 * kp) = (f32x2){run0, run1};
        __syncthreads();
        { float pre0 = 0.f, pre1 = 0.f, tot0 = 0.f, tot1 = 0.f;
#pragma unroll
          for (int gq = 0; gq < 8; ++gq) { const f32x2 pv = *(const LAS f32x2*)(part + gq * 128 + 2 * kp); tot0 += pv[0]; tot1 += pv[1]; if (gq < tg) { pre0 += pv[0]; pre1 += pv[1]; } }
          const float dlast0 = __builtin_amdgcn_exp2f(tot0), dlast1 = __builtin_amdgcn_exp2f(tot1);
          if (tg == 0) *(LAS f32x2*)(dl + 2 * kp) = (f32x2){dlast0, dlast1};
#pragma unroll
          for (int i = 0; i < 8; ++i) { const int t = tg * 8 + i; const float bb0 = pre0 + lf0[i], bb1 = pre1 + lf1[i];
              const unsigned qw = *(const LAS unsigned*)(lds + T_QR + t * 256 + kp * 4), ow = *(const LAS unsigned*)(lds + T_OR + t * 256 + kp * 4);
              const float qd0 = __uint_as_float(qw << 16) * __builtin_amdgcn_exp2f(bb0), qd1 = __uint_as_float(qw & 0xffff0000u) * __builtin_amdgcn_exp2f(bb1);
              const float kd0 = __uint_as_float(ow << 16) * __builtin_amdgcn_exp2f(-bb0), kd1 = __uint_as_float(ow & 0xffff0000u) * __builtin_amdgcn_exp2f(-bb1);
              const int ko = AT_KSWZ(t, kp * 4);
              *(LAS unsigned*)(lds + T_QD + ko) = cvt_pk_bf16(qd0, qd1); *(LAS unsigned*)(lds + T_KD + ko) = cvt_pk_bf16(kd0, kd1);
              *(LAS unsigned*)(lds + T_KL + v_st(t, 2 * kp)) = cvt_pk_bf16(kd0 * dlast0, kd1 * dlast1); } }
        __syncthreads();
        if (c + 1 < SEQ / 64) HG_LOAD(t0 + 64);
        const int tl = th * 32 + r32;
        bf16x8 qr[8];
#pragma unroll
        for (int d0 = 0; d0 < 8; ++d0) qr[d0] = *(const LAS bf16x8*)(lds + T_QD + AT_KSWZ(tl, (d0 * 16 + hi * 8) * 2));
        bf16x8 pa0, pa1, pa2, pa3;
        if (th == 0) {
            f32x16 p0;
#pragma unroll
            for (int r = 0; r < 16; ++r) p0[r] = 0.f;
#pragma unroll
            for (int d0 = 0; d0 < 8; ++d0) { const bf16x8 b0 = *(const LAS bf16x8*)(lds + T_KD + AT_KSWZ(r32, (d0 * 16 + hi * 8) * 2)); p0 = __builtin_amdgcn_mfma_f32_32x32x16_bf16(b0, qr[d0], p0, 0, 0, 0); }
#pragma unroll
            for (int r = 0; r < 16; ++r) { const int s = crow(r, hi); if (s > tl) p0[r] = 0.f; }
            at::pack_p(p0, pa0, pa1); pa2 = (bf16x8){0, 0, 0, 0, 0, 0, 0, 0}; pa3 = pa2;
        } else {
            f32x16 p0, p1;
            at::qkt(p0, p1, lds + T_KD, r32, hi, qr);
#pragma unroll
            for (int r = 0; r < 16; ++r) { const int s = crow(r, hi); if (s + 32 > tl) p1[r] = 0.f; }
            at::pack_p(p0, pa0, pa1); at::pack_p(p1, pa2, pa3);
        }
        f32x16 o;
#pragma unroll
        for (int r = 0; r < 16; ++r) o[r] = 0.f;
        const int vb = (int)(uintptr_t)(lds + T_V) + v_rd_base(lane) + vq * 512;
        const int klb = (int)(uintptr_t)(lds + T_KL) + v_rd_base(lane);
#define HG_TRRD(dst, addr, off) asm volatile("ds_read_b64_tr_b16 %0, %1 offset:%2" : "=&v"(dst) : "v"(addr), "i"(off) : "memory")
        s16x4 vl0, vh0, vl1, vh1, vl2, vh2, vl3, vh3;
        HG_TRRD(vl0, vb, 0); HG_TRRD(vh0, vb, 2048); HG_TRRD(vl1, vb, 4096); HG_TRRD(vh1, vb, 6144); HG_TRRD(vl2, vb, 8192); HG_TRRD(vh2, vb, 10240); HG_TRRD(vl3, vb, 12288); HG_TRRD(vh3, vb, 14336);
        asm volatile("s_waitcnt lgkmcnt(0)" ::: "memory"); __builtin_amdgcn_sched_barrier(0);
        const bf16x8 vf0 = (bf16x8){vl0[0], vl0[1], vl0[2], vl0[3], vh0[0], vh0[1], vh0[2], vh0[3]}, vf1 = (bf16x8){vl1[0], vl1[1], vl1[2], vl1[3], vh1[0], vh1[1], vh1[2], vh1[3]};
        const bf16x8 vf2 = (bf16x8){vl2[0], vl2[1], vl2[2], vl2[3], vh2[0], vh2[1], vh2[2], vh2[3]}, vf3 = (bf16x8){vl3[0], vl3[1], vl3[2], vl3[3], vh3[0], vh3[1], vh3[2], vh3[3]};
        o = __builtin_amdgcn_mfma_f32_32x32x16_bf16(pa0, vf0, o, 0, 0, 0); o = __builtin_amdgcn_mfma_f32_32x32x16_bf16(pa1, vf1, o, 0, 0, 0);
        o = __builtin_amdgcn_mfma_f32_32x32x16_bf16(pa2, vf2, o, 0, 0, 0); o = __builtin_amdgcn_mfma_f32_32x32x16_bf16(pa3, vf3, o, 0, 0, 0);
#pragma unroll
        for (int kb = 0; kb < 4; ++kb)
#pragma unroll
            for (int sp = 0; sp < 2; ++sp) {
                const u32x2 a_lo = *(const LAS u32x2*)(lds + T_QD + tl * 256 + ((((4 * kb + 2 * sp) * 16)) ^ ((tl & 7) << 4)) + 8 * hi);
                const u32x2 a_hi = *(const LAS u32x2*)(lds + T_QD + tl * 256 + ((((4 * kb + 2 * sp + 1) * 16)) ^ ((tl & 7) << 4)) + 8 * hi);
                u32x4 aw = {a_lo[0], a_lo[1], a_hi[0], a_hi[1]};
                u32x4 bw = {cvt_pk_bf16(Sacc[kb][8 * sp + 0], Sacc[kb][8 * sp + 1]), cvt_pk_bf16(Sacc[kb][8 * sp + 2], Sacc[kb][8 * sp + 3]),
                            cvt_pk_bf16(Sacc[kb][8 * sp + 4], Sacc[kb][8 * sp + 5]), cvt_pk_bf16(Sacc[kb][8 * sp + 6], Sacc[kb][8 * sp + 7])};
                o = __builtin_amdgcn_mfma_f32_32x32x16_bf16(*reinterpret_cast<bf16x8*>(&aw), *reinterpret_cast<bf16x8*>(&bw), o, 0, 0, 0); }
        float gt[16];
#pragma unroll
        for (int r = 0; r < 16; ++r) gt[r] = bf2f(base[(size_t)(t0 + th * 32 + crow(r, hi)) * PROJ_LD + C_HGT + vq * 32 + r32]);
#define HG_SUPD(kb) do { \
            _Pragma("unroll") for (int i4 = 0; i4 < 4; ++i4) { const f32x4 dv = *(const LAS f32x4*)(dl + (kb) * 32 + 8 * i4 + 4 * hi); \
                Sacc[kb][4 * i4] *= dv[0]; Sacc[kb][4 * i4 + 1] *= dv[1]; Sacc[kb][4 * i4 + 2] *= dv[2]; Sacc[kb][4 * i4 + 3] *= dv[3]; } \
            s16x4 al0, ah0, al1, ah1, al2, ah2, al3, ah3; \
            HG_TRRD(al0, klb, (kb) * 512); HG_TRRD(ah0, klb, (kb) * 512 + 2048); HG_TRRD(al1, klb, (kb) * 512 + 4096); HG_TRRD(ah1, klb, (kb) * 512 + 6144); \
            HG_TRRD(al2, klb, (kb) * 512 + 8192); HG_TRRD(ah2, klb, (kb) * 512 + 10240); HG_TRRD(al3, klb, (kb) * 512 + 12288); HG_TRRD(ah3, klb, (kb) * 512 + 14336); \
            asm volatile("s_waitcnt lgkmcnt(0)" ::: "memory"); __builtin_amdgcn_sched_barrier(0); \
            Sacc[kb] = __builtin_amdgcn_mfma_f32_32x32x16_bf16((bf16x8){al0[0], al0[1], al0[2], al0[3], ah0[0], ah0[1], ah0[2], ah0[3]}, vf0, Sacc[kb], 0, 0, 0); \
            Sacc[kb] = __builtin_amdgcn_mfma_f32_32x32x16_bf16((bf16x8){al1[0], al1[1], al1[2], al1[3], ah1[0], ah1[1], ah1[2], ah1[3]}, vf1, Sacc[kb], 0, 0, 0); \
            Sacc[kb] = __builtin_amdgcn_mfma_f32_32x32x16_bf16((bf16x8){al2[0], al2[1], al2[2], al2[3], ah2[0], ah2[1], ah2[2], ah2[3]}, vf2, Sacc[kb], 0, 0, 0); \
            Sacc[kb] = __builtin_amdgcn_mfma_f32_32x32x16_bf16((bf16x8){al3[0], al3[1], al3[2], al3[3], ah3[0], ah3[1], ah3[2], ah3[3]}, vf3, Sacc[kb], 0, 0, 0); } while (0)
        HG_SUPD(0); HG_SUPD(1); HG_SUPD(2); HG_SUPD(3);
#undef HG_SUPD
#undef HG_TRRD
        { float y8[8], y4[4], y2[2], y1;
          const bool b4 = (r32 & 16) != 0, b3 = (r32 & 8) != 0, b2 = (r32 & 4) != 0, b1 = (r32 & 2) != 0;
#pragma unroll
          for (int i = 0; i < 8; ++i) { const float lo = o[i] * o[i], hi_ = o[8 + i] * o[8 + i]; const float keep = b4 ? hi_ : lo, send = b4 ? lo : hi_; y8[i] = keep + __shfl_xor(send, 16); }
#pragma unroll
          for (int i = 0; i < 4; ++i) { const float keep = b3 ? y8[4 + i] : y8[i], send = b3 ? y8[i] : y8[4 + i]; y4[i] = keep + __shfl_xor(send, 8); }
#pragma unroll
          for (int i = 0; i < 2; ++i) { const float keep = b2 ? y4[2 + i] : y4[i], send = b2 ? y4[i] : y4[2 + i]; y2[i] = keep + __shfl_xor(send, 4); }
          { const float keep = b1 ? y2[1] : y2[0], send = b1 ? y2[0] : y2[1]; y1 = keep + __shfl_xor(send, 2); }
          y1 += __shfl_xor(y1, 1);
          const int rf = ((r32 >> 1) & 15);
          if ((r32 & 1) == 0) ssq[vq * 64 + th * 32 + crow(rf, hi)] = y1; }
        __syncthreads();
        { bf16_t* yb = YM + (size_t)(b * SEQ + t0 + th * 32) * DM + h * 128 + vq * 32;
          const unsigned loff = (unsigned)(4 * hi) * DM + (unsigned)r32;
          LAS float* wrs = (LAS float*)(lds + T_SSQ + 1024) + F.wid * 32;
          if (lane < 32) { const int t = th * 32 + lane; const float ss = ((ssq[t] + ssq[64 + t]) + ssq[128 + t]) + ssq[192 + t]; wrs[lane] = rsqrtf(ss * (1.f / 128.f) + EPS); }
          f32x4 rsv[4];
#pragma unroll
          for (int i = 0; i < 4; ++i) rsv[i] = *(const LAS f32x4*)(wrs + 8 * i + 4 * hi);
#pragma unroll
          for (int r = 0; r < 16; ++r) { const int tc = (r & 3) + 8 * (r >> 2);
              (yb + (size_t)tc * DM)[loff] = f2bf(o[r] * (rsv[r >> 2][r & 3] * ngv) * gt[r]); } }
    }
#undef HG_LOAD
    __syncthreads();
}

__device__ __forceinline__ void compress_fast_unit(const Frame& F, const Args& a, int u) {
    unsigned char* ws = F.ws; const bf16_t* PROJ = (const bf16_t*)(ws + WS_PROJ); LAS unsigned char* lds = F.lds;
    const int j = u >> 6, bg = (u >> 2) & 15, mt = u & 3, b = bg >> 1, g = bg & 1;
    int tz = threadIdx.x; asm volatile("" : "+v"(tz));
    const int lane = tz & 63, r32 = lane & 31, hi = lane >> 5, w = F.wid;
    const int n = mt * 32 + r32, nl = n < 126 ? n : 126;
    const bf16_t* W2T = (const bf16_t*)(ws + WS_W2T) + (size_t)j * 128 * 128;
    const int colb = (j ? C_VCM : C_KCM) + g * 128;
    const bf16_t* arow = PROJ + (size_t)(b * SEQ + 16 * nl) * PROJ_LD + colb + hi * 8;
    const bf16_t* bfrag = (const bf16_t*)(ws + WS_W1T) + ((size_t)(j * 8 + w) * 32 * 4 * 64 + lane) * 8;
    f32x16 acc[4];
#pragma unroll
    for (int c = 0; c < 4; ++c)
#pragma unroll
        for (int r = 0; r < 16; ++r) acc[c][r] = 0.f;
#pragma unroll 4
    for (int ks = 0; ks < 32; ++ks) {
        const int l = 4 * w + (ks >> 3), d = (ks & 7) * 16;
        const bf16x8 af = *(const bf16x8*)(arow + (size_t)l * PROJ_LD + d);
#pragma unroll
        for (int c = 0; c < 4; ++c) { const bf16x8 bfr = *(const bf16x8*)(bfrag + (size_t)(ks * 4 + c) * 64 * 8);
            acc[c] = __builtin_amdgcn_mfma_f32_32x32x16_bf16(af, bfr, acc[c], 0, 0, 0); }
    }
    LAS float* red = (LAS float*)lds;
#pragma unroll
    for (int c = 0; c < 4; ++c)
#pragma unroll
        for (int r = 0; r < 16; ++r) red[(w * 32 + at::crow(r, hi)) * 128 + c * 32 + r32] = acc[c][r];
    __syncthreads();
    LAS unsigned char* hdn = lds + 131072 - 8192;
    { const int nn = tz >> 4, c8 = (tz & 15) * 8; float sv[8];
      const float* b1 = (const float*)(ws + WS_B1P) + (size_t)j * 32 * 128 + c8;
#pragma unroll
      for (int i = 0; i < 8; ++i) sv[i] = 0.f;
#pragma unroll 4
      for (int kg = 0; kg < 32; ++kg) { const f32x4 x0 = *(const f32x4*)(b1 + kg * 128), x1 = *(const f32x4*)(b1 + kg * 128 + 4);
#pragma unroll
          for (int i = 0; i < 4; ++i) { sv[i] += x0[i]; sv[4 + i] += x1[i]; } }
#pragma unroll
      for (int ww = 0; ww < 8; ++ww) { const f32x4 x0 = *(const LAS f32x4*)(red + (ww * 32 + nn) * 128 + c8), x1 = *(const LAS f32x4*)(red + (ww * 32 + nn) * 128 + c8 + 4);
#pragma unroll
          for (int i = 0; i < 4; ++i) { sv[i] += x0[i]; sv[4 + i] += x1[i]; } }
      __syncthreads();
#pragma unroll
      for (int i = 0; i < 8; ++i) sv[i] = gelu_tanh(sv[i]);
      u32x4 pw; pw[0] = cvt_pk_bf16(sv[0], sv[1]); pw[1] = cvt_pk_bf16(sv[2], sv[3]); pw[2] = cvt_pk_bf16(sv[4], sv[5]); pw[3] = cvt_pk_bf16(sv[6], sv[7]);
      *(LAS u32x4*)(hdn + AT_KSWZ(nn, c8 * 2)) = pw; }
    __syncthreads();
    if (w < 4) {
        f32x16 o2;
#pragma unroll
        for (int r = 0; r < 16; ++r) o2[r] = 0.f;
#pragma unroll
        for (int ks = 0; ks < 8; ++ks) { const bf16x8 af = *(const LAS bf16x8*)(hdn + AT_KSWZ(r32, (ks * 16 + hi * 8) * 2));
            const bf16x8 bfr = *(const bf16x8*)(W2T + (size_t)(w * 32 + r32) * 128 + ks * 16 + hi * 8);
            o2 = __builtin_amdgcn_mfma_f32_32x32x16_bf16(af, bfr, o2, 0, 0, 0); }
        bf16_t* dst = (bf16_t*)(ws + (DEBUG_CMP ? (j ? WS_Y + 1048576 : WS_Y) : (j ? WS_VC : WS_KC))) + (size_t)bg * 128 * 128;
#pragma unroll
        for (int r = 0; r < 16; ++r) { const int nn = mt * 32 + at::crow(r, hi); dst[(size_t)nn * 128 + w * 32 + r32] = (nn < NCMP) ? f2bf(o2[r]) : (bf16_t)0; }
    }
    __syncthreads();
}

__device__ __forceinline__ void p5_router(const Frame& F, const Args& a) {
    unsigned char* ws = F.ws; const bf16_t* H1 = (const bf16_t*)(ws + WS_H1); unsigned char* XN = ws + WS_U;
    const float* wr2 = (const float*)(ws + WS_WR2); const float* g2 = a.in[I_N2G]; const float* br = a.in[I_BR];
    float* tokw = (float*)(ws + WS_TOKW); int* slot = (int*)(ws + WS_SLOT); unsigned* cnt = F.ctl + CW_CNT;
    constexpr int HS_LD = 4104;
    LAS unsigned char* hs = F.lds; LAS float* rsv = (LAS float*)(F.lds + 32 * HS_LD); LAS float* red = (LAS float*)F.lds;
    LAS unsigned* lcnt = (LAS unsigned*)(F.lds + 32 * HS_LD + 256); LAS unsigned* lbase = lcnt + 32;
    if (F.tid < 32) lcnt[F.tid] = 0u;
    int myexp[2] = {0, 0}, myrank[2] = {0, 0};
    __syncthreads();
    for (int it = F.bid; it < NTOK / 32; it += F.G) {
#pragma unroll
        for (int rr = 0; rr < 4; ++rr) { const int tl = F.wid * 4 + rr, row = it * 32 + tl;
            const bf16_t* hr = H1 + (size_t)row * DM; u32x4 hw[4]; float ss = 0.f;
#pragma unroll
            for (int i = 0; i < 4; ++i) { hw[i] = *(const u32x4*)(hr + i * 512 + F.lane * 8); float hf[8]; unpack8(hw[i], hf);
#pragma unroll
                for (int j = 0; j < 8; ++j) ss += hf[j] * hf[j]; }
            ss = wave_sum(ss); const float rs = rsqrtf(ss * (1.f / DM) + EPS);
            if (F.lane == 0) rsv[tl] = rs;
#pragma unroll
            for (int i = 0; i < 4; ++i) { const f32x4 g0 = *(const f32x4*)(g2 + i * 512 + F.lane * 8), g1 = *(const f32x4*)(g2 + i * 512 + F.lane * 8 + 4);
                float hf[8]; unpack8(hw[i], hf);
                const f32x4 a0 = (f32x4){hf[0], hf[1], hf[2], hf[3]} * rs * g0, a1 = (f32x4){hf[4], hf[5], hf[6], hf[7]} * rs * g1;
                u32x2 w; w[0] = cvt4_fp8(a0[0], a0[1], a0[2], a0[3]); w[1] = cvt4_fp8(a1[0], a1[1], a1[2], a1[3]);
                *(u32x2*)(XN + (size_t)row * DM + i * 512 + F.lane * 8) = w;
                LAS unsigned char* hp = hs + tl * HS_LD + (i * 512 + F.lane * 8) * 2;
                *(LAS u32x2*)hp = (u32x2){hw[i][0], hw[i][1]}; *(LAS u32x2*)(hp + 8) = (u32x2){hw[i][2], hw[i][3]}; } }
        __syncthreads();
        f32x4 c00 = {0.f, 0.f, 0.f, 0.f}, c01 = c00, c10 = c00, c11 = c00;
        { const int ti = F.lane & 15, kq = F.lane >> 4, kb = F.wid * 256 + kq;
          const LAS unsigned char* ha = hs + ti * HS_LD + kb * 2; const float* wb = wr2 + (size_t)kb * 32 + ti;
#pragma unroll 16
          for (int s_ = 0; s_ < 64; ++s_) {
              const float a0 = bf2f(*(const LAS bf16_t*)(ha + s_ * 8)), a1 = bf2f(*(const LAS bf16_t*)(ha + 16 * HS_LD + s_ * 8));
              const float b0 = wb[(size_t)s_ * 128], b1 = wb[(size_t)s_ * 128 + 16];
              c00 = __builtin_amdgcn_mfma_f32_16x16x4f32(a0, b0, c00, 0, 0, 0); c01 = __builtin_amdgcn_mfma_f32_16x16x4f32(a0, b1, c01, 0, 0, 0);
              c10 = __builtin_amdgcn_mfma_f32_16x16x4f32(a1, b0, c10, 0, 0, 0); c11 = __builtin_amdgcn_mfma_f32_16x16x4f32(a1, b1, c11, 0, 0, 0); } }
        float rsl[2];
        rsl[0] = rsv[F.tid >> 5]; rsl[1] = rsv[16 + (F.tid >> 5)];
        __syncthreads();
        { const int cj = F.lane & 15, rq = (F.lane >> 4) * 4; LAS float* rw = red + F.wid * 1024;
#pragma unroll
          for (int r = 0; r < 4; ++r) { rw[(rq + r) * 32 + cj] = c00[r]; rw[(rq + r) * 32 + 16 + cj] = c01[r]; rw[(16 + rq + r) * 32 + cj] = c10[r]; rw[(16 + rq + r) * 32 + 16 + cj] = c11[r]; } }
        __syncthreads();
#pragma unroll
        for (int ps = 0; ps < 2; ++ps) {
            const int tl = ps * 16 + (F.tid >> 5), e = F.tid & 31, row = it * 32 + tl;
            float acc = 0.f;
#pragma unroll
            for (int w = 0; w < 8; ++w) acc += red[w * 1024 + tl * 32 + e];
            const float logit = acc * rsl[ps] + br[e];
            float tv[4]; int ti[4]; float cur = logit;
#pragma unroll
            for (int k = 0; k < 4; ++k) { float bv = cur; int bi = e;
#pragma unroll
                for (int o = 16; o > 0; o >>= 1) { const float ov = __shfl_xor(bv, o); const int oi = __shfl_xor(bi, o); if (ov > bv || (ov == bv && oi < bi)) { bv = ov; bi = oi; } }
                tv[k] = bv; ti[k] = bi; if (e == bi) cur = -INFINITY; }
            const float m = tv[0]; const float e0 = 1.f, e1 = __expf(tv[1] - m), e2 = __expf(tv[2] - m), e3 = __expf(tv[3] - m); const float inv = 1.f / (e0 + e1 + e2 + e3);
            if (e < 4) { const int k = e; const int ee = k == 0 ? ti[0] : k == 1 ? ti[1] : k == 2 ? ti[2] : ti[3]; const float w = (k == 0 ? e0 : k == 1 ? e1 : k == 2 ? e2 : e3) * inv;
                tokw[(size_t)row * 4 + k] = w;
                myexp[ps] = ee; myrank[ps] = (int)__hip_atomic_fetch_add(lcnt + ee, 1u, __ATOMIC_RELAXED, __HIP_MEMORY_SCOPE_WORKGROUP); } }
        __syncthreads();
        if (F.tid < 32) { const unsigned c = lcnt[F.tid]; lbase[F.tid] = c ? atomicAdd(&cnt[F.tid], c) : 0u; lcnt[F.tid] = 0u; }
        __syncthreads();
#pragma unroll
        for (int ps = 0; ps < 2; ++ps) { const int e = F.tid & 31; if (e < 4) { const int row = it * 32 + ps * 16 + (F.tid >> 5);
                slot[(size_t)myexp[ps] * NTOK + lbase[myexp[ps]] + myrank[ps]] = row * 4 + e; } }
        __syncthreads();
    }
}

__device__ __forceinline__ void moe_build_tiles(const Frame& F, LAS int* tstart, LAS int* cntl, LAS int* tstartB) {
    if (F.tid == 0) { int acc = 0, accb = 0; for (int e = 0; e < NEXP; ++e) { const int c = (int)__hip_atomic_load(F.ctl + CW_CNT + e, __ATOMIC_RELAXED, __HIP_MEMORY_SCOPE_AGENT); const int rem = c & 255;
            cntl[e] = c; tstart[e] = acc; tstartB[e] = accb; acc += (c >> 8) + (rem > 128 ? 1 : 0); accb += (rem >= 1 && rem <= 128) ? 1 : 0; } tstart[NEXP] = acc; tstartB[NEXP] = accb; }
    if (F.tid < 64) { const int sh = amax_shift(__hip_atomic_load(F.ctl + CW_AMAX + F.tid, __ATOMIC_RELAXED, __HIP_MEMORY_SCOPE_AGENT)); const unsigned b_ = (unsigned)(127 - sh) & 0xffu;
        cntl[40 + F.tid] = (int)(b_ | (b_ << 8) | (b_ << 16) | (b_ << 24)); }
    __syncthreads();
}

__device__ __forceinline__ void p9_combine(const Frame& F, const Args& a) {
    unsigned char* ws = F.ws; const bf16_t* H1 = (const bf16_t*)(ws + WS_H1); const unsigned char* Y = ws + WS_Y;
    const float* tokw = (const float*)(ws + WS_TOKW); const float* gf = a.in[I_FNG]; float* out = a.out;
    int tz = threadIdx.x; asm volatile("" : "+v"(tz));
    const int lane_ = tz & 63;
    for (int row = F.bid * 8 + F.wid; row < NTOK; row += F.G * 8) {
        const bf16_t* hr = H1 + (size_t)row * DM; f32x4 v[8]; float ss = 0.f;
        const f32x4 w4 = *(const f32x4*)(tokw + (size_t)row * 4);
#pragma unroll
        for (int i = 0; i < 4; ++i) { const int c0 = i * 512 + lane_ * 8; { const u32x4 hw = *(const u32x4*)(hr + c0); float hf[8]; unpack8(hw, hf);
                v[2 * i] = (f32x4){hf[0], hf[1], hf[2], hf[3]}; v[2 * i + 1] = (f32x4){hf[4], hf[5], hf[6], hf[7]}; }
#pragma unroll
            for (int k = 0; k < 4; ++k) { const u32x2 yw = *(const u32x2*)(Y + ((size_t)row * 4 + k) * DM + c0); float f[8];
                { const f32x2 t0 = __builtin_amdgcn_cvt_pk_f32_fp8(yw[0], false), t1 = __builtin_amdgcn_cvt_pk_f32_fp8(yw[0], true), t2 = __builtin_amdgcn_cvt_pk_f32_fp8(yw[1], false), t3 = __builtin_amdgcn_cvt_pk_f32_fp8(yw[1], true);
                  f[0] = t0[0]; f[1] = t0[1]; f[2] = t1[0]; f[3] = t1[1]; f[4] = t2[0]; f[5] = t2[1]; f[6] = t3[0]; f[7] = t3[1]; }
#pragma unroll
                for (int j = 0; j < 4; ++j) { v[2 * i][j] += w4[k] * f[j]; v[2 * i + 1][j] += w4[k] * f[4 + j]; } }
#pragma unroll
            for (int j = 0; j < 4; ++j) ss += v[2 * i][j] * v[2 * i][j] + v[2 * i + 1][j] * v[2 * i + 1][j]; }
        ss = wave_sum(ss); const float rs = rsqrtf(ss * (1.f / DM) + EPS);
#pragma unroll
        for (int i = 0; i < 4; ++i) { const int c0 = i * 512 + lane_ * 8; const f32x4 g0 = *(const f32x4*)(gf + c0), g1 = *(const f32x4*)(gf + c0 + 4);
            *(f32x4*)(out + (size_t)row * DM + c0) = v[2 * i] * rs * g0; *(f32x4*)(out + (size_t)row * DM + c0 + 4) = v[2 * i + 1] * rs * g1; }
    }
}

#if DEBUG_CMP
__device__ __noinline__ void dbg_compare(unsigned char* ws, unsigned* ctl, LAS unsigned char* lds) {
    const int tid = threadIdx.x, lane = tid & 63, wid = tid >> 6;
    float mx = 0.f, md = 0.f; const bf16_t* r0 = (const bf16_t*)(ws + WS_KC); const bf16_t* r1 = (const bf16_t*)(ws + WS_Y);
    for (int i = tid; i < 2 * 16 * 128 * 128; i += NTHREADS) { const float x = bf2f(i < 262144 ? r0[i] : ((const bf16_t*)(ws + WS_VC))[i - 262144]); const float y = bf2f(i < 262144 ? r1[i] : ((const bf16_t*)(ws + WS_Y + 1048576))[i - 262144]);
        mx = fmaxf(mx, fabsf(x)); md = fmaxf(md, fabsf(x - y)); if (!(y == y)) md = 1e30f; }
    mx = wave_max(mx); md = wave_max(md); LAS float* t2 = (LAS float*)lds; if (lane == 0) { t2[wid] = mx; t2[8 + wid] = md; } __syncthreads();
    if (tid == 0) { float a1 = 0.f, a2 = 0.f; for (int i = 0; i < 8; ++i) { a1 = fmaxf(a1, t2[i]); a2 = fmaxf(a2, t2[8 + i]); }
        const float rel = a2 / fmaxf(a1, 1e-20f); int code = 0;
        if (rel >= 1.f) code = 10; else if (rel >= 0.3f) code = 11; else if (rel >= 0.1f) code = 12; else if (rel >= 0.03f) code = 13; else if (rel >= 0.01f) code = 14; else if (rel >= 0.003f) code = 15;
        if (blockIdx.x == 0) ctl[CW_ERR] = (unsigned)code; }
    __syncthreads();
}
#endif
constexpr int N_PHASES = 9;
extern "C" __global__ void __launch_bounds__(NTHREADS, 2) fwd(Args args) {
    extern __shared__ __attribute__((aligned(16))) unsigned char shm[];
    LAS unsigned char* lds = (LAS unsigned char*)shm;
    Frame F; F.lds = lds; F.ws = args.ws; F.ctl = (unsigned*)(args.ws + WS_CTL);
    F.tid = threadIdx.x; F.wid = __builtin_amdgcn_readfirstlane(F.tid >> 6); F.lane = F.tid & 63; F.G = gridDim.x; F.bid = blockIdx.x;
    LAS unsigned* misc = (LAS unsigned*)(lds + LDS_MISC);
    if (F.tid < 4) misc[F.tid] = 0u;
    __syncthreads();
    const int lo = args.ph_lo, hi = args.ph_hi;
    XcdBarrier bar; bar.bar = F.ctl; bar.x = 0; bar.st = nullptr;
    if (hi - lo > 1) bar = xcd_barrier_post(F.ctl, (volatile LAS unsigned*)misc);
#define IN(k) (lo <= (k) && (k) < hi)
#define SEAM(k) do { if (IN(k) && IN((k) + 1)) xcd_barrier(bar); } while (0)
    unsigned char* ws = args.ws;

    if (IN(0)) { p0_prologue(F, args); }
#if (REP_MASK >> 0) & 1
    if (IN(0)) { p0_prologue(F, args); }
#endif
    SEAM(0);
    if (IN(1)) {
        const int gi = F.bid >> 3, g8i = gi & 7; const bool split = (F.G == 256), conv = split && (g8i == 2 || g8i == 5 || g8i == 7);
        if (conv) { const int crank = ((gi >> 3) * 3 + (g8i == 2 ? 0 : (g8i == 5 ? 1 : 2))) * 8 + (F.bid & 7); conv_experts(F, args, CONV_P2 + crank, 96, 12288); bias1_partials(F, args, crank, 96); }
        else {
            const int grank = (gi >> 3) * 5 + (g8i < 2 ? g8i : (g8i < 5 ? g8i - 1 : 4));
            g8::DenseSched<DM, DM> S; S.init(ws + WS_U, ws + WS_WINT, NTOK, PROJ_LD, split ? 160 : F.G, split ? grank * 8 + (F.bid & 7) : F.bid);
            g8::EpiProj E{(bf16_t*)(ws + WS_PROJ), PROJ_LD, (bf16_t*)(ws + WS_OMF), (const float*)(ws + WS_LB)};
            g8::gemm_phase(lds, S, E);
            if (!split) { conv_experts(F, args, CONV_P2 + F.bid, F.G, 12288); bias1_partials(F, args, F.bid, F.G); }
            else { const int c = grank * 8 + (F.bid & 7);
                if (c >= 128) conv_experts(F, args, CONV_P0 + (c - 128), 32, CONV_P0 + CONV_SPARE); }
        }
    }
#if (REP_MASK >> 1) & 1
    if (IN(1)) {
        g8::DenseSched<DM, DM> S; S.init(ws + WS_U, ws + WS_WINT, NTOK, PROJ_LD, F.G, F.bid);
        g8::EpiProj E{(bf16_t*)(ws + WS_PROJ), PROJ_LD, (bf16_t*)(ws + WS_OMF), (const float*)(ws + WS_LB)};
        g8::gemm_phase(lds, S, E);
    }
#endif
    SEAM(1);
    if (IN(2) || IN(3)) {
        constexpr int CW_CDONE = 4800, CW_CONVQ = 4864;
        constexpr int CONV_QB = 8, CONV_QBASE = CONV_P0 + CONV_SPARE, CONV_NBATCH = (CONV_P2 - CONV_QBASE) / CONV_QB;
        static_assert((CONV_P2 - CONV_QBASE) % CONV_QB == 0, "conversion queue: whole batches");
        const bool big = (F.G == 256);
        if (big) {
            if (F.bid < 64) hgrn_fast_unit(F, args, F.bid);
            else if (F.bid < 192) { compress_fast_unit(F, args, F.bid - 64);
                asm volatile("s_waitcnt vmcnt(0)" ::: "memory"); __syncthreads();
                if (F.tid == 0) { __builtin_amdgcn_fence(__ATOMIC_RELEASE, "agent"); asm volatile("s_waitcnt vmcnt(0)" ::: "memory"); (void)xb_add(F.ctl + CW_CDONE, 1u); }
            }
            else {
                for (;;) { if (F.tid == 0) misc[9] = (xb_ld(F.ctl + CW_CDONE) >= 128u) ? 0xffffffffu : atomicAdd(F.ctl + CW_CONVQ, 1u);
                    __syncthreads();
                    const unsigned qi = misc[9];
                    if (qi >= (unsigned)CONV_NBATCH) break;
                    conv_experts(F, args, CONV_QBASE + (int)qi * CONV_QB, 1, CONV_QBASE + ((int)qi + 1) * CONV_QB); } }
        } else {
            for (int u = F.bid; u < 128; u += F.G) { compress_fast_unit(F, args, u); asm volatile("s_waitcnt vmcnt(0)" ::: "memory"); __syncthreads();
                if (F.tid == 0) { __builtin_amdgcn_fence(__ATOMIC_RELEASE, "agent"); asm volatile("s_waitcnt vmcnt(0)" ::: "memory"); (void)xb_add(F.ctl + CW_CDONE, 1u); } }
            conv_experts(F, args, CONV_P0 + F.bid, F.G, CONV_P2);
            if (F.bid < 64) hgrn_fast_unit(F, args, F.bid);
        }
        if (F.tid == 0) { XB_SPIN(xb_ld(F.ctl + CW_CDONE) < 128u, F.ctl); __builtin_amdgcn_fence(__ATOMIC_ACQUIRE, "agent"); asm volatile("s_waitcnt vmcnt(0)" ::: "memory"); }
        __syncthreads();
        for (;;) { if (F.tid == 0) misc[8] = atomicAdd(F.ctl + CW_QUEUE, 1u);
            __syncthreads();
            const int u = (int)misc[8];
            if (u >= BATCH * NSA_G * 32) break;
            attn_fast_unit(F, args, u); }
        if (big) for (;;) { if (F.tid == 0) misc[9] = atomicAdd(F.ctl + CW_CONVQ, 1u);
            __syncthreads();
            const unsigned qi = misc[9];
            if (qi >= (unsigned)CONV_NBATCH) break;
            conv_experts(F, args, CONV_QBASE + (int)qi * CONV_QB, 1, CONV_QBASE + ((int)qi + 1) * CONV_QB); }
    }
#if ((REP_MASK >> 2) & 1) || ((REP_MASK >> 3) & 1)
#error "phases 2 and 3 are merged: repetition not supported"
#endif
    SEAM(3);
    if (IN(4)) {
        g8::DenseSched<DM, DM> S; S.init(ws + WS_YMIX, ws + WS_WOUTT, NTOK, DM, F.G, F.bid);
        g8::EpiResBf16 E{(bf16_t*)(ws + WS_H1), args.in[I_X], DM};
        g8::gemm_phase(lds, S, E);
    }
#if (REP_MASK >> 4) & 1
    if (IN(4)) {
        g8::DenseSched<DM, DM> S; S.init(ws + WS_YMIX, ws + WS_WOUTT, NTOK, DM, F.G, F.bid);
        g8::EpiResBf16 E{(bf16_t*)(ws + WS_H1), args.in[I_X], DM};
        g8::gemm_phase(lds, S, E);
    }
#endif
    SEAM(4);
    if (IN(5)) { p5_router(F, args); }
#if (REP_MASK >> 5) & 1
    if (IN(5)) { p5_router(F, args); }
#endif
    SEAM(5);
    if (IN(6)) {
        LAS int* tstart = (LAS int*)(misc + 64); LAS int* cntl = tstart + 40; LAS int* tstartB = cntl + 104;
        moe_build_tiles(F, tstart, cntl, tstartB);
        g8::EpiGateUp E{(unsigned char*)(ws + WS_ACT), args.in[I_BGU]};
        { g8::MoeSched<16, 2, true, 0> S{(const char*)(ws + WS_U), (const char*)(ws + WS_WGUT), (const int*)(ws + WS_SLOT), args.in[I_BGU], tstart, cntl, F.G, F.bid}; g8::gemm_phase(lds, S, E); }
        { g8::MoeSched<16, 2, true, 1> S{(const char*)(ws + WS_U), (const char*)(ws + WS_WGUT), (const int*)(ws + WS_SLOT), args.in[I_BGU], tstartB, cntl, F.G, F.bid}; g8::gemm_phase(lds, S, E); }
    }
#if (REP_MASK >> 6) & 1
    if (IN(6)) {
        LAS int* tstart = (LAS int*)(misc + 64); LAS int* cntl = tstart + 40;
        moe_build_tiles(F, tstart, cntl);
        g8::MoeSched<16, 2, true> S{(const char*)(ws + WS_U), (const char*)(ws + WS_WGUT), (const int*)(ws + WS_SLOT), args.in[I_BGU], tstart, cntl, F.G, F.bid};
        g8::EpiGateUp E{(unsigned char*)(ws + WS_ACT), args.in[I_BGU]};
        g8::gemm_phase(lds, S, E);
    }
#endif
    SEAM(6);
    if (IN(7)) {
        LAS int* tstart = (LAS int*)(misc + 64); LAS int* cntl = tstart + 40; LAS int* tstartB = cntl + 104;
        moe_build_tiles(F, tstart, cntl, tstartB);
        g8::EpiDown E{ws + WS_Y, args.in[I_BD]};
        { g8::MoeSched<8, 0, false, 0> S{(const char*)(ws + WS_ACT), (const char*)(ws + WS_WDT), (const int*)(ws + WS_SLOT), args.in[I_BD], tstart, cntl, F.G, F.bid}; g8::gemm_phase(lds, S, E); }
        { g8::MoeSched<8, 0, false, 1> S{(const char*)(ws + WS_ACT), (const char*)(ws + WS_WDT), (const int*)(ws + WS_SLOT), args.in[I_BD], tstartB, cntl, F.G, F.bid}; g8::gemm_phase(lds, S, E); }
    }
#if (REP_MASK >> 7) & 1
    if (IN(7)) {
        LAS int* tstart = (LAS int*)(misc + 64); LAS int* cntl = tstart + 40;
        moe_build_tiles(F, tstart, cntl);
        g8::MoeSched<8, 0, false> S{(const char*)(ws + WS_ACT), (const char*)(ws + WS_WDT), (const int*)(ws + WS_SLOT), args.in[I_BD], tstart, cntl, F.G, F.bid};
        g8::EpiDown E{ws + WS_Y, args.in[I_BD]};
        g8::gemm_phase(lds, S, E);
    }
#endif
    SEAM(7);
    if (IN(8)) { p9_combine(F, args);
#if DEBUG_CMP
        { const unsigned code = __hip_atomic_load(F.ctl + CW_ERR, __ATOMIC_RELAXED, __HIP_MEMORY_SCOPE_AGENT);
          if (code) { const float cval = sqrtf((float)code); for (size_t i = (size_t)F.bid * NTHREADS + F.tid; i < (size_t)NTOK * DM; i += (size_t)F.G * NTHREADS) args.out[i] = cval; } }
#endif
    }
#if (REP_MASK >> 8) & 1
    if (IN(8)) { p9_combine(F, args);
#if DEBUG_CMP
        { const unsigned code = __hip_atomic_load(F.ctl + CW_ERR, __ATOMIC_RELAXED, __HIP_MEMORY_SCOPE_AGENT);
          if (code) { const float cval = sqrtf((float)code); for (size_t i = (size_t)F.bid * NTHREADS + F.tid; i < (size_t)NTOK * DM; i += (size_t)F.G * NTHREADS) args.out[i] = cval; } }
#endif
    }
#endif
#undef IN
#undef SEAM
}

extern "C" void kernel_launch(void* const* d_in, const int* in_sizes, int n_in, void* d_out, int out_size, void* d_ws, size_t ws_size, hipStream_t stream) {
    static int grid = 0;
    if (grid == 0) {
        if (n_in != 18 || ws_size < WS_END) { fprintf(stderr, "kernel_launch: n_in %d ws %zu (need %zu)\n", n_in, ws_size, (size_t)WS_END); grid = -1; return; }
        int dev = 0, cus = 0, per_cu = 0;
        if (hipGetDevice(&dev) != hipSuccess || hipDeviceGetAttribute(&cus, hipDeviceAttributeMultiprocessorCount, dev) != hipSuccess) { grid = -1; return; }
        if (hipFuncSetAttribute((const void*)fwd, hipFuncAttributeMaxDynamicSharedMemorySize, LDS_BYTES) != hipSuccess) { fprintf(stderr, "kernel_launch: hipFuncSetAttribute failed\n"); grid = -1; return; }
        if (hipOccupancyMaxActiveBlocksPerMultiprocessor(&per_cu, (const void*)fwd, NTHREADS, LDS_BYTES) != hipSuccess || per_cu < 1) { fprintf(stderr, "kernel_launch: occupancy query says %d\n", per_cu); }
        (void)hipGetLastError();
        grid = cus;
    }
    if (grid < 0) return;
    (void)hipMemsetAsync((char*)d_ws + WS_CTL, 0, CTL_BYTES, stream);
    Args a{};
    for (int i = 0; i < 18; ++i) a.in[i] = (const float*)d_in[i];
    a.out = (float*)d_out; a.ws = (unsigned char*)d_ws;
#if N_LAUNCH_PER_PHASE
    for (int p = 0; p < N_PHASES; ++p) { a.ph_lo = p; a.ph_hi = p + 1; hipLaunchKernelGGL(fwd, dim3(grid), dim3(NTHREADS), LDS_BYTES, stream, a); }
#else
    a.ph_lo = 0; a.ph_hi = N_PHASES; hipLaunchKernelGGL(fwd, dim3(grid), dim3(NTHREADS), LDS_BYTES, stream, a);
#endif
}
```

```cpp
#include <hip/hip_runtime.h>
#include <stdint.h>
#include <stdio.h>

#ifndef N_LAUNCH_PER_PHASE
#define N_LAUNCH_PER_PHASE 0
#endif

#define DEBUG_CMP 0
#ifndef REP_MASK
#define REP_MASK 0
#endif
#define LAS __attribute__((address_space(3)))
typedef unsigned short bf16_t;
typedef short bf16x8 __attribute__((ext_vector_type(8)));
typedef float f32x4 __attribute__((ext_vector_type(4)));
typedef float f32x2 __attribute__((ext_vector_type(2)));
typedef float f32x16 __attribute__((ext_vector_type(16)));
typedef unsigned u32x4 __attribute__((ext_vector_type(4)));
typedef unsigned u32x2 __attribute__((ext_vector_type(2)));
typedef int i32x8 __attribute__((ext_vector_type(8)));

constexpr int BATCH = 8, SEQ = 2048, NTOK = BATCH * SEQ, DM = 2048;
constexpr int HG_W = 1024, HG_H = 8, HG_DK = 128, HG_DV = 128;
constexpr int NSA_H = 8, NSA_G = 2, NSA_R = 4, HD = 128, KVW = 256;
constexpr int IN_COLS = 6680, PROJ_LD = 6912;
constexpr int C_HQ = 0, C_HF = 1024, C_HI = 2048, C_HGT = 3072, C_NQ = 4096, C_KCM = 5120, C_VCM = 5376, C_KSL = 5632, C_VSL = 5888, C_KWN = 6144, C_VWN = 6400, C_NGT = 6656;
constexpr int NCMP = 127, NSEL = 32, SEL_TOP = 16, WINDOW = 512;
constexpr int NEXP = 32, TOPK = 4, DFF = 2048, NASG = NTOK * TOPK;
constexpr float EPS = 1e-6f;
constexpr int NTHREADS = 512;
constexpr int CONV_SPARE = 256;
constexpr int CONV_P0 = 0, CONV_P2 = 2048;

constexpr size_t al256(size_t x) { return (x + 255) & ~(size_t)255; }
constexpr size_t WS_CTL = 0, CTL_BYTES = 65536;
constexpr size_t WS_WINT = WS_CTL + CTL_BYTES;
constexpr size_t WS_WOUTT = WS_WINT + (size_t)PROJ_LD * DM * 2;
constexpr size_t WS_WGUT = WS_WOUTT + (size_t)DM * DM * 2;
constexpr size_t WS_WDT = WS_WGUT + (size_t)NEXP * 2 * DFF * DM * 2;
constexpr size_t WS_W1T = WS_WDT + (size_t)NEXP * DM * DFF * 2;
constexpr size_t WS_W2T = WS_W1T + (size_t)2 * 128 * 4096 * 2;
constexpr size_t WS_BIAS1 = WS_W2T + (size_t)2 * 128 * 128 * 2;
constexpr size_t WS_WR2 = WS_BIAS1 + 1024;
constexpr size_t WS_LB = WS_WR2 + (size_t)DM * NEXP * 4;
constexpr size_t WS_U = WS_LB + 4096;
constexpr size_t WS_PROJ = WS_U + (size_t)NTOK * DM * 2;
constexpr size_t WS_KC = WS_PROJ + (size_t)(NTOK + 64) * PROJ_LD * 2;
constexpr size_t WS_VC = WS_KC + (size_t)16 * 128 * 128 * 2;
constexpr size_t WS_YMIX = WS_VC + (size_t)16 * 128 * 128 * 2;
constexpr size_t WS_H1 = WS_YMIX + (size_t)NTOK * DM * 2;
constexpr size_t WS_TOKW = WS_H1 + (size_t)NTOK * DM * 4;
constexpr size_t WS_SLOT = WS_TOKW + (size_t)NTOK * 4 * 4;
constexpr size_t WS_ACT = WS_SLOT + (size_t)NEXP * NTOK * 4;
constexpr size_t WS_Y = WS_ACT + (size_t)NASG * DFF * 2;
constexpr size_t WS_OT = WS_Y + (size_t)NASG * DM * 2;
constexpr size_t WS_OMF = WS_OT + (size_t)256 * 64 * 512 * 4;
constexpr size_t WS_B1P = WS_OMF + (size_t)NTOK * HG_W * 2;
constexpr size_t WS_END = WS_B1P + (size_t)2 * 32 * 128 * 4;
constexpr int CW_CNT = 4096, CW_QUEUE = 4160, CW_ERR = 4224, CW_AMAX = 4544;

__device__ __forceinline__ float bf2f(bf16_t b) { return __uint_as_float(((unsigned)b) << 16); }
typedef __bf16 bf16v2_t __attribute__((ext_vector_type(2)));
__device__ __forceinline__ unsigned cvt_pk_bf16(float lo, float hi) { f32x2 v = {lo, hi}; bf16v2_t r = __builtin_convertvector(v, bf16v2_t); return __builtin_bit_cast(unsigned, r); }
__device__ __forceinline__ unsigned cvt4_fp8(float a, float b, float c, float d) { unsigned w = 0u; w = __builtin_amdgcn_cvt_pk_fp8_f32(a, b, w, false); w = __builtin_amdgcn_cvt_pk_fp8_f32(c, d, w, true); return w; }
__device__ __forceinline__ unsigned cvt4_bf8(float a, float b, float c, float d) { unsigned w = 0u; w = __builtin_amdgcn_cvt_pk_bf8_f32(a, b, w, false); w = __builtin_amdgcn_cvt_pk_bf8_f32(c, d, w, true); return w; }
__device__ __forceinline__ int amax_shift(unsigned bits) { if (bits == 0u) return 0; int s_ = 5 - ((int)(bits >> 23) - 127); return s_ < -60 ? -60 : (s_ > 60 ? 60 : s_); }
__device__ __forceinline__ float shift_mult(int s_) { return __uint_as_float((unsigned)(s_ + 127) << 23); }
__device__ __forceinline__ unsigned cvt4_fp8s(float a, float b, float c, float d, float m) {
    return cvt4_fp8(__builtin_amdgcn_fmed3f(a * m, -448.f, 448.f), __builtin_amdgcn_fmed3f(b * m, -448.f, 448.f), __builtin_amdgcn_fmed3f(c * m, -448.f, 448.f), __builtin_amdgcn_fmed3f(d * m, -448.f, 448.f)); }
__device__ __forceinline__ bf16_t f2bf(float f) { return (bf16_t)(cvt_pk_bf16(f, 0.f) & 0xffffu); }
__device__ __forceinline__ float sigmoidf_(float x) { return 1.f / (1.f + __expf(-x)); }
__device__ __forceinline__ float siluf_(float x) { return x * sigmoidf_(x); }
__device__ __forceinline__ float wave_sum(float v) {
#pragma unroll
    for (int o = 32; o > 0; o >>= 1) v += __shfl_xor(v, o);
    return v;
}
__device__ __forceinline__ float wave_max(float v) {
#pragma unroll
    for (int o = 32; o > 0; o >>= 1) v = fmaxf(v, __shfl_xor(v, o));
    return v;
}
__device__ __forceinline__ void unpack8(const u32x4 w, float (&f)[8]) {
#pragma unroll
    for (int i = 0; i < 4; ++i) { f[2 * i] = __uint_as_float(w[i] << 16); f[2 * i + 1] = __uint_as_float(w[i] & 0xffff0000u); }
}

#define XB_TMO      128
#define XB_XCNT(j)  (256  + 64 * (j))
#define XB_XSUB(j)  (1280 + 64 * (j))
#define XB_XGEN(j)  (2304 + 64 * (j))
#define XB_TOP      3328
#define XB_TOPGEN   3392
#define XCD_BAR_WORDS 3456
#define XB_SPIN_CAP (1u << 18)
__device__ __forceinline__ unsigned xb_ld(unsigned* p)              { return __hip_atomic_load(p, __ATOMIC_RELAXED, __HIP_MEMORY_SCOPE_AGENT); }
__device__ __forceinline__ unsigned xb_add(unsigned* p, unsigned v) { return __hip_atomic_fetch_add(p, v, __ATOMIC_RELAXED, __HIP_MEMORY_SCOPE_AGENT); }
__device__ __forceinline__ unsigned xb_xcc_id() { return (unsigned)__builtin_amdgcn_s_getreg((3 << 11) | 20) & 0xFu; }
#define XB_SPIN(cond, bar) do { unsigned _sp = 0; while (cond) { __builtin_amdgcn_s_sleep(1); \
    if ((++_sp & 255u) == 0u) { if (xb_ld(&(bar)[XB_TMO])) break; if (_sp > XB_SPIN_CAP) { atomicAdd(&(bar)[XB_TMO], 1u); break; } } } } while (0)
struct XcdBarrier { unsigned* bar; unsigned x; volatile LAS unsigned* st; };
__device__ __forceinline__ XcdBarrier xcd_barrier_post(unsigned* bar, volatile LAS unsigned* st) {
    XcdBarrier b; b.bar = bar; b.x = xb_xcc_id(); b.st = st;
    if (threadIdx.x == 0) (void)xb_add(&bar[XB_XCNT(b.x)], 1u);
    return b;
}
__device__ __forceinline__ void xcd_barrier_complete(unsigned* bar, unsigned x, unsigned& nloc, unsigned& nx) {
    const unsigned G = gridDim.x * gridDim.y * gridDim.z;
    unsigned sum, cnt, mine, sp = 0u;
    for (;;) {
        sum = 0u; cnt = 0u; mine = 0u;
#pragma unroll
        for (unsigned j = 0; j < 16; ++j) { const unsigned c = xb_ld(&bar[XB_XCNT(j)]); sum += c; cnt += (c > 0u) ? 1u : 0u; mine = (j == x) ? c : mine; }
        if (sum == G) break;
        __builtin_amdgcn_s_sleep(1);
        if ((++sp & 255u) == 0u) { if (xb_ld(&bar[XB_TMO])) break; if (sp > XB_SPIN_CAP) { atomicAdd(&bar[XB_TMO], 1u); break; } }
    }
    nloc = mine > 0u ? mine : 1u; nx = cnt > 0u ? cnt : 1u;
}
__device__ __forceinline__ void xcd_barrier(const XcdBarrier& b) {
    asm volatile("s_waitcnt vmcnt(0)" ::: "memory");
    __syncthreads();
    if (threadIdx.x == 0) {
        unsigned* bar = b.bar;
        __builtin_amdgcn_s_waitcnt(0);
        unsigned nloc = b.st[0], nx = b.st[1];
        if (nloc == 0u) { xcd_barrier_complete(bar, b.x, nloc, nx); b.st[0] = nloc; b.st[1] = nx; }
        const unsigned old = xb_add(&bar[XB_XSUB(b.x)], 1u);
        const unsigned gen = old / nloc;
        if (old + 1u == (gen + 1u) * nloc) {
            __builtin_amdgcn_fence(__ATOMIC_RELEASE, "agent");
            asm volatile("s_waitcnt vmcnt(0)" ::: "memory");
            const unsigned og = xb_add(&bar[XB_TOP], 1u);
            const unsigned tg = og / nx;
            if (og + 1u == (tg + 1u) * nx) xb_add(&bar[XB_TOPGEN], 1u);
            else XB_SPIN(xb_ld(&bar[XB_TOPGEN]) == tg, bar);
            __builtin_amdgcn_fence(__ATOMIC_ACQUIRE, "agent");
            xb_add(&bar[XB_XGEN(b.x)], 1u);
            asm volatile("s_waitcnt vmcnt(0)" ::: "memory");
        } else {
            XB_SPIN(xb_ld(&bar[XB_XGEN(b.x)]) == gen, bar);
            __builtin_amdgcn_fence(__ATOMIC_ACQUIRE, "agent");
            asm volatile("s_waitcnt vmcnt(0)" ::: "memory");
        }
    }
    __syncthreads();
}

namespace g8 {
constexpr int BM = 256, BK = 64, HALF = 128, HTB = HALF * BK * 2, STAGE_BYTES = 8 * HTB, NXCD = 8;
__host__ __device__ __forceinline__ int lds_byte(int r, int c) { const int st = (r >> 4) * 2 + (c >> 5), rr = r & 15, cc = c & 31, ob = rr * 64 + cc * 2; return st * 1024 + (ob ^ (((ob >> 9) & 1) << 5)); }
__host__ __device__ __forceinline__ void stage_rc(int b, int& R, int& C) { const int st = b / 1024, sb = b % 1024, swz = sb ^ (((sb >> 9) & 1) << 5); R = (st >> 1) * 16 + swz / 64; C = (st & 1) * 32 + (swz % 64) / 2; }
__host__ __device__ __forceinline__ int perm32(int rho) { const int n = rho >> 4, i = rho & 15; return 8 * (i >> 2) + 4 * n + (i & 3); }

struct Unit { const char* A; const char* B0; const char* B1; const int* rows; const float* bias0; const float* bias1; int nvalid; int m0, n0, e; int wscale; };

template <class Sched>
__device__ __forceinline__ void a_offsets(const Unit& u, const int (&R)[2], const int (&C)[2], unsigned (&vo)[2][2]) {
#pragma unroll
    for (int h = 0; h < 2; ++h)
#pragma unroll
        for (int i = 0; i < 2; ++i) {
            if constexpr (Sched::GATHER) {
                const int r = h * HALF + R[i];
                const int idx = u.rows[r < u.nvalid ? r : 0] >> Sched::SHIFT;
                vo[h][i] = (unsigned)idx * (unsigned)(Sched::LDA * Sched::ESZ) + (unsigned)C[i] * 2u;
            } else {
                vo[h][i] = (unsigned)(h * HALF + R[i]) * (unsigned)(Sched::LDA * Sched::ESZ) + (unsigned)C[i] * 2u;
            }
        }
}

__device__ __forceinline__ const char* uni_ptr(const char* p) { const unsigned long long v = (unsigned long long)p;
    const unsigned lo = (unsigned)__builtin_amdgcn_readfirstlane((int)(unsigned)v), hi = (unsigned)__builtin_amdgcn_readfirstlane((int)(unsigned)(v >> 32));
    return (const char*)(((unsigned long long)hi << 32) | lo); }
template <class Sched, class Epi>
__device__ __forceinline__ void gemm_phase(LAS unsigned char* lds, const Sched& S, const Epi& E) {
    const int tid = threadIdx.x, wid = __builtin_amdgcn_readfirstlane(tid >> 6), lane = tid & 63, wr = wid >> 2, wc = wid & 3, fr = lane & 15, fq = lane >> 4;
    constexpr int K = Sched::K, nt = K * Sched::ESZ / (BK * 2);
    int Rr[2], Cc[2]; unsigned voffB[2];
#pragma unroll
    for (int i = 0; i < 2; ++i) { stage_rc(tid * 16 + i * 8192, Rr[i], Cc[i]); const int Rb = Epi::PERM ? ((Rr[i] & ~31) + perm32(Rr[i] & 31)) : Rr[i];
        voffB[i] = (unsigned)Rb * (unsigned)(K * Sched::ESZ) + (unsigned)Cc[i] * 2u; }
    const size_t kstep = (size_t)(BK * 2);
    const unsigned ldsw = (unsigned)wid * 1024u;
    const int aoff = lds_byte(wr * 64 + fr, fq * 8), boff = lds_byte(wc * 32 + fr, fq * 8);
#define G8_SA(b, h) (((b) * 2 + (h)) * HTB)
#define G8_SB(b, h) ((4 + (b) * 2 + (h)) * HTB)
#define G8_STAGE(bufoff, gbase, voff) do { _Pragma("unroll") for (int _i = 0; _i < 2; ++_i) \
        __builtin_amdgcn_global_load_lds((const unsigned*)((const char*)(gbase) + (voff)[_i]), (LAS unsigned*)(lds + (bufoff) + ldsw + _i * 8192), 16, 0, 0); } while (0)
#define G8_LDA(dst, b, h) do { if constexpr (Sched::MV != 0 && (h) == 1) break; _Pragma("unroll") for (int m = 0; m < 4; ++m) _Pragma("unroll") for (int k = 0; k < 2; ++k) dst[m][k] = *(const LAS bf16x8*)(lds + G8_SA(b, h) + aoff + m * 2048 + k * 1024); } while (0)
#define G8_LDB(dst, b, h) do { _Pragma("unroll") for (int n = 0; n < 2; ++n) _Pragma("unroll") for (int k = 0; k < 2; ++k) dst[n][k] = *(const LAS bf16x8*)(lds + G8_SB(b, h) + boff + n * 2048 + k * 1024); } while (0)
#define G8_MMA(ai, bj, At, Bt) do { if constexpr (Sched::MV != 0 && (ai) == 1) break; __builtin_amdgcn_s_setprio(1); _Pragma("unroll") for (int m = 0; m < 4; ++m) _Pragma("unroll") for (int n = 0; n < 2; ++n) { \
        if constexpr (Sched::ESZ == 2) { _Pragma("unroll") for (int k = 0; k < 2; ++k) acc[ai][bj][m][n] = __builtin_amdgcn_mfma_f32_16x16x32_bf16(Bt[n][k], At[m][k], acc[ai][bj][m][n], 0, 0, 0); } \
        else { const u32x4 b0_ = __builtin_bit_cast(u32x4, Bt[n][0]), b1_ = __builtin_bit_cast(u32x4, Bt[n][1]), a0_ = __builtin_bit_cast(u32x4, At[m][0]), a1_ = __builtin_bit_cast(u32x4, At[m][1]); \
            const i32x8 bw_ = {(int)b0_[0], (int)b0_[1], (int)b0_[2], (int)b0_[3], (int)b1_[0], (int)b1_[1], (int)b1_[2], (int)b1_[3]}; \
            const i32x8 aw_ = {(int)a0_[0], (int)a0_[1], (int)a0_[2], (int)a0_[3], (int)a1_[0], (int)a1_[1], (int)a1_[2], (int)a1_[3]}; \
            acc[ai][bj][m][n] = __builtin_amdgcn_mfma_scale_f32_16x16x128_f8f6f4(bw_, aw_, acc[ai][bj][m][n], Sched::FMT_W, Sched::FMT_A, 0, wsc_cur, 0, 0x7f7f7f7f); } } \
        __builtin_amdgcn_s_setprio(0); } while (0)
#define G8_WAIT_V(n) asm volatile("s_waitcnt vmcnt(" #n ")" ::: "memory")
#define G8_WAIT_L(n) asm volatile("s_waitcnt lgkmcnt(" #n ")" ::: "memory")
#define G8_BAR __builtin_amdgcn_s_barrier()
#define G8_SCHED __builtin_amdgcn_sched_barrier(0)
    Unit cur, nxt; int ui = 0;
    if (!S.next(0, cur)) return;
    f32x4 acc[2][2][4][2];
#pragma unroll
    for (int a = 0; a < 2; ++a)
#pragma unroll
        for (int b = 0; b < 2; ++b)
#pragma unroll
            for (int m = 0; m < 4; ++m)
#pragma unroll
                for (int n = 0; n < 2; ++n) acc[a][b][m][n] = (f32x4){0.f, 0.f, 0.f, 0.f};
    bf16x8 At[4][2], B0[2][2], B1[2][2];
    unsigned voffA[2][2], nvoffA[2][2];
    LAS unsigned char* auxb = lds + STAGE_BYTES; int par_cur = 0, par_nxt = 1;
#define G8_AUX_ISSUE(U, PAR) do { if (wid < 4) { const int r_ = wid * 64 + lane; __builtin_amdgcn_global_load_lds((const unsigned*)((U).rows + (r_ < (U).nvalid ? r_ : 0)), (LAS unsigned*)(auxb + (PAR) * 2048 + wid * 256), 4, 0, 0); } \
        else { const float* b_ = (wid < 6 ? (U).bias0 + (wid - 4) * 64 : (U).bias1 + (wid - 6) * 64) + lane; __builtin_amdgcn_global_load_lds((const unsigned*)b_, (LAS unsigned*)(auxb + (PAR) * 2048 + 1024 + (wid - 4) * 256), 4, 0, 0); } } while (0)
#define G8_AUX_OFFS(PAR) do { _Pragma("unroll") for (int h = 0; h < 2; ++h) _Pragma("unroll") for (int i = 0; i < 2; ++i) { \
        const int idx_ = *(const LAS int*)(auxb + (PAR) * 2048 + (h * HALF + Rr[i]) * 4) >> Sched::SHIFT; voffA[h][i] = (unsigned)idx_ * (unsigned)(Sched::LDA * Sched::ESZ) + (unsigned)Cc[i] * 2u; } } while (0)
    if constexpr (Sched::LDSAUX) { G8_AUX_ISSUE(cur, 0); G8_WAIT_V(0); __syncthreads(); G8_AUX_OFFS(0); }
    else a_offsets<Sched>(cur, Rr, Cc, voffA);
    const char* cA = cur.A; const char* cB0 = cur.B0; const char* cB1 = cur.B1;
    int wsc_cur = cur.wscale;
    G8_STAGE(G8_SB(0, 0), cB0, voffB); G8_STAGE(G8_SA(0, 0), cA, voffA[0]); G8_STAGE(G8_SB(0, 1), cB1, voffB); G8_STAGE(G8_SA(0, 1), cA, voffA[1]);
    if (wr == 1) G8_BAR;
    G8_WAIT_V(4); G8_BAR;
    G8_STAGE(G8_SB(1, 0), cB0 + kstep, voffB); G8_STAGE(G8_SA(1, 0), cA + kstep, voffA[0]); G8_STAGE(G8_SB(1, 1), cB1 + kstep, voffB);
    G8_WAIT_V(6); G8_BAR;
    for (;;) {
        const bool has_next = S.next(ui + 1, nxt);
        const char* nA = has_next ? nxt.A : cA; const char* nB0 = has_next ? nxt.B0 : cB0; const char* nB1 = has_next ? nxt.B1 : cB1;
        if constexpr (Sched::LDSAUX) { if (has_next) G8_AUX_ISSUE(nxt, par_nxt); }
        else if constexpr (Sched::GATHER) {
            if (has_next) a_offsets<Sched>(nxt, Rr, Cc, nvoffA);
            else {
#pragma unroll
                for (int h = 0; h < 2; ++h)
#pragma unroll
                    for (int i = 0; i < 2; ++i) nvoffA[h][i] = voffA[h][i];
            }
        }
        for (int t = 0; t < nt; t += 2) {
            const bool last = (t == nt - 2);
            const char* a1 = cA + (size_t)(t + 1) * kstep;
            const char* a2 = last ? nA : cA + (size_t)(t + 2) * kstep;
            const char* b20 = last ? nB0 : cB0 + (size_t)(t + 2) * kstep; const char* b21 = last ? nB1 : cB1 + (size_t)(t + 2) * kstep;
            const char* a3 = a2 + kstep; const char* b30 = b20 + kstep; const char* b31 = b21 + kstep;
            G8_LDB(B0, 0, 0); G8_SCHED; G8_LDA(At, 0, 0); G8_STAGE(G8_SA(1, 1), a1, voffA[1]);
            G8_WAIT_L(8); G8_BAR; G8_WAIT_L(0); G8_MMA(0, 0, At, B0); G8_BAR; G8_SCHED;
            if constexpr (Sched::LDSAUX) { if (last && has_next) G8_AUX_OFFS(par_nxt); }
            else if constexpr (Sched::GATHER) { if (last) {
#pragma unroll
                for (int h = 0; h < 2; ++h)
#pragma unroll
                    for (int i = 0; i < 2; ++i) voffA[h][i] = nvoffA[h][i]; } }
            G8_LDB(B1, 0, 1); G8_STAGE(G8_SB(0, 0), b20, voffB);
            G8_BAR; G8_WAIT_L(0); G8_MMA(0, 1, At, B1); G8_BAR;
            G8_LDA(At, 0, 1); G8_STAGE(G8_SA(0, 0), a2, voffA[0]);
            G8_BAR; G8_WAIT_L(0); G8_MMA(1, 0, At, B0); G8_BAR; G8_SCHED;
            G8_STAGE(G8_SB(0, 1), b21, voffB);
            G8_WAIT_V(6); G8_BAR; G8_MMA(1, 1, At, B1); G8_BAR;
            G8_LDB(B0, 1, 0); G8_SCHED; G8_LDA(At, 1, 0); G8_STAGE(G8_SA(0, 1), a2, voffA[1]);
            G8_WAIT_L(8); G8_BAR; G8_WAIT_L(0); G8_MMA(0, 0, At, B0); G8_BAR; G8_SCHED;
            G8_LDB(B1, 1, 1); G8_STAGE(G8_SB(1, 0), b30, voffB);
            G8_BAR; G8_WAIT_L(0); G8_MMA(0, 1, At, B1); G8_BAR;
            G8_LDA(At, 1, 1); G8_STAGE(G8_SA(1, 0), a3, voffA[0]);
            G8_BAR; G8_WAIT_L(0); G8_MMA(1, 0, At, B0); G8_BAR; G8_SCHED;
            G8_STAGE(G8_SB(1, 1), b31, voffB);
            G8_WAIT_V(6); G8_BAR; G8_MMA(1, 1, At, B1); G8_BAR;
        }
        E.template run<(Sched::MV != 0 ? 1 : 2)>(acc, cur, wr, wc, fr, fq, (const LAS int*)(auxb + par_cur * 2048), (const LAS float*)(auxb + par_cur * 2048 + 1024));
        if (!has_next) break;
#pragma unroll
        for (int a = 0; a < 2; ++a)
#pragma unroll
            for (int b = 0; b < 2; ++b)
#pragma unroll
                for (int m = 0; m < 4; ++m)
#pragma unroll
                    for (int n = 0; n < 2; ++n) acc[a][b][m][n] = (f32x4){0.f, 0.f, 0.f, 0.f};
        cur = nxt; cA = nA; cB0 = nB0; cB1 = nB1; ++ui; wsc_cur = cur.wscale; par_cur = par_nxt; par_nxt = par_nxt == 2 ? 0 : par_nxt + 1;
    }
    G8_WAIT_V(0);
    if (wr == 0) G8_BAR;
    G8_BAR;
#undef G8_AUX_ISSUE
#undef G8_AUX_OFFS
#undef G8_SA
#undef G8_SB
#undef G8_STAGE
#undef G8_LDA
#undef G8_LDB
#undef G8_MMA
#undef G8_WAIT_V
#undef G8_WAIT_L
#undef G8_BAR
#undef G8_SCHED
}

template <int K_, int LDA_>
struct DenseSched {
    static constexpr int K = K_, LDA = LDA_, SHIFT = 0, ESZ = 2, FMT_W = 0, FMT_A = 0, MV = 0; static constexpr bool GATHER = false, LDSAUX = false;
    const char* A; const char* Bt; int nM, nN, nwg, G, c;
    __device__ void init(const void* A_, const void* Bt_, int M, int N, int G_, int c_) { A = (const char*)A_; Bt = (const char*)Bt_; nM = M / BM; nN = N / BM; nwg = nM * nN; G = G_; c = c_; }
    __device__ __forceinline__ bool next(int i, Unit& u) const {
        const long L = (long)i * G + c; if (L >= nwg) return false;
        int wgid = (int)L; { const int q = nwg / NXCD, r = nwg % NXCD, xcd = wgid % NXCD, off = wgid / NXCD; wgid = (xcd < r ? xcd * (q + 1) : r * (q + 1) + (xcd - r) * q) + off; }
        constexpr int WGM = 8;
        const int nig = WGM * nN, gid = wgid / nig, fm = gid * WGM, gsz = (nM - fm) < WGM ? (nM - fm) : WGM;
        const int pm = fm + ((wgid % nig) % gsz), pn = (wgid % nig) / gsz;
        u.A = A + (size_t)pm * BM * LDA * 2; u.B0 = Bt + (size_t)pn * BM * K * 2; u.B1 = u.B0 + (size_t)HALF * K * 2;
        u.rows = nullptr; u.bias0 = nullptr; u.bias1 = nullptr; u.wscale = 0x7f7f7f7f; u.nvalid = BM; u.m0 = pm * BM; u.n0 = pn * BM; u.e = 0; return true;
    }
};

template <int NPN  , int SHIFT_, bool GU, int MV_ = 0>
struct MoeSched {
    static constexpr int K = 2048, LDA = 2048, SHIFT = SHIFT_, ESZ = 1, MV = MV_, FMT_W = 0  , FMT_A = 0  ; static constexpr bool GATHER = true, LDSAUX = true;
    const char* A; const char* Bt; const int* slot; const float* bias; const LAS int* tstart; const LAS int* cnt; int G, c;
    __device__ __forceinline__ bool next(int i, Unit& u) const {
        const int ntile = tstart[NEXP]; const int nwg = ntile * NPN;
        const long L = (long)i * G + c; if (L >= nwg) return false;
        int wgid = (int)L; { const int q = nwg / NXCD, r = nwg % NXCD, xcd = wgid % NXCD, off = wgid / NXCD; wgid = (xcd < r ? xcd * (q + 1) : r * (q + 1) + (xcd - r) * q) + off; }
        int e = 0;
        for (int s = 16; s > 0; s >>= 1) if (tstart[e + s] * NPN <= wgid) e += s;
        const int mt = tstart[e + 1] - tstart[e], w = wgid - tstart[e] * NPN, pn = MV ? w : w / mt, m = MV ? (cnt[e] >> 8) : w % mt;
        u.A = A; u.e = e; u.m0 = m * BM; u.n0 = pn; u.wscale = cnt[40 + (GU ? 0 : 32) + e]; u.rows = slot + (size_t)e * NTOK + m * BM;
        const int left = cnt[e] - m * BM; u.nvalid = left < BM ? left : BM;
        if (GU) { u.B0 = Bt + ((size_t)e * 4096 + (size_t)pn * HALF) * K * ESZ; u.B1 = u.B0 + (size_t)2048 * K * ESZ; u.bias0 = bias + (size_t)e * 4096 + pn * HALF; u.bias1 = u.bias0 + 2048; }
        else { u.B0 = Bt + ((size_t)e * 2048 + (size_t)pn * BM) * K * ESZ; u.B1 = u.B0 + (size_t)HALF * K * ESZ; u.bias0 = bias + (size_t)e * 2048 + pn * BM; u.bias1 = u.bias0 + HALF; }
        return true;
    }
};

struct EpiBf16 {
    static constexpr bool PERM = true;
    bf16_t* O; int ldc;
    template <int NAI> __device__ __forceinline__ void run(const f32x4 (&acc)[2][2][4][2], const Unit& u, int wr, int wc, int fr, int fq, const LAS int* lrows, const LAS float* lbias) const {
        const int row0 = u.m0 + wr * 64 + fr, col0 = u.n0 + wc * 32 + 8 * fq;
#pragma unroll
        for (int ai = 0; ai < NAI; ++ai)
#pragma unroll
            for (int m = 0; m < 4; ++m) { bf16_t* rowp = O + (size_t)(row0 + ai * HALF + m * 16) * ldc + col0;
#pragma unroll
                for (int bj = 0; bj < 2; ++bj) { const f32x4 v0 = acc[ai][bj][m][0], v1 = acc[ai][bj][m][1];
                    u32x4 w; w[0] = cvt_pk_bf16(v0[0], v0[1]); w[1] = cvt_pk_bf16(v0[2], v0[3]); w[2] = cvt_pk_bf16(v1[0], v1[1]); w[3] = cvt_pk_bf16(v1[2], v1[3]);
                    *(u32x4*)(rowp + bj * HALF) = w; } }
    }
};
struct EpiProj {
    static constexpr bool PERM = true;
    bf16_t* O; int ldc; bf16_t* OMF; const float* lb;
    template <int NAI> __device__ __forceinline__ void run(const f32x4 (&acc)[2][2][4][2], const Unit& u, int wr, int wc, int fr, int fq, const LAS int* lrows, const LAS float* lbias) const {
        const int row0 = u.m0 + wr * 64 + fr, col0 = u.n0 + wc * 32 + 8 * fq;
        const int mode = (u.n0 < 1024 || (u.n0 >= 3072 && u.n0 < 4096)) ? 1 : ((u.n0 >= 1024 && u.n0 < 2048) ? 2 : 0);
        f32x4 lbv[2][2];
        if (mode == 2) {
#pragma unroll
            for (int bj = 0; bj < 2; ++bj) { lbv[bj][0] = *(const f32x4*)(lb + col0 - 1024 + bj * HALF); lbv[bj][1] = *(const f32x4*)(lb + col0 - 1024 + bj * HALF + 4); } }
#pragma unroll
        for (int ai = 0; ai < NAI; ++ai)
#pragma unroll
            for (int m = 0; m < 4; ++m) { const size_t rowi = (size_t)(row0 + ai * HALF + m * 16); bf16_t* rowp = O + rowi * ldc + col0;
#pragma unroll
                for (int bj = 0; bj < 2; ++bj) { f32x4 v0 = acc[ai][bj][m][0], v1 = acc[ai][bj][m][1];
                    f32x4 o0 = {0.f, 0.f, 0.f, 0.f}, o1 = o0;
                    if (mode != 0) {
                        f32x4 e0 = v0 * (-1.4426950408889634f), e1 = v1 * (-1.4426950408889634f);
#pragma unroll
                        for (int j = 0; j < 4; ++j) { e0[j] = __builtin_amdgcn_exp2f(e0[j]); e1[j] = __builtin_amdgcn_exp2f(e1[j]); }
                        e0 = e0 + 1.f; e1 = e1 + 1.f;
#pragma unroll
                        for (int j = 0; j < 4; ++j) { e0[j] = __builtin_amdgcn_rcpf(e0[j]); e1[j] = __builtin_amdgcn_rcpf(e1[j]); }
                        if (mode == 1) { v0 = v0 * e0; v1 = v1 * e1; }
                        else { const f32x4 f0 = lbv[bj][0] + (1.f - lbv[bj][0]) * e0, f1 = lbv[bj][1] + (1.f - lbv[bj][1]) * e1;
#pragma unroll
                            for (int j = 0; j < 4; ++j) { v0[j] = __builtin_amdgcn_logf(f0[j]); v1[j] = __builtin_amdgcn_logf(f1[j]); }
                            o0 = 1.f - f0; o1 = 1.f - f1; } }
                    if (mode == 2) {
                        u32x4 w2; w2[0] = cvt_pk_bf16(o0[0], o0[1]); w2[1] = cvt_pk_bf16(o0[2], o0[3]); w2[2] = cvt_pk_bf16(o1[0], o1[1]); w2[3] = cvt_pk_bf16(o1[2], o1[3]);
                        *(u32x4*)(OMF + rowi * HG_W + (col0 - 1024) + bj * HALF) = w2; }
                    u32x4 w; w[0] = cvt_pk_bf16(v0[0], v0[1]); w[1] = cvt_pk_bf16(v0[2], v0[3]); w[2] = cvt_pk_bf16(v1[0], v1[1]); w[3] = cvt_pk_bf16(v1[2], v1[3]);
                    *(u32x4*)(rowp + bj * HALF) = w; } }
    }
};
struct EpiResF32 {
    static constexpr bool PERM = false;
    float* C; const float* res; int ldc;
    template <int NAI> __device__ __forceinline__ void run(const f32x4 (&acc)[2][2][4][2], const Unit& u, int wr, int wc, int fr, int fq, const LAS int* lrows, const LAS float* lbias) const {
        const int row0 = u.m0 + wr * 64 + fr, col0 = u.n0 + wc * 32 + 4 * fq;
#pragma unroll
        for (int ai = 0; ai < NAI; ++ai)
#pragma unroll
            for (int m = 0; m < 4; ++m) { const size_t off = (size_t)(row0 + ai * HALF + m * 16) * ldc + col0;
#pragma unroll
                for (int bj = 0; bj < 2; ++bj)
#pragma unroll
                    for (int n = 0; n < 2; ++n) { const f32x4 r = *(const f32x4*)(res + off + bj * HALF + n * 16); *(f32x4*)(C + off + bj * HALF + n * 16) = acc[ai][bj][m][n] + r; } }
    }
};
struct EpiResBf16 {
    static constexpr bool PERM = true;
    bf16_t* C; const float* res; int ldc;
    template <int NAI> __device__ __forceinline__ void run(const f32x4 (&acc)[2][2][4][2], const Unit& u, int wr, int wc, int fr, int fq, const LAS int*, const LAS float*) const {
        const int row0 = u.m0 + wr * 64 + fr, col0 = u.n0 + wc * 32 + 8 * fq;
#pragma unroll
        for (int ai = 0; ai < NAI; ++ai)
#pragma unroll
            for (int m = 0; m < 4; ++m) { const size_t off = (size_t)(row0 + ai * HALF + m * 16) * ldc + col0;
#pragma unroll
                for (int bj = 0; bj < 2; ++bj) { const f32x4 r0 = *(const f32x4*)(res + off + bj * HALF), r1 = *(const f32x4*)(res + off + bj * HALF + 4);
                    const f32x4 v0 = acc[ai][bj][m][0] + r0, v1 = acc[ai][bj][m][1] + r1;
                    u32x4 w; w[0] = cvt_pk_bf16(v0[0], v0[1]); w[1] = cvt_pk_bf16(v0[2], v0[3]); w[2] = cvt_pk_bf16(v1[0], v1[1]); w[3] = cvt_pk_bf16(v1[2], v1[3]);
                    *(u32x4*)(C + off + bj * HALF) = w; } }
    }
};
struct EpiGateUp {
    static constexpr bool PERM = true;
    unsigned char* ACT; const float* bias;
    template <int NAI> __device__ __forceinline__ void run(const f32x4 (&acc)[2][2][4][2], const Unit& u, int wr, int wc, int fr, int fq, const LAS int* lrows, const LAS float* lbias) const {
        const int colh = u.n0 * HALF + wc * 32 + 8 * fq;
        const LAS float* bp = lbias + wc * 32 + 8 * fq;
        const f32x4 bg0 = *(const LAS f32x4*)bp, bg1 = *(const LAS f32x4*)(bp + 4), bu0 = *(const LAS f32x4*)(bp + 128), bu1 = *(const LAS f32x4*)(bp + 132);
#pragma unroll
        for (int ai = 0; ai < NAI; ++ai)
#pragma unroll
            for (int m = 0; m < 4; ++m) { const int r = ai * HALF + wr * 64 + m * 16 + fr;
                if (r < u.nvalid) { const int asg = lrows[r];
                    f32x4 g0 = acc[ai][0][m][0] + bg0, g1 = acc[ai][0][m][1] + bg1, u0 = acc[ai][1][m][0] + bu0, u1 = acc[ai][1][m][1] + bu1;
                    f32x4 e0, e1;
#pragma unroll
                    for (int j = 0; j < 4; ++j) { g0[j] = fminf(g0[j], 7.f); g1[j] = fminf(g1[j], 7.f); u0[j] = __builtin_amdgcn_fmed3f(u0[j], -7.f, 7.f); u1[j] = __builtin_amdgcn_fmed3f(u1[j], -7.f, 7.f); }
                    const f32x4 z0 = g0 * (-1.702f * 1.4426950408889634f), z1 = g1 * (-1.702f * 1.4426950408889634f);
#pragma unroll
                    for (int j = 0; j < 4; ++j) { e0[j] = __builtin_amdgcn_exp2f(z0[j]); e1[j] = __builtin_amdgcn_exp2f(z1[j]); }
                    e0 = e0 + 1.f; e1 = e1 + 1.f;
#pragma unroll
                    for (int j = 0; j < 4; ++j) { e0[j] = __builtin_amdgcn_rcpf(e0[j]); e1[j] = __builtin_amdgcn_rcpf(e1[j]); }
                    const f32x4 o0 = (g0 * e0) * (u0 + 1.f), o1 = (g1 * e1) * (u1 + 1.f);
                    u32x2 w; w[0] = cvt4_fp8(o0[0], o0[1], o0[2], o0[3]); w[1] = cvt4_fp8(o1[0], o1[1], o1[2], o1[3]);
                    *(u32x2*)(ACT + (size_t)asg * DFF + colh) = w; } }
    }
};
struct EpiDown {
    static constexpr bool PERM = true;
    unsigned char* Y; const float* bias;
    template <int NAI> __device__ __forceinline__ void run(const f32x4 (&acc)[2][2][4][2], const Unit& u, int wr, int wc, int fr, int fq, const LAS int* lrows, const LAS float* lbias) const {
        const int col0 = u.n0 * BM + wc * 32 + 8 * fq;
        const LAS float* bp = lbias + wc * 32 + 8 * fq;
        f32x4 bv[2][2];
#pragma unroll
        for (int bj = 0; bj < 2; ++bj) { bv[bj][0] = *(const LAS f32x4*)(bp + bj * HALF); bv[bj][1] = *(const LAS f32x4*)(bp + bj * HALF + 4); }
#pragma unroll
        for (int ai = 0; ai < NAI; ++ai)
#pragma unroll
            for (int m = 0; m < 4; ++m) { const int r = ai * HALF + wr * 64 + m * 16 + fr;
                if (r < u.nvalid) { const int asg = lrows[r]; unsigned char* rowp = Y + (size_t)asg * DM + col0;
#pragma unroll
                    for (int bj = 0; bj < 2; ++bj) { const f32x4 v0 = acc[ai][bj][m][0] + bv[bj][0], v1 = acc[ai][bj][m][1] + bv[bj][1];
                        u32x2 w; w[0] = cvt4_fp8(v0[0], v0[1], v0[2], v0[3]); w[1] = cvt4_fp8(v1[0], v1[1], v1[2], v1[3]);
                        *(u32x2*)(rowp + bj * HALF) = w; } } }
    }
};
}

struct Args { const float* in[18]; float* out; unsigned char* ws; int ph_lo, ph_hi; };
enum { I_X = 0, I_N1G, I_WIN, I_LBL, I_HGNG, I_CPOS, I_CW1, I_CW2, I_NSAG, I_WOUT, I_N2G, I_WR, I_BR, I_WGU, I_BGU, I_WD, I_BD, I_FNG };
constexpr int LDS_STAGE = 131072, LDS_BYTES = LDS_STAGE + 16384, LDS_MISC = LDS_BYTES - 4096;

struct Frame {
    LAS unsigned char* lds; unsigned char* ws; unsigned* ctl; int tid, wid, lane, G, bid;
};

__device__ __forceinline__ void conv_tile(const Frame& F, const float* src, int lds_, int k0, int n0, int N, bf16_t* dst, int ldd) {
    LAS float* tile = (LAS float*)F.lds;
#pragma unroll
    for (int p = 0; p < 2; ++p) { const int k = p * 32 + (F.tid >> 4), n = (F.tid & 15) * 4;
        f32x4 v = (f32x4){0.f, 0.f, 0.f, 0.f};
        if (n0 + n < N) v = *(const f32x4*)(src + (size_t)(k0 + k) * lds_ + n0 + n);
        tile[k * 65 + n] = v[0]; tile[k * 65 + n + 1] = v[1]; tile[k * 65 + n + 2] = v[2]; tile[k * 65 + n + 3] = v[3]; }
    __syncthreads();
    { const int n = F.tid >> 3, kc = (F.tid & 7) * 8;
      if (n0 + n < N) { float f[8];
#pragma unroll
          for (int j = 0; j < 8; ++j) f[j] = tile[(kc + j) * 65 + n];
          u32x4 w; w[0] = cvt_pk_bf16(f[0], f[1]); w[1] = cvt_pk_bf16(f[2], f[3]); w[2] = cvt_pk_bf16(f[4], f[5]); w[3] = cvt_pk_bf16(f[6], f[7]);
          *(u32x4*)(dst + (size_t)(n0 + n) * ldd + k0 + kc) = w; } }
    __syncthreads();
}
struct ConvJob { const float* src; unsigned char* dst; int N; };
__device__ __forceinline__ ConvJob conv_job(const Args& a, unsigned char* ws, int st, int& kt, int& ntile) {
    ConvJob j;
    if (st < 8192) { const int e = st >> 8, r = st & 255; kt = r >> 4; ntile = r & 15; j.src = a.in[I_WGU] + (size_t)e * DM * 4096; j.dst = ws + WS_WGUT + (size_t)e * 4096 * DM; j.N = 4096; }
    else { const int q = st - 8192, e = q >> 7, r = q & 127; kt = r >> 3; ntile = r & 7; j.src = a.in[I_WD] + (size_t)e * DFF * DM; j.dst = ws + WS_WDT + (size_t)e * DM * DFF; j.N = 2048; }
    return j;
}
__device__ __forceinline__ void conv_experts(const Frame& F, const Args& a, int first, int stride, int limit) {
    unsigned char* ws = F.ws; LAS unsigned* tile = (LAS unsigned*)F.lds;
    LAS float* mtab = (LAS float*)(F.lds + 32768);
    if (F.tid < 64) mtab[F.tid] = shift_mult(amax_shift(__hip_atomic_load(F.ctl + CW_AMAX + F.tid, __ATOMIC_RELAXED, __HIP_MEMORY_SCOPE_AGENT)));
    __syncthreads();
    const int NST = limit;
    const int lk = F.tid >> 5, lc = F.tid & 31;
    f32x4 v[16];
    int st = first, kt = 0, ntile = 0; ConvJob J{};
#define CV_LOAD() do { _Pragma("unroll") for (int T = 0; T < 2; ++T) _Pragma("unroll") for (int pp = 0; pp < 8; ++pp) \
        v[T * 8 + pp] = __builtin_nontemporal_load((const f32x4*)(J.src + (size_t)(kt * 128 + pp * 16 + lk) * J.N + ntile * 256 + T * 128 + lc * 4)); } while (0)
    if (st < NST) { J = conv_job(a, ws, st, kt, ntile); CV_LOAD(); }
    for (; st < NST; st += stride) {
        const float mlt = mtab[st < 8192 ? (st >> 8) : 32 + ((st - 8192) >> 7)];
#pragma unroll
        for (int T = 0; T < 2; ++T)
#pragma unroll
            for (int pp = 0; pp < 8; ++pp) { const int k = pp * 16 + lk; const f32x4 x = v[T * 8 + pp];
                tile[T * 4096 + k * 32 + (lc ^ (4 * (k >> 4)))] = cvt4_fp8s(x[0], x[1], x[2], x[3], mlt); }
        __syncthreads();
        const ConvJob Jc = J; const int ktc = kt, ntc = ntile;
        const int nx = st + stride;
        if (nx < NST) { J = conv_job(a, ws, nx, kt, ntile); CV_LOAD(); }
        { const int i = F.tid & 7, n4g = (F.tid >> 3) & 31, T = F.tid >> 8;
          unsigned d[16];
#pragma unroll
          for (int jj = 0; jj < 16; ++jj) d[jj] = tile[T * 4096 + (16 * i + jj) * 32 + (n4g ^ (4 * i))];
          u32x4 o[4];
#pragma unroll
          for (int q = 0; q < 4; ++q) {
              const unsigned a0 = __builtin_amdgcn_perm(d[4 * q + 1], d[4 * q], 0x05010400u), a1 = __builtin_amdgcn_perm(d[4 * q + 1], d[4 * q], 0x07030602u);
              const unsigned a2 = __builtin_amdgcn_perm(d[4 * q + 3], d[4 * q + 2], 0x05010400u), a3 = __builtin_amdgcn_perm(d[4 * q + 3], d[4 * q + 2], 0x07030602u);
              o[0][q] = __builtin_amdgcn_perm(a2, a0, 0x05040100u); o[1][q] = __builtin_amdgcn_perm(a2, a0, 0x07060302u);
              o[2][q] = __builtin_amdgcn_perm(a3, a1, 0x05040100u); o[3][q] = __builtin_amdgcn_perm(a3, a1, 0x07060302u); }
          unsigned char* dp = Jc.dst + (size_t)(ntc * 256 + T * 128 + n4g * 4) * DM + ktc * 128 + 16 * i;
#pragma unroll
          for (int r = 0; r < 4; ++r) *(u32x4*)(dp + (size_t)r * DM) = o[r]; }
        __syncthreads();
    }
#undef CV_LOAD
}
__device__ __forceinline__ void conv_matrix4(const Frame& F, const float* src, int K, int N, bf16_t* dst) {
    LAS float* tile = (LAS float*)F.lds;
    const int tn4 = (N + 255) / 256, tk = K / 64, cnt = tn4 * tk;
    for (int t = F.bid; t < cnt; t += F.G) { const int k0 = (t / tn4) * 64, n00 = (t % tn4) * 256;
        f32x4 v[8];
#pragma unroll
        for (int q = 0; q < 4; ++q)
#pragma unroll
            for (int p = 0; p < 2; ++p) { const int k = p * 32 + (F.tid >> 4), n = n00 + q * 64 + (F.tid & 15) * 4;
                v[q * 2 + p] = (n < N) ? *(const f32x4*)(src + (size_t)(k0 + k) * N + n) : (f32x4){0.f, 0.f, 0.f, 0.f}; }
#pragma unroll
        for (int q = 0; q < 4; ++q)
#pragma unroll
            for (int p = 0; p < 2; ++p) { LAS float* tp = tile + q * (64 * 65) + (p * 32 + (F.tid >> 4)) * 65 + (F.tid & 15) * 4; const f32x4 x = v[q * 2 + p]; tp[0] = x[0]; tp[1] = x[1]; tp[2] = x[2]; tp[3] = x[3]; }
        __syncthreads();
        { const int n = F.tid >> 3, kc = (F.tid & 7) * 8;
#pragma unroll
          for (int q = 0; q < 4; ++q) { const int nn = n00 + q * 64 + n;
              if (nn < N) { float f[8];
#pragma unroll
                  for (int j = 0; j < 8; ++j) f[j] = tile[q * (64 * 65) + (kc + j) * 65 + n];
                  u32x4 w; w[0] = cvt_pk_bf16(f[0], f[1]); w[1] = cvt_pk_bf16(f[2], f[3]); w[2] = cvt_pk_bf16(f[4], f[5]); w[3] = cvt_pk_bf16(f[6], f[7]);
                  *(u32x4*)(dst + (size_t)nn * K + k0 + kc) = w; } } }
        __syncthreads(); }
}
__device__ __forceinline__ void conv_matrix(const Frame& F, const float* src, int K, int N, bf16_t* dst, long& base) {
    const int tn = (N + 63) / 64, tk = K / 64; const long cnt = (long)tn * tk;
    long first = ((long)F.bid - base) % F.G; if (first < 0) first += F.G;
    for (long t = first; t < cnt; t += F.G) { const int kt = (int)(t / tn), nt_ = (int)(t % tn); conv_tile(F, src, N, kt * 64, nt_ * 64, N, dst, K); }
    base += cnt;
}
__device__ __forceinline__ void bias1_partials(const Frame& F, const Args& a, int rank, int nranks) {
    LAS float* red = (LAS float*)F.lds;
    const int c = F.tid & 127, kq = F.tid >> 7;
    for (int job = rank; job < 64; job += nranks) { const int j = job >> 5, kg = job & 31;
        const float* pos = a.in[I_CPOS] + (size_t)j * 4096 + kg * 128 + kq * 32; const float* w1 = a.in[I_CW1] + ((size_t)j * 4096 + kg * 128 + kq * 32) * 128 + c;
        float s0 = 0.f, s1 = 0.f, s2 = 0.f, s3 = 0.f;
#pragma unroll
        for (int k = 0; k < 32; k += 4) { s0 += pos[k] * w1[(size_t)k * 128]; s1 += pos[k + 1] * w1[(size_t)(k + 1) * 128]; s2 += pos[k + 2] * w1[(size_t)(k + 2) * 128]; s3 += pos[k + 3] * w1[(size_t)(k + 3) * 128]; }
        red[kq * 128 + c] = (s0 + s1) + (s2 + s3);
        __syncthreads();
        if (F.tid < 128) ((float*)(F.ws + WS_B1P))[((size_t)j * 32 + kg) * 128 + c] = ((red[c] + red[128 + c]) + red[256 + c]) + red[384 + c];
        __syncthreads(); }
}
__device__ __forceinline__ void p0_sample(const Frame& F, const Args& a) {
    const int j = F.bid & 63, q = F.bid >> 6, nq = (F.G + 63 - j) >> 6;
    const float* src; size_t stride; int nalt;
    if (j < 32) { src = a.in[I_WGU] + (size_t)j * DM * 4096; stride = (size_t)DM * 4096 / 64; nalt = 2; }
    else { src = a.in[I_WD] + (size_t)(j - 32) * DFF * DM; stride = (size_t)DFF * DM / 64; nalt = 1; }
    float mx = 0.f;
    for (int c = q; c < 64; c += nq) { const f32x4 v = *(const f32x4*)(src + (size_t)c * stride + (size_t)(c % nalt) * 2048 + F.tid * 4);
        mx = fmaxf(fmaxf(mx, fmaxf(fabsf(v[0]), fabsf(v[1]))), fmaxf(fabsf(v[2]), fabsf(v[3]))); }
    mx = wave_max(mx);
    if (F.lane == 0 && mx > 0.f) atomicMax(F.ctl + CW_AMAX + j, __float_as_uint(mx));
}
__device__ __forceinline__ void p0_prologue(const Frame& F, const Args& a) {
    unsigned char* ws = F.ws;
    long base = 0;
    p0_sample(F, a);
    static_assert(CONV_P0 == 0, "expert tiles need the sampled scales: none may be converted in the prologue");
    conv_matrix4(F, a.in[I_WIN], DM, IN_COLS, (bf16_t*)(ws + WS_WINT));
    conv_matrix(F, a.in[I_WOUT], DM, DM, (bf16_t*)(ws + WS_WOUTT), base);
    for (int fi = F.bid * NTHREADS + F.tid; fi < 2 * 8 * 32 * 4 * 64; fi += F.G * NTHREADS) {
        const int ln_ = fi & 63, ct = (fi >> 6) & 3, ks = (fi >> 8) & 31, w = (fi >> 13) & 7, j = fi >> 16;
        const float* wp = a.in[I_CW1] + ((size_t)j * 4096 + w * 512 + ks * 16 + (ln_ >> 5) * 8) * 128 + ct * 32 + (ln_ & 31);
        u32x4 fw; fw[0] = cvt_pk_bf16(wp[0], wp[128]); fw[1] = cvt_pk_bf16(wp[256], wp[384]); fw[2] = cvt_pk_bf16(wp[512], wp[640]); fw[3] = cvt_pk_bf16(wp[768], wp[896]);
        *(u32x4*)((bf16_t*)(ws + WS_W1T) + (size_t)fi * 8) = fw; }
    for (int j = 0; j < 2; ++j) conv_matrix(F, a.in[I_CW2] + (size_t)j * 128 * 128, 128, 128, (bf16_t*)(ws + WS_W2T) + (size_t)j * 128 * 128, base);
    { const float* x = a.in[I_X]; const float* g = a.in[I_N1G]; bf16_t* U = (bf16_t*)(ws + WS_U);
      f32x4 vn[8]; int row = F.bid * 8 + F.wid;
#define P0_LDROW(r_) do { const float* xr_ = x + (size_t)(r_) * DM; _Pragma("unroll") for (int i = 0; i < 4; ++i) { vn[2 * i] = *(const f32x4*)(xr_ + i * 512 + F.lane * 8); vn[2 * i + 1] = *(const f32x4*)(xr_ + i * 512 + F.lane * 8 + 4); } } while (0)
      if (row < NTOK) P0_LDROW(row);
      for (; row < NTOK; row += F.G * 8) {
          f32x4 v[8]; float ss = 0.f;
#pragma unroll
          for (int i = 0; i < 8; ++i) v[i] = vn[i];
          if (row + F.G * 8 < NTOK) P0_LDROW(row + F.G * 8);
#pragma unroll
          for (int i = 0; i < 8; ++i)
#pragma unroll
              for (int j = 0; j < 4; ++j) ss += v[i][j] * v[i][j];
          ss = wave_sum(ss); const float rs = rsqrtf(ss * (1.f / DM) + EPS);
#pragma unroll
          for (int i = 0; i < 4; ++i) { const f32x4 g0 = *(const f32x4*)(g + i * 512 + F.lane * 8), g1 = *(const f32x4*)(g + i * 512 + F.lane * 8 + 4);
              const f32x4 a0 = v[2 * i] * rs * g0, a1 = v[2 * i + 1] * rs * g1;
              u32x4 w; w[0] = cvt_pk_bf16(a0[0], a0[1]); w[1] = cvt_pk_bf16(a0[2], a0[3]); w[2] = cvt_pk_bf16(a1[0], a1[1]); w[3] = cvt_pk_bf16(a1[2], a1[3]);
              *(u32x4*)(U + (size_t)row * DM + i * 512 + F.lane * 8) = w; } }
#undef P0_LDROW
    }
    { const int gw = F.bid * 8 + F.wid;
      (void)gw;
      for (int i = F.bid * NTHREADS + F.tid; i < DM * NEXP; i += F.G * NTHREADS) ((float*)(ws + WS_WR2))[i] = a.in[I_N2G][i >> 5] * a.in[I_WR][i];
      for (int i = F.bid * NTHREADS + F.tid; i < HG_W; i += F.G * NTHREADS) { const float l0 = a.in[I_LBL][i], l1 = a.in[I_LBL][HG_W + i]; const float m = fmaxf(l0, l1);
          const float e0 = __expf(l0 - m), e1 = __expf(l1 - m); ((float*)(ws + WS_LB))[i] = e0 / (e0 + e1); } }
}

__device__ __forceinline__ float gelu_tanh(float x) { const float u = 0.7978845608028654f * (x + 0.044715f * x * x * x); return 0.5f * x * (1.f + tanhf(u)); }
__device__ __forceinline__ void p2_compress_naive(const Frame& F, const Args& a) {
    unsigned char* ws = F.ws; const bf16_t* PROJ = (const bf16_t*)(ws + WS_PROJ);
    LAS float* red = (LAS float*)F.lds;
    LAS float* hdn = red + 512;
    const int c = F.tid & 127, kq = F.tid >> 7;
    for (int u = F.bid; u < 2 * 16 * 128; u += F.G) {
        const int j = u >> 11, bg = (u >> 7) & 15, n = u & 127, b = bg >> 1, g = bg & 1;
        bf16_t* dst = (bf16_t*)(ws + (j ? WS_VC : WS_KC)) + ((size_t)bg * 128 + n) * 128;
        if (n == 127) { if (F.tid < 128) dst[F.tid] = 0; continue; }
        const float* w1 = a.in[I_CW1] + (size_t)j * 4096 * 128; const float* pos = a.in[I_CPOS] + (size_t)j * 4096;
        const int colb = (j ? C_VCM : C_KCM) + g * 128;
        float s = 0.f;
        for (int k = kq * 1024; k < kq * 1024 + 1024; ++k) { const int l = k >> 7, d = k & 127;
            const float av = bf2f(PROJ[(size_t)(b * SEQ + 16 * n + l) * PROJ_LD + colb + d]) + pos[k];
            s += av * w1[(size_t)k * 128 + c]; }
        red[kq * 128 + c] = s; __syncthreads();
        if (F.tid < 128) hdn[c] = gelu_tanh(red[c] + red[128 + c] + red[256 + c] + red[384 + c]);
        __syncthreads();
        if (F.tid < 128) { const float* w2 = a.in[I_CW2] + (size_t)j * 128 * 128; float o = 0.f; for (int k = 0; k < 128; ++k) o += hdn[k] * w2[k * 128 + c]; dst[c] = f2bf(o); }
        __syncthreads();
    }
}

__device__ __forceinline__ void hgrn_naive_unit(const Frame& F, const Args& a, int unit) {
    unsigned char* ws = F.ws; const bf16_t* PROJ = (const bf16_t*)(ws + WS_PROJ); bf16_t* YM = (bf16_t*)(ws + WS_YMIX);
    const float* lbv = (const float*)(ws + WS_LB);
    const int b = unit >> 3, h = unit & 7, v = F.tid & 127, kg = F.tid >> 7;
    LAS float* fs = (LAS float*)F.lds;
    LAS float* qs = fs + 2048; LAS float* is_ = qs + 2048; LAS float* red = is_ + 2048  ; LAS float* ob = red + 512  ;
    float S[32];
#pragma unroll
    for (int i = 0; i < 32; ++i) S[i] = 0.f;
    for (int t0 = 0; t0 < SEQ; t0 += 16) {
        for (int i = F.tid; i < 2048; i += NTHREADS) { const int st = i >> 7, k = i & 127; const size_t rowo = (size_t)(b * SEQ + t0 + st) * PROJ_LD + h * 128 + k;
            const float lb = lbv[h * 128 + k];
            fs[i] = lb + (1.f - lb) * sigmoidf_(bf2f(PROJ[rowo + C_HF])); qs[i] = siluf_(bf2f(PROJ[rowo + C_HQ])); is_[i] = bf2f(PROJ[rowo + C_HI]); }
        __syncthreads();
        for (int st = 0; st < 16; ++st) {
            const float iv = is_[st * 128 + v]; float po = 0.f;
#pragma unroll
            for (int kk = 0; kk < 32; ++kk) { const int k = kg * 32 + kk; const float f = fs[st * 128 + k]; S[kk] = f * S[kk] + (1.f - f) * iv; po += S[kk] * qs[st * 128 + k]; }
            red[kg * 128 + v] = po; __syncthreads();
            if (kg == 0) ob[st * 128 + v] = red[v] + red[128 + v] + red[256 + v] + red[384 + v];
            __syncthreads();
        }
        for (int s2 = 0; s2 < 2; ++s2) { const int st = F.wid * 2 + s2; const float o0 = ob[st * 128 + F.lane], o1 = ob[st * 128 + 64 + F.lane];
            const float ss = wave_sum(o0 * o0 + o1 * o1); const float rs = rsqrtf(ss * (1.f / 128.f) + EPS);
            const size_t row = (size_t)(b * SEQ + t0 + st);
            const float g0 = bf2f(PROJ[row * PROJ_LD + C_HGT + h * 128 + F.lane]), g1 = bf2f(PROJ[row * PROJ_LD + C_HGT + h * 128 + 64 + F.lane]);
            YM[row * DM + h * 128 + F.lane] = f2bf(o0 * rs * a.in[I_HGNG][F.lane] * siluf_(g0));
            YM[row * DM + h * 128 + 64 + F.lane] = f2bf(o1 * rs * a.in[I_HGNG][64 + F.lane] * siluf_(g1)); }
        __syncthreads();
    }
}

__device__ __forceinline__ float dot128_bf(const LAS float* q, const bf16_t* k) {
    float s = 0.f;
#pragma unroll
    for (int c = 0; c < 16; ++c) { const u32x4 w = *(const u32x4*)(k + c * 8); float f[8]; unpack8(w, f);
#pragma unroll
        for (int j = 0; j < 8; ++j) s += q[c * 8 + j] * f[j]; }
    return s;
}
__device__ __forceinline__ void softmax4(const Frame& F, LAS float* sc, int stride, int n, LAS float* tmp  ) {
    const int r = F.tid >> 7, i0 = F.tid & 127;
    float m = -INFINITY; for (int i = i0; i < n; i += 128) m = fmaxf(m, sc[r * stride + i]);
    m = wave_max(m); if (F.lane == 0) tmp[F.wid] = m; __syncthreads();
    m = fmaxf(tmp[2 * r], tmp[2 * r + 1]); __syncthreads();
    float s = 0.f;
    for (int i = i0; i < n; i += 128) { const float x = sc[r * stride + i]; const float p = (x == -INFINITY) ? 0.f : __expf(x - m); sc[r * stride + i] = p; s += p; }
    s = wave_sum(s); if (F.lane == 0) tmp[F.wid] = s; __syncthreads();
    s = tmp[2 * r] + tmp[2 * r + 1]; const float inv = s > 0.f ? 1.f / s : 0.f;
    for (int i = i0; i < n; i += 128) sc[r * stride + i] *= inv;
    __syncthreads();
}
__device__ __forceinline__ void attn_naive_unit(const Frame& F, const Args& a, int unit) {
    unsigned char* ws = F.ws; const bf16_t* PROJ = (const bf16_t*)(ws + WS_PROJ); bf16_t* YM = (bf16_t*)(ws + WS_YMIX);
    const int b = unit >> 12, g = (unit >> 11) & 1, t = unit & 2047, bg = b * 2 + g;
    LAS float* qs = (LAS float*)F.lds;
    LAS float* sc = qs + 512;
    LAS float* tmp = sc + 4096;
    LAS float* imp = tmp + 16;
    LAS int* selk = (LAS int*)(imp + 32);
    LAS float* oacc = (LAS float*)(selk + 32);
    const int r4 = F.tid >> 7, d = F.tid & 127;
    const size_t rowq = (size_t)(b * SEQ + t) * PROJ_LD;
    qs[F.tid] = bf2f(PROJ[rowq + C_NQ + (g * 4 + r4) * 128 + d]);
    const float slope = exp2f(-(float)(g * 4 + r4 + 1));
    const float scale = 0.08838834764831845f;
    float gate[3];
#pragma unroll
    for (int c = 0; c < 3; ++c) gate[c] = sigmoidf_(bf2f(PROJ[rowq + C_NGT + (g * 4 + r4) * 3 + c]));
    __syncthreads();
    { const int n = d; float s = -INFINITY;
      if (n < NCMP) { const int dist = t - (16 * n + 31); if (dist >= 0) s = dot128_bf(qs + r4 * 128, (const bf16_t*)(ws + WS_KC) + ((size_t)bg * 128 + n) * 128) * scale - slope * (float)dist; }
      sc[r4 * 1024 + n] = s; }
    __syncthreads();
    softmax4(F, sc, 1024, 128, tmp);
    { float o = 0.f; const bf16_t* vc = (const bf16_t*)(ws + WS_VC) + (size_t)bg * 128 * 128;
      for (int n = 0; n < NCMP; ++n) o += sc[r4 * 1024 + n] * bf2f(vc[n * 128 + d]);
      oacc[F.tid] = gate[0] * o; }
    if (F.tid < 32) { const int j = F.tid; float s = 0.f;
        for (int r = 0; r < 4; ++r) for (int q = -1; q <= 3; ++q) { const int n = 4 * j + q; if (n >= 0 && n < NCMP) s += ((q == -1 || q == 3) ? 1.f : 2.f) * sc[r * 1024 + n]; }
        const int cur = t >> 6; const bool forced = (j == 0) || (j == cur) || (j == cur - 1);
        imp[j] = forced ? 1e4f : (j <= cur ? s : -1e4f); }
    __syncthreads();
    if (F.tid < 32) { const int j = F.tid; const float me = imp[j]; int rank = 0;
        for (int k = 0; k < 32; ++k) { const float o = imp[k]; rank += (o > me || (o == me && k < j)) ? 1 : 0; }
        const bool sel = rank < SEL_TOP && j <= (t >> 6);
        const unsigned long long mask = __ballot(sel);
        if (sel) selk[__popcll(mask & ((1ull << j) - 1ull))] = j;
        if (j == 0) selk[16] = __popcll(mask); }
    __syncthreads();
    { const int nsel = selk[16];
      for (int i = F.tid; i < 4 * 1024; i += NTHREADS) sc[i] = -INFINITY;
      __syncthreads();
      const int l = F.tid & 63, r = (F.tid >> 6) & 3, which = F.tid >> 8;
      for (int s0 = 0; s0 < nsel; s0 += 2) { const int si = s0 + which;
          if (si < nsel) { const int kp = selk[si] * 64 + l;
              if (kp <= t) { const float s = dot128_bf(qs + r * 128, PROJ + (size_t)(b * SEQ + kp) * PROJ_LD + C_KSL + g * 128) * scale - exp2f(-(float)(g * 4 + r + 1)) * (float)(t - kp); sc[r * 1024 + si * 64 + l] = s; } } }
      __syncthreads();
      softmax4(F, sc, 1024, nsel * 64, tmp);
      float o = 0.f;
      for (int si = 0; si < nsel; ++si) { const int kb = selk[si] * 64;
          for (int l2 = 0; l2 < 64; ++l2) { const int kp = kb + l2; if (kp > t) break; o += sc[r4 * 1024 + si * 64 + l2] * bf2f(PROJ[(size_t)(b * SEQ + kp) * PROJ_LD + C_VSL + g * 128 + d]); } }
      oacc[F.tid] += gate[1] * o; }
    __syncthreads();
    { for (int i = F.tid; i < 4 * 1024; i += NTHREADS) sc[i] = -INFINITY;
      __syncthreads();
      for (int i = F.tid; i < 4 * 512; i += NTHREADS) { const int r = i >> 9, w = i & 511, kp = t - 511 + w;
          if (kp >= 0) sc[r * 1024 + w] = dot128_bf(qs + r * 128, PROJ + (size_t)(b * SEQ + kp) * PROJ_LD + C_KWN + g * 128) * scale - exp2f(-(float)(g * 4 + r + 1)) * (float)(t - kp); }
      __syncthreads();
      softmax4(F, sc, 1024, 512, tmp);
      float o = 0.f;
      for (int w = 0; w < 512; ++w) { const int kp = t - 511 + w; if (kp >= 0) o += sc[r4 * 1024 + w] * bf2f(PROJ[(size_t)(b * SEQ + kp) * PROJ_LD + C_VWN + g * 128 + d]); }
      oacc[F.tid] += gate[2] * o; }
    __syncthreads();
    { const float o = oacc[F.tid]; float ss = wave_sum(o * o); if (F.lane == 0) tmp[F.wid] = ss; __syncthreads();
      ss = tmp[2 * r4] + tmp[2 * r4 + 1]; const float rs = rsqrtf(ss * (1.f / 128.f) + EPS);
      YM[(size_t)(b * SEQ + t) * DM + HG_W + (g * 4 + r4) * 128 + d] = f2bf(o * rs * a.in[I_NSAG][d]); }
    __syncthreads();
}

namespace at {
constexpr int SHM_T = 64 * 128 * 2;
constexpr int BUF_B = 2 * SHM_T;
constexpr int OFF_V = 0, OFF_K = SHM_T, OFF_IMP = 2 * BUF_B  , OFF_SELM = 3 * BUF_B, OFF_WSC = OFF_SELM + 256;
constexpr float SCALE = 0.08838834764831845f, LOG2E = 1.4426950408889634f, THR = 8.f;
#define AT_KSWZ(row, colB) ((row) * 256 + ((colB) ^ (((row) & 7) << 4)))
__device__ __forceinline__ int v_st(int k, int c) { const int kk = (k & ~0xC) | ((k & 4) << 1) | ((k & 8) >> 1); return ((kk >> 3) * 4 + (c >> 5)) * 512 + ((kk & 7) * 32 + (c & 31)) * 2; }
__device__ __forceinline__ int v_rd_base(int lane) { return ((lane & 3) << 3) | (((lane >> 2) & 3) << 6) | (((lane >> 4) & 1) << 5) | (((lane >> 5) & 1) << 8); }
__device__ __forceinline__ int crow(int r, int hi) { return (r & 3) + 8 * (r >> 2) + 4 * hi; }
typedef short s16x4 __attribute__((ext_vector_type(4)));
struct Stage { u32x4 k0, k1, v0, v1; };
__device__ __forceinline__ void stage_load(Stage& S, const bf16_t* Kp, const bf16_t* Vp, int ld, int row0, int sr, int sc) {
    S.k0 = *(const u32x4*)(Kp + (size_t)(row0 + sr) * ld + sc); S.k1 = *(const u32x4*)(Kp + (size_t)(row0 + 32 + sr) * ld + sc);
    S.v0 = *(const u32x4*)(Vp + (size_t)(row0 + sr) * ld + sc); S.v1 = *(const u32x4*)(Vp + (size_t)(row0 + 32 + sr) * ld + sc);
}
__device__ __forceinline__ void stage_write(const Stage& S, LAS unsigned char* lds, int buf, int sr, int sc) {
    const int kws = AT_KSWZ(sr, sc * 2);
    *(LAS u32x4*)(lds + OFF_K + buf * BUF_B + kws) = S.k0; *(LAS u32x4*)(lds + OFF_K + buf * BUF_B + kws + 32 * 256) = S.k1;
    *(LAS u32x4*)(lds + OFF_V + buf * BUF_B + v_st(sr, sc)) = S.v0; *(LAS u32x4*)(lds + OFF_V + buf * BUF_B + v_st(32 + sr, sc)) = S.v1;
}
template <bool EXTRA = false>
__device__ __forceinline__ void qkt(f32x16& p0, f32x16& p1, const LAS unsigned char* ktile, int r32, int hi, const bf16x8 (&qr)[8], bf16x8 kx0 = bf16x8{}, bf16x8 kx1 = bf16x8{}, bf16x8 qx = bf16x8{}) {
#pragma unroll
    for (int r = 0; r < 16; ++r) { p0[r] = 0.f; p1[r] = 0.f; }
    const LAS unsigned char* kb[4];
#pragma unroll
    for (int dd = 0; dd < 4; ++dd) kb[dd] = ktile + AT_KSWZ(r32, (dd * 16 + hi * 8) * 2);
#pragma unroll
    for (int d0 = 0; d0 < 8; ++d0) { const LAS unsigned char* a = kb[d0 & 3] + (d0 >> 2) * 128;
        const bf16x8 b0 = *(const LAS bf16x8*)a; const bf16x8 b1 = *(const LAS bf16x8*)(a + 32 * 256);
        p0 = __builtin_amdgcn_mfma_f32_32x32x16_bf16(b0, qr[d0], p0, 0, 0, 0);
        p1 = __builtin_amdgcn_mfma_f32_32x32x16_bf16(b1, qr[d0], p1, 0, 0, 0); }
    if constexpr (EXTRA) {
        p0 = __builtin_amdgcn_mfma_f32_32x32x16_bf16(kx0, qx, p0, 0, 0, 0);
        p1 = __builtin_amdgcn_mfma_f32_32x32x16_bf16(kx1, qx, p1, 0, 0, 0); }
}
__device__ __forceinline__ void pv_tile(f32x16 (&o)[4], int vb, bf16x8 pa0, bf16x8 pa1, bf16x8 pa2, bf16x8 pa3) {
#define AT_TRRD(dst, off) asm volatile("ds_read_b64_tr_b16 %0, %1 offset:%2" : "=&v"(dst) : "v"(vb), "i"(off) : "memory")
#define AT_PV_D0(d0) do { s16x4 l0, l1, l2, l3, h0, h1, h2, h3; constexpr int b_ = (d0) * 512; \
        AT_TRRD(l0, b_); AT_TRRD(h0, b_ + 2048); AT_TRRD(l1, b_ + 4096); AT_TRRD(h1, b_ + 6144); AT_TRRD(l2, b_ + 8192); AT_TRRD(h2, b_ + 10240); AT_TRRD(l3, b_ + 12288); AT_TRRD(h3, b_ + 14336); \
        asm volatile("s_waitcnt lgkmcnt(0)" ::: "memory"); __builtin_amdgcn_sched_barrier(0); \
        o[d0] = __builtin_amdgcn_mfma_f32_32x32x16_bf16(pa0, (bf16x8){l0[0], l0[1], l0[2], l0[3], h0[0], h0[1], h0[2], h0[3]}, o[d0], 0, 0, 0); \
        o[d0] = __builtin_amdgcn_mfma_f32_32x32x16_bf16(pa1, (bf16x8){l1[0], l1[1], l1[2], l1[3], h1[0], h1[1], h1[2], h1[3]}, o[d0], 0, 0, 0); \
        o[d0] = __builtin_amdgcn_mfma_f32_32x32x16_bf16(pa2, (bf16x8){l2[0], l2[1], l2[2], l2[3], h2[0], h2[1], h2[2], h2[3]}, o[d0], 0, 0, 0); \
        o[d0] = __builtin_amdgcn_mfma_f32_32x32x16_bf16(pa3, (bf16x8){l3[0], l3[1], l3[2], l3[3], h3[0], h3[1], h3[2], h3[3]}, o[d0], 0, 0, 0); } while (0)
    AT_PV_D0(0); AT_PV_D0(1); AT_PV_D0(2); AT_PV_D0(3);
#undef AT_PV_D0
#undef AT_TRRD
}
__device__ __forceinline__ float swap_max(float v) { auto rr = __builtin_amdgcn_permlane32_swap(__float_as_uint(v), __float_as_uint(v), false, false); return fmaxf(__uint_as_float(rr[0]), __uint_as_float(rr[1])); }
__device__ __forceinline__ float swap_sum(float v) { auto rr = __builtin_amdgcn_permlane32_swap(__float_as_uint(v), __float_as_uint(v), false, false); return __uint_as_float(rr[0]) + __uint_as_float(rr[1]); }
__device__ __forceinline__ void pack_p(const f32x16& P, bf16x8& outA, bf16x8& outB) {
#define AT_PK4(B_, OUT) do { unsigned a0 = cvt_pk_bf16(P[B_ + 0], P[B_ + 1]), a1 = cvt_pk_bf16(P[B_ + 2], P[B_ + 3]); \
        unsigned b0 = cvt_pk_bf16(P[B_ + 4], P[B_ + 5]), b1 = cvt_pk_bf16(P[B_ + 6], P[B_ + 7]); \
        auto r0 = __builtin_amdgcn_permlane32_swap(a0, b0, false, false); auto r1 = __builtin_amdgcn_permlane32_swap(a1, b1, false, false); \
        u32x4 w = {r0[0], r1[0], r0[1], r1[1]}; OUT = *reinterpret_cast<bf16x8*>(&w); } while (0)
    AT_PK4(0, outA); AT_PK4(8, outB);
#undef AT_PK4
}
__device__ __forceinline__ float online_sm1(const f32x16& p0, const f32x16& p1, float& m_reg, float& mnL) {
    float pmax = p0[0];
#pragma unroll
    for (int r = 1; r < 16; ++r) pmax = fmaxf(pmax, p0[r]);
#pragma unroll
    for (int r = 0; r < 16; ++r) pmax = fmaxf(pmax, p1[r]);
    pmax = swap_max(pmax);
    float mn, alpha;
    if (__all(pmax - m_reg <= THR)) { mn = m_reg; alpha = 1.f; }
    else { mn = fmaxf(m_reg, pmax); alpha = __builtin_amdgcn_exp2f((m_reg - mn) * LOG2E); m_reg = mn; }
    mnL = -mn * LOG2E;
    return alpha;
}
__device__ __forceinline__ float online_sm1_raw(const f32x16& p0, const f32x16& p1, float& m_reg, float& mnL, float base2, bool on = true) {
    float pmax = p0[0];
#pragma unroll
    for (int r = 1; r < 16; ++r) pmax = fmaxf(pmax, p0[r]);
#pragma unroll
    for (int r = 0; r < 16; ++r) pmax = fmaxf(pmax, p1[r]);
    pmax = on ? fmaf(swap_max(pmax), SCALE, base2) : -INFINITY;
    float mn, alpha;
    if (__all(pmax - m_reg <= THR)) { mn = m_reg; alpha = 1.f; }
    else { mn = fmaxf(m_reg, pmax); alpha = __builtin_amdgcn_exp2f((m_reg - mn) * LOG2E); m_reg = mn; }
    mnL = on ? (base2 - mn) * LOG2E : -INFINITY;
    return alpha;
}
__device__ __forceinline__ void online_sm2_raw(f32x16& p0, f32x16& p1, float mnL, float alpha, float& l_reg) {
    constexpr float C2 = SCALE * LOG2E;
    float ps = 0.f;
#pragma unroll
    for (int r = 0; r < 16; ++r) { p0[r] = __builtin_amdgcn_exp2f(fmaf(p0[r], C2, mnL)); p1[r] = __builtin_amdgcn_exp2f(fmaf(p1[r], C2, mnL)); ps += p0[r] + p1[r]; }
    ps = swap_sum(ps);
    l_reg = l_reg * alpha + ps;
}
__device__ __forceinline__ void online_sm2(f32x16& p0, f32x16& p1, float mnL, float alpha, float& l_reg) {
    float ps = 0.f;
#pragma unroll
    for (int r = 0; r < 16; ++r) { p0[r] = __builtin_amdgcn_exp2f(fmaf(p0[r], LOG2E, mnL)); p1[r] = __builtin_amdgcn_exp2f(fmaf(p1[r], LOG2E, mnL)); ps += p0[r] + p1[r]; }
    ps = swap_sum(ps);
    l_reg = l_reg * alpha + ps;
}
template <int MODE>
__device__ __forceinline__ void branch_loop(f32x16 (&o)[4], float& l_out, LAS unsigned char* lds, const bf16_t* Kp, const bf16_t* Vp, int jlo, int qt,
                                            const bf16x8 (&qr)[8], int tq, float slope, unsigned selbits, int r32, int hi, int sr, int sc, LAS float* wsc, int wave_tmin, int grpB,
                                            const Stage& P0, const Stage& P1  ,
                                            const LAS int* jl  ) {
    float m_reg = -1e30f, l_reg = 0.f;
#pragma unroll
    for (int d = 0; d < 4; ++d)
#pragma unroll
        for (int r = 0; r < 16; ++r) o[d][r] = 0.f;
    const int vb0 = (int)(uintptr_t)(lds + OFF_V) + v_rd_base(r32 + 32 * hi);
    const int NT = (MODE == 1) ? __builtin_amdgcn_readfirstlane(jl[32]) : qt - jlo + 1;
#define AT_TJ(t) ((MODE == 1) ? __builtin_amdgcn_readfirstlane(jl[t]) : jlo + (t))
    unsigned xk0w, xk1w, xqw;
    { const float sv = slope * (1.f / SCALE); const bf16_t shi = f2bf(sv), slo = f2bf(sv - bf2f(shi));
      xk0w = hi ? 0u : (unsigned)f2bf((float)r32) * 0x10001u; xk1w = hi ? 0u : (unsigned)f2bf((float)(32 + r32)) * 0x10001u; xqw = hi ? 0u : ((unsigned)shi | ((unsigned)slo << 16)); }
#define AT_LGKM0() asm volatile("s_waitcnt lgkmcnt(0)" ::: "memory")
#define AT_BAR() do { AT_LGKM0(); __builtin_amdgcn_s_barrier(); asm volatile("" ::: "memory"); } while (0)
    Stage S0; stage_write(P0, lds, 0, sr, sc); if (NT > 1) stage_write(P1, lds, 1, sr, sc);
    if (NT > 2) stage_load(S0, Kp, Vp, PROJ_LD, AT_TJ(2) * 64, sr, sc);
    __syncthreads();
    if (grpB) AT_BAR();
    int buf = 0;
#define AT_STEP(tau, SX, DIAG) do { \
        const int j = AT_TJ(tau); \
        f32x16 p0, p1; \
        bf16x8 kx0, kx1, qx; { unsigned t0_ = xk0w, t1_ = xk1w, t2_ = xqw; asm volatile("" : "+v"(t0_), "+v"(t1_), "+v"(t2_)); \
            u32x4 a0_ = {t0_, 0u, 0u, 0u}, a1_ = {t1_, 0u, 0u, 0u}, b0_ = {t2_, 0u, 0u, 0u}; kx0 = *reinterpret_cast<bf16x8*>(&a0_); kx1 = *reinterpret_cast<bf16x8*>(&a1_); qx = *reinterpret_cast<bf16x8*>(&b0_); } \
        qkt<true>(p0, p1, lds + OFF_K + buf * BUF_B, r32, hi, qr, kx0, kx1, qx); \
        const int kbase = j * 64; const int dq = tq - kbase - 4 * hi; \
        const float base2 = slope * (float)(kbase - tq); \
        bool on = true; \
        if (MODE == 1) { \
            on = (selbits >> j) & 1u; \
            if (DIAG) {        \
                _Pragma("unroll") for (int r = 0; r < 16; ++r) { const int cc = (r & 3) + 8 * (r >> 2); if (cc > dq) p0[r] = -INFINITY; if (cc + 32 > dq) p1[r] = -INFINITY; } \
            } \
        } else { \
            if (kbase + 63 > wave_tmin || kbase < wave_tmin + 31 - (WINDOW - 1)) { \
                _Pragma("unroll") for (int r = 0; r < 16; ++r) { const int cc = (r & 3) + 8 * (r >> 2); \
                    if ((unsigned)(dq - cc) >= (unsigned)WINDOW) p0[r] = -INFINITY; if ((unsigned)(dq - cc - 32) >= (unsigned)WINDOW) p1[r] = -INFINITY; } \
            } \
        } \
        float mnL; const float alpha = online_sm1_raw(p0, p1, m_reg, mnL, base2, on); \
        AT_BAR(); \
        if ((tau) + 2 < NT) { int b2 = buf + 2; if (b2 >= 3) b2 -= 3; stage_write(SX, lds, b2, sr, sc); } \
        if ((tau) + 3 < NT) stage_load(SX, Kp, Vp, PROJ_LD, AT_TJ((tau) + 3) * 64, sr, sc); \
        online_sm2_raw(p0, p1, mnL, alpha, l_reg); \
        bf16x8 pa0, pa1, pa2, pa3; pack_p(p0, pa0, pa1); pack_p(p1, pa2, pa3); \
        if (__any(alpha < 1.f)) { if (hi == 0) wsc[r32] = alpha; \
            _Pragma("unroll") for (int r = 0; r < 16; ++r) { const float al = wsc[crow(r, hi)]; \
                _Pragma("unroll") for (int d = 0; d < 4; ++d) o[d][r] *= al; } } \
        pv_tile(o, vb0 + buf * BUF_B, pa0, pa1, pa2, pa3); \
        AT_BAR(); \
        buf = buf + 1; if (buf >= 3) buf = 0; } while (0)
    if (MODE == 1) { for (int tau = 0; tau < NT - 1; ++tau) { AT_STEP(tau, S0, 0); } { const int tau = NT - 1; AT_STEP(tau, S0, 1); } }
    else { for (int tau = 0; tau < NT; ++tau) { AT_STEP(tau, S0, 0); } }
#undef AT_STEP
#undef AT_TJ
    if (!grpB) AT_BAR();
#undef AT_BAR
#undef AT_LGKM0
    l_out = l_reg;
    __syncthreads();
}
}

__device__ __forceinline__ void attn_fast_unit(const Frame& F, const Args& a, int unit) {
    using namespace at;
    unsigned char* ws = F.ws; const bf16_t* PROJ = (const bf16_t*)(ws + WS_PROJ); bf16_t* YM = (bf16_t*)(ws + WS_YMIX);
    LAS unsigned char* lds = F.lds;
    const int qt = 31 - (unit >> 4), bg = unit & 15, b = bg >> 1, g = bg & 1;
    int tz = threadIdx.x; asm volatile("" : "+v"(tz));
    const int lane = tz & 63, r32 = lane & 31, hi = lane >> 5, head = F.wid & 3, qh = F.wid >> 2;
    const int t0 = qt * 64, tq = t0 + qh * 32 + r32, wave_tmin = t0 + qh * 32;
    const int sr = tz >> 4, sc = (tz & 15) * 8;
    const float slope = exp2f(-(float)(g * 4 + head + 1));
    LAS float* wsc = (LAS float*)(lds + OFF_WSC) + F.wid * 256;
    LAS float* imph = (LAS float*)(lds + OFF_IMP);
    LAS unsigned* selm = (LAS unsigned*)(lds + OFF_SELM);
    const bf16_t* Kc = (const bf16_t*)(ws + WS_KC) + (size_t)bg * 128 * 128; const bf16_t* Vc = (const bf16_t*)(ws + WS_VC) + (size_t)bg * 128 * 128;
    Stage Sc0, Sc1; stage_load(Sc0, Kc, Vc, 128, 0, sr, sc); stage_load(Sc1, Kc, Vc, 128, 64, sr, sc);
    bf16x8 qr[8];
    { const bf16_t* qp = PROJ + (size_t)(b * SEQ + tq) * PROJ_LD + C_NQ + (g * 4 + head) * 128 + hi * 8;
#pragma unroll
      for (int d0 = 0; d0 < 8; ++d0) qr[d0] = *(const bf16x8*)(qp + d0 * 16); }
    float gate[3];
    { const bf16_t* gp = PROJ + (size_t)(b * SEQ + tq) * PROJ_LD + C_NGT + (g * 4 + head) * 3;
#pragma unroll
      for (int c = 0; c < 3; ++c) gate[c] = sigmoidf_(bf2f(gp[c])); }
    f32x16 o[4];
    float* otp = (float*)(ws + WS_OT) + ((size_t)F.bid * 512 + tz) * 64;
    { stage_write(Sc0, lds, 0, sr, sc); stage_write(Sc1, lds, 1, sr, sc);
      __syncthreads();
      f32x16 p0, p1, p2, p3;
      qkt(p0, p1, lds + OFF_K, r32, hi, qr); qkt(p2, p3, lds + OFF_K + BUF_B, r32, hi, qr);
      const int dl0 = ((tq - 31) >> 4) - 4 * hi;
      const float base_f = slope * (float)(16 * 4 * hi + 31 - tq);
      float mx = -INFINITY;
#pragma unroll
      for (int r = 0; r < 16; ++r) { const int cc = (r & 3) + 8 * (r >> 2);
          p0[r] = (cc <= dl0)      ? fmaf(p0[r], SCALE, fmaf(slope, (float)(16 * cc), base_f))        : -INFINITY;
          p1[r] = (cc + 32 <= dl0) ? fmaf(p1[r], SCALE, fmaf(slope, (float)(16 * (cc + 32)), base_f)) : -INFINITY;
          p2[r] = (cc + 64 <= dl0) ? fmaf(p2[r], SCALE, fmaf(slope, (float)(16 * (cc + 64)), base_f)) : -INFINITY;
          p3[r] = (cc + 96 <= dl0) ? fmaf(p3[r], SCALE, fmaf(slope, (float)(16 * (cc + 96)), base_f)) : -INFINITY;
          mx = fmaxf(fmaxf(mx, p0[r]), fmaxf(p1[r], fmaxf(p2[r], p3[r]))); }
      mx = swap_max(mx);
      const float mL = (mx == -INFINITY) ? 0.f : -mx * LOG2E;
      float ps = 0.f;
#pragma unroll
      for (int r = 0; r < 16; ++r) { p0[r] = __builtin_amdgcn_exp2f(fmaf(p0[r], LOG2E, mL)); p1[r] = __builtin_amdgcn_exp2f(fmaf(p1[r], LOG2E, mL));
          p2[r] = __builtin_amdgcn_exp2f(fmaf(p2[r], LOG2E, mL)); p3[r] = __builtin_amdgcn_exp2f(fmaf(p3[r], LOG2E, mL)); ps += (p0[r] + p1[r]) + (p2[r] + p3[r]); }
      ps = swap_sum(ps);
      const float inv = ps > 0.f ? 1.f / ps : 0.f;
#pragma unroll
      for (int r = 0; r < 16; ++r) { p0[r] *= inv; p1[r] *= inv; p2[r] *= inv; p3[r] *= inv; }
      { LAS float* dst = imph + ((size_t)head * 64 + qh * 32 + r32) * 32;
        float prev = 0.f;
#define AT_GRP(P, blk) do { _Pragma("unroll") for (int i = 0; i < 4; ++i) { const float av = 2.f * (P[4 * i] + P[4 * i + 1] + P[4 * i + 2]) + P[4 * i + 3]; const float bv = P[4 * i + 3]; \
            auto rr = __builtin_amdgcn_permlane32_swap(__float_as_uint(bv), __float_as_uint(bv), false, false); const float pb = __uint_as_float(hi ? rr[0] : rr[1]); \
            dst[2 * ((blk) * 4 + i) + hi] = av + (hi ? pb : prev); prev = pb; } } while (0)
        AT_GRP(p0, 0); AT_GRP(p1, 1); AT_GRP(p2, 2); AT_GRP(p3, 3);
#undef AT_GRP
      }
      bf16x8 pa0, pa1, pa2, pa3;
#pragma unroll
      for (int d = 0; d < 4; ++d)
#pragma unroll
          for (int r = 0; r < 16; ++r) o[d][r] = 0.f;
      const int vb0 = (int)(uintptr_t)(lds + OFF_V) + v_rd_base(lane);
      pack_p(p0, pa0, pa1); pack_p(p1, pa2, pa3); pv_tile(o, vb0, pa0, pa1, pa2, pa3);
      pack_p(p2, pa0, pa1); pack_p(p3, pa2, pa3); pv_tile(o, vb0 + BUF_B, pa0, pa1, pa2, pa3);
      if (hi == 0) wsc[r32] = gate[0];
#pragma unroll
      for (int r = 0; r < 16; ++r) { const float f = wsc[crow(r, hi)];
#pragma unroll
          for (int d = 0; d < 4; ++d) o[d][r] *= f; }
#pragma unroll
      for (int d = 0; d < 4; ++d)
#pragma unroll
          for (int k = 0; k < 4; ++k) *(f32x4*)(otp + d * 16 + 4 * k) = (f32x4){o[d][4 * k], o[d][4 * k + 1], o[d][4 * k + 2], o[d][4 * k + 3]};
    }
    __syncthreads();
    const bf16_t* Ksl = PROJ + (size_t)(b * SEQ) * PROJ_LD + C_KSL + g * 128; const bf16_t* Vsl = PROJ + (size_t)(b * SEQ) * PROJ_LD + C_VSL + g * 128;
    Stage Pa, Pb; stage_load(Pa, Ksl, Vsl, PROJ_LD, 0, sr, sc);
    { const int q = tz >> 3, part = tz & 7, tqq = t0 + q, cur = tqq >> 6;
      unsigned bits = 0u;
      if (cur < SEL_TOP) { bits = (part == 0) ? ((2u << cur) - 1u) : 0u; }
      else {
          float sc_[4];
#pragma unroll
          for (int k = 0; k < 4; ++k) { const int j = part * 4 + k; const float v = ((imph[(0 * 64 + q) * 32 + j] + imph[(1 * 64 + q) * 32 + j]) + imph[(2 * 64 + q) * 32 + j]) + imph[(3 * 64 + q) * 32 + j];
              const bool forced = (j == 0) || (j == cur) || (j == cur - 1); sc_[k] = forced ? 1e4f : (j <= cur ? v : -1e4f); }
          int rank[4] = {0, 0, 0, 0};
          for (int jj = 0; jj < 32; ++jj) { const float v = ((imph[(0 * 64 + q) * 32 + jj] + imph[(1 * 64 + q) * 32 + jj]) + imph[(2 * 64 + q) * 32 + jj]) + imph[(3 * 64 + q) * 32 + jj];
              const bool forced = (jj == 0) || (jj == cur) || (jj == cur - 1); const float s2 = forced ? 1e4f : (jj <= cur ? v : -1e4f);
#pragma unroll
              for (int k = 0; k < 4; ++k) { const int j = part * 4 + k; rank[k] += (s2 > sc_[k] || (s2 == sc_[k] && jj < j)) ? 1 : 0; } }
#pragma unroll
          for (int k = 0; k < 4; ++k) { const int j = part * 4 + k; if (rank[k] < SEL_TOP && j <= cur) bits |= 1u << j; }
      }
      bits |= __shfl_xor(bits, 1); bits |= __shfl_xor(bits, 2); bits |= __shfl_xor(bits, 4);
      if (part == 0) selm[q] = bits; }
    __syncthreads();
    LAS int* jlist = (LAS int*)(lds + OFF_WSC + 8192);
    if (F.wid == 0) { unsigned um = selm[lane];
        um |= __shfl_xor(um, 1); um |= __shfl_xor(um, 2); um |= __shfl_xor(um, 4); um |= __shfl_xor(um, 8); um |= __shfl_xor(um, 16); um |= __shfl_xor(um, 32);
        if (lane == 0) { int n = 0; for (int j = 0; j <= qt; ++j) if ((um >> j) & 1u) jlist[n++] = j; jlist[32] = n; for (int j = n; j < 32; ++j) jlist[j] = qt; } }
    __syncthreads();
    const unsigned selbits = selm[qh * 32 + r32];
    if (jlist[32] > 1) stage_load(Pb, Ksl, Vsl, PROJ_LD, jlist[1] * 64, sr, sc);
    const int jlo = (t0 - (WINDOW - 1)) > 0 ? (t0 - (WINDOW - 1)) >> 6 : 0;
    const bf16_t* Kwn = PROJ + (size_t)(b * SEQ) * PROJ_LD + C_KWN + g * 128; const bf16_t* Vwn = PROJ + (size_t)(b * SEQ) * PROJ_LD + C_VWN + g * 128;
    { float l_sel;
      branch_loop<1>(o, l_sel, lds, Ksl, Vsl, 0, qt, qr, tq, slope, selbits, r32, hi, sr, sc, wsc, wave_tmin, qh, Pa, Pb, jlist);
      stage_load(Pa, Kwn, Vwn, PROJ_LD, jlo * 64, sr, sc); stage_load(Pb, Kwn, Vwn, PROJ_LD, (jlo + 1) * 64, sr, sc);
      if (hi == 0) wsc[r32] = gate[1] / l_sel;
#pragma unroll
      for (int r = 0; r < 16; ++r) { const float f = wsc[crow(r, hi)];
#pragma unroll
          for (int d = 0; d < 4; ++d) o[d][r] *= f; }
#pragma unroll
      for (int d = 0; d < 4; ++d)
#pragma unroll
          for (int k = 0; k < 4; ++k) { const f32x4 pv = *(const f32x4*)(otp + d * 16 + 4 * k); *(f32x4*)(otp + d * 16 + 4 * k) = pv + (f32x4){o[d][4 * k], o[d][4 * k + 1], o[d][4 * k + 2], o[d][4 * k + 3]}; } }
    { float l_win;
      branch_loop<2>(o, l_win, lds, Kwn, Vwn, jlo, qt, qr, tq, slope, 0u, r32, hi, sr, sc, wsc, wave_tmin, qh, Pa, Pb, jlist);
      if (hi == 0) wsc[r32] = gate[2] / l_win;
#pragma unroll
      for (int r = 0; r < 16; ++r) { const float f = wsc[crow(r, hi)];
#pragma unroll
          for (int d = 0; d < 4; ++d) o[d][r] *= f; }
#pragma unroll
      for (int d = 0; d < 4; ++d)
#pragma unroll
          for (int k = 0; k < 4; ++k) { const f32x4 pv = *(const f32x4*)(otp + d * 16 + 4 * k); o[d][4 * k] += pv[0]; o[d][4 * k + 1] += pv[1]; o[d][4 * k + 2] += pv[2]; o[d][4 * k + 3] += pv[3]; } }
    { const float* ng = a.in[I_NSAG];
      float gsc[4];
#pragma unroll
      for (int d = 0; d < 4; ++d) gsc[d] = ng[d * 32 + r32];
#pragma unroll
      for (int r = 0; r < 16; ++r) { float ss = 0.f;
#pragma unroll
          for (int d = 0; d < 4; ++d) ss += o[d][r] * o[d][r];
          ss += __shfl_xor(ss, 1); ss += __shfl_xor(ss, 2); ss += __shfl_xor(ss, 4); ss += __shfl_xor(ss, 8); ss += __shfl_xor(ss, 16);
          const float rs = rsqrtf(ss * (1.f / 128.f) + EPS);
          const int row = b * SEQ + t0 + qh * 32 + crow(r, hi);
          bf16_t* yp = YM + (size_t)row * DM + HG_W + (g * 4 + head) * 128 + r32;
#pragma unroll
          for (int d = 0; d < 4; ++d) yp[d * 32] = f2bf(o[d][r] * rs * gsc[d]); } }
    __syncthreads();
}

namespace hg {
constexpr int T_KD = 0, T_QD = 16384, T_V = 32768, T_KL = 49152, T_FR = 65536, T_QR = 81920, T_OR = 98304, T_PART = 114688, T_DL = T_PART + 4096, T_SSQ = T_DL + 512;
}
__device__ __forceinline__ void hgrn_fast_unit(const Frame& F, const Args& a, int unit) {
    using namespace hg; using at::crow; using at::v_st; using at::v_rd_base; typedef at::s16x4 s16x4;
    unsigned char* ws = F.ws; const bf16_t* PROJ = (const bf16_t*)(ws + WS_PROJ); bf16_t* YM = (bf16_t*)(ws + WS_YMIX);
    LAS unsigned char* lds = F.lds;
    const int b = unit >> 3, h = unit & 7;
    int tz = threadIdx.x; asm volatile("" : "+v"(tz));
    const int lane = tz & 63, r32 = lane & 31, hi = lane >> 5, th = F.wid >> 2, vq = F.wid & 3;
    const int lr = tz >> 4, lc = (tz & 15) * 8;
    const int kp = tz & 63, tg = tz >> 6;
    LAS float* part = (LAS float*)(lds + T_PART); LAS float* dl = (LAS float*)(lds + T_DL); LAS float* ssq = (LAS float*)(lds + T_SSQ);
    f32x16 Sacc[4];
#pragma unroll
    for (int k = 0; k < 4; ++k)
#pragma unroll
        for (int r = 0; r < 16; ++r) Sacc[k][r] = 0.f;
    const bf16_t* base = PROJ + (size_t)(b * SEQ) * PROJ_LD + h * 128;
    u32x4 rf0, rf1, rq0, rq1, ri0, ri1, ro0, ro1;
    const bf16_t* obase = (const bf16_t*)(ws + WS_OMF) + (size_t)(b * SEQ) * HG_W + h * 128;
#define HG_LOAD(t0_) do { const bf16_t* p0_ = base + (size_t)((t0_) + lr) * PROJ_LD + lc; const bf16_t* p1_ = p0_ + (size_t)32 * PROJ_LD; \
        rf0 = *(const u32x4*)(p0_ + C_HF); rf1 = *(const u32x4*)(p1_ + C_HF); rq0 = *(const u32x4*)(p0_ + C_HQ); rq1 = *(const u32x4*)(p1_ + C_HQ); \
        ri0 = *(const u32x4*)(p0_ + C_HI); ri1 = *(const u32x4*)(p1_ + C_HI); \
        ro0 = *(const u32x4*)(obase + (size_t)((t0_) + lr) * HG_W + lc); ro1 = *(const u32x4*)(obase + (size_t)((t0_) + lr + 32) * HG_W + lc); } while (0)
    HG_LOAD(0);
    const float ngv = a.in[I_HGNG][vq * 32 + r32];
    for (int c = 0; c < SEQ / 64; ++c) {
        const int t0 = c * 64;
        *(LAS u32x4*)(lds + T_FR + lr * 256 + lc * 2) = rf0; *(LAS u32x4*)(lds + T_FR + (lr + 32) * 256 + lc * 2) = rf1;
        *(LAS u32x4*)(lds + T_QR + lr * 256 + lc * 2) = rq0; *(LAS u32x4*)(lds + T_QR + (lr + 32) * 256 + lc * 2) = rq1;
        *(LAS u32x4*)(lds + T_OR + lr * 256 + lc * 2) = ro0; *(LAS u32x4*)(lds + T_OR + (lr + 32) * 256 + lc * 2) = ro1;
        *(LAS u32x4*)(lds + T_V + v_st(lr, lc)) = ri0; *(LAS u32x4*)(lds + T_V + v_st(lr + 32, lc)) = ri1;
        __syncthreads();
        float lf0[8], lf1[8]; float run0 = 0.f, run1 = 0.f;
#pragma unroll
        for (int i = 0; i < 8; ++i) { const int t = tg * 8 + i; const unsigned w = *(const LAS unsigned*)(lds + T_FR + t * 256 + kp * 4);
            run0 += __uint_as_float(w << 16); run1 += __uint_as_float(w & 0xffff0000u); lf0[i] = run0; lf1[i] = run1; }
        *(LAS f32x2*)(part + tg * 128 + 2 * kp) = (f32x2){run0, run1};
        __syncthreads();
        { float pre0 = 0.f, pre1 = 0.f, tot0 = 0.f, tot1 = 0.f;
#pragma unroll
          for (int gq = 0; gq < 8; ++gq) { const f32x2 pv = *(const LAS f32x2*)(part + gq * 128 + 2 * kp); tot0 += pv[0]; tot1 += pv[1]; if (gq < tg) { pre0 += pv[0]; pre1 += pv[1]; } }
          const float dlast0 = __builtin_amdgcn_exp2f(tot0), dlast1 = __builtin_amdgcn_exp2f(tot1);
          if (tg == 0) *(LAS f32x2*)(dl + 2 * kp) = (f32x2){dlast0, dlast1};
#pragma unroll
          for (int i = 0; i < 8; ++i) { const int t = tg * 8 + i; const float bb0 = pre0 + lf0[i], bb1 = pre1 + lf1[i];
              const unsigned qw = *(const LAS unsigned*)(lds + T_QR + t * 256 + kp * 4), ow = *(const LAS unsigned*)(lds + T_OR + t * 256 + kp * 4);
              const float qd0 = __uint_as_float(qw << 16) * __builtin_amdgcn_exp2f(bb0), qd1 = __uint_as_float(qw & 0xffff0000u) * __builtin_amdgcn_exp2f(bb1);
              const float kd0 = __uint_as_float(ow << 16) * __builtin_amdgcn_exp2f(-bb0), kd1 = __uint_as_float(ow & 0xffff0000u) * __builtin_amdgcn_exp2f(-bb1);
              const int ko = AT_KSWZ(t, kp * 4);
              *(LAS unsigned*)(lds + T_QD + ko) = cvt_pk_bf16(qd0, qd1); *(LAS unsigned*)(lds + T_KD + ko) = cvt_pk_bf16(kd0, kd1);
              *(LAS unsigned*)(lds + T_KL + v_st(t, 2 * kp)) = cvt_pk_bf16(kd0 * dlast0, kd1 * dlast1); } }
        __syncthreads();
        if (c + 1 < SEQ / 64) HG_LOAD(t0 + 64);
        const int tl = th * 32 + r32;
        bf16x8 qr[8];
#pragma unroll
        for (int d0 = 0; d0 < 8; ++d0) qr[d0] = *(const LAS bf16x8*)(lds + T_QD + AT_KSWZ(tl, (d0 * 16 + hi * 8) * 2));
        bf16x8 pa0, pa1, pa2, pa3;
        if (th == 0) {
            f32x16 p0;
#pragma unroll
            for (int r = 0; r < 16; ++r) p0[r] = 0.f;
#pragma unroll
            for (int d0 = 0; d0 < 8; ++d0) { const bf16x8 b0 = *(const LAS bf16x8*)(lds + T_KD + AT_KSWZ(r32, (d0 * 16 + hi * 8) * 2)); p0 = __builtin_amdgcn_mfma_f32_32x32x16_bf16(b0, qr[d0], p0, 0, 0, 0); }
#pragma unroll
            for (int r = 0; r < 16; ++r) { const int s = crow(r, hi); if (s > tl) p0[r] = 0.f; }
            at::pack_p(p0, pa0, pa1); pa2 = (bf16x8){0, 0, 0, 0, 0, 0, 0, 0}; pa3 = pa2;
        } else {
            f32x16 p0, p1;
            at::qkt(p0, p1, lds + T_KD, r32, hi, qr);
#pragma unroll
            for (int r = 0; r < 16; ++r) { const int s = crow(r, hi); if (s + 32 > tl) p1[r] = 0.f; }
            at::pack_p(p0, pa0, pa1); at::pack_p(p1, pa2, pa3);
        }
        f32x16 o;
#pragma unroll
        for (int r = 0; r < 16; ++r) o[r] = 0.f;
        const int vb = (int)(uintptr_t)(lds + T_V) + v_rd_base(lane) + vq * 512;
        const int klb = (int)(uintptr_t)(lds + T_KL) + v_rd_base(lane);
#define HG_TRRD(dst, addr, off) asm volatile("ds_read_b64_tr_b16 %0, %1 offset:%2" : "=&v"(dst) : "v"(addr), "i"(off) : "memory")
        s16x4 vl0, vh0, vl1, vh1, vl2, vh2, vl3, vh3;
        HG_TRRD(vl0, vb, 0); HG_TRRD(vh0, vb, 2048); HG_TRRD(vl1, vb, 4096); HG_TRRD(vh1, vb, 6144); HG_TRRD(vl2, vb, 8192); HG_TRRD(vh2, vb, 10240); HG_TRRD(vl3, vb, 12288); HG_TRRD(vh3, vb, 14336);
        asm volatile("s_waitcnt lgkmcnt(0)" ::: "memory"); __builtin_amdgcn_sched_barrier(0);
        const bf16x8 vf0 = (bf16x8){vl0[0], vl0[1], vl0[2], vl0[3], vh0[0], vh0[1], vh0[2], vh0[3]}, vf1 = (bf16x8){vl1[0], vl1[1], vl1[2], vl1[3], vh1[0], vh1[1], vh1[2], vh1[3]};
        const bf16x8 vf2 = (bf16x8){vl2[0], vl2[1], vl2[2], vl2[3], vh2[0], vh2[1], vh2[2], vh2[3]}, vf3 = (bf16x8){vl3[0], vl3[1], vl3[2], vl3[3], vh3[0], vh3[1], vh3[2], vh3[3]};
        o = __builtin_amdgcn_mfma_f32_32x32x16_bf16(pa0, vf0, o, 0, 0, 0); o = __builtin_amdgcn_mfma_f32_32x32x16_bf16(pa1, vf1, o, 0, 0, 0);
        o = __builtin_amdgcn_mfma_f32_32x32x16_bf16(pa2, vf2, o, 0, 0, 0); o = __builtin_amdgcn_mfma_f32_32x32x16_bf16(pa3, vf3, o, 0, 0, 0);
#pragma unroll
        for (int kb = 0; kb < 4; ++kb)
#pragma unroll
            for (int sp = 0; sp < 2; ++sp) {
                const u32x2 a_lo = *(const LAS u32x2*)(lds + T_QD + tl * 256 + ((((4 * kb + 2 * sp) * 16)) ^ ((tl & 7) << 4)) + 8 * hi);
                const u32x2 a_hi = *(const LAS u32x2*)(lds + T_QD + tl * 256 + ((((4 * kb + 2 * sp + 1) * 16)) ^ ((tl & 7) << 4)) + 8 * hi);
                u32x4 aw = {a_lo[0], a_lo[1], a_hi[0], a_hi[1]};
                u32x4 bw = {cvt_pk_bf16(Sacc[kb][8 * sp + 0], Sacc[kb][8 * sp + 1]), cvt_pk_bf16(Sacc[kb][8 * sp + 2], Sacc[kb][8 * sp + 3]),
                            cvt_pk_bf16(Sacc[kb][8 * sp + 4], Sacc[kb][8 * sp + 5]), cvt_pk_bf16(Sacc[kb][8 * sp + 6], Sacc[kb][8 * sp + 7])};
                o = __builtin_amdgcn_mfma_f32_32x32x16_bf16(*reinterpret_cast<bf16x8*>(&aw), *reinterpret_cast<bf16x8*>(&bw), o, 0, 0, 0); }
        float gt[16];
#pragma unroll
        for (int r = 0; r < 16; ++r) gt[r] = bf2f(base[(size_t)(t0 + th * 32 + crow(r, hi)) * PROJ_LD + C_HGT + vq * 32 + r32]);
#define HG_SUPD(kb) do { \
            _Pragma("unroll") for (int i4 = 0; i4 < 4; ++i4) { const f32x4 dv = *(const LAS f32x4*)(dl + (kb) * 32 + 8 * i4 + 4 * hi); \
                Sacc[kb][4 * i4] *= dv[0]; Sacc[kb][4 * i4 + 1] *= dv[1]; Sacc[kb][4 * i4 + 2] *= dv[2]; Sacc[kb][4 * i4 + 3] *= dv[3]; } \
            s16x4 al0, ah0, al1, ah1, al2, ah2, al3, ah3; \
            HG_TRRD(al0, klb, (kb) * 512); HG_TRRD(ah0, klb, (kb) * 512 + 2048); HG_TRRD(al1, klb, (kb) * 512 + 4096); HG_TRRD(ah1, klb, (kb) * 512 + 6144); \
            HG_TRRD(al2, klb, (kb) * 512 + 8192); HG_TRRD(ah2, klb, (kb) * 512 + 10240); HG_TRRD(al3, klb, (kb) * 512 + 12288); HG_TRRD(ah3, klb, (kb) * 512 + 14336); \
            asm volatile("s_waitcnt lgkmcnt(0)" ::: "memory"); __builtin_amdgcn_sched_barrier(0); \
            Sacc[kb] = __builtin_amdgcn_mfma_f32_32x32x16_bf16((bf16x8){al0[0], al0[1], al0[2], al0[3], ah0[0], ah0[1], ah0[2], ah0[3]}, vf0, Sacc[kb], 0, 0, 0); \
            Sacc[kb] = __builtin_amdgcn_mfma_f32_32x32x16_bf16((bf16x8){al1[0], al1[1], al1[2], al1[3], ah1[0], ah1[1], ah1[2], ah1[3]}, vf1, Sacc[kb], 0, 0, 0); \
            Sacc[kb] = __builtin_amdgcn_mfma_f32_32x32x16_bf16((bf16x8){al2[0], al2[1], al2[2], al2[3], ah2[0], ah2[1], ah2[2], ah2[3]}, vf2, Sacc[kb], 0, 0, 0); \
            Sacc[kb] = __builtin_amdgcn_mfma_f32_32x32x16_bf16((bf16x8){al3[0], al3[1], al3[2], al3[3], ah3[0], ah3[1], ah3[2], ah3[3]}, vf3, Sacc[kb], 0, 0, 0); } while (0)
        HG_SUPD(0); HG_SUPD(1); HG_SUPD(2); HG_SUPD(3);
#undef HG_SUPD
#undef HG_TRRD
        { float y8[8], y4[4], y2[2], y1;
          const bool b4 = (r32 & 16) != 0, b3 = (r32 & 8) != 0, b2 = (r32 & 4) != 0, b1 = (r32 & 2) != 0;
#pragma unroll
          for (int i = 0; i < 8; ++i) { const float lo = o[i] * o[i], hi_ = o[8 + i] * o[8 + i]; const float keep = b4 ? hi_ : lo, send = b4 ? lo : hi_; y8[i] = keep + __shfl_xor(send, 16); }
#pragma unroll
          for (int i = 0; i < 4; ++i) { const float keep = b3 ? y8[4 + i] : y8[i], send = b3 ? y8[i] : y8[4 + i]; y4[i] = keep + __shfl_xor(send, 8); }
#pragma unroll
          for (int i = 0; i < 2; ++i) { const float keep = b2 ? y4[2 + i] : y4[i], send = b2 ? y4[i] : y4[2 + i]; y2[i] = keep + __shfl_xor(send, 4); }
          { const float keep = b1 ? y2[1] : y2[0], send = b1 ? y2[0] : y2[1]; y1 = keep + __shfl_xor(send, 2); }
          y1 += __shfl_xor(y1, 1);
          const int rf = ((r32 >> 1) & 15);
          if ((r32 & 1) == 0) ssq[vq * 64 + th * 32 + crow(rf, hi)] = y1; }
        __syncthreads();
        { bf16_t* yb = YM + (size_t)(b * SEQ + t0 + th * 32) * DM + h * 128 + vq * 32;
          const unsigned loff = (unsigned)(4 * hi) * DM + (unsigned)r32;
          LAS float* wrs = (LAS float*)(lds + T_SSQ + 1024) + F.wid * 32;
          if (lane < 32) { const int t = th * 32 + lane; const float ss = ((ssq[t] + ssq[64 + t]) + ssq[128 + t]) + ssq[192 + t]; wrs[lane] = rsqrtf(ss * (1.f / 128.f) + EPS); }
          f32x4 rsv[4];
#pragma unroll
          for (int i = 0; i < 4; ++i) rsv[i] = *(const LAS f32x4*)(wrs + 8 * i + 4 * hi);
#pragma unroll
          for (int r = 0; r < 16; ++r) { const int tc = (r & 3) + 8 * (r >> 2);
              (yb + (size_t)tc * DM)[loff] = f2bf(o[r] * (rsv[r >> 2][r & 3] * ngv) * gt[r]); } }
    }
#undef HG_LOAD
    __syncthreads();
}

__device__ __forceinline__ void compress_fast_unit(const Frame& F, const Args& a, int u) {
    unsigned char* ws = F.ws; const bf16_t* PROJ = (const bf16_t*)(ws + WS_PROJ); LAS unsigned char* lds = F.lds;
    const int j = u >> 6, bg = (u >> 2) & 15, mt = u & 3, b = bg >> 1, g = bg & 1;
    int tz = threadIdx.x; asm volatile("" : "+v"(tz));
    const int lane = tz & 63, r32 = lane & 31, hi = lane >> 5, w = F.wid;
    const int n = mt * 32 + r32, nl = n < 126 ? n : 126;
    const bf16_t* W2T = (const bf16_t*)(ws + WS_W2T) + (size_t)j * 128 * 128;
    const int colb = (j ? C_VCM : C_KCM) + g * 128;
    const bf16_t* arow = PROJ + (size_t)(b * SEQ + 16 * nl) * PROJ_LD + colb + hi * 8;
    const bf16_t* bfrag = (const bf16_t*)(ws + WS_W1T) + ((size_t)(j * 8 + w) * 32 * 4 * 64 + lane) * 8;
    f32x16 acc[4];
#pragma unroll
    for (int c = 0; c < 4; ++c)
#pragma unroll
        for (int r = 0; r < 16; ++r) acc[c][r] = 0.f;
#pragma unroll 4
    for (int ks = 0; ks < 32; ++ks) {
        const int l = 4 * w + (ks >> 3), d = (ks & 7) * 16;
        const bf16x8 af = *(const bf16x8*)(arow + (size_t)l * PROJ_LD + d);
#pragma unroll
        for (int c = 0; c < 4; ++c) { const bf16x8 bfr = *(const bf16x8*)(bfrag + (size_t)(ks * 4 + c) * 64 * 8);
            acc[c] = __builtin_amdgcn_mfma_f32_32x32x16_bf16(af, bfr, acc[c], 0, 0, 0); }
    }
    LAS float* red = (LAS float*)lds;
#pragma unroll
    for (int c = 0; c < 4; ++c)
#pragma unroll
        for (int r = 0; r < 16; ++r) red[(w * 32 + at::crow(r, hi)) * 128 + c * 32 + r32] = acc[c][r];
    __syncthreads();
    LAS unsigned char* hdn = lds + 131072 - 8192;
    { const int nn = tz >> 4, c8 = (tz & 15) * 8; float sv[8];
      const float* b1 = (const float*)(ws + WS_B1P) + (size_t)j * 32 * 128 + c8;
#pragma unroll
      for (int i = 0; i < 8; ++i) sv[i] = 0.f;
#pragma unroll 4
      for (int kg = 0; kg < 32; ++kg) { const f32x4 x0 = *(const f32x4*)(b1 + kg * 128), x1 = *(const f32x4*)(b1 + kg * 128 + 4);
#pragma unroll
          for (int i = 0; i < 4; ++i) { sv[i] += x0[i]; sv[4 + i] += x1[i]; } }
#pragma unroll
      for (int ww = 0; ww < 8; ++ww) { const f32x4 x0 = *(const LAS f32x4*)(red + (ww * 32 + nn) * 128 + c8), x1 = *(const LAS f32x4*)(red + (ww * 32 + nn) * 128 + c8 + 4);
#pragma unroll
          for (int i = 0; i < 4; ++i) { sv[i] += x0[i]; sv[4 + i] += x1[i]; } }
      __syncthreads();
#pragma unroll
      for (int i = 0; i < 8; ++i) sv[i] = gelu_tanh(sv[i]);
      u32x4 pw; pw[0] = cvt_pk_bf16(sv[0], sv[1]); pw[1] = cvt_pk_bf16(sv[2], sv[3]); pw[2] = cvt_pk_bf16(sv[4], sv[5]); pw[3] = cvt_pk_bf16(sv[6], sv[7]);
      *(LAS u32x4*)(hdn + AT_KSWZ(nn, c8 * 2)) = pw; }
    __syncthreads();
    if (w < 4) {
        f32x16 o2;
#pragma unroll
        for (int r = 0; r < 16; ++r) o2[r] = 0.f;
#pragma unroll
        for (int ks = 0; ks < 8; ++ks) { const bf16x8 af = *(const LAS bf16x8*)(hdn + AT_KSWZ(r32, (ks * 16 + hi * 8) * 2));
            const bf16x8 bfr = *(const bf16x8*)(W2T + (size_t)(w * 32 + r32) * 128 + ks * 16 + hi * 8);
            o2 = __builtin_amdgcn_mfma_f32_32x32x16_bf16(af, bfr, o2, 0, 0, 0); }
        bf16_t* dst = (bf16_t*)(ws + (DEBUG_CMP ? (j ? WS_Y + 1048576 : WS_Y) : (j ? WS_VC : WS_KC))) + (size_t)bg * 128 * 128;
#pragma unroll
        for (int r = 0; r < 16; ++r) { const int nn = mt * 32 + at::crow(r, hi); dst[(size_t)nn * 128 + w * 32 + r32] = (nn < NCMP) ? f2bf(o2[r]) : (bf16_t)0; }
    }
    __syncthreads();
}

__device__ __forceinline__ void p5_router(const Frame& F, const Args& a) {
    unsigned char* ws = F.ws; const bf16_t* H1 = (const bf16_t*)(ws + WS_H1); unsigned char* XN = ws + WS_U;
    const float* wr2 = (const float*)(ws + WS_WR2); const float* g2 = a.in[I_N2G]; const float* br = a.in[I_BR];
    float* tokw = (float*)(ws + WS_TOKW); int* slot = (int*)(ws + WS_SLOT); unsigned* cnt = F.ctl + CW_CNT;
    constexpr int HS_LD = 4104;
    LAS unsigned char* hs = F.lds; LAS float* rsv = (LAS float*)(F.lds + 32 * HS_LD); LAS float* red = (LAS float*)F.lds;
    LAS unsigned* lcnt = (LAS unsigned*)(F.lds + 32 * HS_LD + 256); LAS unsigned* lbase = lcnt + 32;
    if (F.tid < 32) lcnt[F.tid] = 0u;
    int myexp[2] = {0, 0}, myrank[2] = {0, 0};
    __syncthreads();
    for (int it = F.bid; it < NTOK / 32; it += F.G) {
#pragma unroll
        for (int rr = 0; rr < 4; ++rr) { const int tl = F.wid * 4 + rr, row = it * 32 + tl;
            const bf16_t* hr = H1 + (size_t)row * DM; u32x4 hw[4]; float ss = 0.f;
#pragma unroll
            for (int i = 0; i < 4; ++i) { hw[i] = *(const u32x4*)(hr + i * 512 + F.lane * 8); float hf[8]; unpack8(hw[i], hf);
#pragma unroll
                for (int j = 0; j < 8; ++j) ss += hf[j] * hf[j]; }
            ss = wave_sum(ss); const float rs = rsqrtf(ss * (1.f / DM) + EPS);
            if (F.lane == 0) rsv[tl] = rs;
#pragma unroll
            for (int i = 0; i < 4; ++i) { const f32x4 g0 = *(const f32x4*)(g2 + i * 512 + F.lane * 8), g1 = *(const f32x4*)(g2 + i * 512 + F.lane * 8 + 4);
                float hf[8]; unpack8(hw[i], hf);
                const f32x4 a0 = (f32x4){hf[0], hf[1], hf[2], hf[3]} * rs * g0, a1 = (f32x4){hf[4], hf[5], hf[6], hf[7]} * rs * g1;
                u32x2 w; w[0] = cvt4_fp8(a0[0], a0[1], a0[2], a0[3]); w[1] = cvt4_fp8(a1[0], a1[1], a1[2], a1[3]);
                *(u32x2*)(XN + (size_t)row * DM + i * 512 + F.lane * 8) = w;
                LAS unsigned char* hp = hs + tl * HS_LD + (i * 512 + F.lane * 8) * 2;
                *(LAS u32x2*)hp = (u32x2){hw[i][0], hw[i][1]}; *(LAS u32x2*)(hp + 8) = (u32x2){hw[i][2], hw[i][3]}; } }
        __syncthreads();
        f32x4 c00 = {0.f, 0.f, 0.f, 0.f}, c01 = c00, c10 = c00, c11 = c00;
        { const int ti = F.lane & 15, kq = F.lane >> 4, kb = F.wid * 256 + kq;
          const LAS unsigned char* ha = hs + ti * HS_LD + kb * 2; const float* wb = wr2 + (size_t)kb * 32 + ti;
#pragma unroll 16
          for (int s_ = 0; s_ < 64; ++s_) {
              const float a0 = bf2f(*(const LAS bf16_t*)(ha + s_ * 8)), a1 = bf2f(*(const LAS bf16_t*)(ha + 16 * HS_LD + s_ * 8));
              const float b0 = wb[(size_t)s_ * 128], b1 = wb[(size_t)s_ * 128 + 16];
              c00 = __builtin_amdgcn_mfma_f32_16x16x4f32(a0, b0, c00, 0, 0, 0); c01 = __builtin_amdgcn_mfma_f32_16x16x4f32(a0, b1, c01, 0, 0, 0);
              c10 = __builtin_amdgcn_mfma_f32_16x16x4f32(a1, b0, c10, 0, 0, 0); c11 = __builtin_amdgcn_mfma_f32_16x16x4f32(a1, b1, c11, 0, 0, 0); } }
        float rsl[2];
        rsl[0] = rsv[F.tid >> 5]; rsl[1] = rsv[16 + (F.tid >> 5)];
        __syncthreads();
        { const int cj = F.lane & 15, rq = (F.lane >> 4) * 4; LAS float* rw = red + F.wid * 1024;
#pragma unroll
          for (int r = 0; r < 4; ++r) { rw[(rq + r) * 32 + cj] = c00[r]; rw[(rq + r) * 32 + 16 + cj] = c01[r]; rw[(16 + rq + r) * 32 + cj] = c10[r]; rw[(16 + rq + r) * 32 + 16 + cj] = c11[r]; } }
        __syncthreads();
#pragma unroll
        for (int ps = 0; ps < 2; ++ps) {
            const int tl = ps * 16 + (F.tid >> 5), e = F.tid & 31, row = it * 32 + tl;
            float acc = 0.f;
#pragma unroll
            for (int w = 0; w < 8; ++w) acc += red[w * 1024 + tl * 32 + e];
            const float logit = acc * rsl[ps] + br[e];
            float tv[4]; int ti[4]; float cur = logit;
#pragma unroll
            for (int k = 0; k < 4; ++k) { float bv = cur; int bi = e;
#pragma unroll
                for (int o = 16; o > 0; o >>= 1) { const float ov = __shfl_xor(bv, o); const int oi = __shfl_xor(bi, o); if (ov > bv || (ov == bv && oi < bi)) { bv = ov; bi = oi; } }
                tv[k] = bv; ti[k] = bi; if (e == bi) cur = -INFINITY; }
            const float m = tv[0]; const float e0 = 1.f, e1 = __expf(tv[1] - m), e2 = __expf(tv[2] - m), e3 = __expf(tv[3] - m); const float inv = 1.f / (e0 + e1 + e2 + e3);
            if (e < 4) { const int k = e; const int ee = k == 0 ? ti[0] : k == 1 ? ti[1] : k == 2 ? ti[2] : ti[3]; const float w = (k == 0 ? e0 : k == 1 ? e1 : k == 2 ? e2 : e3) * inv;
                tokw[(size_t)row * 4 + k] = w;
                myexp[ps] = ee; myrank[ps] = (int)__hip_atomic_fetch_add(lcnt + ee, 1u, __ATOMIC_RELAXED, __HIP_MEMORY_SCOPE_WORKGROUP); } }
        __syncthreads();
        if (F.tid < 32) { const unsigned c = lcnt[F.tid]; lbase[F.tid] = c ? atomicAdd(&cnt[F.tid], c) : 0u; lcnt[F.tid] = 0u; }
        __syncthreads();
#pragma unroll
        for (int ps = 0; ps < 2; ++ps) { const int e = F.tid & 31; if (e < 4) { const int row = it * 32 + ps * 16 + (F.tid >> 5);
                slot[(size_t)myexp[ps] * NTOK + lbase[myexp[ps]] + myrank[ps]] = row * 4 + e; } }
        __syncthreads();
    }
}

__device__ __forceinline__ void moe_build_tiles(const Frame& F, LAS int* tstart, LAS int* cntl, LAS int* tstartB) {
    if (F.tid < NEXP) cntl[F.tid] = (int)__hip_atomic_load(F.ctl + CW_CNT + F.tid, __ATOMIC_RELAXED, __HIP_MEMORY_SCOPE_AGENT);
    __syncthreads();
    if (F.tid == 0) { int acc = 0, accb = 0; for (int e = 0; e < NEXP; ++e) { const int c = cntl[e]; const int rem = c & 255;
            tstart[e] = acc; tstartB[e] = accb; acc += (c >> 8) + (rem > 128 ? 1 : 0); accb += (rem >= 1 && rem <= 128) ? 1 : 0; } tstart[NEXP] = acc; tstartB[NEXP] = accb; }
    if (F.tid < 64) { const int sh = amax_shift(__hip_atomic_load(F.ctl + CW_AMAX + F.tid, __ATOMIC_RELAXED, __HIP_MEMORY_SCOPE_AGENT)); const unsigned b_ = (unsigned)(127 - sh) & 0xffu;
        cntl[40 + F.tid] = (int)(b_ | (b_ << 8) | (b_ << 16) | (b_ << 24)); }
    __syncthreads();
}

__device__ __forceinline__ void p9_combine(const Frame& F, const Args& a) {
    unsigned char* ws = F.ws; const bf16_t* H1 = (const bf16_t*)(ws + WS_H1); const unsigned char* Y = ws + WS_Y;
    const float* tokw = (const float*)(ws + WS_TOKW); const float* gf = a.in[I_FNG]; float* out = a.out;
    int tz = threadIdx.x; asm volatile("" : "+v"(tz));
    const int lane_ = tz & 63;
    for (int row = F.bid * 8 + F.wid; row < NTOK; row += F.G * 8) {
        const bf16_t* hr = H1 + (size_t)row * DM; f32x4 v[8]; float ss = 0.f;
        const f32x4 w4 = *(const f32x4*)(tokw + (size_t)row * 4);
#pragma unroll
        for (int i = 0; i < 4; ++i) { const int c0 = i * 512 + lane_ * 8; { const u32x4 hw = *(const u32x4*)(hr + c0); float hf[8]; unpack8(hw, hf);
                v[2 * i] = (f32x4){hf[0], hf[1], hf[2], hf[3]}; v[2 * i + 1] = (f32x4){hf[4], hf[5], hf[6], hf[7]}; }
#pragma unroll
            for (int k = 0; k < 4; ++k) { const u32x2 yw = *(const u32x2*)(Y + ((size_t)row * 4 + k) * DM + c0); float f[8];
                { const f32x2 t0 = __builtin_amdgcn_cvt_pk_f32_fp8(yw[0], false), t1 = __builtin_amdgcn_cvt_pk_f32_fp8(yw[0], true), t2 = __builtin_amdgcn_cvt_pk_f32_fp8(yw[1], false), t3 = __builtin_amdgcn_cvt_pk_f32_fp8(yw[1], true);
                  f[0] = t0[0]; f[1] = t0[1]; f[2] = t1[0]; f[3] = t1[1]; f[4] = t2[0]; f[5] = t2[1]; f[6] = t3[0]; f[7] = t3[1]; }
#pragma unroll
                for (int j = 0; j < 4; ++j) { v[2 * i][j] += w4[k] * f[j]; v[2 * i + 1][j] += w4[k] * f[4 + j]; } }
#pragma unroll
            for (int j = 0; j < 4; ++j) ss += v[2 * i][j] * v[2 * i][j] + v[2 * i + 1][j] * v[2 * i + 1][j]; }
        ss = wave_sum(ss); const float rs = rsqrtf(ss * (1.f / DM) + EPS);
#pragma unroll
        for (int i = 0; i < 4; ++i) { const int c0 = i * 512 + lane_ * 8; const f32x4 g0 = *(const f32x4*)(gf + c0), g1 = *(const f32x4*)(gf + c0 + 4);
            *(f32x4*)(out + (size_t)row * DM + c0) = v[2 * i] * rs * g0; *(f32x4*)(out + (size_t)row * DM + c0 + 4) = v[2 * i + 1] * rs * g1; }
    }
}

#if DEBUG_CMP
__device__ __noinline__ void dbg_compare(unsigned char* ws, unsigned* ctl, LAS unsigned char* lds) {
    const int tid = threadIdx.x, lane = tid & 63, wid = tid >> 6;
    float mx = 0.f, md = 0.f; const bf16_t* r0 = (const bf16_t*)(ws + WS_KC); const bf16_t* r1 = (const bf16_t*)(ws + WS_Y);
    for (int i = tid; i < 2 * 16 * 128 * 128; i += NTHREADS) { const float x = bf2f(i < 262144 ? r0[i] : ((const bf16_t*)(ws + WS_VC))[i - 262144]); const float y = bf2f(i < 262144 ? r1[i] : ((const bf16_t*)(ws + WS_Y + 1048576))[i - 262144]);
        mx = fmaxf(mx, fabsf(x)); md = fmaxf(md, fabsf(x - y)); if (!(y == y)) md = 1e30f; }
    mx = wave_max(mx); md = wave_max(md); LAS float* t2 = (LAS float*)lds; if (lane == 0) { t2[wid] = mx; t2[8 + wid] = md; } __syncthreads();
    if (tid == 0) { float a1 = 0.f, a2 = 0.f; for (int i = 0; i < 8; ++i) { a1 = fmaxf(a1, t2[i]); a2 = fmaxf(a2, t2[8 + i]); }
        const float rel = a2 / fmaxf(a1, 1e-20f); int code = 0;
        if (rel >= 1.f) code = 10; else if (rel >= 0.3f) code = 11; else if (rel >= 0.1f) code = 12; else if (rel >= 0.03f) code = 13; else if (rel >= 0.01f) code = 14; else if (rel >= 0.003f) code = 15;
        if (blockIdx.x == 0) ctl[CW_ERR] = (unsigned)code; }
    __syncthreads();
}
#endif
constexpr int N_PHASES = 9;
extern "C" __global__ void __launch_bounds__(NTHREADS, 2) fwd(Args args) {
    extern __shared__ __attribute__((aligned(16))) unsigned char shm[];
    LAS unsigned char* lds = (LAS unsigned char*)shm;
    Frame F; F.lds = lds; F.ws = args.ws; F.ctl = (unsigned*)(args.ws + WS_CTL);
    F.tid = threadIdx.x; F.wid = __builtin_amdgcn_readfirstlane(F.tid >> 6); F.lane = F.tid & 63; F.G = gridDim.x; F.bid = blockIdx.x;
    LAS unsigned* misc = (LAS unsigned*)(lds + LDS_MISC);
    if (F.tid < 4) misc[F.tid] = 0u;
    __syncthreads();
    const int lo = args.ph_lo, hi = args.ph_hi;
    XcdBarrier bar; bar.bar = F.ctl; bar.x = 0; bar.st = nullptr;
    if (hi - lo > 1) bar = xcd_barrier_post(F.ctl, (volatile LAS unsigned*)misc);
#define IN(k) (lo <= (k) && (k) < hi)
#define SEAM(k) do { if (IN(k) && IN((k) + 1)) xcd_barrier(bar); } while (0)
    unsigned char* ws = args.ws;

    if (IN(0)) { p0_prologue(F, args); }
#if (REP_MASK >> 0) & 1
    if (IN(0)) { p0_prologue(F, args); }
#endif
    SEAM(0);
    if (IN(1)) {
        const int gi = F.bid >> 3, g8i = gi & 7; const bool split = (F.G == 256), conv = split && (g8i == 2 || g8i == 5 || g8i == 7);
        if (conv) { const int crank = ((gi >> 3) * 3 + (g8i == 2 ? 0 : (g8i == 5 ? 1 : 2))) * 8 + (F.bid & 7); conv_experts(F, args, CONV_P2 + crank, 96, 12288); bias1_partials(F, args, crank, 96); }
        else {
            const int grank = (gi >> 3) * 5 + (g8i < 2 ? g8i : (g8i < 5 ? g8i - 1 : 4));
            g8::DenseSched<DM, DM> S; S.init(ws + WS_U, ws + WS_WINT, NTOK, PROJ_LD, split ? 160 : F.G, split ? grank * 8 + (F.bid & 7) : F.bid);
            g8::EpiProj E{(bf16_t*)(ws + WS_PROJ), PROJ_LD, (bf16_t*)(ws + WS_OMF), (const float*)(ws + WS_LB)};
            g8::gemm_phase(lds, S, E);
            if (!split) { conv_experts(F, args, CONV_P2 + F.bid, F.G, 12288); bias1_partials(F, args, F.bid, F.G); }
            else { const int c = grank * 8 + (F.bid & 7);
                if (c >= 128) conv_experts(F, args, CONV_P0 + (c - 128), 32, CONV_P0 + CONV_SPARE); }
        }
    }
#if (REP_MASK >> 1) & 1
    if (IN(1)) {
        g8::DenseSched<DM, DM> S; S.init(ws + WS_U, ws + WS_WINT, NTOK, PROJ_LD, F.G, F.bid);
        g8::EpiProj E{(bf16_t*)(ws + WS_PROJ), PROJ_LD, (bf16_t*)(ws + WS_OMF), (const float*)(ws + WS_LB)};
        g8::gemm_phase(lds, S, E);
    }
#endif
    SEAM(1);
    if (IN(2) || IN(3)) {
        constexpr int CW_CDONE = 4800, CW_CONVQ = 4864;
        constexpr int CONV_QB = 8, CONV_QBASE = CONV_P0 + CONV_SPARE, CONV_NBATCH = (CONV_P2 - CONV_QBASE) / CONV_QB;
        static_assert((CONV_P2 - CONV_QBASE) % CONV_QB == 0, "conversion queue: whole batches");
        const bool big = (F.G == 256);
        if (big) {
            if (F.bid < 64) hgrn_fast_unit(F, args, F.bid);
            else if (F.bid < 192) { compress_fast_unit(F, args, F.bid - 64);
                asm volatile("s_waitcnt vmcnt(0)" ::: "memory"); __syncthreads();
                if (F.tid == 0) { __builtin_amdgcn_fence(__ATOMIC_RELEASE, "agent"); asm volatile("s_waitcnt vmcnt(0)" ::: "memory"); (void)xb_add(F.ctl + CW_CDONE, 1u); }
            }
            else {
                for (;;) { if (F.tid == 0) misc[9] = (xb_ld(F.ctl + CW_CDONE) >= 128u) ? 0xffffffffu : atomicAdd(F.ctl + CW_CONVQ, 1u);
                    __syncthreads();
                    const unsigned qi = misc[9];
                    if (qi >= (unsigned)CONV_NBATCH) break;
                    conv_experts(F, args, CONV_QBASE + (int)qi * CONV_QB, 1, CONV_QBASE + ((int)qi + 1) * CONV_QB); } }
        } else {
            for (int u = F.bid; u < 128; u += F.G) { compress_fast_unit(F, args, u); asm volatile("s_waitcnt vmcnt(0)" ::: "memory"); __syncthreads();
                if (F.tid == 0) { __builtin_amdgcn_fence(__ATOMIC_RELEASE, "agent"); asm volatile("s_waitcnt vmcnt(0)" ::: "memory"); (void)xb_add(F.ctl + CW_CDONE, 1u); } }
            conv_experts(F, args, CONV_P0 + F.bid, F.G, CONV_P2);
            if (F.bid < 64) hgrn_fast_unit(F, args, F.bid);
        }
        if (F.tid == 0) { XB_SPIN(xb_ld(F.ctl + CW_CDONE) < 128u, F.ctl); __builtin_amdgcn_fence(__ATOMIC_ACQUIRE, "agent"); asm volatile("s_waitcnt vmcnt(0)" ::: "memory"); }
        __syncthreads();
        for (;;) { if (F.tid == 0) misc[8] = atomicAdd(F.ctl + CW_QUEUE, 1u);
            __syncthreads();
            const int u = (int)misc[8];
            if (u >= BATCH * NSA_G * 32) break;
            attn_fast_unit(F, args, u); }
        if (big) for (;;) { if (F.tid == 0) misc[9] = atomicAdd(F.ctl + CW_CONVQ, 1u);
            __syncthreads();
            const unsigned qi = misc[9];
            if (qi >= (unsigned)CONV_NBATCH) break;
            conv_experts(F, args, CONV_QBASE + (int)qi * CONV_QB, 1, CONV_QBASE + ((int)qi + 1) * CONV_QB); }
    }
#if ((REP_MASK >> 2) & 1) || ((REP_MASK >> 3) & 1)
#error "phases 2 and 3 are merged: repetition not supported"
#endif
    SEAM(3);
    if (IN(4)) {
        g8::DenseSched<DM, DM> S; S.init(ws + WS_YMIX, ws + WS_WOUTT, NTOK, DM, F.G, F.bid);
        g8::EpiResBf16 E{(bf16_t*)(ws + WS_H1), args.in[I_X], DM};
        g8::gemm_phase(lds, S, E);
    }
#if (REP_MASK >> 4) & 1
    if (IN(4)) {
        g8::DenseSched<DM, DM> S; S.init(ws + WS_YMIX, ws + WS_WOUTT, NTOK, DM, F.G, F.bid);
        g8::EpiResBf16 E{(bf16_t*)(ws + WS_H1), args.in[I_X], DM};
        g8::gemm_phase(lds, S, E);
    }
#endif
    SEAM(4);
    if (IN(5)) { p5_router(F, args); }
#if (REP_MASK >> 5) & 1
    if (IN(5)) { p5_router(F, args); }
#endif
    SEAM(5);
    if (IN(6)) {
        LAS int* tstart = (LAS int*)(misc + 64); LAS int* cntl = tstart + 40; LAS int* tstartB = cntl + 104;
        moe_build_tiles(F, tstart, cntl, tstartB);
        g8::EpiGateUp E{(unsigned char*)(ws + WS_ACT), args.in[I_BGU]};
        { g8::MoeSched<16, 2, true, 0> S{(const char*)(ws + WS_U), (const char*)(ws + WS_WGUT), (const int*)(ws + WS_SLOT), args.in[I_BGU], tstart, cntl, F.G, F.bid}; g8::gemm_phase(lds, S, E); }
        { g8::MoeSched<16, 2, true, 1> S{(const char*)(ws + WS_U), (const char*)(ws + WS_WGUT), (const int*)(ws + WS_SLOT), args.in[I_BGU], tstartB, cntl, F.G, F.bid}; g8::gemm_phase(lds, S, E); }
    }
#if (REP_MASK >> 6) & 1
    if (IN(6)) {
        LAS int* tstart = (LAS int*)(misc + 64); LAS int* cntl = tstart + 40;
        moe_build_tiles(F, tstart, cntl);
        g8::MoeSched<16, 2, true> S{(const char*)(ws + WS_U), (const char*)(ws + WS_WGUT), (const int*)(ws + WS_SLOT), args.in[I_BGU], tstart, cntl, F.G, F.bid};
        g8::EpiGateUp E{(unsigned char*)(ws + WS_ACT), args.in[I_BGU]};
        g8::gemm_phase(lds, S, E);
    }
#endif
    SEAM(6);
    if (IN(7)) {
        LAS int* tstart = (LAS int*)(misc + 64); LAS int* cntl = tstart + 40; LAS int* tstartB = cntl + 104;
        moe_build_tiles(F, tstart, cntl, tstartB);
        g8::EpiDown E{ws + WS_Y, args.in[I_BD]};
        { g8::MoeSched<8, 0, false, 0> S{(const char*)(ws + WS_ACT), (const char*)(ws + WS_WDT), (const int*)(ws + WS_SLOT), args.in[I_BD], tstart, cntl, F.G, F.bid}; g8::gemm_phase(lds, S, E); }
        { g8::MoeSched<8, 0, false, 1> S{(const char*)(ws + WS_ACT), (const char*)(ws + WS_WDT), (const int*)(ws + WS_SLOT), args.in[I_BD], tstartB, cntl, F.G, F.bid}; g8::gemm_phase(lds, S, E); }
    }
#if (REP_MASK >> 7) & 1
    if (IN(7)) {
        LAS int* tstart = (LAS int*)(misc + 64); LAS int* cntl = tstart + 40;
        moe_build_tiles(F, tstart, cntl);
        g8::MoeSched<8, 0, false> S{(const char*)(ws + WS_ACT), (const char*)(ws + WS_WDT), (const int*)(ws + WS_SLOT), args.in[I_BD], tstart, cntl, F.G, F.bid};
        g8::EpiDown E{ws + WS_Y, args.in[I_BD]};
        g8::gemm_phase(lds, S, E);
    }
#endif
    SEAM(7);
    if (IN(8)) { p9_combine(F, args);
#if DEBUG_CMP
        { const unsigned code = __hip_atomic_load(F.ctl + CW_ERR, __ATOMIC_RELAXED, __HIP_MEMORY_SCOPE_AGENT);
          if (code) { const float cval = sqrtf((float)code); for (size_t i = (size_t)F.bid * NTHREADS + F.tid; i < (size_t)NTOK * DM; i += (size_t)F.G * NTHREADS) args.out[i] = cval; } }
#endif
    }
#if (REP_MASK >> 8) & 1
    if (IN(8)) { p9_combine(F, args);
#if DEBUG_CMP
        { const unsigned code = __hip_atomic_load(F.ctl + CW_ERR, __ATOMIC_RELAXED, __HIP_MEMORY_SCOPE_AGENT);
          if (code) { const float cval = sqrtf((float)code); for (size_t i = (size_t)F.bid * NTHREADS + F.tid; i < (size_t)NTOK * DM; i += (size_t)F.G * NTHREADS) args.out[i] = cval; } }
#endif
    }
#endif
#undef IN
#undef SEAM
}

extern "C" void kernel_launch(void* const* d_in, const int* in_sizes, int n_in, void* d_out, int out_size, void* d_ws, size_t ws_size, hipStream_t stream) {
    static int grid = 0;
    if (grid == 0) {
        if (n_in != 18 || ws_size < WS_END) { fprintf(stderr, "kernel_launch: n_in %d ws %zu (need %zu)\n", n_in, ws_size, (size_t)WS_END); grid = -1; return; }
        int dev = 0, cus = 0, per_cu = 0;
        if (hipGetDevice(&dev) != hipSuccess || hipDeviceGetAttribute(&cus, hipDeviceAttributeMultiprocessorCount, dev) != hipSuccess) { grid = -1; return; }
        if (hipFuncSetAttribute((const void*)fwd, hipFuncAttributeMaxDynamicSharedMemorySize, LDS_BYTES) != hipSuccess) { fprintf(stderr, "kernel_launch: hipFuncSetAttribute failed\n"); grid = -1; return; }
        if (hipOccupancyMaxActiveBlocksPerMultiprocessor(&per_cu, (const void*)fwd, NTHREADS, LDS_BYTES) != hipSuccess || per_cu < 1) { fprintf(stderr, "kernel_launch: occupancy query says %d\n", per_cu); }
        (void)hipGetLastError();
        grid = cus;
    }
    if (grid < 0) return;
    (void)hipMemsetAsync((char*)d_ws + WS_CTL, 0, CTL_BYTES, stream);
    Args a{};
    for (int i = 0; i < 18; ++i) a.in[i] = (const float*)d_in[i];
    a.out = (float*)d_out; a.ws = (unsigned char*)d_ws;
#if N_LAUNCH_PER_PHASE
    for (int p = 0; p < N_PHASES; ++p) { a.ph_lo = p; a.ph_hi = p + 1; hipLaunchKernelGGL(fwd, dim3(grid), dim3(NTHREADS), LDS_BYTES, stream, a); }
#else
    a.ph_lo = 0; a.ph_hi = N_PHASES; hipLaunchKernelGGL(fwd, dim3(grid), dim3(NTHREADS), LDS_BYTES, stream, a);
#endif
}
```

```cpp
#include <hip/hip_runtime.h>
#include <stdint.h>
#include <stdio.h>

#ifndef N_LAUNCH_PER_PHASE
#define N_LAUNCH_PER_PHASE 0
#endif

#define DEBUG_CMP 0
#ifndef REP_MASK
#define REP_MASK 0
#endif
#define LAS __attribute__((address_space(3)))
typedef unsigned short bf16_t;
typedef short bf16x8 __attribute__((ext_vector_type(8)));
typedef float f32x4 __attribute__((ext_vector_type(4)));
typedef float f32x2 __attribute__((ext_vector_type(2)));
typedef float f32x16 __attribute__((ext_vector_type(16)));
typedef unsigned u32x4 __attribute__((ext_vector_type(4)));
typedef unsigned u32x2 __attribute__((ext_vector_type(2)));
typedef int i32x8 __attribute__((ext_vector_type(8)));

constexpr int BATCH = 8, SEQ = 2048, NTOK = BATCH * SEQ, DM = 2048;
constexpr int HG_W = 1024, HG_H = 8, HG_DK = 128, HG_DV = 128;
constexpr int NSA_H = 8, NSA_G = 2, NSA_R = 4, HD = 128, KVW = 256;
constexpr int IN_COLS = 6680, PROJ_LD = 6912;
constexpr int C_HQ = 0, C_HF = 1024, C_HI = 2048, C_HGT = 3072, C_NQ = 4096, C_KCM = 5120, C_VCM = 5376, C_KSL = 5632, C_VSL = 5888, C_KWN = 6144, C_VWN = 6400, C_NGT = 6656;
constexpr int NCMP = 127, NSEL = 32, SEL_TOP = 16, WINDOW = 512;
constexpr int NEXP = 32, TOPK = 4, DFF = 2048, NASG = NTOK * TOPK;
constexpr float EPS = 1e-6f;
constexpr int NTHREADS = 512;
constexpr int CONV_SPARE = 256;
constexpr int CONV_P0 = 0, CONV_P2 = 2048;

constexpr size_t al256(size_t x) { return (x + 255) & ~(size_t)255; }
constexpr size_t WS_CTL = 0, CTL_BYTES = 65536;
constexpr size_t WS_WINT = WS_CTL + CTL_BYTES;
constexpr size_t WS_WOUTT = WS_WINT + (size_t)PROJ_LD * DM * 2;
constexpr size_t WS_WGUT = WS_WOUTT + (size_t)DM * DM * 2;
constexpr size_t WS_WDT = WS_WGUT + (size_t)NEXP * 2 * DFF * DM * 2;
constexpr size_t WS_W1T = WS_WDT + (size_t)NEXP * DM * DFF * 2;
constexpr size_t WS_W2T = WS_W1T + (size_t)2 * 128 * 4096 * 2;
constexpr size_t WS_BIAS1 = WS_W2T + (size_t)2 * 128 * 128 * 2;
constexpr size_t WS_WR2 = WS_BIAS1 + 1024;
constexpr size_t WS_LB = WS_WR2 + (size_t)DM * NEXP * 4;
constexpr size_t WS_U = WS_LB + 4096;
constexpr size_t WS_PROJ = WS_U + (size_t)NTOK * DM * 2;
constexpr size_t WS_KC = WS_PROJ + (size_t)(NTOK + 64) * PROJ_LD * 2;
constexpr size_t WS_VC = WS_KC + (size_t)16 * 128 * 128 * 2;
constexpr size_t WS_YMIX = WS_VC + (size_t)16 * 128 * 128 * 2;
constexpr size_t WS_H1 = WS_YMIX + (size_t)NTOK * DM * 2;
constexpr size_t WS_TOKW = WS_H1 + (size_t)NTOK * DM * 4;
constexpr size_t WS_SLOT = WS_TOKW + (size_t)NTOK * 4 * 4;
constexpr size_t WS_ACT = WS_SLOT + (size_t)NEXP * NTOK * 4;
constexpr size_t WS_Y = WS_ACT + (size_t)NASG * DFF * 2;
constexpr size_t WS_OT = WS_Y + (size_t)NASG * DM * 2;
constexpr size_t WS_OMF = WS_OT + (size_t)256 * 64 * 512 * 4;
constexpr size_t WS_B1P = WS_OMF + (size_t)NTOK * HG_W * 2;
constexpr size_t WS_END = WS_B1P + (size_t)2 * 32 * 128 * 4;
constexpr int CW_CNT = 4096, CW_QUEUE = 4160, CW_ERR = 4224, CW_AMAX = 4544;

__device__ __forceinline__ float bf2f(bf16_t b) { return __uint_as_float(((unsigned)b) << 16); }
typedef __bf16 bf16v2_t __attribute__((ext_vector_type(2)));
__device__ __forceinline__ unsigned cvt_pk_bf16(float lo, float hi) { f32x2 v = {lo, hi}; bf16v2_t r = __builtin_convertvector(v, bf16v2_t); return __builtin_bit_cast(unsigned, r); }
__device__ __forceinline__ unsigned cvt4_fp8(float a, float b, float c, float d) { unsigned w = 0u; w = __builtin_amdgcn_cvt_pk_fp8_f32(a, b, w, false); w = __builtin_amdgcn_cvt_pk_fp8_f32(c, d, w, true); return w; }
__device__ __forceinline__ unsigned cvt4_bf8(float a, float b, float c, float d) { unsigned w = 0u; w = __builtin_amdgcn_cvt_pk_bf8_f32(a, b, w, false); w = __builtin_amdgcn_cvt_pk_bf8_f32(c, d, w, true); return w; }
__device__ __forceinline__ int amax_shift(unsigned bits) { if (bits == 0u) return 0; int s_ = 5 - ((int)(bits >> 23) - 127); return s_ < -60 ? -60 : (s_ > 60 ? 60 : s_); }
__device__ __forceinline__ float shift_mult(int s_) { return __uint_as_float((unsigned)(s_ + 127) << 23); }
__device__ __forceinline__ unsigned cvt4_fp8s(float a, float b, float c, float d, float m) {
    return cvt4_fp8(__builtin_amdgcn_fmed3f(a * m, -448.f, 448.f), __builtin_amdgcn_fmed3f(b * m, -448.f, 448.f), __builtin_amdgcn_fmed3f(c * m, -448.f, 448.f), __builtin_amdgcn_fmed3f(d * m, -448.f, 448.f)); }
__device__ __forceinline__ bf16_t f2bf(float f) { return (bf16_t)(cvt_pk_bf16(f, 0.f) & 0xffffu); }
__device__ __forceinline__ float sigmoidf_(float x) { return 1.f / (1.f + __expf(-x)); }
__device__ __forceinline__ float siluf_(float x) { return x * sigmoidf_(x); }
__device__ __forceinline__ float wave_sum(float v) {
#pragma unroll
    for (int o = 32; o > 0; o >>= 1) v += __shfl_xor(v, o);
    return v;
}
__device__ __forceinline__ float wave_max(float v) {
#pragma unroll
    for (int o = 32; o > 0; o >>= 1) v = fmaxf(v, __shfl_xor(v, o));
    return v;
}
__device__ __forceinline__ void unpack8(const u32x4 w, float (&f)[8]) {
#pragma unroll
    for (int i = 0; i < 4; ++i) { f[2 * i] = __uint_as_float(w[i] << 16); f[2 * i + 1] = __uint_as_float(w[i] & 0xffff0000u); }
}

#define XB_TMO      128
#define XB_XCNT(j)  (256  + 64 * (j))
#define XB_XSUB(j)  (1280 + 64 * (j))
#define XB_XGEN(j)  (2304 + 64 * (j))
#define XB_TOP      3328
#define XB_TOPGEN   3392
#define XCD_BAR_WORDS 3456
#define XB_SPIN_CAP (1u << 18)
__device__ __forceinline__ unsigned xb_ld(unsigned* p)              { return __hip_atomic_load(p, __ATOMIC_RELAXED, __HIP_MEMORY_SCOPE_AGENT); }
__device__ __forceinline__ unsigned xb_add(unsigned* p, unsigned v) { return __hip_atomic_fetch_add(p, v, __ATOMIC_RELAXED, __HIP_MEMORY_SCOPE_AGENT); }
__device__ __forceinline__ unsigned xb_xcc_id() { return (unsigned)__builtin_amdgcn_s_getreg((3 << 11) | 20) & 0xFu; }
#define XB_SPIN(cond, bar) do { unsigned _sp = 0; while (cond) { __builtin_amdgcn_s_sleep(1); \
    if ((++_sp & 255u) == 0u) { if (xb_ld(&(bar)[XB_TMO])) break; if (_sp > XB_SPIN_CAP) { atomicAdd(&(bar)[XB_TMO], 1u); break; } } } } while (0)
struct XcdBarrier { unsigned* bar; unsigned x; volatile LAS unsigned* st; };
__device__ __forceinline__ XcdBarrier xcd_barrier_post(unsigned* bar, volatile LAS unsigned* st) {
    XcdBarrier b; b.bar = bar; b.x = xb_xcc_id(); b.st = st;
    if (threadIdx.x == 0) (void)xb_add(&bar[XB_XCNT(b.x)], 1u);
    return b;
}
__device__ __forceinline__ void xcd_barrier_complete(unsigned* bar, unsigned x, unsigned& nloc, unsigned& nx) {
    const unsigned G = gridDim.x * gridDim.y * gridDim.z;
    unsigned sum, cnt, mine, sp = 0u;
    for (;;) {
        sum = 0u; cnt = 0u; mine = 0u;
#pragma unroll
        for (unsigned j = 0; j < 16; ++j) { const unsigned c = xb_ld(&bar[XB_XCNT(j)]); sum += c; cnt += (c > 0u) ? 1u : 0u; mine = (j == x) ? c : mine; }
        if (sum == G) break;
        __builtin_amdgcn_s_sleep(1);
        if ((++sp & 255u) == 0u) { if (xb_ld(&bar[XB_TMO])) break; if (sp > XB_SPIN_CAP) { atomicAdd(&bar[XB_TMO], 1u); break; } }
    }
    nloc = mine > 0u ? mine : 1u; nx = cnt > 0u ? cnt : 1u;
}
__device__ __forceinline__ void xcd_barrier(const XcdBarrier& b) {
    asm volatile("s_waitcnt vmcnt(0)" ::: "memory");
    __syncthreads();
    if (threadIdx.x == 0) {
        unsigned* bar = b.bar;
        __builtin_amdgcn_s_waitcnt(0);
        unsigned nloc = b.st[0], nx = b.st[1];
        if (nloc == 0u) { xcd_barrier_complete(bar, b.x, nloc, nx); b.st[0] = nloc; b.st[1] = nx; }
        const unsigned old = xb_add(&bar[XB_XSUB(b.x)], 1u);
        const unsigned gen = old / nloc;
        if (old + 1u == (gen + 1u) * nloc) {
            __builtin_amdgcn_fence(__ATOMIC_RELEASE, "agent");
            asm volatile("s_waitcnt vmcnt(0)" ::: "memory");
            const unsigned og = xb_add(&bar[XB_TOP], 1u);
            const unsigned tg = og / nx;
            if (og + 1u == (tg + 1u) * nx) xb_add(&bar[XB_TOPGEN], 1u);
            else XB_SPIN(xb_ld(&bar[XB_TOPGEN]) == tg, bar);
            __builtin_amdgcn_fence(__ATOMIC_ACQUIRE, "agent");
            xb_add(&bar[XB_XGEN(b.x)], 1u);
            asm volatile("s_waitcnt vmcnt(0)" ::: "memory");
        } else {
            XB_SPIN(xb_ld(&bar[XB_XGEN(b.x)]) == gen, bar);
            __builtin_amdgcn_fence(__ATOMIC_ACQUIRE, "agent");
            asm volatile("s_waitcnt vmcnt(0)" ::: "memory");
        }
    }
    __syncthreads();
}

namespace g8 {
constexpr int BM = 256, BK = 64, HALF = 128, HTB = HALF * BK * 2, STAGE_BYTES = 8 * HTB, NXCD = 8;
__host__ __device__ __forceinline__ int lds_byte(int r, int c) { const int st = (r >> 4) * 2 + (c >> 5), rr = r & 15, cc = c & 31, ob = rr * 64 + cc * 2; return st * 1024 + (ob ^ (((ob >> 9) & 1) << 5)); }
__host__ __device__ __forceinline__ void stage_rc(int b, int& R, int& C) { const int st = b / 1024, sb = b % 1024, swz = sb ^ (((sb >> 9) & 1) << 5); R = (st >> 1) * 16 + swz / 64; C = (st & 1) * 32 + (swz % 64) / 2; }
__host__ __device__ __forceinline__ int perm32(int rho) { const int n = rho >> 4, i = rho & 15; return 8 * (i >> 2) + 4 * n + (i & 3); }

struct Unit { const char* A; const char* B0; const char* B1; const int* rows; const float* bias0; const float* bias1; int nvalid; int m0, n0, e; int wscale; };

template <class Sched>
__device__ __forceinline__ void a_offsets(const Unit& u, const int (&R)[2], const int (&C)[2], unsigned (&vo)[2][2]) {
#pragma unroll
    for (int h = 0; h < 2; ++h)
#pragma unroll
        for (int i = 0; i < 2; ++i) {
            if constexpr (Sched::GATHER) {
                const int r = h * HALF + R[i];
                const int idx = u.rows[r < u.nvalid ? r : 0] >> Sched::SHIFT;
                vo[h][i] = (unsigned)idx * (unsigned)(Sched::LDA * Sched::ESZ) + (unsigned)C[i] * 2u;
            } else {
                vo[h][i] = (unsigned)(h * HALF + R[i]) * (unsigned)(Sched::LDA * Sched::ESZ) + (unsigned)C[i] * 2u;
            }
        }
}

__device__ __forceinline__ const char* uni_ptr(const char* p) { const unsigned long long v = (unsigned long long)p;
    const unsigned lo = (unsigned)__builtin_amdgcn_readfirstlane((int)(unsigned)v), hi = (unsigned)__builtin_amdgcn_readfirstlane((int)(unsigned)(v >> 32));
    return (const char*)(((unsigned long long)hi << 32) | lo); }
template <class Sched, class Epi>
__device__ __forceinline__ void gemm_phase(LAS unsigned char* lds, const Sched& S, const Epi& E) {
    const int tid = threadIdx.x, wid = __builtin_amdgcn_readfirstlane(tid >> 6), lane = tid & 63, wr = wid >> 2, wc = wid & 3, fr = lane & 15, fq = lane >> 4;
    constexpr int K = Sched::K, nt = K * Sched::ESZ / (BK * 2);
    int Rr[2], Cc[2]; unsigned voffB[2];
#pragma unroll
    for (int i = 0; i < 2; ++i) { stage_rc(tid * 16 + i * 8192, Rr[i], Cc[i]); const int Rb = Epi::PERM ? ((Rr[i] & ~31) + perm32(Rr[i] & 31)) : Rr[i];
        voffB[i] = (unsigned)Rb * (unsigned)(K * Sched::ESZ) + (unsigned)Cc[i] * 2u; }
    const size_t kstep = (size_t)(BK * 2);
    const unsigned ldsw = (unsigned)wid * 1024u;
    const int aoff = lds_byte(wr * 64 + fr, fq * 8), boff = lds_byte(wc * 32 + fr, fq * 8);
#define G8_SA(b, h) (((b) * 2 + (h)) * HTB)
#define G8_SB(b, h) ((4 + (b) * 2 + (h)) * HTB)
#define G8_STAGE(bufoff, gbase, voff) do { _Pragma("unroll") for (int _i = 0; _i < 2; ++_i) \
        __builtin_amdgcn_global_load_lds((const unsigned*)((const char*)(gbase) + (voff)[_i]), (LAS unsigned*)(lds + (bufoff) + ldsw + _i * 8192), 16, 0, 0); } while (0)
#define G8_LDA(dst, b, h) do { if constexpr (Sched::MV != 0 && (h) == 1) break; _Pragma("unroll") for (int m = 0; m < 4; ++m) _Pragma("unroll") for (int k = 0; k < 2; ++k) dst[m][k] = *(const LAS bf16x8*)(lds + G8_SA(b, h) + aoff + m * 2048 + k * 1024); } while (0)
#define G8_LDB(dst, b, h) do { _Pragma("unroll") for (int n = 0; n < 2; ++n) _Pragma("unroll") for (int k = 0; k < 2; ++k) dst[n][k] = *(const LAS bf16x8*)(lds + G8_SB(b, h) + boff + n * 2048 + k * 1024); } while (0)
#define G8_MMA(ai, bj, At, Bt) do { if constexpr (Sched::MV != 0 && (ai) == 1) break; __builtin_amdgcn_s_setprio(1); _Pragma("unroll") for (int m = 0; m < 4; ++m) _Pragma("unroll") for (int n = 0; n < 2; ++n) { \
        if constexpr (Sched::ESZ == 2) { _Pragma("unroll") for (int k = 0; k < 2; ++k) acc[ai][bj][m][n] = __builtin_amdgcn_mfma_f32_16x16x32_bf16(Bt[n][k], At[m][k], acc[ai][bj][m][n], 0, 0, 0); } \
        else { const u32x4 b0_ = __builtin_bit_cast(u32x4, Bt[n][0]), b1_ = __builtin_bit_cast(u32x4, Bt[n][1]), a0_ = __builtin_bit_cast(u32x4, At[m][0]), a1_ = __builtin_bit_cast(u32x4, At[m][1]); \
            const i32x8 bw_ = {(int)b0_[0], (int)b0_[1], (int)b0_[2], (int)b0_[3], (int)b1_[0], (int)b1_[1], (int)b1_[2], (int)b1_[3]}; \
            const i32x8 aw_ = {(int)a0_[0], (int)a0_[1], (int)a0_[2], (int)a0_[3], (int)a1_[0], (int)a1_[1], (int)a1_[2], (int)a1_[3]}; \
            acc[ai][bj][m][n] = __builtin_amdgcn_mfma_scale_f32_16x16x128_f8f6f4(bw_, aw_, acc[ai][bj][m][n], Sched::FMT_W, Sched::FMT_A, 0, wsc_cur, 0, 0x7f7f7f7f); } } \
        __builtin_amdgcn_s_setprio(0); } while (0)
#define G8_WAIT_V(n) asm volatile("s_waitcnt vmcnt(" #n ")" ::: "memory")
#define G8_WAIT_L(n) asm volatile("s_waitcnt lgkmcnt(" #n ")" ::: "memory")
#define G8_BAR __builtin_amdgcn_s_barrier()
#define G8_SCHED __builtin_amdgcn_sched_barrier(0)
    Unit cur, nxt; int ui = 0;
    if (!S.next(0, cur)) return;
    f32x4 acc[2][2][4][2];
#pragma unroll
    for (int a = 0; a < 2; ++a)
#pragma unroll
        for (int b = 0; b < 2; ++b)
#pragma unroll
            for (int m = 0; m < 4; ++m)
#pragma unroll
                for (int n = 0; n < 2; ++n) acc[a][b][m][n] = (f32x4){0.f, 0.f, 0.f, 0.f};
    bf16x8 At[4][2], B0[2][2], B1[2][2];
    unsigned voffA[2][2], nvoffA[2][2];
    LAS unsigned char* auxb = lds + STAGE_BYTES; int par_cur = 0, par_nxt = 1;
#define G8_AUX_ISSUE(U, PAR) do { if (wid < 4) { const int r_ = wid * 64 + lane; __builtin_amdgcn_global_load_lds((const unsigned*)((U).rows + (r_ < (U).nvalid ? r_ : 0)), (LAS unsigned*)(auxb + (PAR) * 2048 + wid * 256), 4, 0, 0); } \
        else { const float* b_ = (wid < 6 ? (U).bias0 + (wid - 4) * 64 : (U).bias1 + (wid - 6) * 64) + lane; __builtin_amdgcn_global_load_lds((const unsigned*)b_, (LAS unsigned*)(auxb + (PAR) * 2048 + 1024 + (wid - 4) * 256), 4, 0, 0); } } while (0)
#define G8_AUX_OFFS(PAR) do { _Pragma("unroll") for (int h = 0; h < 2; ++h) _Pragma("unroll") for (int i = 0; i < 2; ++i) { \
        const int idx_ = *(const LAS int*)(auxb + (PAR) * 2048 + (h * HALF + Rr[i]) * 4) >> Sched::SHIFT; voffA[h][i] = (unsigned)idx_ * (unsigned)(Sched::LDA * Sched::ESZ) + (unsigned)Cc[i] * 2u; } } while (0)
    if constexpr (Sched::LDSAUX) { G8_AUX_ISSUE(cur, 0); G8_WAIT_V(0); __syncthreads(); G8_AUX_OFFS(0); }
    else a_offsets<Sched>(cur, Rr, Cc, voffA);
    const char* cA = cur.A; const char* cB0 = cur.B0; const char* cB1 = cur.B1;
    int wsc_cur = cur.wscale;
    G8_STAGE(G8_SB(0, 0), cB0, voffB); G8_STAGE(G8_SA(0, 0), cA, voffA[0]); G8_STAGE(G8_SB(0, 1), cB1, voffB); G8_STAGE(G8_SA(0, 1), cA, voffA[1]);
    if (wr == 1) G8_BAR;
    G8_WAIT_V(4); G8_BAR;
    G8_STAGE(G8_SB(1, 0), cB0 + kstep, voffB); G8_STAGE(G8_SA(1, 0), cA + kstep, voffA[0]); G8_STAGE(G8_SB(1, 1), cB1 + kstep, voffB);
    G8_WAIT_V(6); G8_BAR;
    for (;;) {
        const bool has_next = S.next(ui + 1, nxt);
        const char* nA = has_next ? nxt.A : cA; const char* nB0 = has_next ? nxt.B0 : cB0; const char* nB1 = has_next ? nxt.B1 : cB1;
        if constexpr (Sched::LDSAUX) { if (has_next) G8_AUX_ISSUE(nxt, par_nxt); }
        else if constexpr (Sched::GATHER) {
            if (has_next) a_offsets<Sched>(nxt, Rr, Cc, nvoffA);
            else {
#pragma unroll
                for (int h = 0; h < 2; ++h)
#pragma unroll
                    for (int i = 0; i < 2; ++i) nvoffA[h][i] = voffA[h][i];
            }
        }
        for (int t = 0; t < nt; t += 2) {
            const bool last = (t == nt - 2);
            const char* a1 = cA + (size_t)(t + 1) * kstep;
            const char* a2 = last ? nA : cA + (size_t)(t + 2) * kstep;
            const char* b20 = last ? nB0 : cB0 + (size_t)(t + 2) * kstep; const char* b21 = last ? nB1 : cB1 + (size_t)(t + 2) * kstep;
            const char* a3 = a2 + kstep; const char* b30 = b20 + kstep; const char* b31 = b21 + kstep;
            G8_LDB(B0, 0, 0); G8_SCHED; G8_LDA(At, 0, 0); G8_STAGE(G8_SA(1, 1), a1, voffA[1]);
            G8_WAIT_L(8); G8_BAR; G8_WAIT_L(0); G8_MMA(0, 0, At, B0); G8_BAR; G8_SCHED;
            if constexpr (Sched::LDSAUX) { if (last && has_next) G8_AUX_OFFS(par_nxt); }
            else if constexpr (Sched::GATHER) { if (last) {
#pragma unroll
                for (int h = 0; h < 2; ++h)
#pragma unroll
                    for (int i = 0; i < 2; ++i) voffA[h][i] = nvoffA[h][i]; } }
            G8_LDB(B1, 0, 1); G8_STAGE(G8_SB(0, 0), b20, voffB);
            G8_BAR; G8_WAIT_L(0); G8_MMA(0, 1, At, B1); G8_BAR;
            G8_LDA(At, 0, 1); G8_STAGE(G8_SA(0, 0), a2, voffA[0]);
            G8_BAR; G8_WAIT_L(0); G8_MMA(1, 0, At, B0); G8_BAR; G8_SCHED;
            G8_STAGE(G8_SB(0, 1), b21, voffB);
            G8_WAIT_V(6); G8_BAR; G8_MMA(1, 1, At, B1); G8_BAR;
            G8_LDB(B0, 1, 0); G8_SCHED; G8_LDA(At, 1, 0); G8_STAGE(G8_SA(0, 1), a2, voffA[1]);
            G8_WAIT_L(8); G8_BAR; G8_WAIT_L(0); G8_MMA(0, 0, At, B0); G8_BAR; G8_SCHED;
            G8_LDB(B1, 1, 1); G8_STAGE(G8_SB(1, 0), b30, voffB);
            G8_BAR; G8_WAIT_L(0); G8_MMA(0, 1, At, B1); G8_BAR;
            G8_LDA(At, 1, 1); G8_STAGE(G8_SA(1, 0), a3, voffA[0]);
            G8_BAR; G8_WAIT_L(0); G8_MMA(1, 0, At, B0); G8_BAR; G8_SCHED;
            G8_STAGE(G8_SB(1, 1), b31, voffB);
            G8_WAIT_V(6); G8_BAR; G8_MMA(1, 1, At, B1); G8_BAR;
        }
        E.template run<(Sched::MV != 0 ? 1 : 2)>(acc, cur, wr, wc, fr, fq, (const LAS int*)(auxb + par_cur * 2048), (const LAS float*)(auxb + par_cur * 2048 + 1024));
        if (!has_next) break;
#pragma unroll
        for (int a = 0; a < 2; ++a)
#pragma unroll
            for (int b = 0; b < 2; ++b)
#pragma unroll
                for (int m = 0; m < 4; ++m)
#pragma unroll
                    for (int n = 0; n < 2; ++n) acc[a][b][m][n] = (f32x4){0.f, 0.f, 0.f, 0.f};
        cur = nxt; cA = nA; cB0 = nB0; cB1 = nB1; ++ui; wsc_cur = cur.wscale; par_cur = par_nxt; par_nxt = par_nxt == 2 ? 0 : par_nxt + 1;
    }
    G8_WAIT_V(0);
    if (wr == 0) G8_BAR;
    G8_BAR;
#undef G8_AUX_ISSUE
#undef G8_AUX_OFFS
#undef G8_SA
#undef G8_SB
#undef G8_STAGE
#undef G8_LDA
#undef G8_LDB
#undef G8_MMA
#undef G8_WAIT_V
#undef G8_WAIT_L
#undef G8_BAR
#undef G8_SCHED
}

template <int K_, int LDA_>
struct DenseSched {
    static constexpr int K = K_, LDA = LDA_, SHIFT = 0, ESZ = 2, FMT_W = 0, FMT_A = 0, MV = 0; static constexpr bool GATHER = false, LDSAUX = false;
    const char* A; const char* Bt; int nM, nN, nwg, G, c;
    __device__ void init(const void* A_, const void* Bt_, int M, int N, int G_, int c_) { A = (const char*)A_; Bt = (const char*)Bt_; nM = M / BM; nN = N / BM; nwg = nM * nN; G = G_; c = c_; }
    __device__ __forceinline__ bool next(int i, Unit& u) const {
        const long L = (long)i * G + c; if (L >= nwg) return false;
        int wgid = (int)L; { const int q = nwg / NXCD, r = nwg % NXCD, xcd = wgid % NXCD, off = wgid / NXCD; wgid = (xcd < r ? xcd * (q + 1) : r * (q + 1) + (xcd - r) * q) + off; }
        constexpr int WGM = 8;
        const int nig = WGM * nN, gid = wgid / nig, fm = gid * WGM, gsz = (nM - fm) < WGM ? (nM - fm) : WGM;
        const int pm = fm + ((wgid % nig) % gsz), pn = (wgid % nig) / gsz;
        u.A = A + (size_t)pm * BM * LDA * 2; u.B0 = Bt + (size_t)pn * BM * K * 2; u.B1 = u.B0 + (size_t)HALF * K * 2;
        u.rows = nullptr; u.bias0 = nullptr; u.bias1 = nullptr; u.wscale = 0x7f7f7f7f; u.nvalid = BM; u.m0 = pm * BM; u.n0 = pn * BM; u.e = 0; return true;
    }
};

template <int NPN  , int SHIFT_, bool GU, int MV_ = 0>
struct MoeSched {
    static constexpr int K = 2048, LDA = 2048, SHIFT = SHIFT_, ESZ = 1, MV = MV_, FMT_W = 0  , FMT_A = 0  ; static constexpr bool GATHER = true, LDSAUX = true;
    const char* A; const char* Bt; const int* slot; const float* bias; const LAS int* tstart; const LAS int* cnt; int G, c;
    __device__ __forceinline__ bool next(int i, Unit& u) const {
        const int ntile = tstart[NEXP]; const int nwg = ntile * NPN;
        const long L = (long)i * G + c; if (L >= nwg) return false;
        int wgid = (int)L; { const int q = nwg / NXCD, r = nwg % NXCD, xcd = wgid % NXCD, off = wgid / NXCD; wgid = (xcd < r ? xcd * (q + 1) : r * (q + 1) + (xcd - r) * q) + off; }
        int e = 0;
        for (int s = 16; s > 0; s >>= 1) if (tstart[e + s] * NPN <= wgid) e += s;
        const int mt = tstart[e + 1] - tstart[e], w = wgid - tstart[e] * NPN, pn = MV ? w : w / mt, m = MV ? (cnt[e] >> 8) : w % mt;
        u.A = A; u.e = e; u.m0 = m * BM; u.n0 = pn; u.wscale = cnt[40 + (GU ? 0 : 32) + e]; u.rows = slot + (size_t)e * NTOK + m * BM;
        const int left = cnt[e] - m * BM; u.nvalid = left < BM ? left : BM;
        if (GU) { u.B0 = Bt + ((size_t)e * 4096 + (size_t)pn * HALF) * K * ESZ; u.B1 = u.B0 + (size_t)2048 * K * ESZ; u.bias0 = bias + (size_t)e * 4096 + pn * HALF; u.bias1 = u.bias0 + 2048; }
        else { u.B0 = Bt + ((size_t)e * 2048 + (size_t)pn * BM) * K * ESZ; u.B1 = u.B0 + (size_t)HALF * K * ESZ; u.bias0 = bias + (size_t)e * 2048 + pn * BM; u.bias1 = u.bias0 + HALF; }
        return true;
    }
};

struct EpiBf16 {
    static constexpr bool PERM = true;
    bf16_t* O; int ldc;
    template <int NAI> __device__ __forceinline__ void run(const f32x4 (&acc)[2][2][4][2], const Unit& u, int wr, int wc, int fr, int fq, const LAS int* lrows, const LAS float* lbias) const {
        const int row0 = u.m0 + wr * 64 + fr, col0 = u.n0 + wc * 32 + 8 * fq;
#pragma unroll
        for (int ai = 0; ai < NAI; ++ai)
#pragma unroll
            for (int m = 0; m < 4; ++m) { bf16_t* rowp = O + (size_t)(row0 + ai * HALF + m * 16) * ldc + col0;
#pragma unroll
                for (int bj = 0; bj < 2; ++bj) { const f32x4 v0 = acc[ai][bj][m][0], v1 = acc[ai][bj][m][1];
                    u32x4 w; w[0] = cvt_pk_bf16(v0[0], v0[1]); w[1] = cvt_pk_bf16(v0[2], v0[3]); w[2] = cvt_pk_bf16(v1[0], v1[1]); w[3] = cvt_pk_bf16(v1[2], v1[3]);
                    *(u32x4*)(rowp + bj * HALF) = w; } }
    }
};
struct EpiProj {
    static constexpr bool PERM = true;
    bf16_t* O; int ldc; bf16_t* OMF; const float* lb;
    template <int NAI> __device__ __forceinline__ void run(const f32x4 (&acc)[2][2][4][2], const Unit& u, int wr, int wc, int fr, int fq, const LAS int* lrows, const LAS float* lbias) const {
        const int row0 = u.m0 + wr * 64 + fr, col0 = u.n0 + wc * 32 + 8 * fq;
        const int mode = (u.n0 < 1024 || (u.n0 >= 3072 && u.n0 < 4096)) ? 1 : ((u.n0 >= 1024 && u.n0 < 2048) ? 2 : 0);
        f32x4 lbv[2][2];
        if (mode == 2) {
#pragma unroll
            for (int bj = 0; bj < 2; ++bj) { lbv[bj][0] = *(const f32x4*)(lb + col0 - 1024 + bj * HALF); lbv[bj][1] = *(const f32x4*)(lb + col0 - 1024 + bj * HALF + 4); } }
#pragma unroll
        for (int ai = 0; ai < NAI; ++ai)
#pragma unroll
            for (int m = 0; m < 4; ++m) { const size_t rowi = (size_t)(row0 + ai * HALF + m * 16); bf16_t* rowp = O + rowi * ldc + col0;
#pragma unroll
                for (int bj = 0; bj < 2; ++bj) { f32x4 v0 = acc[ai][bj][m][0], v1 = acc[ai][bj][m][1];
                    f32x4 o0 = {0.f, 0.f, 0.f, 0.f}, o1 = o0;
                    if (mode != 0) {
                        f32x4 e0 = v0 * (-1.4426950408889634f), e1 = v1 * (-1.4426950408889634f);
#pragma unroll
                        for (int j = 0; j < 4; ++j) { e0[j] = __builtin_amdgcn_exp2f(e0[j]); e1[j] = __builtin_amdgcn_exp2f(e1[j]); }
                        e0 = e0 + 1.f; e1 = e1 + 1.f;
#pragma unroll
                        for (int j = 0; j < 4; ++j) { e0[j] = __builtin_amdgcn_rcpf(e0[j]); e1[j] = __builtin_amdgcn_rcpf(e1[j]); }
                        if (mode == 1) { v0 = v0 * e0; v1 = v1 * e1; }
                        else { const f32x4 f0 = lbv[bj][0] + (1.f - lbv[bj][0]) * e0, f1 = lbv[bj][1] + (1.f - lbv[bj][1]) * e1;
#pragma unroll
                            for (int j = 0; j < 4; ++j) { v0[j] = __builtin_amdgcn_logf(f0[j]); v1[j] = __builtin_amdgcn_logf(f1[j]); }
                            o0 = 1.f - f0; o1 = 1.f - f1; } }
                    if (mode == 2) {
                        u32x4 w2; w2[0] = cvt_pk_bf16(o0[0], o0[1]); w2[1] = cvt_pk_bf16(o0[2], o0[3]); w2[2] = cvt_pk_bf16(o1[0], o1[1]); w2[3] = cvt_pk_bf16(o1[2], o1[3]);
                        *(u32x4*)(OMF + rowi * HG_W + (col0 - 1024) + bj * HALF) = w2; }
                    u32x4 w; w[0] = cvt_pk_bf16(v0[0], v0[1]); w[1] = cvt_pk_bf16(v0[2], v0[3]); w[2] = cvt_pk_bf16(v1[0], v1[1]); w[3] = cvt_pk_bf16(v1[2], v1[3]);
                    *(u32x4*)(rowp + bj * HALF) = w; } }
    }
};
struct EpiResF32 {
    static constexpr bool PERM = false;
    float* C; const float* res; int ldc;
    template <int NAI> __device__ __forceinline__ void run(const f32x4 (&acc)[2][2][4][2], const Unit& u, int wr, int wc, int fr, int fq, const LAS int* lrows, const LAS float* lbias) const {
        const int row0 = u.m0 + wr * 64 + fr, col0 = u.n0 + wc * 32 + 4 * fq;
#pragma unroll
        for (int ai = 0; ai < NAI; ++ai)
#pragma unroll
            for (int m = 0; m < 4; ++m) { const size_t off = (size_t)(row0 + ai * HALF + m * 16) * ldc + col0;
#pragma unroll
                for (int bj = 0; bj < 2; ++bj)
#pragma unroll
                    for (int n = 0; n < 2; ++n) { const f32x4 r = *(const f32x4*)(res + off + bj * HALF + n * 16); *(f32x4*)(C + off + bj * HALF + n * 16) = acc[ai][bj][m][n] + r; } }
    }
};
struct EpiResBf16 {
    static constexpr bool PERM = true;
    bf16_t* C; const float* res; int ldc;
    template <int NAI> __device__ __forceinline__ void run(const f32x4 (&acc)[2][2][4][2], const Unit& u, int wr, int wc, int fr, int fq, const LAS int*, const LAS float*) const {
        const int row0 = u.m0 + wr * 64 + fr, col0 = u.n0 + wc * 32 + 8 * fq;
#pragma unroll
        for (int ai = 0; ai < NAI; ++ai)
#pragma unroll
            for (int m = 0; m < 4; ++m) { const size_t off = (size_t)(row0 + ai * HALF + m * 16) * ldc + col0;
#pragma unroll
                for (int bj = 0; bj < 2; ++bj) { const f32x4 r0 = *(const f32x4*)(res + off + bj * HALF), r1 = *(const f32x4*)(res + off + bj * HALF + 4);
                    const f32x4 v0 = acc[ai][bj][m][0] + r0, v1 = acc[ai][bj][m][1] + r1;
                    u32x4 w; w[0] = cvt_pk_bf16(v0[0], v0[1]); w[1] = cvt_pk_bf16(v0[2], v0[3]); w[2] = cvt_pk_bf16(v1[0], v1[1]); w[3] = cvt_pk_bf16(v1[2], v1[3]);
                    *(u32x4*)(C + off + bj * HALF) = w; } }
    }
};
struct EpiGateUp {
    static constexpr bool PERM = true;
    unsigned char* ACT; const float* bias;
    template <int NAI> __device__ __forceinline__ void run(const f32x4 (&acc)[2][2][4][2], const Unit& u, int wr, int wc, int fr, int fq, const LAS int* lrows, const LAS float* lbias) const {
        const int colh = u.n0 * HALF + wc * 32 + 8 * fq;
        const LAS float* bp = lbias + wc * 32 + 8 * fq;
        const f32x4 bg0 = *(const LAS f32x4*)bp, bg1 = *(const LAS f32x4*)(bp + 4), bu0 = *(const LAS f32x4*)(bp + 128), bu1 = *(const LAS f32x4*)(bp + 132);
#pragma unroll
        for (int ai = 0; ai < NAI; ++ai)
#pragma unroll
            for (int m = 0; m < 4; ++m) { const int r = ai * HALF + wr * 64 + m * 16 + fr;
                if (r < u.nvalid) { const int asg = lrows[r];
                    f32x4 g0 = acc[ai][0][m][0] + bg0, g1 = acc[ai][0][m][1] + bg1, u0 = acc[ai][1][m][0] + bu0, u1 = acc[ai][1][m][1] + bu1;
                    f32x4 e0, e1;
#pragma unroll
                    for (int j = 0; j < 4; ++j) { g0[j] = fminf(g0[j], 7.f); g1[j] = fminf(g1[j], 7.f); u0[j] = __builtin_amdgcn_fmed3f(u0[j], -7.f, 7.f); u1[j] = __builtin_amdgcn_fmed3f(u1[j], -7.f, 7.f); }
                    const f32x4 z0 = g0 * (-1.702f * 1.4426950408889634f), z1 = g1 * (-1.702f * 1.4426950408889634f);
#pragma unroll
                    for (int j = 0; j < 4; ++j) { e0[j] = __builtin_amdgcn_exp2f(z0[j]); e1[j] = __builtin_amdgcn_exp2f(z1[j]); }
                    e0 = e0 + 1.f; e1 = e1 + 1.f;
#pragma unroll
                    for (int j = 0; j < 4; ++j) { e0[j] = __builtin_amdgcn_rcpf(e0[j]); e1[j] = __builtin_amdgcn_rcpf(e1[j]); }
                    const f32x4 o0 = (g0 * e0) * (u0 + 1.f), o1 = (g1 * e1) * (u1 + 1.f);
                    u32x2 w; w[0] = cvt4_fp8(o0[0], o0[1], o0[2], o0[3]); w[1] = cvt4_fp8(o1[0], o1[1], o1[2], o1[3]);
                    *(u32x2*)(ACT + (size_t)asg * DFF + colh) = w; } }
    }
};
struct EpiDown {
    static constexpr bool PERM = true;
    unsigned char* Y; const float* bias;
    template <int NAI> __device__ __forceinline__ void run(const f32x4 (&acc)[2][2][4][2], const Unit& u, int wr, int wc, int fr, int fq, const LAS int* lrows, const LAS float* lbias) const {
        const int col0 = u.n0 * BM + wc * 32 + 8 * fq;
        const LAS float* bp = lbias + wc * 32 + 8 * fq;
        f32x4 bv[2][2];
#pragma unroll
        for (int bj = 0; bj < 2; ++bj) { bv[bj][0] = *(const LAS f32x4*)(bp + bj * HALF); bv[bj][1] = *(const LAS f32x4*)(bp + bj * HALF + 4); }
#pragma unroll
        for (int ai = 0; ai < NAI; ++ai)
#pragma unroll
            for (int m = 0; m < 4; ++m) { const int r = ai * HALF + wr * 64 + m * 16 + fr;
                if (r < u.nvalid) { const int asg = lrows[r]; unsigned char* rowp = Y + (size_t)asg * DM + col0;
#pragma unroll
                    for (int bj = 0; bj < 2; ++bj) { const f32x4 v0 = acc[ai][bj][m][0] + bv[bj][0], v1 = acc[ai][bj][m][1] + bv[bj][1];
                        u32x2 w; w[0] = cvt4_fp8(v0[0], v0[1], v0[2], v0[3]); w[1] = cvt4_fp8(v1[0], v1[1], v1[2], v1[3]);
                        *(u32x2*)(rowp + bj * HALF) = w; } } }
    }
};
}

struct Args { const float* in[18]; float* out; unsigned char* ws; int ph_lo, ph_hi; };
enum { I_X = 0, I_N1G, I_WIN, I_LBL, I_HGNG, I_CPOS, I_CW1, I_CW2, I_NSAG, I_WOUT, I_N2G, I_WR, I_BR, I_WGU, I_BGU, I_WD, I_BD, I_FNG };
constexpr int LDS_STAGE = 131072, LDS_BYTES = LDS_STAGE + 16384, LDS_MISC = LDS_BYTES - 4096;

struct Frame {
    LAS unsigned char* lds; unsigned char* ws; unsigned* ctl; int tid, wid, lane, G, bid;
};

__device__ __forceinline__ void conv_tile(const Frame& F, const float* src, int lds_, int k0, int n0, int N, bf16_t* dst, int ldd) {
    LAS float* tile = (LAS float*)F.lds;
#pragma unroll
    for (int p = 0; p < 2; ++p) { const int k = p * 32 + (F.tid >> 4), n = (F.tid & 15) * 4;
        f32x4 v = (f32x4){0.f, 0.f, 0.f, 0.f};
        if (n0 + n < N) v = *(const f32x4*)(src + (size_t)(k0 + k) * lds_ + n0 + n);
        tile[k * 65 + n] = v[0]; tile[k * 65 + n + 1] = v[1]; tile[k * 65 + n + 2] = v[2]; tile[k * 65 + n + 3] = v[3]; }
    __syncthreads();
    { const int n = F.tid >> 3, kc = (F.tid & 7) * 8;
      if (n0 + n < N) { float f[8];
#pragma unroll
          for (int j = 0; j < 8; ++j) f[j] = tile[(kc + j) * 65 + n];
          u32x4 w; w[0] = cvt_pk_bf16(f[0], f[1]); w[1] = cvt_pk_bf16(f[2], f[3]); w[2] = cvt_pk_bf16(f[4], f[5]); w[3] = cvt_pk_bf16(f[6], f[7]);
          *(u32x4*)(dst + (size_t)(n0 + n) * ldd + k0 + kc) = w; } }
    __syncthreads();
}
struct ConvJob { const float* src; unsigned char* dst; int N; };
__device__ __forceinline__ ConvJob conv_job(const Args& a, unsigned char* ws, int st, int& kt, int& ntile) {
    ConvJob j;
    if (st < 8192) { const int e = st >> 8, r = st & 255; kt = r >> 4; ntile = r & 15; j.src = a.in[I_WGU] + (size_t)e * DM * 4096; j.dst = ws + WS_WGUT + (size_t)e * 4096 * DM; j.N = 4096; }
    else { const int q = st - 8192, e = q >> 7, r = q & 127; kt = r >> 3; ntile = r & 7; j.src = a.in[I_WD] + (size_t)e * DFF * DM; j.dst = ws + WS_WDT + (size_t)e * DM * DFF; j.N = 2048; }
    return j;
}
__device__ __forceinline__ void conv_experts(const Frame& F, const Args& a, int first, int stride, int limit) {
    unsigned char* ws = F.ws; LAS unsigned* tile = (LAS unsigned*)F.lds;
    LAS float* mtab = (LAS float*)(F.lds + 32768);
    if (F.tid < 64) mtab[F.tid] = shift_mult(amax_shift(__hip_atomic_load(F.ctl + CW_AMAX + F.tid, __ATOMIC_RELAXED, __HIP_MEMORY_SCOPE_AGENT)));
    __syncthreads();
    const int NST = limit;
    const int lk = F.tid >> 5, lc = F.tid & 31;
    f32x4 v[16];
    int st = first, kt = 0, ntile = 0; ConvJob J{};
#define CV_LOAD() do { _Pragma("unroll") for (int T = 0; T < 2; ++T) _Pragma("unroll") for (int pp = 0; pp < 8; ++pp) \
        v[T * 8 + pp] = __builtin_nontemporal_load((const f32x4*)(J.src + (size_t)(kt * 128 + pp * 16 + lk) * J.N + ntile * 256 + T * 128 + lc * 4)); } while (0)
    if (st < NST) { J = conv_job(a, ws, st, kt, ntile); CV_LOAD(); }
    for (; st < NST; st += stride) {
        const float mlt = mtab[st < 8192 ? (st >> 8) : 32 + ((st - 8192) >> 7)];
#pragma unroll
        for (int T = 0; T < 2; ++T)
#pragma unroll
            for (int pp = 0; pp < 8; ++pp) { const int k = pp * 16 + lk; const f32x4 x = v[T * 8 + pp];
                tile[T * 4096 + k * 32 + (lc ^ (4 * (k >> 4)))] = cvt4_fp8s(x[0], x[1], x[2], x[3], mlt); }
        __syncthreads();
        const ConvJob Jc = J; const int ktc = kt, ntc = ntile;
        const int nx = st + stride;
        if (nx < NST) { J = conv_job(a, ws, nx, kt, ntile); CV_LOAD(); }
        { const int i = F.tid & 7, n4g = (F.tid >> 3) & 31, T = F.tid >> 8;
          unsigned d[16];
#pragma unroll
          for (int jj = 0; jj < 16; ++jj) d[jj] = tile[T * 4096 + (16 * i + jj) * 32 + (n4g ^ (4 * i))];
          u32x4 o[4];
#pragma unroll
          for (int q = 0; q < 4; ++q) {
              const unsigned a0 = __builtin_amdgcn_perm(d[4 * q + 1], d[4 * q], 0x05010400u), a1 = __builtin_amdgcn_perm(d[4 * q + 1], d[4 * q], 0x07030602u);
              const unsigned a2 = __builtin_amdgcn_perm(d[4 * q + 3], d[4 * q + 2], 0x05010400u), a3 = __builtin_amdgcn_perm(d[4 * q + 3], d[4 * q + 2], 0x07030602u);
              o[0][q] = __builtin_amdgcn_perm(a2, a0, 0x05040100u); o[1][q] = __builtin_amdgcn_perm(a2, a0, 0x07060302u);
              o[2][q] = __builtin_amdgcn_perm(a3, a1, 0x05040100u); o[3][q] = __builtin_amdgcn_perm(a3, a1, 0x07060302u); }
          unsigned char* dp = Jc.dst + (size_t)(ntc * 256 + T * 128 + n4g * 4) * DM + ktc * 128 + 16 * i;
#pragma unroll
          for (int r = 0; r < 4; ++r) *(u32x4*)(dp + (size_t)r * DM) = o[r]; }
        __syncthreads();
    }
#undef CV_LOAD
}
__device__ __forceinline__ void conv_matrix4(const Frame& F, const float* src, int K, int N, bf16_t* dst) {
    LAS float* tile = (LAS float*)F.lds;
    const int tn4 = (N + 255) / 256, tk = K / 64, cnt = tn4 * tk;
    for (int t = F.bid; t < cnt; t += F.G) { const int k0 = (t / tn4) * 64, n00 = (t % tn4) * 256;
        f32x4 v[8];
#pragma unroll
        for (int q = 0; q < 4; ++q)
#pragma unroll
            for (int p = 0; p < 2; ++p) { const int k = p * 32 + (F.tid >> 4), n = n00 + q * 64 + (F.tid & 15) * 4;
                v[q * 2 + p] = (n < N) ? *(const f32x4*)(src + (size_t)(k0 + k) * N + n) : (f32x4){0.f, 0.f, 0.f, 0.f}; }
#pragma unroll
        for (int q = 0; q < 4; ++q)
#pragma unroll
            for (int p = 0; p < 2; ++p) { LAS float* tp = tile + q * (64 * 65) + (p * 32 + (F.tid >> 4)) * 65 + (F.tid & 15) * 4; const f32x4 x = v[q * 2 + p]; tp[0] = x[0]; tp[1] = x[1]; tp[2] = x[2]; tp[3] = x[3]; }
        __syncthreads();
        { const int n = F.tid >> 3, kc = (F.tid & 7) * 8;
#pragma unroll
          for (int q = 0; q < 4; ++q) { const int nn = n00 + q * 64 + n;
              if (nn < N) { float f[8];
#pragma unroll
                  for (int j = 0; j < 8; ++j) f[j] = tile[q * (64 * 65) + (kc + j) * 65 + n];
                  u32x4 w; w[0] = cvt_pk_bf16(f[0], f[1]); w[1] = cvt_pk_bf16(f[2], f[3]); w[2] = cvt_pk_bf16(f[4], f[5]); w[3] = cvt_pk_bf16(f[6], f[7]);
                  *(u32x4*)(dst + (size_t)nn * K + k0 + kc) = w; } } }
        __syncthreads(); }
}
__device__ __forceinline__ void conv_matrix(const Frame& F, const float* src, int K, int N, bf16_t* dst, long& base) {
    const int tn = (N + 63) / 64, tk = K / 64; const long cnt = (long)tn * tk;
    long first = ((long)F.bid - base) % F.G; if (first < 0) first += F.G;
    for (long t = first; t < cnt; t += F.G) { const int kt = (int)(t / tn), nt_ = (int)(t % tn); conv_tile(F, src, N, kt * 64, nt_ * 64, N, dst, K); }
    base += cnt;
}
__device__ __forceinline__ void bias1_partials(const Frame& F, const Args& a, int rank, int nranks) {
    LAS float* red = (LAS float*)F.lds;
    const int c = F.tid & 127, kq = F.tid >> 7;
    for (int job = rank; job < 64; job += nranks) { const int j = job >> 5, kg = job & 31;
        const float* pos = a.in[I_CPOS] + (size_t)j * 4096 + kg * 128 + kq * 32; const float* w1 = a.in[I_CW1] + ((size_t)j * 4096 + kg * 128 + kq * 32) * 128 + c;
        float s0 = 0.f, s1 = 0.f, s2 = 0.f, s3 = 0.f;
#pragma unroll
        for (int k = 0; k < 32; k += 4) { s0 += pos[k] * w1[(size_t)k * 128]; s1 += pos[k + 1] * w1[(size_t)(k + 1) * 128]; s2 += pos[k + 2] * w1[(size_t)(k + 2) * 128]; s3 += pos[k + 3] * w1[(size_t)(k + 3) * 128]; }
        red[kq * 128 + c] = (s0 + s1) + (s2 + s3);
        __syncthreads();
        if (F.tid < 128) ((float*)(F.ws + WS_B1P))[((size_t)j * 32 + kg) * 128 + c] = ((red[c] + red[128 + c]) + red[256 + c]) + red[384 + c];
        __syncthreads(); }
}
__device__ __forceinline__ void p0_sample(const Frame& F, const Args& a) {
    const int j = F.bid & 63, q = F.bid >> 6, nq = (F.G + 63 - j) >> 6;
    const float* src; size_t stride; int nalt;
    if (j < 32) { src = a.in[I_WGU] + (size_t)j * DM * 4096; stride = (size_t)DM * 4096 / 64; nalt = 2; }
    else { src = a.in[I_WD] + (size_t)(j - 32) * DFF * DM; stride = (size_t)DFF * DM / 64; nalt = 1; }
    float mx = 0.f;
    for (int c = q; c < 64; c += nq) { const f32x4 v = *(const f32x4*)(src + (size_t)c * stride + (size_t)(c % nalt) * 2048 + F.tid * 4);
        mx = fmaxf(fmaxf(mx, fmaxf(fabsf(v[0]), fabsf(v[1]))), fmaxf(fabsf(v[2]), fabsf(v[3]))); }
    mx = wave_max(mx);
    if (F.lane == 0 && mx > 0.f) atomicMax(F.ctl + CW_AMAX + j, __float_as_uint(mx));
}
__device__ __forceinline__ void p0_prologue(const Frame& F, const Args& a) {
    unsigned char* ws = F.ws;
    long base = 0;
    p0_sample(F, a);
    static_assert(CONV_P0 == 0, "expert tiles need the sampled scales: none may be converted in the prologue");
    conv_matrix4(F, a.in[I_WIN], DM, IN_COLS, (bf16_t*)(ws + WS_WINT));
    conv_matrix(F, a.in[I_WOUT], DM, DM, (bf16_t*)(ws + WS_WOUTT), base);
    for (int fi = F.bid * NTHREADS + F.tid; fi < 2 * 8 * 32 * 4 * 64; fi += F.G * NTHREADS) {
        const int ln_ = fi & 63, ct = (fi >> 6) & 3, ks = (fi >> 8) & 31, w = (fi >> 13) & 7, j = fi >> 16;
        const float* wp = a.in[I_CW1] + ((size_t)j * 4096 + w * 512 + ks * 16 + (ln_ >> 5) * 8) * 128 + ct * 32 + (ln_ & 31);
        u32x4 fw; fw[0] = cvt_pk_bf16(wp[0], wp[128]); fw[1] = cvt_pk_bf16(wp[256], wp[384]); fw[2] = cvt_pk_bf16(wp[512], wp[640]); fw[3] = cvt_pk_bf16(wp[768], wp[896]);
        *(u32x4*)((bf16_t*)(ws + WS_W1T) + (size_t)fi * 8) = fw; }
    for (int j = 0; j < 2; ++j) conv_matrix(F, a.in[I_CW2] + (size_t)j * 128 * 128, 128, 128, (bf16_t*)(ws + WS_W2T) + (size_t)j * 128 * 128, base);
    { const float* x = a.in[I_X]; const float* g = a.in[I_N1G]; bf16_t* U = (bf16_t*)(ws + WS_U);
      f32x4 vn[8]; int row = F.bid * 8 + F.wid;
#define P0_LDROW(r_) do { const float* xr_ = x + (size_t)(r_) * DM; _Pragma("unroll") for (int i = 0; i < 4; ++i) { vn[2 * i] = *(const f32x4*)(xr_ + i * 512 + F.lane * 8); vn[2 * i + 1] = *(const f32x4*)(xr_ + i * 512 + F.lane * 8 + 4); } } while (0)
      if (row < NTOK) P0_LDROW(row);
      for (; row < NTOK; row += F.G * 8) {
          f32x4 v[8]; float ss = 0.f;
#pragma unroll
          for (int i = 0; i < 8; ++i) v[i] = vn[i];
          if (row + F.G * 8 < NTOK) P0_LDROW(row + F.G * 8);
#pragma unroll
          for (int i = 0; i < 8; ++i)
#pragma unroll
              for (int j = 0; j < 4; ++j) ss += v[i][j] * v[i][j];
          ss = wave_sum(ss); const float rs = rsqrtf(ss * (1.f / DM) + EPS);
#pragma unroll
          for (int i = 0; i < 4; ++i) { const f32x4 g0 = *(const f32x4*)(g + i * 512 + F.lane * 8), g1 = *(const f32x4*)(g + i * 512 + F.lane * 8 + 4);
              const f32x4 a0 = v[2 * i] * rs * g0, a1 = v[2 * i + 1] * rs * g1;
              u32x4 w; w[0] = cvt_pk_bf16(a0[0], a0[1]); w[1] = cvt_pk_bf16(a0[2], a0[3]); w[2] = cvt_pk_bf16(a1[0], a1[1]); w[3] = cvt_pk_bf16(a1[2], a1[3]);
              *(u32x4*)(U + (size_t)row * DM + i * 512 + F.lane * 8) = w; } }
#undef P0_LDROW
    }
    { const int gw = F.bid * 8 + F.wid;
      (void)gw;
      for (int i = F.bid * NTHREADS + F.tid; i < DM * NEXP; i += F.G * NTHREADS) ((float*)(ws + WS_WR2))[i] = a.in[I_N2G][i >> 5] * a.in[I_WR][i];
      for (int i = F.bid * NTHREADS + F.tid; i < HG_W; i += F.G * NTHREADS) { const float l0 = a.in[I_LBL][i], l1 = a.in[I_LBL][HG_W + i]; const float m = fmaxf(l0, l1);
          const float e0 = __expf(l0 - m), e1 = __expf(l1 - m); ((float*)(ws + WS_LB))[i] = e0 / (e0 + e1); } }
}

__device__ __forceinline__ float gelu_tanh(float x) { const float u = 0.7978845608028654f * (x + 0.044715f * x * x * x); return 0.5f * x * (1.f + tanhf(u)); }
__device__ __forceinline__ void p2_compress_naive(const Frame& F, const Args& a) {
    unsigned char* ws = F.ws; const bf16_t* PROJ = (const bf16_t*)(ws + WS_PROJ);
    LAS float* red = (LAS float*)F.lds;
    LAS float* hdn = red + 512;
    const int c = F.tid & 127, kq = F.tid >> 7;
    for (int u = F.bid; u < 2 * 16 * 128; u += F.G) {
        const int j = u >> 11, bg = (u >> 7) & 15, n = u & 127, b = bg >> 1, g = bg & 1;
        bf16_t* dst = (bf16_t*)(ws + (j ? WS_VC : WS_KC)) + ((size_t)bg * 128 + n) * 128;
        if (n == 127) { if (F.tid < 128) dst[F.tid] = 0; continue; }
        const float* w1 = a.in[I_CW1] + (size_t)j * 4096 * 128; const float* pos = a.in[I_CPOS] + (size_t)j * 4096;
        const int colb = (j ? C_VCM : C_KCM) + g * 128;
        float s = 0.f;
        for (int k = kq * 1024; k < kq * 1024 + 1024; ++k) { const int l = k >> 7, d = k & 127;
            const float av = bf2f(PROJ[(size_t)(b * SEQ + 16 * n + l) * PROJ_LD + colb + d]) + pos[k];
            s += av * w1[(size_t)k * 128 + c]; }
        red[kq * 128 + c] = s; __syncthreads();
        if (F.tid < 128) hdn[c] = gelu_tanh(red[c] + red[128 + c] + red[256 + c] + red[384 + c]);
        __syncthreads();
        if (F.tid < 128) { const float* w2 = a.in[I_CW2] + (size_t)j * 128 * 128; float o = 0.f; for (int k = 0; k < 128; ++k) o += hdn[k] * w2[k * 128 + c]; dst[c] = f2bf(o); }
        __syncthreads();
    }
}

__device__ __forceinline__ void hgrn_naive_unit(const Frame& F, const Args& a, int unit) {
    unsigned char* ws = F.ws; const bf16_t* PROJ = (const bf16_t*)(ws + WS_PROJ); bf16_t* YM = (bf16_t*)(ws + WS_YMIX);
    const float* lbv = (const float*)(ws + WS_LB);
    const int b = unit >> 3, h = unit & 7, v = F.tid & 127, kg = F.tid >> 7;
    LAS float* fs = (LAS float*)F.lds;
    LAS float* qs = fs + 2048; LAS float* is_ = qs + 2048; LAS float* red = is_ + 2048  ; LAS float* ob = red + 512  ;
    float S[32];
#pragma unroll
    for (int i = 0; i < 32; ++i) S[i] = 0.f;
    for (int t0 = 0; t0 < SEQ; t0 += 16) {
        for (int i = F.tid; i < 2048; i += NTHREADS) { const int st = i >> 7, k = i & 127; const size_t rowo = (size_t)(b * SEQ + t0 + st) * PROJ_LD + h * 128 + k;
            const float lb = lbv[h * 128 + k];
            fs[i] = lb + (1.f - lb) * sigmoidf_(bf2f(PROJ[rowo + C_HF])); qs[i] = siluf_(bf2f(PROJ[rowo + C_HQ])); is_[i] = bf2f(PROJ[rowo + C_HI]); }
        __syncthreads();
        for (int st = 0; st < 16; ++st) {
            const float iv = is_[st * 128 + v]; float po = 0.f;
#pragma unroll
            for (int kk = 0; kk < 32; ++kk) { const int k = kg * 32 + kk; const float f = fs[st * 128 + k]; S[kk] = f * S[kk] + (1.f - f) * iv; po += S[kk] * qs[st * 128 + k]; }
            red[kg * 128 + v] = po; __syncthreads();
            if (kg == 0) ob[st * 128 + v] = red[v] + red[128 + v] + red[256 + v] + red[384 + v];
            __syncthreads();
        }
        for (int s2 = 0; s2 < 2; ++s2) { const int st = F.wid * 2 + s2; const float o0 = ob[st * 128 + F.lane], o1 = ob[st * 128 + 64 + F.lane];
            const float ss = wave_sum(o0 * o0 + o1 * o1); const float rs = rsqrtf(ss * (1.f / 128.f) + EPS);
            const size_t row = (size_t)(b * SEQ + t0 + st);
            const float g0 = bf2f(PROJ[row * PROJ_LD + C_HGT + h * 128 + F.lane]), g1 = bf2f(PROJ[row * PROJ_LD + C_HGT + h * 128 + 64 + F.lane]);
            YM[row * DM + h * 128 + F.lane] = f2bf(o0 * rs * a.in[I_HGNG][F.lane] * siluf_(g0));
            YM[row * DM + h * 128 + 64 + F.lane] = f2bf(o1 * rs * a.in[I_HGNG][64 + F.lane] * siluf_(g1)); }
        __syncthreads();
    }
}

__device__ __forceinline__ float dot128_bf(const LAS float* q, const bf16_t* k) {
    float s = 0.f;
#pragma unroll
    for (int c = 0; c < 16; ++c) { const u32x4 w = *(const u32x4*)(k + c * 8); float f[8]; unpack8(w, f);
#pragma unroll
        for (int j = 0; j < 8; ++j) s += q[c * 8 + j] * f[j]; }
    return s;
}
__device__ __forceinline__ void softmax4(const Frame& F, LAS float* sc, int stride, int n, LAS float* tmp  ) {
    const int r = F.tid >> 7, i0 = F.tid & 127;
    float m = -INFINITY; for (int i = i0; i < n; i += 128) m = fmaxf(m, sc[r * stride + i]);
    m = wave_max(m); if (F.lane == 0) tmp[F.wid] = m; __syncthreads();
    m = fmaxf(tmp[2 * r], tmp[2 * r + 1]); __syncthreads();
    float s = 0.f;
    for (int i = i0; i < n; i += 128) { const float x = sc[r * stride + i]; const float p = (x == -INFINITY) ? 0.f : __expf(x - m); sc[r * stride + i] = p; s += p; }
    s = wave_sum(s); if (F.lane == 0) tmp[F.wid] = s; __syncthreads();
    s = tmp[2 * r] + tmp[2 * r + 1]; const float inv = s > 0.f ? 1.f / s : 0.f;
    for (int i = i0; i < n; i += 128) sc[r * stride + i] *= inv;
    __syncthreads();
}
__device__ __forceinline__ void attn_naive_unit(const Frame& F, const Args& a, int unit) {
    unsigned char* ws = F.ws; const bf16_t* PROJ = (const bf16_t*)(ws + WS_PROJ); bf16_t* YM = (bf16_t*)(ws + WS_YMIX);
    const int b = unit >> 12, g = (unit >> 11) & 1, t = unit & 2047, bg = b * 2 + g;
    LAS float* qs = (LAS float*)F.lds;
    LAS float* sc = qs + 512;
    LAS float* tmp = sc + 4096;
    LAS float* imp = tmp + 16;
    LAS int* selk = (LAS int*)(imp + 32);
    LAS float* oacc = (LAS float*)(selk + 32);
    const int r4 = F.tid >> 7, d = F.tid & 127;
    const size_t rowq = (size_t)(b * SEQ + t) * PROJ_LD;
    qs[F.tid] = bf2f(PROJ[rowq + C_NQ + (g * 4 + r4) * 128 + d]);
    const float slope = exp2f(-(float)(g * 4 + r4 + 1));
    const float scale = 0.08838834764831845f;
    float gate[3];
#pragma unroll
    for (int c = 0; c < 3; ++c) gate[c] = sigmoidf_(bf2f(PROJ[rowq + C_NGT + (g * 4 + r4) * 3 + c]));
    __syncthreads();
    { const int n = d; float s = -INFINITY;
      if (n < NCMP) { const int dist = t - (16 * n + 31); if (dist >= 0) s = dot128_bf(qs + r4 * 128, (const bf16_t*)(ws + WS_KC) + ((size_t)bg * 128 + n) * 128) * scale - slope * (float)dist; }
      sc[r4 * 1024 + n] = s; }
    __syncthreads();
    softmax4(F, sc, 1024, 128, tmp);
    { float o = 0.f; const bf16_t* vc = (const bf16_t*)(ws + WS_VC) + (size_t)bg * 128 * 128;
      for (int n = 0; n < NCMP; ++n) o += sc[r4 * 1024 + n] * bf2f(vc[n * 128 + d]);
      oacc[F.tid] = gate[0] * o; }
    if (F.tid < 32) { const int j = F.tid; float s = 0.f;
        for (int r = 0; r < 4; ++r) for (int q = -1; q <= 3; ++q) { const int n = 4 * j + q; if (n >= 0 && n < NCMP) s += ((q == -1 || q == 3) ? 1.f : 2.f) * sc[r * 1024 + n]; }
        const int cur = t >> 6; const bool forced = (j == 0) || (j == cur) || (j == cur - 1);
        imp[j] = forced ? 1e4f : (j <= cur ? s : -1e4f); }
    __syncthreads();
    if (F.tid < 32) { const int j = F.tid; const float me = imp[j]; int rank = 0;
        for (int k = 0; k < 32; ++k) { const float o = imp[k]; rank += (o > me || (o == me && k < j)) ? 1 : 0; }
        const bool sel = rank < SEL_TOP && j <= (t >> 6);
        const unsigned long long mask = __ballot(sel);
        if (sel) selk[__popcll(mask & ((1ull << j) - 1ull))] = j;
        if (j == 0) selk[16] = __popcll(mask); }
    __syncthreads();
    { const int nsel = selk[16];
      for (int i = F.tid; i < 4 * 1024; i += NTHREADS) sc[i] = -INFINITY;
      __syncthreads();
      const int l = F.tid & 63, r = (F.tid >> 6) & 3, which = F.tid >> 8;
      for (int s0 = 0; s0 < nsel; s0 += 2) { const int si = s0 + which;
          if (si < nsel) { const int kp = selk[si] * 64 + l;
              if (kp <= t) { const float s = dot128_bf(qs + r * 128, PROJ + (size_t)(b * SEQ + kp) * PROJ_LD + C_KSL + g * 128) * scale - exp2f(-(float)(g * 4 + r + 1)) * (float)(t - kp); sc[r * 1024 + si * 64 + l] = s; } } }
      __syncthreads();
      softmax4(F, sc, 1024, nsel * 64, tmp);
      float o = 0.f;
      for (int si = 0; si < nsel; ++si) { const int kb = selk[si] * 64;
          for (int l2 = 0; l2 < 64; ++l2) { const int kp = kb + l2; if (kp > t) break; o += sc[r4 * 1024 + si * 64 + l2] * bf2f(PROJ[(size_t)(b * SEQ + kp) * PROJ_LD + C_VSL + g * 128 + d]); } }
      oacc[F.tid] += gate[1] * o; }
    __syncthreads();
    { for (int i = F.tid; i < 4 * 1024; i += NTHREADS) sc[i] = -INFINITY;
      __syncthreads();
      for (int i = F.tid; i < 4 * 512; i += NTHREADS) { const int r = i >> 9, w = i & 511, kp = t - 511 + w;
          if (kp >= 0) sc[r * 1024 + w] = dot128_bf(qs + r * 128, PROJ + (size_t)(b * SEQ + kp) * PROJ_LD + C_KWN + g * 128) * scale - exp2f(-(float)(g * 4 + r + 1)) * (float)(t - kp); }
      __syncthreads();
      softmax4(F, sc, 1024, 512, tmp);
      float o = 0.f;
      for (int w = 0; w < 512; ++w) { const int kp = t - 511 + w; if (kp >= 0) o += sc[r4 * 1024 + w] * bf2f(PROJ[(size_t)(b * SEQ + kp) * PROJ_LD + C_VWN + g * 128 + d]); }
      oacc[F.tid] += gate[2] * o; }
    __syncthreads();
    { const float o = oacc[F.tid]; float ss = wave_sum(o * o); if (F.lane == 0) tmp[F.wid] = ss; __syncthreads();
      ss = tmp[2 * r4] + tmp[2 * r4 + 1]; const float rs = rsqrtf(ss * (1.f / 128.f) + EPS);
      YM[(size_t)(b * SEQ + t) * DM + HG_W + (g * 4 + r4) * 128 + d] = f2bf(o * rs * a.in[I_NSAG][d]); }
    __syncthreads();
}

namespace at {
constexpr int SHM_T = 64 * 128 * 2;
constexpr int BUF_B = 2 * SHM_T;
constexpr int OFF_V = 0, OFF_K = SHM_T, OFF_IMP = 2 * BUF_B  , OFF_SELM = 3 * BUF_B, OFF_WSC = OFF_SELM + 256;
constexpr float SCALE = 0.08838834764831845f, LOG2E = 1.4426950408889634f, THR = 8.f;
#define AT_KSWZ(row, colB) ((row) * 256 + ((colB) ^ (((row) & 7) << 4)))
__device__ __forceinline__ int v_st(int k, int c) { const int kk = (k & ~0xC) | ((k & 4) << 1) | ((k & 8) >> 1); return ((kk >> 3) * 4 + (c >> 5)) * 512 + ((kk & 7) * 32 + (c & 31)) * 2; }
__device__ __forceinline__ int v_rd_base(int lane) { return ((lane & 3) << 3) | (((lane >> 2) & 3) << 6) | (((lane >> 4) & 1) << 5) | (((lane >> 5) & 1) << 8); }
__device__ __forceinline__ int crow(int r, int hi) { return (r & 3) + 8 * (r >> 2) + 4 * hi; }
typedef short s16x4 __attribute__((ext_vector_type(4)));
struct Stage { u32x4 k0, k1, v0, v1; };
__device__ __forceinline__ void stage_load(Stage& S, const bf16_t* Kp, const bf16_t* Vp, int ld, int row0, int sr, int sc) {
    S.k0 = *(const u32x4*)(Kp + (size_t)(row0 + sr) * ld + sc); S.k1 = *(const u32x4*)(Kp + (size_t)(row0 + 32 + sr) * ld + sc);
    S.v0 = *(const u32x4*)(Vp + (size_t)(row0 + sr) * ld + sc); S.v1 = *(const u32x4*)(Vp + (size_t)(row0 + 32 + sr) * ld + sc);
}
__device__ __forceinline__ void stage_write(const Stage& S, LAS unsigned char* lds, int buf, int sr, int sc) {
    const int kws = AT_KSWZ(sr, sc * 2);
    *(LAS u32x4*)(lds + OFF_K + buf * BUF_B + kws) = S.k0; *(LAS u32x4*)(lds + OFF_K + buf * BUF_B + kws + 32 * 256) = S.k1;
    *(LAS u32x4*)(lds + OFF_V + buf * BUF_B + v_st(sr, sc)) = S.v0; *(LAS u32x4*)(lds + OFF_V + buf * BUF_B + v_st(32 + sr, sc)) = S.v1;
}
template <bool EXTRA = false>
__device__ __forceinline__ void qkt(f32x16& p0, f32x16& p1, const LAS unsigned char* ktile, int r32, int hi, const bf16x8 (&qr)[8], bf16x8 kx0 = bf16x8{}, bf16x8 kx1 = bf16x8{}, bf16x8 qx = bf16x8{}) {
#pragma unroll
    for (int r = 0; r < 16; ++r) { p0[r] = 0.f; p1[r] = 0.f; }
    const LAS unsigned char* kb[4];
#pragma unroll
    for (int dd = 0; dd < 4; ++dd) kb[dd] = ktile + AT_KSWZ(r32, (dd * 16 + hi * 8) * 2);
#pragma unroll
    for (int d0 = 0; d0 < 8; ++d0) { const LAS unsigned char* a = kb[d0 & 3] + (d0 >> 2) * 128;
        const bf16x8 b0 = *(const LAS bf16x8*)a; const bf16x8 b1 = *(const LAS bf16x8*)(a + 32 * 256);
        p0 = __builtin_amdgcn_mfma_f32_32x32x16_bf16(b0, qr[d0], p0, 0, 0, 0);
        p1 = __builtin_amdgcn_mfma_f32_32x32x16_bf16(b1, qr[d0], p1, 0, 0, 0); }
    if constexpr (EXTRA) {
        p0 = __builtin_amdgcn_mfma_f32_32x32x16_bf16(kx0, qx, p0, 0, 0, 0);
        p1 = __builtin_amdgcn_mfma_f32_32x32x16_bf16(kx1, qx, p1, 0, 0, 0); }
}
__device__ __forceinline__ void pv_tile(f32x16 (&o)[4], int vb, bf16x8 pa0, bf16x8 pa1, bf16x8 pa2, bf16x8 pa3) {
#define AT_TRRD(dst, off) asm volatile("ds_read_b64_tr_b16 %0, %1 offset:%2" : "=&v"(dst) : "v"(vb), "i"(off) : "memory")
#define AT_PV_D0(d0) do { s16x4 l0, l1, l2, l3, h0, h1, h2, h3; constexpr int b_ = (d0) * 512; \
        AT_TRRD(l0, b_); AT_TRRD(h0, b_ + 2048); AT_TRRD(l1, b_ + 4096); AT_TRRD(h1, b_ + 6144); AT_TRRD(l2, b_ + 8192); AT_TRRD(h2, b_ + 10240); AT_TRRD(l3, b_ + 12288); AT_TRRD(h3, b_ + 14336); \
        asm volatile("s_waitcnt lgkmcnt(0)" ::: "memory"); __builtin_amdgcn_sched_barrier(0); \
        o[d0] = __builtin_amdgcn_mfma_f32_32x32x16_bf16(pa0, (bf16x8){l0[0], l0[1], l0[2], l0[3], h0[0], h0[1], h0[2], h0[3]}, o[d0], 0, 0, 0); \
        o[d0] = __builtin_amdgcn_mfma_f32_32x32x16_bf16(pa1, (bf16x8){l1[0], l1[1], l1[2], l1[3], h1[0], h1[1], h1[2], h1[3]}, o[d0], 0, 0, 0); \
        o[d0] = __builtin_amdgcn_mfma_f32_32x32x16_bf16(pa2, (bf16x8){l2[0], l2[1], l2[2], l2[3], h2[0], h2[1], h2[2], h2[3]}, o[d0], 0, 0, 0); \
        o[d0] = __builtin_amdgcn_mfma_f32_32x32x16_bf16(pa3, (bf16x8){l3[0], l3[1], l3[2], l3[3], h3[0], h3[1], h3[2], h3[3]}, o[d0], 0, 0, 0); } while (0)
    AT_PV_D0(0); AT_PV_D0(1); AT_PV_D0(2); AT_PV_D0(3);
#undef AT_PV_D0
#undef AT_TRRD
}
__device__ __forceinline__ float swap_max(float v) { auto rr = __builtin_amdgcn_permlane32_swap(__float_as_uint(v), __float_as_uint(v), false, false); return fmaxf(__uint_as_float(rr[0]), __uint_as_float(rr[1])); }
__device__ __forceinline__ float swap_sum(float v) { auto rr = __builtin_amdgcn_permlane32_swap(__float_as_uint(v), __float_as_uint(v), false, false); return __uint_as_float(rr[0]) + __uint_as_float(rr[1]); }
__device__ __forceinline__ void pack_p(const f32x16& P, bf16x8& outA, bf16x8& outB) {
#define AT_PK4(B_, OUT) do { unsigned a0 = cvt_pk_bf16(P[B_ + 0], P[B_ + 1]), a1 = cvt_pk_bf16(P[B_ + 2], P[B_ + 3]); \
        unsigned b0 = cvt_pk_bf16(P[B_ + 4], P[B_ + 5]), b1 = cvt_pk_bf16(P[B_ + 6], P[B_ + 7]); \
        auto r0 = __builtin_amdgcn_permlane32_swap(a0, b0, false, false); auto r1 = __builtin_amdgcn_permlane32_swap(a1, b1, false, false); \
        u32x4 w = {r0[0], r1[0], r0[1], r1[1]}; OUT = *reinterpret_cast<bf16x8*>(&w); } while (0)
    AT_PK4(0, outA); AT_PK4(8, outB);
#undef AT_PK4
}
__device__ __forceinline__ float online_sm1(const f32x16& p0, const f32x16& p1, float& m_reg, float& mnL) {
    float pmax = p0[0];
#pragma unroll
    for (int r = 1; r < 16; ++r) pmax = fmaxf(pmax, p0[r]);
#pragma unroll
    for (int r = 0; r < 16; ++r) pmax = fmaxf(pmax, p1[r]);
    pmax = swap_max(pmax);
    float mn, alpha;
    if (__all(pmax - m_reg <= THR)) { mn = m_reg; alpha = 1.f; }
    else { mn = fmaxf(m_reg, pmax); alpha = __builtin_amdgcn_exp2f((m_reg - mn) * LOG2E); m_reg = mn; }
    mnL = -mn * LOG2E;
    return alpha;
}
__device__ __forceinline__ float online_sm1_raw(const f32x16& p0, const f32x16& p1, float& m_reg, float& mnL, float base2, bool on = true) {
    float pmax = p0[0];
#pragma unroll
    for (int r = 1; r < 16; ++r) pmax = fmaxf(pmax, p0[r]);
#pragma unroll
    for (int r = 0; r < 16; ++r) pmax = fmaxf(pmax, p1[r]);
    pmax = on ? fmaf(swap_max(pmax), SCALE, base2) : -INFINITY;
    float mn, alpha;
    if (__all(pmax - m_reg <= THR)) { mn = m_reg; alpha = 1.f; }
    else { mn = fmaxf(m_reg, pmax); alpha = __builtin_amdgcn_exp2f((m_reg - mn) * LOG2E); m_reg = mn; }
    mnL = on ? (base2 - mn) * LOG2E : -INFINITY;
    return alpha;
}
__device__ __forceinline__ void online_sm2_raw(f32x16& p0, f32x16& p1, float mnL, float alpha, float& l_reg) {
    constexpr float C2 = SCALE * LOG2E;
    float ps = 0.f;
#pragma unroll
    for (int r = 0; r < 16; ++r) { p0[r] = __builtin_amdgcn_exp2f(fmaf(p0[r], C2, mnL)); p1[r] = __builtin_amdgcn_exp2f(fmaf(p1[r], C2, mnL)); ps += p0[r] + p1[r]; }
    ps = swap_sum(ps);
    l_reg = l_reg * alpha + ps;
}
__device__ __forceinline__ void online_sm2(f32x16& p0, f32x16& p1, float mnL, float alpha, float& l_reg) {
    float ps = 0.f;
#pragma unroll
    for (int r = 0; r < 16; ++r) { p0[r] = __builtin_amdgcn_exp2f(fmaf(p0[r], LOG2E, mnL)); p1[r] = __builtin_amdgcn_exp2f(fmaf(p1[r], LOG2E, mnL)); ps += p0[r] + p1[r]; }
    ps = swap_sum(ps);
    l_reg = l_reg * alpha + ps;
}
template <int MODE>
__device__ __forceinline__ void branch_loop(f32x16 (&o)[4], float& l_out, LAS unsigned char* lds, const bf16_t* Kp, const bf16_t* Vp, int jlo, int qt,
                                            const bf16x8 (&qr)[8], int tq, float slope, unsigned selbits, int r32, int hi, int sr, int sc, LAS float* wsc, int wave_tmin, int grpB,
                                            const Stage& P0, const Stage& P1  ,
                                            const LAS int* jl  ) {
    float m_reg = -1e30f, l_reg = 0.f;
#pragma unroll
    for (int d = 0; d < 4; ++d)
#pragma unroll
        for (int r = 0; r < 16; ++r) o[d][r] = 0.f;
    const int vb0 = (int)(uintptr_t)(lds + OFF_V) + v_rd_base(r32 + 32 * hi);
    const int NT = (MODE == 1) ? __builtin_amdgcn_readfirstlane(jl[32]) : qt - jlo + 1;
#define AT_TJ(t) ((MODE == 1) ? __builtin_amdgcn_readfirstlane(jl[t]) : jlo + (t))
    unsigned xk0w, xk1w, xqw;
    { const float sv = slope * (1.f / SCALE); const bf16_t shi = f2bf(sv), slo = f2bf(sv - bf2f(shi));
      xk0w = hi ? 0u : (unsigned)f2bf((float)r32) * 0x10001u; xk1w = hi ? 0u : (unsigned)f2bf((float)(32 + r32)) * 0x10001u; xqw = hi ? 0u : ((unsigned)shi | ((unsigned)slo << 16)); }
#define AT_LGKM0() asm volatile("s_waitcnt lgkmcnt(0)" ::: "memory")
#define AT_BAR() do { AT_LGKM0(); __builtin_amdgcn_s_barrier(); asm volatile("" ::: "memory"); } while (0)
    Stage S0; stage_write(P0, lds, 0, sr, sc); if (NT > 1) stage_write(P1, lds, 1, sr, sc);
    if (NT > 2) stage_load(S0, Kp, Vp, PROJ_LD, AT_TJ(2) * 64, sr, sc);
    __syncthreads();
    if (grpB) AT_BAR();
    int buf = 0;
#define AT_STEP(tau, SX, DIAG) do { \
        const int j = AT_TJ(tau); \
        f32x16 p0, p1; \
        bf16x8 kx0, kx1, qx; { unsigned t0_ = xk0w, t1_ = xk1w, t2_ = xqw; asm volatile("" : "+v"(t0_), "+v"(t1_), "+v"(t2_)); \
            u32x4 a0_ = {t0_, 0u, 0u, 0u}, a1_ = {t1_, 0u, 0u, 0u}, b0_ = {t2_, 0u, 0u, 0u}; kx0 = *reinterpret_cast<bf16x8*>(&a0_); kx1 = *reinterpret_cast<bf16x8*>(&a1_); qx = *reinterpret_cast<bf16x8*>(&b0_); } \
        qkt<true>(p0, p1, lds + OFF_K + buf * BUF_B, r32, hi, qr, kx0, kx1, qx); \
        const int kbase = j * 64; const int dq = tq - kbase - 4 * hi; \
        const float base2 = slope * (float)(kbase - tq); \
        bool on = true; \
        if (MODE == 1) { \
            on = (selbits >> j) & 1u; \
            if (DIAG) {        \
                _Pragma("unroll") for (int r = 0; r < 16; ++r) { const int cc = (r & 3) + 8 * (r >> 2); if (cc > dq) p0[r] = -INFINITY; if (cc + 32 > dq) p1[r] = -INFINITY; } \
            } \
        } else { \
            if (kbase + 63 > wave_tmin || kbase < wave_tmin + 31 - (WINDOW - 1)) { \
                _Pragma("unroll") for (int r = 0; r < 16; ++r) { const int cc = (r & 3) + 8 * (r >> 2); \
                    if ((unsigned)(dq - cc) >= (unsigned)WINDOW) p0[r] = -INFINITY; if ((unsigned)(dq - cc - 32) >= (unsigned)WINDOW) p1[r] = -INFINITY; } \
            } \
        } \
        float mnL; const float alpha = online_sm1_raw(p0, p1, m_reg, mnL, base2, on); \
        AT_BAR(); \
        if ((tau) + 2 < NT) { int b2 = buf + 2; if (b2 >= 3) b2 -= 3; stage_write(SX, lds, b2, sr, sc); } \
        if ((tau) + 3 < NT) stage_load(SX, Kp, Vp, PROJ_LD, AT_TJ((tau) + 3) * 64, sr, sc); \
        online_sm2_raw(p0, p1, mnL, alpha, l_reg); \
        bf16x8 pa0, pa1, pa2, pa3; pack_p(p0, pa0, pa1); pack_p(p1, pa2, pa3); \
        if (__any(alpha < 1.f)) { if (hi == 0) wsc[r32] = alpha; \
            _Pragma("unroll") for (int r = 0; r < 16; ++r) { const float al = wsc[crow(r, hi)]; \
                _Pragma("unroll") for (int d = 0; d < 4; ++d) o[d][r] *= al; } } \
        pv_tile(o, vb0 + buf * BUF_B, pa0, pa1, pa2, pa3); \
        AT_BAR(); \
        buf = buf + 1; if (buf >= 3) buf = 0; } while (0)
    if (MODE == 1) { for (int tau = 0; tau < NT - 1; ++tau) { AT_STEP(tau, S0, 0); } { const int tau = NT - 1; AT_STEP(tau, S0, 1); } }
    else { for (int tau = 0; tau < NT; ++tau) { AT_STEP(tau, S0, 0); } }
#undef AT_STEP
#undef AT_TJ
    if (!grpB) AT_BAR();
#undef AT_BAR
#undef AT_LGKM0
    l_out = l_reg;
    __syncthreads();
}
}

__device__ __forceinline__ void attn_fast_unit(const Frame& F, const Args& a, int unit) {
    using namespace at;
    unsigned char* ws = F.ws; const bf16_t* PROJ = (const bf16_t*)(ws + WS_PROJ); bf16_t* YM = (bf16_t*)(ws + WS_YMIX);
    LAS unsigned char* lds = F.lds;
    const int qt = 31 - (unit >> 4), bg = unit & 15, b = bg >> 1, g = bg & 1;
    int tz = threadIdx.x; asm volatile("" : "+v"(tz));
    const int lane = tz & 63, r32 = lane & 31, hi = lane >> 5, head = F.wid & 3, qh = F.wid >> 2;
    const int t0 = qt * 64, tq = t0 + qh * 32 + r32, wave_tmin = t0 + qh * 32;
    const int sr = tz >> 4, sc = (tz & 15) * 8;
    const float slope = exp2f(-(float)(g * 4 + head + 1));
    LAS float* wsc = (LAS float*)(lds + OFF_WSC) + F.wid * 256;
    LAS float* imph = (LAS float*)(lds + OFF_IMP);
    LAS unsigned* selm = (LAS unsigned*)(lds + OFF_SELM);
    const bf16_t* Kc = (const bf16_t*)(ws + WS_KC) + (size_t)bg * 128 * 128; const bf16_t* Vc = (const bf16_t*)(ws + WS_VC) + (size_t)bg * 128 * 128;
    Stage Sc0, Sc1; stage_load(Sc0, Kc, Vc, 128, 0, sr, sc); stage_load(Sc1, Kc, Vc, 128, 64, sr, sc);
    bf16x8 qr[8];
    { const bf16_t* qp = PROJ + (size_t)(b * SEQ + tq) * PROJ_LD + C_NQ + (g * 4 + head) * 128 + hi * 8;
#pragma unroll
      for (int d0 = 0; d0 < 8; ++d0) qr[d0] = *(const bf16x8*)(qp + d0 * 16); }
    float gate[3];
    { const bf16_t* gp = PROJ + (size_t)(b * SEQ + tq) * PROJ_LD + C_NGT + (g * 4 + head) * 3;
#pragma unroll
      for (int c = 0; c < 3; ++c) gate[c] = sigmoidf_(bf2f(gp[c])); }
    f32x16 o[4];
    float* otp = (float*)(ws + WS_OT) + ((size_t)F.bid * 512 + tz) * 64;
    { stage_write(Sc0, lds, 0, sr, sc); stage_write(Sc1, lds, 1, sr, sc);
      __syncthreads();
      f32x16 p0, p1, p2, p3;
      qkt(p0, p1, lds + OFF_K, r32, hi, qr); qkt(p2, p3, lds + OFF_K + BUF_B, r32, hi, qr);
      const int dl0 = ((tq - 31) >> 4) - 4 * hi;
      const float base_f = slope * (float)(16 * 4 * hi + 31 - tq);
      float mx = -INFINITY;
#pragma unroll
      for (int r = 0; r < 16; ++r) { const int cc = (r & 3) + 8 * (r >> 2);
          p0[r] = (cc <= dl0)      ? fmaf(p0[r], SCALE, fmaf(slope, (float)(16 * cc), base_f))        : -INFINITY;
          p1[r] = (cc + 32 <= dl0) ? fmaf(p1[r], SCALE, fmaf(slope, (float)(16 * (cc + 32)), base_f)) : -INFINITY;
          p2[r] = (cc + 64 <= dl0) ? fmaf(p2[r], SCALE, fmaf(slope, (float)(16 * (cc + 64)), base_f)) : -INFINITY;
          p3[r] = (cc + 96 <= dl0) ? fmaf(p3[r], SCALE, fmaf(slope, (float)(16 * (cc + 96)), base_f)) : -INFINITY;
          mx = fmaxf(fmaxf(mx, p0[r]), fmaxf(p1[r], fmaxf(p2[r], p3[r]))); }
      mx = swap_max(mx);
      const float mL = (mx == -INFINITY) ? 0.f : -mx * LOG2E;
      float ps = 0.f;
#pragma unroll
      for (int r = 0; r < 16; ++r) { p0[r] = __builtin_amdgcn_exp2f(fmaf(p0[r], LOG2E, mL)); p1[r] = __builtin_amdgcn_exp2f(fmaf(p1[r], LOG2E, mL));
          p2[r] = __builtin_amdgcn_exp2f(fmaf(p2[r], LOG2E, mL)); p3[r] = __builtin_amdgcn_exp2f(fmaf(p3[r], LOG2E, mL)); ps += (p0[r] + p1[r]) + (p2[r] + p3[r]); }
      ps = swap_sum(ps);
      const float inv = ps > 0.f ? 1.f / ps : 0.f;
#pragma unroll
      for (int r = 0; r < 16; ++r) { p0[r] *= inv; p1[r] *= inv; p2[r] *= inv; p3[r] *= inv; }
      { LAS float* dst = imph + ((size_t)head * 64 + qh * 32 + r32) * 32;
        float prev = 0.f;
#define AT_GRP(P, blk) do { _Pragma("unroll") for (int i = 0; i < 4; ++i) { const float av = 2.f * (P[4 * i] + P[4 * i + 1] + P[4 * i + 2]) + P[4 * i + 3]; const float bv = P[4 * i + 3]; \
            auto rr = __builtin_amdgcn_permlane32_swap(__float_as_uint(bv), __float_as_uint(bv), false, false); const float pb = __uint_as_float(hi ? rr[0] : rr[1]); \
            dst[2 * ((blk) * 4 + i) + hi] = av + (hi ? pb : prev); prev = pb; } } while (0)
        AT_GRP(p0, 0); AT_GRP(p1, 1); AT_GRP(p2, 2); AT_GRP(p3, 3);
#undef AT_GRP
      }
      bf16x8 pa0, pa1, pa2, pa3;
#pragma unroll
      for (int d = 0; d < 4; ++d)
#pragma unroll
          for (int r = 0; r < 16; ++r) o[d][r] = 0.f;
      const int vb0 = (int)(uintptr_t)(lds + OFF_V) + v_rd_base(lane);
      pack_p(p0, pa0, pa1); pack_p(p1, pa2, pa3); pv_tile(o, vb0, pa0, pa1, pa2, pa3);
      pack_p(p2, pa0, pa1); pack_p(p3, pa2, pa3); pv_tile(o, vb0 + BUF_B, pa0, pa1, pa2, pa3);
      if (hi == 0) wsc[r32] = gate[0];
#pragma unroll
      for (int r = 0; r < 16; ++r) { const float f = wsc[crow(r, hi)];
#pragma unroll
          for (int d = 0; d < 4; ++d) o[d][r] *= f; }
#pragma unroll
      for (int d = 0; d < 4; ++d)
#pragma unroll
          for (int k = 0; k < 4; ++k) *(f32x4*)(otp + d * 16 + 4 * k) = (f32x4){o[d][4 * k], o[d][4 * k + 1], o[d][4 * k + 2], o[d][4 * k + 3]};
    }
    __syncthreads();
    const bf16_t* Ksl = PROJ + (size_t)(b * SEQ) * PROJ_LD + C_KSL + g * 128; const bf16_t* Vsl = PROJ + (size_t)(b * SEQ) * PROJ_LD + C_VSL + g * 128;
    Stage Pa, Pb; stage_load(Pa, Ksl, Vsl, PROJ_LD, 0, sr, sc);
    { const int q = tz >> 3, part = tz & 7, tqq = t0 + q, cur = tqq >> 6;
      unsigned bits = 0u;
      if (cur < SEL_TOP) { bits = (part == 0) ? ((2u << cur) - 1u) : 0u; }
      else {
          float sc_[4];
#pragma unroll
          for (int k = 0; k < 4; ++k) { const int j = part * 4 + k; const float v = ((imph[(0 * 64 + q) * 32 + j] + imph[(1 * 64 + q) * 32 + j]) + imph[(2 * 64 + q) * 32 + j]) + imph[(3 * 64 + q) * 32 + j];
              const bool forced = (j == 0) || (j == cur) || (j == cur - 1); sc_[k] = forced ? 1e4f : (j <= cur ? v : -1e4f); }
          int rank[4] = {0, 0, 0, 0};
          for (int jj = 0; jj < 32; ++jj) { const float v = ((imph[(0 * 64 + q) * 32 + jj] + imph[(1 * 64 + q) * 32 + jj]) + imph[(2 * 64 + q) * 32 + jj]) + imph[(3 * 64 + q) * 32 + jj];
              const bool forced = (jj == 0) || (jj == cur) || (jj == cur - 1); const float s2 = forced ? 1e4f : (jj <= cur ? v : -1e4f);
#pragma unroll
              for (int k = 0; k < 4; ++k) { const int j = part * 4 + k; rank[k] += (s2 > sc_[k] || (s2 == sc_[k] && jj < j)) ? 1 : 0; } }
#pragma unroll
          for (int k = 0; k < 4; ++k) { const int j = part * 4 + k; if (rank[k] < SEL_TOP && j <= cur) bits |= 1u << j; }
      }
      bits |= __shfl_xor(bits, 1); bits |= __shfl_xor(bits, 2); bits |= __shfl_xor(bits, 4);
      if (part == 0) selm[q] = bits; }
    __syncthreads();
    LAS int* jlist = (LAS int*)(lds + OFF_WSC + 8192);
    if (F.wid == 0) { unsigned um = selm[lane];
        um |= __shfl_xor(um, 1); um |= __shfl_xor(um, 2); um |= __shfl_xor(um, 4); um |= __shfl_xor(um, 8); um |= __shfl_xor(um, 16); um |= __shfl_xor(um, 32);
        if (lane == 0) { int n = 0; for (int j = 0; j <= qt; ++j) if ((um >> j) & 1u) jlist[n++] = j; jlist[32] = n; for (int j = n; j < 32; ++j) jlist[j] = qt; } }
    __syncthreads();
    const unsigned selbits = selm[qh * 32 + r32];
    if (jlist[32] > 1) stage_load(Pb, Ksl, Vsl, PROJ_LD, jlist[1] * 64, sr, sc);
    const int jlo = (t0 - (WINDOW - 1)) > 0 ? (t0 - (WINDOW - 1)) >> 6 : 0;
    const bf16_t* Kwn = PROJ + (size_t)(b * SEQ) * PROJ_LD + C_KWN + g * 128; const bf16_t* Vwn = PROJ + (size_t)(b * SEQ) * PROJ_LD + C_VWN + g * 128;
    { float l_sel;
      branch_loop<1>(o, l_sel, lds, Ksl, Vsl, 0, qt, qr, tq, slope, selbits, r32, hi, sr, sc, wsc, wave_tmin, qh, Pa, Pb, jlist);
      stage_load(Pa, Kwn, Vwn, PROJ_LD, jlo * 64, sr, sc); stage_load(Pb, Kwn, Vwn, PROJ_LD, (jlo + 1) * 64, sr, sc);
      if (hi == 0) wsc[r32] = gate[1] / l_sel;
#pragma unroll
      for (int r = 0; r < 16; ++r) { const float f = wsc[crow(r, hi)];
#pragma unroll
          for (int d = 0; d < 4; ++d) o[d][r] *= f; }
#pragma unroll
      for (int d = 0; d < 4; ++d)
#pragma unroll
          for (int k = 0; k < 4; ++k) { const f32x4 pv = *(const f32x4*)(otp + d * 16 + 4 * k); *(f32x4*)(otp + d * 16 + 4 * k) = pv + (f32x4){o[d][4 * k], o[d][4 * k + 1], o[d][4 * k + 2], o[d][4 * k + 3]}; } }
    { float l_win;
      branch_loop<2>(o, l_win, lds, Kwn, Vwn, jlo, qt, qr, tq, slope, 0u, r32, hi, sr, sc, wsc, wave_tmin, qh, Pa, Pb, jlist);
      if (hi == 0) wsc[r32] = gate[2] / l_win;
#pragma unroll
      for (int r = 0; r < 16; ++r) { const float f = wsc[crow(r, hi)];
#pragma unroll
          for (int d = 0; d < 4; ++d) o[d][r] *= f; }
#pragma unroll
      for (int d = 0; d < 4; ++d)
#pragma unroll
          for (int k = 0; k < 4; ++k) { const f32x4 pv = *(const f32x4*)(otp + d * 16 + 4 * k); o[d][4 * k] += pv[0]; o[d][4 * k + 1] += pv[1]; o[d][4 * k + 2] += pv[2]; o[d][4 * k + 3] += pv[3]; } }
    { const float* ng = a.in[I_NSAG];
      float gsc[4];
#pragma unroll
      for (int d = 0; d < 4; ++d) gsc[d] = ng[d * 32 + r32];
#pragma unroll
      for (int r = 0; r < 16; ++r) { float ss = 0.f;
#pragma unroll
          for (int d = 0; d < 4; ++d) ss += o[d][r] * o[d][r];
          ss += __shfl_xor(ss, 1); ss += __shfl_xor(ss, 2); ss += __shfl_xor(ss, 4); ss += __shfl_xor(ss, 8); ss += __shfl_xor(ss, 16);
          const float rs = rsqrtf(ss * (1.f / 128.f) + EPS);
          const int row = b * SEQ + t0 + qh * 32 + crow(r, hi);
          bf16_t* yp = YM + (size_t)row * DM + HG_W + (g * 4 + head) * 128 + r32;
#pragma unroll
          for (int d = 0; d < 4; ++d) yp[d * 32] = f2bf(o[d][r] * rs * gsc[d]); } }
    __syncthreads();
}

namespace hg {
constexpr int T_KD = 0, T_QD = 16384, T_V = 32768, T_KL = 49152, T_FR = 65536, T_QR = 81920, T_OR = 98304, T_PART = 114688, T_DL = T_PART + 4096, T_SSQ = T_DL + 512;
}
__device__ __forceinline__ void hgrn_fast_unit(const Frame& F, const Args& a, int unit) {
    using namespace hg; using at::crow; using at::v_st; using at::v_rd_base; typedef at::s16x4 s16x4;
    unsigned char* ws = F.ws; const bf16_t* PROJ = (const bf16_t*)(ws + WS_PROJ); bf16_t* YM = (bf16_t*)(ws + WS_YMIX);
    LAS unsigned char* lds = F.lds;
    const int b = unit >> 3, h = unit & 7;
    int tz = threadIdx.x; asm volatile("" : "+v"(tz));
    const int lane = tz & 63, r32 = lane & 31, hi = lane >> 5, th = F.wid >> 2, vq = F.wid & 3;
    const int lr = tz >> 4, lc = (tz & 15) * 8;
    const int kp = tz & 63, tg = tz >> 6;
    LAS float* part = (LAS float*)(lds + T_PART); LAS float* dl = (LAS float*)(lds + T_DL); LAS float* ssq = (LAS float*)(lds + T_SSQ);
    f32x16 Sacc[4];
#pragma unroll
    for (int k = 0; k < 4; ++k)
#pragma unroll
        for (int r = 0; r < 16; ++r) Sacc[k][r] = 0.f;
    const bf16_t* base = PROJ + (size_t)(b * SEQ) * PROJ_LD + h * 128;
    u32x4 rf0, rf1, rq0, rq1, ri0, ri1, ro0, ro1;
    const bf16_t* obase = (const bf16_t*)(ws + WS_OMF) + (size_t)(b * SEQ) * HG_W + h * 128;
#define HG_LOAD(t0_) do { const bf16_t* p0_ = base + (size_t)((t0_) + lr) * PROJ_LD + lc; const bf16_t* p1_ = p0_ + (size_t)32 * PROJ_LD; \
        rf0 = *(const u32x4*)(p0_ + C_HF); rf1 = *(const u32x4*)(p1_ + C_HF); rq0 = *(const u32x4*)(p0_ + C_HQ); rq1 = *(const u32x4*)(p1_ + C_HQ); \
        ri0 = *(const u32x4*)(p0_ + C_HI); ri1 = *(const u32x4*)(p1_ + C_HI); \
        ro0 = *(const u32x4*)(obase + (size_t)((t0_) + lr) * HG_W + lc); ro1 = *(const u32x4*)(obase + (size_t)((t0_) + lr + 32) * HG_W + lc); } while (0)
    HG_LOAD(0);
    const float ngv = a.in[I_HGNG][vq * 32 + r32];
    for (int c = 0; c < SEQ / 64; ++c) {
        const int t0 = c * 64;
        *(LAS u32x4*)(lds + T_FR + lr * 256 + lc * 2) = rf0; *(LAS u32x4*)(lds + T_FR + (lr + 32) * 256 + lc * 2) = rf1;
        *(LAS u32x4*)(lds + T_QR + lr * 256 + lc * 2) = rq0; *(LAS u32x4*)(lds + T_QR + (lr + 32) * 256 + lc * 2) = rq1;
        *(LAS u32x4*)(lds + T_OR + lr * 256 + lc * 2) = ro0; *(LAS u32x4*)(lds + T_OR + (lr + 32) * 256 + lc * 2) = ro1;
        *(LAS u32x4*)(lds + T_V + v_st(lr, lc)) = ri0; *(LAS u32x4*)(lds + T_V + v_st(lr + 32, lc)) = ri1;
        __syncthreads();
        float lf0[8], lf1[8]; float run0 = 0.f, run1 = 0.f;
#pragma unroll
        for (int i = 0; i < 8; ++i) { const int t = tg * 8 + i; const unsigned w = *(const LAS unsigned*)(lds + T_FR + t * 256 + kp * 4);
            run0 += __uint_as_float(w << 16); run1 += __uint_as_float(w & 0xffff0000u); lf0[i] = run0; lf1[i] = run1; }
        *(LAS f32x2*)(part + tg * 128 + 2 * kp) = (f32x2){run0, run1};
        __syncthreads();
        { float pre0 = 0.f, pre1 = 0.f, tot0 = 0.f, tot1 = 0.f;
#pragma unroll
          for (int gq = 0; gq < 8; ++gq) { const f32x2 pv = *(const LAS f32x2*)(part + gq * 128 + 2 * kp); tot0 += pv[0]; tot1 += pv[1]; if (gq < tg) { pre0 += pv[0]; pre1 += pv[1]; } }
          const float dlast0 = __builtin_amdgcn_exp2f(tot0), dlast1 = __builtin_amdgcn_exp2f(tot1);
          if (tg == 0) *(LAS f32x2*)(dl + 2 * kp) = (f32x2){dlast0, dlast1};
#pragma unroll
          for (int i = 0; i < 8; ++i) { const int t = tg * 8 + i; const float bb0 = pre0 + lf0[i], bb1 = pre1 + lf1[i];
              const unsigned qw = *(const LAS unsigned*)(lds + T_QR + t * 256 + kp * 4), ow = *(const LAS unsigned*)(lds + T_OR + t * 256 + kp * 4);
              const float qd0 = __uint_as_float(qw << 16) * __builtin_amdgcn_exp2f(bb0), qd1 = __uint_as_float(qw & 0xffff0000u) * __builtin_amdgcn_exp2f(bb1);
              const float kd0 = __uint_as_float(ow << 16) * __builtin_amdgcn_exp2f(-bb0), kd1 = __uint_as_float(ow & 0xffff0000u) * __builtin_amdgcn_exp2f(-bb1);
              const int ko = AT_KSWZ(t, kp * 4);
              *(LAS unsigned*)(lds + T_QD + ko) = cvt_pk_bf16(qd0, qd1); *(LAS unsigned*)(lds + T_KD + ko) = cvt_pk_bf16(kd0, kd1);
              *(LAS unsigned*)(lds + T_KL + v_st(t, 2 * kp)) = cvt_pk_bf16(kd0 * dlast0, kd1 * dlast1); } }
        __syncthreads();
        if (c + 1 < SEQ / 64) HG_LOAD(t0 + 64);
        const int tl = th * 32 + r32;
        bf16x8 qr[8];
#pragma unroll
        for (int d0 = 0; d0 < 8; ++d0) qr[d0] = *(const LAS bf16x8*)(lds + T_QD + AT_KSWZ(tl, (d0 * 16 + hi * 8) * 2));
        bf16x8 pa0, pa1, pa2, pa3;
        if (th == 0) {
            f32x16 p0;
#pragma unroll
            for (int r = 0; r < 16; ++r) p0[r] = 0.f;
#pragma unroll
            for (int d0 = 0; d0 < 8; ++d0) { const bf16x8 b0 = *(const LAS bf16x8*)(lds + T_KD + AT_KSWZ(r32, (d0 * 16 + hi * 8) * 2)); p0 = __builtin_amdgcn_mfma_f32_32x32x16_bf16(b0, qr[d0], p0, 0, 0, 0); }
#pragma unroll
            for (int r = 0; r < 16; ++r) { const int s = crow(r, hi); if (s > tl) p0[r] = 0.f; }
            at::pack_p(p0, pa0, pa1); pa2 = (bf16x8){0, 0, 0, 0, 0, 0, 0, 0}; pa3 = pa2;
        } else {
            f32x16 p0, p1;
            at::qkt(p0, p1, lds + T_KD, r32, hi, qr);
#pragma unroll
            for (int r = 0; r < 16; ++r) { const int s = crow(r, hi); if (s + 32 > tl) p1[r] = 0.f; }
            at::pack_p(p0, pa0, pa1); at::pack_p(p1, pa2, pa3);
        }
        f32x16 o;
#pragma unroll
        for (int r = 0; r < 16; ++r) o[r] = 0.f;
        const int vb = (int)(uintptr_t)(lds + T_V) + v_rd_base(lane) + vq * 512;
        const int klb = (int)(uintptr_t)(lds + T_KL) + v_rd_base(lane);
#define HG_TRRD(dst, addr, off) asm volatile("ds_read_b64_tr_b16 %0, %1 offset:%2" : "=&v"(dst) : "v"(addr), "i"(off) : "memory")
        s16x4 vl0, vh0, vl1, vh1, vl2, vh2, vl3, vh3;
        HG_TRRD(vl0, vb, 0); HG_TRRD(vh0, vb, 2048); HG_TRRD(vl1, vb, 4096); HG_TRRD(vh1, vb, 6144); HG_TRRD(vl2, vb, 8192); HG_TRRD(vh2, vb, 10240); HG_TRRD(vl3, vb, 12288); HG_TRRD(vh3, vb, 14336);
        asm volatile("s_waitcnt lgkmcnt(0)" ::: "memory"); __builtin_amdgcn_sched_barrier(0);
        const bf16x8 vf0 = (bf16x8){vl0[0], vl0[1], vl0[2], vl0[3], vh0[0], vh0[1], vh0[2], vh0[3]}, vf1 = (bf16x8){vl1[0], vl1[1], vl1[2], vl1[3], vh1[0], vh1[1], vh1[2], vh1[3]};
        const bf16x8 vf2 = (bf16x8){vl2[0], vl2[1], vl2[2], vl2[3], vh2[0], vh2[1], vh2[2], vh2[3]}, vf3 = (bf16x8){vl3[0], vl3[1], vl3[2], vl3[3], vh3[0], vh3[1], vh3[2], vh3[3]};
        o = __builtin_amdgcn_mfma_f32_32x32x16_bf16(pa0, vf0, o, 0, 0, 0); o = __builtin_amdgcn_mfma_f32_32x32x16_bf16(pa1, vf1, o, 0, 0, 0);
        o = __builtin_amdgcn_mfma_f32_32x32x16_bf16(pa2, vf2, o, 0, 0, 0); o = __builtin_amdgcn_mfma_f32_32x32x16_bf16(pa3, vf3, o, 0, 0, 0);
#pragma unroll
        for (int kb = 0; kb < 4; ++kb)
#pragma unroll
            for (int sp = 0; sp < 2; ++sp) {
                const u32x2 a_lo = *(const LAS u32x2*)(lds + T_QD + tl * 256 + ((((4 * kb + 2 * sp) * 16)) ^ ((tl & 7) << 4)) + 8 * hi);
                const u32x2 a_hi = *(const LAS u32x2*)(lds + T_QD + tl * 256 + ((((4 * kb + 2 * sp + 1) * 16)) ^ ((tl & 7) << 4)) + 8 * hi);
                u32x4 aw = {a_lo[0], a_lo[1], a_hi[0], a_hi[1]};
                u32x4 bw = {cvt_pk_bf16(Sacc[kb][8 * sp + 0], Sacc[kb][8 * sp + 1]), cvt_pk_bf16(Sacc[kb][8 * sp + 2], Sacc[kb][8 * sp + 3]),
                            cvt_pk_bf16(Sacc[kb][8 * sp + 4], Sacc[kb][8 * sp + 5]), cvt_pk_bf16(Sacc[kb][8 * sp + 6], Sacc[kb][8 * sp + 7])};
                o = __builtin_amdgcn_mfma_f32_32x32x16_bf16(*reinterpret_cast<bf16x8*>(&aw), *reinterpret_cast<bf16x8*>(&bw), o, 0, 0, 0); }
        float gt[16];
#pragma unroll
        for (int r = 0; r < 16; ++r) gt[r] = bf2f(base[(size_t)(t0 + th * 32 + crow(r, hi)) * PROJ_LD + C_HGT + vq * 32 + r32]);
#define HG_SUPD(kb) do { \
            _Pragma("unroll") for (int i4 = 0; i4 < 4; ++i4) { const f32x4 dv = *(const LAS f32x4*)(dl + (kb) * 32 + 8 * i4 + 4 * hi); \
                Sacc[kb][4 * i4] *= dv[0]; Sacc[kb][4 * i4 + 1] *= dv[1]; Sacc[kb][4 * i4 + 2] *= dv[2]; Sacc[kb][4 * i4 + 3] *= dv[3]; } \
            s16x4 al0, ah0, al1, ah1, al2, ah2, al3, ah3; \
            HG_TRRD(al0, klb, (kb) * 512); HG_TRRD(ah0, klb, (kb) * 512 + 2048); HG_TRRD(al1, klb, (kb) * 512 + 4096); HG_TRRD(ah1, klb, (kb) * 512 + 6144); \
            HG_TRRD(al2, klb, (kb) * 512 + 8192); HG_TRRD(ah2, klb, (kb) * 512 + 10240); HG_TRRD(al3, klb, (kb) * 512 + 12288); HG_TRRD(ah3, klb, (kb) * 512 + 14336); \
            asm volatile("s_waitcnt lgkmcnt(0)" ::: "memory"); __builtin_amdgcn_sched_barrier(0); \
            Sacc[kb] = __builtin_amdgcn_mfma_f32_32x32x16_bf16((bf16x8){al0[0], al0[1], al0[2], al0[3], ah0[0], ah0[1], ah0[2], ah0[3]}, vf0, Sacc[kb], 0, 0, 0); \
            Sacc[kb] = __builtin_amdgcn_mfma_f32_32x32x16_bf16((bf16x8){al1[0], al1[1], al1[2], al1[3], ah1[0], ah1[1], ah1[2], ah1[3]}, vf1, Sacc[kb], 0, 0, 0); \
            Sacc[kb] = __builtin_amdgcn_mfma_f32_32x32x16_bf16((bf16x8){al2[0], al2[1], al2[2], al2[3], ah2[0], ah2[1], ah2[2], ah2[3]}, vf2, Sacc[kb], 0, 0, 0); \
            Sacc[kb] = __builtin_amdgcn_mfma_f32_32x32x16_bf16((bf16x8){al3[0], al3[1], al3[2], al3[3], ah3[0], ah3[1], ah3[2], ah3[3]}, vf3, Sacc[kb], 0, 0, 0); } while (0)
        HG_SUPD(0); HG_SUPD(1); HG_SUPD(2); HG_SUPD(3);
#undef HG_SUPD
#undef HG_TRRD
        { float y8[8], y4[4], y2[2], y1;
          const bool b4 = (r32 & 16) != 0, b3 = (r32 & 8) != 0, b2 = (r32 & 4) != 0, b1 = (r32 & 2) != 0;
#pragma unroll
          for (int i = 0; i < 8; ++i) { const float lo = o[i] * o[i], hi_ = o[8 + i] * o[8 + i]; const float keep = b4 ? hi_ : lo, send = b4 ? lo : hi_; y8[i] = keep + __shfl_xor(send, 16); }
#pragma unroll
          for (int i = 0; i < 4; ++i) { const float keep = b3 ? y8[4 + i] : y8[i], send = b3 ? y8[i] : y8[4 + i]; y4[i] = keep + __shfl_xor(send, 8); }
#pragma unroll
          for (int i = 0; i < 2; ++i) { const float keep = b2 ? y4[2 + i] : y4[i], send = b2 ? y4[i] : y4[2 + i]; y2[i] = keep + __shfl_xor(send, 4); }
          { const float keep = b1 ? y2[1] : y2[0], send = b1 ? y2[0] : y2[1]; y1 = keep + __shfl_xor(send, 2); }
          y1 += __shfl_xor(y1, 1);
          const int rf = ((r32 >> 1) & 15);
          if ((r32 & 1) == 0) ssq[vq * 64 + th * 32 + crow(rf, hi)] = y1; }
        __syncthreads();
        { bf16_t* yb = YM + (size_t)(b * SEQ + t0 + th * 32) * DM + h * 128 + vq * 32;
          const unsigned loff = (unsigned)(4 * hi) * DM + (unsigned)r32;
          LAS float* wrs = (LAS float*)(lds + T_SSQ + 1024) + F.wid * 32;
          if (lane < 32) { const int t = th * 32 + lane; const float ss = ((ssq[t] + ssq[64 + t]) + ssq[128 + t]) + ssq[192 + t]; wrs[lane] = rsqrtf(ss * (1.f / 128.f) + EPS); }
          f32x4 rsv[4];
#pragma unroll
          for (int i = 0; i < 4; ++i) rsv[i] = *(const LAS f32x4*)(wrs + 8 * i + 4 * hi);
#pragma unroll
          for (int r = 0; r < 16; ++r) { const int tc = (r & 3) + 8 * (r >> 2);
              (yb + (size_t)tc * DM)[loff] = f2bf(o[r] * (rsv[r >> 2][r & 3] * ngv) * gt[r]); } }
    }
#undef HG_LOAD
    __syncthreads();
}

__device__ __forceinline__ void compress_fast_unit(const Frame& F, const Args& a, int u) {
    unsigned char* ws = F.ws; const bf16_t* PROJ = (const bf16_t*)(ws + WS_PROJ); LAS unsigned char* lds = F.lds;
    const int j = u >> 6, bg = (u >> 2) & 15, mt = u & 3, b = bg >> 1, g = bg & 1;
    int tz = threadIdx.x; asm volatile("" : "+v"(tz));
    const int lane = tz & 63, r32 = lane & 31, hi = lane >> 5, w = F.wid;
    const int n = mt * 32 + r32, nl = n < 126 ? n : 126;
    const bf16_t* W2T = (const bf16_t*)(ws + WS_W2T) + (size_t)j * 128 * 128;
    const int colb = (j ? C_VCM : C_KCM) + g * 128;
    const bf16_t* arow = PROJ + (size_t)(b * SEQ + 16 * nl) * PROJ_LD + colb + hi * 8;
    const bf16_t* bfrag = (const bf16_t*)(ws + WS_W1T) + ((size_t)(j * 8 + w) * 32 * 4 * 64 + lane) * 8;
    f32x16 acc[4];
#pragma unroll
    for (int c = 0; c < 4; ++c)
#pragma unroll
        for (int r = 0; r < 16; ++r) acc[c][r] = 0.f;
#pragma unroll 4
    for (int ks = 0; ks < 32; ++ks) {
        const int l = 4 * w + (ks >> 3), d = (ks & 7) * 16;
        const bf16x8 af = *(const bf16x8*)(arow + (size_t)l * PROJ_LD + d);
#pragma unroll
        for (int c = 0; c < 4; ++c) { const bf16x8 bfr = *(const bf16x8*)(bfrag + (size_t)(ks * 4 + c) * 64 * 8);
            acc[c] = __builtin_amdgcn_mfma_f32_32x32x16_bf16(af, bfr, acc[c], 0, 0, 0); }
    }
    LAS float* red = (LAS float*)lds;
#pragma unroll
    for (int c = 0; c < 4; ++c)
#pragma unroll
        for (int r = 0; r < 16; ++r) red[(w * 32 + at::crow(r, hi)) * 128 + c * 32 + r32] = acc[c][r];
    __syncthreads();
    LAS unsigned char* hdn = lds + 131072 - 8192;
    { const int nn = tz >> 4, c8 = (tz & 15) * 8; float sv[8];
      const float* b1 = (const float*)(ws + WS_B1P) + (size_t)j * 32 * 128 + c8;
#pragma unroll
      for (int i = 0; i < 8; ++i) sv[i] = 0.f;
#pragma unroll 4
      for (int kg = 0; kg < 32; ++kg) { const f32x4 x0 = *(const f32x4*)(b1 + kg * 128), x1 = *(const f32x4*)(b1 + kg * 128 + 4);
#pragma unroll
          for (int i = 0; i < 4; ++i) { sv[i] += x0[i]; sv[4 + i] += x1[i]; } }
#pragma unroll
      for (int ww = 0; ww < 8; ++ww) { const f32x4 x0 = *(const LAS f32x4*)(red + (ww * 32 + nn) * 128 + c8), x1 = *(const LAS f32x4*)(red + (ww * 32 + nn) * 128 + c8 + 4);
#pragma unroll
          for (int i = 0; i < 4; ++i) { sv[i] += x0[i]; sv[4 + i] += x1[i]; } }
      __syncthreads();
#pragma unroll
      for (int i = 0; i < 8; ++i) sv[i] = gelu_tanh(sv[i]);
      u32x4 pw; pw[0] = cvt_pk_bf16(sv[0], sv[1]); pw[1] = cvt_pk_bf16(sv[2], sv[3]); pw[2] = cvt_pk_bf16(sv[4], sv[5]); pw[3] = cvt_pk_bf16(sv[6], sv[7]);
      *(LAS u32x4*)(hdn + AT_KSWZ(nn, c8 * 2)) = pw; }
    __syncthreads();
    if (w < 4) {
        f32x16 o2;
#pragma unroll
        for (int r = 0; r < 16; ++r) o2[r] = 0.f;
#pragma unroll
        for (int ks = 0; ks < 8; ++ks) { const bf16x8 af = *(const LAS bf16x8*)(hdn + AT_KSWZ(r32, (ks * 16 + hi * 8) * 2));
            const bf16x8 bfr = *(const bf16x8*)(W2T + (size_t)(w * 32 + r32) * 128 + ks * 16 + hi * 8);
            o2 = __builtin_amdgcn_mfma_f32_32x32x16_bf16(af, bfr, o2, 0, 0, 0); }
        bf16_t* dst = (bf16_t*)(ws + (DEBUG_CMP ? (j ? WS_Y + 1048576 : WS_Y) : (j ? WS_VC : WS_KC))) + (size_t)bg * 128 * 128;
#pragma unroll
        for (int r = 0; r < 16; ++r) { const int nn = mt * 32 + at::crow(r, hi); dst[(size_t)nn * 128 + w * 32 + r32] = (nn < NCMP) ? f2bf(o2[r]) : (bf16_t)0; }
    }
    __syncthreads();
}

__device__ __forceinline__ void p5_router(const Frame& F, const Args& a) {
    unsigned char* ws = F.ws; const bf16_t* H1 = (const bf16_t*)(ws + WS_H1); unsigned char* XN = ws + WS_U;
    const float* wr2 = (const float*)(ws + WS_WR2); const float* g2 = a.in[I_N2G]; const float* br = a.in[I_BR];
    float* tokw = (float*)(ws + WS_TOKW); int* slot = (int*)(ws + WS_SLOT); unsigned* cnt = F.ctl + CW_CNT;
    constexpr int HS_LD = 4104;
    LAS unsigned char* hs = F.lds; LAS float* rsv = (LAS float*)(F.lds + 32 * HS_LD); LAS float* red = (LAS float*)F.lds;
    LAS unsigned* lcnt = (LAS unsigned*)(F.lds + 32 * HS_LD + 256); LAS unsigned* lbase = lcnt + 32;
    if (F.tid < 32) lcnt[F.tid] = 0u;
    int myexp[2][2] = {{0, 0}, {0, 0}}, myrank[2][2] = {{0, 0}, {0, 0}};
    __syncthreads();
    for (int it0 = F.bid; it0 < NTOK / 32; it0 += 2 * F.G) {
#pragma unroll
      for (int kk = 0; kk < 2; ++kk) { const int it = it0 + kk * F.G;
        if (it < NTOK / 32) {
#pragma unroll
        for (int rr = 0; rr < 4; ++rr) { const int tl = F.wid * 4 + rr, row = it * 32 + tl;
            const bf16_t* hr = H1 + (size_t)row * DM; u32x4 hw[4]; float ss = 0.f;
#pragma unroll
            for (int i = 0; i < 4; ++i) { hw[i] = *(const u32x4*)(hr + i * 512 + F.lane * 8); float hf[8]; unpack8(hw[i], hf);
#pragma unroll
                for (int j = 0; j < 8; ++j) ss += hf[j] * hf[j]; }
            ss = wave_sum(ss); const float rs = rsqrtf(ss * (1.f / DM) + EPS);
            if (F.lane == 0) rsv[tl] = rs;
#pragma unroll
            for (int i = 0; i < 4; ++i) { const f32x4 g0 = *(const f32x4*)(g2 + i * 512 + F.lane * 8), g1 = *(const f32x4*)(g2 + i * 512 + F.lane * 8 + 4);
                float hf[8]; unpack8(hw[i], hf);
                const f32x4 a0 = (f32x4){hf[0], hf[1], hf[2], hf[3]} * rs * g0, a1 = (f32x4){hf[4], hf[5], hf[6], hf[7]} * rs * g1;
                u32x2 w; w[0] = cvt4_fp8(a0[0], a0[1], a0[2], a0[3]); w[1] = cvt4_fp8(a1[0], a1[1], a1[2], a1[3]);
                *(u32x2*)(XN + (size_t)row * DM + i * 512 + F.lane * 8) = w;
                LAS unsigned char* hp = hs + tl * HS_LD + (i * 512 + F.lane * 8) * 2;
                *(LAS u32x2*)hp = (u32x2){hw[i][0], hw[i][1]}; *(LAS u32x2*)(hp + 8) = (u32x2){hw[i][2], hw[i][3]}; } }
        __syncthreads();
        f32x4 c00 = {0.f, 0.f, 0.f, 0.f}, c01 = c00, c10 = c00, c11 = c00;
        { const int ti = F.lane & 15, kq = F.lane >> 4, kb = F.wid * 256 + kq;
          const LAS unsigned char* ha = hs + ti * HS_LD + kb * 2; const float* wb = wr2 + (size_t)kb * 32 + ti;
#pragma unroll 16
          for (int s_ = 0; s_ < 64; ++s_) {
              const float a0 = bf2f(*(const LAS bf16_t*)(ha + s_ * 8)), a1 = bf2f(*(const LAS bf16_t*)(ha + 16 * HS_LD + s_ * 8));
              const float b0 = wb[(size_t)s_ * 128], b1 = wb[(size_t)s_ * 128 + 16];
              c00 = __builtin_amdgcn_mfma_f32_16x16x4f32(a0, b0, c00, 0, 0, 0); c01 = __builtin_amdgcn_mfma_f32_16x16x4f32(a0, b1, c01, 0, 0, 0);
              c10 = __builtin_amdgcn_mfma_f32_16x16x4f32(a1, b0, c10, 0, 0, 0); c11 = __builtin_amdgcn_mfma_f32_16x16x4f32(a1, b1, c11, 0, 0, 0); } }
        float rsl[2];
        rsl[0] = rsv[F.tid >> 5]; rsl[1] = rsv[16 + (F.tid >> 5)];
        __syncthreads();
        { const int cj = F.lane & 15, rq = (F.lane >> 4) * 4; LAS float* rw = red + F.wid * 1024;
#pragma unroll
          for (int r = 0; r < 4; ++r) { rw[(rq + r) * 32 + cj] = c00[r]; rw[(rq + r) * 32 + 16 + cj] = c01[r]; rw[(16 + rq + r) * 32 + cj] = c10[r]; rw[(16 + rq + r) * 32 + 16 + cj] = c11[r]; } }
        __syncthreads();
#pragma unroll
        for (int ps = 0; ps < 2; ++ps) {
            const int tl = ps * 16 + (F.tid >> 5), e = F.tid & 31, row = it * 32 + tl;
            float acc = 0.f;
#pragma unroll
            for (int w = 0; w < 8; ++w) acc += red[w * 1024 + tl * 32 + e];
            const float logit = acc * rsl[ps] + br[e];
            float tv[4]; int ti[4]; float cur = logit;
#pragma unroll
            for (int k = 0; k < 4; ++k) { float bv = cur; int bi = e;
#pragma unroll
                for (int o = 16; o > 0; o >>= 1) { const float ov = __shfl_xor(bv, o); const int oi = __shfl_xor(bi, o); if (ov > bv || (ov == bv && oi < bi)) { bv = ov; bi = oi; } }
                tv[k] = bv; ti[k] = bi; if (e == bi) cur = -INFINITY; }
            const float m = tv[0]; const float e0 = 1.f, e1 = __expf(tv[1] - m), e2 = __expf(tv[2] - m), e3 = __expf(tv[3] - m); const float inv = 1.f / (e0 + e1 + e2 + e3);
            if (e < 4) { const int k = e; const int ee = k == 0 ? ti[0] : k == 1 ? ti[1] : k == 2 ? ti[2] : ti[3]; const float w = (k == 0 ? e0 : k == 1 ? e1 : k == 2 ? e2 : e3) * inv;
                tokw[(size_t)row * 4 + k] = w;
                myexp[kk][ps] = ee; myrank[kk][ps] = (int)__hip_atomic_fetch_add(lcnt + ee, 1u, __ATOMIC_RELAXED, __HIP_MEMORY_SCOPE_WORKGROUP); } }
        __syncthreads();
        } }
        if (F.tid < 32) { const unsigned c = lcnt[F.tid]; lbase[F.tid] = c ? atomicAdd(&cnt[F.tid], c) : 0u; lcnt[F.tid] = 0u; }
        __syncthreads();
#pragma unroll
        for (int kk = 0; kk < 2; ++kk) { const int it = it0 + kk * F.G;
            if (it < NTOK / 32) {
#pragma unroll
                for (int ps = 0; ps < 2; ++ps) { const int e = F.tid & 31; if (e < 4) { const int row = it * 32 + ps * 16 + (F.tid >> 5);
                        slot[(size_t)myexp[kk][ps] * NTOK + lbase[myexp[kk][ps]] + myrank[kk][ps]] = row * 4 + e; } } } }
        __syncthreads();
    }
}

__device__ __forceinline__ void moe_build_tiles(const Frame& F, LAS int* tstart, LAS int* cntl, LAS int* tstartB) {
    if (F.tid < NEXP) cntl[F.tid] = (int)__hip_atomic_load(F.ctl + CW_CNT + F.tid, __ATOMIC_RELAXED, __HIP_MEMORY_SCOPE_AGENT);
    __syncthreads();
    if (F.tid == 0) { int acc = 0, accb = 0; for (int e = 0; e < NEXP; ++e) { const int c = cntl[e]; const int rem = c & 255;
            tstart[e] = acc; tstartB[e] = accb; acc += (c >> 8) + (rem > 128 ? 1 : 0); accb += (rem >= 1 && rem <= 128) ? 1 : 0; } tstart[NEXP] = acc; tstartB[NEXP] = accb; }
    if (F.tid < 64) { const int sh = amax_shift(__hip_atomic_load(F.ctl + CW_AMAX + F.tid, __ATOMIC_RELAXED, __HIP_MEMORY_SCOPE_AGENT)); const unsigned b_ = (unsigned)(127 - sh) & 0xffu;
        cntl[40 + F.tid] = (int)(b_ | (b_ << 8) | (b_ << 16) | (b_ << 24)); }
    __syncthreads();
}

__device__ __forceinline__ void p9_combine(const Frame& F, const Args& a) {
    unsigned char* ws = F.ws; const bf16_t* H1 = (const bf16_t*)(ws + WS_H1); const unsigned char* Y = ws + WS_Y;
    const float* tokw = (const float*)(ws + WS_TOKW); const float* gf = a.in[I_FNG]; float* out = a.out;
    int tz = threadIdx.x; asm volatile("" : "+v"(tz));
    const int lane_ = tz & 63;
    for (int row = F.bid * 8 + F.wid; row < NTOK; row += F.G * 8) {
        const bf16_t* hr = H1 + (size_t)row * DM; f32x4 v[8]; float ss = 0.f;
        const f32x4 w4 = *(const f32x4*)(tokw + (size_t)row * 4);
#pragma unroll
        for (int i = 0; i < 4; ++i) { const int c0 = i * 512 + lane_ * 8; { const u32x4 hw = *(const u32x4*)(hr + c0); float hf[8]; unpack8(hw, hf);
                v[2 * i] = (f32x4){hf[0], hf[1], hf[2], hf[3]}; v[2 * i + 1] = (f32x4){hf[4], hf[5], hf[6], hf[7]}; }
#pragma unroll
            for (int k = 0; k < 4; ++k) { const u32x2 yw = *(const u32x2*)(Y + ((size_t)row * 4 + k) * DM + c0); float f[8];
                { const f32x2 t0 = __builtin_amdgcn_cvt_pk_f32_fp8(yw[0], false), t1 = __builtin_amdgcn_cvt_pk_f32_fp8(yw[0], true), t2 = __builtin_amdgcn_cvt_pk_f32_fp8(yw[1], false), t3 = __builtin_amdgcn_cvt_pk_f32_fp8(yw[1], true);
                  f[0] = t0[0]; f[1] = t0[1]; f[2] = t1[0]; f[3] = t1[1]; f[4] = t2[0]; f[5] = t2[1]; f[6] = t3[0]; f[7] = t3[1]; }
#pragma unroll
                for (int j = 0; j < 4; ++j) { v[2 * i][j] += w4[k] * f[j]; v[2 * i + 1][j] += w4[k] * f[4 + j]; } }
#pragma unroll
            for (int j = 0; j < 4; ++j) ss += v[2 * i][j] * v[2 * i][j] + v[2 * i + 1][j] * v[2 * i + 1][j]; }
        ss = wave_sum(ss); const float rs = rsqrtf(ss * (1.f / DM) + EPS);
#pragma unroll
        for (int i = 0; i < 4; ++i) { const int c0 = i * 512 + lane_ * 8; const f32x4 g0 = *(const f32x4*)(gf + c0), g1 = *(const f32x4*)(gf + c0 + 4);
            *(f32x4*)(out + (size_t)row * DM + c0) = v[2 * i] * rs * g0; *(f32x4*)(out + (size_t)row * DM + c0 + 4) = v[2 * i + 1] * rs * g1; }
    }
}

#if DEBUG_CMP
__device__ __noinline__ void dbg_compare(unsigned char* ws, unsigned* ctl, LAS unsigned char* lds) {
    const int tid = threadIdx.x, lane = tid & 63, wid = tid >> 6;
    float mx = 0.f, md = 0.f; const bf16_t* r0 = (const bf16_t*)(ws + WS_KC); const bf16_t* r1 = (const bf16_t*)(ws + WS_Y);
    for (int i = tid; i < 2 * 16 * 128 * 128; i += NTHREADS) { const float x = bf2f(i < 262144 ? r0[i] : ((const bf16_t*)(ws + WS_VC))[i - 262144]); const float y = bf2f(i < 262144 ? r1[i] : ((const bf16_t*)(ws + WS_Y + 1048576))[i - 262144]);
        mx = fmaxf(mx, fabsf(x)); md = fmaxf(md, fabsf(x - y)); if (!(y == y)) md = 1e30f; }
    mx = wave_max(mx); md = wave_max(md); LAS float* t2 = (LAS float*)lds; if (lane == 0) { t2[wid] = mx; t2[8 + wid] = md; } __syncthreads();
    if (tid == 0) { float a1 = 0.f, a2 = 0.f; for (int i = 0; i < 8; ++i) { a1 = fmaxf(a1, t2[i]); a2 = fmaxf(a2, t2[8 + i]); }
        const float rel = a2 / fmaxf(a1, 1e-20f); int code = 0;
        if (rel >= 1.f) code = 10; else if (rel >= 0.3f) code = 11; else if (rel >= 0.1f) code = 12; else if (rel >= 0.03f) code = 13; else if (rel >= 0.01f) code = 14; else if (rel >= 0.003f) code = 15;
        if (blockIdx.x == 0) ctl[CW_ERR] = (unsigned)code; }
    __syncthreads();
}
#endif
constexpr int N_PHASES = 9;
extern "C" __global__ void __launch_bounds__(NTHREADS, 2) fwd(Args args) {
    extern __shared__ __attribute__((aligned(16))) unsigned char shm[];
    LAS unsigned char* lds = (LAS unsigned char*)shm;
    Frame F; F.lds = lds; F.ws = args.ws; F.ctl = (unsigned*)(args.ws + WS_CTL);
    F.tid = threadIdx.x; F.wid = __builtin_amdgcn_readfirstlane(F.tid >> 6); F.lane = F.tid & 63; F.G = gridDim.x; F.bid = blockIdx.x;
    LAS unsigned* misc = (LAS unsigned*)(lds + LDS_MISC);
    if (F.tid < 4) misc[F.tid] = 0u;
    __syncthreads();
    const int lo = args.ph_lo, hi = args.ph_hi;
    XcdBarrier bar; bar.bar = F.ctl; bar.x = 0; bar.st = nullptr;
    if (hi - lo > 1) bar = xcd_barrier_post(F.ctl, (volatile LAS unsigned*)misc);
#define IN(k) (lo <= (k) && (k) < hi)
#define SEAM(k) do { if (IN(k) && IN((k) + 1)) xcd_barrier(bar); } while (0)
    unsigned char* ws = args.ws;

    if (IN(0)) { p0_prologue(F, args); }
#if (REP_MASK >> 0) & 1
    if (IN(0)) { p0_prologue(F, args); }
#endif
    SEAM(0);
    if (IN(1)) {
        const int gi = F.bid >> 3, g8i = gi & 7; const bool split = (F.G == 256), conv = split && (g8i == 2 || g8i == 5 || g8i == 7);
        if (conv) { const int crank = ((gi >> 3) * 3 + (g8i == 2 ? 0 : (g8i == 5 ? 1 : 2))) * 8 + (F.bid & 7); conv_experts(F, args, CONV_P2 + crank, 96, 12288); bias1_partials(F, args, crank, 96); }
        else {
            const int grank = (gi >> 3) * 5 + (g8i < 2 ? g8i : (g8i < 5 ? g8i - 1 : 4));
            g8::DenseSched<DM, DM> S; S.init(ws + WS_U, ws + WS_WINT, NTOK, PROJ_LD, split ? 160 : F.G, split ? grank * 8 + (F.bid & 7) : F.bid);
            g8::EpiProj E{(bf16_t*)(ws + WS_PROJ), PROJ_LD, (bf16_t*)(ws + WS_OMF), (const float*)(ws + WS_LB)};
            g8::gemm_phase(lds, S, E);
            if (!split) { conv_experts(F, args, CONV_P2 + F.bid, F.G, 12288); bias1_partials(F, args, F.bid, F.G); }
            else { const int c = grank * 8 + (F.bid & 7);
                if (c >= 128) conv_experts(F, args, CONV_P0 + (c - 128), 32, CONV_P0 + CONV_SPARE); }
        }
    }
#if (REP_MASK >> 1) & 1
    if (IN(1)) {
        g8::DenseSched<DM, DM> S; S.init(ws + WS_U, ws + WS_WINT, NTOK, PROJ_LD, F.G, F.bid);
        g8::EpiProj E{(bf16_t*)(ws + WS_PROJ), PROJ_LD, (bf16_t*)(ws + WS_OMF), (const float*)(ws + WS_LB)};
        g8::gemm_phase(lds, S, E);
    }
#endif
    SEAM(1);
    if (IN(2) || IN(3)) {
        constexpr int CW_CDONE = 4800, CW_CONVQ = 4864;
        constexpr int CONV_QB = 8, CONV_QBASE = CONV_P0 + CONV_SPARE, CONV_NBATCH = (CONV_P2 - CONV_QBASE) / CONV_QB;
        static_assert((CONV_P2 - CONV_QBASE) % CONV_QB == 0, "conversion queue: whole batches");
        const bool big = (F.G == 256);
        if (big) {
            if (F.bid < 64) hgrn_fast_unit(F, args, F.bid);
            else if (F.bid < 192) { compress_fast_unit(F, args, F.bid - 64);
                asm volatile("s_waitcnt vmcnt(0)" ::: "memory"); __syncthreads();
                if (F.tid == 0) { __builtin_amdgcn_fence(__ATOMIC_RELEASE, "agent"); asm volatile("s_waitcnt vmcnt(0)" ::: "memory"); (void)xb_add(F.ctl + CW_CDONE, 1u); }
            }
            else {
                for (;;) { if (F.tid == 0) misc[9] = (xb_ld(F.ctl + CW_CDONE) >= 128u) ? 0xffffffffu : atomicAdd(F.ctl + CW_CONVQ, 1u);
                    __syncthreads();
                    const unsigned qi = misc[9];
                    if (qi >= (unsigned)CONV_NBATCH) break;
                    conv_experts(F, args, CONV_QBASE + (int)qi * CONV_QB, 1, CONV_QBASE + ((int)qi + 1) * CONV_QB); } }
        } else {
            for (int u = F.bid; u < 128; u += F.G) { compress_fast_unit(F, args, u); asm volatile("s_waitcnt vmcnt(0)" ::: "memory"); __syncthreads();
                if (F.tid == 0) { __builtin_amdgcn_fence(__ATOMIC_RELEASE, "agent"); asm volatile("s_waitcnt vmcnt(0)" ::: "memory"); (void)xb_add(F.ctl + CW_CDONE, 1u); } }
            conv_experts(F, args, CONV_P0 + F.bid, F.G, CONV_P2);
            if (F.bid < 64) hgrn_fast_unit(F, args, F.bid);
        }
        if (F.tid == 0) { XB_SPIN(xb_ld(F.ctl + CW_CDONE) < 128u, F.ctl); __builtin_amdgcn_fence(__ATOMIC_ACQUIRE, "agent"); asm volatile("s_waitcnt vmcnt(0)" ::: "memory"); }
        __syncthreads();
        for (;;) { if (F.tid == 0) misc[8] = atomicAdd(F.ctl + CW_QUEUE, 1u);
            __syncthreads();
            const int u = (int)misc[8];
            if (u >= BATCH * NSA_G * 32) break;
            attn_fast_unit(F, args, u); }
        if (big) for (;;) { if (F.tid == 0) misc[9] = atomicAdd(F.ctl + CW_CONVQ, 1u);
            __syncthreads();
            const unsigned qi = misc[9];
            if (qi >= (unsigned)CONV_NBATCH) break;
            conv_experts(F, args, CONV_QBASE + (int)qi * CONV_QB, 1, CONV_QBASE + ((int)qi + 1) * CONV_QB); }
    }
#if ((REP_MASK >> 2) & 1) || ((REP_MASK >> 3) & 1)
#error "phases 2 and 3 are merged: repetition not supported"
#endif
    SEAM(3);
    if (IN(4)) {
        g8::DenseSched<DM, DM> S; S.init(ws + WS_YMIX, ws + WS_WOUTT, NTOK, DM, F.G, F.bid);
        g8::EpiResBf16 E{(bf16_t*)(ws + WS_H1), args.in[I_X], DM};
        g8::gemm_phase(lds, S, E);
    }
#if (REP_MASK >> 4) & 1
    if (IN(4)) {
        g8::DenseSched<DM, DM> S; S.init(ws + WS_YMIX, ws + WS_WOUTT, NTOK, DM, F.G, F.bid);
        g8::EpiResBf16 E{(bf16_t*)(ws + WS_H1), args.in[I_X], DM};
        g8::gemm_phase(lds, S, E);
    }
#endif
    SEAM(4);
    if (IN(5)) { p5_router(F, args); }
#if (REP_MASK >> 5) & 1
    if (IN(5)) { p5_router(F, args); }
#endif
    SEAM(5);
    if (IN(6)) {
        LAS int* tstart = (LAS int*)(misc + 64); LAS int* cntl = tstart + 40; LAS int* tstartB = cntl + 104;
        moe_build_tiles(F, tstart, cntl, tstartB);
        g8::EpiGateUp E{(unsigned char*)(ws + WS_ACT), args.in[I_BGU]};
        { g8::MoeSched<16, 2, true, 0> S{(const char*)(ws + WS_U), (const char*)(ws + WS_WGUT), (const int*)(ws + WS_SLOT), args.in[I_BGU], tstart, cntl, F.G, F.bid}; g8::gemm_phase(lds, S, E); }
        { g8::MoeSched<16, 2, true, 1> S{(const char*)(ws + WS_U), (const char*)(ws + WS_WGUT), (const int*)(ws + WS_SLOT), args.in[I_BGU], tstartB, cntl, F.G, F.bid}; g8::gemm_phase(lds, S, E); }
    }
#if (REP_MASK >> 6) & 1
    if (IN(6)) {
        LAS int* tstart = (LAS int*)(misc + 64); LAS int* cntl = tstart + 40;
        moe_build_tiles(F, tstart, cntl);
        g8::MoeSched<16, 2, true> S{(const char*)(ws + WS_U), (const char*)(ws + WS_WGUT), (const int*)(ws + WS_SLOT), args.in[I_BGU], tstart, cntl, F.G, F.bid};
        g8::EpiGateUp E{(unsigned char*)(ws + WS_ACT), args.in[I_BGU]};
        g8::gemm_phase(lds, S, E);
    }
#endif
    SEAM(6);
    if (IN(7)) {
        LAS int* tstart = (LAS int*)(misc + 64); LAS int* cntl = tstart + 40; LAS int* tstartB = cntl + 104;
        moe_build_tiles(F, tstart, cntl, tstartB);
        g8::EpiDown E{ws + WS_Y, args.in[I_BD]};
        { g8::MoeSched<8, 0, false, 0> S{(const char*)(ws + WS_ACT), (const char*)(ws + WS_WDT), (const int*)(ws + WS_SLOT), args.in[I_BD], tstart, cntl, F.G, F.bid}; g8::gemm_phase(lds, S, E); }
        { g8::MoeSched<8, 0, false, 1> S{(const char*)(ws + WS_ACT), (const char*)(ws + WS_WDT), (const int*)(ws + WS_SLOT), args.in[I_BD], tstartB, cntl, F.G, F.bid}; g8::gemm_phase(lds, S, E); }
    }
#if (REP_MASK >> 7) & 1
    if (IN(7)) {
        LAS int* tstart = (LAS int*)(misc + 64); LAS int* cntl = tstart + 40;
        moe_build_tiles(F, tstart, cntl);
        g8::MoeSched<8, 0, false> S{(const char*)(ws + WS_ACT), (const char*)(ws + WS_WDT), (const int*)(ws + WS_SLOT), args.in[I_BD], tstart, cntl, F.G, F.bid};
        g8::EpiDown E{ws + WS_Y, args.in[I_BD]};
        g8::gemm_phase(lds, S, E);
    }
#endif
    SEAM(7);
    if (IN(8)) { p9_combine(F, args);
#if DEBUG_CMP
        { const unsigned code = __hip_atomic_load(F.ctl + CW_ERR, __ATOMIC_RELAXED, __HIP_MEMORY_SCOPE_AGENT);
          if (code) { const float cval = sqrtf((float)code); for (size_t i = (size_t)F.bid * NTHREADS + F.tid; i < (size_t)NTOK * DM; i += (size_t)F.G * NTHREADS) args.out[i] = cval; } }
#endif
    }
#if (REP_MASK >> 8) & 1
    if (IN(8)) { p9_combine(F, args);
#if DEBUG_CMP
        { const unsigned code = __hip_atomic_load(F.ctl + CW_ERR, __ATOMIC_RELAXED, __HIP_MEMORY_SCOPE_AGENT);
          if (code) { const float cval = sqrtf((float)code); for (size_t i = (size_t)F.bid * NTHREADS + F.tid; i < (size_t)NTOK * DM; i += (size_t)F.G * NTHREADS) args.out[i] = cval; } }
#endif
    }
#endif
#undef IN
#undef SEAM
}

extern "C" void kernel_launch(void* const* d_in, const int* in_sizes, int n_in, void* d_out, int out_size, void* d_ws, size_t ws_size, hipStream_t stream) {
    static int grid = 0;
    if (grid == 0) {
        if (n_in != 18 || ws_size < WS_END) { fprintf(stderr, "kernel_launch: n_in %d ws %zu (need %zu)\n", n_in, ws_size, (size_t)WS_END); grid = -1; return; }
        int dev = 0, cus = 0, per_cu = 0;
        if (hipGetDevice(&dev) != hipSuccess || hipDeviceGetAttribute(&cus, hipDeviceAttributeMultiprocessorCount, dev) != hipSuccess) { grid = -1; return; }
        if (hipFuncSetAttribute((const void*)fwd, hipFuncAttributeMaxDynamicSharedMemorySize, LDS_BYTES) != hipSuccess) { fprintf(stderr, "kernel_launch: hipFuncSetAttribute failed\n"); grid = -1; return; }
        if (hipOccupancyMaxActiveBlocksPerMultiprocessor(&per_cu, (const void*)fwd, NTHREADS, LDS_BYTES) != hipSuccess || per_cu < 1) { fprintf(stderr, "kernel_launch: occupancy query says %d\n", per_cu); }
        (void)hipGetLastError();
        grid = cus;
    }
    if (grid < 0) return;
    (void)hipMemsetAsync((char*)d_ws + WS_CTL, 0, CTL_BYTES, stream);
    Args a{};
    for (int i = 0; i < 18; ++i) a.in[i] = (const float*)d_in[i];
    a.out = (float*)d_out; a.ws = (unsigned char*)d_ws;
#if N_LAUNCH_PER_PHASE
    for (int p = 0; p < N_PHASES; ++p) { a.ph_lo = p; a.ph_hi = p + 1; hipLaunchKernelGGL(fwd, dim3(grid), dim3(NTHREADS), LDS_BYTES, stream, a); }
#else
    a.ph_lo = 0; a.ph_hi = N_PHASES; hipLaunchKernelGGL(fwd, dim3(grid), dim3(NTHREADS), LDS_BYTES, stream, a);
#endif
}
```
